# Optimizing an MI355X kernel written in HIP

```python
import jax, jax.numpy as jnp
from jax import lax
import numpy as np

D_MODEL = 2048
BATCH = 4
SEQ = 2048
DEPTH = 4
DEC_BATCH = 128
DEC_SEQ = 1
PAST_LEN = 16384
PAGE_SIZE = 128

W_A = D_MODEL // 4
A_GROUPS = 4
A_GD = W_A // A_GROUPS
A_CHUNK = 128
W_B = 3 * D_MODEL // 8
B_HEAD = 64
B_HEADS = W_B // B_HEAD
LORA_W = 64
LORA_A = 64
LORA_G = 128
W_C = D_MODEL - W_A - W_B
C_HEAD = 128
C_HEADS = W_C // C_HEAD
C_CHUNK = 128
MIX_WIDTH = W_A + W_B + W_C
P_A = 2 * W_A
P_B = 3 * W_B + LORA_W + LORA_A + LORA_G
P_C = 4 * W_C
P_IN = P_A + P_B + P_C
D_FF = (8 * D_MODEL + 3 * 256 - 1) // (3 * 256) * 256
D_PLE = 256
DEEPNORM_ALPHA = (2 * DEPTH) ** 0.25
DEEPNORM_BETA = (8 * DEPTH) ** -0.25
LN_EPS = 1e-5
B_GN_EPS = 1e-5 * B_HEAD
RMS_EPS = 1e-6

kernel_name = 'hybrid_sgu_rwkv7_hgrn2_deepnorm_step'


def layer_norm(x, g, b, eps=LN_EPS):
    xf = x.astype(jnp.float32)
    mu = jnp.mean(xf, axis=-1, keepdims=True)
    var = jnp.mean(jnp.square(xf - mu), axis=-1, keepdims=True)
    return ((xf - mu) * lax.rsqrt(var + eps) * g.astype(jnp.float32) + b.astype(jnp.float32)).astype(x.dtype)


def rms_norm(x, g, eps=RMS_EPS):
    xf = x.astype(jnp.float32)
    return (xf * lax.rsqrt(jnp.mean(jnp.square(xf), axis=-1, keepdims=True) + eps) * g.astype(jnp.float32)).astype(x.dtype)


def chunk_sgu(u, v, ln_g, ln_b, w_s, b_s):
    B, T, _ = u.shape
    n_chunks = -(-T // A_CHUNK)
    pad = n_chunks * A_CHUNK - T
    vn = layer_norm(v.reshape(B, T, A_GROUPS, A_GD), ln_g.reshape(A_GROUPS, A_GD), ln_b.reshape(A_GROUPS, A_GD))
    vb = jnp.pad(vn, ((0, 0), (0, pad), (0, 0), (0, 0))).reshape(B, n_chunks, A_CHUNK, A_GROUPS, A_GD)
    causal = jnp.tril(jnp.ones((A_CHUNK, A_CHUNK), dtype=bool))
    w_causal = jnp.where(causal[None], w_s, jnp.zeros_like(w_s))
    mixed = jnp.einsum('gts,bcsgd->bctgd', w_causal, vb) + b_s.T[None, None, :, :, None]
    mixed = mixed.reshape(B, n_chunks * A_CHUNK, W_A)[:, :T]
    return u * mixed, vn.reshape(B, T, W_A)


def rwkv7_scan(r, log_w, k, v, kk, a, S0):
    xs = tuple(jnp.swapaxes(t.astype(jnp.float32), 0, 1) for t in (r, log_w, k, v, kk, a))

    def step(S, xt):
        r_t, lw_t, k_t, v_t, kk_t, a_t = xt
        s_kk = jnp.einsum('bhvk,bhk->bhv', S, kk_t)
        S = (S * jnp.exp(lw_t)[:, :, None, :]
             - s_kk[..., None] * (kk_t * a_t)[:, :, None, :]
             + v_t[..., None] * k_t[:, :, None, :])
        return S, jnp.einsum('bhvk,bhk->bhv', S, r_t)

    S, ys = lax.scan(step, S0.astype(jnp.float32), xs)
    return jnp.swapaxes(ys, 0, 1), S


def rwkv7_mix(zb, S0, W):
    B, T, _ = zb.shape
    o1, o2, o3 = W_B, 2 * W_B, 3 * W_B
    o4, o5 = o3 + LORA_W, o3 + LORA_W + LORA_A
    r, k, v = zb[..., :o1], zb[..., o1:o2], zb[..., o2:o3]
    wd, ad, gd = zb[..., o3:o4], zb[..., o4:o5], zb[..., o5:]
    w = (W['b_w0'] + jnp.tanh(wd) @ W['b_w_up']).astype(jnp.float32)
    log_decay = -jnp.exp(-jax.nn.softplus(-w) - 0.5)
    a = jax.nn.sigmoid(W['b_a0'] + ad @ W['b_a_up'])
    g = jax.nn.sigmoid(gd) @ W['b_g_up']
    heads = lambda t: t.reshape(B, T, B_HEADS, B_HEAD)
    kk = heads((k * W['b_k_k']).astype(jnp.float32))
    kk = kk / jnp.maximum(jnp.sqrt(jnp.sum(jnp.square(kk), axis=-1, keepdims=True)), 1e-12)
    k = k * (1 + (a - 1) * W['b_k_a'])
    rh, kh, vh, ah = heads(r), heads(k), heads(v), heads(a)
    y, S = rwkv7_scan(rh, heads(log_decay), kh, vh, kk, ah, S0)
    y = layer_norm(y, W['b_gn_g'].reshape(B_HEADS, B_HEAD), W['b_gn_b'].reshape(B_HEADS, B_HEAD), eps=B_GN_EPS)
    bonus = jnp.sum((rh * kh * W['b_r_k']).astype(jnp.float32), axis=-1, keepdims=True) * vh.astype(jnp.float32)
    y = (y + bonus).reshape(B, T, W_B) * g.astype(jnp.float32)
    return y.astype(zb.dtype), S


def hgrn2_chunkwise(q, log_f, k, v, S0):
    B, T, H, DK = q.shape
    DV = v.shape[-1]
    C = min(C_CHUNK, T)
    n = -(-T // C)
    pad = n * C - T

    def blocks(t):
        t = jnp.pad(t.astype(jnp.float32), ((0, 0), (0, pad), (0, 0), (0, 0)))
        return jnp.swapaxes(t.reshape(B, n, C, H, t.shape[-1]), 0, 1)

    causal = jnp.tril(jnp.ones((C, C), dtype=bool))[None, :, :, None, None]

    def step(S, blk):
        qc, lfc, kc, vc = blk
        b = jnp.cumsum(lfc, axis=1)
        o_inter = jnp.einsum('bthk,bhkv->bthv', qc * jnp.exp(b), S)
        diff = b[:, :, None] - b[:, None, :]
        dec = jnp.where(causal, jnp.exp(jnp.minimum(diff, 0.0)), 0.0)
        att = jnp.einsum('bthk,bshk,btshk->bhts', qc, kc, dec)
        o_intra = jnp.einsum('bhts,bshv->bthv', att, vc)
        b_end = b[:, -1]
        S = jnp.exp(b_end)[..., None] * S + jnp.einsum('bshk,bshv->bhkv', kc * jnp.exp(b_end[:, None] - b), vc)
        return S, o_inter + o_intra

    S, o = lax.scan(step, S0.astype(jnp.float32), tuple(blocks(t) for t in (q, log_f, k, v)))
    o = jnp.swapaxes(o, 0, 1).reshape(B, n * C, H, DV)[:, :T]
    return o, S


def hgrn2_mix(zc, lb, S0, W):
    B, T, _ = zc.shape
    q, fz, iv, g = jnp.split(zc, 4, axis=-1)
    fz = fz.astype(jnp.float32)
    log_f = jnp.logaddexp(jax.nn.log_sigmoid(fz), jnp.log(lb) + jax.nn.log_sigmoid(-fz))
    k = (1.0 - lb) * jax.nn.sigmoid(-fz)
    heads = lambda t: t.reshape(B, T, C_HEADS, C_HEAD)
    o, S = hgrn2_chunkwise(heads(q), heads(log_f), heads(k), heads(iv), S0)
    o = rms_norm(o.reshape(B, T, W_C), W['c_norm_g']) * jax.nn.silu(g.astype(jnp.float32))
    return o.astype(zc.dtype), S


def hybrid_layer(h, p_l, shift0, rwkv0, hgrn0, lb, W):
    z = h @ W['w_in']
    za, zb, zc = z[..., :P_A], z[..., P_A:P_A + P_B], z[..., P_A + P_B:]
    u = jax.nn.gelu(za[..., :W_A], approximate=False)
    v = jax.nn.gelu(za[..., W_A:], approximate=False)
    y_a, v_rows = chunk_sgu(u, v, W['a_ln_g'], W['a_ln_b'], W['a_ws'], W['a_bs'])
    prev = jnp.concatenate([shift0[:, None].astype(zb.dtype), zb[:, :-1]], axis=1)
    y_b, rwkv_new = rwkv7_mix(zb + W['b_mu'] * (prev - zb), rwkv0, W)
    y_c, hgrn_new = hgrn2_mix(zc, lb, hgrn0, W)
    mix = jnp.concatenate([y_a, y_b, y_c], axis=-1) @ W['w_out']
    h = layer_norm(DEEPNORM_ALPHA * h + mix, W['ln1_g'], W['ln1_b'])
    ffn = (jax.nn.silu(h @ W['w_ffn_gate']) * (h @ W['w_ffn_up'])) @ W['w_ffn_down']
    ple = jax.nn.sigmoid(h @ W['w_ple_gate']) * (p_l.astype(h.dtype) @ W['w_ple_proj'])
    h = layer_norm(DEEPNORM_ALPHA * h + ffn + ple, W['ln2_g'], W['ln2_b'])
    return h, zb[:, -1], rwkv_new.astype(h.dtype), hgrn_new.astype(h.dtype), v_rows


def setup_inputs(seed: int = 0) -> dict:
    key = jax.random.key(seed)
    ks = jax.random.split(key, 40)
    f32 = jnp.float32

    def nrm(i, shape, scale=1.0):
        return scale * jax.random.normal(ks[i], shape, f32)

    return {
        'x_prompt': nrm(0, (BATCH, SEQ, D_MODEL)),
        'x_sample': nrm(1, (DEC_BATCH, DEC_SEQ, D_MODEL)),
        'state_rwkv': nrm(2, (DEPTH, DEC_BATCH, B_HEADS, B_HEAD, B_HEAD), 0.3),
        'state_shift': nrm(3, (DEPTH, DEC_BATCH, P_B)),
        'state_hgrn': nrm(4, (DEPTH, DEC_BATCH, C_HEADS, C_HEAD, C_HEAD), 0.3),
        'p_prompt': nrm(5, (DEPTH, BATCH, SEQ, D_PLE)),
        'p_sample': nrm(6, (DEPTH, DEC_BATCH, DEC_SEQ, D_PLE)),
        'ln_in_g': 1.0 + nrm(7, (D_MODEL,), 0.02),
        'ln_in_b': nrm(8, (D_MODEL,), 0.02),
        'w_in': nrm(9, (DEPTH, D_MODEL, P_IN), D_MODEL ** -0.5),
        'a_ln_g': 1.0 + nrm(10, (DEPTH, W_A), 0.02),
        'a_ln_b': nrm(11, (DEPTH, W_A), 0.02),
        'a_ws': nrm(12, (DEPTH, A_GROUPS, A_CHUNK, A_CHUNK), A_CHUNK ** -0.5),
        'a_bs': 1.0 + nrm(13, (DEPTH, A_GROUPS, A_CHUNK), 0.02),
        'b_mu': jax.random.uniform(ks[14], (DEPTH, P_B), f32, 0.1, 0.9),
        'b_w0': jax.random.uniform(ks[15], (DEPTH, W_B), f32, -6.0, 1.0),
        'b_w_up': nrm(16, (DEPTH, LORA_W, W_B), 0.5 * LORA_W ** -0.5),
        'b_a0': nrm(17, (DEPTH, W_B), 0.1),
        'b_a_up': nrm(18, (DEPTH, LORA_A, W_B), 0.5 * LORA_A ** -0.5),
        'b_g_up': nrm(19, (DEPTH, LORA_G, W_B), LORA_G ** -0.5),
        'b_k_k': 0.85 + nrm(20, (DEPTH, W_B), 0.05),
        'b_k_a': 1.0 + nrm(21, (DEPTH, W_B), 0.05),
        'b_r_k': nrm(22, (DEPTH, B_HEADS, B_HEAD), 0.1),
        'b_gn_g': 1.0 + nrm(23, (DEPTH, W_B), 0.02),
        'b_gn_b': nrm(24, (DEPTH, W_B), 0.02),
        'c_lower_bounds': nrm(25, (DEPTH, W_C)),
        'c_norm_g': 1.0 + nrm(26, (DEPTH, W_C), 0.02),
        'w_out': nrm(27, (DEPTH, MIX_WIDTH, D_MODEL), DEEPNORM_BETA * MIX_WIDTH ** -0.5),
        'ln1_g': 1.0 + nrm(28, (DEPTH, D_MODEL), 0.02),
        'ln1_b': nrm(29, (DEPTH, D_MODEL), 0.02),
        'w_ffn_gate': nrm(30, (DEPTH, D_MODEL, D_FF), D_MODEL ** -0.5),
        'w_ffn_up': nrm(31, (DEPTH, D_MODEL, D_FF), D_MODEL ** -0.5),
        'w_ffn_down': nrm(32, (DEPTH, D_FF, D_MODEL), DEEPNORM_BETA * D_FF ** -0.5),
        'w_ple_gate': nrm(33, (DEPTH, D_MODEL, D_MODEL), D_MODEL ** -0.5),
        'w_ple_proj': nrm(34, (DEPTH, D_PLE, D_MODEL), DEEPNORM_BETA * D_PLE ** -0.5),
        'ln2_g': 1.0 + nrm(35, (DEPTH, D_MODEL), 0.02),
        'ln2_b': nrm(36, (DEPTH, D_MODEL), 0.02),
    }


def reference(x_prompt, x_sample, state_rwkv, state_shift, state_hgrn, p_prompt, p_sample,
              ln_in_g, ln_in_b, w_in, a_ln_g, a_ln_b, a_ws, a_bs,
              b_mu, b_w0, b_w_up, b_a0, b_a_up, b_g_up, b_k_k, b_k_a, b_r_k, b_gn_g, b_gn_b,
              c_lower_bounds, c_norm_g, w_out, ln1_g, ln1_b,
              w_ffn_gate, w_ffn_up, w_ffn_down, w_ple_gate, w_ple_proj, ln2_g, ln2_b):
    lb_cum = jnp.cumsum(jax.nn.softmax(c_lower_bounds.astype(jnp.float32), axis=0), axis=0)
    lower_bound = lb_cum - lb_cum[0]
    n_prompt = x_prompt.shape[0]
    dt = x_prompt.dtype
    hp = layer_norm(x_prompt, ln_in_g, ln_in_b)
    hs = layer_norm(x_sample, ln_in_g, ln_in_b)
    shift_zero = jnp.zeros((n_prompt, P_B), dt)
    rwkv_zero = jnp.zeros((n_prompt, B_HEADS, B_HEAD, B_HEAD), dt)
    hgrn_zero = jnp.zeros((n_prompt, C_HEADS, C_HEAD, C_HEAD), dt)
    rwkv_p, shift_p, hgrn_p = [], [], []
    rwkv_s, shift_s, hgrn_s, sgu_v_s = [], [], [], []
    for i in range(DEPTH):
        W = dict(w_in=w_in[i], a_ln_g=a_ln_g[i], a_ln_b=a_ln_b[i], a_ws=a_ws[i], a_bs=a_bs[i],
                 b_mu=b_mu[i], b_w0=b_w0[i], b_w_up=b_w_up[i], b_a0=b_a0[i], b_a_up=b_a_up[i],
                 b_g_up=b_g_up[i], b_k_k=b_k_k[i], b_k_a=b_k_a[i], b_r_k=b_r_k[i],
                 b_gn_g=b_gn_g[i], b_gn_b=b_gn_b[i], c_norm_g=c_norm_g[i], w_out=w_out[i],
                 ln1_g=ln1_g[i], ln1_b=ln1_b[i], w_ffn_gate=w_ffn_gate[i], w_ffn_up=w_ffn_up[i],
                 w_ffn_down=w_ffn_down[i], w_ple_gate=w_ple_gate[i], w_ple_proj=w_ple_proj[i],
                 ln2_g=ln2_g[i], ln2_b=ln2_b[i])
        hp, sh, r_st, c_st, _ = hybrid_layer(hp, p_prompt[i], shift_zero, rwkv_zero, hgrn_zero, lower_bound[i], W)
        rwkv_p.append(r_st)
        shift_p.append(sh)
        hgrn_p.append(c_st)
        hs, sh, r_st, c_st, v_rows = hybrid_layer(hs, p_sample[i], state_shift[i], state_rwkv[i], state_hgrn[i], lower_bound[i], W)
        rwkv_s.append(r_st)
        shift_s.append(sh)
        hgrn_s.append(c_st)
        sgu_v_s.append(v_rows)
    return (hp, hs, jnp.stack(rwkv_p), jnp.stack(shift_p), jnp.stack(hgrn_p),
            jnp.stack(rwkv_s), jnp.stack(shift_s), jnp.stack(hgrn_s), jnp.stack(sgu_v_s))
```

```cpp
#include <hip/hip_runtime.h>
#include <cstdio>
#include <cstdint>
namespace pg8 {
#define PG8_LAS __attribute__((address_space(3)))
typedef unsigned short bf16_t;
typedef short bf16x8 __attribute__((ext_vector_type(8)));
typedef float f32x4 __attribute__((ext_vector_type(4)));
typedef unsigned u32x4 __attribute__((ext_vector_type(4)));
constexpr int BM = 256, BK = 64, HALF = 128, HTB = HALF * BK * 2  , STAGE_BYTES = 8 * HTB, NXCD = 8, WGM = 8;

__host__ __device__ __forceinline__ int lds_byte(int r, int c) { const int st = (r >> 4) * 2 + (c >> 5), rr = r & 15, cc = c & 31, ob = rr * 64 + cc * 2; return st * 1024 + (ob ^ (((ob >> 9) & 1) << 5)); }
__host__ __device__ __forceinline__ void stage_rc(int b, int& R, int& C) { const int st = b / 1024, sb = b % 1024, swz = sb ^ (((sb >> 9) & 1) << 5); R = (st >> 1) * 16 + swz / 64; C = (st & 1) * 32 + (swz % 64) / 2; }
__host__ __device__ __forceinline__ int perm32(int rho) { const int n = rho >> 4, i = rho & 15; return 8 * (i >> 2) + 4 * n + (i & 3); }

struct Unit { int pm, pn; };
struct Gemm { const bf16_t* A; const bf16_t* Bt; int M, N, K; };

struct StaticOrder {
    int nM, nN, nwg, G, c;
    __host__ __device__ void init(int M, int N, int G_, int c_) { nM = M / BM; nN = N / BM; nwg = nM * nN; G = G_; c = c_; }
    __host__ __device__ bool next(int i, Unit& u) const {
        const long L = (long)i * G + c; if (L >= nwg) return false;
        int wgid = (int)L; { const int q = nwg / NXCD, r = nwg % NXCD, xcd = wgid % NXCD, off = wgid / NXCD; wgid = (xcd < r ? xcd * (q + 1) : r * (q + 1) + (xcd - r) * q) + off; }
        const int nig = WGM * nN, gid = wgid / nig, fm = gid * WGM, gsz = (nM - fm) < WGM ? (nM - fm) : WGM;
        u.pm = fm + ((wgid % nig) % gsz); u.pn = (wgid % nig) / gsz; return true;
    }
    __device__ __forceinline__ void a_ready(const Unit&) const {}
    __device__ __forceinline__ void done(const Unit&) const {}
};

__device__ __forceinline__ unsigned cvt_pk_bf16(float lo, float hi) { unsigned r; asm volatile("v_cvt_pk_bf16_f32 %0, %1, %2" : "=v"(r) : "v"(lo), "v"(hi)); return r; }
typedef float f32x2 __attribute__((ext_vector_type(2)));
struct EpiF32 {
    static constexpr bool PERM = false, AFTER_DRAIN = false;
    float* C; int ldc;
    __device__ __forceinline__ void operator()(const f32x4 (&acc)[2][2][4][2], const Unit& u, int wr, int wc, int fr, int fq) const {
        const int row0 = u.pm * BM + wr * 64 + fr, col0 = u.pn * BM + wc * 32 + 4 * fq;
#pragma unroll
        for (int ai = 0; ai < 2; ++ai)
#pragma unroll
            for (int m = 0; m < 4; ++m) { float* rowp = C + (size_t)(row0 + ai * HALF + m * 16) * ldc + col0;
#pragma unroll
                for (int bj = 0; bj < 2; ++bj)
#pragma unroll
                    for (int n = 0; n < 2; ++n) *(f32x4*)(rowp + bj * HALF + n * 16) = acc[ai][bj][m][n]; }
    }
};
struct EpiResid {
    static constexpr bool PERM = false, AFTER_DRAIN = false;
    float* out; const float* base; const float* add; int ldc; float alpha;
    __device__ __forceinline__ void operator()(const f32x4 (&acc)[2][2][4][2], const Unit& u, int wr, int wc, int fr, int fq) const {
        const int row0 = u.pm * BM + wr * 64 + fr, col0 = u.pn * BM + wc * 32 + 4 * fq;
#pragma unroll
        for (int ai = 0; ai < 2; ++ai)
#pragma unroll
            for (int m = 0; m < 4; ++m) { const size_t off = (size_t)(row0 + ai * HALF + m * 16) * ldc + col0;
#pragma unroll
                for (int bj = 0; bj < 2; ++bj)
#pragma unroll
                    for (int n = 0; n < 2; ++n) { const size_t o2 = off + bj * HALF + n * 16; f32x4 v = *(const f32x4*)(base + o2) * alpha + acc[ai][bj][m][n];
                        if (add) v += *(const f32x4*)(add + o2); *(f32x4*)(out + o2) = v; } }
    }
};
struct EpiSigMul {
    static constexpr bool PERM = false, AFTER_DRAIN = false;
    float* out; const float* mul; int ldc;
    __device__ __forceinline__ void operator()(const f32x4 (&acc)[2][2][4][2], const Unit& u, int wr, int wc, int fr, int fq) const {
        const int row0 = u.pm * BM + wr * 64 + fr, col0 = u.pn * BM + wc * 32 + 4 * fq;
#pragma unroll
        for (int ai = 0; ai < 2; ++ai)
#pragma unroll
            for (int m = 0; m < 4; ++m) { const size_t off = (size_t)(row0 + ai * HALF + m * 16) * ldc + col0;
#pragma unroll
                for (int bj = 0; bj < 2; ++bj)
#pragma unroll
                    for (int n = 0; n < 2; ++n) { const size_t o2 = off + bj * HALF + n * 16; const f32x4 x = acc[ai][bj][m][n]; const f32x4 p = *(const f32x4*)(mul + o2); f32x4 v;
#pragma unroll
                        for (int e = 0; e < 4; ++e) v[e] = p[e] * __builtin_amdgcn_rcpf(1.0f + __expf(-x[e]));
                        *(f32x4*)(out + o2) = v; } }
    }
};
struct EpiSwiglu {
    static constexpr bool PERM = true, AFTER_DRAIN = false;
    bf16_t* O; int ldo;
    __device__ __forceinline__ void operator()(const f32x4 (&acc)[2][2][4][2], const Unit& u, int wr, int wc, int fr, int fq) const {
        const int row0 = u.pm * BM + wr * 64 + fr, col0 = u.pn * HALF + wc * 32 + 8 * fq;
#pragma unroll
        for (int ai = 0; ai < 2; ++ai)
#pragma unroll
            for (int m = 0; m < 4; ++m) { bf16_t* rowp = O + (size_t)(row0 + ai * HALF + m * 16) * ldo + col0; float r[8];
#pragma unroll
                for (int n = 0; n < 2; ++n)
#pragma unroll
                    for (int e = 0; e < 4; ++e) { const float g = acc[ai][0][m][n][e], up = acc[ai][1][m][n][e]; r[4 * n + e] = g * __builtin_amdgcn_rcpf(1.0f + __expf(-g)) * up; }
                u32x4 w; w.x = cvt_pk_bf16(r[0], r[1]); w.y = cvt_pk_bf16(r[2], r[3]); w.z = cvt_pk_bf16(r[4], r[5]); w.w = cvt_pk_bf16(r[6], r[7]);
                *(u32x4*)rowp = w; }
    }
};
template <class Epi, class Sched, bool ALIGN_EPI = false, bool SP2 = false>
__device__ __forceinline__ void gemm_phase(PG8_LAS unsigned char* lds, const Gemm g, const Sched& S, const Epi& E) {
    int tid_l = threadIdx.x; asm volatile("" : "+v"(tid_l));
    const int tid = tid_l, wid = __builtin_amdgcn_readfirstlane(tid >> 6), lane = tid & 63, wr = wid >> 2, wc = wid & 3, fr = lane & 15, fq = lane >> 4;
    const int K = g.K, nt = K / BK;
    unsigned voffA[2], voffB[2];
#pragma unroll
    for (int i = 0; i < 2; ++i) { int R, C; stage_rc(tid * 16 + i * 8192, R, C); const int Rb = Epi::PERM ? ((R & ~31) + perm32(R & 31)) : R;
        voffA[i] = (unsigned)(R * K + C) * 2u; voffB[i] = (unsigned)(Rb * K + C) * 2u; }
    const size_t kstep = (size_t)(BK * 2);
    const size_t hstep = (size_t)HALF * K * 2;
    const size_t tstep = 2 * hstep;
    const unsigned ldsw = (unsigned)wid * 1024u;
    const int aoff = lds_byte(wr * 64 + fr, fq * 8), boff = lds_byte(wc * 32 + fr, fq * 8);
#define PG8_SA(b, h) (((b) * 2 + (h)) * HTB)
#define PG8_SB(b, h) ((4 + (b) * 2 + (h)) * HTB)
#define PG8_STAGE(bufoff, gbase, voff) do { _Pragma("unroll") for (int _i = 0; _i < 2; ++_i) \
        __builtin_amdgcn_global_load_lds((const unsigned*)((const char*)(gbase) + (voff)[_i]), (PG8_LAS unsigned*)(lds + (bufoff) + ldsw + _i * 8192), 16, 0, 0); } while (0)
#define PG8_LDA(dst, b, h) do { _Pragma("unroll") for (int m = 0; m < 4; ++m) _Pragma("unroll") for (int k = 0; k < 2; ++k) dst[m][k] = *(const PG8_LAS bf16x8*)(lds + PG8_SA(b, h) + aoff + m * 2048 + k * 1024); } while (0)
#define PG8_LDB(dst, b, h) do { _Pragma("unroll") for (int n = 0; n < 2; ++n) _Pragma("unroll") for (int k = 0; k < 2; ++k) dst[n][k] = *(const PG8_LAS bf16x8*)(lds + PG8_SB(b, h) + boff + n * 2048 + k * 1024); } while (0)
#define PG8_MMA(ai, bj, At, Bt) do { __builtin_amdgcn_s_setprio(1); _Pragma("unroll") for (int m = 0; m < 4; ++m) _Pragma("unroll") for (int n = 0; n < 2; ++n) _Pragma("unroll") for (int k = 0; k < 2; ++k) \
        acc[ai][bj][m][n] = __builtin_amdgcn_mfma_f32_16x16x32_bf16(Bt[n][k], At[m][k], acc[ai][bj][m][n], 0, 0, 0); __builtin_amdgcn_s_setprio(0); } while (0)
#define PG8_WAIT_V(n) asm volatile("s_waitcnt vmcnt(" #n ")" ::: "memory")
#define PG8_WAIT_L(n) asm volatile("s_waitcnt lgkmcnt(" #n ")" ::: "memory")
#define PG8_BAR __builtin_amdgcn_s_barrier()
#define PG8_SCHED __builtin_amdgcn_sched_barrier(0)
    Unit cur, nxt; int ui = 0;
    if (!S.next(0, cur)) return;
    f32x4 acc[2][2][4][2];
#pragma unroll
    for (int a = 0; a < 2; ++a)
#pragma unroll
        for (int b = 0; b < 2; ++b)
#pragma unroll
            for (int m = 0; m < 4; ++m)
#pragma unroll
                for (int n = 0; n < 2; ++n) acc[a][b][m][n] = (f32x4){0.f, 0.f, 0.f, 0.f};
    bf16x8 At[4][2], B0[2][2], B1[2][2];
    const char* cA = (const char*)g.A + (size_t)cur.pm * tstep; const char* cB = (const char*)g.Bt + (size_t)cur.pn * tstep;
    S.a_ready(cur);
    if constexpr (SP2) {
        PG8_STAGE(PG8_SB(0, 0), cB, voffB); PG8_STAGE(PG8_SB(0, 1), cB + hstep, voffB); PG8_STAGE(PG8_SA(0, 0), cA, voffA); PG8_STAGE(PG8_SA(0, 1), cA + hstep, voffA);
        if (wr == 1) PG8_BAR;
        PG8_WAIT_V(2); PG8_BAR;
        PG8_STAGE(PG8_SB(1, 0), cB + kstep, voffB); PG8_STAGE(PG8_SA(1, 0), cA + kstep, voffA); PG8_STAGE(PG8_SB(1, 1), cB + hstep + kstep, voffB);
        PG8_WAIT_V(6); PG8_BAR;
    } else {
        PG8_STAGE(PG8_SB(0, 0), cB, voffB); PG8_STAGE(PG8_SA(0, 0), cA, voffA); PG8_STAGE(PG8_SB(0, 1), cB + hstep, voffB); PG8_STAGE(PG8_SA(0, 1), cA + hstep, voffA);
        if (wr == 1) PG8_BAR;
        PG8_WAIT_V(4); PG8_BAR;
        PG8_STAGE(PG8_SB(1, 0), cB + kstep, voffB); PG8_STAGE(PG8_SA(1, 0), cA + kstep, voffA); PG8_STAGE(PG8_SB(1, 1), cB + hstep + kstep, voffB);
        PG8_WAIT_V(6); PG8_BAR;
    }
    for (;;) {
        const bool has_next = S.next(ui + 1, nxt);
        const char* nA = has_next ? (const char*)g.A + (size_t)nxt.pm * tstep : cA; const char* nB = has_next ? (const char*)g.Bt + (size_t)nxt.pn * tstep : cB;
        for (int t = 0; t < nt; t += 2) {
            const bool last = (t == nt - 2);
            const char* a1 = cA + (size_t)(t + 1) * kstep;
            const char* a2 = last ? nA : cA + (size_t)(t + 2) * kstep; const char* b2 = last ? nB : cB + (size_t)(t + 2) * kstep;
            const char* a3 = a2 + kstep; const char* b3 = b2 + kstep;
            if (last && has_next) S.a_ready(nxt);
            if constexpr (SP2) {
            PG8_LDB(B0, 0, 0); PG8_LDB(B1, 0, 1); PG8_SCHED; PG8_LDA(At, 0, 0); PG8_STAGE(PG8_SA(1, 1), a1 + hstep, voffA);
            PG8_WAIT_V(8); PG8_WAIT_L(0); PG8_BAR; PG8_MMA(0, 0, At, B0); PG8_MMA(0, 1, At, B1); PG8_BAR; PG8_SCHED;
            PG8_LDA(At, 0, 1); PG8_STAGE(PG8_SB(0, 0), b2, voffB); PG8_STAGE(PG8_SB(0, 1), b2 + hstep, voffB); PG8_STAGE(PG8_SA(0, 0), a2, voffA);
            PG8_WAIT_V(8); PG8_WAIT_L(0); PG8_BAR; PG8_MMA(1, 0, At, B0); PG8_MMA(1, 1, At, B1); PG8_BAR; PG8_SCHED;
            PG8_LDB(B0, 1, 0); PG8_LDB(B1, 1, 1); PG8_SCHED; PG8_LDA(At, 1, 0); PG8_STAGE(PG8_SA(0, 1), a2 + hstep, voffA);
            PG8_WAIT_V(8); PG8_WAIT_L(0); PG8_BAR; PG8_MMA(0, 0, At, B0); PG8_MMA(0, 1, At, B1); PG8_BAR; PG8_SCHED;
            PG8_LDA(At, 1, 1); PG8_STAGE(PG8_SB(1, 0), b3, voffB); PG8_STAGE(PG8_SB(1, 1), b3 + hstep, voffB); PG8_STAGE(PG8_SA(1, 0), a3, voffA);
            PG8_WAIT_V(8); PG8_WAIT_L(0); PG8_BAR; PG8_MMA(1, 0, At, B0); PG8_MMA(1, 1, At, B1); PG8_BAR; PG8_SCHED;
            } else {
            PG8_LDB(B0, 0, 0); PG8_SCHED; PG8_LDA(At, 0, 0); PG8_STAGE(PG8_SA(1, 1), a1 + hstep, voffA);
            PG8_WAIT_L(8); PG8_BAR; PG8_WAIT_L(0); PG8_MMA(0, 0, At, B0); PG8_BAR; PG8_SCHED;
            PG8_LDB(B1, 0, 1); PG8_STAGE(PG8_SB(0, 0), b2, voffB);
            PG8_BAR; PG8_WAIT_L(0); PG8_MMA(0, 1, At, B1); PG8_BAR;
            PG8_LDA(At, 0, 1); PG8_STAGE(PG8_SA(0, 0), a2, voffA);
            PG8_BAR; PG8_WAIT_L(0); PG8_MMA(1, 0, At, B0); PG8_BAR; PG8_SCHED;
            PG8_STAGE(PG8_SB(0, 1), b2 + hstep, voffB);
            PG8_WAIT_V(6); PG8_BAR; PG8_MMA(1, 1, At, B1); PG8_BAR;
            PG8_LDB(B0, 1, 0); PG8_SCHED; PG8_LDA(At, 1, 0); PG8_STAGE(PG8_SA(0, 1), a2 + hstep, voffA);
            PG8_WAIT_L(8); PG8_BAR; PG8_WAIT_L(0); PG8_MMA(0, 0, At, B0); PG8_BAR; PG8_SCHED;
            PG8_LDB(B1, 1, 1); PG8_STAGE(PG8_SB(1, 0), b3, voffB);
            PG8_BAR; PG8_WAIT_L(0); PG8_MMA(0, 1, At, B1); PG8_BAR;
            PG8_LDA(At, 1, 1); PG8_STAGE(PG8_SA(1, 0), a3, voffA);
            PG8_BAR; PG8_WAIT_L(0); PG8_MMA(1, 0, At, B0); PG8_BAR; PG8_SCHED;
            PG8_STAGE(PG8_SB(1, 1), b3 + hstep, voffB);
            PG8_WAIT_V(6); PG8_BAR; PG8_MMA(1, 1, At, B1); PG8_BAR;
            }
        }
        if constexpr (ALIGN_EPI) { if (wr == 0) PG8_BAR; }
        if constexpr (!Epi::AFTER_DRAIN) { E(acc, cur, wr, wc, fr, fq); S.done(cur); }
        if (!has_next) break;
#pragma unroll
        for (int a = 0; a < 2; ++a)
#pragma unroll
            for (int b = 0; b < 2; ++b)
#pragma unroll
                for (int m = 0; m < 4; ++m)
#pragma unroll
                    for (int n = 0; n < 2; ++n) acc[a][b][m][n] = (f32x4){0.f, 0.f, 0.f, 0.f};
        cur = nxt; cA = nA; cB = nB; ++ui;
        if constexpr (ALIGN_EPI) { if (wr == 1) PG8_BAR; }
    }
    PG8_WAIT_V(0);
    if constexpr (!ALIGN_EPI) { if (wr == 0) PG8_BAR; }
    PG8_BAR;
    if constexpr (Epi::AFTER_DRAIN) { E.fused(acc, cur, wr, wc, fr, fq, lds, wid, lane); S.done(cur); }
#undef PG8_SA
#undef PG8_SB
#undef PG8_STAGE
#undef PG8_LDA
#undef PG8_LDB
#undef PG8_MMA
#undef PG8_WAIT_V
#undef PG8_WAIT_L
#undef PG8_BAR
#undef PG8_SCHED
}
}
#define GAS __attribute__((address_space(1)))
#define LAS __attribute__((address_space(3)))
typedef unsigned short bf16;
typedef unsigned v4u __attribute__((ext_vector_type(4)));
typedef float f32x4 __attribute__((ext_vector_type(4)));
typedef short bf16x8 __attribute__((ext_vector_type(8)));
typedef GAS unsigned gu32;
typedef GAS unsigned long long gu64;
#define RLX_AGENT __ATOMIC_RELAXED, __HIP_MEMORY_SCOPE_AGENT
#define LDS_WAIT() asm volatile("s_waitcnt lgkmcnt(0)" ::: "memory")
#define VM_WAIT() asm volatile("s_waitcnt vmcnt(0)" ::: "memory")
__device__ __forceinline__ unsigned long long rt() { return __builtin_amdgcn_s_memrealtime(); }
__device__ __forceinline__ unsigned f2bf(float f) { unsigned u = __builtin_bit_cast(unsigned, f); return (u + 0x7fffu + ((u >> 16) & 1u)) >> 16; }
__device__ __forceinline__ unsigned pk2(float lo, float hi) { return f2bf(lo) | (f2bf(hi) << 16); }

#define XB_TMO      128
#define XB_XCNT(j)  (256  + 64 * (j))
#define XB_XSUB(j)  (1280 + 64 * (j))
#define XB_XGEN(j)  (2304 + 64 * (j))
#define XB_TOP      3328
#define XB_TOPGEN   3392
#define XCD_BAR_WORDS 3456
#define XB_SPIN_CAP (1u << 18)

__device__ __forceinline__ unsigned xb_ld(unsigned* p)              { return __hip_atomic_load(p, __ATOMIC_RELAXED, __HIP_MEMORY_SCOPE_AGENT); }
__device__ __forceinline__ unsigned xb_add(unsigned* p, unsigned v) { return __hip_atomic_fetch_add(p, v, __ATOMIC_RELAXED, __HIP_MEMORY_SCOPE_AGENT); }
__device__ __forceinline__ unsigned xb_xcc_id() { return (unsigned)__builtin_amdgcn_s_getreg((3 << 11) | 20) & 0xFu; }
#define XB_SPIN(cond, bar) do { unsigned _sp = 0; while (cond) { __builtin_amdgcn_s_sleep(1); \
    if ((++_sp & 255u) == 0u) { if (xb_ld(&(bar)[XB_TMO])) break; if (_sp > XB_SPIN_CAP) { atomicAdd(&(bar)[XB_TMO], 1u); break; } } } } while (0)

struct XcdBarrier {
    unsigned* bar; unsigned x;
    volatile LAS unsigned* st;
};

__device__ __forceinline__ XcdBarrier xcd_barrier_post(unsigned* bar, volatile LAS unsigned* st) {
    XcdBarrier b; b.bar = bar; b.x = xb_xcc_id(); b.st = st;
    if (threadIdx.x == 0) (void)xb_add(&bar[XB_XCNT(b.x)], 1u);
    return b;
}
__device__ __forceinline__ void xcd_barrier_complete(unsigned* bar, unsigned x, unsigned& nloc, unsigned& nx) {
    const unsigned G = gridDim.x * gridDim.y * gridDim.z;
    unsigned sum, cnt, mine, sp = 0u;
    for (;;) {
        sum = 0u; cnt = 0u; mine = 0u;
#pragma unroll
        for (unsigned j = 0; j < 16; ++j) { const unsigned c = xb_ld(&bar[XB_XCNT(j)]); sum += c; cnt += (c > 0u) ? 1u : 0u; mine = (j == x) ? c : mine; }
        if (sum == G) break;
        __builtin_amdgcn_s_sleep(1);
        if ((++sp & 255u) == 0u) { if (xb_ld(&bar[XB_TMO])) break; if (sp > XB_SPIN_CAP) { atomicAdd(&bar[XB_TMO], 1u); break; } }
    }
    nloc = mine > 0u ? mine : 1u; nx = cnt > 0u ? cnt : 1u;
}

__device__ __forceinline__ void xcd_barrier(const XcdBarrier& b) {
    asm volatile("s_waitcnt vmcnt(0)" ::: "memory");
    __syncthreads();
    if (threadIdx.x == 0) {
        unsigned* bar = b.bar;
        __builtin_amdgcn_s_waitcnt(0);
        unsigned nloc = b.st[0], nx = b.st[1];
        if (nloc == 0u) { xcd_barrier_complete(bar, b.x, nloc, nx); b.st[0] = nloc; b.st[1] = nx; }
        const unsigned old = xb_add(&bar[XB_XSUB(b.x)], 1u);
        const unsigned gen = old / nloc;
        if (old + 1u == (gen + 1u) * nloc) {
            __builtin_amdgcn_fence(__ATOMIC_RELEASE, "agent");
            asm volatile("s_waitcnt vmcnt(0)" ::: "memory");
            const unsigned og = xb_add(&bar[XB_TOP], 1u);
            const unsigned tg = og / nx;
            if (og + 1u == (tg + 1u) * nx) xb_add(&bar[XB_TOPGEN], 1u);
            else XB_SPIN(xb_ld(&bar[XB_TOPGEN]) == tg, bar);
            __builtin_amdgcn_fence(__ATOMIC_ACQUIRE, "agent");
            xb_add(&bar[XB_XGEN(b.x)], 1u);
            asm volatile("s_waitcnt vmcnt(0)" ::: "memory");
        } else {
            XB_SPIN(xb_ld(&bar[XB_XGEN(b.x)]) == gen, bar);
            __builtin_amdgcn_fence(__ATOMIC_ACQUIRE, "agent");
            asm volatile("s_waitcnt vmcnt(0)" ::: "memory");
        }
    }
    __syncthreads();
}

constexpr int DM = 2048, NBAT = 4, SEQ = 2048, DEPTH = 4, NS = 128;
constexpr int MP = NBAT * SEQ;
constexpr int MV = MP + NS;
constexpr int MPAD = 8448;
constexpr int WA = 512, WB = 768, WC = 768, PIN = 6656, DFF = 5632, DPLE = 256, PBW = 2560;
constexpr int OFF_B = 1024, OFF_C = 3584;
constexpr float LN_EPS = 1e-5f, GN_EPS = 64e-5f, RMS_EPS = 1e-6f;
constexpr float DN_ALPHA = 1.681792830507429f;
enum { I_XP = 0, I_XS, I_SRWKV, I_SSHIFT, I_SHGRN, I_PP, I_PS, I_LNING, I_LNINB, I_WIN, I_ALNG, I_ALNB, I_AWS, I_ABS, I_BMU, I_BW0, I_BWUP, I_BA0, I_BAUP, I_BGUP,
       I_BKK, I_BKA, I_BRK, I_BGNG, I_BGNB, I_CLB, I_CNG, I_WOUT, I_LN1G, I_LN1B, I_WG, I_WU, I_WD, I_WPG, I_WPP, I_LN2G, I_LN2B, N_IN };
constexpr size_t O_YP = 0, O_YS = O_YP + (size_t)MP * DM, O_RP = O_YS + (size_t)NS * DM, O_SP = O_RP + (size_t)DEPTH * NBAT * 12 * 4096,
                 O_HP = O_SP + (size_t)DEPTH * NBAT * PBW, O_RS = O_HP + (size_t)DEPTH * NBAT * 6 * 16384, O_SS = O_RS + (size_t)DEPTH * NS * 12 * 4096,
                 O_HS = O_SS + (size_t)DEPTH * NS * PBW, O_VS = O_HS + (size_t)DEPTH * NS * 6 * 16384, O_END = O_VS + (size_t)DEPTH * NS * WA;
static_assert(O_END == 96509952, "output size");
constexpr size_t al256(size_t x) { return (x + 255) & ~(size_t)255; }
constexpr size_t WS_CTL = 0, CTL_ZERO_BYTES = 1u << 20;
constexpr size_t SZ_WIN = (size_t)PIN * DM * 2, SZ_WOUT = (size_t)DM * DM * 2, SZ_WGU = (size_t)2 * DFF * DM * 2, SZ_WD = (size_t)DM * DFF * 2, SZ_WPG = SZ_WOUT, SZ_WPP = (size_t)DM * DPLE * 2;
constexpr size_t WS_WIN = CTL_ZERO_BYTES, WS_WOUT = WS_WIN + DEPTH * SZ_WIN, WS_WGU = WS_WOUT + DEPTH * SZ_WOUT, WS_WD = WS_WGU + DEPTH * SZ_WGU, WS_WPG = WS_WD + DEPTH * SZ_WD,
                 WS_WPP = WS_WPG + DEPTH * SZ_WPG, WS_PBF = WS_WPP + DEPTH * SZ_WPP;
constexpr size_t SZ_PBF = (size_t)MPAD * DPLE * 2;
constexpr size_t WS_H = WS_PBF + DEPTH * SZ_PBF, WS_HB = WS_H + (size_t)MPAD * DM * 4, WS_T = WS_HB + (size_t)MPAD * DM * 2, WS_YMIX = WS_T + (size_t)MPAD * DM * 4;
constexpr size_t WS_Z = WS_YMIX + (size_t)MPAD * DM * 2;
constexpr size_t WS_ACT = WS_Z, WS_PLE = WS_ACT + al256((size_t)MPAD * DFF * 2);
constexpr size_t WS_PPO = WS_Z + (size_t)MPAD * PIN * 4;
static_assert(WS_PLE + (size_t)MPAD * DM * 4 <= WS_PPO, "overlay fits");
constexpr size_t WS_RPB = WS_PPO + (size_t)MPAD * DM * 4;
constexpr size_t WS_RPS = WS_RPB + (size_t)NBAT * 12 * SEQ * 384 * 4;
constexpr size_t WS_G = WS_RPS + (size_t)NS * 12 * 384 * 4;
constexpr size_t WS_Y = WS_G + (size_t)MPAD * WB * 4;
constexpr size_t WS_O = WS_Y + (size_t)MPAD * WB * 4;
constexpr size_t WS_END = WS_O + (size_t)MPAD * WC * 4;
static_assert(WS_WIN % 256 == 0 && WS_H % 256 == 0 && WS_Z % 256 == 0 && WS_RPB % 256 == 0 && WS_G % 256 == 0, "alignment");
constexpr int CW_BAR = 4096;

constexpr int RING_BYTES = 131072, LDSCTL_OFF = RING_BYTES, MISC_OFF = LDSCTL_OFF + 320, LDS_BYTES = 147456;
constexpr int NWAVES = 8, NTHR = 512;

struct Args { const float* in[N_IN]; float* out; unsigned char* ws; int ph_lo, ph_hi; };
static_assert(sizeof(Args) == (N_IN + 2) * 8 + 8, "no padding in Args");

typedef float f4 __attribute__((ext_vector_type(4)));
typedef float f2 __attribute__((ext_vector_type(2)));
typedef unsigned u2 __attribute__((ext_vector_type(2)));

__device__ __forceinline__ float wave_sum(float v) {
#pragma unroll
    for (int o = 1; o < 64; o <<= 1) v += __shfl_xor(v, o);
    return v;
}
template <int CTRL> __device__ __forceinline__ float dpp_f(float x) { return __builtin_bit_cast(float, __builtin_amdgcn_update_dpp(0, __builtin_bit_cast(int, x), CTRL, 0xF, 0xF, true)); }
__device__ __forceinline__ float row16_sum(float x) {
    x += dpp_f<0xB1>(x);
    x += dpp_f<0x4E>(x);
    x += dpp_f<0x141>(x);
    x += dpp_f<0x140>(x);
    return x;
}
__device__ __forceinline__ float sigmoidf_(float x) { return 1.0f / (1.0f + expf(-x)); }
__device__ __forceinline__ float gelu_erf(float x) { return 0.5f * x * (1.0f + erff(x * 0.70710678118654752f)); }
__device__ __forceinline__ unsigned short bf1(float x) { return (unsigned short)(pg8::cvt_pk_bf16(x, 0.f) & 0xffffu); }
__device__ __forceinline__ float lbound(const float* clb, int L, int c) {
    const float x0 = clb[c], x1 = clb[WC + c], x2 = clb[2 * WC + c], x3 = clb[3 * WC + c];
    const float mx = fmaxf(fmaxf(x0, x1), fmaxf(x2, x3));
    const float e0 = expf(x0 - mx), e1 = expf(x1 - mx), e2 = expf(x2 - mx), e3 = expf(x3 - mx);
    float s = 0.f; if (L >= 1) s += e1; if (L >= 2) s += e2; if (L >= 3) s += e3;
    return s / (e0 + e1 + e2 + e3);
}
__device__ __forceinline__ float log_sigmoid(float x) { return fminf(x, 0.f) - log1pf(expf(-fabsf(x))); }

__device__ __forceinline__ void tr_item(const float* W, int K, int N, bf16* WT, int mode, LAS float* scr, int item, int lane) {
    const int nblk = N >> 5, kb = item / nblk, nb = item - kb * nblk, k0 = kb << 6, n0 = nb << 5;
    int rb = n0; if (mode) rb = ((n0 >> 7) << 8) + (n0 & 127) + (mode == 2 ? 128 : 0);
#pragma unroll 8
    for (int i = 0; i < 32; ++i) { const int kk = 2 * i + (lane >> 5); scr[kk * 33 + (lane & 31)] = W[(size_t)(k0 + kk) * N + n0 + (lane & 31)]; }
    LDS_WAIT(); asm volatile("" ::: "memory");
    const int c = lane & 7;
#pragma unroll
    for (int j = 0; j < 4; ++j) { const int n = (lane >> 3) + 8 * j; const LAS float* s = scr + (8 * c) * 33 + n;
        v4u o; o.x = pg8::cvt_pk_bf16(s[0 * 33], s[1 * 33]); o.y = pg8::cvt_pk_bf16(s[2 * 33], s[3 * 33]); o.z = pg8::cvt_pk_bf16(s[4 * 33], s[5 * 33]); o.w = pg8::cvt_pk_bf16(s[6 * 33], s[7 * 33]);
        *(v4u*)(WT + (size_t)(rb + n) * K + k0 + 8 * c) = o; }
    LDS_WAIT(); asm volatile("" ::: "memory");
}
__device__ __forceinline__ void ln_row(const float* src, const float* g, const float* b, float* dstf, bf16* dstb, float* dst2, int lane) {
    f4 v[8]; float s = 0.f;
#pragma unroll
    for (int j = 0; j < 8; ++j) { v[j] = *(const f4*)(src + 4 * (lane + 64 * j)); s += (v[j].x + v[j].y) + (v[j].z + v[j].w); }
    const float mean = wave_sum(s) * (1.f / DM); float s2 = 0.f;
#pragma unroll
    for (int j = 0; j < 8; ++j) { v[j] = v[j] - mean; s2 += (v[j].x * v[j].x + v[j].y * v[j].y) + (v[j].z * v[j].z + v[j].w * v[j].w); }
    const float rstd = 1.0f / sqrtf(wave_sum(s2) * (1.f / DM) + LN_EPS);
#pragma unroll
    for (int j = 0; j < 8; ++j) { const int c = 4 * (lane + 64 * j); const f4 gg = *(const f4*)(g + c), bb = *(const f4*)(b + c); const f4 o = v[j] * rstd * gg + bb;
        *(f4*)(dstf + c) = o; if (dst2) *(f4*)(dst2 + c) = o;
        u2 w; w.x = pg8::cvt_pk_bf16(o.x, o.y); w.y = pg8::cvt_pk_bf16(o.z, o.w); *(u2*)(dstb + c) = w; }
}
__device__ __forceinline__ void phase_prologue(const Args& a, LAS unsigned char* lds, int lane, int wave, int blk, int G) {
    LAS float* scr = (LAS float*)(lds + wave * 16384);
    const int gw = blk * NWAVES + wave, NGW = G * NWAVES;
    constexpr int I_IN = 32 * (PIN / 32), I_OUT = 32 * (DM / 32), I_G = 32 * (DFF / 32), I_D = (DFF / 64) * (DM / 32), I_PGc = I_OUT, I_PPc = (DPLE / 64) * (DM / 32);
    constexpr int PER_L = I_IN + I_OUT + 2 * I_G + I_D + I_PGc + I_PPc;
    unsigned char* ws = a.ws;
    for (int it = gw; it < DEPTH * PER_L; it += NGW) {
        const int L = it / PER_L; int r = it - L * PER_L;
        if (r < I_IN) { tr_item(a.in[I_WIN] + (size_t)L * DM * PIN, DM, PIN, (bf16*)(ws + WS_WIN + L * SZ_WIN), 0, scr, r, lane); continue; } r -= I_IN;
        if (r < I_OUT) { tr_item(a.in[I_WOUT] + (size_t)L * DM * DM, DM, DM, (bf16*)(ws + WS_WOUT + L * SZ_WOUT), 0, scr, r, lane); continue; } r -= I_OUT;
        if (r < I_G) { tr_item(a.in[I_WG] + (size_t)L * DM * DFF, DM, DFF, (bf16*)(ws + WS_WGU + L * SZ_WGU), 1, scr, r, lane); continue; } r -= I_G;
        if (r < I_G) { tr_item(a.in[I_WU] + (size_t)L * DM * DFF, DM, DFF, (bf16*)(ws + WS_WGU + L * SZ_WGU), 2, scr, r, lane); continue; } r -= I_G;
        if (r < I_D) { tr_item(a.in[I_WD] + (size_t)L * DFF * DM, DFF, DM, (bf16*)(ws + WS_WD + L * SZ_WD), 0, scr, r, lane); continue; } r -= I_D;
        if (r < I_PGc) { tr_item(a.in[I_WPG] + (size_t)L * DM * DM, DM, DM, (bf16*)(ws + WS_WPG + L * SZ_WPG), 0, scr, r, lane); continue; } r -= I_PGc;
        tr_item(a.in[I_WPP] + (size_t)L * DPLE * DM, DPLE, DM, (bf16*)(ws + WS_WPP + L * SZ_WPP), 0, scr, r, lane);
    }
    for (int it = gw; it < DEPTH * MV; it += NGW) { const int L = it / MV, m = it - L * MV;
        const float* src = (m < MP) ? a.in[I_PP] + ((size_t)L * MP + m) * DPLE : a.in[I_PS] + ((size_t)L * NS + (m - MP)) * DPLE;
        const f4 v = *(const f4*)(src + 4 * lane); u2 w; w.x = pg8::cvt_pk_bf16(v.x, v.y); w.y = pg8::cvt_pk_bf16(v.z, v.w);
        *(u2*)((bf16*)(ws + WS_PBF + L * SZ_PBF) + (size_t)m * DPLE + 4 * lane) = w; }
    for (int m = gw; m < MV; m += NGW) { const float* src = (m < MP) ? a.in[I_XP] + (size_t)m * DM : a.in[I_XS] + (size_t)(m - MP) * DM;
        ln_row(src, a.in[I_LNING], a.in[I_LNINB], (float*)(ws + WS_H) + (size_t)m * DM, (bf16*)(ws + WS_HB) + (size_t)m * DM, nullptr, lane); }
}
__device__ __forceinline__ void phase_ln(const Args& a, const float* g, const float* b, bool last, int lane, int wave, int blk, int G) {
    const int gw = blk * NWAVES + wave, NGW = G * NWAVES; unsigned char* ws = a.ws;
    for (int m = gw; m < MV; m += NGW)
        ln_row((const float*)(ws + WS_T) + (size_t)m * DM, g, b, (float*)(ws + WS_H) + (size_t)m * DM, (bf16*)(ws + WS_HB) + (size_t)m * DM,
               last ? a.out + (m < MP ? O_YP + (size_t)m * DM : O_YS + (size_t)(m - MP) * DM) : nullptr, lane);
}

__device__ __forceinline__ void phase_prep(const Args& a, int L, LAS unsigned char* lds, int tid, int lane, int wave, int blk, int G) {
    unsigned char* ws = a.ws;
    const float* Z = (const float*)(ws + WS_Z);
    LAS float* xsT = (LAS float*)lds;
    const float* mu = a.in[I_BMU] + L * PBW; const float* w0 = a.in[I_BW0] + L * WB; const float* a0 = a.in[I_BA0] + L * WB;
    const float* w_up = a.in[I_BWUP] + (size_t)L * 64 * WB; const float* a_up = a.in[I_BAUP] + (size_t)L * 64 * WB; const float* g_up = a.in[I_BGUP] + (size_t)L * 128 * WB;
    const float* k_k = a.in[I_BKK] + L * WB; const float* k_a = a.in[I_BKA] + L * WB;
    const float* sh0 = a.in[I_SSHIFT] + (size_t)L * NS * PBW;
    for (int tile = blk; tile < MV / 16; tile += G) {
        const bool samp = tile >= MP / 16; const int m0 = tile * 16;
        __syncthreads();
        for (int e = tid; e < 4096; e += NTHR) { const int tok = e >> 8, j = e & 255, m = m0 + tok, col = OFF_B + 2304 + j;
            const float cur = Z[(size_t)m * PIN + col]; float prev;
            if (samp) prev = sh0[(size_t)(m - MP) * PBW + 2304 + j]; else prev = (m & (SEQ - 1)) ? Z[(size_t)(m - 1) * PIN + col] : 0.f;
            float x = cur + mu[2304 + j] * (prev - cur);
            if (j < 64) x = tanhf(x); else if (j >= 128) x = sigmoidf_(x);
            xsT[j * 16 + tok] = x; }
        __syncthreads();
        const int cw = tid & 255, th = tid >> 8;
        float accw[3][8], acca[3][8], accg[3][8];
#pragma unroll
        for (int jc = 0; jc < 3; ++jc)
#pragma unroll
            for (int tk = 0; tk < 8; ++tk) { accw[jc][tk] = 0.f; acca[jc][tk] = 0.f; accg[jc][tk] = 0.f; }
        for (int j2 = 0; j2 < 64; ++j2) {
            const f4 xw0 = *(const LAS f4*)(xsT + j2 * 16 + th * 8), xw1 = *(const LAS f4*)(xsT + j2 * 16 + th * 8 + 4);
            const f4 xa0 = *(const LAS f4*)(xsT + (64 + j2) * 16 + th * 8), xa1 = *(const LAS f4*)(xsT + (64 + j2) * 16 + th * 8 + 4);
#pragma unroll
            for (int jc = 0; jc < 3; ++jc) { const float wu = w_up[j2 * WB + cw + 256 * jc], au = a_up[j2 * WB + cw + 256 * jc];
#pragma unroll
                for (int tk = 0; tk < 4; ++tk) { accw[jc][tk] += xw0[tk] * wu; accw[jc][4 + tk] += xw1[tk] * wu; acca[jc][tk] += xa0[tk] * au; acca[jc][4 + tk] += xa1[tk] * au; } }
        }
        for (int j2 = 0; j2 < 128; ++j2) {
            const f4 xg0 = *(const LAS f4*)(xsT + (128 + j2) * 16 + th * 8), xg1 = *(const LAS f4*)(xsT + (128 + j2) * 16 + th * 8 + 4);
#pragma unroll
            for (int jc = 0; jc < 3; ++jc) { const float gu = g_up[j2 * WB + cw + 256 * jc];
#pragma unroll
                for (int tk = 0; tk < 4; ++tk) { accg[jc][tk] += xg0[tk] * gu; accg[jc][4 + tk] += xg1[tk] * gu; } }
        }
#pragma unroll
        for (int jc = 0; jc < 3; ++jc) { const int c = cw + 256 * jc, h = c >> 6, i = c & 63;
            const float w0c = w0[c], a0c = a0[c], kkc = k_k[c], kac = k_a[c], mur = mu[c], muk = mu[WB + c], muv = mu[2 * WB + c];
#pragma unroll
            for (int tk = 0; tk < 8; ++tk) { const int m = m0 + th * 8 + tk; const float* zr = Z + (size_t)m * PIN + OFF_B + c;
                const float cr = zr[0], ck = zr[WB], cv = zr[2 * WB]; float pr, pk, pv;
                if (samp) { const float* s = sh0 + (size_t)(m - MP) * PBW + c; pr = s[0]; pk = s[WB]; pv = s[2 * WB]; }
                else if (m & (SEQ - 1)) { pr = zr[-PIN]; pk = zr[WB - PIN]; pv = zr[2 * WB - PIN]; } else { pr = 0.f; pk = 0.f; pv = 0.f; }
                const float r = cr + mur * (pr - cr), k = ck + muk * (pk - ck), v = cv + muv * (pv - cv);
                const float wv = w0c + accw[jc][tk]; const float dec = expf(-0.6065306597126334f * sigmoidf_(wv));
                const float av = sigmoidf_(a0c + acca[jc][tk]);
                const float kkr = k * kkc; const float ss = wave_sum(kkr * kkr); const float kk = kkr / fmaxf(sqrtf(ss), 1e-12f);
                const float kp = k * (1.0f + (av - 1.0f) * kac);
                float* rec = samp ? (float*)(ws + WS_RPS) + ((size_t)(m - MP) * 12 + h) * 384 : (float*)(ws + WS_RPB) + (((size_t)(m >> 11) * 12 + h) * SEQ + (m & (SEQ - 1))) * 384;
                rec[i] = r; rec[64 + i] = dec; rec[128 + i] = kp; rec[192 + i] = v; rec[256 + i] = kk; rec[320 + i] = kk * av;
                ((float*)(ws + WS_G))[(size_t)m * WB + c] = accg[jc][tk]; }
        }
        if (samp) { for (int e = tid; e < 16 * PBW; e += NTHR) { const int tok = e / PBW, j = e - tok * PBW, i = m0 + tok - MP;
                        a.out[O_SS + ((size_t)L * NS + i) * PBW + j] = Z[(size_t)(m0 + tok) * PIN + OFF_B + j]; } }
        else if ((m0 & (SEQ - 1)) == SEQ - 16) { const int b = m0 >> 11; for (int j = tid; j < PBW; j += NTHR) a.out[O_SP + ((size_t)L * NBAT + b) * PBW + j] = Z[(size_t)(m0 + 15) * PIN + OFF_B + j]; }
        if (samp) {
            const float* lng = a.in[I_ALNG] + L * WA; const float* lnb = a.in[I_ALNB] + L * WA;
            for (int rr = 0; rr < 2; ++rr) { const int m = m0 + wave * 2 + rr, i = m - MP; const float* zr = Z + (size_t)m * PIN;
                for (int g = 0; g < 4; ++g) {
                    const float u0 = gelu_erf(zr[g * 128 + lane]), u1 = gelu_erf(zr[g * 128 + 64 + lane]);
                    const float v0 = gelu_erf(zr[WA + g * 128 + lane]), v1 = gelu_erf(zr[WA + g * 128 + 64 + lane]);
                    const float mean = wave_sum(v0 + v1) * (1.f / 128.f); const float d0 = v0 - mean, d1 = v1 - mean;
                    const float rstd = 1.0f / sqrtf(wave_sum(d0 * d0 + d1 * d1) * (1.f / 128.f) + LN_EPS);
                    const float n0 = d0 * rstd * lng[g * 128 + lane] + lnb[g * 128 + lane], n1 = d1 * rstd * lng[g * 128 + 64 + lane] + lnb[g * 128 + 64 + lane];
                    float* ov = a.out + O_VS + ((size_t)L * NS + i) * WA + g * 128; ov[lane] = n0; ov[64 + lane] = n1;
                    const float w00 = a.in[I_AWS][(size_t)(L * 4 + g) * 16384], b0 = a.in[I_ABS][(L * 4 + g) * 128];
                    bf16* yo = (bf16*)(ws + WS_YMIX) + (size_t)m * DM + g * 128; yo[lane] = bf1(u0 * (w00 * n0 + b0)); yo[64 + lane] = bf1(u1 * (w00 * n1 + b0)); } }
        }
    }
}

__device__ __forceinline__ void rwkv_scan_unit(const Args& a, int L, int unit, LAS unsigned char* lds, int tid, int lane, int wave) {
    unsigned char* ws = a.ws;
    const int bh = unit >> 1, half = unit & 1, b = bh / 12, h = bh - b * 12;
    const f4* rec4 = (const f4*)((const float*)(ws + WS_RPB) + (size_t)bh * SEQ * 384);
    LAS float* buf = (LAS float*)lds;
    LAS float* ybuf = (LAS float*)(lds + 49152);
    const int rowl = wave * 4 + (lane >> 4), kg = lane & 15, row = half * 32 + rowl;
    float S0 = 0.f, S1 = 0.f, S2 = 0.f, S3 = 0.f;
    f4 st0, st1, st2;
    __syncthreads();
    st0 = rec4[tid]; st1 = rec4[512 + tid]; st2 = rec4[1024 + tid];
    *(LAS f4*)(buf + 4 * tid) = st0; *(LAS f4*)(buf + 4 * (512 + tid)) = st1; *(LAS f4*)(buf + 4 * (1024 + tid)) = st2;
    __syncthreads();
    float* Y = (float*)(ws + WS_Y);
    for (int c = 0; c < SEQ / 16; ++c) {
        if (c + 1 < SEQ / 16) { const f4* nx = rec4 + (size_t)(c + 1) * 1536; st0 = nx[tid]; st1 = nx[512 + tid]; st2 = nx[1024 + tid]; }
        const LAS float* cur = buf + (c & 1) * 6144; LAS float* yb = ybuf + (c & 1) * 512;
#pragma unroll 4
        for (int s = 0; s < 16; ++s) {
            const LAS float* R = cur + s * 384;
            const f4 r4 = *(const LAS f4*)(R + 4 * kg), w4 = *(const LAS f4*)(R + 64 + 4 * kg), k4 = *(const LAS f4*)(R + 128 + 4 * kg),
                     kk4 = *(const LAS f4*)(R + 256 + 4 * kg), ka4 = *(const LAS f4*)(R + 320 + 4 * kg);
            const float v = R[192 + row];
            float sa = (S0 * kk4.x + S1 * kk4.y) + (S2 * kk4.z + S3 * kk4.w);
            sa = row16_sum(sa);
            S0 = S0 * w4.x + (v * k4.x - sa * ka4.x); S1 = S1 * w4.y + (v * k4.y - sa * ka4.y);
            S2 = S2 * w4.z + (v * k4.z - sa * ka4.z); S3 = S3 * w4.w + (v * k4.w - sa * ka4.w);
            float y = (S0 * r4.x + S1 * r4.y) + (S2 * r4.z + S3 * r4.w);
            y = row16_sum(y);
            if (kg == 0) yb[s * 32 + rowl] = y;
        }
        if (c + 1 < SEQ / 16) { LAS float* nb = buf + ((c + 1) & 1) * 6144;
            *(LAS f4*)(nb + 4 * tid) = st0; *(LAS f4*)(nb + 4 * (512 + tid)) = st1; *(LAS f4*)(nb + 4 * (1024 + tid)) = st2; }
        __syncthreads();
        { const int s = tid >> 5, rl = tid & 31; Y[((size_t)b * SEQ + c * 16 + s) * WB + h * 64 + half * 32 + rl] = yb[tid]; }
    }
    f4 so; so.x = S0; so.y = S1; so.z = S2; so.w = S3;
    *(f4*)(a.out + O_RP + ((((size_t)L * NBAT + b) * 12 + h) * 64 + row) * 64 + 4 * kg) = so;
    __syncthreads();
}
__device__ __forceinline__ void rwkv_sample_item(const Args& a, int L, int item, LAS unsigned char* lds, int lane, int wave) {
    unsigned char* ws = a.ws;
    const int ih = item * 8 + wave, i = ih / 12, h = ih - i * 12;
    const float* rec = (const float*)(ws + WS_RPS) + (size_t)ih * 384;
    LAS float* sc = (LAS float*)(lds + wave * 2048);
    const float r = rec[lane], w = rec[64 + lane], k = rec[128 + lane], v = rec[192 + lane], kk = rec[256 + lane], ka = rec[320 + lane];
    sc[lane] = r; sc[64 + lane] = w; sc[128 + lane] = k; sc[192 + lane] = kk; sc[256 + lane] = ka;
    LDS_WAIT(); asm volatile("" ::: "memory");
    const f4* S0p = (const f4*)(a.in[I_SRWKV] + (((size_t)L * NS + i) * 12 + h) * 4096 + lane * 64);
    f4 S[16];
#pragma unroll
    for (int j = 0; j < 16; ++j) S[j] = S0p[j];
    float sa = 0.f;
#pragma unroll
    for (int j = 0; j < 16; ++j) { const f4 q = *(const LAS f4*)(sc + 192 + 4 * j); sa += (S[j].x * q.x + S[j].y * q.y) + (S[j].z * q.z + S[j].w * q.w); }
    float y = 0.f;
    f4* So = (f4*)(a.out + O_RS + (((size_t)L * NS + i) * 12 + h) * 4096 + lane * 64);
#pragma unroll
    for (int j = 0; j < 16; ++j) { const f4 w4 = *(const LAS f4*)(sc + 64 + 4 * j), k4 = *(const LAS f4*)(sc + 128 + 4 * j), a4 = *(const LAS f4*)(sc + 256 + 4 * j), r4 = *(const LAS f4*)(sc + 4 * j);
        f4 n = S[j] * w4 + (k4 * v - a4 * sa); So[j] = n; y += (n.x * r4.x + n.y * r4.y) + (n.z * r4.z + n.w * r4.w); }
    ((float*)(ws + WS_Y))[(size_t)(MP + i) * WB + h * 64 + lane] = y;
    LDS_WAIT(); asm volatile("" ::: "memory");
}
__device__ __forceinline__ void hgrn_sample_item(const Args& a, int L, int item, LAS unsigned char* lds, int lane, int wave) {
    unsigned char* ws = a.ws;
    const int ih = item * 4 + (wave >> 1), i = ih / 6, h = ih - i * 6, vcol = (wave & 1) * 64 + lane, m = MP + i;
    const float* zc = (const float*)(ws + WS_Z) + (size_t)m * PIN + OFF_C + h * 128;
    LAS float* sc = (LAS float*)(lds + wave * 2048);
#pragma unroll
    for (int t = 0; t < 2; ++t) { const int k = lane + 64 * t; const float lb = lbound(a.in[I_CLB], L, h * 128 + k); const float fz = zc[WC + k];
        const float sg = sigmoidf_(fz); sc[k] = lb + (1.0f - lb) * sg; sc[128 + k] = (1.0f - lb) * (1.0f - sg) ; sc[256 + k] = zc[k]; }
    const float iv = zc[2 * WC + vcol];
    LDS_WAIT(); asm volatile("" ::: "memory");
    const float* S0 = a.in[I_SHGRN] + (((size_t)L * NS + i) * 6 + h) * 16384 + vcol;
    float* So = a.out + O_HS + (((size_t)L * NS + i) * 6 + h) * 16384 + vcol;
    float o = 0.f;
#pragma unroll 8
    for (int k = 0; k < 128; ++k) { const float n = sc[k] * S0[(size_t)k * 128] + sc[128 + k] * iv; So[(size_t)k * 128] = n; o += n * sc[256 + k]; }
    ((float*)(ws + WS_O))[(size_t)m * WC + h * 128 + vcol] = o;
    LDS_WAIT(); asm volatile("" ::: "memory");
}
__device__ __forceinline__ void sgu_item(const Args& a, int L, int item, LAS unsigned char* lds, int tid, int lane, int wave) {
    unsigned char* ws = a.ws;
    const int g = item & 3, bc = item >> 2, m0 = bc * 128;
    const float* Z = (const float*)(ws + WS_Z);
    LAS float* vn = (LAS float*)lds;
    LAS float* wt = (LAS float*)(lds + 65536);
    const float* wsrc = a.in[I_AWS] + (size_t)(L * 4 + g) * 16384;
    __syncthreads();
    for (int e = tid; e < 16384; e += NTHR) { const int t = e >> 7, s = e & 127; wt[s * 128 + t] = (s <= t) ? wsrc[e] : 0.f; }
    const float* lng = a.in[I_ALNG] + L * WA + g * 128; const float* lnb = a.in[I_ALNB] + L * WA + g * 128;
    for (int rr = 0; rr < 16; ++rr) { const int t = wave * 16 + rr; const float* zr = Z + (size_t)(m0 + t) * PIN + WA + g * 128;
        const float v0 = gelu_erf(zr[lane]), v1 = gelu_erf(zr[64 + lane]);
        const float mean = wave_sum(v0 + v1) * (1.f / 128.f); const float d0 = v0 - mean, d1 = v1 - mean;
        const float rstd = 1.0f / sqrtf(wave_sum(d0 * d0 + d1 * d1) * (1.f / 128.f) + LN_EPS);
        vn[t * 128 + lane] = d0 * rstd * lng[lane] + lnb[lane]; vn[t * 128 + 64 + lane] = d1 * rstd * lng[64 + lane] + lnb[64 + lane]; }
    __syncthreads();
    const int t = tid >> 2, dq = tid & 3, send = (wave * 16 + 15);
    f4 acc[8];
#pragma unroll
    for (int j = 0; j < 8; ++j) acc[j] = (f4){0.f, 0.f, 0.f, 0.f};
    for (int s = 0; s <= send; ++s) { const float w = wt[s * 128 + t]; const LAS f4* vr = (const LAS f4*)(vn + s * 128 + dq * 32);
#pragma unroll
        for (int j = 0; j < 8; ++j) acc[j] += vr[j] * w; }
    const float bs = a.in[I_ABS][(L * 4 + g) * 128 + t];
    const float* ur = Z + (size_t)(m0 + t) * PIN + g * 128 + dq * 32;
    bf16* yo = (bf16*)(ws + WS_YMIX) + (size_t)(m0 + t) * DM + g * 128 + dq * 32;
#pragma unroll
    for (int j = 0; j < 4; ++j) { const f4 u0 = *(const f4*)(ur + 8 * j), u1 = *(const f4*)(ur + 8 * j + 4); const f4 x0 = acc[2 * j] + bs, x1 = acc[2 * j + 1] + bs; v4u o;
        o.x = pg8::cvt_pk_bf16(gelu_erf(u0.x) * x0.x, gelu_erf(u0.y) * x0.y); o.y = pg8::cvt_pk_bf16(gelu_erf(u0.z) * x0.z, gelu_erf(u0.w) * x0.w);
        o.z = pg8::cvt_pk_bf16(gelu_erf(u1.x) * x1.x, gelu_erf(u1.y) * x1.y); o.w = pg8::cvt_pk_bf16(gelu_erf(u1.z) * x1.z, gelu_erf(u1.w) * x1.w);
        *(v4u*)(yo + 8 * j) = o; }
}

__device__ __forceinline__ void hgrn_seq_unit(const Args& a, int L, int unit, LAS unsigned char* lds, int tid, int lane, int wave) {
    unsigned char* ws = a.ws;
    const int b = unit / 6, h = unit - b * 6;
    const float* Z = (const float*)(ws + WS_Z);
    LAS bf16* qs = (LAS bf16*)(lds);
    LAS bf16* ks = (LAS bf16*)(lds + 4352);
    LAS bf16* vt = (LAS bf16*)(lds + 8704);
    LAS bf16* kht = (LAS bf16*)(lds + 12800);
    LAS float* ev = (LAS float*)(lds + 16896);
    LAS float* part = (LAS float*)(lds + 17408);
    const int ch = tid & 127, tq = tid >> 7;
    const float lb = lbound(a.in[I_CLB], L, h * 128 + ch), loglb = logf(lb), oml = 1.0f - lb;
    const int pch = (ch & ~31) | (((ch >> 2) & 3) << 3) | (((ch >> 4) & 1) << 2) | (ch & 3);
    const int x = lane & 15, quad = lane >> 4;
    pg8::f32x4 Sacc[8];
#pragma unroll
    for (int mt = 0; mt < 8; ++mt) Sacc[mt] = (pg8::f32x4){0.f, 0.f, 0.f, 0.f};
    const float* zb = Z + (size_t)(b * SEQ + 4 * tq) * PIN + OFF_C + h * 128 + ch;
    float qn[4], fn[4], vn_[4];
#pragma unroll
    for (int j = 0; j < 4; ++j) { const float* p = zb + (size_t)j * PIN; qn[j] = p[0]; fn[j] = p[WC]; vn_[j] = p[2 * WC]; }
    float* O = (float*)(ws + WS_O);
    __syncthreads();
    for (int st = 0; st < SEQ / 16; ++st) {
        float q[4], fz[4], iv[4];
#pragma unroll
        for (int j = 0; j < 4; ++j) { q[j] = qn[j]; fz[j] = fn[j]; iv[j] = vn_[j]; }
        if (st + 1 < SEQ / 16) {
#pragma unroll
            for (int j = 0; j < 4; ++j) { const float* p = zb + (size_t)((st + 1) * 16 + j) * PIN; qn[j] = p[0]; fn[j] = p[WC]; vn_[j] = p[2 * WC]; } }
        float bl[4], kv[4]; float run = 0.f;
#pragma unroll
        for (int j = 0; j < 4; ++j) { const float A = log_sigmoid(fz[j]), Bv = loglb + log_sigmoid(-fz[j]); const float mx = fmaxf(A, Bv), d = -fabsf(A - Bv);
            run += mx + log1pf(expf(d)); bl[j] = run; kv[j] = oml * sigmoidf_(-fz[j]); }
        part[tq * 128 + ch] = run;
        __syncthreads();
        const float p0 = part[ch], p1 = part[128 + ch], p2 = part[256 + ch], p3 = part[384 + ch];
        const float tot = (p0 + p1) + (p2 + p3); const float pre = (tq > 0 ? p0 : 0.f) + (tq > 1 ? p1 : 0.f) + (tq > 2 ? p2 : 0.f);
#pragma unroll
        for (int j = 0; j < 4; ++j) { const float bj = pre + bl[j]; const int t = 4 * tq + j;
            qs[t * 136 + pch] = bf1(q[j] * expf(bj)); ks[t * 136 + pch] = bf1(kv[j] * expf(fminf(-bj, 60.f)));
            kht[ch * 16 + t] = bf1(kv[j] * expf(tot - bj)); vt[ch * 16 + t] = bf1(iv[j]); }
        if (tq == 0) ev[ch] = expf(tot);
        __syncthreads();
        bf16x8 qf[4], kf[4];
#pragma unroll
        for (int kt = 0; kt < 4; ++kt) { qf[kt] = *(const LAS bf16x8*)(qs + x * 136 + 32 * kt + 8 * quad); kf[kt] = *(const LAS bf16x8*)(ks + x * 136 + 32 * kt + 8 * quad); }
        pg8::f32x4 att = (pg8::f32x4){0.f, 0.f, 0.f, 0.f};
#pragma unroll
        for (int kt = 0; kt < 4; ++kt) att = __builtin_amdgcn_mfma_f32_16x16x32_bf16(kf[kt], qf[kt], att, 0, 0, 0);
#pragma unroll
        for (int i = 0; i < 4; ++i) if (4 * quad + i > x) att[i] = 0.f;
        v4u pbu; pbu.x = pg8::cvt_pk_bf16(att[0], att[1]); pbu.y = pg8::cvt_pk_bf16(att[2], att[3]); pbu.z = 0u; pbu.w = 0u;
        const bf16x8 pb = __builtin_bit_cast(bf16x8, pbu);
        const u2 vv = *(const LAS u2*)(vt + (16 * wave + x) * 16 + 4 * quad);
        v4u vfu; vfu.x = vv.x; vfu.y = vv.y; vfu.z = 0u; vfu.w = 0u; const bf16x8 vf = __builtin_bit_cast(bf16x8, vfu);
        pg8::f32x4 o = (pg8::f32x4){0.f, 0.f, 0.f, 0.f};
#pragma unroll
        for (int kt = 0; kt < 4; ++kt) { v4u su; su.x = pg8::cvt_pk_bf16(Sacc[2 * kt][0], Sacc[2 * kt][1]); su.y = pg8::cvt_pk_bf16(Sacc[2 * kt][2], Sacc[2 * kt][3]);
            su.z = pg8::cvt_pk_bf16(Sacc[2 * kt + 1][0], Sacc[2 * kt + 1][1]); su.w = pg8::cvt_pk_bf16(Sacc[2 * kt + 1][2], Sacc[2 * kt + 1][3]);
            o = __builtin_amdgcn_mfma_f32_16x16x32_bf16(__builtin_bit_cast(bf16x8, su), qf[kt], o, 0, 0, 0); }
        o = __builtin_amdgcn_mfma_f32_16x16x32_bf16(vf, pb, o, 0, 0, 0);
        *(pg8::f32x4*)(O + (size_t)(b * SEQ + st * 16 + x) * WC + h * 128 + 16 * wave + 4 * quad) = o;
#pragma unroll
        for (int mt = 0; mt < 8; ++mt) { const pg8::f32x4 e4 = *(const LAS pg8::f32x4*)(ev + 16 * mt + 4 * quad);
            const u2 kk2 = *(const LAS u2*)(kht + (16 * mt + x) * 16 + 4 * quad); v4u ku; ku.x = kk2.x; ku.y = kk2.y; ku.z = 0u; ku.w = 0u;
            Sacc[mt] = __builtin_amdgcn_mfma_f32_16x16x32_bf16(__builtin_bit_cast(bf16x8, ku), vf, Sacc[mt] * e4, 0, 0, 0); }
    }
    float* So = a.out + O_HP + (((size_t)L * NBAT + b) * 6 + h) * 16384;
#pragma unroll
    for (int mt = 0; mt < 8; ++mt)
#pragma unroll
        for (int i = 0; i < 4; ++i) So[(size_t)(16 * mt + 4 * quad + i) * 128 + 16 * wave + x] = Sacc[mt][i];
    __syncthreads();
}

__device__ __forceinline__ void phase_post(const Args& a, int L, int lane, int wave, int blk, int G) {
    unsigned char* ws = a.ws; const int gw = blk * NWAVES + wave, NGW = G * NWAVES;
    const float* Y = (const float*)(ws + WS_Y); const float* O = (const float*)(ws + WS_O); const float* Gt = (const float*)(ws + WS_G); const float* Z = (const float*)(ws + WS_Z);
    const float* gng = a.in[I_BGNG] + L * WB; const float* gnb = a.in[I_BGNB] + L * WB; const float* rk = a.in[I_BRK] + L * WB; const float* cng = a.in[I_CNG] + L * WC;
    for (int m = gw; m < MV; m += NGW) {
        bf16* yo = (bf16*)(ws + WS_YMIX) + (size_t)m * DM;
#pragma unroll
        for (int j = 0; j < 12; ++j) { const int c = 64 * j + lane; const float y = Y[(size_t)m * WB + c];
            const float mean = wave_sum(y) * (1.f / 64.f); const float d = y - mean; const float rstd = 1.0f / sqrtf(wave_sum(d * d) * (1.f / 64.f) + GN_EPS);
            const float* rec = (m < MP) ? (const float*)(ws + WS_RPB) + (((size_t)(m >> 11) * 12 + j) * SEQ + (m & (SEQ - 1))) * 384 : (const float*)(ws + WS_RPS) + ((size_t)(m - MP) * 12 + j) * 384;
            const float r = rec[lane], kp = rec[128 + lane], v = rec[192 + lane];
            const float bonus = wave_sum(r * kp * rk[c]);
            yo[WA + c] = bf1((d * rstd * gng[c] + gnb[c] + bonus * v) * Gt[(size_t)m * WB + c]); }
        float ov[12]; float ss = 0.f;
#pragma unroll
        for (int j = 0; j < 12; ++j) { ov[j] = O[(size_t)m * WC + 64 * j + lane]; ss += ov[j] * ov[j]; }
        const float rms = 1.0f / sqrtf(wave_sum(ss) * (1.f / WC) + RMS_EPS);
#pragma unroll
        for (int j = 0; j < 12; ++j) { const int c = 64 * j + lane; const float gz = Z[(size_t)m * PIN + OFF_C + 3 * WC + c];
            yo[WA + WB + c] = bf1(ov[j] * rms * cng[c] * (gz * sigmoidf_(gz))); }
    }
}

#ifndef EN_PRO
#define EN_PRO 1
#endif
#ifndef EN_G1
#define EN_G1 1
#endif
#ifndef EN_PREP
#define EN_PREP 1
#endif
#ifndef EN_MIX
#define EN_MIX 1
#endif
#ifndef EN_POST
#define EN_POST 1
#endif
#ifndef EN_G3
#define EN_G3 1
#endif
#ifndef EN_LN
#define EN_LN 1
#endif
#ifndef EN_G4
#define EN_G4 1
#endif
#ifndef EN_G5
#define EN_G5 1
#endif
#ifndef MK_SINGLE
#define MK_SINGLE 0
#endif
constexpr int N_PHASES = 1 + 9 * DEPTH;
constexpr int SCAN_UNITS = NBAT * 12 * 2, HSEQ_UNITS = NBAT * 6, ROLE_BLOCKS = SCAN_UNITS + HSEQ_UNITS;
constexpr int N_SGU = NBAT * 16 * 4, N_RS = NS * 12 / 8, N_HS = NS * 6 / 4, N_MISC = N_SGU + N_RS + N_HS;

__global__ void __launch_bounds__(NTHR, 2) mk_fwd(Args a) {
    extern __shared__ __attribute__((aligned(16))) unsigned char lds_raw[];
    LAS unsigned char* lds = (LAS unsigned char*)lds_raw;
    const int tid = threadIdx.x, lane = tid & 63, wave = __builtin_amdgcn_readfirstlane(tid >> 6), blk = blockIdx.x, G = gridDim.x;
    unsigned char* ws = a.ws;
    volatile LAS unsigned* MISC = (volatile LAS unsigned*)(lds + MISC_OFF);
    for (int u = tid; u < (LDS_BYTES - LDSCTL_OFF) / 4; u += NTHR) ((LAS unsigned*)(lds + LDSCTL_OFF))[u] = 0u;
    __syncthreads();
    const int lo = a.ph_lo, hi = a.ph_hi;
    XcdBarrier bar; bar.bar = (unsigned*)(ws + WS_CTL) + CW_BAR; bar.x = 0; bar.st = nullptr;
    if (hi - lo > 1) bar = xcd_barrier_post((unsigned*)(ws + WS_CTL) + CW_BAR, MISC + 8);
#define IN(k) (lo <= (k) && (k) < hi)
#define SEAM(k) do { if (IN(k) && IN((k) + 1)) { xcd_barrier(bar); } } while (0)
    bf16* HB = (bf16*)(ws + WS_HB); float* H = (float*)(ws + WS_H); float* T = (float*)(ws + WS_T);

    #if EN_PRO
    if (IN(0)) phase_prologue(a, lds, lane, wave, blk, G);
#endif
    SEAM(0);
    for (int L = 0; L < DEPTH; ++L) {
        const int pb = 1 + 9 * L;
#define LAUNDER() int tid_ = threadIdx.x; asm volatile("" : "+v"(tid_)); const int lane_ = tid_ & 63; const int wave_ = __builtin_amdgcn_readfirstlane(tid_ >> 6)
#if EN_G1
        if (IN(pb)) {
            { pg8::Gemm g{HB, (const bf16*)(ws + WS_WIN + L * SZ_WIN), MPAD, PIN, DM}; pg8::StaticOrder S; S.init(MPAD, PIN, G, blk);
              pg8::EpiF32 E{(float*)(ws + WS_Z), PIN}; pg8::gemm_phase<pg8::EpiF32, pg8::StaticOrder, true, true>(lds, g, S, E); }
            { pg8::Gemm g{(const bf16*)(ws + WS_PBF + L * SZ_PBF), (const bf16*)(ws + WS_WPP + L * SZ_WPP), MPAD, DM, DPLE}; pg8::StaticOrder S; S.init(MPAD, DM, G, G - 1 - blk);
              pg8::EpiF32 E{(float*)(ws + WS_PPO), DM}; pg8::gemm_phase<pg8::EpiF32, pg8::StaticOrder, true, true>(lds, g, S, E); }
        }
#endif
        SEAM(pb);
#if EN_PREP
        if (IN(pb + 1)) { LAUNDER(); phase_prep(a, L, lds, tid_, lane_, wave_, blk, G); }
#endif
        SEAM(pb + 1);
#if EN_MIX
        if (IN(pb + 2)) {
            LAUNDER(); const int tid = tid_, lane = lane_, wave = wave_;
            if (blk < SCAN_UNITS) rwkv_scan_unit(a, L, blk, lds, tid, lane, wave);
            else if (blk < ROLE_BLOCKS) hgrn_seq_unit(a, L, blk - SCAN_UNITS, lds, tid, lane, wave);
            else for (int it = blk - ROLE_BLOCKS; it < N_MISC; it += G - ROLE_BLOCKS) {
                if (it < N_SGU) sgu_item(a, L, it, lds, tid, lane, wave);
                else if (it < N_SGU + N_RS) rwkv_sample_item(a, L, it - N_SGU, lds, lane, wave);
                else hgrn_sample_item(a, L, it - N_SGU - N_RS, lds, lane, wave);
                __syncthreads();
            }
        }
#endif
        SEAM(pb + 2);
#if EN_POST
        if (IN(pb + 3)) { LAUNDER(); phase_post(a, L, lane_, wave_, blk, G); }
#endif
        SEAM(pb + 3);
#if EN_G3
        if (IN(pb + 4)) {
            pg8::Gemm g{(const bf16*)(ws + WS_YMIX), (const bf16*)(ws + WS_WOUT + L * SZ_WOUT), MPAD, DM, DM}; pg8::StaticOrder S; S.init(MPAD, DM, G, blk);
            pg8::EpiResid E{T, H, nullptr, DM, DN_ALPHA}; pg8::gemm_phase<pg8::EpiResid, pg8::StaticOrder, true, true>(lds, g, S, E);
        }
#endif
        SEAM(pb + 4);
#if EN_LN
        if (IN(pb + 5)) { LAUNDER(); phase_ln(a, a.in[I_LN1G] + L * DM, a.in[I_LN1B] + L * DM, false, lane_, wave_, blk, G); }
#endif
        SEAM(pb + 5);
#if EN_G4
        if (IN(pb + 6)) {
            { pg8::Gemm g{HB, (const bf16*)(ws + WS_WGU + L * SZ_WGU), MPAD, 2 * DFF, DM}; pg8::StaticOrder S; S.init(MPAD, 2 * DFF, G, blk);
              pg8::EpiSwiglu E{(bf16*)(ws + WS_ACT), DFF}; pg8::gemm_phase<pg8::EpiSwiglu, pg8::StaticOrder, true, true>(lds, g, S, E); }
            { pg8::Gemm g{HB, (const bf16*)(ws + WS_WPG + L * SZ_WPG), MPAD, DM, DM}; pg8::StaticOrder S; S.init(MPAD, DM, G, G - 1 - blk);
              pg8::EpiSigMul E{(float*)(ws + WS_PLE), (const float*)(ws + WS_PPO), DM}; pg8::gemm_phase<pg8::EpiSigMul, pg8::StaticOrder, true, true>(lds, g, S, E); }
        }
#endif
        SEAM(pb + 6);
#if EN_G5
        if (IN(pb + 7)) {
            pg8::Gemm g{(const bf16*)(ws + WS_ACT), (const bf16*)(ws + WS_WD + L * SZ_WD), MPAD, DM, DFF}; pg8::StaticOrder S; S.init(MPAD, DM, G, blk);
            pg8::EpiResid E{T, H, (const float*)(ws + WS_PLE), DM, DN_ALPHA}; pg8::gemm_phase<pg8::EpiResid, pg8::StaticOrder, true, true>(lds, g, S, E);
        }
#endif
        SEAM(pb + 7);
#if EN_LN
        if (IN(pb + 8)) { LAUNDER(); phase_ln(a, a.in[I_LN2G] + L * DM, a.in[I_LN2B] + L * DM, L == DEPTH - 1, lane_, wave_, blk, G); }
#endif
        SEAM(pb + 8);
    }
#undef IN
#undef SEAM
}

extern "C" void kernel_launch(void* const* d_in, const int* in_sizes, int n_in, void* d_out, int out_size, void* d_ws, size_t ws_size, hipStream_t stream) {
    static int grid = 0;
    if (grid == 0) {
        if (n_in != N_IN || (size_t)out_size != O_END || ws_size < WS_END) { fprintf(stderr, "kernel_launch: unexpected sizes n_in %d out %d ws %zu (need %zu)\n", n_in, out_size, ws_size, (size_t)WS_END); grid = -1; return; }
        int dev = 0, cus = 0, per_cu = 0;
        if (hipGetDevice(&dev) != hipSuccess || hipDeviceGetAttribute(&cus, hipDeviceAttributeMultiprocessorCount, dev) != hipSuccess) { grid = -1; return; }
        if (hipFuncSetAttribute((const void*)mk_fwd, hipFuncAttributeMaxDynamicSharedMemorySize, LDS_BYTES) != hipSuccess) { fprintf(stderr, "kernel_launch: hipFuncSetAttribute failed\n"); grid = -1; return; }
        if (hipOccupancyMaxActiveBlocksPerMultiprocessor(&per_cu, (const void*)mk_fwd, NTHR, LDS_BYTES) != hipSuccess || per_cu < 1) fprintf(stderr, "kernel_launch: occupancy query says %d\n", per_cu);
        (void)hipGetLastError();
        grid = cus;
        if (grid < ROLE_BLOCKS + 8) { fprintf(stderr, "kernel_launch: %d CUs is too few\n", grid); grid = -1; return; }
    }
    if (grid < 0) return;
    if (hipMemsetAsync((char*)d_ws + WS_CTL, 0, CTL_ZERO_BYTES, stream) != hipSuccess) return;
    Args a{};
    for (int i = 0; i < N_IN; ++i) a.in[i] = (const float*)d_in[i];
    a.out = (float*)d_out; a.ws = (unsigned char*)d_ws;
#if MK_SINGLE
    a.ph_lo = 0; a.ph_hi = N_PHASES;
    hipLaunchKernelGGL(mk_fwd, dim3(grid), dim3(NTHR), LDS_BYTES, stream, a);
#else
    for (int p = 0; p < N_PHASES; ++p) { a.ph_lo = p; a.ph_hi = p + 1; hipLaunchKernelGGL(mk_fwd, dim3(grid), dim3(NTHR), LDS_BYTES, stream, a); }
#endif
}
```

```cpp
#include <hip/hip_runtime.h>
#include <cstdio>
#include <cstdint>
namespace pg8 {
#define PG8_LAS __attribute__((address_space(3)))
typedef unsigned short bf16_t;
typedef short bf16x8 __attribute__((ext_vector_type(8)));
typedef float f32x4 __attribute__((ext_vector_type(4)));
typedef unsigned u32x4 __attribute__((ext_vector_type(4)));
constexpr int BM = 256, BK = 64, HALF = 128, HTB = HALF * BK * 2  , STAGE_BYTES = 8 * HTB, NXCD = 8, WGM = 8;

__host__ __device__ __forceinline__ int lds_byte(int r, int c) { const int st = (r >> 4) * 2 + (c >> 5), rr = r & 15, cc = c & 31, ob = rr * 64 + cc * 2; return st * 1024 + (ob ^ (((ob >> 9) & 1) << 5)); }
__host__ __device__ __forceinline__ void stage_rc(int b, int& R, int& C) { const int st = b / 1024, sb = b % 1024, swz = sb ^ (((sb >> 9) & 1) << 5); R = (st >> 1) * 16 + swz / 64; C = (st & 1) * 32 + (swz % 64) / 2; }
__host__ __device__ __forceinline__ int perm32(int rho) { const int n = rho >> 4, i = rho & 15; return 8 * (i >> 2) + 4 * n + (i & 3); }

struct Unit { int pm, pn; };
struct Gemm { const bf16_t* A; const bf16_t* Bt; int M, N, K; };

struct StaticOrder {
    int nM, nN, nwg, G, c;
    __host__ __device__ void init(int M, int N, int G_, int c_) { nM = M / BM; nN = N / BM; nwg = nM * nN; G = G_; c = c_; }
    __host__ __device__ bool next(int i, Unit& u) const {
        const long L = (long)i * G + c; if (L >= nwg) return false;
        int wgid = (int)L; { const int q = nwg / NXCD, r = nwg % NXCD, xcd = wgid % NXCD, off = wgid / NXCD; wgid = (xcd < r ? xcd * (q + 1) : r * (q + 1) + (xcd - r) * q) + off; }
        const int nig = WGM * nN, gid = wgid / nig, fm = gid * WGM, gsz = (nM - fm) < WGM ? (nM - fm) : WGM;
        u.pm = fm + ((wgid % nig) % gsz); u.pn = (wgid % nig) / gsz; return true;
    }
    __device__ __forceinline__ void a_ready(const Unit&) const {}
    __device__ __forceinline__ void done(const Unit&) const {}
};

__device__ __forceinline__ unsigned cvt_pk_bf16(float lo, float hi) { unsigned r; asm volatile("v_cvt_pk_bf16_f32 %0, %1, %2" : "=v"(r) : "v"(lo), "v"(hi)); return r; }
typedef float f32x2 __attribute__((ext_vector_type(2)));
struct EpiF32 {
    static constexpr bool PERM = false, AFTER_DRAIN = false;
    float* C; int ldc;
    __device__ __forceinline__ void operator()(const f32x4 (&acc)[2][2][4][2], const Unit& u, int wr, int wc, int fr, int fq) const {
        const int row0 = u.pm * BM + wr * 64 + fr, col0 = u.pn * BM + wc * 32 + 4 * fq;
#pragma unroll
        for (int ai = 0; ai < 2; ++ai)
#pragma unroll
            for (int m = 0; m < 4; ++m) { float* rowp = C + (size_t)(row0 + ai * HALF + m * 16) * ldc + col0;
#pragma unroll
                for (int bj = 0; bj < 2; ++bj)
#pragma unroll
                    for (int n = 0; n < 2; ++n) *(f32x4*)(rowp + bj * HALF + n * 16) = acc[ai][bj][m][n]; }
    }
};
struct EpiResid {
    static constexpr bool PERM = false, AFTER_DRAIN = false;
    float* out; const float* base; const float* add; int ldc; float alpha;
    __device__ __forceinline__ void operator()(const f32x4 (&acc)[2][2][4][2], const Unit& u, int wr, int wc, int fr, int fq) const {
        const int row0 = u.pm * BM + wr * 64 + fr, col0 = u.pn * BM + wc * 32 + 4 * fq;
#pragma unroll
        for (int ai = 0; ai < 2; ++ai)
#pragma unroll
            for (int m = 0; m < 4; ++m) { const size_t off = (size_t)(row0 + ai * HALF + m * 16) * ldc + col0;
#pragma unroll
                for (int bj = 0; bj < 2; ++bj)
#pragma unroll
                    for (int n = 0; n < 2; ++n) { const size_t o2 = off + bj * HALF + n * 16; f32x4 v = *(const f32x4*)(base + o2) * alpha + acc[ai][bj][m][n];
                        if (add) v += *(const f32x4*)(add + o2); *(f32x4*)(out + o2) = v; } }
    }
};
struct EpiSigMul {
    static constexpr bool PERM = false, AFTER_DRAIN = false;
    float* out; const float* mul; int ldc;
    __device__ __forceinline__ void operator()(const f32x4 (&acc)[2][2][4][2], const Unit& u, int wr, int wc, int fr, int fq) const {
        const int row0 = u.pm * BM + wr * 64 + fr, col0 = u.pn * BM + wc * 32 + 4 * fq;
#pragma unroll
        for (int ai = 0; ai < 2; ++ai)
#pragma unroll
            for (int m = 0; m < 4; ++m) { const size_t off = (size_t)(row0 + ai * HALF + m * 16) * ldc + col0;
#pragma unroll
                for (int bj = 0; bj < 2; ++bj)
#pragma unroll
                    for (int n = 0; n < 2; ++n) { const size_t o2 = off + bj * HALF + n * 16; const f32x4 x = acc[ai][bj][m][n]; const f32x4 p = *(const f32x4*)(mul + o2); f32x4 v;
#pragma unroll
                        for (int e = 0; e < 4; ++e) v[e] = p[e] * __builtin_amdgcn_rcpf(1.0f + __expf(-x[e]));
                        *(f32x4*)(out + o2) = v; } }
    }
};
struct EpiSwiglu {
    static constexpr bool PERM = true, AFTER_DRAIN = false;
    bf16_t* O; int ldo;
    __device__ __forceinline__ void operator()(const f32x4 (&acc)[2][2][4][2], const Unit& u, int wr, int wc, int fr, int fq) const {
        const int row0 = u.pm * BM + wr * 64 + fr, col0 = u.pn * HALF + wc * 32 + 8 * fq;
#pragma unroll
        for (int ai = 0; ai < 2; ++ai)
#pragma unroll
            for (int m = 0; m < 4; ++m) { bf16_t* rowp = O + (size_t)(row0 + ai * HALF + m * 16) * ldo + col0; float r[8];
#pragma unroll
                for (int n = 0; n < 2; ++n)
#pragma unroll
                    for (int e = 0; e < 4; ++e) { const float g = acc[ai][0][m][n][e], up = acc[ai][1][m][n][e]; r[4 * n + e] = g * __builtin_amdgcn_rcpf(1.0f + __expf(-g)) * up; }
                u32x4 w; w.x = cvt_pk_bf16(r[0], r[1]); w.y = cvt_pk_bf16(r[2], r[3]); w.z = cvt_pk_bf16(r[4], r[5]); w.w = cvt_pk_bf16(r[6], r[7]);
                *(u32x4*)rowp = w; }
    }
};
template <class Epi, class Sched, bool ALIGN_EPI = false, bool SP2 = false>
__device__ __forceinline__ void gemm_phase(PG8_LAS unsigned char* lds, const Gemm g, const Sched& S, const Epi& E) {
    int tid_l = threadIdx.x; asm volatile("" : "+v"(tid_l));
    const int tid = tid_l, wid = __builtin_amdgcn_readfirstlane(tid >> 6), lane = tid & 63, wr = wid >> 2, wc = wid & 3, fr = lane & 15, fq = lane >> 4;
    const int K = g.K, nt = K / BK;
    unsigned voffA[2], voffB[2];
#pragma unroll
    for (int i = 0; i < 2; ++i) { int R, C; stage_rc(tid * 16 + i * 8192, R, C); const int Rb = Epi::PERM ? ((R & ~31) + perm32(R & 31)) : R;
        voffA[i] = (unsigned)(R * K + C) * 2u; voffB[i] = (unsigned)(Rb * K + C) * 2u; }
    const size_t kstep = (size_t)(BK * 2);
    const size_t hstep = (size_t)HALF * K * 2;
    const size_t tstep = 2 * hstep;
    const unsigned ldsw = (unsigned)wid * 1024u;
    const int aoff = lds_byte(wr * 64 + fr, fq * 8), boff = lds_byte(wc * 32 + fr, fq * 8);
#define PG8_SA(b, h) (((b) * 2 + (h)) * HTB)
#define PG8_SB(b, h) ((4 + (b) * 2 + (h)) * HTB)
#define PG8_STAGE(bufoff, gbase, voff) do { _Pragma("unroll") for (int _i = 0; _i < 2; ++_i) \
        __builtin_amdgcn_global_load_lds((const unsigned*)((const char*)(gbase) + (voff)[_i]), (PG8_LAS unsigned*)(lds + (bufoff) + ldsw + _i * 8192), 16, 0, 0); } while (0)
#define PG8_LDA(dst, b, h) do { _Pragma("unroll") for (int m = 0; m < 4; ++m) _Pragma("unroll") for (int k = 0; k < 2; ++k) dst[m][k] = *(const PG8_LAS bf16x8*)(lds + PG8_SA(b, h) + aoff + m * 2048 + k * 1024); } while (0)
#define PG8_LDB(dst, b, h) do { _Pragma("unroll") for (int n = 0; n < 2; ++n) _Pragma("unroll") for (int k = 0; k < 2; ++k) dst[n][k] = *(const PG8_LAS bf16x8*)(lds + PG8_SB(b, h) + boff + n * 2048 + k * 1024); } while (0)
#define PG8_MMA(ai, bj, At, Bt) do { __builtin_amdgcn_s_setprio(1); _Pragma("unroll") for (int m = 0; m < 4; ++m) _Pragma("unroll") for (int n = 0; n < 2; ++n) _Pragma("unroll") for (int k = 0; k < 2; ++k) \
        acc[ai][bj][m][n] = __builtin_amdgcn_mfma_f32_16x16x32_bf16(Bt[n][k], At[m][k], acc[ai][bj][m][n], 0, 0, 0); __builtin_amdgcn_s_setprio(0); } while (0)
#define PG8_WAIT_V(n) asm volatile("s_waitcnt vmcnt(" #n ")" ::: "memory")
#define PG8_WAIT_L(n) asm volatile("s_waitcnt lgkmcnt(" #n ")" ::: "memory")
#define PG8_BAR __builtin_amdgcn_s_barrier()
#define PG8_SCHED __builtin_amdgcn_sched_barrier(0)
    Unit cur, nxt; int ui = 0;
    if (!S.next(0, cur)) return;
    f32x4 acc[2][2][4][2];
#pragma unroll
    for (int a = 0; a < 2; ++a)
#pragma unroll
        for (int b = 0; b < 2; ++b)
#pragma unroll
            for (int m = 0; m < 4; ++m)
#pragma unroll
                for (int n = 0; n < 2; ++n) acc[a][b][m][n] = (f32x4){0.f, 0.f, 0.f, 0.f};
    bf16x8 At[4][2], B0[2][2], B1[2][2];
    const char* cA = (const char*)g.A + (size_t)cur.pm * tstep; const char* cB = (const char*)g.Bt + (size_t)cur.pn * tstep;
    S.a_ready(cur);
    if constexpr (SP2) {
        PG8_STAGE(PG8_SB(0, 0), cB, voffB); PG8_STAGE(PG8_SB(0, 1), cB + hstep, voffB); PG8_STAGE(PG8_SA(0, 0), cA, voffA); PG8_STAGE(PG8_SA(0, 1), cA + hstep, voffA);
        if (wr == 1) PG8_BAR;
        PG8_WAIT_V(2); PG8_BAR;
        PG8_STAGE(PG8_SB(1, 0), cB + kstep, voffB); PG8_STAGE(PG8_SA(1, 0), cA + kstep, voffA); PG8_STAGE(PG8_SB(1, 1), cB + hstep + kstep, voffB);
        PG8_WAIT_V(6); PG8_BAR;
    } else {
        PG8_STAGE(PG8_SB(0, 0), cB, voffB); PG8_STAGE(PG8_SA(0, 0), cA, voffA); PG8_STAGE(PG8_SB(0, 1), cB + hstep, voffB); PG8_STAGE(PG8_SA(0, 1), cA + hstep, voffA);
        if (wr == 1) PG8_BAR;
        PG8_WAIT_V(4); PG8_BAR;
        PG8_STAGE(PG8_SB(1, 0), cB + kstep, voffB); PG8_STAGE(PG8_SA(1, 0), cA + kstep, voffA); PG8_STAGE(PG8_SB(1, 1), cB + hstep + kstep, voffB);
        PG8_WAIT_V(6); PG8_BAR;
    }
    for (;;) {
        const bool has_next = S.next(ui + 1, nxt);
        const char* nA = has_next ? (const char*)g.A + (size_t)nxt.pm * tstep : cA; const char* nB = has_next ? (const char*)g.Bt + (size_t)nxt.pn * tstep : cB;
        for (int t = 0; t < nt; t += 2) {
            const bool last = (t == nt - 2);
            const char* a1 = cA + (size_t)(t + 1) * kstep;
            const char* a2 = last ? nA : cA + (size_t)(t + 2) * kstep; const char* b2 = last ? nB : cB + (size_t)(t + 2) * kstep;
            const char* a3 = a2 + kstep; const char* b3 = b2 + kstep;
            if (last && has_next) S.a_ready(nxt);
            if constexpr (SP2) {
            PG8_LDB(B0, 0, 0); PG8_LDB(B1, 0, 1); PG8_SCHED; PG8_LDA(At, 0, 0); PG8_STAGE(PG8_SA(1, 1), a1 + hstep, voffA);
            PG8_WAIT_V(8); PG8_WAIT_L(0); PG8_BAR; PG8_MMA(0, 0, At, B0); PG8_MMA(0, 1, At, B1); PG8_BAR; PG8_SCHED;
            PG8_LDA(At, 0, 1); PG8_STAGE(PG8_SB(0, 0), b2, voffB); PG8_STAGE(PG8_SB(0, 1), b2 + hstep, voffB); PG8_STAGE(PG8_SA(0, 0), a2, voffA);
            PG8_WAIT_V(8); PG8_WAIT_L(0); PG8_BAR; PG8_MMA(1, 0, At, B0); PG8_MMA(1, 1, At, B1); PG8_BAR; PG8_SCHED;
            PG8_LDB(B0, 1, 0); PG8_LDB(B1, 1, 1); PG8_SCHED; PG8_LDA(At, 1, 0); PG8_STAGE(PG8_SA(0, 1), a2 + hstep, voffA);
            PG8_WAIT_V(8); PG8_WAIT_L(0); PG8_BAR; PG8_MMA(0, 0, At, B0); PG8_MMA(0, 1, At, B1); PG8_BAR; PG8_SCHED;
            PG8_LDA(At, 1, 1); PG8_STAGE(PG8_SB(1, 0), b3, voffB); PG8_STAGE(PG8_SB(1, 1), b3 + hstep, voffB); PG8_STAGE(PG8_SA(1, 0), a3, voffA);
            PG8_WAIT_V(8); PG8_WAIT_L(0); PG8_BAR; PG8_MMA(1, 0, At, B0); PG8_MMA(1, 1, At, B1); PG8_BAR; PG8_SCHED;
            } else {
            PG8_LDB(B0, 0, 0); PG8_SCHED; PG8_LDA(At, 0, 0); PG8_STAGE(PG8_SA(1, 1), a1 + hstep, voffA);
            PG8_WAIT_L(8); PG8_BAR; PG8_WAIT_L(0); PG8_MMA(0, 0, At, B0); PG8_BAR; PG8_SCHED;
            PG8_LDB(B1, 0, 1); PG8_STAGE(PG8_SB(0, 0), b2, voffB);
            PG8_BAR; PG8_WAIT_L(0); PG8_MMA(0, 1, At, B1); PG8_BAR;
            PG8_LDA(At, 0, 1); PG8_STAGE(PG8_SA(0, 0), a2, voffA);
            PG8_BAR; PG8_WAIT_L(0); PG8_MMA(1, 0, At, B0); PG8_BAR; PG8_SCHED;
            PG8_STAGE(PG8_SB(0, 1), b2 + hstep, voffB);
            PG8_WAIT_V(6); PG8_BAR; PG8_MMA(1, 1, At, B1); PG8_BAR;
            PG8_LDB(B0, 1, 0); PG8_SCHED; PG8_LDA(At, 1, 0); PG8_STAGE(PG8_SA(0, 1), a2 + hstep, voffA);
            PG8_WAIT_L(8); PG8_BAR; PG8_WAIT_L(0); PG8_MMA(0, 0, At, B0); PG8_BAR; PG8_SCHED;
            PG8_LDB(B1, 1, 1); PG8_STAGE(PG8_SB(1, 0), b3, voffB);
            PG8_BAR; PG8_WAIT_L(0); PG8_MMA(0, 1, At, B1); PG8_BAR;
            PG8_LDA(At, 1, 1); PG8_STAGE(PG8_SA(1, 0), a3, voffA);
            PG8_BAR; PG8_WAIT_L(0); PG8_MMA(1, 0, At, B0); PG8_BAR; PG8_SCHED;
            PG8_STAGE(PG8_SB(1, 1), b3 + hstep, voffB);
            PG8_WAIT_V(6); PG8_BAR; PG8_MMA(1, 1, At, B1); PG8_BAR;
            }
        }
        if constexpr (ALIGN_EPI) { if (wr == 0) PG8_BAR; }
        if constexpr (!Epi::AFTER_DRAIN) { E(acc, cur, wr, wc, fr, fq); S.done(cur); }
        if (!has_next) break;
#pragma unroll
        for (int a = 0; a < 2; ++a)
#pragma unroll
            for (int b = 0; b < 2; ++b)
#pragma unroll
                for (int m = 0; m < 4; ++m)
#pragma unroll
                    for (int n = 0; n < 2; ++n) acc[a][b][m][n] = (f32x4){0.f, 0.f, 0.f, 0.f};
        cur = nxt; cA = nA; cB = nB; ++ui;
        if constexpr (ALIGN_EPI) { if (wr == 1) PG8_BAR; }
    }
    PG8_WAIT_V(0);
    if constexpr (!ALIGN_EPI) { if (wr == 0) PG8_BAR; }
    PG8_BAR;
    if constexpr (Epi::AFTER_DRAIN) { E.fused(acc, cur, wr, wc, fr, fq, lds, wid, lane); S.done(cur); }
#undef PG8_SA
#undef PG8_SB
#undef PG8_STAGE
#undef PG8_LDA
#undef PG8_LDB
#undef PG8_MMA
#undef PG8_WAIT_V
#undef PG8_WAIT_L
#undef PG8_BAR
#undef PG8_SCHED
}
}
#define GAS __attribute__((address_space(1)))
#define LAS __attribute__((address_space(3)))
typedef unsigned short bf16;
typedef unsigned v4u __attribute__((ext_vector_type(4)));
typedef float f32x4 __attribute__((ext_vector_type(4)));
typedef short bf16x8 __attribute__((ext_vector_type(8)));
typedef GAS unsigned gu32;
typedef GAS unsigned long long gu64;
#define RLX_AGENT __ATOMIC_RELAXED, __HIP_MEMORY_SCOPE_AGENT
#define LDS_WAIT() asm volatile("s_waitcnt lgkmcnt(0)" ::: "memory")
#define VM_WAIT() asm volatile("s_waitcnt vmcnt(0)" ::: "memory")
__device__ __forceinline__ unsigned long long rt() { return __builtin_amdgcn_s_memrealtime(); }
__device__ __forceinline__ unsigned f2bf(float f) { unsigned u = __builtin_bit_cast(unsigned, f); return (u + 0x7fffu + ((u >> 16) & 1u)) >> 16; }
__device__ __forceinline__ unsigned pk2(float lo, float hi) { return f2bf(lo) | (f2bf(hi) << 16); }

#define XB_TMO      128
#define XB_XCNT(j)  (256  + 64 * (j))
#define XB_XSUB(j)  (1280 + 64 * (j))
#define XB_XGEN(j)  (2304 + 64 * (j))
#define XB_TOP      3328
#define XB_TOPGEN   3392
#define XCD_BAR_WORDS 3456
#define XB_SPIN_CAP (1u << 18)

__device__ __forceinline__ unsigned xb_ld(unsigned* p)              { return __hip_atomic_load(p, __ATOMIC_RELAXED, __HIP_MEMORY_SCOPE_AGENT); }
__device__ __forceinline__ unsigned xb_add(unsigned* p, unsigned v) { return __hip_atomic_fetch_add(p, v, __ATOMIC_RELAXED, __HIP_MEMORY_SCOPE_AGENT); }
__device__ __forceinline__ unsigned xb_xcc_id() { return (unsigned)__builtin_amdgcn_s_getreg((3 << 11) | 20) & 0xFu; }
#define XB_SPIN(cond, bar) do { unsigned _sp = 0; while (cond) { __builtin_amdgcn_s_sleep(1); \
    if ((++_sp & 255u) == 0u) { if (xb_ld(&(bar)[XB_TMO])) break; if (_sp > XB_SPIN_CAP) { atomicAdd(&(bar)[XB_TMO], 1u); break; } } } } while (0)

struct XcdBarrier {
    unsigned* bar; unsigned x;
    volatile LAS unsigned* st;
};

__device__ __forceinline__ XcdBarrier xcd_barrier_post(unsigned* bar, volatile LAS unsigned* st) {
    XcdBarrier b; b.bar = bar; b.x = xb_xcc_id(); b.st = st;
    if (threadIdx.x == 0) (void)xb_add(&bar[XB_XCNT(b.x)], 1u);
    return b;
}
__device__ __forceinline__ void xcd_barrier_complete(unsigned* bar, unsigned x, unsigned& nloc, unsigned& nx) {
    const unsigned G = gridDim.x * gridDim.y * gridDim.z;
    unsigned sum, cnt, mine, sp = 0u;
    for (;;) {
        sum = 0u; cnt = 0u; mine = 0u;
#pragma unroll
        for (unsigned j = 0; j < 16; ++j) { const unsigned c = xb_ld(&bar[XB_XCNT(j)]); sum += c; cnt += (c > 0u) ? 1u : 0u; mine = (j == x) ? c : mine; }
        if (sum == G) break;
        __builtin_amdgcn_s_sleep(1);
        if ((++sp & 255u) == 0u) { if (xb_ld(&bar[XB_TMO])) break; if (sp > XB_SPIN_CAP) { atomicAdd(&bar[XB_TMO], 1u); break; } }
    }
    nloc = mine > 0u ? mine : 1u; nx = cnt > 0u ? cnt : 1u;
}

__device__ __forceinline__ void xcd_barrier(const XcdBarrier& b) {
    asm volatile("s_waitcnt vmcnt(0)" ::: "memory");
    __syncthreads();
    if (threadIdx.x == 0) {
        unsigned* bar = b.bar;
        __builtin_amdgcn_s_waitcnt(0);
        unsigned nloc = b.st[0], nx = b.st[1];
        if (nloc == 0u) { xcd_barrier_complete(bar, b.x, nloc, nx); b.st[0] = nloc; b.st[1] = nx; }
        const unsigned old = xb_add(&bar[XB_XSUB(b.x)], 1u);
        const unsigned gen = old / nloc;
        if (old + 1u == (gen + 1u) * nloc) {
            __builtin_amdgcn_fence(__ATOMIC_RELEASE, "agent");
            asm volatile("s_waitcnt vmcnt(0)" ::: "memory");
            const unsigned og = xb_add(&bar[XB_TOP], 1u);
            const unsigned tg = og / nx;
            if (og + 1u == (tg + 1u) * nx) xb_add(&bar[XB_TOPGEN], 1u);
            else XB_SPIN(xb_ld(&bar[XB_TOPGEN]) == tg, bar);
            __builtin_amdgcn_fence(__ATOMIC_ACQUIRE, "agent");
            xb_add(&bar[XB_XGEN(b.x)], 1u);
            asm volatile("s_waitcnt vmcnt(0)" ::: "memory");
        } else {
            XB_SPIN(xb_ld(&bar[XB_XGEN(b.x)]) == gen, bar);
            __builtin_amdgcn_fence(__ATOMIC_ACQUIRE, "agent");
            asm volatile("s_waitcnt vmcnt(0)" ::: "memory");
        }
    }
    __syncthreads();
}

constexpr int DM = 2048, NBAT = 4, SEQ = 2048, DEPTH = 4, NS = 128;
constexpr int MP = NBAT * SEQ;
constexpr int MV = MP + NS;
constexpr int MPAD = 8448;
constexpr int WA = 512, WB = 768, WC = 768, PIN = 6656, DFF = 5632, DPLE = 256, PBW = 2560;
constexpr int OFF_B = 1024, OFF_C = 3584;
constexpr float LN_EPS = 1e-5f, GN_EPS = 64e-5f, RMS_EPS = 1e-6f;
constexpr float DN_ALPHA = 1.681792830507429f;
enum { I_XP = 0, I_XS, I_SRWKV, I_SSHIFT, I_SHGRN, I_PP, I_PS, I_LNING, I_LNINB, I_WIN, I_ALNG, I_ALNB, I_AWS, I_ABS, I_BMU, I_BW0, I_BWUP, I_BA0, I_BAUP, I_BGUP,
       I_BKK, I_BKA, I_BRK, I_BGNG, I_BGNB, I_CLB, I_CNG, I_WOUT, I_LN1G, I_LN1B, I_WG, I_WU, I_WD, I_WPG, I_WPP, I_LN2G, I_LN2B, N_IN };
constexpr size_t O_YP = 0, O_YS = O_YP + (size_t)MP * DM, O_RP = O_YS + (size_t)NS * DM, O_SP = O_RP + (size_t)DEPTH * NBAT * 12 * 4096,
                 O_HP = O_SP + (size_t)DEPTH * NBAT * PBW, O_RS = O_HP + (size_t)DEPTH * NBAT * 6 * 16384, O_SS = O_RS + (size_t)DEPTH * NS * 12 * 4096,
                 O_HS = O_SS + (size_t)DEPTH * NS * PBW, O_VS = O_HS + (size_t)DEPTH * NS * 6 * 16384, O_END = O_VS + (size_t)DEPTH * NS * WA;
static_assert(O_END == 96509952, "output size");
constexpr size_t al256(size_t x) { return (x + 255) & ~(size_t)255; }
constexpr size_t WS_CTL = 0, CTL_ZERO_BYTES = 1u << 20;
constexpr size_t SZ_WIN = (size_t)PIN * DM * 2, SZ_WOUT = (size_t)DM * DM * 2, SZ_WGU = (size_t)2 * DFF * DM * 2, SZ_WD = (size_t)DM * DFF * 2, SZ_WPG = SZ_WOUT, SZ_WPP = (size_t)DM * DPLE * 2;
constexpr size_t WS_WIN = CTL_ZERO_BYTES, WS_WOUT = WS_WIN + DEPTH * SZ_WIN, WS_WGU = WS_WOUT + DEPTH * SZ_WOUT, WS_WD = WS_WGU + DEPTH * SZ_WGU, WS_WPG = WS_WD + DEPTH * SZ_WD,
                 WS_WPP = WS_WPG + DEPTH * SZ_WPG, WS_PBF = WS_WPP + DEPTH * SZ_WPP;
constexpr size_t SZ_PBF = (size_t)MPAD * DPLE * 2;
constexpr size_t WS_H = WS_PBF + DEPTH * SZ_PBF, WS_HB = WS_H + (size_t)MPAD * DM * 4, WS_T = WS_HB + (size_t)MPAD * DM * 2, WS_YMIX = WS_T + (size_t)MPAD * DM * 4;
constexpr size_t WS_Z = WS_YMIX + (size_t)MPAD * DM * 2;
constexpr size_t WS_ACT = WS_Z, WS_PLE = WS_ACT + al256((size_t)MPAD * DFF * 2);
constexpr size_t WS_PPO = WS_Z + (size_t)MPAD * PIN * 4;
static_assert(WS_PLE + (size_t)MPAD * DM * 4 <= WS_PPO, "overlay fits");
constexpr size_t WS_RPB = WS_PPO + (size_t)MPAD * DM * 4;
constexpr size_t WS_RPS = WS_RPB + (size_t)NBAT * 12 * SEQ * 384 * 4;
constexpr size_t WS_G = WS_RPS + (size_t)NS * 12 * 384 * 4;
constexpr size_t WS_Y = WS_G + (size_t)MPAD * WB * 4;
constexpr size_t WS_O = WS_Y + (size_t)MPAD * WB * 4;
constexpr size_t WS_END = WS_O + (size_t)MPAD * WC * 4;
static_assert(WS_WIN % 256 == 0 && WS_H % 256 == 0 && WS_Z % 256 == 0 && WS_RPB % 256 == 0 && WS_G % 256 == 0, "alignment");
constexpr int CW_BAR = 4096;

constexpr int RING_BYTES = 131072, LDSCTL_OFF = RING_BYTES, MISC_OFF = LDSCTL_OFF + 320, LDS_BYTES = 147456;
constexpr int NWAVES = 8, NTHR = 512;

struct Args { const float* in[N_IN]; float* out; unsigned char* ws; int ph_lo, ph_hi; };
static_assert(sizeof(Args) == (N_IN + 2) * 8 + 8, "no padding in Args");

typedef float f4 __attribute__((ext_vector_type(4)));
typedef float f2 __attribute__((ext_vector_type(2)));
typedef unsigned u2 __attribute__((ext_vector_type(2)));

__device__ __forceinline__ float wave_sum(float v) {
#pragma unroll
    for (int o = 1; o < 64; o <<= 1) v += __shfl_xor(v, o);
    return v;
}
template <int CTRL> __device__ __forceinline__ float dpp_f(float x) { return __builtin_bit_cast(float, __builtin_amdgcn_update_dpp(0, __builtin_bit_cast(int, x), CTRL, 0xF, 0xF, true)); }
__device__ __forceinline__ float row16_sum(float x) {
    x += dpp_f<0xB1>(x);
    x += dpp_f<0x4E>(x);
    x += dpp_f<0x141>(x);
    x += dpp_f<0x140>(x);
    return x;
}
__device__ __forceinline__ float sigmoidf_(float x) { return 1.0f / (1.0f + expf(-x)); }
__device__ __forceinline__ float gelu_erf(float x) { return 0.5f * x * (1.0f + erff(x * 0.70710678118654752f)); }
__device__ __forceinline__ unsigned short bf1(float x) { return (unsigned short)(pg8::cvt_pk_bf16(x, 0.f) & 0xffffu); }
__device__ __forceinline__ float lbound(const float* clb, int L, int c) {
    const float x0 = clb[c], x1 = clb[WC + c], x2 = clb[2 * WC + c], x3 = clb[3 * WC + c];
    const float mx = fmaxf(fmaxf(x0, x1), fmaxf(x2, x3));
    const float e0 = expf(x0 - mx), e1 = expf(x1 - mx), e2 = expf(x2 - mx), e3 = expf(x3 - mx);
    float s = 0.f; if (L >= 1) s += e1; if (L >= 2) s += e2; if (L >= 3) s += e3;
    return s / (e0 + e1 + e2 + e3);
}
__device__ __forceinline__ float log_sigmoid(float x) { return fminf(x, 0.f) - log1pf(expf(-fabsf(x))); }

__device__ __forceinline__ void tr_item(const float* W, int K, int N, bf16* WT, int mode, LAS float* scr, int item, int lane) {
    const int nblk = N >> 5, kb = item / nblk, nb = item - kb * nblk, k0 = kb << 6, n0 = nb << 5;
    int rb = n0; if (mode) rb = ((n0 >> 7) << 8) + (n0 & 127) + (mode == 2 ? 128 : 0);
#pragma unroll 8
    for (int i = 0; i < 32; ++i) { const int kk = 2 * i + (lane >> 5); scr[kk * 33 + (lane & 31)] = W[(size_t)(k0 + kk) * N + n0 + (lane & 31)]; }
    LDS_WAIT(); asm volatile("" ::: "memory");
    const int c = lane & 7;
#pragma unroll
    for (int j = 0; j < 4; ++j) { const int n = (lane >> 3) + 8 * j; const LAS float* s = scr + (8 * c) * 33 + n;
        v4u o; o.x = pg8::cvt_pk_bf16(s[0 * 33], s[1 * 33]); o.y = pg8::cvt_pk_bf16(s[2 * 33], s[3 * 33]); o.z = pg8::cvt_pk_bf16(s[4 * 33], s[5 * 33]); o.w = pg8::cvt_pk_bf16(s[6 * 33], s[7 * 33]);
        *(v4u*)(WT + (size_t)(rb + n) * K + k0 + 8 * c) = o; }
    LDS_WAIT(); asm volatile("" ::: "memory");
}
__device__ __forceinline__ void ln_row(const float* src, const float* g, const float* b, float* dstf, bf16* dstb, float* dst2, int lane) {
    f4 v[8]; float s = 0.f;
#pragma unroll
    for (int j = 0; j < 8; ++j) { v[j] = *(const f4*)(src + 4 * (lane + 64 * j)); s += (v[j].x + v[j].y) + (v[j].z + v[j].w); }
    const float mean = wave_sum(s) * (1.f / DM); float s2 = 0.f;
#pragma unroll
    for (int j = 0; j < 8; ++j) { v[j] = v[j] - mean; s2 += (v[j].x * v[j].x + v[j].y * v[j].y) + (v[j].z * v[j].z + v[j].w * v[j].w); }
    const float rstd = 1.0f / sqrtf(wave_sum(s2) * (1.f / DM) + LN_EPS);
#pragma unroll
    for (int j = 0; j < 8; ++j) { const int c = 4 * (lane + 64 * j); const f4 gg = *(const f4*)(g + c), bb = *(const f4*)(b + c); const f4 o = v[j] * rstd * gg + bb;
        *(f4*)(dstf + c) = o; if (dst2) *(f4*)(dst2 + c) = o;
        u2 w; w.x = pg8::cvt_pk_bf16(o.x, o.y); w.y = pg8::cvt_pk_bf16(o.z, o.w); *(u2*)(dstb + c) = w; }
}
__device__ __forceinline__ void phase_prologue(const Args& a, LAS unsigned char* lds, int lane, int wave, int blk, int G) {
    LAS float* scr = (LAS float*)(lds + wave * 16384);
    const int gw = blk * NWAVES + wave, NGW = G * NWAVES;
    constexpr int I_IN = 32 * (PIN / 32), I_OUT = 32 * (DM / 32), I_G = 32 * (DFF / 32), I_D = (DFF / 64) * (DM / 32), I_PGc = I_OUT, I_PPc = (DPLE / 64) * (DM / 32);
    constexpr int PER_L = I_IN + I_OUT + 2 * I_G + I_D + I_PGc + I_PPc;
    unsigned char* ws = a.ws;
    for (int it = gw; it < DEPTH * PER_L; it += NGW) {
        const int L = it / PER_L; int r = it - L * PER_L;
        if (r < I_IN) { tr_item(a.in[I_WIN] + (size_t)L * DM * PIN, DM, PIN, (bf16*)(ws + WS_WIN + L * SZ_WIN), 0, scr, r, lane); continue; } r -= I_IN;
        if (r < I_OUT) { tr_item(a.in[I_WOUT] + (size_t)L * DM * DM, DM, DM, (bf16*)(ws + WS_WOUT + L * SZ_WOUT), 0, scr, r, lane); continue; } r -= I_OUT;
        if (r < I_G) { tr_item(a.in[I_WG] + (size_t)L * DM * DFF, DM, DFF, (bf16*)(ws + WS_WGU + L * SZ_WGU), 1, scr, r, lane); continue; } r -= I_G;
        if (r < I_G) { tr_item(a.in[I_WU] + (size_t)L * DM * DFF, DM, DFF, (bf16*)(ws + WS_WGU + L * SZ_WGU), 2, scr, r, lane); continue; } r -= I_G;
        if (r < I_D) { tr_item(a.in[I_WD] + (size_t)L * DFF * DM, DFF, DM, (bf16*)(ws + WS_WD + L * SZ_WD), 0, scr, r, lane); continue; } r -= I_D;
        if (r < I_PGc) { tr_item(a.in[I_WPG] + (size_t)L * DM * DM, DM, DM, (bf16*)(ws + WS_WPG + L * SZ_WPG), 0, scr, r, lane); continue; } r -= I_PGc;
        tr_item(a.in[I_WPP] + (size_t)L * DPLE * DM, DPLE, DM, (bf16*)(ws + WS_WPP + L * SZ_WPP), 0, scr, r, lane);
    }
    for (int it = gw; it < DEPTH * MV; it += NGW) { const int L = it / MV, m = it - L * MV;
        const float* src = (m < MP) ? a.in[I_PP] + ((size_t)L * MP + m) * DPLE : a.in[I_PS] + ((size_t)L * NS + (m - MP)) * DPLE;
        const f4 v = *(const f4*)(src + 4 * lane); u2 w; w.x = pg8::cvt_pk_bf16(v.x, v.y); w.y = pg8::cvt_pk_bf16(v.z, v.w);
        *(u2*)((bf16*)(ws + WS_PBF + L * SZ_PBF) + (size_t)m * DPLE + 4 * lane) = w; }
    for (int m = gw; m < MV; m += NGW) { const float* src = (m < MP) ? a.in[I_XP] + (size_t)m * DM : a.in[I_XS] + (size_t)(m - MP) * DM;
        ln_row(src, a.in[I_LNING], a.in[I_LNINB], (float*)(ws + WS_H) + (size_t)m * DM, (bf16*)(ws + WS_HB) + (size_t)m * DM, nullptr, lane); }
}
__device__ __forceinline__ void phase_ln(const Args& a, const float* g, const float* b, bool last, int lane, int wave, int blk, int G) {
    const int gw = blk * NWAVES + wave, NGW = G * NWAVES; unsigned char* ws = a.ws;
    for (int m = gw; m < MV; m += NGW)
        ln_row((const float*)(ws + WS_T) + (size_t)m * DM, g, b, (float*)(ws + WS_H) + (size_t)m * DM, (bf16*)(ws + WS_HB) + (size_t)m * DM,
               last ? a.out + (m < MP ? O_YP + (size_t)m * DM : O_YS + (size_t)(m - MP) * DM) : nullptr, lane);
}

__device__ __forceinline__ void phase_prep(const Args& a, int L, LAS unsigned char* lds, int tid, int lane, int wave, int blk, int G) {
    unsigned char* ws = a.ws;
    const float* Z = (const float*)(ws + WS_Z);
    LAS float* xsT = (LAS float*)lds;
    const float* mu = a.in[I_BMU] + L * PBW; const float* w0 = a.in[I_BW0] + L * WB; const float* a0 = a.in[I_BA0] + L * WB;
    const float* w_up = a.in[I_BWUP] + (size_t)L * 64 * WB; const float* a_up = a.in[I_BAUP] + (size_t)L * 64 * WB; const float* g_up = a.in[I_BGUP] + (size_t)L * 128 * WB;
    const float* k_k = a.in[I_BKK] + L * WB; const float* k_a = a.in[I_BKA] + L * WB;
    const float* sh0 = a.in[I_SSHIFT] + (size_t)L * NS * PBW;
    for (int tile = blk; tile < MV / 16; tile += G) {
        const bool samp = tile >= MP / 16; const int m0 = tile * 16;
        __syncthreads();
        for (int e = tid; e < 4096; e += NTHR) { const int tok = e >> 8, j = e & 255, m = m0 + tok, col = OFF_B + 2304 + j;
            const float cur = Z[(size_t)m * PIN + col]; float prev;
            if (samp) prev = sh0[(size_t)(m - MP) * PBW + 2304 + j]; else prev = (m & (SEQ - 1)) ? Z[(size_t)(m - 1) * PIN + col] : 0.f;
            float x = cur + mu[2304 + j] * (prev - cur);
            if (j < 64) x = tanhf(x); else if (j >= 128) x = sigmoidf_(x);
            xsT[j * 16 + tok] = x; }
        __syncthreads();
        const int cw = tid & 255, th = tid >> 8;
        float accw[3][8], acca[3][8], accg[3][8];
#pragma unroll
        for (int jc = 0; jc < 3; ++jc)
#pragma unroll
            for (int tk = 0; tk < 8; ++tk) { accw[jc][tk] = 0.f; acca[jc][tk] = 0.f; accg[jc][tk] = 0.f; }
        for (int j2 = 0; j2 < 64; ++j2) {
            const f4 xw0 = *(const LAS f4*)(xsT + j2 * 16 + th * 8), xw1 = *(const LAS f4*)(xsT + j2 * 16 + th * 8 + 4);
            const f4 xa0 = *(const LAS f4*)(xsT + (64 + j2) * 16 + th * 8), xa1 = *(const LAS f4*)(xsT + (64 + j2) * 16 + th * 8 + 4);
#pragma unroll
            for (int jc = 0; jc < 3; ++jc) { const float wu = w_up[j2 * WB + cw + 256 * jc], au = a_up[j2 * WB + cw + 256 * jc];
#pragma unroll
                for (int tk = 0; tk < 4; ++tk) { accw[jc][tk] += xw0[tk] * wu; accw[jc][4 + tk] += xw1[tk] * wu; acca[jc][tk] += xa0[tk] * au; acca[jc][4 + tk] += xa1[tk] * au; } }
        }
        for (int j2 = 0; j2 < 128; ++j2) {
            const f4 xg0 = *(const LAS f4*)(xsT + (128 + j2) * 16 + th * 8), xg1 = *(const LAS f4*)(xsT + (128 + j2) * 16 + th * 8 + 4);
#pragma unroll
            for (int jc = 0; jc < 3; ++jc) { const float gu = g_up[j2 * WB + cw + 256 * jc];
#pragma unroll
                for (int tk = 0; tk < 4; ++tk) { accg[jc][tk] += xg0[tk] * gu; accg[jc][4 + tk] += xg1[tk] * gu; } }
        }
#pragma unroll
        for (int jc = 0; jc < 3; ++jc) { const int c = cw + 256 * jc, h = c >> 6, i = c & 63;
            const float w0c = w0[c], a0c = a0[c], kkc = k_k[c], kac = k_a[c], mur = mu[c], muk = mu[WB + c], muv = mu[2 * WB + c];
#pragma unroll
            for (int tk = 0; tk < 8; ++tk) { const int m = m0 + th * 8 + tk; const float* zr = Z + (size_t)m * PIN + OFF_B + c;
                const float cr = zr[0], ck = zr[WB], cv = zr[2 * WB]; float pr, pk, pv;
                if (samp) { const float* s = sh0 + (size_t)(m - MP) * PBW + c; pr = s[0]; pk = s[WB]; pv = s[2 * WB]; }
                else if (m & (SEQ - 1)) { pr = zr[-PIN]; pk = zr[WB - PIN]; pv = zr[2 * WB - PIN]; } else { pr = 0.f; pk = 0.f; pv = 0.f; }
                const float r = cr + mur * (pr - cr), k = ck + muk * (pk - ck), v = cv + muv * (pv - cv);
                const float wv = w0c + accw[jc][tk]; const float dec = expf(-0.6065306597126334f * sigmoidf_(wv));
                const float av = sigmoidf_(a0c + acca[jc][tk]);
                const float kkr = k * kkc; const float ss = wave_sum(kkr * kkr); const float kk = kkr / fmaxf(sqrtf(ss), 1e-12f);
                const float kp = k * (1.0f + (av - 1.0f) * kac);
                float* rec = samp ? (float*)(ws + WS_RPS) + ((size_t)(m - MP) * 12 + h) * 384 : (float*)(ws + WS_RPB) + (((size_t)(m >> 11) * 12 + h) * SEQ + (m & (SEQ - 1))) * 384;
                rec[i] = r; rec[64 + i] = dec; rec[128 + i] = kp; rec[192 + i] = v; rec[256 + i] = kk; rec[320 + i] = kk * av;
                ((float*)(ws + WS_G))[(size_t)m * WB + c] = accg[jc][tk]; }
        }
        if (samp) { for (int e = tid; e < 16 * PBW; e += NTHR) { const int tok = e / PBW, j = e - tok * PBW, i = m0 + tok - MP;
                        a.out[O_SS + ((size_t)L * NS + i) * PBW + j] = Z[(size_t)(m0 + tok) * PIN + OFF_B + j]; } }
        else if ((m0 & (SEQ - 1)) == SEQ - 16) { const int b = m0 >> 11; for (int j = tid; j < PBW; j += NTHR) a.out[O_SP + ((size_t)L * NBAT + b) * PBW + j] = Z[(size_t)(m0 + 15) * PIN + OFF_B + j]; }
        if (samp) {
            const float* lng = a.in[I_ALNG] + L * WA; const float* lnb = a.in[I_ALNB] + L * WA;
            for (int rr = 0; rr < 2; ++rr) { const int m = m0 + wave * 2 + rr, i = m - MP; const float* zr = Z + (size_t)m * PIN;
                for (int g = 0; g < 4; ++g) {
                    const float u0 = gelu_erf(zr[g * 128 + lane]), u1 = gelu_erf(zr[g * 128 + 64 + lane]);
                    const float v0 = gelu_erf(zr[WA + g * 128 + lane]), v1 = gelu_erf(zr[WA + g * 128 + 64 + lane]);
                    const float mean = wave_sum(v0 + v1) * (1.f / 128.f); const float d0 = v0 - mean, d1 = v1 - mean;
                    const float rstd = 1.0f / sqrtf(wave_sum(d0 * d0 + d1 * d1) * (1.f / 128.f) + LN_EPS);
                    const float n0 = d0 * rstd * lng[g * 128 + lane] + lnb[g * 128 + lane], n1 = d1 * rstd * lng[g * 128 + 64 + lane] + lnb[g * 128 + 64 + lane];
                    float* ov = a.out + O_VS + ((size_t)L * NS + i) * WA + g * 128; ov[lane] = n0; ov[64 + lane] = n1;
                    const float w00 = a.in[I_AWS][(size_t)(L * 4 + g) * 16384], b0 = a.in[I_ABS][(L * 4 + g) * 128];
                    bf16* yo = (bf16*)(ws + WS_YMIX) + (size_t)m * DM + g * 128; yo[lane] = bf1(u0 * (w00 * n0 + b0)); yo[64 + lane] = bf1(u1 * (w00 * n1 + b0)); } }
        }
    }
}

__device__ __forceinline__ void rwkv_scan_unit(const Args& a, int L, int unit, LAS unsigned char* lds, int tid, int lane, int wave) {
    unsigned char* ws = a.ws;
    const int bh = unit >> 1, half = unit & 1, b = bh / 12, h = bh - b * 12;
    const f4* rec4 = (const f4*)((const float*)(ws + WS_RPB) + (size_t)bh * SEQ * 384);
    LAS float* buf = (LAS float*)lds;
    LAS float* ybuf = (LAS float*)(lds + 49152);
    const int rowl = wave * 4 + (lane >> 4), kg = lane & 15, row = half * 32 + rowl;
    float S0 = 0.f, S1 = 0.f, S2 = 0.f, S3 = 0.f;
    f4 st0, st1, st2;
    __syncthreads();
    st0 = rec4[tid]; st1 = rec4[512 + tid]; st2 = rec4[1024 + tid];
    *(LAS f4*)(buf + 4 * tid) = st0; *(LAS f4*)(buf + 4 * (512 + tid)) = st1; *(LAS f4*)(buf + 4 * (1024 + tid)) = st2;
    __syncthreads();
    float* Y = (float*)(ws + WS_Y);
    for (int c = 0; c < SEQ / 16; ++c) {
        if (c + 1 < SEQ / 16) { const f4* nx = rec4 + (size_t)(c + 1) * 1536; st0 = nx[tid]; st1 = nx[512 + tid]; st2 = nx[1024 + tid]; }
        const LAS float* cur = buf + (c & 1) * 6144; LAS float* yb = ybuf + (c & 1) * 512;
#pragma unroll 4
        for (int s = 0; s < 16; ++s) {
            const LAS float* R = cur + s * 384;
            const f4 r4 = *(const LAS f4*)(R + 4 * kg), w4 = *(const LAS f4*)(R + 64 + 4 * kg), k4 = *(const LAS f4*)(R + 128 + 4 * kg),
                     kk4 = *(const LAS f4*)(R + 256 + 4 * kg), ka4 = *(const LAS f4*)(R + 320 + 4 * kg);
            const float v = R[192 + row];
            float sa = (S0 * kk4.x + S1 * kk4.y) + (S2 * kk4.z + S3 * kk4.w);
            sa = row16_sum(sa);
            S0 = S0 * w4.x + (v * k4.x - sa * ka4.x); S1 = S1 * w4.y + (v * k4.y - sa * ka4.y);
            S2 = S2 * w4.z + (v * k4.z - sa * ka4.z); S3 = S3 * w4.w + (v * k4.w - sa * ka4.w);
            float y = (S0 * r4.x + S1 * r4.y) + (S2 * r4.z + S3 * r4.w);
            y = row16_sum(y);
            if (kg == 0) yb[s * 32 + rowl] = y;
        }
        if (c + 1 < SEQ / 16) { LAS float* nb = buf + ((c + 1) & 1) * 6144;
            *(LAS f4*)(nb + 4 * tid) = st0; *(LAS f4*)(nb + 4 * (512 + tid)) = st1; *(LAS f4*)(nb + 4 * (1024 + tid)) = st2; }
        __syncthreads();
        { const int s = tid >> 5, rl = tid & 31; Y[((size_t)b * SEQ + c * 16 + s) * WB + h * 64 + half * 32 + rl] = yb[tid]; }
    }
    f4 so; so.x = S0; so.y = S1; so.z = S2; so.w = S3;
    *(f4*)(a.out + O_RP + ((((size_t)L * NBAT + b) * 12 + h) * 64 + row) * 64 + 4 * kg) = so;
    __syncthreads();
}
__device__ __forceinline__ void rwkv_sample_item(const Args& a, int L, int item, LAS unsigned char* lds, int lane, int wave) {
    unsigned char* ws = a.ws;
    const int ih = item * 8 + wave, i = ih / 12, h = ih - i * 12;
    const float* rec = (const float*)(ws + WS_RPS) + (size_t)ih * 384;
    LAS float* sc = (LAS float*)(lds + wave * 2048);
    const float r = rec[lane], w = rec[64 + lane], k = rec[128 + lane], v = rec[192 + lane], kk = rec[256 + lane], ka = rec[320 + lane];
    sc[lane] = r; sc[64 + lane] = w; sc[128 + lane] = k; sc[192 + lane] = kk; sc[256 + lane] = ka;
    LDS_WAIT(); asm volatile("" ::: "memory");
    const f4* S0p = (const f4*)(a.in[I_SRWKV] + (((size_t)L * NS + i) * 12 + h) * 4096 + lane * 64);
    f4 S[16];
#pragma unroll
    for (int j = 0; j < 16; ++j) S[j] = S0p[j];
    float sa = 0.f;
#pragma unroll
    for (int j = 0; j < 16; ++j) { const f4 q = *(const LAS f4*)(sc + 192 + 4 * j); sa += (S[j].x * q.x + S[j].y * q.y) + (S[j].z * q.z + S[j].w * q.w); }
    float y = 0.f;
    f4* So = (f4*)(a.out + O_RS + (((size_t)L * NS + i) * 12 + h) * 4096 + lane * 64);
#pragma unroll
    for (int j = 0; j < 16; ++j) { const f4 w4 = *(const LAS f4*)(sc + 64 + 4 * j), k4 = *(const LAS f4*)(sc + 128 + 4 * j), a4 = *(const LAS f4*)(sc + 256 + 4 * j), r4 = *(const LAS f4*)(sc + 4 * j);
        f4 n = S[j] * w4 + (k4 * v - a4 * sa); So[j] = n; y += (n.x * r4.x + n.y * r4.y) + (n.z * r4.z + n.w * r4.w); }
    ((float*)(ws + WS_Y))[(size_t)(MP + i) * WB + h * 64 + lane] = y;
    LDS_WAIT(); asm volatile("" ::: "memory");
}
__device__ __forceinline__ void hgrn_sample_item(const Args& a, int L, int item, LAS unsigned char* lds, int lane, int wave) {
    unsigned char* ws = a.ws;
    const int ih = item * 4 + (wave >> 1), i = ih / 6, h = ih - i * 6, vcol = (wave & 1) * 64 + lane, m = MP + i;
    const float* zc = (const float*)(ws + WS_Z) + (size_t)m * PIN + OFF_C + h * 128;
    LAS float* sc = (LAS float*)(lds + wave * 2048);
#pragma unroll
    for (int t = 0; t < 2; ++t) { const int k = lane + 64 * t; const float lb = lbound(a.in[I_CLB], L, h * 128 + k); const float fz = zc[WC + k];
        const float sg = sigmoidf_(fz); sc[k] = lb + (1.0f - lb) * sg; sc[128 + k] = (1.0f - lb) * (1.0f - sg) ; sc[256 + k] = zc[k]; }
    const float iv = zc[2 * WC + vcol];
    LDS_WAIT(); asm volatile("" ::: "memory");
    const float* S0 = a.in[I_SHGRN] + (((size_t)L * NS + i) * 6 + h) * 16384 + vcol;
    float* So = a.out + O_HS + (((size_t)L * NS + i) * 6 + h) * 16384 + vcol;
    float o = 0.f;
#pragma unroll 8
    for (int k = 0; k < 128; ++k) { const float n = sc[k] * S0[(size_t)k * 128] + sc[128 + k] * iv; So[(size_t)k * 128] = n; o += n * sc[256 + k]; }
    ((float*)(ws + WS_O))[(size_t)m * WC + h * 128 + vcol] = o;
    LDS_WAIT(); asm volatile("" ::: "memory");
}
__device__ __forceinline__ void sgu_item(const Args& a, int L, int item, LAS unsigned char* lds, int tid, int lane, int wave) {
    unsigned char* ws = a.ws;
    const int g = item & 3, bc = item >> 2, m0 = bc * 128;
    const float* Z = (const float*)(ws + WS_Z);
    LAS float* vn = (LAS float*)lds;
    LAS float* wt = (LAS float*)(lds + 65536);
    const float* wsrc = a.in[I_AWS] + (size_t)(L * 4 + g) * 16384;
    __syncthreads();
    for (int e = tid; e < 16384; e += NTHR) { const int t = e >> 7, s = e & 127; wt[s * 128 + t] = (s <= t) ? wsrc[e] : 0.f; }
    const float* lng = a.in[I_ALNG] + L * WA + g * 128; const float* lnb = a.in[I_ALNB] + L * WA + g * 128;
    for (int rr = 0; rr < 16; ++rr) { const int t = wave * 16 + rr; const float* zr = Z + (size_t)(m0 + t) * PIN + WA + g * 128;
        const float v0 = gelu_erf(zr[lane]), v1 = gelu_erf(zr[64 + lane]);
        const float mean = wave_sum(v0 + v1) * (1.f / 128.f); const float d0 = v0 - mean, d1 = v1 - mean;
        const float rstd = 1.0f / sqrtf(wave_sum(d0 * d0 + d1 * d1) * (1.f / 128.f) + LN_EPS);
        vn[t * 128 + lane] = d0 * rstd * lng[lane] + lnb[lane]; vn[t * 128 + 64 + lane] = d1 * rstd * lng[64 + lane] + lnb[64 + lane]; }
    __syncthreads();
    const int t = tid >> 2, dq = tid & 3, send = (wave * 16 + 15);
    f4 acc[8];
#pragma unroll
    for (int j = 0; j < 8; ++j) acc[j] = (f4){0.f, 0.f, 0.f, 0.f};
    for (int s = 0; s <= send; ++s) { const float w = wt[s * 128 + t]; const LAS f4* vr = (const LAS f4*)(vn + s * 128 + dq * 32);
#pragma unroll
        for (int j = 0; j < 8; ++j) acc[j] += vr[j] * w; }
    const float bs = a.in[I_ABS][(L * 4 + g) * 128 + t];
    const float* ur = Z + (size_t)(m0 + t) * PIN + g * 128 + dq * 32;
    bf16* yo = (bf16*)(ws + WS_YMIX) + (size_t)(m0 + t) * DM + g * 128 + dq * 32;
#pragma unroll
    for (int j = 0; j < 4; ++j) { const f4 u0 = *(const f4*)(ur + 8 * j), u1 = *(const f4*)(ur + 8 * j + 4); const f4 x0 = acc[2 * j] + bs, x1 = acc[2 * j + 1] + bs; v4u o;
        o.x = pg8::cvt_pk_bf16(gelu_erf(u0.x) * x0.x, gelu_erf(u0.y) * x0.y); o.y = pg8::cvt_pk_bf16(gelu_erf(u0.z) * x0.z, gelu_erf(u0.w) * x0.w);
        o.z = pg8::cvt_pk_bf16(gelu_erf(u1.x) * x1.x, gelu_erf(u1.y) * x1.y); o.w = pg8::cvt_pk_bf16(gelu_erf(u1.z) * x1.z, gelu_erf(u1.w) * x1.w);
        *(v4u*)(yo + 8 * j) = o; }
}

__device__ __forceinline__ void hgrn_seq_unit(const Args& a, int L, int unit, LAS unsigned char* lds, int tid, int lane, int wave) {
    unsigned char* ws = a.ws;
    const int b = unit / 6, h = unit - b * 6;
    const float* Z = (const float*)(ws + WS_Z);
    LAS bf16* qs = (LAS bf16*)(lds);
    LAS bf16* ks = (LAS bf16*)(lds + 4352);
    LAS bf16* vt = (LAS bf16*)(lds + 8704);
    LAS bf16* kht = (LAS bf16*)(lds + 12800);
    LAS float* ev = (LAS float*)(lds + 16896);
    LAS float* part = (LAS float*)(lds + 17408);
    const int ch = tid & 127, tq = tid >> 7;
    const float lb = lbound(a.in[I_CLB], L, h * 128 + ch), loglb = logf(lb), oml = 1.0f - lb;
    const int pch = (ch & ~31) | (((ch >> 2) & 3) << 3) | (((ch >> 4) & 1) << 2) | (ch & 3);
    const int x = lane & 15, quad = lane >> 4;
    pg8::f32x4 Sacc[8];
#pragma unroll
    for (int mt = 0; mt < 8; ++mt) Sacc[mt] = (pg8::f32x4){0.f, 0.f, 0.f, 0.f};
    const float* zb = Z + (size_t)(b * SEQ + 4 * tq) * PIN + OFF_C + h * 128 + ch;
    float qn[4], fn[4], vn_[4];
#pragma unroll
    for (int j = 0; j < 4; ++j) { const float* p = zb + (size_t)j * PIN; qn[j] = p[0]; fn[j] = p[WC]; vn_[j] = p[2 * WC]; }
    float* O = (float*)(ws + WS_O);
    __syncthreads();
    for (int st = 0; st < SEQ / 16; ++st) {
        float q[4], fz[4], iv[4];
#pragma unroll
        for (int j = 0; j < 4; ++j) { q[j] = qn[j]; fz[j] = fn[j]; iv[j] = vn_[j]; }
        if (st + 1 < SEQ / 16) {
#pragma unroll
            for (int j = 0; j < 4; ++j) { const float* p = zb + (size_t)((st + 1) * 16 + j) * PIN; qn[j] = p[0]; fn[j] = p[WC]; vn_[j] = p[2 * WC]; } }
        float bl[4], kv[4]; float run = 0.f;
#pragma unroll
        for (int j = 0; j < 4; ++j) { const float A = log_sigmoid(fz[j]), Bv = loglb + log_sigmoid(-fz[j]); const float mx = fmaxf(A, Bv), d = -fabsf(A - Bv);
            run += mx + log1pf(expf(d)); bl[j] = run; kv[j] = oml * sigmoidf_(-fz[j]); }
        part[tq * 128 + ch] = run;
        __syncthreads();
        const float p0 = part[ch], p1 = part[128 + ch], p2 = part[256 + ch], p3 = part[384 + ch];
        const float tot = (p0 + p1) + (p2 + p3); const float pre = (tq > 0 ? p0 : 0.f) + (tq > 1 ? p1 : 0.f) + (tq > 2 ? p2 : 0.f);
#pragma unroll
        for (int j = 0; j < 4; ++j) { const float bj = pre + bl[j]; const int t = 4 * tq + j;
            qs[t * 136 + pch] = bf1(q[j] * expf(bj)); ks[t * 136 + pch] = bf1(kv[j] * expf(fminf(-bj, 60.f)));
            kht[ch * 16 + t] = bf1(kv[j] * expf(tot - bj)); vt[ch * 16 + t] = bf1(iv[j]); }
        if (tq == 0) ev[ch] = expf(tot);
        __syncthreads();
        bf16x8 qf[4], kf[4];
#pragma unroll
        for (int kt = 0; kt < 4; ++kt) { qf[kt] = *(const LAS bf16x8*)(qs + x * 136 + 32 * kt + 8 * quad); kf[kt] = *(const LAS bf16x8*)(ks + x * 136 + 32 * kt + 8 * quad); }
        pg8::f32x4 att = (pg8::f32x4){0.f, 0.f, 0.f, 0.f};
#pragma unroll
        for (int kt = 0; kt < 4; ++kt) att = __builtin_amdgcn_mfma_f32_16x16x32_bf16(kf[kt], qf[kt], att, 0, 0, 0);
#pragma unroll
        for (int i = 0; i < 4; ++i) if (4 * quad + i > x) att[i] = 0.f;
        v4u pbu; pbu.x = pg8::cvt_pk_bf16(att[0], att[1]); pbu.y = pg8::cvt_pk_bf16(att[2], att[3]); pbu.z = 0u; pbu.w = 0u;
        const bf16x8 pb = __builtin_bit_cast(bf16x8, pbu);
        const u2 vv = *(const LAS u2*)(vt + (16 * wave + x) * 16 + 4 * quad);
        v4u vfu; vfu.x = vv.x; vfu.y = vv.y; vfu.z = 0u; vfu.w = 0u; const bf16x8 vf = __builtin_bit_cast(bf16x8, vfu);
        pg8::f32x4 o = (pg8::f32x4){0.f, 0.f, 0.f, 0.f};
#pragma unroll
        for (int kt = 0; kt < 4; ++kt) { v4u su; su.x = pg8::cvt_pk_bf16(Sacc[2 * kt][0], Sacc[2 * kt][1]); su.y = pg8::cvt_pk_bf16(Sacc[2 * kt][2], Sacc[2 * kt][3]);
            su.z = pg8::cvt_pk_bf16(Sacc[2 * kt + 1][0], Sacc[2 * kt + 1][1]); su.w = pg8::cvt_pk_bf16(Sacc[2 * kt + 1][2], Sacc[2 * kt + 1][3]);
            o = __builtin_amdgcn_mfma_f32_16x16x32_bf16(__builtin_bit_cast(bf16x8, su), qf[kt], o, 0, 0, 0); }
        o = __builtin_amdgcn_mfma_f32_16x16x32_bf16(vf, pb, o, 0, 0, 0);
        *(pg8::f32x4*)(O + (size_t)(b * SEQ + st * 16 + x) * WC + h * 128 + 16 * wave + 4 * quad) = o;
#pragma unroll
        for (int mt = 0; mt < 8; ++mt) { const pg8::f32x4 e4 = *(const LAS pg8::f32x4*)(ev + 16 * mt + 4 * quad);
            const u2 kk2 = *(const LAS u2*)(kht + (16 * mt + x) * 16 + 4 * quad); v4u ku; ku.x = kk2.x; ku.y = kk2.y; ku.z = 0u; ku.w = 0u;
            Sacc[mt] = __builtin_amdgcn_mfma_f32_16x16x32_bf16(__builtin_bit_cast(bf16x8, ku), vf, Sacc[mt] * e4, 0, 0, 0); }
    }
    float* So = a.out + O_HP + (((size_t)L * NBAT + b) * 6 + h) * 16384;
#pragma unroll
    for (int mt = 0; mt < 8; ++mt)
#pragma unroll
        for (int i = 0; i < 4; ++i) So[(size_t)(16 * mt + 4 * quad + i) * 128 + 16 * wave + x] = Sacc[mt][i];
    __syncthreads();
}

__device__ __forceinline__ void phase_post(const Args& a, int L, int lane, int wave, int blk, int G) {
    unsigned char* ws = a.ws; const int gw = blk * NWAVES + wave, NGW = G * NWAVES;
    const float* Y = (const float*)(ws + WS_Y); const float* O = (const float*)(ws + WS_O); const float* Gt = (const float*)(ws + WS_G); const float* Z = (const float*)(ws + WS_Z);
    const float* gng = a.in[I_BGNG] + L * WB; const float* gnb = a.in[I_BGNB] + L * WB; const float* rk = a.in[I_BRK] + L * WB; const float* cng = a.in[I_CNG] + L * WC;
    for (int m = gw; m < MV; m += NGW) {
        bf16* yo = (bf16*)(ws + WS_YMIX) + (size_t)m * DM;
#pragma unroll
        for (int j = 0; j < 12; ++j) { const int c = 64 * j + lane; const float y = Y[(size_t)m * WB + c];
            const float mean = wave_sum(y) * (1.f / 64.f); const float d = y - mean; const float rstd = 1.0f / sqrtf(wave_sum(d * d) * (1.f / 64.f) + GN_EPS);
            const float* rec = (m < MP) ? (const float*)(ws + WS_RPB) + (((size_t)(m >> 11) * 12 + j) * SEQ + (m & (SEQ - 1))) * 384 : (const float*)(ws + WS_RPS) + ((size_t)(m - MP) * 12 + j) * 384;
            const float r = rec[lane], kp = rec[128 + lane], v = rec[192 + lane];
            const float bonus = wave_sum(r * kp * rk[c]);
            yo[WA + c] = bf1((d * rstd * gng[c] + gnb[c] + bonus * v) * Gt[(size_t)m * WB + c]); }
        float ov[12]; float ss = 0.f;
#pragma unroll
        for (int j = 0; j < 12; ++j) { ov[j] = O[(size_t)m * WC + 64 * j + lane]; ss += ov[j] * ov[j]; }
        const float rms = 1.0f / sqrtf(wave_sum(ss) * (1.f / WC) + RMS_EPS);
#pragma unroll
        for (int j = 0; j < 12; ++j) { const int c = 64 * j + lane; const float gz = Z[(size_t)m * PIN + OFF_C + 3 * WC + c];
            yo[WA + WB + c] = bf1(ov[j] * rms * cng[c] * (gz * sigmoidf_(gz))); }
    }
}

#ifndef EN_PRO
#define EN_PRO 1
#endif
#ifndef EN_G1
#define EN_G1 1
#endif
#ifndef EN_PREP
#define EN_PREP 1
#endif
#ifndef EN_MIX
#define EN_MIX 1
#endif
#ifndef EN_POST
#define EN_POST 1
#endif
#ifndef EN_G3
#define EN_G3 1
#endif
#ifndef EN_LN
#define EN_LN 1
#endif
#ifndef EN_G4
#define EN_G4 1
#endif
#ifndef EN_G5
#define EN_G5 1
#endif
#ifndef MK_SINGLE
#define MK_SINGLE 1
#endif
constexpr int N_PHASES = 1 + 9 * DEPTH;
constexpr int SCAN_UNITS = NBAT * 12 * 2, HSEQ_UNITS = NBAT * 6, ROLE_BLOCKS = SCAN_UNITS + HSEQ_UNITS;
constexpr int N_SGU = NBAT * 16 * 4, N_RS = NS * 12 / 8, N_HS = NS * 6 / 4, N_MISC = N_SGU + N_RS + N_HS;

__global__ void __launch_bounds__(NTHR, 2) mk_fwd(Args a) {
    extern __shared__ __attribute__((aligned(16))) unsigned char lds_raw[];
    LAS unsigned char* lds = (LAS unsigned char*)lds_raw;
    const int tid = threadIdx.x, lane = tid & 63, wave = __builtin_amdgcn_readfirstlane(tid >> 6), blk = blockIdx.x, G = gridDim.x;
    unsigned char* ws = a.ws;
    volatile LAS unsigned* MISC = (volatile LAS unsigned*)(lds + MISC_OFF);
    for (int u = tid; u < (LDS_BYTES - LDSCTL_OFF) / 4; u += NTHR) ((LAS unsigned*)(lds + LDSCTL_OFF))[u] = 0u;
    __syncthreads();
    const int lo = a.ph_lo, hi = a.ph_hi;
    XcdBarrier bar; bar.bar = (unsigned*)(ws + WS_CTL) + CW_BAR; bar.x = 0; bar.st = nullptr;
    if (hi - lo > 1) bar = xcd_barrier_post((unsigned*)(ws + WS_CTL) + CW_BAR, MISC + 8);
#define IN(k) (lo <= (k) && (k) < hi)
#define SEAM(k) do { if (IN(k) && IN((k) + 1)) { xcd_barrier(bar); } } while (0)
    bf16* HB = (bf16*)(ws + WS_HB); float* H = (float*)(ws + WS_H); float* T = (float*)(ws + WS_T);

    #if EN_PRO
    if (IN(0)) phase_prologue(a, lds, lane, wave, blk, G);
#endif
    SEAM(0);
    for (int L = 0; L < DEPTH; ++L) {
        const int pb = 1 + 9 * L;
#define LAUNDER() int tid_ = threadIdx.x; asm volatile("" : "+v"(tid_)); const int lane_ = tid_ & 63; const int wave_ = __builtin_amdgcn_readfirstlane(tid_ >> 6)
#if EN_G1
        if (IN(pb)) {
            { pg8::Gemm g{HB, (const bf16*)(ws + WS_WIN + L * SZ_WIN), MPAD, PIN, DM}; pg8::StaticOrder S; S.init(MPAD, PIN, G, blk);
              pg8::EpiF32 E{(float*)(ws + WS_Z), PIN}; pg8::gemm_phase<pg8::EpiF32, pg8::StaticOrder, true, true>(lds, g, S, E); }
            { pg8::Gemm g{(const bf16*)(ws + WS_PBF + L * SZ_PBF), (const bf16*)(ws + WS_WPP + L * SZ_WPP), MPAD, DM, DPLE}; pg8::StaticOrder S; S.init(MPAD, DM, G, G - 1 - blk);
              pg8::EpiF32 E{(float*)(ws + WS_PPO), DM}; pg8::gemm_phase<pg8::EpiF32, pg8::StaticOrder, true, true>(lds, g, S, E); }
        }
#endif
        SEAM(pb);
#if EN_PREP
        if (IN(pb + 1)) { LAUNDER(); phase_prep(a, L, lds, tid_, lane_, wave_, blk, G); }
#endif
        SEAM(pb + 1);
#if EN_MIX
        if (IN(pb + 2)) {
            LAUNDER(); const int tid = tid_, lane = lane_, wave = wave_;
            if (blk < SCAN_UNITS) rwkv_scan_unit(a, L, blk, lds, tid, lane, wave);
            else if (blk < ROLE_BLOCKS) hgrn_seq_unit(a, L, blk - SCAN_UNITS, lds, tid, lane, wave);
            else for (int it = blk - ROLE_BLOCKS; it < N_MISC; it += G - ROLE_BLOCKS) {
                if (it < N_SGU) sgu_item(a, L, it, lds, tid, lane, wave);
                else if (it < N_SGU + N_RS) rwkv_sample_item(a, L, it - N_SGU, lds, lane, wave);
                else hgrn_sample_item(a, L, it - N_SGU - N_RS, lds, lane, wave);
                __syncthreads();
            }
        }
#endif
        SEAM(pb + 2);
#if EN_POST
        if (IN(pb + 3)) { LAUNDER(); phase_post(a, L, lane_, wave_, blk, G); }
#endif
        SEAM(pb + 3);
#if EN_G3
        if (IN(pb + 4)) {
            pg8::Gemm g{(const bf16*)(ws + WS_YMIX), (const bf16*)(ws + WS_WOUT + L * SZ_WOUT), MPAD, DM, DM}; pg8::StaticOrder S; S.init(MPAD, DM, G, blk);
            pg8::EpiResid E{T, H, nullptr, DM, DN_ALPHA}; pg8::gemm_phase<pg8::EpiResid, pg8::StaticOrder, true, true>(lds, g, S, E);
        }
#endif
        SEAM(pb + 4);
#if EN_LN
        if (IN(pb + 5)) { LAUNDER(); phase_ln(a, a.in[I_LN1G] + L * DM, a.in[I_LN1B] + L * DM, false, lane_, wave_, blk, G); }
#endif
        SEAM(pb + 5);
#if EN_G4
        if (IN(pb + 6)) {
            { pg8::Gemm g{HB, (const bf16*)(ws + WS_WGU + L * SZ_WGU), MPAD, 2 * DFF, DM}; pg8::StaticOrder S; S.init(MPAD, 2 * DFF, G, blk);
              pg8::EpiSwiglu E{(bf16*)(ws + WS_ACT), DFF}; pg8::gemm_phase<pg8::EpiSwiglu, pg8::StaticOrder, true, true>(lds, g, S, E); }
            { pg8::Gemm g{HB, (const bf16*)(ws + WS_WPG + L * SZ_WPG), MPAD, DM, DM}; pg8::StaticOrder S; S.init(MPAD, DM, G, G - 1 - blk);
              pg8::EpiSigMul E{(float*)(ws + WS_PLE), (const float*)(ws + WS_PPO), DM}; pg8::gemm_phase<pg8::EpiSigMul, pg8::StaticOrder, true, true>(lds, g, S, E); }
        }
#endif
        SEAM(pb + 6);
#if EN_G5
        if (IN(pb + 7)) {
            pg8::Gemm g{(const bf16*)(ws + WS_ACT), (const bf16*)(ws + WS_WD + L * SZ_WD), MPAD, DM, DFF}; pg8::StaticOrder S; S.init(MPAD, DM, G, blk);
            pg8::EpiResid E{T, H, (const float*)(ws + WS_PLE), DM, DN_ALPHA}; pg8::gemm_phase<pg8::EpiResid, pg8::StaticOrder, true, true>(lds, g, S, E);
        }
#endif
        SEAM(pb + 7);
#if EN_LN
        if (IN(pb + 8)) { LAUNDER(); phase_ln(a, a.in[I_LN2G] + L * DM, a.in[I_LN2B] + L * DM, L == DEPTH - 1, lane_, wave_, blk, G); }
#endif
        SEAM(pb + 8);
    }
#undef IN
#undef SEAM
}

extern "C" void kernel_launch(void* const* d_in, const int* in_sizes, int n_in, void* d_out, int out_size, void* d_ws, size_t ws_size, hipStream_t stream) {
    static int grid = 0;
    if (grid == 0) {
        if (n_in != N_IN || (size_t)out_size != O_END || ws_size < WS_END) { fprintf(stderr, "kernel_launch: unexpected sizes n_in %d out %d ws %zu (need %zu)\n", n_in, out_size, ws_size, (size_t)WS_END); grid = -1; return; }
        int dev = 0, cus = 0, per_cu = 0;
        if (hipGetDevice(&dev) != hipSuccess || hipDeviceGetAttribute(&cus, hipDeviceAttributeMultiprocessorCount, dev) != hipSuccess) { grid = -1; return; }
        if (hipFuncSetAttribute((const void*)mk_fwd, hipFuncAttributeMaxDynamicSharedMemorySize, LDS_BYTES) != hipSuccess) { fprintf(stderr, "kernel_launch: hipFuncSetAttribute failed\n"); grid = -1; return; }
        if (hipOccupancyMaxActiveBlocksPerMultiprocessor(&per_cu, (const void*)mk_fwd, NTHR, LDS_BYTES) != hipSuccess || per_cu < 1) fprintf(stderr, "kernel_launch: occupancy query says %d\n", per_cu);
        (void)hipGetLastError();
        grid = cus;
        if (grid < ROLE_BLOCKS + 8) { fprintf(stderr, "kernel_launch: %d CUs is too few\n", grid); grid = -1; return; }
    }
    if (grid < 0) return;
    if (hipMemsetAsync((char*)d_ws + WS_CTL, 0, CTL_ZERO_BYTES, stream) != hipSuccess) return;
    Args a{};
    for (int i = 0; i < N_IN; ++i) a.in[i] = (const float*)d_in[i];
    a.out = (float*)d_out; a.ws = (unsigned char*)d_ws;
#if MK_SINGLE
    a.ph_lo = 0; a.ph_hi = N_PHASES;
    hipLaunchKernelGGL(mk_fwd, dim3(grid), dim3(NTHR), LDS_BYTES, stream, a);
#else
    for (int p = 0; p < N_PHASES; ++p) { a.ph_lo = p; a.ph_hi = p + 1; hipLaunchKernelGGL(mk_fwd, dim3(grid), dim3(NTHR), LDS_BYTES, stream, a); }
#endif
}
```

```cpp
#include <hip/hip_runtime.h>
#include <cstdio>
#include <cstdint>
namespace pg8 {
#define PG8_LAS __attribute__((address_space(3)))
typedef unsigned short bf16_t;
typedef short bf16x8 __attribute__((ext_vector_type(8)));
typedef float f32x4 __attribute__((ext_vector_type(4)));
typedef unsigned u32x4 __attribute__((ext_vector_type(4)));
constexpr int BM = 256, BK = 64, HALF = 128, HTB = HALF * BK * 2  , STAGE_BYTES = 8 * HTB, NXCD = 8, WGM = 8;

__host__ __device__ __forceinline__ int lds_byte(int r, int c) { const int st = (r >> 4) * 2 + (c >> 5), rr = r & 15, cc = c & 31, ob = rr * 64 + cc * 2; return st * 1024 + (ob ^ (((ob >> 9) & 1) << 5)); }
__host__ __device__ __forceinline__ void stage_rc(int b, int& R, int& C) { const int st = b / 1024, sb = b % 1024, swz = sb ^ (((sb >> 9) & 1) << 5); R = (st >> 1) * 16 + swz / 64; C = (st & 1) * 32 + (swz % 64) / 2; }
__host__ __device__ __forceinline__ int perm32(int rho) { const int n = rho >> 4, i = rho & 15; return 8 * (i >> 2) + 4 * n + (i & 3); }

struct Unit { int pm, pn; };
struct Gemm { const bf16_t* A; const bf16_t* Bt; int M, N, K; };

struct StaticOrder {
    int nM, nN, nwg, G, c;
    __host__ __device__ void init(int M, int N, int G_, int c_) { nM = M / BM; nN = N / BM; nwg = nM * nN; G = G_; c = c_; }
    __host__ __device__ bool next(int i, Unit& u) const {
        const long L = (long)i * G + c; if (L >= nwg) return false;
        int wgid = (int)L; { const int q = nwg / NXCD, r = nwg % NXCD, xcd = wgid % NXCD, off = wgid / NXCD; wgid = (xcd < r ? xcd * (q + 1) : r * (q + 1) + (xcd - r) * q) + off; }
        const int nig = WGM * nN, gid = wgid / nig, fm = gid * WGM, gsz = (nM - fm) < WGM ? (nM - fm) : WGM;
        u.pm = fm + ((wgid % nig) % gsz); u.pn = (wgid % nig) / gsz; return true;
    }
    __device__ __forceinline__ void a_ready(const Unit&) const {}
    __device__ __forceinline__ void done(const Unit&) const {}
};

__device__ __forceinline__ unsigned cvt_pk_bf16(float lo, float hi) { unsigned r; asm volatile("v_cvt_pk_bf16_f32 %0, %1, %2" : "=v"(r) : "v"(lo), "v"(hi)); return r; }
typedef float f32x2 __attribute__((ext_vector_type(2)));
struct EpiF32 {
    static constexpr bool PERM = false, AFTER_DRAIN = false;
    float* C; int ldc;
    __device__ __forceinline__ void operator()(const f32x4 (&acc)[2][2][4][2], const Unit& u, int wr, int wc, int fr, int fq) const {
        const int row0 = u.pm * BM + wr * 64 + fr, col0 = u.pn * BM + wc * 32 + 4 * fq;
#pragma unroll
        for (int ai = 0; ai < 2; ++ai)
#pragma unroll
            for (int m = 0; m < 4; ++m) { float* rowp = C + (size_t)(row0 + ai * HALF + m * 16) * ldc + col0;
#pragma unroll
                for (int bj = 0; bj < 2; ++bj)
#pragma unroll
                    for (int n = 0; n < 2; ++n) *(f32x4*)(rowp + bj * HALF + n * 16) = acc[ai][bj][m][n]; }
    }
};
struct EpiResid {
    static constexpr bool PERM = false, AFTER_DRAIN = false;
    float* out; const float* base; const float* add; int ldc; float alpha;
    __device__ __forceinline__ void operator()(const f32x4 (&acc)[2][2][4][2], const Unit& u, int wr, int wc, int fr, int fq) const {
        const int row0 = u.pm * BM + wr * 64 + fr, col0 = u.pn * BM + wc * 32 + 4 * fq;
#pragma unroll
        for (int ai = 0; ai < 2; ++ai)
#pragma unroll
            for (int m = 0; m < 4; ++m) { const size_t off = (size_t)(row0 + ai * HALF + m * 16) * ldc + col0;
#pragma unroll
                for (int bj = 0; bj < 2; ++bj)
#pragma unroll
                    for (int n = 0; n < 2; ++n) { const size_t o2 = off + bj * HALF + n * 16; f32x4 v = *(const f32x4*)(base + o2) * alpha + acc[ai][bj][m][n];
                        if (add) v += *(const f32x4*)(add + o2); *(f32x4*)(out + o2) = v; } }
    }
};
struct EpiSigMul {
    static constexpr bool PERM = false, AFTER_DRAIN = false;
    float* out; const float* mul; int ldc;
    __device__ __forceinline__ void operator()(const f32x4 (&acc)[2][2][4][2], const Unit& u, int wr, int wc, int fr, int fq) const {
        const int row0 = u.pm * BM + wr * 64 + fr, col0 = u.pn * BM + wc * 32 + 4 * fq;
#pragma unroll
        for (int ai = 0; ai < 2; ++ai)
#pragma unroll
            for (int m = 0; m < 4; ++m) { const size_t off = (size_t)(row0 + ai * HALF + m * 16) * ldc + col0;
#pragma unroll
                for (int bj = 0; bj < 2; ++bj)
#pragma unroll
                    for (int n = 0; n < 2; ++n) { const size_t o2 = off + bj * HALF + n * 16; const f32x4 x = acc[ai][bj][m][n]; const f32x4 p = *(const f32x4*)(mul + o2); f32x4 v;
#pragma unroll
                        for (int e = 0; e < 4; ++e) v[e] = p[e] * __builtin_amdgcn_rcpf(1.0f + __expf(-x[e]));
                        *(f32x4*)(out + o2) = v; } }
    }
};
struct EpiSwiglu {
    static constexpr bool PERM = true, AFTER_DRAIN = false;
    bf16_t* O; int ldo;
    __device__ __forceinline__ void operator()(const f32x4 (&acc)[2][2][4][2], const Unit& u, int wr, int wc, int fr, int fq) const {
        const int row0 = u.pm * BM + wr * 64 + fr, col0 = u.pn * HALF + wc * 32 + 8 * fq;
#pragma unroll
        for (int ai = 0; ai < 2; ++ai)
#pragma unroll
            for (int m = 0; m < 4; ++m) { bf16_t* rowp = O + (size_t)(row0 + ai * HALF + m * 16) * ldo + col0; float r[8];
#pragma unroll
                for (int n = 0; n < 2; ++n)
#pragma unroll
                    for (int e = 0; e < 4; ++e) { const float g = acc[ai][0][m][n][e], up = acc[ai][1][m][n][e]; r[4 * n + e] = g * __builtin_amdgcn_rcpf(1.0f + __expf(-g)) * up; }
                u32x4 w; w.x = cvt_pk_bf16(r[0], r[1]); w.y = cvt_pk_bf16(r[2], r[3]); w.z = cvt_pk_bf16(r[4], r[5]); w.w = cvt_pk_bf16(r[6], r[7]);
                *(u32x4*)rowp = w; }
    }
};
template <class Epi, class Sched, bool ALIGN_EPI = false, bool SP2 = false>
__device__ __forceinline__ void gemm_phase(PG8_LAS unsigned char* lds, const Gemm g, const Sched& S, const Epi& E) {
    int tid_l = threadIdx.x; asm volatile("" : "+v"(tid_l));
    const int tid = tid_l, wid = __builtin_amdgcn_readfirstlane(tid >> 6), lane = tid & 63, wr = wid >> 2, wc = wid & 3, fr = lane & 15, fq = lane >> 4;
    const int K = g.K, nt = K / BK;
    unsigned voffA[2], voffB[2];
#pragma unroll
    for (int i = 0; i < 2; ++i) { int R, C; stage_rc(tid * 16 + i * 8192, R, C); const int Rb = Epi::PERM ? ((R & ~31) + perm32(R & 31)) : R;
        voffA[i] = (unsigned)(R * K + C) * 2u; voffB[i] = (unsigned)(Rb * K + C) * 2u; }
    const size_t kstep = (size_t)(BK * 2);
    const size_t hstep = (size_t)HALF * K * 2;
    const size_t tstep = 2 * hstep;
    const unsigned ldsw = (unsigned)wid * 1024u;
    const int aoff = lds_byte(wr * 64 + fr, fq * 8), boff = lds_byte(wc * 32 + fr, fq * 8);
#define PG8_SA(b, h) (((b) * 2 + (h)) * HTB)
#define PG8_SB(b, h) ((4 + (b) * 2 + (h)) * HTB)
#define PG8_STAGE(bufoff, gbase, voff) do { _Pragma("unroll") for (int _i = 0; _i < 2; ++_i) \
        __builtin_amdgcn_global_load_lds((const unsigned*)((const char*)(gbase) + (voff)[_i]), (PG8_LAS unsigned*)(lds + (bufoff) + ldsw + _i * 8192), 16, 0, 0); } while (0)
#define PG8_LDA(dst, b, h) do { _Pragma("unroll") for (int m = 0; m < 4; ++m) _Pragma("unroll") for (int k = 0; k < 2; ++k) dst[m][k] = *(const PG8_LAS bf16x8*)(lds + PG8_SA(b, h) + aoff + m * 2048 + k * 1024); } while (0)
#define PG8_LDB(dst, b, h) do { _Pragma("unroll") for (int n = 0; n < 2; ++n) _Pragma("unroll") for (int k = 0; k < 2; ++k) dst[n][k] = *(const PG8_LAS bf16x8*)(lds + PG8_SB(b, h) + boff + n * 2048 + k * 1024); } while (0)
#define PG8_MMA(ai, bj, At, Bt) do { __builtin_amdgcn_s_setprio(1); _Pragma("unroll") for (int m = 0; m < 4; ++m) _Pragma("unroll") for (int n = 0; n < 2; ++n) _Pragma("unroll") for (int k = 0; k < 2; ++k) \
        acc[ai][bj][m][n] = __builtin_amdgcn_mfma_f32_16x16x32_bf16(Bt[n][k], At[m][k], acc[ai][bj][m][n], 0, 0, 0); __builtin_amdgcn_s_setprio(0); } while (0)
#define PG8_WAIT_V(n) asm volatile("s_waitcnt vmcnt(" #n ")" ::: "memory")
#define PG8_WAIT_L(n) asm volatile("s_waitcnt lgkmcnt(" #n ")" ::: "memory")
#define PG8_BAR __builtin_amdgcn_s_barrier()
#define PG8_SCHED __builtin_amdgcn_sched_barrier(0)
    Unit cur, nxt; int ui = 0;
    if (!S.next(0, cur)) return;
    f32x4 acc[2][2][4][2];
#pragma unroll
    for (int a = 0; a < 2; ++a)
#pragma unroll
        for (int b = 0; b < 2; ++b)
#pragma unroll
            for (int m = 0; m < 4; ++m)
#pragma unroll
                for (int n = 0; n < 2; ++n) acc[a][b][m][n] = (f32x4){0.f, 0.f, 0.f, 0.f};
    bf16x8 At[4][2], B0[2][2], B1[2][2];
    const char* cA = (const char*)g.A + (size_t)cur.pm * tstep; const char* cB = (const char*)g.Bt + (size_t)cur.pn * tstep;
    S.a_ready(cur);
    if constexpr (SP2) {
        PG8_STAGE(PG8_SB(0, 0), cB, voffB); PG8_STAGE(PG8_SB(0, 1), cB + hstep, voffB); PG8_STAGE(PG8_SA(0, 0), cA, voffA); PG8_STAGE(PG8_SA(0, 1), cA + hstep, voffA);
        if (wr == 1) PG8_BAR;
        PG8_WAIT_V(2); PG8_BAR;
        PG8_STAGE(PG8_SB(1, 0), cB + kstep, voffB); PG8_STAGE(PG8_SA(1, 0), cA + kstep, voffA); PG8_STAGE(PG8_SB(1, 1), cB + hstep + kstep, voffB);
        PG8_WAIT_V(6); PG8_BAR;
    } else {
        PG8_STAGE(PG8_SB(0, 0), cB, voffB); PG8_STAGE(PG8_SA(0, 0), cA, voffA); PG8_STAGE(PG8_SB(0, 1), cB + hstep, voffB); PG8_STAGE(PG8_SA(0, 1), cA + hstep, voffA);
        if (wr == 1) PG8_BAR;
        PG8_WAIT_V(4); PG8_BAR;
        PG8_STAGE(PG8_SB(1, 0), cB + kstep, voffB); PG8_STAGE(PG8_SA(1, 0), cA + kstep, voffA); PG8_STAGE(PG8_SB(1, 1), cB + hstep + kstep, voffB);
        PG8_WAIT_V(6); PG8_BAR;
    }
    for (;;) {
        const bool has_next = S.next(ui + 1, nxt);
        const char* nA = has_next ? (const char*)g.A + (size_t)nxt.pm * tstep : cA; const char* nB = has_next ? (const char*)g.Bt + (size_t)nxt.pn * tstep : cB;
        for (int t = 0; t < nt; t += 2) {
            const bool last = (t == nt - 2);
            const char* a1 = cA + (size_t)(t + 1) * kstep;
            const char* a2 = last ? nA : cA + (size_t)(t + 2) * kstep; const char* b2 = last ? nB : cB + (size_t)(t + 2) * kstep;
            const char* a3 = a2 + kstep; const char* b3 = b2 + kstep;
            if (last && has_next) S.a_ready(nxt);
            if constexpr (SP2) {
            PG8_LDB(B0, 0, 0); PG8_LDB(B1, 0, 1); PG8_SCHED; PG8_LDA(At, 0, 0); PG8_STAGE(PG8_SA(1, 1), a1 + hstep, voffA);
            PG8_WAIT_V(8); PG8_WAIT_L(0); PG8_BAR; PG8_MMA(0, 0, At, B0); PG8_MMA(0, 1, At, B1); PG8_BAR; PG8_SCHED;
            PG8_LDA(At, 0, 1); PG8_STAGE(PG8_SB(0, 0), b2, voffB); PG8_STAGE(PG8_SB(0, 1), b2 + hstep, voffB); PG8_STAGE(PG8_SA(0, 0), a2, voffA);
            PG8_WAIT_V(8); PG8_WAIT_L(0); PG8_BAR; PG8_MMA(1, 0, At, B0); PG8_MMA(1, 1, At, B1); PG8_BAR; PG8_SCHED;
            PG8_LDB(B0, 1, 0); PG8_LDB(B1, 1, 1); PG8_SCHED; PG8_LDA(At, 1, 0); PG8_STAGE(PG8_SA(0, 1), a2 + hstep, voffA);
            PG8_WAIT_V(8); PG8_WAIT_L(0); PG8_BAR; PG8_MMA(0, 0, At, B0); PG8_MMA(0, 1, At, B1); PG8_BAR; PG8_SCHED;
            PG8_LDA(At, 1, 1); PG8_STAGE(PG8_SB(1, 0), b3, voffB); PG8_STAGE(PG8_SB(1, 1), b3 + hstep, voffB); PG8_STAGE(PG8_SA(1, 0), a3, voffA);
            PG8_WAIT_V(8); PG8_WAIT_L(0); PG8_BAR; PG8_MMA(1, 0, At, B0); PG8_MMA(1, 1, At, B1); PG8_BAR; PG8_SCHED;
            } else {
            PG8_LDB(B0, 0, 0); PG8_SCHED; PG8_LDA(At, 0, 0); PG8_STAGE(PG8_SA(1, 1), a1 + hstep, voffA);
            PG8_WAIT_L(8); PG8_BAR; PG8_WAIT_L(0); PG8_MMA(0, 0, At, B0); PG8_BAR; PG8_SCHED;
            PG8_LDB(B1, 0, 1); PG8_STAGE(PG8_SB(0, 0), b2, voffB);
            PG8_BAR; PG8_WAIT_L(0); PG8_MMA(0, 1, At, B1); PG8_BAR;
            PG8_LDA(At, 0, 1); PG8_STAGE(PG8_SA(0, 0), a2, voffA);
            PG8_BAR; PG8_WAIT_L(0); PG8_MMA(1, 0, At, B0); PG8_BAR; PG8_SCHED;
            PG8_STAGE(PG8_SB(0, 1), b2 + hstep, voffB);
            PG8_WAIT_V(6); PG8_BAR; PG8_MMA(1, 1, At, B1); PG8_BAR;
            PG8_LDB(B0, 1, 0); PG8_SCHED; PG8_LDA(At, 1, 0); PG8_STAGE(PG8_SA(0, 1), a2 + hstep, voffA);
            PG8_WAIT_L(8); PG8_BAR; PG8_WAIT_L(0); PG8_MMA(0, 0, At, B0); PG8_BAR; PG8_SCHED;
            PG8_LDB(B1, 1, 1); PG8_STAGE(PG8_SB(1, 0), b3, voffB);
            PG8_BAR; PG8_WAIT_L(0); PG8_MMA(0, 1, At, B1); PG8_BAR;
            PG8_LDA(At, 1, 1); PG8_STAGE(PG8_SA(1, 0), a3, voffA);
            PG8_BAR; PG8_WAIT_L(0); PG8_MMA(1, 0, At, B0); PG8_BAR; PG8_SCHED;
            PG8_STAGE(PG8_SB(1, 1), b3 + hstep, voffB);
            PG8_WAIT_V(6); PG8_BAR; PG8_MMA(1, 1, At, B1); PG8_BAR;
            }
        }
        if constexpr (ALIGN_EPI) { if (wr == 0) PG8_BAR; }
        if constexpr (!Epi::AFTER_DRAIN) { E(acc, cur, wr, wc, fr, fq); S.done(cur); }
        if (!has_next) break;
#pragma unroll
        for (int a = 0; a < 2; ++a)
#pragma unroll
            for (int b = 0; b < 2; ++b)
#pragma unroll
                for (int m = 0; m < 4; ++m)
#pragma unroll
                    for (int n = 0; n < 2; ++n) acc[a][b][m][n] = (f32x4){0.f, 0.f, 0.f, 0.f};
        cur = nxt; cA = nA; cB = nB; ++ui;
        if constexpr (ALIGN_EPI) { if (wr == 1) PG8_BAR; }
    }
    PG8_WAIT_V(0);
    if constexpr (!ALIGN_EPI) { if (wr == 0) PG8_BAR; }
    PG8_BAR;
    if constexpr (Epi::AFTER_DRAIN) { E.fused(acc, cur, wr, wc, fr, fq, lds, wid, lane); S.done(cur); }
#undef PG8_SA
#undef PG8_SB
#undef PG8_STAGE
#undef PG8_LDA
#undef PG8_LDB
#undef PG8_MMA
#undef PG8_WAIT_V
#undef PG8_WAIT_L
#undef PG8_BAR
#undef PG8_SCHED
}
}
#define GAS __attribute__((address_space(1)))
#define LAS __attribute__((address_space(3)))
typedef unsigned short bf16;
typedef unsigned v4u __attribute__((ext_vector_type(4)));
typedef float f32x4 __attribute__((ext_vector_type(4)));
typedef short bf16x8 __attribute__((ext_vector_type(8)));
typedef GAS unsigned gu32;
typedef GAS unsigned long long gu64;
#define RLX_AGENT __ATOMIC_RELAXED, __HIP_MEMORY_SCOPE_AGENT
#define LDS_WAIT() asm volatile("s_waitcnt lgkmcnt(0)" ::: "memory")
#define VM_WAIT() asm volatile("s_waitcnt vmcnt(0)" ::: "memory")
__device__ __forceinline__ unsigned long long rt() { return __builtin_amdgcn_s_memrealtime(); }
__device__ __forceinline__ unsigned f2bf(float f) { unsigned u = __builtin_bit_cast(unsigned, f); return (u + 0x7fffu + ((u >> 16) & 1u)) >> 16; }
__device__ __forceinline__ unsigned pk2(float lo, float hi) { return f2bf(lo) | (f2bf(hi) << 16); }

#define XB_TMO      128
#define XB_XCNT(j)  (256  + 64 * (j))
#define XB_XSUB(j)  (1280 + 64 * (j))
#define XB_XGEN(j)  (2304 + 64 * (j))
#define XB_TOP      3328
#define XB_TOPGEN   3392
#define XCD_BAR_WORDS 3456
#define XB_SPIN_CAP (1u << 18)

__device__ __forceinline__ unsigned xb_ld(unsigned* p)              { return __hip_atomic_load(p, __ATOMIC_RELAXED, __HIP_MEMORY_SCOPE_AGENT); }
__device__ __forceinline__ unsigned xb_add(unsigned* p, unsigned v) { return __hip_atomic_fetch_add(p, v, __ATOMIC_RELAXED, __HIP_MEMORY_SCOPE_AGENT); }
__device__ __forceinline__ unsigned xb_xcc_id() { return (unsigned)__builtin_amdgcn_s_getreg((3 << 11) | 20) & 0xFu; }
#define XB_SPIN(cond, bar) do { unsigned _sp = 0; while (cond) { __builtin_amdgcn_s_sleep(1); \
    if ((++_sp & 255u) == 0u) { if (xb_ld(&(bar)[XB_TMO])) break; if (_sp > XB_SPIN_CAP) { atomicAdd(&(bar)[XB_TMO], 1u); break; } } } } while (0)

struct XcdBarrier {
    unsigned* bar; unsigned x;
    volatile LAS unsigned* st;
};

__device__ __forceinline__ XcdBarrier xcd_barrier_post(unsigned* bar, volatile LAS unsigned* st) {
    XcdBarrier b; b.bar = bar; b.x = xb_xcc_id(); b.st = st;
    if (threadIdx.x == 0) (void)xb_add(&bar[XB_XCNT(b.x)], 1u);
    return b;
}
__device__ __forceinline__ void xcd_barrier_complete(unsigned* bar, unsigned x, unsigned& nloc, unsigned& nx) {
    const unsigned G = gridDim.x * gridDim.y * gridDim.z;
    unsigned sum, cnt, mine, sp = 0u;
    for (;;) {
        sum = 0u; cnt = 0u; mine = 0u;
#pragma unroll
        for (unsigned j = 0; j < 16; ++j) { const unsigned c = xb_ld(&bar[XB_XCNT(j)]); sum += c; cnt += (c > 0u) ? 1u : 0u; mine = (j == x) ? c : mine; }
        if (sum == G) break;
        __builtin_amdgcn_s_sleep(1);
        if ((++sp & 255u) == 0u) { if (xb_ld(&bar[XB_TMO])) break; if (sp > XB_SPIN_CAP) { atomicAdd(&bar[XB_TMO], 1u); break; } }
    }
    nloc = mine > 0u ? mine : 1u; nx = cnt > 0u ? cnt : 1u;
}

__device__ __forceinline__ void xcd_barrier(const XcdBarrier& b) {
    asm volatile("s_waitcnt vmcnt(0)" ::: "memory");
    __syncthreads();
    if (threadIdx.x == 0) {
        unsigned* bar = b.bar;
        __builtin_amdgcn_s_waitcnt(0);
        unsigned nloc = b.st[0], nx = b.st[1];
        if (nloc == 0u) { xcd_barrier_complete(bar, b.x, nloc, nx); b.st[0] = nloc; b.st[1] = nx; }
        const unsigned old = xb_add(&bar[XB_XSUB(b.x)], 1u);
        const unsigned gen = old / nloc;
        if (old + 1u == (gen + 1u) * nloc) {
            __builtin_amdgcn_fence(__ATOMIC_RELEASE, "agent");
            asm volatile("s_waitcnt vmcnt(0)" ::: "memory");
            const unsigned og = xb_add(&bar[XB_TOP], 1u);
            const unsigned tg = og / nx;
            if (og + 1u == (tg + 1u) * nx) xb_add(&bar[XB_TOPGEN], 1u);
            else XB_SPIN(xb_ld(&bar[XB_TOPGEN]) == tg, bar);
            __builtin_amdgcn_fence(__ATOMIC_ACQUIRE, "agent");
            xb_add(&bar[XB_XGEN(b.x)], 1u);
            asm volatile("s_waitcnt vmcnt(0)" ::: "memory");
        } else {
            XB_SPIN(xb_ld(&bar[XB_XGEN(b.x)]) == gen, bar);
            __builtin_amdgcn_fence(__ATOMIC_ACQUIRE, "agent");
            asm volatile("s_waitcnt vmcnt(0)" ::: "memory");
        }
    }
    __syncthreads();
}

constexpr int DM = 2048, NBAT = 4, SEQ = 2048, DEPTH = 4, NS = 128;
constexpr int MP = NBAT * SEQ;
constexpr int MV = MP + NS;
constexpr int MPAD = 8448;
constexpr int WA = 512, WB = 768, WC = 768, PIN = 6656, DFF = 5632, DPLE = 256, PBW = 2560;
constexpr int OFF_B = 1024, OFF_C = 3584;
constexpr float LN_EPS = 1e-5f, GN_EPS = 64e-5f, RMS_EPS = 1e-6f;
constexpr float DN_ALPHA = 1.681792830507429f;
enum { I_XP = 0, I_XS, I_SRWKV, I_SSHIFT, I_SHGRN, I_PP, I_PS, I_LNING, I_LNINB, I_WIN, I_ALNG, I_ALNB, I_AWS, I_ABS, I_BMU, I_BW0, I_BWUP, I_BA0, I_BAUP, I_BGUP,
       I_BKK, I_BKA, I_BRK, I_BGNG, I_BGNB, I_CLB, I_CNG, I_WOUT, I_LN1G, I_LN1B, I_WG, I_WU, I_WD, I_WPG, I_WPP, I_LN2G, I_LN2B, N_IN };
constexpr size_t O_YP = 0, O_YS = O_YP + (size_t)MP * DM, O_RP = O_YS + (size_t)NS * DM, O_SP = O_RP + (size_t)DEPTH * NBAT * 12 * 4096,
                 O_HP = O_SP + (size_t)DEPTH * NBAT * PBW, O_RS = O_HP + (size_t)DEPTH * NBAT * 6 * 16384, O_SS = O_RS + (size_t)DEPTH * NS * 12 * 4096,
                 O_HS = O_SS + (size_t)DEPTH * NS * PBW, O_VS = O_HS + (size_t)DEPTH * NS * 6 * 16384, O_END = O_VS + (size_t)DEPTH * NS * WA;
static_assert(O_END == 96509952, "output size");
constexpr size_t al256(size_t x) { return (x + 255) & ~(size_t)255; }
constexpr size_t WS_CTL = 0, CTL_ZERO_BYTES = 1u << 20;
constexpr size_t SZ_WIN = (size_t)PIN * DM * 2, SZ_WOUT = (size_t)DM * DM * 2, SZ_WGU = (size_t)2 * DFF * DM * 2, SZ_WD = (size_t)DM * DFF * 2, SZ_WPG = SZ_WOUT, SZ_WPP = (size_t)DM * DPLE * 2;
constexpr size_t WS_WIN = CTL_ZERO_BYTES, WS_WOUT = WS_WIN + DEPTH * SZ_WIN, WS_WGU = WS_WOUT + DEPTH * SZ_WOUT, WS_WD = WS_WGU + DEPTH * SZ_WGU, WS_WPG = WS_WD + DEPTH * SZ_WD,
                 WS_WPP = WS_WPG + DEPTH * SZ_WPG, WS_PBF = WS_WPP + DEPTH * SZ_WPP;
constexpr size_t SZ_PBF = (size_t)MPAD * DPLE * 2;
constexpr size_t WS_H = WS_PBF + DEPTH * SZ_PBF, WS_HB = WS_H + (size_t)MPAD * DM * 4, WS_T = WS_HB + (size_t)MPAD * DM * 2, WS_YMIX = WS_T + (size_t)MPAD * DM * 4;
constexpr size_t WS_Z = WS_YMIX + (size_t)MPAD * DM * 2;
constexpr size_t WS_ACT = WS_Z, WS_PLE = WS_ACT + al256((size_t)MPAD * DFF * 2);
constexpr size_t WS_PPO = WS_Z + (size_t)MPAD * PIN * 4;
static_assert(WS_PLE + (size_t)MPAD * DM * 4 <= WS_PPO, "overlay fits");
constexpr size_t WS_RPB = WS_PPO + (size_t)MPAD * DM * 4;
constexpr size_t WS_RPS = WS_RPB + (size_t)NBAT * 12 * SEQ * 384 * 4;
constexpr size_t WS_G = WS_RPS + (size_t)NS * 12 * 384 * 4;
constexpr size_t WS_Y = WS_G + (size_t)MPAD * WB * 4;
constexpr size_t WS_O = WS_Y + (size_t)MPAD * WB * 4;
constexpr size_t WS_END = WS_O + (size_t)MPAD * WC * 4;
static_assert(WS_WIN % 256 == 0 && WS_H % 256 == 0 && WS_Z % 256 == 0 && WS_RPB % 256 == 0 && WS_G % 256 == 0, "alignment");
constexpr int CW_BAR = 4096;

constexpr int RING_BYTES = 131072, LDSCTL_OFF = RING_BYTES, MISC_OFF = LDSCTL_OFF + 320, LDS_BYTES = 147456;
constexpr int NWAVES = 8, NTHR = 512;

struct Args { const float* in[N_IN]; float* out; unsigned char* ws; int ph_lo, ph_hi; };
static_assert(sizeof(Args) == (N_IN + 2) * 8 + 8, "no padding in Args");

typedef float f4 __attribute__((ext_vector_type(4)));
typedef float f2 __attribute__((ext_vector_type(2)));
typedef unsigned u2 __attribute__((ext_vector_type(2)));

__device__ __forceinline__ float wave_sum(float v) {
#pragma unroll
    for (int o = 1; o < 64; o <<= 1) v += __shfl_xor(v, o);
    return v;
}
template <int CTRL> __device__ __forceinline__ float dpp_f(float x) { return __builtin_bit_cast(float, __builtin_amdgcn_update_dpp(0, __builtin_bit_cast(int, x), CTRL, 0xF, 0xF, true)); }
__device__ __forceinline__ float row16_sum(float x) {
    x += dpp_f<0xB1>(x);
    x += dpp_f<0x4E>(x);
    x += dpp_f<0x141>(x);
    x += dpp_f<0x140>(x);
    return x;
}
__device__ __forceinline__ float sigmoidf_(float x) { return 1.0f / (1.0f + expf(-x)); }
__device__ __forceinline__ float gelu_erf(float x) { return 0.5f * x * (1.0f + erff(x * 0.70710678118654752f)); }
__device__ __forceinline__ unsigned short bf1(float x) { return (unsigned short)(pg8::cvt_pk_bf16(x, 0.f) & 0xffffu); }
__device__ __forceinline__ float lbound(const float* clb, int L, int c) {
    const float x0 = clb[c], x1 = clb[WC + c], x2 = clb[2 * WC + c], x3 = clb[3 * WC + c];
    const float mx = fmaxf(fmaxf(x0, x1), fmaxf(x2, x3));
    const float e0 = expf(x0 - mx), e1 = expf(x1 - mx), e2 = expf(x2 - mx), e3 = expf(x3 - mx);
    float s = 0.f; if (L >= 1) s += e1; if (L >= 2) s += e2; if (L >= 3) s += e3;
    return s / (e0 + e1 + e2 + e3);
}
__device__ __forceinline__ float log_sigmoid(float x) { return fminf(x, 0.f) - log1pf(expf(-fabsf(x))); }

__device__ __forceinline__ void tr_item(const float* W, int K, int N, bf16* WT, int mode, LAS float* scr, int item, int lane) {
    const int nblk = N >> 5, kb = item / nblk, nb = item - kb * nblk, k0 = kb << 6, n0 = nb << 5;
    int rb = n0; if (mode) rb = ((n0 >> 7) << 8) + (n0 & 127) + (mode == 2 ? 128 : 0);
#pragma unroll 8
    for (int i = 0; i < 32; ++i) { const int kk = 2 * i + (lane >> 5); scr[kk * 33 + (lane & 31)] = W[(size_t)(k0 + kk) * N + n0 + (lane & 31)]; }
    LDS_WAIT(); asm volatile("" ::: "memory");
    const int c = lane & 7;
#pragma unroll
    for (int j = 0; j < 4; ++j) { const int n = (lane >> 3) + 8 * j; const LAS float* s = scr + (8 * c) * 33 + n;
        v4u o; o.x = pg8::cvt_pk_bf16(s[0 * 33], s[1 * 33]); o.y = pg8::cvt_pk_bf16(s[2 * 33], s[3 * 33]); o.z = pg8::cvt_pk_bf16(s[4 * 33], s[5 * 33]); o.w = pg8::cvt_pk_bf16(s[6 * 33], s[7 * 33]);
        *(v4u*)(WT + (size_t)(rb + n) * K + k0 + 8 * c) = o; }
    LDS_WAIT(); asm volatile("" ::: "memory");
}
__device__ __forceinline__ void ln_row(const float* src, const float* g, const float* b, float* dstf, bf16* dstb, float* dst2, int lane) {
    f4 v[8]; float s = 0.f;
#pragma unroll
    for (int j = 0; j < 8; ++j) { v[j] = *(const f4*)(src + 4 * (lane + 64 * j)); s += (v[j].x + v[j].y) + (v[j].z + v[j].w); }
    const float mean = wave_sum(s) * (1.f / DM); float s2 = 0.f;
#pragma unroll
    for (int j = 0; j < 8; ++j) { v[j] = v[j] - mean; s2 += (v[j].x * v[j].x + v[j].y * v[j].y) + (v[j].z * v[j].z + v[j].w * v[j].w); }
    const float rstd = 1.0f / sqrtf(wave_sum(s2) * (1.f / DM) + LN_EPS);
#pragma unroll
    for (int j = 0; j < 8; ++j) { const int c = 4 * (lane + 64 * j); const f4 gg = *(const f4*)(g + c), bb = *(const f4*)(b + c); const f4 o = v[j] * rstd * gg + bb;
        *(f4*)(dstf + c) = o; if (dst2) *(f4*)(dst2 + c) = o;
        u2 w; w.x = pg8::cvt_pk_bf16(o.x, o.y); w.y = pg8::cvt_pk_bf16(o.z, o.w); *(u2*)(dstb + c) = w; }
}
__device__ __forceinline__ void phase_prologue(const Args& a, LAS unsigned char* lds, int lane, int wave, int blk, int G) {
    LAS float* scr = (LAS float*)(lds + wave * 16384);
    const int gw = blk * NWAVES + wave, NGW = G * NWAVES;
    constexpr int I_IN = 32 * (PIN / 32), I_OUT = 32 * (DM / 32), I_G = 32 * (DFF / 32), I_D = (DFF / 64) * (DM / 32), I_PGc = I_OUT, I_PPc = (DPLE / 64) * (DM / 32);
    constexpr int PER_L = I_IN + I_OUT + 2 * I_G + I_D + I_PGc + I_PPc;
    unsigned char* ws = a.ws;
    for (int it = gw; it < DEPTH * PER_L; it += NGW) {
        const int L = it / PER_L; int r = it - L * PER_L;
        if (r < I_IN) { tr_item(a.in[I_WIN] + (size_t)L * DM * PIN, DM, PIN, (bf16*)(ws + WS_WIN + L * SZ_WIN), 0, scr, r, lane); continue; } r -= I_IN;
        if (r < I_OUT) { tr_item(a.in[I_WOUT] + (size_t)L * DM * DM, DM, DM, (bf16*)(ws + WS_WOUT + L * SZ_WOUT), 0, scr, r, lane); continue; } r -= I_OUT;
        if (r < I_G) { tr_item(a.in[I_WG] + (size_t)L * DM * DFF, DM, DFF, (bf16*)(ws + WS_WGU + L * SZ_WGU), 1, scr, r, lane); continue; } r -= I_G;
        if (r < I_G) { tr_item(a.in[I_WU] + (size_t)L * DM * DFF, DM, DFF, (bf16*)(ws + WS_WGU + L * SZ_WGU), 2, scr, r, lane); continue; } r -= I_G;
        if (r < I_D) { tr_item(a.in[I_WD] + (size_t)L * DFF * DM, DFF, DM, (bf16*)(ws + WS_WD + L * SZ_WD), 0, scr, r, lane); continue; } r -= I_D;
        if (r < I_PGc) { tr_item(a.in[I_WPG] + (size_t)L * DM * DM, DM, DM, (bf16*)(ws + WS_WPG + L * SZ_WPG), 0, scr, r, lane); continue; } r -= I_PGc;
        tr_item(a.in[I_WPP] + (size_t)L * DPLE * DM, DPLE, DM, (bf16*)(ws + WS_WPP + L * SZ_WPP), 0, scr, r, lane);
    }
    for (int it = gw; it < DEPTH * MV; it += NGW) { const int L = it / MV, m = it - L * MV;
        const float* src = (m < MP) ? a.in[I_PP] + ((size_t)L * MP + m) * DPLE : a.in[I_PS] + ((size_t)L * NS + (m - MP)) * DPLE;
        const f4 v = *(const f4*)(src + 4 * lane); u2 w; w.x = pg8::cvt_pk_bf16(v.x, v.y); w.y = pg8::cvt_pk_bf16(v.z, v.w);
        *(u2*)((bf16*)(ws + WS_PBF + L * SZ_PBF) + (size_t)m * DPLE + 4 * lane) = w; }
    for (int m = gw; m < MV; m += NGW) { const float* src = (m < MP) ? a.in[I_XP] + (size_t)m * DM : a.in[I_XS] + (size_t)(m - MP) * DM;
        ln_row(src, a.in[I_LNING], a.in[I_LNINB], (float*)(ws + WS_H) + (size_t)m * DM, (bf16*)(ws + WS_HB) + (size_t)m * DM, nullptr, lane); }
}
__device__ __forceinline__ void phase_ln(const Args& a, const float* g, const float* b, bool last, int lane, int wave, int blk, int G) {
    const int gw = blk * NWAVES + wave, NGW = G * NWAVES; unsigned char* ws = a.ws;
    for (int m = gw; m < MV; m += NGW)
        ln_row((const float*)(ws + WS_T) + (size_t)m * DM, g, b, (float*)(ws + WS_H) + (size_t)m * DM, (bf16*)(ws + WS_HB) + (size_t)m * DM,
               last ? a.out + (m < MP ? O_YP + (size_t)m * DM : O_YS + (size_t)(m - MP) * DM) : nullptr, lane);
}

__device__ __forceinline__ void phase_prep(const Args& a, int L, LAS unsigned char* lds, int tid, int lane, int wave, int blk, int G) {
    unsigned char* ws = a.ws;
    const float* Z = (const float*)(ws + WS_Z);
    LAS float* xsT = (LAS float*)lds;
    const float* mu = a.in[I_BMU] + L * PBW; const float* w0 = a.in[I_BW0] + L * WB; const float* a0 = a.in[I_BA0] + L * WB;
    const float* w_up = a.in[I_BWUP] + (size_t)L * 64 * WB; const float* a_up = a.in[I_BAUP] + (size_t)L * 64 * WB; const float* g_up = a.in[I_BGUP] + (size_t)L * 128 * WB;
    const float* k_k = a.in[I_BKK] + L * WB; const float* k_a = a.in[I_BKA] + L * WB;
    const float* sh0 = a.in[I_SSHIFT] + (size_t)L * NS * PBW;
    for (int tile = blk; tile < MV / 16; tile += G) {
        const bool samp = tile >= MP / 16; const int m0 = tile * 16;
        __syncthreads();
        for (int e = tid; e < 4096; e += NTHR) { const int tok = e >> 8, j = e & 255, m = m0 + tok, col = OFF_B + 2304 + j;
            const float cur = Z[(size_t)m * PIN + col]; float prev;
            if (samp) prev = sh0[(size_t)(m - MP) * PBW + 2304 + j]; else prev = (m & (SEQ - 1)) ? Z[(size_t)(m - 1) * PIN + col] : 0.f;
            float x = cur + mu[2304 + j] * (prev - cur);
            if (j < 64) x = tanhf(x); else if (j >= 128) x = sigmoidf_(x);
            xsT[j * 16 + tok] = x; }
        __syncthreads();
        const int cw = tid & 255, th = tid >> 8;
        float accw[3][8], acca[3][8], accg[3][8];
#pragma unroll
        for (int jc = 0; jc < 3; ++jc)
#pragma unroll
            for (int tk = 0; tk < 8; ++tk) { accw[jc][tk] = 0.f; acca[jc][tk] = 0.f; accg[jc][tk] = 0.f; }
        for (int j2 = 0; j2 < 64; ++j2) {
            const f4 xw0 = *(const LAS f4*)(xsT + j2 * 16 + th * 8), xw1 = *(const LAS f4*)(xsT + j2 * 16 + th * 8 + 4);
            const f4 xa0 = *(const LAS f4*)(xsT + (64 + j2) * 16 + th * 8), xa1 = *(const LAS f4*)(xsT + (64 + j2) * 16 + th * 8 + 4);
#pragma unroll
            for (int jc = 0; jc < 3; ++jc) { const float wu = w_up[j2 * WB + cw + 256 * jc], au = a_up[j2 * WB + cw + 256 * jc];
#pragma unroll
                for (int tk = 0; tk < 4; ++tk) { accw[jc][tk] += xw0[tk] * wu; accw[jc][4 + tk] += xw1[tk] * wu; acca[jc][tk] += xa0[tk] * au; acca[jc][4 + tk] += xa1[tk] * au; } }
        }
        for (int j2 = 0; j2 < 128; ++j2) {
            const f4 xg0 = *(const LAS f4*)(xsT + (128 + j2) * 16 + th * 8), xg1 = *(const LAS f4*)(xsT + (128 + j2) * 16 + th * 8 + 4);
#pragma unroll
            for (int jc = 0; jc < 3; ++jc) { const float gu = g_up[j2 * WB + cw + 256 * jc];
#pragma unroll
                for (int tk = 0; tk < 4; ++tk) { accg[jc][tk] += xg0[tk] * gu; accg[jc][4 + tk] += xg1[tk] * gu; } }
        }
#pragma unroll
        for (int jc = 0; jc < 3; ++jc) { const int c = cw + 256 * jc, h = c >> 6, i = c & 63;
            const float w0c = w0[c], a0c = a0[c], kkc = k_k[c], kac = k_a[c], mur = mu[c], muk = mu[WB + c], muv = mu[2 * WB + c];
#pragma unroll
            for (int tk = 0; tk < 8; ++tk) { const int m = m0 + th * 8 + tk; const float* zr = Z + (size_t)m * PIN + OFF_B + c;
                const float cr = zr[0], ck = zr[WB], cv = zr[2 * WB]; float pr, pk, pv;
                if (samp) { const float* s = sh0 + (size_t)(m - MP) * PBW + c; pr = s[0]; pk = s[WB]; pv = s[2 * WB]; }
                else if (m & (SEQ - 1)) { pr = zr[-PIN]; pk = zr[WB - PIN]; pv = zr[2 * WB - PIN]; } else { pr = 0.f; pk = 0.f; pv = 0.f; }
                const float r = cr + mur * (pr - cr), k = ck + muk * (pk - ck), v = cv + muv * (pv - cv);
                const float wv = w0c + accw[jc][tk]; const float dec = expf(-0.6065306597126334f * sigmoidf_(wv));
                const float av = sigmoidf_(a0c + acca[jc][tk]);
                const float kkr = k * kkc; const float ss = wave_sum(kkr * kkr); const float kk = kkr / fmaxf(sqrtf(ss), 1e-12f);
                const float kp = k * (1.0f + (av - 1.0f) * kac);
                float* rec = samp ? (float*)(ws + WS_RPS) + ((size_t)(m - MP) * 12 + h) * 384 : (float*)(ws + WS_RPB) + (((size_t)(m >> 11) * 12 + h) * SEQ + (m & (SEQ - 1))) * 384;
                rec[i] = r; rec[64 + i] = dec; rec[128 + i] = kp; rec[192 + i] = v; rec[256 + i] = kk; rec[320 + i] = kk * av;
                ((float*)(ws + WS_G))[(size_t)m * WB + c] = accg[jc][tk]; }
        }
        if (samp) { for (int e = tid; e < 16 * PBW; e += NTHR) { const int tok = e / PBW, j = e - tok * PBW, i = m0 + tok - MP;
                        a.out[O_SS + ((size_t)L * NS + i) * PBW + j] = Z[(size_t)(m0 + tok) * PIN + OFF_B + j]; } }
        else if ((m0 & (SEQ - 1)) == SEQ - 16) { const int b = m0 >> 11; for (int j = tid; j < PBW; j += NTHR) a.out[O_SP + ((size_t)L * NBAT + b) * PBW + j] = Z[(size_t)(m0 + 15) * PIN + OFF_B + j]; }
        if (samp) {
            const float* lng = a.in[I_ALNG] + L * WA; const float* lnb = a.in[I_ALNB] + L * WA;
            for (int rr = 0; rr < 2; ++rr) { const int m = m0 + wave * 2 + rr, i = m - MP; const float* zr = Z + (size_t)m * PIN;
                for (int g = 0; g < 4; ++g) {
                    const float u0 = gelu_erf(zr[g * 128 + lane]), u1 = gelu_erf(zr[g * 128 + 64 + lane]);
                    const float v0 = gelu_erf(zr[WA + g * 128 + lane]), v1 = gelu_erf(zr[WA + g * 128 + 64 + lane]);
                    const float mean = wave_sum(v0 + v1) * (1.f / 128.f); const float d0 = v0 - mean, d1 = v1 - mean;
                    const float rstd = 1.0f / sqrtf(wave_sum(d0 * d0 + d1 * d1) * (1.f / 128.f) + LN_EPS);
                    const float n0 = d0 * rstd * lng[g * 128 + lane] + lnb[g * 128 + lane], n1 = d1 * rstd * lng[g * 128 + 64 + lane] + lnb[g * 128 + 64 + lane];
                    float* ov = a.out + O_VS + ((size_t)L * NS + i) * WA + g * 128; ov[lane] = n0; ov[64 + lane] = n1;
                    const float w00 = a.in[I_AWS][(size_t)(L * 4 + g) * 16384], b0 = a.in[I_ABS][(L * 4 + g) * 128];
                    bf16* yo = (bf16*)(ws + WS_YMIX) + (size_t)m * DM + g * 128; yo[lane] = bf1(u0 * (w00 * n0 + b0)); yo[64 + lane] = bf1(u1 * (w00 * n1 + b0)); } }
        }
    }
}

__device__ __forceinline__ void rwkv_scan_unit(const Args& a, int L, int unit, LAS unsigned char* lds, int tid, int lane, int wave) {
    unsigned char* ws = a.ws;
    const int bh = unit >> 1, half = unit & 1, b = bh / 12, h = bh - b * 12;
    const f4* rec4 = (const f4*)((const float*)(ws + WS_RPB) + (size_t)bh * SEQ * 384);
    LAS float* buf = (LAS float*)lds;
    LAS float* ybuf = (LAS float*)(lds + 49152);
    const int rowl = wave * 4 + (lane >> 4), kg = lane & 15, row = half * 32 + rowl;
    float S0 = 0.f, S1 = 0.f, S2 = 0.f, S3 = 0.f;
    f4 st0, st1, st2;
    __syncthreads();
    st0 = rec4[tid]; st1 = rec4[512 + tid]; st2 = rec4[1024 + tid];
    *(LAS f4*)(buf + 4 * tid) = st0; *(LAS f4*)(buf + 4 * (512 + tid)) = st1; *(LAS f4*)(buf + 4 * (1024 + tid)) = st2;
    __syncthreads();
    float* Y = (float*)(ws + WS_Y);
    for (int c = 0; c < SEQ / 16; ++c) {
        if (c + 1 < SEQ / 16) { const f4* nx = rec4 + (size_t)(c + 1) * 1536; st0 = nx[tid]; st1 = nx[512 + tid]; st2 = nx[1024 + tid]; }
        const LAS float* cur = buf + (c & 1) * 6144; LAS float* yb = ybuf + (c & 1) * 512;
        f4 r4 = *(const LAS f4*)(cur + 4 * kg), w4 = *(const LAS f4*)(cur + 64 + 4 * kg), k4 = *(const LAS f4*)(cur + 128 + 4 * kg),
           kk4 = *(const LAS f4*)(cur + 256 + 4 * kg), ka4 = *(const LAS f4*)(cur + 320 + 4 * kg); float v = cur[192 + row];
#pragma unroll
        for (int s = 0; s < 16; ++s) {
            const LAS float* R = cur + (s < 15 ? s + 1 : 15) * 384;
            const f4 nr4 = *(const LAS f4*)(R + 4 * kg), nw4 = *(const LAS f4*)(R + 64 + 4 * kg), nk4 = *(const LAS f4*)(R + 128 + 4 * kg),
                     nkk4 = *(const LAS f4*)(R + 256 + 4 * kg), nka4 = *(const LAS f4*)(R + 320 + 4 * kg);
            const float nv = R[192 + row];
            float sa = (S0 * kk4.x + S1 * kk4.y) + (S2 * kk4.z + S3 * kk4.w);
            sa = row16_sum(sa);
            S0 = S0 * w4.x + (v * k4.x - sa * ka4.x); S1 = S1 * w4.y + (v * k4.y - sa * ka4.y);
            S2 = S2 * w4.z + (v * k4.z - sa * ka4.z); S3 = S3 * w4.w + (v * k4.w - sa * ka4.w);
            float y = (S0 * r4.x + S1 * r4.y) + (S2 * r4.z + S3 * r4.w);
            y = row16_sum(y);
            if (kg == 0) yb[s * 32 + rowl] = y;
            r4 = nr4; w4 = nw4; k4 = nk4; kk4 = nkk4; ka4 = nka4; v = nv;
        }
        if (c + 1 < SEQ / 16) { LAS float* nb = buf + ((c + 1) & 1) * 6144;
            *(LAS f4*)(nb + 4 * tid) = st0; *(LAS f4*)(nb + 4 * (512 + tid)) = st1; *(LAS f4*)(nb + 4 * (1024 + tid)) = st2; }
        __syncthreads();
        { const int s = tid >> 5, rl = tid & 31; Y[((size_t)b * SEQ + c * 16 + s) * WB + h * 64 + half * 32 + rl] = yb[tid]; }
    }
    f4 so; so.x = S0; so.y = S1; so.z = S2; so.w = S3;
    *(f4*)(a.out + O_RP + ((((size_t)L * NBAT + b) * 12 + h) * 64 + row) * 64 + 4 * kg) = so;
    __syncthreads();
}
__device__ __forceinline__ void rwkv_sample_item(const Args& a, int L, int item, LAS unsigned char* lds, int lane, int wave) {
    unsigned char* ws = a.ws;
    const int ih = item * 8 + wave, i = ih / 12, h = ih - i * 12;
    const float* rec = (const float*)(ws + WS_RPS) + (size_t)ih * 384;
    LAS float* sc = (LAS float*)(lds + wave * 2048);
    const float r = rec[lane], w = rec[64 + lane], k = rec[128 + lane], v = rec[192 + lane], kk = rec[256 + lane], ka = rec[320 + lane];
    sc[lane] = r; sc[64 + lane] = w; sc[128 + lane] = k; sc[192 + lane] = kk; sc[256 + lane] = ka;
    LDS_WAIT(); asm volatile("" ::: "memory");
    const f4* S0p = (const f4*)(a.in[I_SRWKV] + (((size_t)L * NS + i) * 12 + h) * 4096 + lane * 64);
    f4 S[16];
#pragma unroll
    for (int j = 0; j < 16; ++j) S[j] = S0p[j];
    float sa = 0.f;
#pragma unroll
    for (int j = 0; j < 16; ++j) { const f4 q = *(const LAS f4*)(sc + 192 + 4 * j); sa += (S[j].x * q.x + S[j].y * q.y) + (S[j].z * q.z + S[j].w * q.w); }
    float y = 0.f;
    f4* So = (f4*)(a.out + O_RS + (((size_t)L * NS + i) * 12 + h) * 4096 + lane * 64);
#pragma unroll
    for (int j = 0; j < 16; ++j) { const f4 w4 = *(const LAS f4*)(sc + 64 + 4 * j), k4 = *(const LAS f4*)(sc + 128 + 4 * j), a4 = *(const LAS f4*)(sc + 256 + 4 * j), r4 = *(const LAS f4*)(sc + 4 * j);
        f4 n = S[j] * w4 + (k4 * v - a4 * sa); So[j] = n; y += (n.x * r4.x + n.y * r4.y) + (n.z * r4.z + n.w * r4.w); }
    ((float*)(ws + WS_Y))[(size_t)(MP + i) * WB + h * 64 + lane] = y;
    LDS_WAIT(); asm volatile("" ::: "memory");
}
__device__ __forceinline__ void hgrn_sample_item(const Args& a, int L, int item, LAS unsigned char* lds, int lane, int wave) {
    unsigned char* ws = a.ws;
    const int ih = item * 4 + (wave >> 1), i = ih / 6, h = ih - i * 6, vcol = (wave & 1) * 64 + lane, m = MP + i;
    const float* zc = (const float*)(ws + WS_Z) + (size_t)m * PIN + OFF_C + h * 128;
    LAS float* sc = (LAS float*)(lds + wave * 2048);
#pragma unroll
    for (int t = 0; t < 2; ++t) { const int k = lane + 64 * t; const float lb = lbound(a.in[I_CLB], L, h * 128 + k); const float fz = zc[WC + k];
        const float sg = sigmoidf_(fz); sc[k] = lb + (1.0f - lb) * sg; sc[128 + k] = (1.0f - lb) * (1.0f - sg) ; sc[256 + k] = zc[k]; }
    const float iv = zc[2 * WC + vcol];
    LDS_WAIT(); asm volatile("" ::: "memory");
    const float* S0 = a.in[I_SHGRN] + (((size_t)L * NS + i) * 6 + h) * 16384 + vcol;
    float* So = a.out + O_HS + (((size_t)L * NS + i) * 6 + h) * 16384 + vcol;
    float o = 0.f;
#pragma unroll 8
    for (int k = 0; k < 128; ++k) { const float n = sc[k] * S0[(size_t)k * 128] + sc[128 + k] * iv; So[(size_t)k * 128] = n; o += n * sc[256 + k]; }
    ((float*)(ws + WS_O))[(size_t)m * WC + h * 128 + vcol] = o;
    LDS_WAIT(); asm volatile("" ::: "memory");
}
__device__ __forceinline__ void sgu_item(const Args& a, int L, int item, LAS unsigned char* lds, int tid, int lane, int wave) {
    unsigned char* ws = a.ws;
    const int g = item & 3, bc = item >> 2, m0 = bc * 128;
    const float* Z = (const float*)(ws + WS_Z);
    LAS float* vn = (LAS float*)lds;
    LAS float* wt = (LAS float*)(lds + 65536);
    const float* wsrc = a.in[I_AWS] + (size_t)(L * 4 + g) * 16384;
    __syncthreads();
    for (int e = tid; e < 16384; e += NTHR) { const int t = e >> 7, s = e & 127; wt[s * 128 + t] = (s <= t) ? wsrc[e] : 0.f; }
    const float* lng = a.in[I_ALNG] + L * WA + g * 128; const float* lnb = a.in[I_ALNB] + L * WA + g * 128;
    for (int rr = 0; rr < 16; ++rr) { const int t = wave * 16 + rr; const float* zr = Z + (size_t)(m0 + t) * PIN + WA + g * 128;
        const float v0 = gelu_erf(zr[lane]), v1 = gelu_erf(zr[64 + lane]);
        const float mean = wave_sum(v0 + v1) * (1.f / 128.f); const float d0 = v0 - mean, d1 = v1 - mean;
        const float rstd = 1.0f / sqrtf(wave_sum(d0 * d0 + d1 * d1) * (1.f / 128.f) + LN_EPS);
        vn[t * 128 + lane] = d0 * rstd * lng[lane] + lnb[lane]; vn[t * 128 + 64 + lane] = d1 * rstd * lng[64 + lane] + lnb[64 + lane]; }
    __syncthreads();
    const int t = tid >> 2, dq = tid & 3, send = (wave * 16 + 15);
    f4 acc[8];
#pragma unroll
    for (int j = 0; j < 8; ++j) acc[j] = (f4){0.f, 0.f, 0.f, 0.f};
    for (int s = 0; s <= send; ++s) { const float w = wt[s * 128 + t]; const LAS f4* vr = (const LAS f4*)(vn + s * 128 + dq * 32);
#pragma unroll
        for (int j = 0; j < 8; ++j) acc[j] += vr[j] * w; }
    const float bs = a.in[I_ABS][(L * 4 + g) * 128 + t];
    const float* ur = Z + (size_t)(m0 + t) * PIN + g * 128 + dq * 32;
    bf16* yo = (bf16*)(ws + WS_YMIX) + (size_t)(m0 + t) * DM + g * 128 + dq * 32;
#pragma unroll
    for (int j = 0; j < 4; ++j) { const f4 u0 = *(const f4*)(ur + 8 * j), u1 = *(const f4*)(ur + 8 * j + 4); const f4 x0 = acc[2 * j] + bs, x1 = acc[2 * j + 1] + bs; v4u o;
        o.x = pg8::cvt_pk_bf16(gelu_erf(u0.x) * x0.x, gelu_erf(u0.y) * x0.y); o.y = pg8::cvt_pk_bf16(gelu_erf(u0.z) * x0.z, gelu_erf(u0.w) * x0.w);
        o.z = pg8::cvt_pk_bf16(gelu_erf(u1.x) * x1.x, gelu_erf(u1.y) * x1.y); o.w = pg8::cvt_pk_bf16(gelu_erf(u1.z) * x1.z, gelu_erf(u1.w) * x1.w);
        *(v4u*)(yo + 8 * j) = o; }
}

__device__ __forceinline__ void hgrn_seq_unit(const Args& a, int L, int unit, LAS unsigned char* lds, int tid, int lane, int wave) {
    unsigned char* ws = a.ws;
    const int b = unit / 6, h = unit - b * 6;
    const float* Z = (const float*)(ws + WS_Z);
    LAS bf16* qs = (LAS bf16*)(lds);
    LAS bf16* ks = (LAS bf16*)(lds + 4352);
    LAS bf16* vt = (LAS bf16*)(lds + 8704);
    LAS bf16* kht = (LAS bf16*)(lds + 12800);
    LAS float* ev = (LAS float*)(lds + 16896);
    LAS float* part = (LAS float*)(lds + 17408);
    const int ch = tid & 127, tq = tid >> 7;
    const float lb = lbound(a.in[I_CLB], L, h * 128 + ch), oml = 1.0f - lb;
    const int pch = (ch & ~31) | (((ch >> 2) & 3) << 3) | (((ch >> 4) & 1) << 2) | (ch & 3);
    const int x = lane & 15, quad = lane >> 4;
    pg8::f32x4 Sacc[8];
#pragma unroll
    for (int mt = 0; mt < 8; ++mt) Sacc[mt] = (pg8::f32x4){0.f, 0.f, 0.f, 0.f};
    const float* zb = Z + (size_t)(b * SEQ + 4 * tq) * PIN + OFF_C + h * 128 + ch;
    float qn[4], fn[4], vn_[4];
#pragma unroll
    for (int j = 0; j < 4; ++j) { const float* p = zb + (size_t)j * PIN; qn[j] = p[0]; fn[j] = p[WC]; vn_[j] = p[2 * WC]; }
    float* O = (float*)(ws + WS_O);
    __syncthreads();
    for (int st = 0; st < SEQ / 16; ++st) {
        float q[4], fz[4], iv[4];
#pragma unroll
        for (int j = 0; j < 4; ++j) { q[j] = qn[j]; fz[j] = fn[j]; iv[j] = vn_[j]; }
        if (st + 1 < SEQ / 16) {
#pragma unroll
            for (int j = 0; j < 4; ++j) { const float* p = zb + (size_t)((st + 1) * 16 + j) * PIN; qn[j] = p[0]; fn[j] = p[WC]; vn_[j] = p[2 * WC]; } }
        float bl[4], kv[4]; float run = 0.f;
#pragma unroll
        for (int j = 0; j < 4; ++j) { const float e = __expf(-fmaxf(fz[j], -80.f)), sg = __builtin_amdgcn_rcpf(1.0f + e);
            run += __logf(lb + oml * sg); bl[j] = run; kv[j] = oml * e * sg; }
        part[tq * 128 + ch] = run;
        __syncthreads();
        const float p0 = part[ch], p1 = part[128 + ch], p2 = part[256 + ch], p3 = part[384 + ch];
        const float tot = (p0 + p1) + (p2 + p3); const float pre = (tq > 0 ? p0 : 0.f) + (tq > 1 ? p1 : 0.f) + (tq > 2 ? p2 : 0.f);
        float kh[4];
#pragma unroll
        for (int j = 0; j < 4; ++j) { const float bj = pre + bl[j]; const int t = 4 * tq + j;
            qs[t * 136 + pch] = bf1(q[j] * __expf(bj)); ks[t * 136 + pch] = bf1(kv[j] * __expf(fminf(-bj, 60.f))); kh[j] = kv[j] * __expf(tot - bj); }
        { u2 w; w.x = pg8::cvt_pk_bf16(kh[0], kh[1]); w.y = pg8::cvt_pk_bf16(kh[2], kh[3]); *(LAS u2*)(kht + ch * 16 + 4 * tq) = w;
          w.x = pg8::cvt_pk_bf16(iv[0], iv[1]); w.y = pg8::cvt_pk_bf16(iv[2], iv[3]); *(LAS u2*)(vt + ch * 16 + 4 * tq) = w; }
        if (tq == 0) ev[ch] = __expf(tot);
        __syncthreads();
        bf16x8 qf[4], kf[4];
#pragma unroll
        for (int kt = 0; kt < 4; ++kt) { qf[kt] = *(const LAS bf16x8*)(qs + x * 136 + 32 * kt + 8 * quad); kf[kt] = *(const LAS bf16x8*)(ks + x * 136 + 32 * kt + 8 * quad); }
        pg8::f32x4 att = (pg8::f32x4){0.f, 0.f, 0.f, 0.f};
#pragma unroll
        for (int kt = 0; kt < 4; ++kt) att = __builtin_amdgcn_mfma_f32_16x16x32_bf16(kf[kt], qf[kt], att, 0, 0, 0);
#pragma unroll
        for (int i = 0; i < 4; ++i) if (4 * quad + i > x) att[i] = 0.f;
        v4u pbu; pbu.x = pg8::cvt_pk_bf16(att[0], att[1]); pbu.y = pg8::cvt_pk_bf16(att[2], att[3]); pbu.z = 0u; pbu.w = 0u;
        const bf16x8 pb = __builtin_bit_cast(bf16x8, pbu);
        const u2 vv = *(const LAS u2*)(vt + (16 * wave + x) * 16 + 4 * quad);
        v4u vfu; vfu.x = vv.x; vfu.y = vv.y; vfu.z = 0u; vfu.w = 0u; const bf16x8 vf = __builtin_bit_cast(bf16x8, vfu);
        pg8::f32x4 o = (pg8::f32x4){0.f, 0.f, 0.f, 0.f};
#pragma unroll
        for (int kt = 0; kt < 4; ++kt) { v4u su; su.x = pg8::cvt_pk_bf16(Sacc[2 * kt][0], Sacc[2 * kt][1]); su.y = pg8::cvt_pk_bf16(Sacc[2 * kt][2], Sacc[2 * kt][3]);
            su.z = pg8::cvt_pk_bf16(Sacc[2 * kt + 1][0], Sacc[2 * kt + 1][1]); su.w = pg8::cvt_pk_bf16(Sacc[2 * kt + 1][2], Sacc[2 * kt + 1][3]);
            o = __builtin_amdgcn_mfma_f32_16x16x32_bf16(__builtin_bit_cast(bf16x8, su), qf[kt], o, 0, 0, 0); }
        o = __builtin_amdgcn_mfma_f32_16x16x32_bf16(vf, pb, o, 0, 0, 0);
        *(pg8::f32x4*)(O + (size_t)(b * SEQ + st * 16 + x) * WC + h * 128 + 16 * wave + 4 * quad) = o;
#pragma unroll
        for (int mt = 0; mt < 8; ++mt) { const pg8::f32x4 e4 = *(const LAS pg8::f32x4*)(ev + 16 * mt + 4 * quad);
            const u2 kk2 = *(const LAS u2*)(kht + (16 * mt + x) * 16 + 4 * quad); v4u ku; ku.x = kk2.x; ku.y = kk2.y; ku.z = 0u; ku.w = 0u;
            Sacc[mt] = __builtin_amdgcn_mfma_f32_16x16x32_bf16(__builtin_bit_cast(bf16x8, ku), vf, Sacc[mt] * e4, 0, 0, 0); }
    }
    float* So = a.out + O_HP + (((size_t)L * NBAT + b) * 6 + h) * 16384;
#pragma unroll
    for (int mt = 0; mt < 8; ++mt)
#pragma unroll
        for (int i = 0; i < 4; ++i) So[(size_t)(16 * mt + 4 * quad + i) * 128 + 16 * wave + x] = Sacc[mt][i];
    __syncthreads();
}

__device__ __forceinline__ void phase_post(const Args& a, int L, int lane, int wave, int blk, int G) {
    unsigned char* ws = a.ws; const int gw = blk * NWAVES + wave, NGW = G * NWAVES;
    const float* Y = (const float*)(ws + WS_Y); const float* O = (const float*)(ws + WS_O); const float* Gt = (const float*)(ws + WS_G); const float* Z = (const float*)(ws + WS_Z);
    const float* gng = a.in[I_BGNG] + L * WB; const float* gnb = a.in[I_BGNB] + L * WB; const float* rk = a.in[I_BRK] + L * WB; const float* cng = a.in[I_CNG] + L * WC;
    for (int m = gw; m < MV; m += NGW) {
        bf16* yo = (bf16*)(ws + WS_YMIX) + (size_t)m * DM;
        float yv[12], rr[12], kp[12], vv[12], gg[12], ov[12], gz[12];
#pragma unroll
        for (int j = 0; j < 12; ++j) { const int c = 64 * j + lane;
            const float* rec = (m < MP) ? (const float*)(ws + WS_RPB) + (((size_t)(m >> 11) * 12 + j) * SEQ + (m & (SEQ - 1))) * 384 : (const float*)(ws + WS_RPS) + ((size_t)(m - MP) * 12 + j) * 384;
            yv[j] = Y[(size_t)m * WB + c]; rr[j] = rec[lane]; kp[j] = rec[128 + lane]; vv[j] = rec[192 + lane]; gg[j] = Gt[(size_t)m * WB + c];
            ov[j] = O[(size_t)m * WC + c]; gz[j] = Z[(size_t)m * PIN + OFF_C + 3 * WC + c]; }
        float ss = 0.f;
#pragma unroll
        for (int j = 0; j < 12; ++j) { const int c = 64 * j + lane; const float y = yv[j];
            const float mean = wave_sum(y) * (1.f / 64.f); const float d = y - mean; const float rstd = 1.0f / sqrtf(wave_sum(d * d) * (1.f / 64.f) + GN_EPS);
            const float bonus = wave_sum(rr[j] * kp[j] * rk[c]);
            yo[WA + c] = bf1((d * rstd * gng[c] + gnb[c] + bonus * vv[j]) * gg[j]); ss += ov[j] * ov[j]; }
        const float rms = 1.0f / sqrtf(wave_sum(ss) * (1.f / WC) + RMS_EPS);
#pragma unroll
        for (int j = 0; j < 12; ++j) { const int c = 64 * j + lane; yo[WA + WB + c] = bf1(ov[j] * rms * cng[c] * (gz[j] * sigmoidf_(gz[j]))); }
    }
}

#ifndef EN_PRO
#define EN_PRO 1
#endif
#ifndef EN_G1
#define EN_G1 1
#endif
#ifndef EN_PREP
#define EN_PREP 1
#endif
#ifndef EN_MIX
#define EN_MIX 1
#endif
#ifndef EN_POST
#define EN_POST 1
#endif
#ifndef EN_G3
#define EN_G3 1
#endif
#ifndef EN_LN
#define EN_LN 1
#endif
#ifndef EN_G4
#define EN_G4 1
#endif
#ifndef EN_G5
#define EN_G5 1
#endif
#ifndef REP_PHASE
#define REP_PHASE -1
#endif
#define NREP(k) ((REP_PHASE) == (k) ? 2 : 1)
#ifndef MK_SINGLE
#define MK_SINGLE 1
#endif
constexpr int N_PHASES = 1 + 9 * DEPTH;
constexpr int SCAN_UNITS = NBAT * 12 * 2, HSEQ_UNITS = NBAT * 6, ROLE_BLOCKS = SCAN_UNITS + HSEQ_UNITS;
constexpr int N_SGU = NBAT * 16 * 4, N_RS = NS * 12 / 8, N_HS = NS * 6 / 4, N_MISC = N_SGU + N_RS + N_HS;

__global__ void __launch_bounds__(NTHR, 2) mk_fwd(Args a) {
    extern __shared__ __attribute__((aligned(16))) unsigned char lds_raw[];
    LAS unsigned char* lds = (LAS unsigned char*)lds_raw;
    const int tid = threadIdx.x, lane = tid & 63, wave = __builtin_amdgcn_readfirstlane(tid >> 6), blk = blockIdx.x, G = gridDim.x;
    unsigned char* ws = a.ws;
    volatile LAS unsigned* MISC = (volatile LAS unsigned*)(lds + MISC_OFF);
    for (int u = tid; u < (LDS_BYTES - LDSCTL_OFF) / 4; u += NTHR) ((LAS unsigned*)(lds + LDSCTL_OFF))[u] = 0u;
    __syncthreads();
    const int lo = a.ph_lo, hi = a.ph_hi;
    XcdBarrier bar; bar.bar = (unsigned*)(ws + WS_CTL) + CW_BAR; bar.x = 0; bar.st = nullptr;
    if (hi - lo > 1) bar = xcd_barrier_post((unsigned*)(ws + WS_CTL) + CW_BAR, MISC + 8);
#define IN(k) (lo <= (k) && (k) < hi)
#define SEAM(k) do { if (IN(k) && IN((k) + 1)) { xcd_barrier(bar); } } while (0)
    bf16* HB = (bf16*)(ws + WS_HB); float* H = (float*)(ws + WS_H); float* T = (float*)(ws + WS_T);

    #if EN_PRO
    if (IN(0)) for (int rep = 0; rep < NREP(0); ++rep) { phase_prologue(a, lds, lane, wave, blk, G); __syncthreads(); }
#endif
    SEAM(0);
    for (int L = 0; L < DEPTH; ++L) {
        const int pb = 1 + 9 * L;
#define LAUNDER() int tid_ = threadIdx.x; asm volatile("" : "+v"(tid_)); const int lane_ = tid_ & 63; const int wave_ = __builtin_amdgcn_readfirstlane(tid_ >> 6)
#if EN_G1
        if (IN(pb)) for (int rep = 0; rep < NREP(1); ++rep) {
            { pg8::Gemm g{HB, (const bf16*)(ws + WS_WIN + L * SZ_WIN), MPAD, PIN, DM}; pg8::StaticOrder S; S.init(MPAD, PIN, G, blk);
              pg8::EpiF32 E{(float*)(ws + WS_Z), PIN}; pg8::gemm_phase<pg8::EpiF32, pg8::StaticOrder, true, true>(lds, g, S, E); }
            { pg8::Gemm g{(const bf16*)(ws + WS_PBF + L * SZ_PBF), (const bf16*)(ws + WS_WPP + L * SZ_WPP), MPAD, DM, DPLE}; pg8::StaticOrder S; S.init(MPAD, DM, G, G - 1 - blk);
              pg8::EpiF32 E{(float*)(ws + WS_PPO), DM}; pg8::gemm_phase<pg8::EpiF32, pg8::StaticOrder, true, true>(lds, g, S, E); }
        }
#endif
        SEAM(pb);
#if EN_PREP
        if (IN(pb + 1)) for (int rep = 0; rep < NREP(2); ++rep) { LAUNDER(); phase_prep(a, L, lds, tid_, lane_, wave_, blk, G); }
#endif
        SEAM(pb + 1);
#if EN_MIX
        if (IN(pb + 2)) for (int rep = 0; rep < NREP(3); ++rep) {
            LAUNDER(); const int tid = tid_, lane = lane_, wave = wave_;
            if (blk < SCAN_UNITS) { for (int r2 = 0; r2 < NREP(31); ++r2) rwkv_scan_unit(a, L, blk, lds, tid, lane, wave); }
            else if (blk < ROLE_BLOCKS) { for (int r2 = 0; r2 < NREP(32); ++r2) hgrn_seq_unit(a, L, blk - SCAN_UNITS, lds, tid, lane, wave); }
            else for (int r2 = 0; r2 < NREP(33); ++r2) for (int it = blk - ROLE_BLOCKS; it < N_MISC; it += G - ROLE_BLOCKS) {
                if (it < N_SGU) sgu_item(a, L, it, lds, tid, lane, wave);
                else if (it < N_SGU + N_RS) rwkv_sample_item(a, L, it - N_SGU, lds, lane, wave);
                else hgrn_sample_item(a, L, it - N_SGU - N_RS, lds, lane, wave);
                __syncthreads();
            }
        }
#endif
        SEAM(pb + 2);
#if EN_POST
        if (IN(pb + 3)) for (int rep = 0; rep < NREP(4); ++rep) { LAUNDER(); phase_post(a, L, lane_, wave_, blk, G); }
#endif
        SEAM(pb + 3);
#if EN_G3
        if (IN(pb + 4)) for (int rep = 0; rep < NREP(5); ++rep) {
            pg8::Gemm g{(const bf16*)(ws + WS_YMIX), (const bf16*)(ws + WS_WOUT + L * SZ_WOUT), MPAD, DM, DM}; pg8::StaticOrder S; S.init(MPAD, DM, G, blk);
            pg8::EpiResid E{T, H, nullptr, DM, DN_ALPHA}; pg8::gemm_phase<pg8::EpiResid, pg8::StaticOrder, true, true>(lds, g, S, E);
        }
#endif
        SEAM(pb + 4);
#if EN_LN
        if (IN(pb + 5)) for (int rep = 0; rep < NREP(6); ++rep) { LAUNDER(); phase_ln(a, a.in[I_LN1G] + L * DM, a.in[I_LN1B] + L * DM, false, lane_, wave_, blk, G); }
#endif
        SEAM(pb + 5);
#if EN_G4
        if (IN(pb + 6)) for (int rep = 0; rep < NREP(7); ++rep) {
            { pg8::Gemm g{HB, (const bf16*)(ws + WS_WGU + L * SZ_WGU), MPAD, 2 * DFF, DM}; pg8::StaticOrder S; S.init(MPAD, 2 * DFF, G, blk);
              pg8::EpiSwiglu E{(bf16*)(ws + WS_ACT), DFF}; pg8::gemm_phase<pg8::EpiSwiglu, pg8::StaticOrder, true, true>(lds, g, S, E); }
            { pg8::Gemm g{HB, (const bf16*)(ws + WS_WPG + L * SZ_WPG), MPAD, DM, DM}; pg8::StaticOrder S; S.init(MPAD, DM, G, G - 1 - blk);
              pg8::EpiSigMul E{(float*)(ws + WS_PLE), (const float*)(ws + WS_PPO), DM}; pg8::gemm_phase<pg8::EpiSigMul, pg8::StaticOrder, true, true>(lds, g, S, E); }
        }
#endif
        SEAM(pb + 6);
#if EN_G5
        if (IN(pb + 7)) for (int rep = 0; rep < NREP(8); ++rep) {
            pg8::Gemm g{(const bf16*)(ws + WS_ACT), (const bf16*)(ws + WS_WD + L * SZ_WD), MPAD, DM, DFF}; pg8::StaticOrder S; S.init(MPAD, DM, G, blk);
            pg8::EpiResid E{T, H, (const float*)(ws + WS_PLE), DM, DN_ALPHA}; pg8::gemm_phase<pg8::EpiResid, pg8::StaticOrder, true, true>(lds, g, S, E);
        }
#endif
        SEAM(pb + 7);
#if EN_LN
        if (IN(pb + 8)) for (int rep = 0; rep < NREP(6); ++rep) { LAUNDER(); phase_ln(a, a.in[I_LN2G] + L * DM, a.in[I_LN2B] + L * DM, L == DEPTH - 1, lane_, wave_, blk, G); }
#endif
        SEAM(pb + 8);
    }
#undef IN
#undef SEAM
}

extern "C" void kernel_launch(void* const* d_in, const int* in_sizes, int n_in, void* d_out, int out_size, void* d_ws, size_t ws_size, hipStream_t stream) {
    static int grid = 0;
    if (grid == 0) {
        if (n_in != N_IN || (size_t)out_size != O_END || ws_size < WS_END) { fprintf(stderr, "kernel_launch: unexpected sizes n_in %d out %d ws %zu (need %zu)\n", n_in, out_size, ws_size, (size_t)WS_END); grid = -1; return; }
        int dev = 0, cus = 0, per_cu = 0;
        if (hipGetDevice(&dev) != hipSuccess || hipDeviceGetAttribute(&cus, hipDeviceAttributeMultiprocessorCount, dev) != hipSuccess) { grid = -1; return; }
        if (hipFuncSetAttribute((const void*)mk_fwd, hipFuncAttributeMaxDynamicSharedMemorySize, LDS_BYTES) != hipSuccess) { fprintf(stderr, "kernel_launch: hipFuncSetAttribute failed\n"); grid = -1; return; }
        if (hipOccupancyMaxActiveBlocksPerMultiprocessor(&per_cu, (const void*)mk_fwd, NTHR, LDS_BYTES) != hipSuccess || per_cu < 1) fprintf(stderr, "kernel_launch: occupancy query says %d\n", per_cu);
        (void)hipGetLastError();
        grid = cus;
        if (grid < ROLE_BLOCKS + 8) { fprintf(stderr, "kernel_launch: %d CUs is too few\n", grid); grid = -1; return; }
    }
    if (grid < 0) return;
    if (hipMemsetAsync((char*)d_ws + WS_CTL, 0, CTL_ZERO_BYTES, stream) != hipSuccess) return;
    Args a{};
    for (int i = 0; i < N_IN; ++i) a.in[i] = (const float*)d_in[i];
    a.out = (float*)d_out; a.ws = (unsigned char*)d_ws;
#if MK_SINGLE
    a.ph_lo = 0; a.ph_hi = N_PHASES;
    hipLaunchKernelGGL(mk_fwd, dim3(grid), dim3(NTHR), LDS_BYTES, stream, a);
#else
    for (int p = 0; p < N_PHASES; ++p) { a.ph_lo = p; a.ph_hi = p + 1; hipLaunchKernelGGL(mk_fwd, dim3(grid), dim3(NTHR), LDS_BYTES, stream, a); }
#endif
}
```

```cpp
#include <hip/hip_runtime.h>
#include <cstdio>
#include <cstdint>
namespace pg8 {
#define PG8_LAS __attribute__((address_space(3)))
typedef unsigned short bf16_t;
typedef short bf16x8 __attribute__((ext_vector_type(8)));
typedef float f32x4 __attribute__((ext_vector_type(4)));
typedef unsigned u32x4 __attribute__((ext_vector_type(4)));
constexpr int BM = 256, BK = 64, HALF = 128, HTB = HALF * BK * 2  , STAGE_BYTES = 8 * HTB, NXCD = 8, WGM = 8;

__host__ __device__ __forceinline__ int lds_byte(int r, int c) { const int st = (r >> 4) * 2 + (c >> 5), rr = r & 15, cc = c & 31, ob = rr * 64 + cc * 2; return st * 1024 + (ob ^ (((ob >> 9) & 1) << 5)); }
__host__ __device__ __forceinline__ void stage_rc(int b, int& R, int& C) { const int st = b / 1024, sb = b % 1024, swz = sb ^ (((sb >> 9) & 1) << 5); R = (st >> 1) * 16 + swz / 64; C = (st & 1) * 32 + (swz % 64) / 2; }
__host__ __device__ __forceinline__ int perm32(int rho) { const int n = rho >> 4, i = rho & 15; return 8 * (i >> 2) + 4 * n + (i & 3); }

struct Unit { int pm, pn; };
struct Gemm { const bf16_t* A; const bf16_t* Bt; int M, N, K; };

struct StaticOrder {
    int nM, nN, nwg, G, c;
    __host__ __device__ void init(int M, int N, int G_, int c_) { nM = M / BM; nN = N / BM; nwg = nM * nN; G = G_; c = c_; }
    __host__ __device__ bool next(int i, Unit& u) const {
        const long L = (long)i * G + c; if (L >= nwg) return false;
        int wgid = (int)L; { const int q = nwg / NXCD, r = nwg % NXCD, xcd = wgid % NXCD, off = wgid / NXCD; wgid = (xcd < r ? xcd * (q + 1) : r * (q + 1) + (xcd - r) * q) + off; }
        const int nig = WGM * nN, gid = wgid / nig, fm = gid * WGM, gsz = (nM - fm) < WGM ? (nM - fm) : WGM;
        u.pm = fm + ((wgid % nig) % gsz); u.pn = (wgid % nig) / gsz; return true;
    }
    __device__ __forceinline__ void a_ready(const Unit&) const {}
    __device__ __forceinline__ void done(const Unit&) const {}
};

__device__ __forceinline__ unsigned cvt_pk_bf16(float lo, float hi) { unsigned r; asm volatile("v_cvt_pk_bf16_f32 %0, %1, %2" : "=v"(r) : "v"(lo), "v"(hi)); return r; }
typedef float f32x2 __attribute__((ext_vector_type(2)));
struct EpiF32 {
    static constexpr bool PERM = false, AFTER_DRAIN = false;
    float* C; int ldc;
    __device__ __forceinline__ void operator()(const f32x4 (&acc)[2][2][4][2], const Unit& u, int wr, int wc, int fr, int fq) const {
        const int row0 = u.pm * BM + wr * 64 + fr, col0 = u.pn * BM + wc * 32 + 4 * fq;
#pragma unroll
        for (int ai = 0; ai < 2; ++ai)
#pragma unroll
            for (int m = 0; m < 4; ++m) { float* rowp = C + (size_t)(row0 + ai * HALF + m * 16) * ldc + col0;
#pragma unroll
                for (int bj = 0; bj < 2; ++bj)
#pragma unroll
                    for (int n = 0; n < 2; ++n) *(f32x4*)(rowp + bj * HALF + n * 16) = acc[ai][bj][m][n]; }
    }
};
struct EpiResid {
    static constexpr bool PERM = false, AFTER_DRAIN = false;
    float* out; const float* base; const float* add; int ldc; float alpha;
    __device__ __forceinline__ void operator()(const f32x4 (&acc)[2][2][4][2], const Unit& u, int wr, int wc, int fr, int fq) const {
        const int row0 = u.pm * BM + wr * 64 + fr, col0 = u.pn * BM + wc * 32 + 4 * fq;
#pragma unroll
        for (int ai = 0; ai < 2; ++ai)
#pragma unroll
            for (int m = 0; m < 4; ++m) { const size_t off = (size_t)(row0 + ai * HALF + m * 16) * ldc + col0;
#pragma unroll
                for (int bj = 0; bj < 2; ++bj)
#pragma unroll
                    for (int n = 0; n < 2; ++n) { const size_t o2 = off + bj * HALF + n * 16; f32x4 v = *(const f32x4*)(base + o2) * alpha + acc[ai][bj][m][n];
                        if (add) v += *(const f32x4*)(add + o2); *(f32x4*)(out + o2) = v; } }
    }
};
struct EpiSigMul {
    static constexpr bool PERM = false, AFTER_DRAIN = false;
    float* out; const float* mul; int ldc;
    __device__ __forceinline__ void operator()(const f32x4 (&acc)[2][2][4][2], const Unit& u, int wr, int wc, int fr, int fq) const {
        const int row0 = u.pm * BM + wr * 64 + fr, col0 = u.pn * BM + wc * 32 + 4 * fq;
#pragma unroll
        for (int ai = 0; ai < 2; ++ai)
#pragma unroll
            for (int m = 0; m < 4; ++m) { const size_t off = (size_t)(row0 + ai * HALF + m * 16) * ldc + col0;
#pragma unroll
                for (int bj = 0; bj < 2; ++bj)
#pragma unroll
                    for (int n = 0; n < 2; ++n) { const size_t o2 = off + bj * HALF + n * 16; const f32x4 x = acc[ai][bj][m][n]; const f32x4 p = *(const f32x4*)(mul + o2); f32x4 v;
#pragma unroll
                        for (int e = 0; e < 4; ++e) v[e] = p[e] * __builtin_amdgcn_rcpf(1.0f + __expf(-x[e]));
                        *(f32x4*)(out + o2) = v; } }
    }
};
struct EpiSwiglu {
    static constexpr bool PERM = true, AFTER_DRAIN = false;
    bf16_t* O; int ldo;
    __device__ __forceinline__ void operator()(const f32x4 (&acc)[2][2][4][2], const Unit& u, int wr, int wc, int fr, int fq) const {
        const int row0 = u.pm * BM + wr * 64 + fr, col0 = u.pn * HALF + wc * 32 + 8 * fq;
#pragma unroll
        for (int ai = 0; ai < 2; ++ai)
#pragma unroll
            for (int m = 0; m < 4; ++m) { bf16_t* rowp = O + (size_t)(row0 + ai * HALF + m * 16) * ldo + col0; float r[8];
#pragma unroll
                for (int n = 0; n < 2; ++n)
#pragma unroll
                    for (int e = 0; e < 4; ++e) { const float g = acc[ai][0][m][n][e], up = acc[ai][1][m][n][e]; r[4 * n + e] = g * __builtin_amdgcn_rcpf(1.0f + __expf(-g)) * up; }
                u32x4 w; w.x = cvt_pk_bf16(r[0], r[1]); w.y = cvt_pk_bf16(r[2], r[3]); w.z = cvt_pk_bf16(r[4], r[5]); w.w = cvt_pk_bf16(r[6], r[7]);
                *(u32x4*)rowp = w; }
    }
};
template <class Epi, class Sched, bool ALIGN_EPI = false, bool SP2 = false>
__device__ __forceinline__ void gemm_phase(PG8_LAS unsigned char* lds, const Gemm g, const Sched& S, const Epi& E) {
    int tid_l = threadIdx.x; asm volatile("" : "+v"(tid_l));
    const int tid = tid_l, wid = __builtin_amdgcn_readfirstlane(tid >> 6), lane = tid & 63, wr = wid >> 2, wc = wid & 3, fr = lane & 15, fq = lane >> 4;
    const int K = g.K, nt = K / BK;
    unsigned voffA[2], voffB[2];
#pragma unroll
    for (int i = 0; i < 2; ++i) { int R, C; stage_rc(tid * 16 + i * 8192, R, C); const int Rb = Epi::PERM ? ((R & ~31) + perm32(R & 31)) : R;
        voffA[i] = (unsigned)(R * K + C) * 2u; voffB[i] = (unsigned)(Rb * K + C) * 2u; }
    const size_t kstep = (size_t)(BK * 2);
    const size_t hstep = (size_t)HALF * K * 2;
    const size_t tstep = 2 * hstep;
    const unsigned ldsw = (unsigned)wid * 1024u;
    const int aoff = lds_byte(wr * 64 + fr, fq * 8), boff = lds_byte(wc * 32 + fr, fq * 8);
#define PG8_SA(b, h) (((b) * 2 + (h)) * HTB)
#define PG8_SB(b, h) ((4 + (b) * 2 + (h)) * HTB)
#define PG8_STAGE(bufoff, gbase, voff) do { _Pragma("unroll") for (int _i = 0; _i < 2; ++_i) \
        __builtin_amdgcn_global_load_lds((const unsigned*)((const char*)(gbase) + (voff)[_i]), (PG8_LAS unsigned*)(lds + (bufoff) + ldsw + _i * 8192), 16, 0, 0); } while (0)
#define PG8_LDA(dst, b, h) do { _Pragma("unroll") for (int m = 0; m < 4; ++m) _Pragma("unroll") for (int k = 0; k < 2; ++k) dst[m][k] = *(const PG8_LAS bf16x8*)(lds + PG8_SA(b, h) + aoff + m * 2048 + k * 1024); } while (0)
#define PG8_LDB(dst, b, h) do { _Pragma("unroll") for (int n = 0; n < 2; ++n) _Pragma("unroll") for (int k = 0; k < 2; ++k) dst[n][k] = *(const PG8_LAS bf16x8*)(lds + PG8_SB(b, h) + boff + n * 2048 + k * 1024); } while (0)
#define PG8_MMA(ai, bj, At, Bt) do { __builtin_amdgcn_s_setprio(1); _Pragma("unroll") for (int m = 0; m < 4; ++m) _Pragma("unroll") for (int n = 0; n < 2; ++n) _Pragma("unroll") for (int k = 0; k < 2; ++k) \
        acc[ai][bj][m][n] = __builtin_amdgcn_mfma_f32_16x16x32_bf16(Bt[n][k], At[m][k], acc[ai][bj][m][n], 0, 0, 0); __builtin_amdgcn_s_setprio(0); } while (0)
#define PG8_WAIT_V(n) asm volatile("s_waitcnt vmcnt(" #n ")" ::: "memory")
#define PG8_WAIT_L(n) asm volatile("s_waitcnt lgkmcnt(" #n ")" ::: "memory")
#define PG8_BAR __builtin_amdgcn_s_barrier()
#define PG8_SCHED __builtin_amdgcn_sched_barrier(0)
    Unit cur, nxt; int ui = 0;
    if (!S.next(0, cur)) return;
    f32x4 acc[2][2][4][2];
#pragma unroll
    for (int a = 0; a < 2; ++a)
#pragma unroll
        for (int b = 0; b < 2; ++b)
#pragma unroll
            for (int m = 0; m < 4; ++m)
#pragma unroll
                for (int n = 0; n < 2; ++n) acc[a][b][m][n] = (f32x4){0.f, 0.f, 0.f, 0.f};
    bf16x8 At[4][2], B0[2][2], B1[2][2];
    const char* cA = (const char*)g.A + (size_t)cur.pm * tstep; const char* cB = (const char*)g.Bt + (size_t)cur.pn * tstep;
    S.a_ready(cur);
    if constexpr (SP2) {
        PG8_STAGE(PG8_SB(0, 0), cB, voffB); PG8_STAGE(PG8_SB(0, 1), cB + hstep, voffB); PG8_STAGE(PG8_SA(0, 0), cA, voffA); PG8_STAGE(PG8_SA(0, 1), cA + hstep, voffA);
        if (wr == 1) PG8_BAR;
        PG8_WAIT_V(2); PG8_BAR;
        PG8_STAGE(PG8_SB(1, 0), cB + kstep, voffB); PG8_STAGE(PG8_SA(1, 0), cA + kstep, voffA); PG8_STAGE(PG8_SB(1, 1), cB + hstep + kstep, voffB);
        PG8_WAIT_V(6); PG8_BAR;
    } else {
        PG8_STAGE(PG8_SB(0, 0), cB, voffB); PG8_STAGE(PG8_SA(0, 0), cA, voffA); PG8_STAGE(PG8_SB(0, 1), cB + hstep, voffB); PG8_STAGE(PG8_SA(0, 1), cA + hstep, voffA);
        if (wr == 1) PG8_BAR;
        PG8_WAIT_V(4); PG8_BAR;
        PG8_STAGE(PG8_SB(1, 0), cB + kstep, voffB); PG8_STAGE(PG8_SA(1, 0), cA + kstep, voffA); PG8_STAGE(PG8_SB(1, 1), cB + hstep + kstep, voffB);
        PG8_WAIT_V(6); PG8_BAR;
    }
    for (;;) {
        const bool has_next = S.next(ui + 1, nxt);
        const char* nA = has_next ? (const char*)g.A + (size_t)nxt.pm * tstep : cA; const char* nB = has_next ? (const char*)g.Bt + (size_t)nxt.pn * tstep : cB;
        for (int t = 0; t < nt; t += 2) {
            const bool last = (t == nt - 2);
            const char* a1 = cA + (size_t)(t + 1) * kstep;
            const char* a2 = last ? nA : cA + (size_t)(t + 2) * kstep; const char* b2 = last ? nB : cB + (size_t)(t + 2) * kstep;
            const char* a3 = a2 + kstep; const char* b3 = b2 + kstep;
            if (last && has_next) S.a_ready(nxt);
            if constexpr (SP2) {
            PG8_LDB(B0, 0, 0); PG8_LDB(B1, 0, 1); PG8_SCHED; PG8_LDA(At, 0, 0); PG8_STAGE(PG8_SA(1, 1), a1 + hstep, voffA);
            PG8_WAIT_V(8); PG8_WAIT_L(0); PG8_BAR; PG8_MMA(0, 0, At, B0); PG8_MMA(0, 1, At, B1); PG8_BAR; PG8_SCHED;
            PG8_LDA(At, 0, 1); PG8_STAGE(PG8_SB(0, 0), b2, voffB); PG8_STAGE(PG8_SB(0, 1), b2 + hstep, voffB); PG8_STAGE(PG8_SA(0, 0), a2, voffA);
            PG8_WAIT_V(8); PG8_WAIT_L(0); PG8_BAR; PG8_MMA(1, 0, At, B0); PG8_MMA(1, 1, At, B1); PG8_BAR; PG8_SCHED;
            PG8_LDB(B0, 1, 0); PG8_LDB(B1, 1, 1); PG8_SCHED; PG8_LDA(At, 1, 0); PG8_STAGE(PG8_SA(0, 1), a2 + hstep, voffA);
            PG8_WAIT_V(8); PG8_WAIT_L(0); PG8_BAR; PG8_MMA(0, 0, At, B0); PG8_MMA(0, 1, At, B1); PG8_BAR; PG8_SCHED;
            PG8_LDA(At, 1, 1); PG8_STAGE(PG8_SB(1, 0), b3, voffB); PG8_STAGE(PG8_SB(1, 1), b3 + hstep, voffB); PG8_STAGE(PG8_SA(1, 0), a3, voffA);
            PG8_WAIT_V(8); PG8_WAIT_L(0); PG8_BAR; PG8_MMA(1, 0, At, B0); PG8_MMA(1, 1, At, B1); PG8_BAR; PG8_SCHED;
            } else {
            PG8_LDB(B0, 0, 0); PG8_SCHED; PG8_LDA(At, 0, 0); PG8_STAGE(PG8_SA(1, 1), a1 + hstep, voffA);
            PG8_WAIT_L(8); PG8_BAR; PG8_WAIT_L(0); PG8_MMA(0, 0, At, B0); PG8_BAR; PG8_SCHED;
            PG8_LDB(B1, 0, 1); PG8_STAGE(PG8_SB(0, 0), b2, voffB);
            PG8_BAR; PG8_WAIT_L(0); PG8_MMA(0, 1, At, B1); PG8_BAR;
            PG8_LDA(At, 0, 1); PG8_STAGE(PG8_SA(0, 0), a2, voffA);
            PG8_BAR; PG8_WAIT_L(0); PG8_MMA(1, 0, At, B0); PG8_BAR; PG8_SCHED;
            PG8_STAGE(PG8_SB(0, 1), b2 + hstep, voffB);
            PG8_WAIT_V(6); PG8_BAR; PG8_MMA(1, 1, At, B1); PG8_BAR;
            PG8_LDB(B0, 1, 0); PG8_SCHED; PG8_LDA(At, 1, 0); PG8_STAGE(PG8_SA(0, 1), a2 + hstep, voffA);
            PG8_WAIT_L(8); PG8_BAR; PG8_WAIT_L(0); PG8_MMA(0, 0, At, B0); PG8_BAR; PG8_SCHED;
            PG8_LDB(B1, 1, 1); PG8_STAGE(PG8_SB(1, 0), b3, voffB);
            PG8_BAR; PG8_WAIT_L(0); PG8_MMA(0, 1, At, B1); PG8_BAR;
            PG8_LDA(At, 1, 1); PG8_STAGE(PG8_SA(1, 0), a3, voffA);
            PG8_BAR; PG8_WAIT_L(0); PG8_MMA(1, 0, At, B0); PG8_BAR; PG8_SCHED;
            PG8_STAGE(PG8_SB(1, 1), b3 + hstep, voffB);
            PG8_WAIT_V(6); PG8_BAR; PG8_MMA(1, 1, At, B1); PG8_BAR;
            }
        }
        if constexpr (ALIGN_EPI) { if (wr == 0) PG8_BAR; }
        if constexpr (!Epi::AFTER_DRAIN) { E(acc, cur, wr, wc, fr, fq); S.done(cur); }
        if (!has_next) break;
#pragma unroll
        for (int a = 0; a < 2; ++a)
#pragma unroll
            for (int b = 0; b < 2; ++b)
#pragma unroll
                for (int m = 0; m < 4; ++m)
#pragma unroll
                    for (int n = 0; n < 2; ++n) acc[a][b][m][n] = (f32x4){0.f, 0.f, 0.f, 0.f};
        cur = nxt; cA = nA; cB = nB; ++ui;
        if constexpr (ALIGN_EPI) { if (wr == 1) PG8_BAR; }
    }
    PG8_WAIT_V(0);
    if constexpr (!ALIGN_EPI) { if (wr == 0) PG8_BAR; }
    PG8_BAR;
    if constexpr (Epi::AFTER_DRAIN) { E.fused(acc, cur, wr, wc, fr, fq, lds, wid, lane); S.done(cur); }
#undef PG8_SA
#undef PG8_SB
#undef PG8_STAGE
#undef PG8_LDA
#undef PG8_LDB
#undef PG8_MMA
#undef PG8_WAIT_V
#undef PG8_WAIT_L
#undef PG8_BAR
#undef PG8_SCHED
}
}
#define GAS __attribute__((address_space(1)))
#define LAS __attribute__((address_space(3)))
typedef unsigned short bf16;
typedef unsigned v4u __attribute__((ext_vector_type(4)));
typedef float f32x4 __attribute__((ext_vector_type(4)));
typedef short bf16x8 __attribute__((ext_vector_type(8)));
typedef GAS unsigned gu32;
typedef GAS unsigned long long gu64;
#define RLX_AGENT __ATOMIC_RELAXED, __HIP_MEMORY_SCOPE_AGENT
#define LDS_WAIT() asm volatile("s_waitcnt lgkmcnt(0)" ::: "memory")
#define VM_WAIT() asm volatile("s_waitcnt vmcnt(0)" ::: "memory")
__device__ __forceinline__ unsigned long long rt() { return __builtin_amdgcn_s_memrealtime(); }
__device__ __forceinline__ unsigned f2bf(float f) { unsigned u = __builtin_bit_cast(unsigned, f); return (u + 0x7fffu + ((u >> 16) & 1u)) >> 16; }
__device__ __forceinline__ unsigned pk2(float lo, float hi) { return f2bf(lo) | (f2bf(hi) << 16); }

#define XB_TMO      128
#define XB_XCNT(j)  (256  + 64 * (j))
#define XB_XSUB(j)  (1280 + 64 * (j))
#define XB_XGEN(j)  (2304 + 64 * (j))
#define XB_TOP      3328
#define XB_TOPGEN   3392
#define XCD_BAR_WORDS 3456
#define XB_SPIN_CAP (1u << 18)

__device__ __forceinline__ unsigned xb_ld(unsigned* p)              { return __hip_atomic_load(p, __ATOMIC_RELAXED, __HIP_MEMORY_SCOPE_AGENT); }
__device__ __forceinline__ unsigned xb_add(unsigned* p, unsigned v) { return __hip_atomic_fetch_add(p, v, __ATOMIC_RELAXED, __HIP_MEMORY_SCOPE_AGENT); }
__device__ __forceinline__ unsigned xb_xcc_id() { return (unsigned)__builtin_amdgcn_s_getreg((3 << 11) | 20) & 0xFu; }
#define XB_SPIN(cond, bar) do { unsigned _sp = 0; while (cond) { __builtin_amdgcn_s_sleep(1); \
    if ((++_sp & 255u) == 0u) { if (xb_ld(&(bar)[XB_TMO])) break; if (_sp > XB_SPIN_CAP) { atomicAdd(&(bar)[XB_TMO], 1u); break; } } } } while (0)

struct XcdBarrier {
    unsigned* bar; unsigned x;
    volatile LAS unsigned* st;
};

__device__ __forceinline__ XcdBarrier xcd_barrier_post(unsigned* bar, volatile LAS unsigned* st) {
    XcdBarrier b; b.bar = bar; b.x = xb_xcc_id(); b.st = st;
    if (threadIdx.x == 0) (void)xb_add(&bar[XB_XCNT(b.x)], 1u);
    return b;
}
__device__ __forceinline__ void xcd_barrier_complete(unsigned* bar, unsigned x, unsigned& nloc, unsigned& nx) {
    const unsigned G = gridDim.x * gridDim.y * gridDim.z;
    unsigned sum, cnt, mine, sp = 0u;
    for (;;) {
        sum = 0u; cnt = 0u; mine = 0u;
#pragma unroll
        for (unsigned j = 0; j < 16; ++j) { const unsigned c = xb_ld(&bar[XB_XCNT(j)]); sum += c; cnt += (c > 0u) ? 1u : 0u; mine = (j == x) ? c : mine; }
        if (sum == G) break;
        __builtin_amdgcn_s_sleep(1);
        if ((++sp & 255u) == 0u) { if (xb_ld(&bar[XB_TMO])) break; if (sp > XB_SPIN_CAP) { atomicAdd(&bar[XB_TMO], 1u); break; } }
    }
    nloc = mine > 0u ? mine : 1u; nx = cnt > 0u ? cnt : 1u;
}

__device__ __forceinline__ void xcd_barrier(const XcdBarrier& b) {
    asm volatile("s_waitcnt vmcnt(0)" ::: "memory");
    __syncthreads();
    if (threadIdx.x == 0) {
        unsigned* bar = b.bar;
        __builtin_amdgcn_s_waitcnt(0);
        unsigned nloc = b.st[0], nx = b.st[1];
        if (nloc == 0u) { xcd_barrier_complete(bar, b.x, nloc, nx); b.st[0] = nloc; b.st[1] = nx; }
        const unsigned old = xb_add(&bar[XB_XSUB(b.x)], 1u);
        const unsigned gen = old / nloc;
        if (old + 1u == (gen + 1u) * nloc) {
            __builtin_amdgcn_fence(__ATOMIC_RELEASE, "agent");
            asm volatile("s_waitcnt vmcnt(0)" ::: "memory");
            const unsigned og = xb_add(&bar[XB_TOP], 1u);
            const unsigned tg = og / nx;
            if (og + 1u == (tg + 1u) * nx) xb_add(&bar[XB_TOPGEN], 1u);
            else XB_SPIN(xb_ld(&bar[XB_TOPGEN]) == tg, bar);
            __builtin_amdgcn_fence(__ATOMIC_ACQUIRE, "agent");
            xb_add(&bar[XB_XGEN(b.x)], 1u);
            asm volatile("s_waitcnt vmcnt(0)" ::: "memory");
        } else {
            XB_SPIN(xb_ld(&bar[XB_XGEN(b.x)]) == gen, bar);
            __builtin_amdgcn_fence(__ATOMIC_ACQUIRE, "agent");
            asm volatile("s_waitcnt vmcnt(0)" ::: "memory");
        }
    }
    __syncthreads();
}

constexpr int DM = 2048, NBAT = 4, SEQ = 2048, DEPTH = 4, NS = 128;
constexpr int MP = NBAT * SEQ;
constexpr int MV = MP + NS;
constexpr int MPAD = 8448;
constexpr int WA = 512, WB = 768, WC = 768, PIN = 6656, DFF = 5632, DPLE = 256, PBW = 2560;
constexpr int OFF_B = 1024, OFF_C = 3584;
constexpr float LN_EPS = 1e-5f, GN_EPS = 64e-5f, RMS_EPS = 1e-6f;
constexpr float DN_ALPHA = 1.681792830507429f;
enum { I_XP = 0, I_XS, I_SRWKV, I_SSHIFT, I_SHGRN, I_PP, I_PS, I_LNING, I_LNINB, I_WIN, I_ALNG, I_ALNB, I_AWS, I_ABS, I_BMU, I_BW0, I_BWUP, I_BA0, I_BAUP, I_BGUP,
       I_BKK, I_BKA, I_BRK, I_BGNG, I_BGNB, I_CLB, I_CNG, I_WOUT, I_LN1G, I_LN1B, I_WG, I_WU, I_WD, I_WPG, I_WPP, I_LN2G, I_LN2B, N_IN };
constexpr size_t O_YP = 0, O_YS = O_YP + (size_t)MP * DM, O_RP = O_YS + (size_t)NS * DM, O_SP = O_RP + (size_t)DEPTH * NBAT * 12 * 4096,
                 O_HP = O_SP + (size_t)DEPTH * NBAT * PBW, O_RS = O_HP + (size_t)DEPTH * NBAT * 6 * 16384, O_SS = O_RS + (size_t)DEPTH * NS * 12 * 4096,
                 O_HS = O_SS + (size_t)DEPTH * NS * PBW, O_VS = O_HS + (size_t)DEPTH * NS * 6 * 16384, O_END = O_VS + (size_t)DEPTH * NS * WA;
static_assert(O_END == 96509952, "output size");
constexpr size_t al256(size_t x) { return (x + 255) & ~(size_t)255; }
constexpr size_t WS_CTL = 0, CTL_ZERO_BYTES = 1u << 20;
constexpr size_t SZ_WIN = (size_t)PIN * DM * 2, SZ_WOUT = (size_t)DM * DM * 2, SZ_WGU = (size_t)2 * DFF * DM * 2, SZ_WD = (size_t)DM * DFF * 2, SZ_WPG = SZ_WOUT, SZ_WPP = (size_t)DM * DPLE * 2;
constexpr size_t WS_WIN = CTL_ZERO_BYTES, WS_WOUT = WS_WIN + DEPTH * SZ_WIN, WS_WGU = WS_WOUT + DEPTH * SZ_WOUT, WS_WD = WS_WGU + DEPTH * SZ_WGU, WS_WPG = WS_WD + DEPTH * SZ_WD,
                 WS_WPP = WS_WPG + DEPTH * SZ_WPG, WS_PBF = WS_WPP + DEPTH * SZ_WPP;
constexpr size_t SZ_PBF = (size_t)MPAD * DPLE * 2;
constexpr size_t WS_H = WS_PBF + DEPTH * SZ_PBF, WS_HB = WS_H + (size_t)MPAD * DM * 4, WS_T = WS_HB + (size_t)MPAD * DM * 2, WS_YMIX = WS_T + (size_t)MPAD * DM * 4;
constexpr size_t WS_Z = WS_YMIX + (size_t)MPAD * DM * 2;
constexpr size_t WS_ACT = WS_Z, WS_PLE = WS_ACT + al256((size_t)MPAD * DFF * 2);
constexpr size_t WS_PPO = WS_Z + (size_t)MPAD * PIN * 4;
static_assert(WS_PLE + (size_t)MPAD * DM * 4 <= WS_PPO, "overlay fits");
constexpr size_t WS_RPB = WS_PPO + (size_t)MPAD * DM * 4;
constexpr size_t WS_RPS = WS_RPB + (size_t)NBAT * 12 * SEQ * 384 * 4;
constexpr int NLORA = 3 * WB;
constexpr size_t SZ_WL = (size_t)NLORA * 256 * 2;
constexpr size_t WS_WL = WS_RPS + (size_t)NS * 12 * 384 * 4;
constexpr size_t WS_XCAT = WS_WL + DEPTH * SZ_WL;
constexpr size_t WS_LORA = WS_XCAT + (size_t)MPAD * 256 * 2;
constexpr size_t WS_Y = WS_LORA + (size_t)MPAD * NLORA * 4;
constexpr size_t WS_O = WS_Y + (size_t)MPAD * WB * 4;
constexpr size_t WS_END = WS_O + (size_t)MPAD * WC * 4;
static_assert(WS_WIN % 256 == 0 && WS_H % 256 == 0 && WS_Z % 256 == 0 && WS_RPB % 256 == 0 && WS_WL % 256 == 0 && WS_XCAT % 256 == 0 && WS_LORA % 256 == 0 && WS_Y % 256 == 0, "alignment");
constexpr int CW_BAR = 4096;

constexpr int RING_BYTES = 131072, LDSCTL_OFF = RING_BYTES, MISC_OFF = LDSCTL_OFF + 320, LDS_BYTES = 147456;
constexpr int NWAVES = 8, NTHR = 512;

struct Args { const float* in[N_IN]; float* out; unsigned char* ws; int ph_lo, ph_hi; };
static_assert(sizeof(Args) == (N_IN + 2) * 8 + 8, "no padding in Args");

typedef float f4 __attribute__((ext_vector_type(4)));
typedef float f2 __attribute__((ext_vector_type(2)));
typedef unsigned u2 __attribute__((ext_vector_type(2)));

__device__ __forceinline__ float wave_sum(float v) {
#pragma unroll
    for (int o = 1; o < 64; o <<= 1) v += __shfl_xor(v, o);
    return v;
}
template <int CTRL> __device__ __forceinline__ float dpp_f(float x) { return __builtin_bit_cast(float, __builtin_amdgcn_update_dpp(0, __builtin_bit_cast(int, x), CTRL, 0xF, 0xF, true)); }
__device__ __forceinline__ float row16_sum(float x) {
    x += dpp_f<0xB1>(x);
    x += dpp_f<0x4E>(x);
    x += dpp_f<0x141>(x);
    x += dpp_f<0x140>(x);
    return x;
}
__device__ __forceinline__ float sigmoidf_(float x) { return 1.0f / (1.0f + expf(-x)); }
__device__ __forceinline__ float gelu_erf(float x) { return 0.5f * x * (1.0f + erff(x * 0.70710678118654752f)); }
__device__ __forceinline__ unsigned short bf1(float x) { return (unsigned short)(pg8::cvt_pk_bf16(x, 0.f) & 0xffffu); }
__device__ __forceinline__ float lbound(const float* clb, int L, int c) {
    const float x0 = clb[c], x1 = clb[WC + c], x2 = clb[2 * WC + c], x3 = clb[3 * WC + c];
    const float mx = fmaxf(fmaxf(x0, x1), fmaxf(x2, x3));
    const float e0 = expf(x0 - mx), e1 = expf(x1 - mx), e2 = expf(x2 - mx), e3 = expf(x3 - mx);
    float s = 0.f; if (L >= 1) s += e1; if (L >= 2) s += e2; if (L >= 3) s += e3;
    return s / (e0 + e1 + e2 + e3);
}
__device__ __forceinline__ float log_sigmoid(float x) { return fminf(x, 0.f) - log1pf(expf(-fabsf(x))); }

__device__ __forceinline__ void tr_item(const float* W, int K, int N, bf16* WT, int mode, LAS float* scr, int item, int lane) {
    const int nblk = N >> 5, kb = item / nblk, nb = item - kb * nblk, k0 = kb << 6, n0 = nb << 5;
    int rb = n0; if (mode) rb = ((n0 >> 7) << 8) + (n0 & 127) + (mode == 2 ? 128 : 0);
#pragma unroll 8
    for (int i = 0; i < 32; ++i) { const int kk = 2 * i + (lane >> 5); scr[kk * 33 + (lane & 31)] = W[(size_t)(k0 + kk) * N + n0 + (lane & 31)]; }
    LDS_WAIT(); asm volatile("" ::: "memory");
    const int c = lane & 7;
#pragma unroll
    for (int j = 0; j < 4; ++j) { const int n = (lane >> 3) + 8 * j; const LAS float* s = scr + (8 * c) * 33 + n;
        v4u o; o.x = pg8::cvt_pk_bf16(s[0 * 33], s[1 * 33]); o.y = pg8::cvt_pk_bf16(s[2 * 33], s[3 * 33]); o.z = pg8::cvt_pk_bf16(s[4 * 33], s[5 * 33]); o.w = pg8::cvt_pk_bf16(s[6 * 33], s[7 * 33]);
        *(v4u*)(WT + (size_t)(rb + n) * K + k0 + 8 * c) = o; }
    LDS_WAIT(); asm volatile("" ::: "memory");
}
__device__ __forceinline__ void ln_row(const float* src, const float* g, const float* b, float* dstf, bf16* dstb, float* dst2, int lane) {
    f4 v[8]; float s = 0.f;
#pragma unroll
    for (int j = 0; j < 8; ++j) { v[j] = *(const f4*)(src + 4 * (lane + 64 * j)); s += (v[j].x + v[j].y) + (v[j].z + v[j].w); }
    const float mean = wave_sum(s) * (1.f / DM); float s2 = 0.f;
#pragma unroll
    for (int j = 0; j < 8; ++j) { v[j] = v[j] - mean; s2 += (v[j].x * v[j].x + v[j].y * v[j].y) + (v[j].z * v[j].z + v[j].w * v[j].w); }
    const float rstd = 1.0f / sqrtf(wave_sum(s2) * (1.f / DM) + LN_EPS);
#pragma unroll
    for (int j = 0; j < 8; ++j) { const int c = 4 * (lane + 64 * j); const f4 gg = *(const f4*)(g + c), bb = *(const f4*)(b + c); const f4 o = v[j] * rstd * gg + bb;
        *(f4*)(dstf + c) = o; if (dst2) *(f4*)(dst2 + c) = o;
        u2 w; w.x = pg8::cvt_pk_bf16(o.x, o.y); w.y = pg8::cvt_pk_bf16(o.z, o.w); *(u2*)(dstb + c) = w; }
}
__device__ __forceinline__ void phase_prologue(const Args& a, LAS unsigned char* lds, int lane, int wave, int blk, int G) {
    LAS float* scr = (LAS float*)(lds + wave * 16384);
    const int gw = blk * NWAVES + wave, NGW = G * NWAVES;
    constexpr int I_IN = 32 * (PIN / 32), I_OUT = 32 * (DM / 32), I_G = 32 * (DFF / 32), I_D = (DFF / 64) * (DM / 32), I_PGc = I_OUT, I_PPc = (DPLE / 64) * (DM / 32);
    constexpr int PER_L = I_IN + I_OUT + 2 * I_G + I_D + I_PGc + I_PPc;
    unsigned char* ws = a.ws;
    for (int it = gw; it < DEPTH * PER_L; it += NGW) {
        const int L = it / PER_L; int r = it - L * PER_L;
        if (r < I_IN) { tr_item(a.in[I_WIN] + (size_t)L * DM * PIN, DM, PIN, (bf16*)(ws + WS_WIN + L * SZ_WIN), 0, scr, r, lane); continue; } r -= I_IN;
        if (r < I_OUT) { tr_item(a.in[I_WOUT] + (size_t)L * DM * DM, DM, DM, (bf16*)(ws + WS_WOUT + L * SZ_WOUT), 0, scr, r, lane); continue; } r -= I_OUT;
        if (r < I_G) { tr_item(a.in[I_WG] + (size_t)L * DM * DFF, DM, DFF, (bf16*)(ws + WS_WGU + L * SZ_WGU), 1, scr, r, lane); continue; } r -= I_G;
        if (r < I_G) { tr_item(a.in[I_WU] + (size_t)L * DM * DFF, DM, DFF, (bf16*)(ws + WS_WGU + L * SZ_WGU), 2, scr, r, lane); continue; } r -= I_G;
        if (r < I_D) { tr_item(a.in[I_WD] + (size_t)L * DFF * DM, DFF, DM, (bf16*)(ws + WS_WD + L * SZ_WD), 0, scr, r, lane); continue; } r -= I_D;
        if (r < I_PGc) { tr_item(a.in[I_WPG] + (size_t)L * DM * DM, DM, DM, (bf16*)(ws + WS_WPG + L * SZ_WPG), 0, scr, r, lane); continue; } r -= I_PGc;
        tr_item(a.in[I_WPP] + (size_t)L * DPLE * DM, DPLE, DM, (bf16*)(ws + WS_WPP + L * SZ_WPP), 0, scr, r, lane);
    }
    for (int it = gw; it < DEPTH * NLORA; it += NGW) { const int L = it / NLORA, n = it - L * NLORA; float v[4];
#pragma unroll
        for (int e = 0; e < 4; ++e) { const int k = 4 * lane + e; float x = 0.f;
            if (n < WB) { if (k < 64) x = a.in[I_BWUP][((size_t)L * 64 + k) * WB + n]; }
            else if (n < 2 * WB) { if (k >= 64 && k < 128) x = a.in[I_BAUP][((size_t)L * 64 + (k - 64)) * WB + (n - WB)]; }
            else { if (k >= 128) x = a.in[I_BGUP][((size_t)L * 128 + (k - 128)) * WB + (n - 2 * WB)]; }
            v[e] = x; }
        u2 w; w.x = pg8::cvt_pk_bf16(v[0], v[1]); w.y = pg8::cvt_pk_bf16(v[2], v[3]); *(u2*)((bf16*)(ws + WS_WL + L * SZ_WL) + (size_t)n * 256 + 4 * lane) = w; }
    for (int it = gw; it < DEPTH * MV; it += NGW) { const int L = it / MV, m = it - L * MV;
        const float* src = (m < MP) ? a.in[I_PP] + ((size_t)L * MP + m) * DPLE : a.in[I_PS] + ((size_t)L * NS + (m - MP)) * DPLE;
        const f4 v = *(const f4*)(src + 4 * lane); u2 w; w.x = pg8::cvt_pk_bf16(v.x, v.y); w.y = pg8::cvt_pk_bf16(v.z, v.w);
        *(u2*)((bf16*)(ws + WS_PBF + L * SZ_PBF) + (size_t)m * DPLE + 4 * lane) = w; }
    for (int m = gw; m < MV; m += NGW) { const float* src = (m < MP) ? a.in[I_XP] + (size_t)m * DM : a.in[I_XS] + (size_t)(m - MP) * DM;
        ln_row(src, a.in[I_LNING], a.in[I_LNINB], (float*)(ws + WS_H) + (size_t)m * DM, (bf16*)(ws + WS_HB) + (size_t)m * DM, nullptr, lane); }
}
__device__ __forceinline__ void phase_ln(const Args& a, const float* g, const float* b, bool last, int lane, int wave, int blk, int G) {
    const int gw = blk * NWAVES + wave, NGW = G * NWAVES; unsigned char* ws = a.ws;
    for (int m = gw; m < MV; m += NGW)
        ln_row((const float*)(ws + WS_T) + (size_t)m * DM, g, b, (float*)(ws + WS_H) + (size_t)m * DM, (bf16*)(ws + WS_HB) + (size_t)m * DM,
               last ? a.out + (m < MP ? O_YP + (size_t)m * DM : O_YS + (size_t)(m - MP) * DM) : nullptr, lane);
}


__device__ __forceinline__ void phase_xc(const Args& a, int L, int lane, int wave, int blk, int G) {
    unsigned char* ws = a.ws; const int gw = blk * NWAVES + wave, NGW = G * NWAVES;
    const float* Z = (const float*)(ws + WS_Z);
    const float* mu = a.in[I_BMU] + L * PBW; const float* sh0 = a.in[I_SSHIFT] + (size_t)L * NS * PBW;
    const f4 mu4 = *(const f4*)(mu + 2304 + 4 * lane);
    for (int m = gw; m < MV; m += NGW) {
        const bool samp = m >= MP; const float* zr = Z + (size_t)m * PIN + OFF_B;
        const f4 cur = *(const f4*)(zr + 2304 + 4 * lane); f4 prev;
        if (samp) prev = *(const f4*)(sh0 + (size_t)(m - MP) * PBW + 2304 + 4 * lane); else if (m & (SEQ - 1)) prev = *(const f4*)(zr - PIN + 2304 + 4 * lane); else prev = (f4){0.f, 0.f, 0.f, 0.f};
        f4 x = cur + mu4 * (prev - cur);
        if (lane < 16) { x.x = tanhf(x.x); x.y = tanhf(x.y); x.z = tanhf(x.z); x.w = tanhf(x.w); }
        else if (lane >= 32) { x.x = sigmoidf_(x.x); x.y = sigmoidf_(x.y); x.z = sigmoidf_(x.z); x.w = sigmoidf_(x.w); }
        u2 w; w.x = pg8::cvt_pk_bf16(x.x, x.y); w.y = pg8::cvt_pk_bf16(x.z, x.w); *(u2*)((bf16*)(ws + WS_XCAT) + (size_t)m * 256 + 4 * lane) = w;
        if (samp || (m & (SEQ - 1)) == SEQ - 1) { float* dst = samp ? a.out + O_SS + ((size_t)L * NS + (m - MP)) * PBW : a.out + O_SP + ((size_t)L * NBAT + (m >> 11)) * PBW;
#pragma unroll
            for (int j = 0; j < PBW / 256; ++j) *(f4*)(dst + 256 * j + 4 * lane) = *(const f4*)(zr + 256 * j + 4 * lane); }
        if (samp) { const int i = m - MP; const float* z0 = Z + (size_t)m * PIN; const float* lng = a.in[I_ALNG] + L * WA; const float* lnb = a.in[I_ALNB] + L * WA;
            for (int g = 0; g < 4; ++g) {
                const float u0 = gelu_erf(z0[g * 128 + lane]), u1 = gelu_erf(z0[g * 128 + 64 + lane]);
                const float v0 = gelu_erf(z0[WA + g * 128 + lane]), v1 = gelu_erf(z0[WA + g * 128 + 64 + lane]);
                const float mean = wave_sum(v0 + v1) * (1.f / 128.f); const float d0 = v0 - mean, d1 = v1 - mean;
                const float rstd = 1.0f / sqrtf(wave_sum(d0 * d0 + d1 * d1) * (1.f / 128.f) + LN_EPS);
                const float n0 = d0 * rstd * lng[g * 128 + lane] + lnb[g * 128 + lane], n1 = d1 * rstd * lng[g * 128 + 64 + lane] + lnb[g * 128 + 64 + lane];
                float* ov = a.out + O_VS + ((size_t)L * NS + i) * WA + g * 128; ov[lane] = n0; ov[64 + lane] = n1;
                const float w00 = a.in[I_AWS][(size_t)(L * 4 + g) * 16384], b0 = a.in[I_ABS][(L * 4 + g) * 128];
                bf16* yo = (bf16*)(ws + WS_YMIX) + (size_t)m * DM + g * 128; yo[lane] = bf1(u0 * (w00 * n0 + b0)); yo[64 + lane] = bf1(u1 * (w00 * n1 + b0)); } }
    }
}
__device__ __forceinline__ void phase_fin(const Args& a, int L, int lane, int wave, int blk, int G) {
    unsigned char* ws = a.ws; const int gw = blk * NWAVES + wave, NGW = G * NWAVES;
    const float* Z = (const float*)(ws + WS_Z); const float* LO = (const float*)(ws + WS_LORA);
    const float* mu = a.in[I_BMU] + L * PBW; const float* w0 = a.in[I_BW0] + L * WB; const float* a0 = a.in[I_BA0] + L * WB;
    const float* k_k = a.in[I_BKK] + L * WB; const float* k_a = a.in[I_BKA] + L * WB; const float* sh0 = a.in[I_SSHIFT] + (size_t)L * NS * PBW;
    for (int m = gw; m < MV; m += NGW) {
        const bool samp = m >= MP; const float* zr = Z + (size_t)m * PIN + OFF_B; const float* lo = LO + (size_t)m * NLORA;
        const float* pz = samp ? sh0 + (size_t)(m - MP) * PBW : zr - PIN; const bool first = !samp && (m & (SEQ - 1)) == 0;
#pragma unroll 4
        for (int j = 0; j < 12; ++j) { const int c = 64 * j + lane;
            const float cr = zr[c], ck = zr[WB + c], cv = zr[2 * WB + c];
            float pr = 0.f, pk = 0.f, pv = 0.f; if (!first) { pr = pz[c]; pk = pz[WB + c]; pv = pz[2 * WB + c]; }
            const float r = cr + mu[c] * (pr - cr), k = ck + mu[WB + c] * (pk - ck), v = cv + mu[2 * WB + c] * (pv - cv);
            const float dec = __expf(-0.6065306597126334f * sigmoidf_(w0[c] + lo[c]));
            const float av = sigmoidf_(a0[c] + lo[WB + c]);
            const float kkr = k * k_k[c]; const float ss = wave_sum(kkr * kkr); const float kk = kkr / fmaxf(sqrtf(ss), 1e-12f);
            const float kp = k * (1.0f + (av - 1.0f) * k_a[c]);
            float* rec = samp ? (float*)(ws + WS_RPS) + ((size_t)(m - MP) * 12 + j) * 384 : (float*)(ws + WS_RPB) + (((size_t)(m >> 11) * 12 + j) * SEQ + (m & (SEQ - 1))) * 384;
            rec[lane] = r; rec[64 + lane] = dec; rec[128 + lane] = kp; rec[192 + lane] = v; rec[256 + lane] = kk; rec[320 + lane] = kk * av; }
    }
}

__device__ __forceinline__ void rwkv_scan_unit(const Args& a, int L, int unit, LAS unsigned char* lds, int tid, int lane, int wave) {
    unsigned char* ws = a.ws;
    const int bh = unit >> 1, half = unit & 1, b = bh / 12, h = bh - b * 12;
    const f4* rec4 = (const f4*)((const float*)(ws + WS_RPB) + (size_t)bh * SEQ * 384);
    LAS float* buf = (LAS float*)lds;
    LAS float* ybuf = (LAS float*)(lds + 49152);
    const int rowl = wave * 4 + (lane >> 4), kg = lane & 15, row = half * 32 + rowl;
    float S0 = 0.f, S1 = 0.f, S2 = 0.f, S3 = 0.f;
    f4 st0, st1, st2;
    __syncthreads();
    st0 = rec4[tid]; st1 = rec4[512 + tid]; st2 = rec4[1024 + tid];
    *(LAS f4*)(buf + 4 * tid) = st0; *(LAS f4*)(buf + 4 * (512 + tid)) = st1; *(LAS f4*)(buf + 4 * (1024 + tid)) = st2;
    __syncthreads();
    float* Y = (float*)(ws + WS_Y);
    for (int c = 0; c < SEQ / 16; ++c) {
        if (c + 1 < SEQ / 16) { const f4* nx = rec4 + (size_t)(c + 1) * 1536; st0 = nx[tid]; st1 = nx[512 + tid]; st2 = nx[1024 + tid]; }
        const LAS float* cur = buf + (c & 1) * 6144; LAS float* yb = ybuf + (c & 1) * 512;
        f4 r4 = *(const LAS f4*)(cur + 4 * kg), w4 = *(const LAS f4*)(cur + 64 + 4 * kg), k4 = *(const LAS f4*)(cur + 128 + 4 * kg),
           kk4 = *(const LAS f4*)(cur + 256 + 4 * kg), ka4 = *(const LAS f4*)(cur + 320 + 4 * kg); float v = cur[192 + row];
#pragma unroll
        for (int s = 0; s < 16; ++s) {
            const LAS float* R = cur + (s < 15 ? s + 1 : 15) * 384;
            const f4 nr4 = *(const LAS f4*)(R + 4 * kg), nw4 = *(const LAS f4*)(R + 64 + 4 * kg), nk4 = *(const LAS f4*)(R + 128 + 4 * kg),
                     nkk4 = *(const LAS f4*)(R + 256 + 4 * kg), nka4 = *(const LAS f4*)(R + 320 + 4 * kg);
            const float nv = R[192 + row];
            float sa = (S0 * kk4.x + S1 * kk4.y) + (S2 * kk4.z + S3 * kk4.w);
            sa = row16_sum(sa);
            S0 = S0 * w4.x + (v * k4.x - sa * ka4.x); S1 = S1 * w4.y + (v * k4.y - sa * ka4.y);
            S2 = S2 * w4.z + (v * k4.z - sa * ka4.z); S3 = S3 * w4.w + (v * k4.w - sa * ka4.w);
            float y = (S0 * r4.x + S1 * r4.y) + (S2 * r4.z + S3 * r4.w);
            y = row16_sum(y);
            if (kg == 0) yb[s * 32 + rowl] = y;
            r4 = nr4; w4 = nw4; k4 = nk4; kk4 = nkk4; ka4 = nka4; v = nv;
        }
        if (c + 1 < SEQ / 16) { LAS float* nb = buf + ((c + 1) & 1) * 6144;
            *(LAS f4*)(nb + 4 * tid) = st0; *(LAS f4*)(nb + 4 * (512 + tid)) = st1; *(LAS f4*)(nb + 4 * (1024 + tid)) = st2; }
        __syncthreads();
        { const int s = tid >> 5, rl = tid & 31; Y[((size_t)b * SEQ + c * 16 + s) * WB + h * 64 + half * 32 + rl] = yb[tid]; }
    }
    f4 so; so.x = S0; so.y = S1; so.z = S2; so.w = S3;
    *(f4*)(a.out + O_RP + ((((size_t)L * NBAT + b) * 12 + h) * 64 + row) * 64 + 4 * kg) = so;
    __syncthreads();
}
__device__ __forceinline__ void rwkv_sample_item(const Args& a, int L, int item, LAS unsigned char* lds, int lane, int wave) {
    unsigned char* ws = a.ws;
    const int ih = item * 8 + wave, i = ih / 12, h = ih - i * 12;
    const float* rec = (const float*)(ws + WS_RPS) + (size_t)ih * 384;
    LAS float* sc = (LAS float*)(lds + wave * 2048);
    const float r = rec[lane], w = rec[64 + lane], k = rec[128 + lane], v = rec[192 + lane], kk = rec[256 + lane], ka = rec[320 + lane];
    sc[lane] = r; sc[64 + lane] = w; sc[128 + lane] = k; sc[192 + lane] = kk; sc[256 + lane] = ka;
    LDS_WAIT(); asm volatile("" ::: "memory");
    const f4* S0p = (const f4*)(a.in[I_SRWKV] + (((size_t)L * NS + i) * 12 + h) * 4096 + lane * 64);
    f4 S[16];
#pragma unroll
    for (int j = 0; j < 16; ++j) S[j] = S0p[j];
    float sa = 0.f;
#pragma unroll
    for (int j = 0; j < 16; ++j) { const f4 q = *(const LAS f4*)(sc + 192 + 4 * j); sa += (S[j].x * q.x + S[j].y * q.y) + (S[j].z * q.z + S[j].w * q.w); }
    float y = 0.f;
    f4* So = (f4*)(a.out + O_RS + (((size_t)L * NS + i) * 12 + h) * 4096 + lane * 64);
#pragma unroll
    for (int j = 0; j < 16; ++j) { const f4 w4 = *(const LAS f4*)(sc + 64 + 4 * j), k4 = *(const LAS f4*)(sc + 128 + 4 * j), a4 = *(const LAS f4*)(sc + 256 + 4 * j), r4 = *(const LAS f4*)(sc + 4 * j);
        f4 n = S[j] * w4 + (k4 * v - a4 * sa); So[j] = n; y += (n.x * r4.x + n.y * r4.y) + (n.z * r4.z + n.w * r4.w); }
    ((float*)(ws + WS_Y))[(size_t)(MP + i) * WB + h * 64 + lane] = y;
    LDS_WAIT(); asm volatile("" ::: "memory");
}
__device__ __forceinline__ void hgrn_sample_item(const Args& a, int L, int item, LAS unsigned char* lds, int lane, int wave) {
    unsigned char* ws = a.ws;
    const int ih = item * 4 + (wave >> 1), i = ih / 6, h = ih - i * 6, vcol = (wave & 1) * 64 + lane, m = MP + i;
    const float* zc = (const float*)(ws + WS_Z) + (size_t)m * PIN + OFF_C + h * 128;
    LAS float* sc = (LAS float*)(lds + wave * 2048);
#pragma unroll
    for (int t = 0; t < 2; ++t) { const int k = lane + 64 * t; const float lb = lbound(a.in[I_CLB], L, h * 128 + k); const float fz = zc[WC + k];
        const float sg = sigmoidf_(fz); sc[k] = lb + (1.0f - lb) * sg; sc[128 + k] = (1.0f - lb) * (1.0f - sg) ; sc[256 + k] = zc[k]; }
    const float iv = zc[2 * WC + vcol];
    LDS_WAIT(); asm volatile("" ::: "memory");
    const float* S0 = a.in[I_SHGRN] + (((size_t)L * NS + i) * 6 + h) * 16384 + vcol;
    float* So = a.out + O_HS + (((size_t)L * NS + i) * 6 + h) * 16384 + vcol;
    float o = 0.f;
#pragma unroll 8
    for (int k = 0; k < 128; ++k) { const float n = sc[k] * S0[(size_t)k * 128] + sc[128 + k] * iv; So[(size_t)k * 128] = n; o += n * sc[256 + k]; }
    ((float*)(ws + WS_O))[(size_t)m * WC + h * 128 + vcol] = o;
    LDS_WAIT(); asm volatile("" ::: "memory");
}
__device__ __forceinline__ void sgu_item(const Args& a, int L, int item, LAS unsigned char* lds, int tid, int lane, int wave) {
    unsigned char* ws = a.ws;
    const int g = item & 3, bc = item >> 2, m0 = bc * 128;
    const float* Z = (const float*)(ws + WS_Z);
    LAS float* vn = (LAS float*)lds;
    LAS float* wt = (LAS float*)(lds + 65536);
    const float* wsrc = a.in[I_AWS] + (size_t)(L * 4 + g) * 16384;
    __syncthreads();
    for (int e = tid; e < 16384; e += NTHR) { const int t = e >> 7, s = e & 127; wt[s * 128 + t] = (s <= t) ? wsrc[e] : 0.f; }
    const float* lng = a.in[I_ALNG] + L * WA + g * 128; const float* lnb = a.in[I_ALNB] + L * WA + g * 128;
    for (int rr = 0; rr < 16; ++rr) { const int t = wave * 16 + rr; const float* zr = Z + (size_t)(m0 + t) * PIN + WA + g * 128;
        const float v0 = gelu_erf(zr[lane]), v1 = gelu_erf(zr[64 + lane]);
        const float mean = wave_sum(v0 + v1) * (1.f / 128.f); const float d0 = v0 - mean, d1 = v1 - mean;
        const float rstd = 1.0f / sqrtf(wave_sum(d0 * d0 + d1 * d1) * (1.f / 128.f) + LN_EPS);
        vn[t * 128 + lane] = d0 * rstd * lng[lane] + lnb[lane]; vn[t * 128 + 64 + lane] = d1 * rstd * lng[64 + lane] + lnb[64 + lane]; }
    __syncthreads();
    const int t = tid >> 2, dq = tid & 3, send = (wave * 16 + 15);
    f4 acc[8];
#pragma unroll
    for (int j = 0; j < 8; ++j) acc[j] = (f4){0.f, 0.f, 0.f, 0.f};
    for (int s = 0; s <= send; ++s) { const float w = wt[s * 128 + t]; const LAS f4* vr = (const LAS f4*)(vn + s * 128 + dq * 32);
#pragma unroll
        for (int j = 0; j < 8; ++j) acc[j] += vr[j] * w; }
    const float bs = a.in[I_ABS][(L * 4 + g) * 128 + t];
    const float* ur = Z + (size_t)(m0 + t) * PIN + g * 128 + dq * 32;
    bf16* yo = (bf16*)(ws + WS_YMIX) + (size_t)(m0 + t) * DM + g * 128 + dq * 32;
#pragma unroll
    for (int j = 0; j < 4; ++j) { const f4 u0 = *(const f4*)(ur + 8 * j), u1 = *(const f4*)(ur + 8 * j + 4); const f4 x0 = acc[2 * j] + bs, x1 = acc[2 * j + 1] + bs; v4u o;
        o.x = pg8::cvt_pk_bf16(gelu_erf(u0.x) * x0.x, gelu_erf(u0.y) * x0.y); o.y = pg8::cvt_pk_bf16(gelu_erf(u0.z) * x0.z, gelu_erf(u0.w) * x0.w);
        o.z = pg8::cvt_pk_bf16(gelu_erf(u1.x) * x1.x, gelu_erf(u1.y) * x1.y); o.w = pg8::cvt_pk_bf16(gelu_erf(u1.z) * x1.z, gelu_erf(u1.w) * x1.w);
        *(v4u*)(yo + 8 * j) = o; }
}

__device__ __forceinline__ void hgrn_seq_unit(const Args& a, int L, int unit, LAS unsigned char* lds, int tid, int lane, int wave) {
    unsigned char* ws = a.ws;
    const int b = unit / 6, h = unit - b * 6;
    const float* Z = (const float*)(ws + WS_Z);
    LAS bf16* qs = (LAS bf16*)(lds);
    LAS bf16* ks = (LAS bf16*)(lds + 4352);
    LAS bf16* vt = (LAS bf16*)(lds + 8704);
    LAS bf16* kht = (LAS bf16*)(lds + 12800);
    LAS float* ev = (LAS float*)(lds + 16896);
    LAS float* part = (LAS float*)(lds + 17408);
    const int ch = tid & 127, tq = tid >> 7;
    const float lb = lbound(a.in[I_CLB], L, h * 128 + ch), oml = 1.0f - lb;
    const int pch = (ch & ~31) | (((ch >> 2) & 3) << 3) | (((ch >> 4) & 1) << 2) | (ch & 3);
    const int x = lane & 15, quad = lane >> 4;
    pg8::f32x4 Sacc[8];
#pragma unroll
    for (int mt = 0; mt < 8; ++mt) Sacc[mt] = (pg8::f32x4){0.f, 0.f, 0.f, 0.f};
    const float* zb = Z + (size_t)(b * SEQ + 4 * tq) * PIN + OFF_C + h * 128 + ch;
    float qn[4], fn[4], vn_[4];
#pragma unroll
    for (int j = 0; j < 4; ++j) { const float* p = zb + (size_t)j * PIN; qn[j] = p[0]; fn[j] = p[WC]; vn_[j] = p[2 * WC]; }
    float* O = (float*)(ws + WS_O);
    __syncthreads();
    for (int st = 0; st < SEQ / 16; ++st) {
        float q[4], fz[4], iv[4];
#pragma unroll
        for (int j = 0; j < 4; ++j) { q[j] = qn[j]; fz[j] = fn[j]; iv[j] = vn_[j]; }
        if (st + 1 < SEQ / 16) {
#pragma unroll
            for (int j = 0; j < 4; ++j) { const float* p = zb + (size_t)((st + 1) * 16 + j) * PIN; qn[j] = p[0]; fn[j] = p[WC]; vn_[j] = p[2 * WC]; } }
        float bl[4], kv[4]; float run = 0.f;
#pragma unroll
        for (int j = 0; j < 4; ++j) { const float e = __expf(-fmaxf(fz[j], -80.f)), sg = __builtin_amdgcn_rcpf(1.0f + e);
            run += __logf(lb + oml * sg); bl[j] = run; kv[j] = oml * e * sg; }
        part[tq * 128 + ch] = run;
        __syncthreads();
        const float p0 = part[ch], p1 = part[128 + ch], p2 = part[256 + ch], p3 = part[384 + ch];
        const float tot = (p0 + p1) + (p2 + p3); const float pre = (tq > 0 ? p0 : 0.f) + (tq > 1 ? p1 : 0.f) + (tq > 2 ? p2 : 0.f);
        float kh[4];
#pragma unroll
        for (int j = 0; j < 4; ++j) { const float bj = pre + bl[j]; const int t = 4 * tq + j;
            qs[t * 136 + pch] = bf1(q[j] * __expf(bj)); ks[t * 136 + pch] = bf1(kv[j] * __expf(fminf(-bj, 60.f))); kh[j] = kv[j] * __expf(tot - bj); }
        { u2 w; w.x = pg8::cvt_pk_bf16(kh[0], kh[1]); w.y = pg8::cvt_pk_bf16(kh[2], kh[3]); *(LAS u2*)(kht + ch * 16 + 4 * tq) = w;
          w.x = pg8::cvt_pk_bf16(iv[0], iv[1]); w.y = pg8::cvt_pk_bf16(iv[2], iv[3]); *(LAS u2*)(vt + ch * 16 + 4 * tq) = w; }
        if (tq == 0) ev[ch] = __expf(tot);
        __syncthreads();
        bf16x8 qf[4], kf[4];
#pragma unroll
        for (int kt = 0; kt < 4; ++kt) { qf[kt] = *(const LAS bf16x8*)(qs + x * 136 + 32 * kt + 8 * quad); kf[kt] = *(const LAS bf16x8*)(ks + x * 136 + 32 * kt + 8 * quad); }
        pg8::f32x4 att = (pg8::f32x4){0.f, 0.f, 0.f, 0.f};
#pragma unroll
        for (int kt = 0; kt < 4; ++kt) att = __builtin_amdgcn_mfma_f32_16x16x32_bf16(kf[kt], qf[kt], att, 0, 0, 0);
#pragma unroll
        for (int i = 0; i < 4; ++i) if (4 * quad + i > x) att[i] = 0.f;
        v4u pbu; pbu.x = pg8::cvt_pk_bf16(att[0], att[1]); pbu.y = pg8::cvt_pk_bf16(att[2], att[3]); pbu.z = 0u; pbu.w = 0u;
        const bf16x8 pb = __builtin_bit_cast(bf16x8, pbu);
        const u2 vv = *(const LAS u2*)(vt + (16 * wave + x) * 16 + 4 * quad);
        v4u vfu; vfu.x = vv.x; vfu.y = vv.y; vfu.z = 0u; vfu.w = 0u; const bf16x8 vf = __builtin_bit_cast(bf16x8, vfu);
        pg8::f32x4 o = (pg8::f32x4){0.f, 0.f, 0.f, 0.f};
#pragma unroll
        for (int kt = 0; kt < 4; ++kt) { v4u su; su.x = pg8::cvt_pk_bf16(Sacc[2 * kt][0], Sacc[2 * kt][1]); su.y = pg8::cvt_pk_bf16(Sacc[2 * kt][2], Sacc[2 * kt][3]);
            su.z = pg8::cvt_pk_bf16(Sacc[2 * kt + 1][0], Sacc[2 * kt + 1][1]); su.w = pg8::cvt_pk_bf16(Sacc[2 * kt + 1][2], Sacc[2 * kt + 1][3]);
            o = __builtin_amdgcn_mfma_f32_16x16x32_bf16(__builtin_bit_cast(bf16x8, su), qf[kt], o, 0, 0, 0); }
        o = __builtin_amdgcn_mfma_f32_16x16x32_bf16(vf, pb, o, 0, 0, 0);
        *(pg8::f32x4*)(O + (size_t)(b * SEQ + st * 16 + x) * WC + h * 128 + 16 * wave + 4 * quad) = o;
#pragma unroll
        for (int mt = 0; mt < 8; ++mt) { const pg8::f32x4 e4 = *(const LAS pg8::f32x4*)(ev + 16 * mt + 4 * quad);
            const u2 kk2 = *(const LAS u2*)(kht + (16 * mt + x) * 16 + 4 * quad); v4u ku; ku.x = kk2.x; ku.y = kk2.y; ku.z = 0u; ku.w = 0u;
            Sacc[mt] = __builtin_amdgcn_mfma_f32_16x16x32_bf16(__builtin_bit_cast(bf16x8, ku), vf, Sacc[mt] * e4, 0, 0, 0); }
    }
    float* So = a.out + O_HP + (((size_t)L * NBAT + b) * 6 + h) * 16384;
#pragma unroll
    for (int mt = 0; mt < 8; ++mt)
#pragma unroll
        for (int i = 0; i < 4; ++i) So[(size_t)(16 * mt + 4 * quad + i) * 128 + 16 * wave + x] = Sacc[mt][i];
    __syncthreads();
}

__device__ __forceinline__ void phase_post(const Args& a, int L, int lane, int wave, int blk, int G) {
    unsigned char* ws = a.ws; const int gw = blk * NWAVES + wave, NGW = G * NWAVES;
    const float* Y = (const float*)(ws + WS_Y); const float* O = (const float*)(ws + WS_O); const float* Gt = (const float*)(ws + WS_LORA) + 2 * WB; const float* Z = (const float*)(ws + WS_Z);
    const float* gng = a.in[I_BGNG] + L * WB; const float* gnb = a.in[I_BGNB] + L * WB; const float* rk = a.in[I_BRK] + L * WB; const float* cng = a.in[I_CNG] + L * WC;
    for (int m = gw; m < MV; m += NGW) {
        bf16* yo = (bf16*)(ws + WS_YMIX) + (size_t)m * DM;
        float yv[12], rr[12], kp[12], vv[12], gg[12], ov[12], gz[12];
#pragma unroll
        for (int j = 0; j < 12; ++j) { const int c = 64 * j + lane;
            const float* rec = (m < MP) ? (const float*)(ws + WS_RPB) + (((size_t)(m >> 11) * 12 + j) * SEQ + (m & (SEQ - 1))) * 384 : (const float*)(ws + WS_RPS) + ((size_t)(m - MP) * 12 + j) * 384;
            yv[j] = Y[(size_t)m * WB + c]; rr[j] = rec[lane]; kp[j] = rec[128 + lane]; vv[j] = rec[192 + lane]; gg[j] = Gt[(size_t)m * NLORA + c];
            ov[j] = O[(size_t)m * WC + c]; gz[j] = Z[(size_t)m * PIN + OFF_C + 3 * WC + c]; }
        float ss = 0.f;
#pragma unroll
        for (int j = 0; j < 12; ++j) { const int c = 64 * j + lane; const float y = yv[j];
            const float mean = wave_sum(y) * (1.f / 64.f); const float d = y - mean; const float rstd = 1.0f / sqrtf(wave_sum(d * d) * (1.f / 64.f) + GN_EPS);
            const float bonus = wave_sum(rr[j] * kp[j] * rk[c]);
            yo[WA + c] = bf1((d * rstd * gng[c] + gnb[c] + bonus * vv[j]) * gg[j]); ss += ov[j] * ov[j]; }
        const float rms = 1.0f / sqrtf(wave_sum(ss) * (1.f / WC) + RMS_EPS);
#pragma unroll
        for (int j = 0; j < 12; ++j) { const int c = 64 * j + lane; yo[WA + WB + c] = bf1(ov[j] * rms * cng[c] * (gz[j] * sigmoidf_(gz[j]))); }
    }
}

#ifndef EN_PRO
#define EN_PRO 1
#endif
#ifndef EN_G1
#define EN_G1 1
#endif
#ifndef EN_PREP
#define EN_PREP 1
#endif
#ifndef EN_MIX
#define EN_MIX 1
#endif
#ifndef EN_POST
#define EN_POST 1
#endif
#ifndef EN_G3
#define EN_G3 1
#endif
#ifndef EN_LN
#define EN_LN 1
#endif
#ifndef EN_G4
#define EN_G4 1
#endif
#ifndef EN_G5
#define EN_G5 1
#endif
#ifndef REP_PHASE
#define REP_PHASE -1
#endif
#define NREP(k) ((REP_PHASE) == (k) ? 2 : 1)
#ifndef MK_SINGLE
#define MK_SINGLE 1
#endif
constexpr int PPL = 11, N_PHASES = 1 + PPL * DEPTH;
constexpr int SCAN_UNITS = NBAT * 12 * 2, HSEQ_UNITS = NBAT * 6, ROLE_BLOCKS = SCAN_UNITS + HSEQ_UNITS;
constexpr int N_SGU = NBAT * 16 * 4, N_RS = NS * 12 / 8, N_HS = NS * 6 / 4, N_MISC = N_SGU + N_RS + N_HS;

__global__ void __launch_bounds__(NTHR, 2) mk_fwd(Args a) {
    extern __shared__ __attribute__((aligned(16))) unsigned char lds_raw[];
    LAS unsigned char* lds = (LAS unsigned char*)lds_raw;
    const int tid = threadIdx.x, lane = tid & 63, wave = __builtin_amdgcn_readfirstlane(tid >> 6), blk = blockIdx.x, G = gridDim.x;
    unsigned char* ws = a.ws;
    volatile LAS unsigned* MISC = (volatile LAS unsigned*)(lds + MISC_OFF);
    for (int u = tid; u < (LDS_BYTES - LDSCTL_OFF) / 4; u += NTHR) ((LAS unsigned*)(lds + LDSCTL_OFF))[u] = 0u;
    __syncthreads();
    const int lo = a.ph_lo, hi = a.ph_hi;
    XcdBarrier bar; bar.bar = (unsigned*)(ws + WS_CTL) + CW_BAR; bar.x = 0; bar.st = nullptr;
    if (hi - lo > 1) bar = xcd_barrier_post((unsigned*)(ws + WS_CTL) + CW_BAR, MISC + 8);
#define IN(k) (lo <= (k) && (k) < hi)
#define SEAM(k) do { if (IN(k) && IN((k) + 1)) { xcd_barrier(bar); } } while (0)
    bf16* HB = (bf16*)(ws + WS_HB); float* H = (float*)(ws + WS_H); float* T = (float*)(ws + WS_T);

    #if EN_PRO
    if (IN(0)) for (int rep = 0; rep < NREP(0); ++rep) { phase_prologue(a, lds, lane, wave, blk, G); __syncthreads(); }
#endif
    SEAM(0);
    for (int L = 0; L < DEPTH; ++L) {
        const int pb = 1 + PPL * L;
#define LAUNDER() int tid_ = threadIdx.x; asm volatile("" : "+v"(tid_)); const int lane_ = tid_ & 63; const int wave_ = __builtin_amdgcn_readfirstlane(tid_ >> 6)
#if EN_G1
        if (IN(pb)) for (int rep = 0; rep < NREP(1); ++rep) {
            { pg8::Gemm g{HB, (const bf16*)(ws + WS_WIN + L * SZ_WIN), MPAD, PIN, DM}; pg8::StaticOrder S; S.init(MPAD, PIN, G, blk);
              pg8::EpiF32 E{(float*)(ws + WS_Z), PIN}; pg8::gemm_phase<pg8::EpiF32, pg8::StaticOrder, true, true>(lds, g, S, E); }
            { pg8::Gemm g{(const bf16*)(ws + WS_PBF + L * SZ_PBF), (const bf16*)(ws + WS_WPP + L * SZ_WPP), MPAD, DM, DPLE}; pg8::StaticOrder S; S.init(MPAD, DM, G, G - 1 - blk);
              pg8::EpiF32 E{(float*)(ws + WS_PPO), DM}; pg8::gemm_phase<pg8::EpiF32, pg8::StaticOrder, true, true>(lds, g, S, E); }
        }
#endif
        SEAM(pb);
#if EN_PREP
        if (IN(pb + 1)) for (int rep = 0; rep < NREP(2); ++rep) { LAUNDER(); phase_xc(a, L, lane_, wave_, blk, G); }
        SEAM(pb + 1);
        if (IN(pb + 2)) for (int rep = 0; rep < NREP(9); ++rep) {
            pg8::Gemm g{(const bf16*)(ws + WS_XCAT), (const bf16*)(ws + WS_WL + L * SZ_WL), MPAD, NLORA, 256}; pg8::StaticOrder S; S.init(MPAD, NLORA, G, blk);
            pg8::EpiF32 E{(float*)(ws + WS_LORA), NLORA}; pg8::gemm_phase<pg8::EpiF32, pg8::StaticOrder, true, true>(lds, g, S, E);
        }
        SEAM(pb + 2);
        if (IN(pb + 3)) for (int rep = 0; rep < NREP(10); ++rep) { LAUNDER(); phase_fin(a, L, lane_, wave_, blk, G); }
#endif
        SEAM(pb + 3);
#if EN_MIX
        if (IN(pb + 4)) for (int rep = 0; rep < NREP(3); ++rep) {
            LAUNDER(); const int tid = tid_, lane = lane_, wave = wave_;
            if (blk < SCAN_UNITS) { for (int r2 = 0; r2 < NREP(31); ++r2) rwkv_scan_unit(a, L, blk, lds, tid, lane, wave); }
            else if (blk < ROLE_BLOCKS) { for (int r2 = 0; r2 < NREP(32); ++r2) hgrn_seq_unit(a, L, blk - SCAN_UNITS, lds, tid, lane, wave); }
            else for (int r2 = 0; r2 < NREP(33); ++r2) for (int it = blk - ROLE_BLOCKS; it < N_MISC; it += G - ROLE_BLOCKS) {
                if (it < N_SGU) sgu_item(a, L, it, lds, tid, lane, wave);
                else if (it < N_SGU + N_RS) rwkv_sample_item(a, L, it - N_SGU, lds, lane, wave);
                else hgrn_sample_item(a, L, it - N_SGU - N_RS, lds, lane, wave);
                __syncthreads();
            }
        }
#endif
        SEAM(pb + 4);
#if EN_POST
        if (IN(pb + 5)) for (int rep = 0; rep < NREP(4); ++rep) { LAUNDER(); phase_post(a, L, lane_, wave_, blk, G); }
#endif
        SEAM(pb + 5);
#if EN_G3
        if (IN(pb + 6)) for (int rep = 0; rep < NREP(5); ++rep) {
            pg8::Gemm g{(const bf16*)(ws + WS_YMIX), (const bf16*)(ws + WS_WOUT + L * SZ_WOUT), MPAD, DM, DM}; pg8::StaticOrder S; S.init(MPAD, DM, G, blk);
            pg8::EpiResid E{T, H, nullptr, DM, DN_ALPHA}; pg8::gemm_phase<pg8::EpiResid, pg8::StaticOrder, true, true>(lds, g, S, E);
        }
#endif
        SEAM(pb + 6);
#if EN_LN
        if (IN(pb + 7)) for (int rep = 0; rep < NREP(6); ++rep) { LAUNDER(); phase_ln(a, a.in[I_LN1G] + L * DM, a.in[I_LN1B] + L * DM, false, lane_, wave_, blk, G); }
#endif
        SEAM(pb + 7);
#if EN_G4
        if (IN(pb + 8)) for (int rep = 0; rep < NREP(7); ++rep) {
            { pg8::Gemm g{HB, (const bf16*)(ws + WS_WGU + L * SZ_WGU), MPAD, 2 * DFF, DM}; pg8::StaticOrder S; S.init(MPAD, 2 * DFF, G, blk);
              pg8::EpiSwiglu E{(bf16*)(ws + WS_ACT), DFF}; pg8::gemm_phase<pg8::EpiSwiglu, pg8::StaticOrder, true, true>(lds, g, S, E); }
            { pg8::Gemm g{HB, (const bf16*)(ws + WS_WPG + L * SZ_WPG), MPAD, DM, DM}; pg8::StaticOrder S; S.init(MPAD, DM, G, G - 1 - blk);
              pg8::EpiSigMul E{(float*)(ws + WS_PLE), (const float*)(ws + WS_PPO), DM}; pg8::gemm_phase<pg8::EpiSigMul, pg8::StaticOrder, true, true>(lds, g, S, E); }
        }
#endif
        SEAM(pb + 8);
#if EN_G5
        if (IN(pb + 9)) for (int rep = 0; rep < NREP(8); ++rep) {
            pg8::Gemm g{(const bf16*)(ws + WS_ACT), (const bf16*)(ws + WS_WD + L * SZ_WD), MPAD, DM, DFF}; pg8::StaticOrder S; S.init(MPAD, DM, G, blk);
            pg8::EpiResid E{T, H, (const float*)(ws + WS_PLE), DM, DN_ALPHA}; pg8::gemm_phase<pg8::EpiResid, pg8::StaticOrder, true, true>(lds, g, S, E);
        }
#endif
        SEAM(pb + 9);
#if EN_LN
        if (IN(pb + 10)) for (int rep = 0; rep < NREP(6); ++rep) { LAUNDER(); phase_ln(a, a.in[I_LN2G] + L * DM, a.in[I_LN2B] + L * DM, L == DEPTH - 1, lane_, wave_, blk, G); }
#endif
        SEAM(pb + 10);
    }
#undef IN
#undef SEAM
}

extern "C" void kernel_launch(void* const* d_in, const int* in_sizes, int n_in, void* d_out, int out_size, void* d_ws, size_t ws_size, hipStream_t stream) {
    static int grid = 0;
    if (grid == 0) {
        if (n_in != N_IN || (size_t)out_size != O_END || ws_size < WS_END) { fprintf(stderr, "kernel_launch: unexpected sizes n_in %d out %d ws %zu (need %zu)\n", n_in, out_size, ws_size, (size_t)WS_END); grid = -1; return; }
        int dev = 0, cus = 0, per_cu = 0;
        if (hipGetDevice(&dev) != hipSuccess || hipDeviceGetAttribute(&cus, hipDeviceAttributeMultiprocessorCount, dev) != hipSuccess) { grid = -1; return; }
        if (hipFuncSetAttribute((const void*)mk_fwd, hipFuncAttributeMaxDynamicSharedMemorySize, LDS_BYTES) != hipSuccess) { fprintf(stderr, "kernel_launch: hipFuncSetAttribute failed\n"); grid = -1; return; }
        if (hipOccupancyMaxActiveBlocksPerMultiprocessor(&per_cu, (const void*)mk_fwd, NTHR, LDS_BYTES) != hipSuccess || per_cu < 1) fprintf(stderr, "kernel_launch: occupancy query says %d\n", per_cu);
        (void)hipGetLastError();
        grid = cus;
        if (grid < ROLE_BLOCKS + 8) { fprintf(stderr, "kernel_launch: %d CUs is too few\n", grid); grid = -1; return; }
    }
    if (grid < 0) return;
    if (hipMemsetAsync((char*)d_ws + WS_CTL, 0, CTL_ZERO_BYTES, stream) != hipSuccess) return;
    Args a{};
    for (int i = 0; i < N_IN; ++i) a.in[i] = (const float*)d_in[i];
    a.out = (float*)d_out; a.ws = (unsigned char*)d_ws;
#if MK_SINGLE
    a.ph_lo = 0; a.ph_hi = N_PHASES;
    hipLaunchKernelGGL(mk_fwd, dim3(grid), dim3(NTHR), LDS_BYTES, stream, a);
#else
    for (int p = 0; p < N_PHASES; ++p) { a.ph_lo = p; a.ph_hi = p + 1; hipLaunchKernelGGL(mk_fwd, dim3(grid), dim3(NTHR), LDS_BYTES, stream, a); }
#endif
}
```

```cpp
#include <hip/hip_runtime.h>
#include <cstdio>
#include <cstdint>
__device__ __forceinline__ int mk_lane_id() { int l; asm volatile("v_mbcnt_lo_u32_b32 %0, -1, 0\n\tv_mbcnt_hi_u32_b32 %0, -1, %0" : "=v"(l)); return l; }
namespace pg8 {
#define PG8_LAS __attribute__((address_space(3)))
typedef unsigned short bf16_t;
typedef short bf16x8 __attribute__((ext_vector_type(8)));
typedef float f32x4 __attribute__((ext_vector_type(4)));
typedef unsigned u32x4 __attribute__((ext_vector_type(4)));
constexpr int BM = 256, BK = 64, HALF = 128, HTB = HALF * BK * 2  , STAGE_BYTES = 8 * HTB, NXCD = 8, WGM = 8;

__host__ __device__ __forceinline__ int lds_byte(int r, int c) { const int st = (r >> 4) * 2 + (c >> 5), rr = r & 15, cc = c & 31, ob = rr * 64 + cc * 2; return st * 1024 + (ob ^ (((ob >> 9) & 1) << 5)); }
__host__ __device__ __forceinline__ void stage_rc(int b, int& R, int& C) { const int st = b / 1024, sb = b % 1024, swz = sb ^ (((sb >> 9) & 1) << 5); R = (st >> 1) * 16 + swz / 64; C = (st & 1) * 32 + (swz % 64) / 2; }
__host__ __device__ __forceinline__ int perm32(int rho) { const int n = rho >> 4, i = rho & 15; return 8 * (i >> 2) + 4 * n + (i & 3); }

struct Unit { int pm, pn; };
struct Gemm { const bf16_t* A; const bf16_t* Bt; int M, N, K; };

struct StaticOrder {
    int nM, nN, nwg, G, c;
    __host__ __device__ void init(int M, int N, int G_, int c_) { nM = M / BM; nN = N / BM; nwg = nM * nN; G = G_; c = c_; }
    __host__ __device__ bool next(int i, Unit& u) const {
        const long L = (long)i * G + c; if (L >= nwg) return false;
        int wgid = (int)L; { const int q = nwg / NXCD, r = nwg % NXCD, xcd = wgid % NXCD, off = wgid / NXCD; wgid = (xcd < r ? xcd * (q + 1) : r * (q + 1) + (xcd - r) * q) + off; }
        const int nig = WGM * nN, gid = wgid / nig, fm = gid * WGM, gsz = (nM - fm) < WGM ? (nM - fm) : WGM;
        u.pm = fm + ((wgid % nig) % gsz); u.pn = (wgid % nig) / gsz; return true;
    }
    __device__ __forceinline__ void a_ready(const Unit&) const {}
    __device__ __forceinline__ void done(const Unit&) const {}
};

__device__ __forceinline__ unsigned cvt_pk_bf16(float lo, float hi) { unsigned r; asm volatile("v_cvt_pk_bf16_f32 %0, %1, %2" : "=v"(r) : "v"(lo), "v"(hi)); return r; }
typedef float f32x2 __attribute__((ext_vector_type(2)));
struct EpiF32 {
    static constexpr bool PERM = false, AFTER_DRAIN = false;
    float* C; int ldc;
    __device__ __forceinline__ void operator()(const f32x4 (&acc)[2][2][4][2], const Unit& u, int wr, int wc, int fr, int fq) const {
        const int row0 = u.pm * BM + wr * 64 + fr, col0 = u.pn * BM + wc * 32 + 4 * fq;
#pragma unroll
        for (int ai = 0; ai < 2; ++ai)
#pragma unroll
            for (int m = 0; m < 4; ++m) { float* rowp = C + (size_t)(row0 + ai * HALF + m * 16) * ldc + col0;
#pragma unroll
                for (int bj = 0; bj < 2; ++bj)
#pragma unroll
                    for (int n = 0; n < 2; ++n) *(f32x4*)(rowp + bj * HALF + n * 16) = acc[ai][bj][m][n]; }
    }
};
struct EpiResid {
    static constexpr bool PERM = false, AFTER_DRAIN = false;
    float* out; const float* base; const float* add; int ldc; float alpha;
    __device__ __forceinline__ void operator()(const f32x4 (&acc)[2][2][4][2], const Unit& u, int wr, int wc, int fr, int fq) const {
        const int row0 = u.pm * BM + wr * 64 + fr, col0 = u.pn * BM + wc * 32 + 4 * fq;
#pragma unroll
        for (int ai = 0; ai < 2; ++ai)
#pragma unroll
            for (int m = 0; m < 4; ++m) { const size_t off = (size_t)(row0 + ai * HALF + m * 16) * ldc + col0;
#pragma unroll
                for (int bj = 0; bj < 2; ++bj)
#pragma unroll
                    for (int n = 0; n < 2; ++n) { const size_t o2 = off + bj * HALF + n * 16; f32x4 v = *(const f32x4*)(base + o2) * alpha + acc[ai][bj][m][n];
                        if (add) v += *(const f32x4*)(add + o2); *(f32x4*)(out + o2) = v; } }
    }
};
struct EpiSigMul {
    static constexpr bool PERM = false, AFTER_DRAIN = false;
    float* out; const float* mul; int ldc;
    __device__ __forceinline__ void operator()(const f32x4 (&acc)[2][2][4][2], const Unit& u, int wr, int wc, int fr, int fq) const {
        const int row0 = u.pm * BM + wr * 64 + fr, col0 = u.pn * BM + wc * 32 + 4 * fq;
#pragma unroll
        for (int ai = 0; ai < 2; ++ai)
#pragma unroll
            for (int m = 0; m < 4; ++m) { const size_t off = (size_t)(row0 + ai * HALF + m * 16) * ldc + col0;
#pragma unroll
                for (int bj = 0; bj < 2; ++bj)
#pragma unroll
                    for (int n = 0; n < 2; ++n) { const size_t o2 = off + bj * HALF + n * 16; const f32x4 x = acc[ai][bj][m][n]; const f32x4 p = *(const f32x4*)(mul + o2); f32x4 v;
#pragma unroll
                        for (int e = 0; e < 4; ++e) v[e] = p[e] * __builtin_amdgcn_rcpf(1.0f + __expf(-x[e]));
                        *(f32x4*)(out + o2) = v; } }
    }
};
struct EpiSwiglu {
    static constexpr bool PERM = true, AFTER_DRAIN = false;
    bf16_t* O; int ldo;
    __device__ __forceinline__ void operator()(const f32x4 (&acc)[2][2][4][2], const Unit& u, int wr, int wc, int fr, int fq) const {
        const int row0 = u.pm * BM + wr * 64 + fr, col0 = u.pn * HALF + wc * 32 + 8 * fq;
#pragma unroll
        for (int ai = 0; ai < 2; ++ai)
#pragma unroll
            for (int m = 0; m < 4; ++m) { bf16_t* rowp = O + (size_t)(row0 + ai * HALF + m * 16) * ldo + col0; float r[8];
#pragma unroll
                for (int n = 0; n < 2; ++n)
#pragma unroll
                    for (int e = 0; e < 4; ++e) { const float g = acc[ai][0][m][n][e], up = acc[ai][1][m][n][e]; r[4 * n + e] = g * __builtin_amdgcn_rcpf(1.0f + __expf(-g)) * up; }
                u32x4 w; w.x = cvt_pk_bf16(r[0], r[1]); w.y = cvt_pk_bf16(r[2], r[3]); w.z = cvt_pk_bf16(r[4], r[5]); w.w = cvt_pk_bf16(r[6], r[7]);
                *(u32x4*)rowp = w; }
    }
};
template <class Epi, class Sched, bool ALIGN_EPI = false, bool SP2 = false>
__device__ __forceinline__ void gemm_phase(PG8_LAS unsigned char* lds, const Gemm g, const Sched& S, const Epi& E, int wid0) {
    int tid_l = wid0 * 64 + mk_lane_id(); asm volatile("" : "+v"(tid_l));
    const int tid = tid_l, wid = __builtin_amdgcn_readfirstlane(tid >> 6), lane = tid & 63, wr = wid >> 2, wc = wid & 3, fr = lane & 15, fq = lane >> 4;
    const int K = g.K, nt = K / BK;
    unsigned voffA[2], voffB[2];
#pragma unroll
    for (int i = 0; i < 2; ++i) { int R, C; stage_rc(tid * 16 + i * 8192, R, C); const int Rb = Epi::PERM ? ((R & ~31) + perm32(R & 31)) : R;
        voffA[i] = (unsigned)(R * K + C) * 2u; voffB[i] = (unsigned)(Rb * K + C) * 2u; }
    const size_t kstep = (size_t)(BK * 2);
    const size_t hstep = (size_t)HALF * K * 2;
    const size_t tstep = 2 * hstep;
    const unsigned ldsw = (unsigned)wid * 1024u;
    const int aoff = lds_byte(wr * 64 + fr, fq * 8), boff = lds_byte(wc * 32 + fr, fq * 8);
#define PG8_SA(b, h) (((b) * 2 + (h)) * HTB)
#define PG8_SB(b, h) ((4 + (b) * 2 + (h)) * HTB)
#define PG8_STAGE(bufoff, gbase, voff) do { _Pragma("unroll") for (int _i = 0; _i < 2; ++_i) \
        __builtin_amdgcn_global_load_lds((const unsigned*)((const char*)(gbase) + (voff)[_i]), (PG8_LAS unsigned*)(lds + (bufoff) + ldsw + _i * 8192), 16, 0, 0); } while (0)
#define PG8_LDA(dst, b, h) do { _Pragma("unroll") for (int m = 0; m < 4; ++m) _Pragma("unroll") for (int k = 0; k < 2; ++k) dst[m][k] = *(const PG8_LAS bf16x8*)(lds + PG8_SA(b, h) + aoff + m * 2048 + k * 1024); } while (0)
#define PG8_LDB(dst, b, h) do { _Pragma("unroll") for (int n = 0; n < 2; ++n) _Pragma("unroll") for (int k = 0; k < 2; ++k) dst[n][k] = *(const PG8_LAS bf16x8*)(lds + PG8_SB(b, h) + boff + n * 2048 + k * 1024); } while (0)
#define PG8_MMA(ai, bj, At, Bt) do { __builtin_amdgcn_s_setprio(1); _Pragma("unroll") for (int m = 0; m < 4; ++m) _Pragma("unroll") for (int n = 0; n < 2; ++n) _Pragma("unroll") for (int k = 0; k < 2; ++k) \
        acc[ai][bj][m][n] = __builtin_amdgcn_mfma_f32_16x16x32_bf16(Bt[n][k], At[m][k], acc[ai][bj][m][n], 0, 0, 0); __builtin_amdgcn_s_setprio(0); } while (0)
#define PG8_WAIT_V(n) asm volatile("s_waitcnt vmcnt(" #n ")" ::: "memory")
#define PG8_WAIT_L(n) asm volatile("s_waitcnt lgkmcnt(" #n ")" ::: "memory")
#define PG8_BAR __builtin_amdgcn_s_barrier()
#define PG8_SCHED __builtin_amdgcn_sched_barrier(0)
    Unit cur, nxt; int ui = 0;
    if (!S.next(0, cur)) return;
    f32x4 acc[2][2][4][2];
#pragma unroll
    for (int a = 0; a < 2; ++a)
#pragma unroll
        for (int b = 0; b < 2; ++b)
#pragma unroll
            for (int m = 0; m < 4; ++m)
#pragma unroll
                for (int n = 0; n < 2; ++n) acc[a][b][m][n] = (f32x4){0.f, 0.f, 0.f, 0.f};
    bf16x8 At[4][2], B0[2][2], B1[2][2];
    const char* cA = (const char*)g.A + (size_t)cur.pm * tstep; const char* cB = (const char*)g.Bt + (size_t)cur.pn * tstep;
    S.a_ready(cur);
    if constexpr (SP2) {
        PG8_STAGE(PG8_SB(0, 0), cB, voffB); PG8_STAGE(PG8_SB(0, 1), cB + hstep, voffB); PG8_STAGE(PG8_SA(0, 0), cA, voffA); PG8_STAGE(PG8_SA(0, 1), cA + hstep, voffA);
        if (wr == 1) PG8_BAR;
        PG8_WAIT_V(2); PG8_BAR;
        PG8_STAGE(PG8_SB(1, 0), cB + kstep, voffB); PG8_STAGE(PG8_SA(1, 0), cA + kstep, voffA); PG8_STAGE(PG8_SB(1, 1), cB + hstep + kstep, voffB);
        PG8_WAIT_V(6); PG8_BAR;
    } else {
        PG8_STAGE(PG8_SB(0, 0), cB, voffB); PG8_STAGE(PG8_SA(0, 0), cA, voffA); PG8_STAGE(PG8_SB(0, 1), cB + hstep, voffB); PG8_STAGE(PG8_SA(0, 1), cA + hstep, voffA);
        if (wr == 1) PG8_BAR;
        PG8_WAIT_V(4); PG8_BAR;
        PG8_STAGE(PG8_SB(1, 0), cB + kstep, voffB); PG8_STAGE(PG8_SA(1, 0), cA + kstep, voffA); PG8_STAGE(PG8_SB(1, 1), cB + hstep + kstep, voffB);
        PG8_WAIT_V(6); PG8_BAR;
    }
    for (;;) {
        const bool has_next = S.next(ui + 1, nxt);
        const char* nA = has_next ? (const char*)g.A + (size_t)nxt.pm * tstep : cA; const char* nB = has_next ? (const char*)g.Bt + (size_t)nxt.pn * tstep : cB;
        for (int t = 0; t < nt; t += 2) {
            const bool last = (t == nt - 2);
            const char* a1 = cA + (size_t)(t + 1) * kstep;
            const char* a2 = last ? nA : cA + (size_t)(t + 2) * kstep; const char* b2 = last ? nB : cB + (size_t)(t + 2) * kstep;
            const char* a3 = a2 + kstep; const char* b3 = b2 + kstep;
            if (last && has_next) S.a_ready(nxt);
            if constexpr (SP2) {
            PG8_LDB(B0, 0, 0); PG8_LDB(B1, 0, 1); PG8_SCHED; PG8_LDA(At, 0, 0); PG8_STAGE(PG8_SA(1, 1), a1 + hstep, voffA);
            PG8_WAIT_V(8); PG8_WAIT_L(0); PG8_BAR; PG8_MMA(0, 0, At, B0); PG8_MMA(0, 1, At, B1); PG8_BAR; PG8_SCHED;
            PG8_LDA(At, 0, 1); PG8_STAGE(PG8_SB(0, 0), b2, voffB); PG8_STAGE(PG8_SB(0, 1), b2 + hstep, voffB); PG8_STAGE(PG8_SA(0, 0), a2, voffA);
            PG8_WAIT_V(8); PG8_WAIT_L(0); PG8_BAR; PG8_MMA(1, 0, At, B0); PG8_MMA(1, 1, At, B1); PG8_BAR; PG8_SCHED;
            PG8_LDB(B0, 1, 0); PG8_LDB(B1, 1, 1); PG8_SCHED; PG8_LDA(At, 1, 0); PG8_STAGE(PG8_SA(0, 1), a2 + hstep, voffA);
            PG8_WAIT_V(8); PG8_WAIT_L(0); PG8_BAR; PG8_MMA(0, 0, At, B0); PG8_MMA(0, 1, At, B1); PG8_BAR; PG8_SCHED;
            PG8_LDA(At, 1, 1); PG8_STAGE(PG8_SB(1, 0), b3, voffB); PG8_STAGE(PG8_SB(1, 1), b3 + hstep, voffB); PG8_STAGE(PG8_SA(1, 0), a3, voffA);
            PG8_WAIT_V(8); PG8_WAIT_L(0); PG8_BAR; PG8_MMA(1, 0, At, B0); PG8_MMA(1, 1, At, B1); PG8_BAR; PG8_SCHED;
            } else {
            PG8_LDB(B0, 0, 0); PG8_SCHED; PG8_LDA(At, 0, 0); PG8_STAGE(PG8_SA(1, 1), a1 + hstep, voffA);
            PG8_WAIT_L(8); PG8_BAR; PG8_WAIT_L(0); PG8_MMA(0, 0, At, B0); PG8_BAR; PG8_SCHED;
            PG8_LDB(B1, 0, 1); PG8_STAGE(PG8_SB(0, 0), b2, voffB);
            PG8_BAR; PG8_WAIT_L(0); PG8_MMA(0, 1, At, B1); PG8_BAR;
            PG8_LDA(At, 0, 1); PG8_STAGE(PG8_SA(0, 0), a2, voffA);
            PG8_BAR; PG8_WAIT_L(0); PG8_MMA(1, 0, At, B0); PG8_BAR; PG8_SCHED;
            PG8_STAGE(PG8_SB(0, 1), b2 + hstep, voffB);
            PG8_WAIT_V(6); PG8_BAR; PG8_MMA(1, 1, At, B1); PG8_BAR;
            PG8_LDB(B0, 1, 0); PG8_SCHED; PG8_LDA(At, 1, 0); PG8_STAGE(PG8_SA(0, 1), a2 + hstep, voffA);
            PG8_WAIT_L(8); PG8_BAR; PG8_WAIT_L(0); PG8_MMA(0, 0, At, B0); PG8_BAR; PG8_SCHED;
            PG8_LDB(B1, 1, 1); PG8_STAGE(PG8_SB(1, 0), b3, voffB);
            PG8_BAR; PG8_WAIT_L(0); PG8_MMA(0, 1, At, B1); PG8_BAR;
            PG8_LDA(At, 1, 1); PG8_STAGE(PG8_SA(1, 0), a3, voffA);
            PG8_BAR; PG8_WAIT_L(0); PG8_MMA(1, 0, At, B0); PG8_BAR; PG8_SCHED;
            PG8_STAGE(PG8_SB(1, 1), b3 + hstep, voffB);
            PG8_WAIT_V(6); PG8_BAR; PG8_MMA(1, 1, At, B1); PG8_BAR;
            }
        }
        if constexpr (ALIGN_EPI) { if (wr == 0) PG8_BAR; }
        if constexpr (!Epi::AFTER_DRAIN) { E(acc, cur, wr, wc, fr, fq); S.done(cur); }
        if (!has_next) break;
#pragma unroll
        for (int a = 0; a < 2; ++a)
#pragma unroll
            for (int b = 0; b < 2; ++b)
#pragma unroll
                for (int m = 0; m < 4; ++m)
#pragma unroll
                    for (int n = 0; n < 2; ++n) acc[a][b][m][n] = (f32x4){0.f, 0.f, 0.f, 0.f};
        cur = nxt; cA = nA; cB = nB; ++ui;
        if constexpr (ALIGN_EPI) { if (wr == 1) PG8_BAR; }
    }
    PG8_WAIT_V(0);
    if constexpr (!ALIGN_EPI) { if (wr == 0) PG8_BAR; }
    PG8_BAR;
    if constexpr (Epi::AFTER_DRAIN) { E.fused(acc, cur, wr, wc, fr, fq, lds, wid, lane); S.done(cur); }
#undef PG8_SA
#undef PG8_SB
#undef PG8_STAGE
#undef PG8_LDA
#undef PG8_LDB
#undef PG8_MMA
#undef PG8_WAIT_V
#undef PG8_WAIT_L
#undef PG8_BAR
#undef PG8_SCHED
}
}
#define GAS __attribute__((address_space(1)))
#define LAS __attribute__((address_space(3)))
typedef unsigned short bf16;
typedef unsigned v4u __attribute__((ext_vector_type(4)));
typedef float f32x4 __attribute__((ext_vector_type(4)));
typedef short bf16x8 __attribute__((ext_vector_type(8)));
typedef GAS unsigned gu32;
typedef GAS unsigned long long gu64;
#define RLX_AGENT __ATOMIC_RELAXED, __HIP_MEMORY_SCOPE_AGENT
#define LDS_WAIT() asm volatile("s_waitcnt lgkmcnt(0)" ::: "memory")
#define VM_WAIT() asm volatile("s_waitcnt vmcnt(0)" ::: "memory")
__device__ __forceinline__ unsigned long long rt() { return __builtin_amdgcn_s_memrealtime(); }
__device__ __forceinline__ unsigned f2bf(float f) { unsigned u = __builtin_bit_cast(unsigned, f); return (u + 0x7fffu + ((u >> 16) & 1u)) >> 16; }
__device__ __forceinline__ unsigned pk2(float lo, float hi) { return f2bf(lo) | (f2bf(hi) << 16); }

#define XB_TMO      128
#define XB_XCNT(j)  (256  + 64 * (j))
#define XB_XSUB(j)  (1280 + 64 * (j))
#define XB_XGEN(j)  (2304 + 64 * (j))
#define XB_TOP      3328
#define XB_TOPGEN   3392
#define XCD_BAR_WORDS 3456
#define XB_SPIN_CAP (1u << 18)

__device__ __forceinline__ unsigned xb_ld(unsigned* p)              { return __hip_atomic_load(p, __ATOMIC_RELAXED, __HIP_MEMORY_SCOPE_AGENT); }
__device__ __forceinline__ unsigned xb_add(unsigned* p, unsigned v) { return __hip_atomic_fetch_add(p, v, __ATOMIC_RELAXED, __HIP_MEMORY_SCOPE_AGENT); }
__device__ __forceinline__ unsigned xb_xcc_id() { return (unsigned)__builtin_amdgcn_s_getreg((3 << 11) | 20) & 0xFu; }
#define XB_SPIN(cond, bar) do { unsigned _sp = 0; while (cond) { __builtin_amdgcn_s_sleep(1); \
    if ((++_sp & 255u) == 0u) { if (xb_ld(&(bar)[XB_TMO])) break; if (_sp > XB_SPIN_CAP) { atomicAdd(&(bar)[XB_TMO], 1u); break; } } } } while (0)

struct XcdBarrier {
    unsigned* bar; unsigned x;
    volatile LAS unsigned* st;
    bool w0;
};

__device__ __forceinline__ XcdBarrier xcd_barrier_post(unsigned* bar, volatile LAS unsigned* st) {
    XcdBarrier b; b.bar = bar; b.x = xb_xcc_id(); b.st = st;
    if (threadIdx.x == 0) (void)xb_add(&bar[XB_XCNT(b.x)], 1u);
    return b;
}
__device__ __forceinline__ void xcd_barrier_complete(unsigned* bar, unsigned x, unsigned& nloc, unsigned& nx) {
    const unsigned G = gridDim.x * gridDim.y * gridDim.z;
    unsigned sum, cnt, mine, sp = 0u;
    for (;;) {
        sum = 0u; cnt = 0u; mine = 0u;
#pragma unroll
        for (unsigned j = 0; j < 16; ++j) { const unsigned c = xb_ld(&bar[XB_XCNT(j)]); sum += c; cnt += (c > 0u) ? 1u : 0u; mine = (j == x) ? c : mine; }
        if (sum == G) break;
        __builtin_amdgcn_s_sleep(1);
        if ((++sp & 255u) == 0u) { if (xb_ld(&bar[XB_TMO])) break; if (sp > XB_SPIN_CAP) { atomicAdd(&bar[XB_TMO], 1u); break; } }
    }
    nloc = mine > 0u ? mine : 1u; nx = cnt > 0u ? cnt : 1u;
}

__device__ __forceinline__ void xcd_barrier(const XcdBarrier& b) {
    asm volatile("s_waitcnt vmcnt(0)" ::: "memory");
    __syncthreads();
    if (b.w0 && mk_lane_id() == 0) {
        unsigned* bar = b.bar;
        __builtin_amdgcn_s_waitcnt(0);
        unsigned nloc = b.st[0], nx = b.st[1];
        if (nloc == 0u) { xcd_barrier_complete(bar, b.x, nloc, nx); b.st[0] = nloc; b.st[1] = nx; }
        const unsigned old = xb_add(&bar[XB_XSUB(b.x)], 1u);
        const unsigned gen = old / nloc;
        if (old + 1u == (gen + 1u) * nloc) {
            __builtin_amdgcn_fence(__ATOMIC_RELEASE, "agent");
            asm volatile("s_waitcnt vmcnt(0)" ::: "memory");
            const unsigned og = xb_add(&bar[XB_TOP], 1u);
            const unsigned tg = og / nx;
            if (og + 1u == (tg + 1u) * nx) xb_add(&bar[XB_TOPGEN], 1u);
            else XB_SPIN(xb_ld(&bar[XB_TOPGEN]) == tg, bar);
            __builtin_amdgcn_fence(__ATOMIC_ACQUIRE, "agent");
            xb_add(&bar[XB_XGEN(b.x)], 1u);
            asm volatile("s_waitcnt vmcnt(0)" ::: "memory");
        } else {
            XB_SPIN(xb_ld(&bar[XB_XGEN(b.x)]) == gen, bar);
            __builtin_amdgcn_fence(__ATOMIC_ACQUIRE, "agent");
            asm volatile("s_waitcnt vmcnt(0)" ::: "memory");
        }
    }
    __syncthreads();
}

constexpr int DM = 2048, NBAT = 4, SEQ = 2048, DEPTH = 4, NS = 128;
constexpr int MP = NBAT * SEQ;
constexpr int MV = MP + NS;
constexpr int MPAD = 8448;
constexpr int WA = 512, WB = 768, WC = 768, PIN = 6656, DFF = 5632, DPLE = 256, PBW = 2560;
constexpr int OFF_B = 1024, OFF_C = 3584;
constexpr float LN_EPS = 1e-5f, GN_EPS = 64e-5f, RMS_EPS = 1e-6f;
constexpr float DN_ALPHA = 1.681792830507429f;
enum { I_XP = 0, I_XS, I_SRWKV, I_SSHIFT, I_SHGRN, I_PP, I_PS, I_LNING, I_LNINB, I_WIN, I_ALNG, I_ALNB, I_AWS, I_ABS, I_BMU, I_BW0, I_BWUP, I_BA0, I_BAUP, I_BGUP,
       I_BKK, I_BKA, I_BRK, I_BGNG, I_BGNB, I_CLB, I_CNG, I_WOUT, I_LN1G, I_LN1B, I_WG, I_WU, I_WD, I_WPG, I_WPP, I_LN2G, I_LN2B, N_IN };
constexpr size_t O_YP = 0, O_YS = O_YP + (size_t)MP * DM, O_RP = O_YS + (size_t)NS * DM, O_SP = O_RP + (size_t)DEPTH * NBAT * 12 * 4096,
                 O_HP = O_SP + (size_t)DEPTH * NBAT * PBW, O_RS = O_HP + (size_t)DEPTH * NBAT * 6 * 16384, O_SS = O_RS + (size_t)DEPTH * NS * 12 * 4096,
                 O_HS = O_SS + (size_t)DEPTH * NS * PBW, O_VS = O_HS + (size_t)DEPTH * NS * 6 * 16384, O_END = O_VS + (size_t)DEPTH * NS * WA;
static_assert(O_END == 96509952, "output size");
constexpr size_t al256(size_t x) { return (x + 255) & ~(size_t)255; }
constexpr size_t WS_CTL = 0, CTL_ZERO_BYTES = 1u << 20;
constexpr size_t SZ_WIN = (size_t)PIN * DM * 2, SZ_WOUT = (size_t)DM * DM * 2, SZ_WGU = (size_t)2 * DFF * DM * 2, SZ_WD = (size_t)DM * DFF * 2, SZ_WPG = SZ_WOUT, SZ_WPP = (size_t)DM * DPLE * 2;
constexpr size_t WS_WIN = CTL_ZERO_BYTES, WS_WOUT = WS_WIN + DEPTH * SZ_WIN, WS_WGU = WS_WOUT + DEPTH * SZ_WOUT, WS_WD = WS_WGU + DEPTH * SZ_WGU, WS_WPG = WS_WD + DEPTH * SZ_WD,
                 WS_WPP = WS_WPG + DEPTH * SZ_WPG, WS_PBF = WS_WPP + DEPTH * SZ_WPP;
constexpr size_t SZ_PBF = (size_t)MPAD * DPLE * 2;
constexpr size_t WS_H = WS_PBF + DEPTH * SZ_PBF, WS_HB = WS_H + (size_t)MPAD * DM * 4, WS_T = WS_HB + (size_t)MPAD * DM * 2, WS_YMIX = WS_T + (size_t)MPAD * DM * 4;
constexpr size_t WS_Z = WS_YMIX + (size_t)MPAD * DM * 2;
constexpr size_t WS_ACT = WS_Z, WS_PLE = WS_ACT + al256((size_t)MPAD * DFF * 2);
constexpr size_t WS_PPO = WS_Z + (size_t)MPAD * PIN * 4;
static_assert(WS_PLE + (size_t)MPAD * DM * 4 <= WS_PPO, "overlay fits");
constexpr size_t WS_RPB = WS_PPO + (size_t)MPAD * DM * 4;
constexpr size_t WS_RPS = WS_RPB + (size_t)NBAT * 12 * SEQ * 384 * 4;
constexpr int NLORA = 3 * WB;
constexpr size_t SZ_WL = (size_t)NLORA * 256 * 2;
constexpr size_t WS_WL = WS_RPS + (size_t)NS * 12 * 384 * 4;
constexpr size_t WS_XCAT = WS_WL + DEPTH * SZ_WL;
constexpr size_t WS_LORA = WS_XCAT + (size_t)MPAD * 256 * 2;
constexpr size_t WS_Y = WS_LORA + (size_t)MPAD * NLORA * 4;
constexpr size_t WS_O = WS_Y + (size_t)MPAD * WB * 4;
constexpr size_t WS_END = WS_O + (size_t)MPAD * WC * 4;
static_assert(WS_WIN % 256 == 0 && WS_H % 256 == 0 && WS_Z % 256 == 0 && WS_RPB % 256 == 0 && WS_WL % 256 == 0 && WS_XCAT % 256 == 0 && WS_LORA % 256 == 0 && WS_Y % 256 == 0, "alignment");
constexpr int CW_BAR = 4096;

constexpr int RING_BYTES = 131072, LDSCTL_OFF = RING_BYTES, MISC_OFF = LDSCTL_OFF + 320, LDS_BYTES = 147456;
constexpr int NWAVES = 8, NTHR = 512;

struct Args { const float* in[N_IN]; float* out; unsigned char* ws; int ph_lo, ph_hi; };
static_assert(sizeof(Args) == (N_IN + 2) * 8 + 8, "no padding in Args");
typedef const __attribute__((address_space(4))) Args* ArgsP;

typedef float f4 __attribute__((ext_vector_type(4)));
typedef float f2 __attribute__((ext_vector_type(2)));
typedef unsigned u2 __attribute__((ext_vector_type(2)));

__device__ __forceinline__ float wave_sum(float v) {
#pragma unroll
    for (int o = 1; o < 64; o <<= 1) v += __shfl_xor(v, o);
    return v;
}
template <int CTRL> __device__ __forceinline__ float dpp_f(float x) { return __builtin_bit_cast(float, __builtin_amdgcn_update_dpp(0, __builtin_bit_cast(int, x), CTRL, 0xF, 0xF, true)); }
__device__ __forceinline__ float row16_sum(float x) {
    x += dpp_f<0xB1>(x);
    x += dpp_f<0x4E>(x);
    x += dpp_f<0x141>(x);
    x += dpp_f<0x140>(x);
    return x;
}
__device__ __forceinline__ float sigmoidf_(float x) { return 1.0f / (1.0f + expf(-x)); }
__device__ __forceinline__ float gelu_erf(float x) { return 0.5f * x * (1.0f + erff(x * 0.70710678118654752f)); }
__device__ __forceinline__ unsigned short bf1(float x) { return (unsigned short)(pg8::cvt_pk_bf16(x, 0.f) & 0xffffu); }
__device__ __forceinline__ float lbound(const float* clb, int L, int c) {
    const float x0 = clb[c], x1 = clb[WC + c], x2 = clb[2 * WC + c], x3 = clb[3 * WC + c];
    const float mx = fmaxf(fmaxf(x0, x1), fmaxf(x2, x3));
    const float e0 = expf(x0 - mx), e1 = expf(x1 - mx), e2 = expf(x2 - mx), e3 = expf(x3 - mx);
    float s = 0.f; if (L >= 1) s += e1; if (L >= 2) s += e2; if (L >= 3) s += e3;
    return s / (e0 + e1 + e2 + e3);
}
__device__ __forceinline__ float log_sigmoid(float x) { return fminf(x, 0.f) - log1pf(expf(-fabsf(x))); }

__device__ __forceinline__ void tr_item(const float* W, int K, int N, bf16* WT, int mode, LAS float* scr, int item, int lane) {
    const int nblk = N >> 5, kb = item / nblk, nb = item - kb * nblk, k0 = kb << 6, n0 = nb << 5;
    int rb = n0; if (mode) rb = ((n0 >> 7) << 8) + (n0 & 127) + (mode == 2 ? 128 : 0);
#pragma unroll 8
    for (int i = 0; i < 32; ++i) { const int kk = 2 * i + (lane >> 5); scr[kk * 33 + (lane & 31)] = W[(size_t)(k0 + kk) * N + n0 + (lane & 31)]; }
    LDS_WAIT(); asm volatile("" ::: "memory");
    const int c = lane & 7;
#pragma unroll
    for (int j = 0; j < 4; ++j) { const int n = (lane >> 3) + 8 * j; const LAS float* s = scr + (8 * c) * 33 + n;
        v4u o; o.x = pg8::cvt_pk_bf16(s[0 * 33], s[1 * 33]); o.y = pg8::cvt_pk_bf16(s[2 * 33], s[3 * 33]); o.z = pg8::cvt_pk_bf16(s[4 * 33], s[5 * 33]); o.w = pg8::cvt_pk_bf16(s[6 * 33], s[7 * 33]);
        *(v4u*)(WT + (size_t)(rb + n) * K + k0 + 8 * c) = o; }
    LDS_WAIT(); asm volatile("" ::: "memory");
}
__device__ __forceinline__ void ln_row(const float* src, const float* g, const float* b, float* dstf, bf16* dstb, float* dst2, int lane) {
    f4 v[8]; float s = 0.f;
#pragma unroll
    for (int j = 0; j < 8; ++j) { v[j] = *(const f4*)(src + 4 * (lane + 64 * j)); s += (v[j].x + v[j].y) + (v[j].z + v[j].w); }
    const float mean = wave_sum(s) * (1.f / DM); float s2 = 0.f;
#pragma unroll
    for (int j = 0; j < 8; ++j) { v[j] = v[j] - mean; s2 += (v[j].x * v[j].x + v[j].y * v[j].y) + (v[j].z * v[j].z + v[j].w * v[j].w); }
    const float rstd = 1.0f / sqrtf(wave_sum(s2) * (1.f / DM) + LN_EPS);
#pragma unroll
    for (int j = 0; j < 8; ++j) { const int c = 4 * (lane + 64 * j); const f4 gg = *(const f4*)(g + c), bb = *(const f4*)(b + c); const f4 o = v[j] * rstd * gg + bb;
        *(f4*)(dstf + c) = o; if (dst2) *(f4*)(dst2 + c) = o;
        u2 w; w.x = pg8::cvt_pk_bf16(o.x, o.y); w.y = pg8::cvt_pk_bf16(o.z, o.w); *(u2*)(dstb + c) = w; }
}
__device__ __forceinline__ void phase_prologue(ArgsP a, LAS unsigned char* lds, int lane, int wave, int blk, int G) {
    LAS float* scr = (LAS float*)(lds + wave * 16384);
    const int gw = blk * NWAVES + wave, NGW = G * NWAVES;
    constexpr int I_IN = 32 * (PIN / 32), I_OUT = 32 * (DM / 32), I_G = 32 * (DFF / 32), I_D = (DFF / 64) * (DM / 32), I_PGc = I_OUT, I_PPc = (DPLE / 64) * (DM / 32);
    constexpr int PER_L = I_IN + I_OUT + 2 * I_G + I_D + I_PGc + I_PPc;
    unsigned char* ws = a->ws;
    for (int it = gw; it < DEPTH * PER_L; it += NGW) {
        const int L = it / PER_L; int r = it - L * PER_L;
        if (r < I_IN) { tr_item(a->in[I_WIN] + (size_t)L * DM * PIN, DM, PIN, (bf16*)(ws + WS_WIN + L * SZ_WIN), 0, scr, r, lane); continue; } r -= I_IN;
        if (r < I_OUT) { tr_item(a->in[I_WOUT] + (size_t)L * DM * DM, DM, DM, (bf16*)(ws + WS_WOUT + L * SZ_WOUT), 0, scr, r, lane); continue; } r -= I_OUT;
        if (r < I_G) { tr_item(a->in[I_WG] + (size_t)L * DM * DFF, DM, DFF, (bf16*)(ws + WS_WGU + L * SZ_WGU), 1, scr, r, lane); continue; } r -= I_G;
        if (r < I_G) { tr_item(a->in[I_WU] + (size_t)L * DM * DFF, DM, DFF, (bf16*)(ws + WS_WGU + L * SZ_WGU), 2, scr, r, lane); continue; } r -= I_G;
        if (r < I_D) { tr_item(a->in[I_WD] + (size_t)L * DFF * DM, DFF, DM, (bf16*)(ws + WS_WD + L * SZ_WD), 0, scr, r, lane); continue; } r -= I_D;
        if (r < I_PGc) { tr_item(a->in[I_WPG] + (size_t)L * DM * DM, DM, DM, (bf16*)(ws + WS_WPG + L * SZ_WPG), 0, scr, r, lane); continue; } r -= I_PGc;
        tr_item(a->in[I_WPP] + (size_t)L * DPLE * DM, DPLE, DM, (bf16*)(ws + WS_WPP + L * SZ_WPP), 0, scr, r, lane);
    }
    for (int it = gw; it < DEPTH * NLORA; it += NGW) { const int L = it / NLORA, n = it - L * NLORA; float v[4];
#pragma unroll
        for (int e = 0; e < 4; ++e) { const int k = 4 * lane + e; float x = 0.f;
            if (n < WB) { if (k < 64) x = a->in[I_BWUP][((size_t)L * 64 + k) * WB + n]; }
            else if (n < 2 * WB) { if (k >= 64 && k < 128) x = a->in[I_BAUP][((size_t)L * 64 + (k - 64)) * WB + (n - WB)]; }
            else { if (k >= 128) x = a->in[I_BGUP][((size_t)L * 128 + (k - 128)) * WB + (n - 2 * WB)]; }
            v[e] = x; }
        u2 w; w.x = pg8::cvt_pk_bf16(v[0], v[1]); w.y = pg8::cvt_pk_bf16(v[2], v[3]); *(u2*)((bf16*)(ws + WS_WL + L * SZ_WL) + (size_t)n * 256 + 4 * lane) = w; }
    for (int it = gw; it < DEPTH * MV; it += NGW) { const int L = it / MV, m = it - L * MV;
        const float* src = (m < MP) ? a->in[I_PP] + ((size_t)L * MP + m) * DPLE : a->in[I_PS] + ((size_t)L * NS + (m - MP)) * DPLE;
        const f4 v = *(const f4*)(src + 4 * lane); u2 w; w.x = pg8::cvt_pk_bf16(v.x, v.y); w.y = pg8::cvt_pk_bf16(v.z, v.w);
        *(u2*)((bf16*)(ws + WS_PBF + L * SZ_PBF) + (size_t)m * DPLE + 4 * lane) = w; }
    for (int m = gw; m < MV; m += NGW) { const float* src = (m < MP) ? a->in[I_XP] + (size_t)m * DM : a->in[I_XS] + (size_t)(m - MP) * DM;
        ln_row(src, a->in[I_LNING], a->in[I_LNINB], (float*)(ws + WS_H) + (size_t)m * DM, (bf16*)(ws + WS_HB) + (size_t)m * DM, nullptr, lane); }
}
__device__ __forceinline__ void phase_ln(ArgsP a, const float* g, const float* b, bool last, int lane, int wave, int blk, int G) {
    const int gw = blk * NWAVES + wave, NGW = G * NWAVES; unsigned char* ws = a->ws;
    for (int m = gw; m < MV; m += NGW)
        ln_row((const float*)(ws + WS_T) + (size_t)m * DM, g, b, (float*)(ws + WS_H) + (size_t)m * DM, (bf16*)(ws + WS_HB) + (size_t)m * DM,
               last ? a->out + (m < MP ? O_YP + (size_t)m * DM : O_YS + (size_t)(m - MP) * DM) : nullptr, lane);
}


__device__ __forceinline__ void phase_xc(ArgsP a, int L, int lane, int wave, int blk, int G) {
    unsigned char* ws = a->ws; const int gw = blk * NWAVES + wave, NGW = G * NWAVES;
    const float* Z = (const float*)(ws + WS_Z);
    const float* mu = a->in[I_BMU] + L * PBW; const float* sh0 = a->in[I_SSHIFT] + (size_t)L * NS * PBW;
    const f4 mu4 = *(const f4*)(mu + 2304 + 4 * lane);
    for (int m = gw; m < MV; m += NGW) {
        const bool samp = m >= MP; const float* zr = Z + (size_t)m * PIN + OFF_B;
        const f4 cur = *(const f4*)(zr + 2304 + 4 * lane); f4 prev;
        if (samp) prev = *(const f4*)(sh0 + (size_t)(m - MP) * PBW + 2304 + 4 * lane); else if (m & (SEQ - 1)) prev = *(const f4*)(zr - PIN + 2304 + 4 * lane); else prev = (f4){0.f, 0.f, 0.f, 0.f};
        f4 x = cur + mu4 * (prev - cur);
        if (lane < 16) { x.x = tanhf(x.x); x.y = tanhf(x.y); x.z = tanhf(x.z); x.w = tanhf(x.w); }
        else if (lane >= 32) { x.x = sigmoidf_(x.x); x.y = sigmoidf_(x.y); x.z = sigmoidf_(x.z); x.w = sigmoidf_(x.w); }
        u2 w; w.x = pg8::cvt_pk_bf16(x.x, x.y); w.y = pg8::cvt_pk_bf16(x.z, x.w); *(u2*)((bf16*)(ws + WS_XCAT) + (size_t)m * 256 + 4 * lane) = w;
        if (samp || (m & (SEQ - 1)) == SEQ - 1) { float* dst = samp ? a->out + O_SS + ((size_t)L * NS + (m - MP)) * PBW : a->out + O_SP + ((size_t)L * NBAT + (m >> 11)) * PBW;
#pragma unroll
            for (int j = 0; j < PBW / 256; ++j) *(f4*)(dst + 256 * j + 4 * lane) = *(const f4*)(zr + 256 * j + 4 * lane); }
        if (samp) { const int i = m - MP; const float* z0 = Z + (size_t)m * PIN; const float* lng = a->in[I_ALNG] + L * WA; const float* lnb = a->in[I_ALNB] + L * WA;
            for (int g = 0; g < 4; ++g) {
                const float u0 = gelu_erf(z0[g * 128 + lane]), u1 = gelu_erf(z0[g * 128 + 64 + lane]);
                const float v0 = gelu_erf(z0[WA + g * 128 + lane]), v1 = gelu_erf(z0[WA + g * 128 + 64 + lane]);
                const float mean = wave_sum(v0 + v1) * (1.f / 128.f); const float d0 = v0 - mean, d1 = v1 - mean;
                const float rstd = 1.0f / sqrtf(wave_sum(d0 * d0 + d1 * d1) * (1.f / 128.f) + LN_EPS);
                const float n0 = d0 * rstd * lng[g * 128 + lane] + lnb[g * 128 + lane], n1 = d1 * rstd * lng[g * 128 + 64 + lane] + lnb[g * 128 + 64 + lane];
                float* ov = a->out + O_VS + ((size_t)L * NS + i) * WA + g * 128; ov[lane] = n0; ov[64 + lane] = n1;
                const float w00 = a->in[I_AWS][(size_t)(L * 4 + g) * 16384], b0 = a->in[I_ABS][(L * 4 + g) * 128];
                bf16* yo = (bf16*)(ws + WS_YMIX) + (size_t)m * DM + g * 128; yo[lane] = bf1(u0 * (w00 * n0 + b0)); yo[64 + lane] = bf1(u1 * (w00 * n1 + b0)); } }
    }
}
__device__ __forceinline__ void phase_fin(ArgsP a, int L, int lane, int wave, int blk, int G) {
    unsigned char* ws = a->ws; const int gw = blk * NWAVES + wave, NGW = G * NWAVES;
    const float* Z = (const float*)(ws + WS_Z); const float* LO = (const float*)(ws + WS_LORA);
    const float* mu = a->in[I_BMU] + L * PBW; const float* w0 = a->in[I_BW0] + L * WB; const float* a0 = a->in[I_BA0] + L * WB;
    const float* k_k = a->in[I_BKK] + L * WB; const float* k_a = a->in[I_BKA] + L * WB; const float* sh0 = a->in[I_SSHIFT] + (size_t)L * NS * PBW;
    for (int m = gw; m < MV; m += NGW) {
        const bool samp = m >= MP; const float* zr = Z + (size_t)m * PIN + OFF_B; const float* lo = LO + (size_t)m * NLORA;
        const float* pz = samp ? sh0 + (size_t)(m - MP) * PBW : zr - PIN; const bool first = !samp && (m & (SEQ - 1)) == 0;
#pragma unroll 4
        for (int j = 0; j < 12; ++j) { const int c = 64 * j + lane;
            const float cr = zr[c], ck = zr[WB + c], cv = zr[2 * WB + c];
            float pr = 0.f, pk = 0.f, pv = 0.f; if (!first) { pr = pz[c]; pk = pz[WB + c]; pv = pz[2 * WB + c]; }
            const float r = cr + mu[c] * (pr - cr), k = ck + mu[WB + c] * (pk - ck), v = cv + mu[2 * WB + c] * (pv - cv);
            const float dec = __expf(-0.6065306597126334f * sigmoidf_(w0[c] + lo[c]));
            const float av = sigmoidf_(a0[c] + lo[WB + c]);
            const float kkr = k * k_k[c]; const float ss = wave_sum(kkr * kkr); const float kk = kkr / fmaxf(sqrtf(ss), 1e-12f);
            const float kp = k * (1.0f + (av - 1.0f) * k_a[c]);
            float* rec = samp ? (float*)(ws + WS_RPS) + ((size_t)(m - MP) * 12 + j) * 384 : (float*)(ws + WS_RPB) + (((size_t)(m >> 11) * 12 + j) * SEQ + (m & (SEQ - 1))) * 384;
            rec[lane] = r; rec[64 + lane] = dec; rec[128 + lane] = kp; rec[192 + lane] = v; rec[256 + lane] = kk; rec[320 + lane] = kk * av; }
    }
}

__device__ __forceinline__ void rwkv_scan_unit(ArgsP a, int L, int unit, LAS unsigned char* lds, int tid, int lane, int wave) {
    unsigned char* ws = a->ws;
    const int bh = unit >> 1, half = unit & 1, b = bh / 12, h = bh - b * 12;
    const f4* rec4 = (const f4*)((const float*)(ws + WS_RPB) + (size_t)bh * SEQ * 384);
    LAS float* buf = (LAS float*)lds;
    LAS float* ybuf = (LAS float*)(lds + 49152);
    const int rowl = wave * 4 + (lane >> 4), kg = lane & 15, row = half * 32 + rowl;
    float S0 = 0.f, S1 = 0.f, S2 = 0.f, S3 = 0.f;
    f4 st0, st1, st2;
    __syncthreads();
    st0 = rec4[tid]; st1 = rec4[512 + tid]; st2 = rec4[1024 + tid];
    *(LAS f4*)(buf + 4 * tid) = st0; *(LAS f4*)(buf + 4 * (512 + tid)) = st1; *(LAS f4*)(buf + 4 * (1024 + tid)) = st2;
    __syncthreads();
    float* Y = (float*)(ws + WS_Y);
    for (int c = 0; c < SEQ / 16; ++c) {
        if (c + 1 < SEQ / 16) { const f4* nx = rec4 + (size_t)(c + 1) * 1536; st0 = nx[tid]; st1 = nx[512 + tid]; st2 = nx[1024 + tid]; }
        const LAS float* cur = buf + (c & 1) * 6144; LAS float* yb = ybuf + (c & 1) * 512;
        f4 r4 = *(const LAS f4*)(cur + 4 * kg), w4 = *(const LAS f4*)(cur + 64 + 4 * kg), k4 = *(const LAS f4*)(cur + 128 + 4 * kg),
           kk4 = *(const LAS f4*)(cur + 256 + 4 * kg), ka4 = *(const LAS f4*)(cur + 320 + 4 * kg); float v = cur[192 + row];
#pragma unroll
        for (int s = 0; s < 16; ++s) {
            const LAS float* R = cur + (s < 15 ? s + 1 : 15) * 384;
            const f4 nr4 = *(const LAS f4*)(R + 4 * kg), nw4 = *(const LAS f4*)(R + 64 + 4 * kg), nk4 = *(const LAS f4*)(R + 128 + 4 * kg),
                     nkk4 = *(const LAS f4*)(R + 256 + 4 * kg), nka4 = *(const LAS f4*)(R + 320 + 4 * kg);
            const float nv = R[192 + row];
            float sa = (S0 * kk4.x + S1 * kk4.y) + (S2 * kk4.z + S3 * kk4.w);
            sa = row16_sum(sa);
            S0 = S0 * w4.x + (v * k4.x - sa * ka4.x); S1 = S1 * w4.y + (v * k4.y - sa * ka4.y);
            S2 = S2 * w4.z + (v * k4.z - sa * ka4.z); S3 = S3 * w4.w + (v * k4.w - sa * ka4.w);
            float y = (S0 * r4.x + S1 * r4.y) + (S2 * r4.z + S3 * r4.w);
            y = row16_sum(y);
            if (kg == 0) yb[s * 32 + rowl] = y;
            r4 = nr4; w4 = nw4; k4 = nk4; kk4 = nkk4; ka4 = nka4; v = nv;
        }
        if (c + 1 < SEQ / 16) { LAS float* nb = buf + ((c + 1) & 1) * 6144;
            *(LAS f4*)(nb + 4 * tid) = st0; *(LAS f4*)(nb + 4 * (512 + tid)) = st1; *(LAS f4*)(nb + 4 * (1024 + tid)) = st2; }
        __syncthreads();
        { const int s = tid >> 5, rl = tid & 31; Y[((size_t)b * SEQ + c * 16 + s) * WB + h * 64 + half * 32 + rl] = yb[tid]; }
    }
    f4 so; so.x = S0; so.y = S1; so.z = S2; so.w = S3;
    *(f4*)(a->out + O_RP + ((((size_t)L * NBAT + b) * 12 + h) * 64 + row) * 64 + 4 * kg) = so;
    __syncthreads();
}
__device__ __forceinline__ void rwkv_sample_item(ArgsP a, int L, int item, LAS unsigned char* lds, int lane, int wave) {
    unsigned char* ws = a->ws;
    const int ih = item * 8 + wave, i = ih / 12, h = ih - i * 12;
    const float* rec = (const float*)(ws + WS_RPS) + (size_t)ih * 384;
    LAS float* sc = (LAS float*)(lds + wave * 2048);
    const float r = rec[lane], w = rec[64 + lane], k = rec[128 + lane], v = rec[192 + lane], kk = rec[256 + lane], ka = rec[320 + lane];
    sc[lane] = r; sc[64 + lane] = w; sc[128 + lane] = k; sc[192 + lane] = kk; sc[256 + lane] = ka;
    LDS_WAIT(); asm volatile("" ::: "memory");
    const f4* S0p = (const f4*)(a->in[I_SRWKV] + (((size_t)L * NS + i) * 12 + h) * 4096 + lane * 64);
    f4 S[16];
#pragma unroll
    for (int j = 0; j < 16; ++j) S[j] = S0p[j];
    float sa = 0.f;
#pragma unroll
    for (int j = 0; j < 16; ++j) { const f4 q = *(const LAS f4*)(sc + 192 + 4 * j); sa += (S[j].x * q.x + S[j].y * q.y) + (S[j].z * q.z + S[j].w * q.w); }
    float y = 0.f;
    f4* So = (f4*)(a->out + O_RS + (((size_t)L * NS + i) * 12 + h) * 4096 + lane * 64);
#pragma unroll
    for (int j = 0; j < 16; ++j) { const f4 w4 = *(const LAS f4*)(sc + 64 + 4 * j), k4 = *(const LAS f4*)(sc + 128 + 4 * j), a4 = *(const LAS f4*)(sc + 256 + 4 * j), r4 = *(const LAS f4*)(sc + 4 * j);
        f4 n = S[j] * w4 + (k4 * v - a4 * sa); So[j] = n; y += (n.x * r4.x + n.y * r4.y) + (n.z * r4.z + n.w * r4.w); }
    ((float*)(ws + WS_Y))[(size_t)(MP + i) * WB + h * 64 + lane] = y;
    LDS_WAIT(); asm volatile("" ::: "memory");
}
__device__ __forceinline__ void hgrn_sample_item(ArgsP a, int L, int item, LAS unsigned char* lds, int lane, int wave) {
    unsigned char* ws = a->ws;
    const int ih = item * 4 + (wave >> 1), i = ih / 6, h = ih - i * 6, vcol = (wave & 1) * 64 + lane, m = MP + i;
    const float* zc = (const float*)(ws + WS_Z) + (size_t)m * PIN + OFF_C + h * 128;
    LAS float* sc = (LAS float*)(lds + wave * 2048);
#pragma unroll
    for (int t = 0; t < 2; ++t) { const int k = lane + 64 * t; const float lb = lbound(a->in[I_CLB], L, h * 128 + k); const float fz = zc[WC + k];
        const float sg = sigmoidf_(fz); sc[k] = lb + (1.0f - lb) * sg; sc[128 + k] = (1.0f - lb) * (1.0f - sg) ; sc[256 + k] = zc[k]; }
    const float iv = zc[2 * WC + vcol];
    LDS_WAIT(); asm volatile("" ::: "memory");
    const float* S0 = a->in[I_SHGRN] + (((size_t)L * NS + i) * 6 + h) * 16384 + vcol;
    float* So = a->out + O_HS + (((size_t)L * NS + i) * 6 + h) * 16384 + vcol;
    float o = 0.f;
#pragma unroll 8
    for (int k = 0; k < 128; ++k) { const float n = sc[k] * S0[(size_t)k * 128] + sc[128 + k] * iv; So[(size_t)k * 128] = n; o += n * sc[256 + k]; }
    ((float*)(ws + WS_O))[(size_t)m * WC + h * 128 + vcol] = o;
    LDS_WAIT(); asm volatile("" ::: "memory");
}
__device__ __forceinline__ void sgu_item(ArgsP a, int L, int item, LAS unsigned char* lds, int tid, int lane, int wave) {
    unsigned char* ws = a->ws;
    const int g = item & 3, bc = item >> 2, m0 = bc * 128;
    const float* Z = (const float*)(ws + WS_Z);
    LAS float* vn = (LAS float*)lds;
    LAS float* wt = (LAS float*)(lds + 65536);
    const float* wsrc = a->in[I_AWS] + (size_t)(L * 4 + g) * 16384;
    __syncthreads();
    for (int e = tid; e < 16384; e += NTHR) { const int t = e >> 7, s = e & 127; wt[s * 128 + t] = (s <= t) ? wsrc[e] : 0.f; }
    const float* lng = a->in[I_ALNG] + L * WA + g * 128; const float* lnb = a->in[I_ALNB] + L * WA + g * 128;
    for (int rr = 0; rr < 16; ++rr) { const int t = wave * 16 + rr; const float* zr = Z + (size_t)(m0 + t) * PIN + WA + g * 128;
        const float v0 = gelu_erf(zr[lane]), v1 = gelu_erf(zr[64 + lane]);
        const float mean = wave_sum(v0 + v1) * (1.f / 128.f); const float d0 = v0 - mean, d1 = v1 - mean;
        const float rstd = 1.0f / sqrtf(wave_sum(d0 * d0 + d1 * d1) * (1.f / 128.f) + LN_EPS);
        vn[t * 128 + lane] = d0 * rstd * lng[lane] + lnb[lane]; vn[t * 128 + 64 + lane] = d1 * rstd * lng[64 + lane] + lnb[64 + lane]; }
    __syncthreads();
    const int t = tid >> 2, dq = tid & 3, send = (wave * 16 + 15);
    f4 acc[8];
#pragma unroll
    for (int j = 0; j < 8; ++j) acc[j] = (f4){0.f, 0.f, 0.f, 0.f};
    for (int s = 0; s <= send; ++s) { const float w = wt[s * 128 + t]; const LAS f4* vr = (const LAS f4*)(vn + s * 128 + dq * 32);
#pragma unroll
        for (int j = 0; j < 8; ++j) acc[j] += vr[j] * w; }
    const float bs = a->in[I_ABS][(L * 4 + g) * 128 + t];
    const float* ur = Z + (size_t)(m0 + t) * PIN + g * 128 + dq * 32;
    bf16* yo = (bf16*)(ws + WS_YMIX) + (size_t)(m0 + t) * DM + g * 128 + dq * 32;
#pragma unroll
    for (int j = 0; j < 4; ++j) { const f4 u0 = *(const f4*)(ur + 8 * j), u1 = *(const f4*)(ur + 8 * j + 4); const f4 x0 = acc[2 * j] + bs, x1 = acc[2 * j + 1] + bs; v4u o;
        o.x = pg8::cvt_pk_bf16(gelu_erf(u0.x) * x0.x, gelu_erf(u0.y) * x0.y); o.y = pg8::cvt_pk_bf16(gelu_erf(u0.z) * x0.z, gelu_erf(u0.w) * x0.w);
        o.z = pg8::cvt_pk_bf16(gelu_erf(u1.x) * x1.x, gelu_erf(u1.y) * x1.y); o.w = pg8::cvt_pk_bf16(gelu_erf(u1.z) * x1.z, gelu_erf(u1.w) * x1.w);
        *(v4u*)(yo + 8 * j) = o; }
}

__device__ __forceinline__ void hgrn_seq_unit(ArgsP a, int L, int unit, LAS unsigned char* lds, int tid, int lane, int wave) {
    unsigned char* ws = a->ws;
    const int b = unit / 6, h = unit - b * 6;
    const float* Z = (const float*)(ws + WS_Z);
    LAS bf16* qs = (LAS bf16*)(lds);
    LAS bf16* ks = (LAS bf16*)(lds + 4352);
    LAS bf16* vt = (LAS bf16*)(lds + 8704);
    LAS bf16* kht = (LAS bf16*)(lds + 12800);
    LAS float* ev = (LAS float*)(lds + 16896);
    LAS float* part = (LAS float*)(lds + 17408);
    const int ch = tid & 127, tq = tid >> 7;
    const float lb = lbound(a->in[I_CLB], L, h * 128 + ch), oml = 1.0f - lb;
    const int pch = (ch & ~31) | (((ch >> 2) & 3) << 3) | (((ch >> 4) & 1) << 2) | (ch & 3);
    const int x = lane & 15, quad = lane >> 4;
    pg8::f32x4 Sacc[8];
#pragma unroll
    for (int mt = 0; mt < 8; ++mt) Sacc[mt] = (pg8::f32x4){0.f, 0.f, 0.f, 0.f};
    const float* zb = Z + (size_t)(b * SEQ + 4 * tq) * PIN + OFF_C + h * 128 + ch;
    float qn[4], fn[4], vn_[4];
#pragma unroll
    for (int j = 0; j < 4; ++j) { const float* p = zb + (size_t)j * PIN; qn[j] = p[0]; fn[j] = p[WC]; vn_[j] = p[2 * WC]; }
    float* O = (float*)(ws + WS_O);
    __syncthreads();
    for (int st = 0; st < SEQ / 16; ++st) {
        float q[4], fz[4], iv[4];
#pragma unroll
        for (int j = 0; j < 4; ++j) { q[j] = qn[j]; fz[j] = fn[j]; iv[j] = vn_[j]; }
        if (st + 1 < SEQ / 16) {
#pragma unroll
            for (int j = 0; j < 4; ++j) { const float* p = zb + (size_t)((st + 1) * 16 + j) * PIN; qn[j] = p[0]; fn[j] = p[WC]; vn_[j] = p[2 * WC]; } }
        float bl[4], kv[4]; float run = 0.f;
#pragma unroll
        for (int j = 0; j < 4; ++j) { const float e = __expf(-fmaxf(fz[j], -80.f)), sg = __builtin_amdgcn_rcpf(1.0f + e);
            run += __logf(lb + oml * sg); bl[j] = run; kv[j] = oml * e * sg; }
        part[tq * 128 + ch] = run;
        __syncthreads();
        const float p0 = part[ch], p1 = part[128 + ch], p2 = part[256 + ch], p3 = part[384 + ch];
        const float tot = (p0 + p1) + (p2 + p3); const float pre = (tq > 0 ? p0 : 0.f) + (tq > 1 ? p1 : 0.f) + (tq > 2 ? p2 : 0.f);
        float kh[4];
#pragma unroll
        for (int j = 0; j < 4; ++j) { const float bj = pre + bl[j]; const int t = 4 * tq + j;
            qs[t * 136 + pch] = bf1(q[j] * __expf(bj)); ks[t * 136 + pch] = bf1(kv[j] * __expf(fminf(-bj, 60.f))); kh[j] = kv[j] * __expf(tot - bj); }
        { u2 w; w.x = pg8::cvt_pk_bf16(kh[0], kh[1]); w.y = pg8::cvt_pk_bf16(kh[2], kh[3]); *(LAS u2*)(kht + ch * 16 + 4 * tq) = w;
          w.x = pg8::cvt_pk_bf16(iv[0], iv[1]); w.y = pg8::cvt_pk_bf16(iv[2], iv[3]); *(LAS u2*)(vt + ch * 16 + 4 * tq) = w; }
        if (tq == 0) ev[ch] = __expf(tot);
        __syncthreads();
        bf16x8 qf[4], kf[4];
#pragma unroll
        for (int kt = 0; kt < 4; ++kt) { qf[kt] = *(const LAS bf16x8*)(qs + x * 136 + 32 * kt + 8 * quad); kf[kt] = *(const LAS bf16x8*)(ks + x * 136 + 32 * kt + 8 * quad); }
        pg8::f32x4 att = (pg8::f32x4){0.f, 0.f, 0.f, 0.f};
#pragma unroll
        for (int kt = 0; kt < 4; ++kt) att = __builtin_amdgcn_mfma_f32_16x16x32_bf16(kf[kt], qf[kt], att, 0, 0, 0);
#pragma unroll
        for (int i = 0; i < 4; ++i) if (4 * quad + i > x) att[i] = 0.f;
        v4u pbu; pbu.x = pg8::cvt_pk_bf16(att[0], att[1]); pbu.y = pg8::cvt_pk_bf16(att[2], att[3]); pbu.z = 0u; pbu.w = 0u;
        const bf16x8 pb = __builtin_bit_cast(bf16x8, pbu);
        const u2 vv = *(const LAS u2*)(vt + (16 * wave + x) * 16 + 4 * quad);
        v4u vfu; vfu.x = vv.x; vfu.y = vv.y; vfu.z = 0u; vfu.w = 0u; const bf16x8 vf = __builtin_bit_cast(bf16x8, vfu);
        pg8::f32x4 o = (pg8::f32x4){0.f, 0.f, 0.f, 0.f};
#pragma unroll
        for (int kt = 0; kt < 4; ++kt) { v4u su; su.x = pg8::cvt_pk_bf16(Sacc[2 * kt][0], Sacc[2 * kt][1]); su.y = pg8::cvt_pk_bf16(Sacc[2 * kt][2], Sacc[2 * kt][3]);
            su.z = pg8::cvt_pk_bf16(Sacc[2 * kt + 1][0], Sacc[2 * kt + 1][1]); su.w = pg8::cvt_pk_bf16(Sacc[2 * kt + 1][2], Sacc[2 * kt + 1][3]);
            o = __builtin_amdgcn_mfma_f32_16x16x32_bf16(__builtin_bit_cast(bf16x8, su), qf[kt], o, 0, 0, 0); }
        o = __builtin_amdgcn_mfma_f32_16x16x32_bf16(vf, pb, o, 0, 0, 0);
        *(pg8::f32x4*)(O + (size_t)(b * SEQ + st * 16 + x) * WC + h * 128 + 16 * wave + 4 * quad) = o;
#pragma unroll
        for (int mt = 0; mt < 8; ++mt) { const pg8::f32x4 e4 = *(const LAS pg8::f32x4*)(ev + 16 * mt + 4 * quad);
            const u2 kk2 = *(const LAS u2*)(kht + (16 * mt + x) * 16 + 4 * quad); v4u ku; ku.x = kk2.x; ku.y = kk2.y; ku.z = 0u; ku.w = 0u;
            Sacc[mt] = __builtin_amdgcn_mfma_f32_16x16x32_bf16(__builtin_bit_cast(bf16x8, ku), vf, Sacc[mt] * e4, 0, 0, 0); }
    }
    float* So = a->out + O_HP + (((size_t)L * NBAT + b) * 6 + h) * 16384;
#pragma unroll
    for (int mt = 0; mt < 8; ++mt)
#pragma unroll
        for (int i = 0; i < 4; ++i) So[(size_t)(16 * mt + 4 * quad + i) * 128 + 16 * wave + x] = Sacc[mt][i];
    __syncthreads();
}

__device__ __forceinline__ void phase_post(ArgsP a, int L, int lane, int wave, int blk, int G) {
    unsigned char* ws = a->ws; const int gw = blk * NWAVES + wave, NGW = G * NWAVES;
    const float* Y = (const float*)(ws + WS_Y); const float* O = (const float*)(ws + WS_O); const float* Gt = (const float*)(ws + WS_LORA) + 2 * WB; const float* Z = (const float*)(ws + WS_Z);
    const float* gng = a->in[I_BGNG] + L * WB; const float* gnb = a->in[I_BGNB] + L * WB; const float* rk = a->in[I_BRK] + L * WB; const float* cng = a->in[I_CNG] + L * WC;
    for (int m = gw; m < MV; m += NGW) {
        bf16* yo = (bf16*)(ws + WS_YMIX) + (size_t)m * DM;
        float yv[12], rr[12], kp[12], vv[12], gg[12], ov[12], gz[12];
#pragma unroll
        for (int j = 0; j < 12; ++j) { const int c = 64 * j + lane;
            const float* rec = (m < MP) ? (const float*)(ws + WS_RPB) + (((size_t)(m >> 11) * 12 + j) * SEQ + (m & (SEQ - 1))) * 384 : (const float*)(ws + WS_RPS) + ((size_t)(m - MP) * 12 + j) * 384;
            yv[j] = Y[(size_t)m * WB + c]; rr[j] = rec[lane]; kp[j] = rec[128 + lane]; vv[j] = rec[192 + lane]; gg[j] = Gt[(size_t)m * NLORA + c];
            ov[j] = O[(size_t)m * WC + c]; gz[j] = Z[(size_t)m * PIN + OFF_C + 3 * WC + c]; }
        float ss = 0.f;
#pragma unroll
        for (int j = 0; j < 12; ++j) { const int c = 64 * j + lane; const float y = yv[j];
            const float mean = wave_sum(y) * (1.f / 64.f); const float d = y - mean; const float rstd = 1.0f / sqrtf(wave_sum(d * d) * (1.f / 64.f) + GN_EPS);
            const float bonus = wave_sum(rr[j] * kp[j] * rk[c]);
            yo[WA + c] = bf1((d * rstd * gng[c] + gnb[c] + bonus * vv[j]) * gg[j]); ss += ov[j] * ov[j]; }
        const float rms = 1.0f / sqrtf(wave_sum(ss) * (1.f / WC) + RMS_EPS);
#pragma unroll
        for (int j = 0; j < 12; ++j) { const int c = 64 * j + lane; yo[WA + WB + c] = bf1(ov[j] * rms * cng[c] * (gz[j] * sigmoidf_(gz[j]))); }
    }
}

enum { SE_STORE = 0, SE_RESID = 1, SE_SWIGLU = 2, SE_SIGMUL = 3 };
struct SEpi { int mode; float* out; const float* base; const float* add; int ld; float alpha; };
__device__ __forceinline__ void strip_task(const bf16* A, const bf16* Bt, int K, int r0, int r1, int c0, const SEpi& E, LAS unsigned char* lds, int lane, int wave) {
    const int x = lane & 15, quad = lane >> 4;
    const int nks = K >> 8;
    const bf16* Ap = A + (size_t)x * K + wave * (nks * 32) + 8 * quad;
    const bf16* B0 = Bt + (size_t)(r0 + x) * K + wave * (nks * 32) + 8 * quad;
    const bf16* B1 = Bt + (size_t)(r1 + x) * K + wave * (nks * 32) + 8 * quad;
    pg8::f32x4 acc[8][2];
#pragma unroll
    for (int mt = 0; mt < 8; ++mt) { acc[mt][0] = (pg8::f32x4){0.f, 0.f, 0.f, 0.f}; acc[mt][1] = (pg8::f32x4){0.f, 0.f, 0.f, 0.f}; }
    for (int s = 0; s < nks; ++s) {
        bf16x8 af[8]; const bf16x8 b0 = *(const bf16x8*)(B0 + 32 * s), b1 = *(const bf16x8*)(B1 + 32 * s);
#pragma unroll
        for (int mt = 0; mt < 8; ++mt) af[mt] = *(const bf16x8*)(Ap + (size_t)(16 * mt) * K + 32 * s);
#pragma unroll
        for (int mt = 0; mt < 8; ++mt) { acc[mt][0] = __builtin_amdgcn_mfma_f32_16x16x32_bf16(af[mt], b0, acc[mt][0], 0, 0, 0); acc[mt][1] = __builtin_amdgcn_mfma_f32_16x16x32_bf16(af[mt], b1, acc[mt][1], 0, 0, 0); }
    }
    __syncthreads();
    LAS pg8::f32x4* red = (LAS pg8::f32x4*)lds;
#pragma unroll
    for (int mt = 0; mt < 8; ++mt) { red[((wave * 8 + mt) * 2 + 0) * 64 + lane] = acc[mt][0]; red[((wave * 8 + mt) * 2 + 1) * 64 + lane] = acc[mt][1]; }
    __syncthreads();
    pg8::f32x4 s0 = (pg8::f32x4){0.f, 0.f, 0.f, 0.f}, s1 = s0;
#pragma unroll
    for (int w2 = 0; w2 < 8; ++w2) { s0 += red[((w2 * 8 + wave) * 2 + 0) * 64 + lane]; s1 += red[((w2 * 8 + wave) * 2 + 1) * 64 + lane]; }
#pragma unroll
    for (int i = 0; i < 4; ++i) { const size_t ro = (size_t)(16 * wave + 4 * quad + i) * E.ld;
        if (E.mode == SE_SWIGLU) { const float g = s0[i]; ((bf16*)E.out)[ro + c0 + x] = bf1(g * __builtin_amdgcn_rcpf(1.0f + __expf(-g)) * s1[i]); }
        else {
#pragma unroll
            for (int t = 0; t < 2; ++t) { const size_t o = ro + c0 + 16 * t + x; const float v = t ? s1[i] : s0[i]; float r;
                if (E.mode == SE_STORE) r = v;
                else if (E.mode == SE_RESID) { r = E.alpha * E.base[o] + v; if (E.add) r += E.add[o]; }
                else r = E.base[o] * __builtin_amdgcn_rcpf(1.0f + __expf(-v));
                E.out[o] = r; } }
    }
}
__device__ __forceinline__ void strip_gemm(const bf16* A, const bf16* Bt, int K, int N, const SEpi& E, LAS unsigned char* lds, int lane, int wave, int blk, int G) {
    const int per = (E.mode == SE_SWIGLU) ? 16 : 32, ntask = N / per;
    for (int t = G - 1 - blk; t < ntask; t += G) { const int c0 = t * per;
        if (E.mode == SE_SWIGLU) { const int rb = ((c0 >> 7) << 8) + (c0 & 127); strip_task(A, Bt, K, rb, rb + 128, c0, E, lds, lane, wave); }
        else strip_task(A, Bt, K, c0, c0 + 16, c0, E, lds, lane, wave); }
    __syncthreads();
}

#ifndef EN_PRO
#define EN_PRO 1
#endif
#ifndef EN_G1
#define EN_G1 1
#endif
#ifndef EN_PREP
#define EN_PREP 1
#endif
#ifndef EN_MIX
#define EN_MIX 1
#endif
#ifndef EN_POST
#define EN_POST 1
#endif
#ifndef EN_G3
#define EN_G3 1
#endif
#ifndef EN_LN
#define EN_LN 1
#endif
#ifndef EN_G4
#define EN_G4 1
#endif
#ifndef EN_G5
#define EN_G5 1
#endif
#ifndef REP_PHASE
#define REP_PHASE -1
#endif
#define NREP(k) ((REP_PHASE) == (k) ? 2 : 1)
#ifndef MK_SINGLE
#define MK_SINGLE 1
#endif
constexpr int PPL = 11, N_PHASES = 1 + PPL * DEPTH;
constexpr int SCAN_UNITS = NBAT * 12 * 2, HSEQ_UNITS = NBAT * 6, ROLE_BLOCKS = SCAN_UNITS + HSEQ_UNITS;
constexpr int N_SGU = NBAT * 16 * 4, N_RS = NS * 12 / 8, N_HS = NS * 6 / 4, N_MISC = N_SGU + N_RS + N_HS;

__global__ void __launch_bounds__(NTHR, 2) mk_fwd(Args a) {
    extern __shared__ __attribute__((aligned(16))) unsigned char lds_raw[];
    LAS unsigned char* lds = (LAS unsigned char*)lds_raw;
    const int tid = threadIdx.x, blk = blockIdx.x, G = gridDim.x; const int wave0 = __builtin_amdgcn_readfirstlane(tid >> 6);
    ArgsP ap0 = (ArgsP)__builtin_amdgcn_kernarg_segment_ptr();
    volatile LAS unsigned* MISC = (volatile LAS unsigned*)(lds + MISC_OFF);
    for (int u = tid; u < (LDS_BYTES - LDSCTL_OFF) / 4; u += NTHR) ((LAS unsigned*)(lds + LDSCTL_OFF))[u] = 0u;
    __syncthreads();
    const int lo = ap0->ph_lo, hi = ap0->ph_hi;
    XcdBarrier bar; bar.bar = (unsigned*)(ap0->ws + WS_CTL) + CW_BAR; bar.x = 0; bar.st = nullptr;
    if (hi - lo > 1) bar = xcd_barrier_post((unsigned*)(ap0->ws + WS_CTL) + CW_BAR, MISC + 8);
    bar.w0 = (wave0 == 0);
#define IN(k) (lo <= (k) && (k) < hi)
#define SEAM(k) do { if (IN(k) && IN((k) + 1)) { xcd_barrier(bar); } } while (0)
#define PHASE_BEGIN() ArgsP a = ap0; asm volatile("" : "+s"(a)); unsigned char* ws = a->ws; int tid_ = wave0 * 64 + mk_lane_id(); asm volatile("" : "+v"(tid_)); \
    const int lane_ = tid_ & 63; const int wave_ = __builtin_amdgcn_readfirstlane(tid_ >> 6); const int lane_s = lane_, wave_s = wave_; \
    bf16* HB = (bf16*)(ws + WS_HB); float* H = (float*)(ws + WS_H); float* T = (float*)(ws + WS_T); (void)HB; (void)H; (void)T; (void)lane_s; (void)wave_s

    #if EN_PRO
    if (IN(0)) for (int rep = 0; rep < NREP(0); ++rep) { PHASE_BEGIN(); phase_prologue(a, lds, lane_, wave_, blk, G); __syncthreads(); }
#endif
    SEAM(0);
    for (int L = 0; L < DEPTH; ++L) {
        const int pb = 1 + PPL * L;
#if EN_G1
        if (IN(pb)) for (int rep = 0; rep < NREP(1); ++rep) {
            { PHASE_BEGIN(); pg8::Gemm g{HB, (const bf16*)(ws + WS_WIN + L * SZ_WIN), MP, PIN, DM}; pg8::StaticOrder S; S.init(MP, PIN, G, blk);
              pg8::EpiF32 E{(float*)(ws + WS_Z), PIN}; pg8::gemm_phase<pg8::EpiF32, pg8::StaticOrder, true, true>(lds, g, S, E, wave0); }
              { PHASE_BEGIN(); const SEpi SE{SE_STORE, (float*)(ws + WS_Z) + (size_t)MP * PIN, nullptr, nullptr, PIN, 0.f}; strip_gemm(HB + (size_t)MP * DM, (const bf16*)(ws + WS_WIN + L * SZ_WIN), DM, PIN, SE, lds, lane_s, wave_s, blk, G); }
            { PHASE_BEGIN(); pg8::Gemm g{(const bf16*)(ws + WS_PBF + L * SZ_PBF), (const bf16*)(ws + WS_WPP + L * SZ_WPP), MP, DM, DPLE}; pg8::StaticOrder S; S.init(MP, DM, G, G - 1 - blk);
              pg8::EpiF32 E{(float*)(ws + WS_PPO), DM}; pg8::gemm_phase<pg8::EpiF32, pg8::StaticOrder, true, true>(lds, g, S, E, wave0); }
              { PHASE_BEGIN(); const SEpi SE{SE_STORE, (float*)(ws + WS_PPO) + (size_t)MP * DM, nullptr, nullptr, DM, 0.f}; strip_gemm((const bf16*)(ws + WS_PBF + L * SZ_PBF) + (size_t)MP * DPLE, (const bf16*)(ws + WS_WPP + L * SZ_WPP), DPLE, DM, SE, lds, lane_s, wave_s, blk, G); }
        }
#endif
        SEAM(pb);
#if EN_PREP
        if (IN(pb + 1)) for (int rep = 0; rep < NREP(2); ++rep) { PHASE_BEGIN(); phase_xc(a, L, lane_, wave_, blk, G); }
        SEAM(pb + 1);
        if (IN(pb + 2)) for (int rep = 0; rep < NREP(9); ++rep) {
            { PHASE_BEGIN(); pg8::Gemm g{(const bf16*)(ws + WS_XCAT), (const bf16*)(ws + WS_WL + L * SZ_WL), MP, NLORA, 256}; pg8::StaticOrder S; S.init(MP, NLORA, G, blk);
            pg8::EpiF32 E{(float*)(ws + WS_LORA), NLORA}; pg8::gemm_phase<pg8::EpiF32, pg8::StaticOrder, true, true>(lds, g, S, E, wave0); }
            { PHASE_BEGIN(); const SEpi SE{SE_STORE, (float*)(ws + WS_LORA) + (size_t)MP * NLORA, nullptr, nullptr, NLORA, 0.f}; strip_gemm((const bf16*)(ws + WS_XCAT) + (size_t)MP * 256, (const bf16*)(ws + WS_WL + L * SZ_WL), 256, NLORA, SE, lds, lane_s, wave_s, blk, G); }
        }
        SEAM(pb + 2);
        if (IN(pb + 3)) for (int rep = 0; rep < NREP(10); ++rep) { PHASE_BEGIN(); phase_fin(a, L, lane_, wave_, blk, G); }
#endif
        SEAM(pb + 3);
#if EN_MIX
        if (IN(pb + 4)) for (int rep = 0; rep < NREP(3); ++rep) { PHASE_BEGIN();
            const int tid = tid_, lane = lane_, wave = wave_;
            if (blk < SCAN_UNITS) { for (int r2 = 0; r2 < NREP(31); ++r2) rwkv_scan_unit(a, L, blk, lds, tid, lane, wave); }
            else if (blk < ROLE_BLOCKS) { for (int r2 = 0; r2 < NREP(32); ++r2) hgrn_seq_unit(a, L, blk - SCAN_UNITS, lds, tid, lane, wave); }
            else for (int r2 = 0; r2 < NREP(33); ++r2) for (int it = blk - ROLE_BLOCKS; it < N_MISC; it += G - ROLE_BLOCKS) {
                if (it < N_SGU) sgu_item(a, L, it, lds, tid, lane, wave);
                else if (it < N_SGU + N_RS) rwkv_sample_item(a, L, it - N_SGU, lds, lane, wave);
                else hgrn_sample_item(a, L, it - N_SGU - N_RS, lds, lane, wave);
                __syncthreads();
            }
        }
#endif
        SEAM(pb + 4);
#if EN_POST
        if (IN(pb + 5)) for (int rep = 0; rep < NREP(4); ++rep) { PHASE_BEGIN(); phase_post(a, L, lane_, wave_, blk, G); }
#endif
        SEAM(pb + 5);
#if EN_G3
        if (IN(pb + 6)) for (int rep = 0; rep < NREP(5); ++rep) {
            { PHASE_BEGIN(); pg8::Gemm g{(const bf16*)(ws + WS_YMIX), (const bf16*)(ws + WS_WOUT + L * SZ_WOUT), MP, DM, DM}; pg8::StaticOrder S; S.init(MP, DM, G, blk);
            pg8::EpiResid E{T, H, nullptr, DM, DN_ALPHA}; pg8::gemm_phase<pg8::EpiResid, pg8::StaticOrder, true, true>(lds, g, S, E, wave0); }
            { PHASE_BEGIN(); const SEpi SE{SE_RESID, T + (size_t)MP * DM, H + (size_t)MP * DM, nullptr, DM, DN_ALPHA}; strip_gemm((const bf16*)(ws + WS_YMIX) + (size_t)MP * DM, (const bf16*)(ws + WS_WOUT + L * SZ_WOUT), DM, DM, SE, lds, lane_s, wave_s, blk, G); }
        }
#endif
        SEAM(pb + 6);
#if EN_LN
        if (IN(pb + 7)) for (int rep = 0; rep < NREP(6); ++rep) { PHASE_BEGIN(); phase_ln(a, a->in[I_LN1G] + L * DM, a->in[I_LN1B] + L * DM, false, lane_, wave_, blk, G); }
#endif
        SEAM(pb + 7);
#if EN_G4
        if (IN(pb + 8)) for (int rep = 0; rep < NREP(7); ++rep) {
            { PHASE_BEGIN(); pg8::Gemm g{HB, (const bf16*)(ws + WS_WGU + L * SZ_WGU), MP, 2 * DFF, DM}; pg8::StaticOrder S; S.init(MP, 2 * DFF, G, blk);
              pg8::EpiSwiglu E{(bf16*)(ws + WS_ACT), DFF}; pg8::gemm_phase<pg8::EpiSwiglu, pg8::StaticOrder, true, true>(lds, g, S, E, wave0); }
              { PHASE_BEGIN(); const SEpi SE{SE_SWIGLU, (float*)((bf16*)(ws + WS_ACT) + (size_t)MP * DFF), nullptr, nullptr, DFF, 0.f}; strip_gemm(HB + (size_t)MP * DM, (const bf16*)(ws + WS_WGU + L * SZ_WGU), DM, DFF, SE, lds, lane_s, wave_s, blk, G); }
            { PHASE_BEGIN(); pg8::Gemm g{HB, (const bf16*)(ws + WS_WPG + L * SZ_WPG), MP, DM, DM}; pg8::StaticOrder S; S.init(MP, DM, G, G - 1 - blk);
              pg8::EpiSigMul E{(float*)(ws + WS_PLE), (const float*)(ws + WS_PPO), DM}; pg8::gemm_phase<pg8::EpiSigMul, pg8::StaticOrder, true, true>(lds, g, S, E, wave0); }
              { PHASE_BEGIN(); const SEpi SE{SE_SIGMUL, (float*)(ws + WS_PLE) + (size_t)MP * DM, (const float*)(ws + WS_PPO) + (size_t)MP * DM, nullptr, DM, 0.f}; strip_gemm(HB + (size_t)MP * DM, (const bf16*)(ws + WS_WPG + L * SZ_WPG), DM, DM, SE, lds, lane_s, wave_s, blk, G); }
        }
#endif
        SEAM(pb + 8);
#if EN_G5
        if (IN(pb + 9)) for (int rep = 0; rep < NREP(8); ++rep) {
            { PHASE_BEGIN(); pg8::Gemm g{(const bf16*)(ws + WS_ACT), (const bf16*)(ws + WS_WD + L * SZ_WD), MP, DM, DFF}; pg8::StaticOrder S; S.init(MP, DM, G, blk);
            pg8::EpiResid E{T, H, (const float*)(ws + WS_PLE), DM, DN_ALPHA}; pg8::gemm_phase<pg8::EpiResid, pg8::StaticOrder, true, true>(lds, g, S, E, wave0); }
            { PHASE_BEGIN(); const SEpi SE{SE_RESID, T + (size_t)MP * DM, H + (size_t)MP * DM, (const float*)(ws + WS_PLE) + (size_t)MP * DM, DM, DN_ALPHA}; strip_gemm((const bf16*)(ws + WS_ACT) + (size_t)MP * DFF, (const bf16*)(ws + WS_WD + L * SZ_WD), DFF, DM, SE, lds, lane_s, wave_s, blk, G); }
        }
#endif
        SEAM(pb + 9);
#if EN_LN
        if (IN(pb + 10)) for (int rep = 0; rep < NREP(6); ++rep) { PHASE_BEGIN(); phase_ln(a, a->in[I_LN2G] + L * DM, a->in[I_LN2B] + L * DM, L == DEPTH - 1, lane_, wave_, blk, G); }
#endif
        SEAM(pb + 10);
    }
#undef IN
#undef SEAM
}

extern "C" void kernel_launch(void* const* d_in, const int* in_sizes, int n_in, void* d_out, int out_size, void* d_ws, size_t ws_size, hipStream_t stream) {
    static int grid = 0;
    if (grid == 0) {
        if (n_in != N_IN || (size_t)out_size != O_END || ws_size < WS_END) { fprintf(stderr, "kernel_launch: unexpected sizes n_in %d out %d ws %zu (need %zu)\n", n_in, out_size, ws_size, (size_t)WS_END); grid = -1; return; }
        int dev = 0, cus = 0, per_cu = 0;
        if (hipGetDevice(&dev) != hipSuccess || hipDeviceGetAttribute(&cus, hipDeviceAttributeMultiprocessorCount, dev) != hipSuccess) { grid = -1; return; }
        if (hipFuncSetAttribute((const void*)mk_fwd, hipFuncAttributeMaxDynamicSharedMemorySize, LDS_BYTES) != hipSuccess) { fprintf(stderr, "kernel_launch: hipFuncSetAttribute failed\n"); grid = -1; return; }
        if (hipOccupancyMaxActiveBlocksPerMultiprocessor(&per_cu, (const void*)mk_fwd, NTHR, LDS_BYTES) != hipSuccess || per_cu < 1) fprintf(stderr, "kernel_launch: occupancy query says %d\n", per_cu);
        (void)hipGetLastError();
        grid = cus;
        if (grid < ROLE_BLOCKS + 8) { fprintf(stderr, "kernel_launch: %d CUs is too few\n", grid); grid = -1; return; }
    }
    if (grid < 0) return;
    if (hipMemsetAsync((char*)d_ws + WS_CTL, 0, CTL_ZERO_BYTES, stream) != hipSuccess) return;
    Args a{};
    for (int i = 0; i < N_IN; ++i) a.in[i] = (const float*)d_in[i];
    a.out = (float*)d_out; a.ws = (unsigned char*)d_ws;
#if MK_SINGLE
    a.ph_lo = 0; a.ph_hi = N_PHASES;
    hipLaunchKernelGGL(mk_fwd, dim3(grid), dim3(NTHR), LDS_BYTES, stream, a);
#else
    for (int p = 0; p < N_PHASES; ++p) { a.ph_lo = p; a.ph_hi = p + 1; hipLaunchKernelGGL(mk_fwd, dim3(grid), dim3(NTHR), LDS_BYTES, stream, a); }
#endif
}
```

```cpp
#include <hip/hip_runtime.h>
#include <cstdio>
#include <cstdint>
typedef float mk_f32x2 __attribute__((ext_vector_type(2))); typedef __bf16 mk_bf16x2 __attribute__((ext_vector_type(2)));
__device__ __forceinline__ unsigned cvt_pk_bf16_c(float lo, float hi) { mk_f32x2 v = {lo, hi}; mk_bf16x2 b = __builtin_convertvector(v, mk_bf16x2); return __builtin_bit_cast(unsigned, b); }
__device__ __forceinline__ int mk_lane_id() { int l; asm volatile("v_mbcnt_lo_u32_b32 %0, -1, 0\n\tv_mbcnt_hi_u32_b32 %0, -1, %0" : "=v"(l)); return l; }
namespace pg8 {
#define PG8_LAS __attribute__((address_space(3)))
typedef unsigned short bf16_t;
typedef short bf16x8 __attribute__((ext_vector_type(8)));
typedef float f32x4 __attribute__((ext_vector_type(4)));
typedef unsigned u32x4 __attribute__((ext_vector_type(4)));
constexpr int BM = 256, BK = 64, HALF = 128, HTB = HALF * BK * 2  , STAGE_BYTES = 8 * HTB, NXCD = 8, WGM = 8;

__host__ __device__ __forceinline__ int lds_byte(int r, int c) { const int st = (r >> 4) * 2 + (c >> 5), rr = r & 15, cc = c & 31, ob = rr * 64 + cc * 2; return st * 1024 + (ob ^ (((ob >> 9) & 1) << 5)); }
__host__ __device__ __forceinline__ void stage_rc(int b, int& R, int& C) { const int st = b / 1024, sb = b % 1024, swz = sb ^ (((sb >> 9) & 1) << 5); R = (st >> 1) * 16 + swz / 64; C = (st & 1) * 32 + (swz % 64) / 2; }
__host__ __device__ __forceinline__ int perm32(int rho) { const int n = rho >> 4, i = rho & 15; return 8 * (i >> 2) + 4 * n + (i & 3); }

struct Unit { int pm, pn; };
struct Gemm { const bf16_t* A; const bf16_t* Bt; int M, N, K; };

struct StaticOrder {
    int nM, nN, nwg, G, c;
    __host__ __device__ void init(int M, int N, int G_, int c_) { nM = M / BM; nN = N / BM; nwg = nM * nN; G = G_; c = c_; }
    __host__ __device__ bool next(int i, Unit& u) const {
        const long L = (long)i * G + c; if (L >= nwg) return false;
        int wgid = (int)L; { const int q = nwg / NXCD, r = nwg % NXCD, xcd = wgid % NXCD, off = wgid / NXCD; wgid = (xcd < r ? xcd * (q + 1) : r * (q + 1) + (xcd - r) * q) + off; }
        const int nig = WGM * nN, gid = wgid / nig, fm = gid * WGM, gsz = (nM - fm) < WGM ? (nM - fm) : WGM;
        u.pm = fm + ((wgid % nig) % gsz); u.pn = (wgid % nig) / gsz; return true;
    }
    __device__ __forceinline__ void a_ready(const Unit&) const {}
    __device__ __forceinline__ void done(const Unit&) const {}
};

__device__ __forceinline__ unsigned cvt_pk_bf16(float lo, float hi) { unsigned r; asm volatile("v_cvt_pk_bf16_f32 %0, %1, %2" : "=v"(r) : "v"(lo), "v"(hi)); return r; }
typedef float f32x2 __attribute__((ext_vector_type(2)));
struct EpiF32 {
    static constexpr bool PERM = false, AFTER_DRAIN = false;
    float* C; int ldc;
    __device__ __forceinline__ void operator()(const f32x4 (&acc)[2][2][4][2], const Unit& u, int wr, int wc, int fr, int fq) const {
        const int row0 = u.pm * BM + wr * 64 + fr, col0 = u.pn * BM + wc * 32 + 4 * fq;
#pragma unroll
        for (int ai = 0; ai < 2; ++ai)
#pragma unroll
            for (int m = 0; m < 4; ++m) { float* rowp = C + (size_t)(row0 + ai * HALF + m * 16) * ldc + col0;
#pragma unroll
                for (int bj = 0; bj < 2; ++bj)
#pragma unroll
                    for (int n = 0; n < 2; ++n) *(f32x4*)(rowp + bj * HALF + n * 16) = acc[ai][bj][m][n]; }
    }
};
struct EpiResid {
    static constexpr bool PERM = false, AFTER_DRAIN = false;
    float* out; const float* base; const float* add; int ldc; float alpha;
    __device__ __forceinline__ void operator()(const f32x4 (&acc)[2][2][4][2], const Unit& u, int wr, int wc, int fr, int fq) const {
        const int row0 = u.pm * BM + wr * 64 + fr, col0 = u.pn * BM + wc * 32 + 4 * fq;
#pragma unroll
        for (int ai = 0; ai < 2; ++ai)
#pragma unroll
            for (int m = 0; m < 4; ++m) { const size_t off = (size_t)(row0 + ai * HALF + m * 16) * ldc + col0;
#pragma unroll
                for (int bj = 0; bj < 2; ++bj)
#pragma unroll
                    for (int n = 0; n < 2; ++n) { const size_t o2 = off + bj * HALF + n * 16; f32x4 v = *(const f32x4*)(base + o2) * alpha + acc[ai][bj][m][n];
                        if (add) v += *(const f32x4*)(add + o2); *(f32x4*)(out + o2) = v; } }
    }
};
struct EpiSigMul {
    static constexpr bool PERM = false, AFTER_DRAIN = false;
    float* out; const float* mul; int ldc;
    __device__ __forceinline__ void operator()(const f32x4 (&acc)[2][2][4][2], const Unit& u, int wr, int wc, int fr, int fq) const {
        const int row0 = u.pm * BM + wr * 64 + fr, col0 = u.pn * BM + wc * 32 + 4 * fq;
#pragma unroll
        for (int ai = 0; ai < 2; ++ai)
#pragma unroll
            for (int m = 0; m < 4; ++m) { const size_t off = (size_t)(row0 + ai * HALF + m * 16) * ldc + col0;
#pragma unroll
                for (int bj = 0; bj < 2; ++bj)
#pragma unroll
                    for (int n = 0; n < 2; ++n) { const size_t o2 = off + bj * HALF + n * 16; const f32x4 x = acc[ai][bj][m][n]; const f32x4 p = *(const f32x4*)(mul + o2); f32x4 v;
#pragma unroll
                        for (int e = 0; e < 4; ++e) v[e] = p[e] * __builtin_amdgcn_rcpf(1.0f + __expf(-x[e]));
                        *(f32x4*)(out + o2) = v; } }
    }
};
struct EpiSwiglu {
    static constexpr bool PERM = true, AFTER_DRAIN = false;
    bf16_t* O; int ldo;
    __device__ __forceinline__ void operator()(const f32x4 (&acc)[2][2][4][2], const Unit& u, int wr, int wc, int fr, int fq) const {
        const int row0 = u.pm * BM + wr * 64 + fr, col0 = u.pn * HALF + wc * 32 + 8 * fq;
#pragma unroll
        for (int ai = 0; ai < 2; ++ai)
#pragma unroll
            for (int m = 0; m < 4; ++m) { bf16_t* rowp = O + (size_t)(row0 + ai * HALF + m * 16) * ldo + col0; float r[8];
#pragma unroll
                for (int n = 0; n < 2; ++n)
#pragma unroll
                    for (int e = 0; e < 4; ++e) { const float g = acc[ai][0][m][n][e], up = acc[ai][1][m][n][e]; r[4 * n + e] = g * __builtin_amdgcn_rcpf(1.0f + __expf(-g)) * up; }
                u32x4 w; w.x = cvt_pk_bf16(r[0], r[1]); w.y = cvt_pk_bf16(r[2], r[3]); w.z = cvt_pk_bf16(r[4], r[5]); w.w = cvt_pk_bf16(r[6], r[7]);
                *(u32x4*)rowp = w; }
    }
};
template <class Epi, class Sched, bool ALIGN_EPI = false, bool SP2 = false>
__device__ __forceinline__ void gemm_phase(PG8_LAS unsigned char* lds, const Gemm g, const Sched& S, const Epi& E, int wid0) {
    int tid_l = wid0 * 64 + mk_lane_id(); asm volatile("" : "+v"(tid_l));
    const int tid = tid_l, wid = __builtin_amdgcn_readfirstlane(tid >> 6), lane = tid & 63, wr = wid >> 2, wc = wid & 3, fr = lane & 15, fq = lane >> 4;
    const int K = g.K, nt = K / BK;
    unsigned voffA[2], voffB[2];
#pragma unroll
    for (int i = 0; i < 2; ++i) { int R, C; stage_rc(tid * 16 + i * 8192, R, C); const int Rb = Epi::PERM ? ((R & ~31) + perm32(R & 31)) : R;
        voffA[i] = (unsigned)(R * K + C) * 2u; voffB[i] = (unsigned)(Rb * K + C) * 2u; }
    const size_t kstep = (size_t)(BK * 2);
    const size_t hstep = (size_t)HALF * K * 2;
    const size_t tstep = 2 * hstep;
    const unsigned ldsw = (unsigned)wid * 1024u;
    const int aoff = lds_byte(wr * 64 + fr, fq * 8), boff = lds_byte(wc * 32 + fr, fq * 8);
#define PG8_SA(b, h) (((b) * 2 + (h)) * HTB)
#define PG8_SB(b, h) ((4 + (b) * 2 + (h)) * HTB)
#define PG8_STAGE(bufoff, gbase, voff) do { _Pragma("unroll") for (int _i = 0; _i < 2; ++_i) \
        __builtin_amdgcn_global_load_lds((const unsigned*)((const char*)(gbase) + (voff)[_i]), (PG8_LAS unsigned*)(lds + (bufoff) + ldsw + _i * 8192), 16, 0, 0); } while (0)
#define PG8_LDA(dst, b, h) do { _Pragma("unroll") for (int m = 0; m < 4; ++m) _Pragma("unroll") for (int k = 0; k < 2; ++k) dst[m][k] = *(const PG8_LAS bf16x8*)(lds + PG8_SA(b, h) + aoff + m * 2048 + k * 1024); } while (0)
#define PG8_LDB(dst, b, h) do { _Pragma("unroll") for (int n = 0; n < 2; ++n) _Pragma("unroll") for (int k = 0; k < 2; ++k) dst[n][k] = *(const PG8_LAS bf16x8*)(lds + PG8_SB(b, h) + boff + n * 2048 + k * 1024); } while (0)
#define PG8_MMA(ai, bj, At, Bt) do { __builtin_amdgcn_s_setprio(1); _Pragma("unroll") for (int m = 0; m < 4; ++m) _Pragma("unroll") for (int n = 0; n < 2; ++n) _Pragma("unroll") for (int k = 0; k < 2; ++k) \
        acc[ai][bj][m][n] = __builtin_amdgcn_mfma_f32_16x16x32_bf16(Bt[n][k], At[m][k], acc[ai][bj][m][n], 0, 0, 0); __builtin_amdgcn_s_setprio(0); } while (0)
#define PG8_WAIT_V(n) asm volatile("s_waitcnt vmcnt(" #n ")" ::: "memory")
#define PG8_WAIT_L(n) asm volatile("s_waitcnt lgkmcnt(" #n ")" ::: "memory")
#define PG8_BAR __builtin_amdgcn_s_barrier()
#define PG8_SCHED __builtin_amdgcn_sched_barrier(0)
    Unit cur, nxt; int ui = 0;
    if (!S.next(0, cur)) return;
    f32x4 acc[2][2][4][2];
#pragma unroll
    for (int a = 0; a < 2; ++a)
#pragma unroll
        for (int b = 0; b < 2; ++b)
#pragma unroll
            for (int m = 0; m < 4; ++m)
#pragma unroll
                for (int n = 0; n < 2; ++n) acc[a][b][m][n] = (f32x4){0.f, 0.f, 0.f, 0.f};
    bf16x8 At[4][2], B0[2][2], B1[2][2];
    const char* cA = (const char*)g.A + (size_t)cur.pm * tstep; const char* cB = (const char*)g.Bt + (size_t)cur.pn * tstep;
    S.a_ready(cur);
    if constexpr (SP2) {
        PG8_STAGE(PG8_SB(0, 0), cB, voffB); PG8_STAGE(PG8_SB(0, 1), cB + hstep, voffB); PG8_STAGE(PG8_SA(0, 0), cA, voffA); PG8_STAGE(PG8_SA(0, 1), cA + hstep, voffA);
        if (wr == 1) PG8_BAR;
        PG8_WAIT_V(2); PG8_BAR;
        PG8_STAGE(PG8_SB(1, 0), cB + kstep, voffB); PG8_STAGE(PG8_SA(1, 0), cA + kstep, voffA); PG8_STAGE(PG8_SB(1, 1), cB + hstep + kstep, voffB);
        PG8_WAIT_V(6); PG8_BAR;
    } else {
        PG8_STAGE(PG8_SB(0, 0), cB, voffB); PG8_STAGE(PG8_SA(0, 0), cA, voffA); PG8_STAGE(PG8_SB(0, 1), cB + hstep, voffB); PG8_STAGE(PG8_SA(0, 1), cA + hstep, voffA);
        if (wr == 1) PG8_BAR;
        PG8_WAIT_V(4); PG8_BAR;
        PG8_STAGE(PG8_SB(1, 0), cB + kstep, voffB); PG8_STAGE(PG8_SA(1, 0), cA + kstep, voffA); PG8_STAGE(PG8_SB(1, 1), cB + hstep + kstep, voffB);
        PG8_WAIT_V(6); PG8_BAR;
    }
    for (;;) {
        const bool has_next = S.next(ui + 1, nxt);
        const char* nA = has_next ? (const char*)g.A + (size_t)nxt.pm * tstep : cA; const char* nB = has_next ? (const char*)g.Bt + (size_t)nxt.pn * tstep : cB;
        for (int t = 0; t < nt; t += 2) {
            const bool last = (t == nt - 2);
            const char* a1 = cA + (size_t)(t + 1) * kstep;
            const char* a2 = last ? nA : cA + (size_t)(t + 2) * kstep; const char* b2 = last ? nB : cB + (size_t)(t + 2) * kstep;
            const char* a3 = a2 + kstep; const char* b3 = b2 + kstep;
            if (last && has_next) S.a_ready(nxt);
            if constexpr (SP2) {
            PG8_LDB(B0, 0, 0); PG8_LDB(B1, 0, 1); PG8_SCHED; PG8_LDA(At, 0, 0); PG8_STAGE(PG8_SA(1, 1), a1 + hstep, voffA);
            PG8_WAIT_V(8); PG8_WAIT_L(0); PG8_BAR; PG8_MMA(0, 0, At, B0); PG8_MMA(0, 1, At, B1); PG8_BAR; PG8_SCHED;
            PG8_LDA(At, 0, 1); PG8_STAGE(PG8_SB(0, 0), b2, voffB); PG8_STAGE(PG8_SB(0, 1), b2 + hstep, voffB); PG8_STAGE(PG8_SA(0, 0), a2, voffA);
            PG8_WAIT_V(8); PG8_WAIT_L(0); PG8_BAR; PG8_MMA(1, 0, At, B0); PG8_MMA(1, 1, At, B1); PG8_BAR; PG8_SCHED;
            PG8_LDB(B0, 1, 0); PG8_LDB(B1, 1, 1); PG8_SCHED; PG8_LDA(At, 1, 0); PG8_STAGE(PG8_SA(0, 1), a2 + hstep, voffA);
            PG8_WAIT_V(8); PG8_WAIT_L(0); PG8_BAR; PG8_MMA(0, 0, At, B0); PG8_MMA(0, 1, At, B1); PG8_BAR; PG8_SCHED;
            PG8_LDA(At, 1, 1); PG8_STAGE(PG8_SB(1, 0), b3, voffB); PG8_STAGE(PG8_SB(1, 1), b3 + hstep, voffB); PG8_STAGE(PG8_SA(1, 0), a3, voffA);
            PG8_WAIT_V(8); PG8_WAIT_L(0); PG8_BAR; PG8_MMA(1, 0, At, B0); PG8_MMA(1, 1, At, B1); PG8_BAR; PG8_SCHED;
            } else {
            PG8_LDB(B0, 0, 0); PG8_SCHED; PG8_LDA(At, 0, 0); PG8_STAGE(PG8_SA(1, 1), a1 + hstep, voffA);
            PG8_WAIT_L(8); PG8_BAR; PG8_WAIT_L(0); PG8_MMA(0, 0, At, B0); PG8_BAR; PG8_SCHED;
            PG8_LDB(B1, 0, 1); PG8_STAGE(PG8_SB(0, 0), b2, voffB);
            PG8_BAR; PG8_WAIT_L(0); PG8_MMA(0, 1, At, B1); PG8_BAR;
            PG8_LDA(At, 0, 1); PG8_STAGE(PG8_SA(0, 0), a2, voffA);
            PG8_BAR; PG8_WAIT_L(0); PG8_MMA(1, 0, At, B0); PG8_BAR; PG8_SCHED;
            PG8_STAGE(PG8_SB(0, 1), b2 + hstep, voffB);
            PG8_WAIT_V(6); PG8_BAR; PG8_MMA(1, 1, At, B1); PG8_BAR;
            PG8_LDB(B0, 1, 0); PG8_SCHED; PG8_LDA(At, 1, 0); PG8_STAGE(PG8_SA(0, 1), a2 + hstep, voffA);
            PG8_WAIT_L(8); PG8_BAR; PG8_WAIT_L(0); PG8_MMA(0, 0, At, B0); PG8_BAR; PG8_SCHED;
            PG8_LDB(B1, 1, 1); PG8_STAGE(PG8_SB(1, 0), b3, voffB);
            PG8_BAR; PG8_WAIT_L(0); PG8_MMA(0, 1, At, B1); PG8_BAR;
            PG8_LDA(At, 1, 1); PG8_STAGE(PG8_SA(1, 0), a3, voffA);
            PG8_BAR; PG8_WAIT_L(0); PG8_MMA(1, 0, At, B0); PG8_BAR; PG8_SCHED;
            PG8_STAGE(PG8_SB(1, 1), b3 + hstep, voffB);
            PG8_WAIT_V(6); PG8_BAR; PG8_MMA(1, 1, At, B1); PG8_BAR;
            }
        }
        if constexpr (ALIGN_EPI) { if (wr == 0) PG8_BAR; }
        if constexpr (!Epi::AFTER_DRAIN) { E(acc, cur, wr, wc, fr, fq); S.done(cur); }
        if (!has_next) break;
#pragma unroll
        for (int a = 0; a < 2; ++a)
#pragma unroll
            for (int b = 0; b < 2; ++b)
#pragma unroll
                for (int m = 0; m < 4; ++m)
#pragma unroll
                    for (int n = 0; n < 2; ++n) acc[a][b][m][n] = (f32x4){0.f, 0.f, 0.f, 0.f};
        cur = nxt; cA = nA; cB = nB; ++ui;
        if constexpr (ALIGN_EPI) { if (wr == 1) PG8_BAR; }
    }
    PG8_WAIT_V(0);
    if constexpr (!ALIGN_EPI) { if (wr == 0) PG8_BAR; }
    PG8_BAR;
    if constexpr (Epi::AFTER_DRAIN) { E.fused(acc, cur, wr, wc, fr, fq, lds, wid, lane); S.done(cur); }
#undef PG8_SA
#undef PG8_SB
#undef PG8_STAGE
#undef PG8_LDA
#undef PG8_LDB
#undef PG8_MMA
#undef PG8_WAIT_V
#undef PG8_WAIT_L
#undef PG8_BAR
#undef PG8_SCHED
}
}
#define GAS __attribute__((address_space(1)))
#define LAS __attribute__((address_space(3)))
typedef unsigned short bf16;
typedef unsigned v4u __attribute__((ext_vector_type(4)));
typedef float f32x4 __attribute__((ext_vector_type(4)));
typedef short bf16x8 __attribute__((ext_vector_type(8)));
typedef GAS unsigned gu32;
typedef GAS unsigned long long gu64;
#define RLX_AGENT __ATOMIC_RELAXED, __HIP_MEMORY_SCOPE_AGENT
#define LDS_WAIT() asm volatile("s_waitcnt lgkmcnt(0)" ::: "memory")
#define VM_WAIT() asm volatile("s_waitcnt vmcnt(0)" ::: "memory")
__device__ __forceinline__ unsigned long long rt() { return __builtin_amdgcn_s_memrealtime(); }
__device__ __forceinline__ unsigned f2bf(float f) { unsigned u = __builtin_bit_cast(unsigned, f); return (u + 0x7fffu + ((u >> 16) & 1u)) >> 16; }
__device__ __forceinline__ unsigned pk2(float lo, float hi) { return f2bf(lo) | (f2bf(hi) << 16); }

#define XB_TMO      128
#define XB_XCNT(j)  (256  + 64 * (j))
#define XB_XSUB(j)  (1280 + 64 * (j))
#define XB_XGEN(j)  (2304 + 64 * (j))
#define XB_TOP      3328
#define XB_TOPGEN   3392
#define XCD_BAR_WORDS 3456
#define XB_SPIN_CAP (1u << 18)

__device__ __forceinline__ unsigned xb_ld(unsigned* p)              { return __hip_atomic_load(p, __ATOMIC_RELAXED, __HIP_MEMORY_SCOPE_AGENT); }
__device__ __forceinline__ unsigned xb_add(unsigned* p, unsigned v) { return __hip_atomic_fetch_add(p, v, __ATOMIC_RELAXED, __HIP_MEMORY_SCOPE_AGENT); }
__device__ __forceinline__ unsigned xb_xcc_id() { return (unsigned)__builtin_amdgcn_s_getreg((3 << 11) | 20) & 0xFu; }
#define XB_SPIN(cond, bar) do { unsigned _sp = 0; while (cond) { __builtin_amdgcn_s_sleep(1); \
    if ((++_sp & 255u) == 0u) { if (xb_ld(&(bar)[XB_TMO])) break; if (_sp > XB_SPIN_CAP) { atomicAdd(&(bar)[XB_TMO], 1u); break; } } } } while (0)

struct XcdBarrier {
    unsigned* bar; unsigned x;
    volatile LAS unsigned* st;
    bool w0;
};

__device__ __forceinline__ XcdBarrier xcd_barrier_post(unsigned* bar, volatile LAS unsigned* st) {
    XcdBarrier b; b.bar = bar; b.x = xb_xcc_id(); b.st = st;
    if (threadIdx.x == 0) (void)xb_add(&bar[XB_XCNT(b.x)], 1u);
    return b;
}
__device__ __forceinline__ void xcd_barrier_complete(unsigned* bar, unsigned x, unsigned& nloc, unsigned& nx) {
    const unsigned G = gridDim.x * gridDim.y * gridDim.z;
    unsigned sum, cnt, mine, sp = 0u;
    for (;;) {
        sum = 0u; cnt = 0u; mine = 0u;
#pragma unroll
        for (unsigned j = 0; j < 16; ++j) { const unsigned c = xb_ld(&bar[XB_XCNT(j)]); sum += c; cnt += (c > 0u) ? 1u : 0u; mine = (j == x) ? c : mine; }
        if (sum == G) break;
        __builtin_amdgcn_s_sleep(1);
        if ((++sp & 255u) == 0u) { if (xb_ld(&bar[XB_TMO])) break; if (sp > XB_SPIN_CAP) { atomicAdd(&bar[XB_TMO], 1u); break; } }
    }
    nloc = mine > 0u ? mine : 1u; nx = cnt > 0u ? cnt : 1u;
}

__device__ __forceinline__ void xcd_barrier(const XcdBarrier& b) {
    asm volatile("s_waitcnt vmcnt(0)" ::: "memory");
    __syncthreads();
    if (b.w0 && mk_lane_id() == 0) {
        unsigned* bar = b.bar;
        __builtin_amdgcn_s_waitcnt(0);
        unsigned nloc = b.st[0], nx = b.st[1];
        if (nloc == 0u) { xcd_barrier_complete(bar, b.x, nloc, nx); b.st[0] = nloc; b.st[1] = nx; }
        const unsigned old = xb_add(&bar[XB_XSUB(b.x)], 1u);
        const unsigned gen = old / nloc;
        if (old + 1u == (gen + 1u) * nloc) {
            __builtin_amdgcn_fence(__ATOMIC_RELEASE, "agent");
            asm volatile("s_waitcnt vmcnt(0)" ::: "memory");
            const unsigned og = xb_add(&bar[XB_TOP], 1u);
            const unsigned tg = og / nx;
            if (og + 1u == (tg + 1u) * nx) xb_add(&bar[XB_TOPGEN], 1u);
            else XB_SPIN(xb_ld(&bar[XB_TOPGEN]) == tg, bar);
            __builtin_amdgcn_fence(__ATOMIC_ACQUIRE, "agent");
            xb_add(&bar[XB_XGEN(b.x)], 1u);
            asm volatile("s_waitcnt vmcnt(0)" ::: "memory");
        } else {
            XB_SPIN(xb_ld(&bar[XB_XGEN(b.x)]) == gen, bar);
            __builtin_amdgcn_fence(__ATOMIC_ACQUIRE, "agent");
            asm volatile("s_waitcnt vmcnt(0)" ::: "memory");
        }
    }
    __syncthreads();
}

constexpr int DM = 2048, NBAT = 4, SEQ = 2048, DEPTH = 4, NS = 128;
constexpr int MP = NBAT * SEQ;
constexpr int MV = MP + NS;
constexpr int MPAD = 8448;
constexpr int WA = 512, WB = 768, WC = 768, PIN = 6656, DFF = 5632, DPLE = 256, PBW = 2560;
constexpr int OFF_B = 1024, OFF_C = 3584;
constexpr float LN_EPS = 1e-5f, GN_EPS = 64e-5f, RMS_EPS = 1e-6f;
constexpr float DN_ALPHA = 1.681792830507429f;
enum { I_XP = 0, I_XS, I_SRWKV, I_SSHIFT, I_SHGRN, I_PP, I_PS, I_LNING, I_LNINB, I_WIN, I_ALNG, I_ALNB, I_AWS, I_ABS, I_BMU, I_BW0, I_BWUP, I_BA0, I_BAUP, I_BGUP,
       I_BKK, I_BKA, I_BRK, I_BGNG, I_BGNB, I_CLB, I_CNG, I_WOUT, I_LN1G, I_LN1B, I_WG, I_WU, I_WD, I_WPG, I_WPP, I_LN2G, I_LN2B, N_IN };
constexpr size_t O_YP = 0, O_YS = O_YP + (size_t)MP * DM, O_RP = O_YS + (size_t)NS * DM, O_SP = O_RP + (size_t)DEPTH * NBAT * 12 * 4096,
                 O_HP = O_SP + (size_t)DEPTH * NBAT * PBW, O_RS = O_HP + (size_t)DEPTH * NBAT * 6 * 16384, O_SS = O_RS + (size_t)DEPTH * NS * 12 * 4096,
                 O_HS = O_SS + (size_t)DEPTH * NS * PBW, O_VS = O_HS + (size_t)DEPTH * NS * 6 * 16384, O_END = O_VS + (size_t)DEPTH * NS * WA;
static_assert(O_END == 96509952, "output size");
constexpr size_t al256(size_t x) { return (x + 255) & ~(size_t)255; }
constexpr size_t WS_CTL = 0, CTL_ZERO_BYTES = 1u << 20;
constexpr size_t SZ_WIN = (size_t)PIN * DM * 2, SZ_WOUT = (size_t)DM * DM * 2, SZ_WGU = (size_t)2 * DFF * DM * 2, SZ_WD = (size_t)DM * DFF * 2, SZ_WPG = SZ_WOUT, SZ_WPP = (size_t)DM * DPLE * 2;
constexpr size_t WS_WIN = CTL_ZERO_BYTES, WS_WOUT = WS_WIN + DEPTH * SZ_WIN, WS_WGU = WS_WOUT + DEPTH * SZ_WOUT, WS_WD = WS_WGU + DEPTH * SZ_WGU, WS_WPG = WS_WD + DEPTH * SZ_WD,
                 WS_WPP = WS_WPG + DEPTH * SZ_WPG, WS_PBF = WS_WPP + DEPTH * SZ_WPP;
constexpr size_t SZ_PBF = (size_t)MPAD * DPLE * 2;
constexpr size_t WS_H = WS_PBF + DEPTH * SZ_PBF, WS_HB = WS_H + (size_t)MPAD * DM * 4, WS_T = WS_HB + (size_t)MPAD * DM * 2, WS_YMIX = WS_T + (size_t)MPAD * DM * 4;
constexpr size_t WS_Z = WS_YMIX + (size_t)MPAD * DM * 2;
constexpr size_t WS_ACT = WS_Z, WS_PLE = WS_ACT + al256((size_t)MPAD * DFF * 2);
constexpr size_t WS_PPO = WS_Z + (size_t)MPAD * PIN * 4;
static_assert(WS_PLE + (size_t)MPAD * DM * 4 <= WS_PPO, "overlay fits");
constexpr size_t WS_RPB = WS_PPO + (size_t)MPAD * DM * 4;
constexpr size_t WS_RPS = WS_RPB + (size_t)NBAT * 12 * SEQ * 384 * 4;
constexpr int NLORA = 3 * WB;
constexpr size_t SZ_WL = (size_t)NLORA * 256 * 2;
constexpr size_t WS_WL = WS_RPS + (size_t)NS * 12 * 384 * 4;
constexpr size_t WS_XCAT = WS_WL + DEPTH * SZ_WL;
constexpr size_t WS_LORA = WS_XCAT + (size_t)MPAD * 256 * 2;
constexpr size_t WS_Y = WS_LORA + (size_t)MPAD * NLORA * 4;
constexpr size_t WS_O = WS_Y + (size_t)MPAD * WB * 4;
constexpr size_t WS_END = WS_O + (size_t)MPAD * WC * 4;
static_assert(WS_WIN % 256 == 0 && WS_H % 256 == 0 && WS_Z % 256 == 0 && WS_RPB % 256 == 0 && WS_WL % 256 == 0 && WS_XCAT % 256 == 0 && WS_LORA % 256 == 0 && WS_Y % 256 == 0, "alignment");
constexpr int CW_BAR = 4096;

constexpr int RING_BYTES = 131072, LDSCTL_OFF = RING_BYTES, MISC_OFF = LDSCTL_OFF + 320, LDS_BYTES = 147456;
constexpr int NWAVES = 8, NTHR = 512;

struct Args { const float* in[N_IN]; float* out; unsigned char* ws; int ph_lo, ph_hi; };
static_assert(sizeof(Args) == (N_IN + 2) * 8 + 8, "no padding in Args");
typedef const __attribute__((address_space(4))) Args* ArgsP;

typedef float f4 __attribute__((ext_vector_type(4)));
typedef float f2 __attribute__((ext_vector_type(2)));
typedef unsigned u2 __attribute__((ext_vector_type(2)));

__device__ __forceinline__ float wave_sum(float v) {
#pragma unroll
    for (int o = 1; o < 64; o <<= 1) v += __shfl_xor(v, o);
    return v;
}
template <int CTRL> __device__ __forceinline__ float dpp_f(float x) { return __builtin_bit_cast(float, __builtin_amdgcn_update_dpp(0, __builtin_bit_cast(int, x), CTRL, 0xF, 0xF, true)); }
__device__ __forceinline__ float row16_sum(float x) {
    x += dpp_f<0xB1>(x);
    x += dpp_f<0x4E>(x);
    x += dpp_f<0x141>(x);
    x += dpp_f<0x140>(x);
    return x;
}
__device__ __forceinline__ float sigmoidf_(float x) { return 1.0f / (1.0f + expf(-x)); }
__device__ __forceinline__ float gelu_erf(float x) { return 0.5f * x * (1.0f + erff(x * 0.70710678118654752f)); }
__device__ __forceinline__ unsigned short bf1(float x) { return (unsigned short)(cvt_pk_bf16_c(x, 0.f) & 0xffffu); }
__device__ __forceinline__ float lbound(const float* clb, int L, int c) {
    const float x0 = clb[c], x1 = clb[WC + c], x2 = clb[2 * WC + c], x3 = clb[3 * WC + c];
    const float mx = fmaxf(fmaxf(x0, x1), fmaxf(x2, x3));
    const float e0 = expf(x0 - mx), e1 = expf(x1 - mx), e2 = expf(x2 - mx), e3 = expf(x3 - mx);
    float s = 0.f; if (L >= 1) s += e1; if (L >= 2) s += e2; if (L >= 3) s += e3;
    return s / (e0 + e1 + e2 + e3);
}
__device__ __forceinline__ float log_sigmoid(float x) { return fminf(x, 0.f) - log1pf(expf(-fabsf(x))); }

__device__ __forceinline__ void tr_item(const float* W, int K, int N, bf16* WT, int mode, LAS float* scr, int item, int lane) {
    const int nblk = N >> 5, kb = item / nblk, nb = item - kb * nblk, k0 = kb << 6, n0 = nb << 5;
    int rb = n0; if (mode) rb = ((n0 >> 7) << 8) + (n0 & 127) + (mode == 2 ? 128 : 0);
#pragma unroll 8
    for (int i = 0; i < 32; ++i) { const int kk = 2 * i + (lane >> 5); scr[kk * 33 + (lane & 31)] = W[(size_t)(k0 + kk) * N + n0 + (lane & 31)]; }
    LDS_WAIT(); asm volatile("" ::: "memory");
    const int c = lane & 7;
#pragma unroll
    for (int j = 0; j < 4; ++j) { const int n = (lane >> 3) + 8 * j; const LAS float* s = scr + (8 * c) * 33 + n;
        v4u o; o.x = pg8::cvt_pk_bf16(s[0 * 33], s[1 * 33]); o.y = pg8::cvt_pk_bf16(s[2 * 33], s[3 * 33]); o.z = pg8::cvt_pk_bf16(s[4 * 33], s[5 * 33]); o.w = pg8::cvt_pk_bf16(s[6 * 33], s[7 * 33]);
        *(v4u*)(WT + (size_t)(rb + n) * K + k0 + 8 * c) = o; }
    LDS_WAIT(); asm volatile("" ::: "memory");
}
__device__ __forceinline__ void ln_row(const float* src, const float* g, const float* b, float* dstf, bf16* dstb, float* dst2, int lane) {
    f4 v[8]; float s = 0.f;
#pragma unroll
    for (int j = 0; j < 8; ++j) { v[j] = *(const f4*)(src + 4 * (lane + 64 * j)); s += (v[j].x + v[j].y) + (v[j].z + v[j].w); }
    const float mean = wave_sum(s) * (1.f / DM); float s2 = 0.f;
#pragma unroll
    for (int j = 0; j < 8; ++j) { v[j] = v[j] - mean; s2 += (v[j].x * v[j].x + v[j].y * v[j].y) + (v[j].z * v[j].z + v[j].w * v[j].w); }
    const float rstd = 1.0f / sqrtf(wave_sum(s2) * (1.f / DM) + LN_EPS);
#pragma unroll
    for (int j = 0; j < 8; ++j) { const int c = 4 * (lane + 64 * j); const f4 gg = *(const f4*)(g + c), bb = *(const f4*)(b + c); const f4 o = v[j] * rstd * gg + bb;
        *(f4*)(dstf + c) = o; if (dst2) *(f4*)(dst2 + c) = o;
        u2 w; w.x = pg8::cvt_pk_bf16(o.x, o.y); w.y = pg8::cvt_pk_bf16(o.z, o.w); *(u2*)(dstb + c) = w; }
}
__device__ __forceinline__ void phase_prologue(ArgsP a, LAS unsigned char* lds, int lane, int wave, int blk, int G) {
    LAS float* scr = (LAS float*)(lds + wave * 16384);
    const int gw = blk * NWAVES + wave, NGW = G * NWAVES;
    constexpr int I_IN = 32 * (PIN / 32), I_OUT = 32 * (DM / 32), I_G = 32 * (DFF / 32), I_D = (DFF / 64) * (DM / 32), I_PGc = I_OUT, I_PPc = (DPLE / 64) * (DM / 32);
    constexpr int PER_L = I_IN + I_OUT + 2 * I_G + I_D + I_PGc + I_PPc;
    unsigned char* ws = a->ws;
    for (int it = gw; it < DEPTH * PER_L; it += NGW) {
        const int L = it / PER_L; int r = it - L * PER_L;
        if (r < I_IN) { tr_item(a->in[I_WIN] + (size_t)L * DM * PIN, DM, PIN, (bf16*)(ws + WS_WIN + L * SZ_WIN), 0, scr, r, lane); continue; } r -= I_IN;
        if (r < I_OUT) { tr_item(a->in[I_WOUT] + (size_t)L * DM * DM, DM, DM, (bf16*)(ws + WS_WOUT + L * SZ_WOUT), 0, scr, r, lane); continue; } r -= I_OUT;
        if (r < I_G) { tr_item(a->in[I_WG] + (size_t)L * DM * DFF, DM, DFF, (bf16*)(ws + WS_WGU + L * SZ_WGU), 1, scr, r, lane); continue; } r -= I_G;
        if (r < I_G) { tr_item(a->in[I_WU] + (size_t)L * DM * DFF, DM, DFF, (bf16*)(ws + WS_WGU + L * SZ_WGU), 2, scr, r, lane); continue; } r -= I_G;
        if (r < I_D) { tr_item(a->in[I_WD] + (size_t)L * DFF * DM, DFF, DM, (bf16*)(ws + WS_WD + L * SZ_WD), 0, scr, r, lane); continue; } r -= I_D;
        if (r < I_PGc) { tr_item(a->in[I_WPG] + (size_t)L * DM * DM, DM, DM, (bf16*)(ws + WS_WPG + L * SZ_WPG), 0, scr, r, lane); continue; } r -= I_PGc;
        tr_item(a->in[I_WPP] + (size_t)L * DPLE * DM, DPLE, DM, (bf16*)(ws + WS_WPP + L * SZ_WPP), 0, scr, r, lane);
    }
    for (int it = gw; it < DEPTH * NLORA; it += NGW) { const int L = it / NLORA, n = it - L * NLORA; float v[4];
#pragma unroll
        for (int e = 0; e < 4; ++e) { const int k = 4 * lane + e; float x = 0.f;
            if (n < WB) { if (k < 64) x = a->in[I_BWUP][((size_t)L * 64 + k) * WB + n]; }
            else if (n < 2 * WB) { if (k >= 64 && k < 128) x = a->in[I_BAUP][((size_t)L * 64 + (k - 64)) * WB + (n - WB)]; }
            else { if (k >= 128) x = a->in[I_BGUP][((size_t)L * 128 + (k - 128)) * WB + (n - 2 * WB)]; }
            v[e] = x; }
        u2 w; w.x = pg8::cvt_pk_bf16(v[0], v[1]); w.y = pg8::cvt_pk_bf16(v[2], v[3]); *(u2*)((bf16*)(ws + WS_WL + L * SZ_WL) + (size_t)n * 256 + 4 * lane) = w; }
    for (int it = gw; it < DEPTH * MV; it += NGW) { const int L = it / MV, m = it - L * MV;
        const float* src = (m < MP) ? a->in[I_PP] + ((size_t)L * MP + m) * DPLE : a->in[I_PS] + ((size_t)L * NS + (m - MP)) * DPLE;
        const f4 v = *(const f4*)(src + 4 * lane); u2 w; w.x = pg8::cvt_pk_bf16(v.x, v.y); w.y = pg8::cvt_pk_bf16(v.z, v.w);
        *(u2*)((bf16*)(ws + WS_PBF + L * SZ_PBF) + (size_t)m * DPLE + 4 * lane) = w; }
    for (int m = gw; m < MV; m += NGW) { const float* src = (m < MP) ? a->in[I_XP] + (size_t)m * DM : a->in[I_XS] + (size_t)(m - MP) * DM;
        ln_row(src, a->in[I_LNING], a->in[I_LNINB], (float*)(ws + WS_H) + (size_t)m * DM, (bf16*)(ws + WS_HB) + (size_t)m * DM, nullptr, lane); }
}
__device__ __forceinline__ void phase_ln(ArgsP a, const float* g, const float* b, bool last, int lane, int wave, int blk, int G) {
    const int gw = blk * NWAVES + wave, NGW = G * NWAVES; unsigned char* ws = a->ws;
    for (int m = gw; m < MV; m += NGW)
        ln_row((const float*)(ws + WS_T) + (size_t)m * DM, g, b, (float*)(ws + WS_H) + (size_t)m * DM, (bf16*)(ws + WS_HB) + (size_t)m * DM,
               last ? a->out + (m < MP ? O_YP + (size_t)m * DM : O_YS + (size_t)(m - MP) * DM) : nullptr, lane);
}


__device__ __forceinline__ void phase_xc(ArgsP a, int L, int lane, int wave, int blk, int G) {
    unsigned char* ws = a->ws; const int gw = blk * NWAVES + wave, NGW = G * NWAVES;
    const float* Z = (const float*)(ws + WS_Z);
    const float* mu = a->in[I_BMU] + L * PBW; const float* sh0 = a->in[I_SSHIFT] + (size_t)L * NS * PBW;
    const f4 mu4 = *(const f4*)(mu + 2304 + 4 * lane);
    for (int m = gw; m < MV; m += NGW) {
        const bool samp = m >= MP; const float* zr = Z + (size_t)m * PIN + OFF_B;
        const f4 cur = *(const f4*)(zr + 2304 + 4 * lane); f4 prev;
        if (samp) prev = *(const f4*)(sh0 + (size_t)(m - MP) * PBW + 2304 + 4 * lane); else if (m & (SEQ - 1)) prev = *(const f4*)(zr - PIN + 2304 + 4 * lane); else prev = (f4){0.f, 0.f, 0.f, 0.f};
        f4 x = cur + mu4 * (prev - cur);
        if (lane < 16) { x.x = tanhf(x.x); x.y = tanhf(x.y); x.z = tanhf(x.z); x.w = tanhf(x.w); }
        else if (lane >= 32) { x.x = sigmoidf_(x.x); x.y = sigmoidf_(x.y); x.z = sigmoidf_(x.z); x.w = sigmoidf_(x.w); }
        u2 w; w.x = pg8::cvt_pk_bf16(x.x, x.y); w.y = pg8::cvt_pk_bf16(x.z, x.w); *(u2*)((bf16*)(ws + WS_XCAT) + (size_t)m * 256 + 4 * lane) = w;
        if (samp || (m & (SEQ - 1)) == SEQ - 1) { float* dst = samp ? a->out + O_SS + ((size_t)L * NS + (m - MP)) * PBW : a->out + O_SP + ((size_t)L * NBAT + (m >> 11)) * PBW;
#pragma unroll
            for (int j = 0; j < PBW / 256; ++j) *(f4*)(dst + 256 * j + 4 * lane) = *(const f4*)(zr + 256 * j + 4 * lane); }
        if (samp) { const int i = m - MP; const float* z0 = Z + (size_t)m * PIN; const float* lng = a->in[I_ALNG] + L * WA; const float* lnb = a->in[I_ALNB] + L * WA;
            for (int g = 0; g < 4; ++g) {
                const float u0 = gelu_erf(z0[g * 128 + lane]), u1 = gelu_erf(z0[g * 128 + 64 + lane]);
                const float v0 = gelu_erf(z0[WA + g * 128 + lane]), v1 = gelu_erf(z0[WA + g * 128 + 64 + lane]);
                const float mean = wave_sum(v0 + v1) * (1.f / 128.f); const float d0 = v0 - mean, d1 = v1 - mean;
                const float rstd = 1.0f / sqrtf(wave_sum(d0 * d0 + d1 * d1) * (1.f / 128.f) + LN_EPS);
                const float n0 = d0 * rstd * lng[g * 128 + lane] + lnb[g * 128 + lane], n1 = d1 * rstd * lng[g * 128 + 64 + lane] + lnb[g * 128 + 64 + lane];
                float* ov = a->out + O_VS + ((size_t)L * NS + i) * WA + g * 128; ov[lane] = n0; ov[64 + lane] = n1;
                const float w00 = a->in[I_AWS][(size_t)(L * 4 + g) * 16384], b0 = a->in[I_ABS][(L * 4 + g) * 128];
                bf16* yo = (bf16*)(ws + WS_YMIX) + (size_t)m * DM + g * 128; yo[lane] = bf1(u0 * (w00 * n0 + b0)); yo[64 + lane] = bf1(u1 * (w00 * n1 + b0)); } }
    }
}
__device__ __forceinline__ void phase_fin(ArgsP a, int L, int lane, int wave, int blk, int G) {
    unsigned char* ws = a->ws; const int gw = blk * NWAVES + wave, NGW = G * NWAVES;
    const float* Z = (const float*)(ws + WS_Z); const float* LO = (const float*)(ws + WS_LORA);
    const float* mu = a->in[I_BMU] + L * PBW; const float* w0 = a->in[I_BW0] + L * WB; const float* a0 = a->in[I_BA0] + L * WB;
    const float* k_k = a->in[I_BKK] + L * WB; const float* k_a = a->in[I_BKA] + L * WB; const float* sh0 = a->in[I_SSHIFT] + (size_t)L * NS * PBW;
    for (int m = MP + gw; m < MV; m += NGW) {
        const bool samp = m >= MP; const float* zr = Z + (size_t)m * PIN + OFF_B; const float* lo = LO + (size_t)m * NLORA;
        const float* pz = samp ? sh0 + (size_t)(m - MP) * PBW : zr - PIN; const bool first = !samp && (m & (SEQ - 1)) == 0;
#pragma unroll 4
        for (int j = 0; j < 12; ++j) { const int c = 64 * j + lane;
            const float cr = zr[c], ck = zr[WB + c], cv = zr[2 * WB + c];
            float pr = 0.f, pk = 0.f, pv = 0.f; if (!first) { pr = pz[c]; pk = pz[WB + c]; pv = pz[2 * WB + c]; }
            const float r = cr + mu[c] * (pr - cr), k = ck + mu[WB + c] * (pk - ck), v = cv + mu[2 * WB + c] * (pv - cv);
            const float dec = __expf(-0.6065306597126334f * sigmoidf_(w0[c] + lo[c]));
            const float av = sigmoidf_(a0[c] + lo[WB + c]);
            const float kkr = k * k_k[c]; const float ss = wave_sum(kkr * kkr); const float kk = kkr / fmaxf(sqrtf(ss), 1e-12f);
            const float kp = k * (1.0f + (av - 1.0f) * k_a[c]);
            float* rec = samp ? (float*)(ws + WS_RPS) + ((size_t)(m - MP) * 12 + j) * 384 : (float*)(ws + WS_RPB) + (((size_t)(m >> 11) * 12 + j) * SEQ + (m & (SEQ - 1))) * 384;
            rec[lane] = r; rec[64 + lane] = dec; rec[128 + lane] = kp; rec[192 + lane] = v; rec[256 + lane] = kk; rec[320 + lane] = kk * av; }
    }
}

__device__ __forceinline__ void rwkv_scan_unit(ArgsP a, int L, int unit, LAS unsigned char* lds, int tid, int lane, int wave) {
    unsigned char* ws = a->ws;
    const int bh = unit >> 1, half = unit & 1, b = bh / 12, h = bh - b * 12;
    const f4* rec4 = (const f4*)((const float*)(ws + WS_RPB) + (size_t)bh * SEQ * 384);
    LAS float* buf = (LAS float*)lds;
    LAS float* ybuf = (LAS float*)(lds + 49152);
    const int rowl = wave * 4 + (lane >> 4), kg = lane & 15, row = half * 32 + rowl;
    float S0 = 0.f, S1 = 0.f, S2 = 0.f, S3 = 0.f;
    f4 st0, st1, st2;
    __syncthreads();
    st0 = rec4[tid]; st1 = rec4[512 + tid]; st2 = rec4[1024 + tid];
    *(LAS f4*)(buf + 4 * tid) = st0; *(LAS f4*)(buf + 4 * (512 + tid)) = st1; *(LAS f4*)(buf + 4 * (1024 + tid)) = st2;
    __syncthreads();
    float* Y = (float*)(ws + WS_Y);
    for (int c = 0; c < SEQ / 16; ++c) {
        if (c + 1 < SEQ / 16) { const f4* nx = rec4 + (size_t)(c + 1) * 1536; st0 = nx[tid]; st1 = nx[512 + tid]; st2 = nx[1024 + tid]; }
        const LAS float* cur = buf + (c & 1) * 6144; LAS float* yb = ybuf + (c & 1) * 512;
        f4 r4 = *(const LAS f4*)(cur + 4 * kg), w4 = *(const LAS f4*)(cur + 64 + 4 * kg), k4 = *(const LAS f4*)(cur + 128 + 4 * kg),
           kk4 = *(const LAS f4*)(cur + 256 + 4 * kg), ka4 = *(const LAS f4*)(cur + 320 + 4 * kg); float v = cur[192 + row];
#pragma unroll
        for (int s = 0; s < 16; ++s) {
            const LAS float* R = cur + (s < 15 ? s + 1 : 15) * 384;
            const f4 nr4 = *(const LAS f4*)(R + 4 * kg), nw4 = *(const LAS f4*)(R + 64 + 4 * kg), nk4 = *(const LAS f4*)(R + 128 + 4 * kg),
                     nkk4 = *(const LAS f4*)(R + 256 + 4 * kg), nka4 = *(const LAS f4*)(R + 320 + 4 * kg);
            const float nv = R[192 + row];
            float sa = (S0 * kk4.x + S1 * kk4.y) + (S2 * kk4.z + S3 * kk4.w);
            sa = row16_sum(sa);
            S0 = S0 * w4.x + (v * k4.x - sa * ka4.x); S1 = S1 * w4.y + (v * k4.y - sa * ka4.y);
            S2 = S2 * w4.z + (v * k4.z - sa * ka4.z); S3 = S3 * w4.w + (v * k4.w - sa * ka4.w);
            float y = (S0 * r4.x + S1 * r4.y) + (S2 * r4.z + S3 * r4.w);
            y = row16_sum(y);
            if (kg == 0) yb[s * 32 + rowl] = y;
            r4 = nr4; w4 = nw4; k4 = nk4; kk4 = nkk4; ka4 = nka4; v = nv;
        }
        if (c + 1 < SEQ / 16) { LAS float* nb = buf + ((c + 1) & 1) * 6144;
            *(LAS f4*)(nb + 4 * tid) = st0; *(LAS f4*)(nb + 4 * (512 + tid)) = st1; *(LAS f4*)(nb + 4 * (1024 + tid)) = st2; }
        __syncthreads();
        { const int s = tid >> 5, rl = tid & 31; Y[((size_t)b * SEQ + c * 16 + s) * WB + h * 64 + half * 32 + rl] = yb[tid]; }
    }
    f4 so; so.x = S0; so.y = S1; so.z = S2; so.w = S3;
    *(f4*)(a->out + O_RP + ((((size_t)L * NBAT + b) * 12 + h) * 64 + row) * 64 + 4 * kg) = so;
    __syncthreads();
}
__device__ __forceinline__ void rwkv_sample_item(ArgsP a, int L, int item, LAS unsigned char* lds, int lane, int wave) {
    unsigned char* ws = a->ws;
    const int ih = item * 8 + wave, i = ih / 12, h = ih - i * 12;
    const float* rec = (const float*)(ws + WS_RPS) + (size_t)ih * 384;
    LAS float* sc = (LAS float*)(lds + wave * 2048);
    const float r = rec[lane], w = rec[64 + lane], k = rec[128 + lane], v = rec[192 + lane], kk = rec[256 + lane], ka = rec[320 + lane];
    sc[lane] = r; sc[64 + lane] = w; sc[128 + lane] = k; sc[192 + lane] = kk; sc[256 + lane] = ka;
    LDS_WAIT(); asm volatile("" ::: "memory");
    const f4* S0p = (const f4*)(a->in[I_SRWKV] + (((size_t)L * NS + i) * 12 + h) * 4096 + lane * 64);
    f4 S[16];
#pragma unroll
    for (int j = 0; j < 16; ++j) S[j] = S0p[j];
    float sa = 0.f;
#pragma unroll
    for (int j = 0; j < 16; ++j) { const f4 q = *(const LAS f4*)(sc + 192 + 4 * j); sa += (S[j].x * q.x + S[j].y * q.y) + (S[j].z * q.z + S[j].w * q.w); }
    float y = 0.f;
    f4* So = (f4*)(a->out + O_RS + (((size_t)L * NS + i) * 12 + h) * 4096 + lane * 64);
#pragma unroll
    for (int j = 0; j < 16; ++j) { const f4 w4 = *(const LAS f4*)(sc + 64 + 4 * j), k4 = *(const LAS f4*)(sc + 128 + 4 * j), a4 = *(const LAS f4*)(sc + 256 + 4 * j), r4 = *(const LAS f4*)(sc + 4 * j);
        f4 n = S[j] * w4 + (k4 * v - a4 * sa); So[j] = n; y += (n.x * r4.x + n.y * r4.y) + (n.z * r4.z + n.w * r4.w); }
    ((float*)(ws + WS_Y))[(size_t)(MP + i) * WB + h * 64 + lane] = y;
    LDS_WAIT(); asm volatile("" ::: "memory");
}
__device__ __forceinline__ void hgrn_sample_item(ArgsP a, int L, int item, LAS unsigned char* lds, int lane, int wave) {
    unsigned char* ws = a->ws;
    const int ih = item * 4 + (wave >> 1), i = ih / 6, h = ih - i * 6, vcol = (wave & 1) * 64 + lane, m = MP + i;
    const float* zc = (const float*)(ws + WS_Z) + (size_t)m * PIN + OFF_C + h * 128;
    LAS float* sc = (LAS float*)(lds + wave * 2048);
#pragma unroll
    for (int t = 0; t < 2; ++t) { const int k = lane + 64 * t; const float lb = lbound(a->in[I_CLB], L, h * 128 + k); const float fz = zc[WC + k];
        const float sg = sigmoidf_(fz); sc[k] = lb + (1.0f - lb) * sg; sc[128 + k] = (1.0f - lb) * (1.0f - sg) ; sc[256 + k] = zc[k]; }
    const float iv = zc[2 * WC + vcol];
    LDS_WAIT(); asm volatile("" ::: "memory");
    const float* S0 = a->in[I_SHGRN] + (((size_t)L * NS + i) * 6 + h) * 16384 + vcol;
    float* So = a->out + O_HS + (((size_t)L * NS + i) * 6 + h) * 16384 + vcol;
    float o = 0.f;
#pragma unroll 8
    for (int k = 0; k < 128; ++k) { const float n = sc[k] * S0[(size_t)k * 128] + sc[128 + k] * iv; So[(size_t)k * 128] = n; o += n * sc[256 + k]; }
    ((float*)(ws + WS_O))[(size_t)m * WC + h * 128 + vcol] = o;
    LDS_WAIT(); asm volatile("" ::: "memory");
}
__device__ __forceinline__ void sgu_item(ArgsP a, int L, int item, LAS unsigned char* lds, int tid, int lane, int wave) {
    unsigned char* ws = a->ws;
    const int g = item & 3, bc = item >> 2, m0 = bc * 128;
    const float* Z = (const float*)(ws + WS_Z);
    LAS float* vn = (LAS float*)lds;
    LAS float* wt = (LAS float*)(lds + 65536);
    const float* wsrc = a->in[I_AWS] + (size_t)(L * 4 + g) * 16384;
    __syncthreads();
    for (int e = tid; e < 16384; e += NTHR) { const int t = e >> 7, s = e & 127; wt[s * 128 + t] = (s <= t) ? wsrc[e] : 0.f; }
    const float* lng = a->in[I_ALNG] + L * WA + g * 128; const float* lnb = a->in[I_ALNB] + L * WA + g * 128;
    for (int rr = 0; rr < 16; ++rr) { const int t = wave * 16 + rr; const float* zr = Z + (size_t)(m0 + t) * PIN + WA + g * 128;
        const float v0 = gelu_erf(zr[lane]), v1 = gelu_erf(zr[64 + lane]);
        const float mean = wave_sum(v0 + v1) * (1.f / 128.f); const float d0 = v0 - mean, d1 = v1 - mean;
        const float rstd = 1.0f / sqrtf(wave_sum(d0 * d0 + d1 * d1) * (1.f / 128.f) + LN_EPS);
        vn[t * 128 + lane] = d0 * rstd * lng[lane] + lnb[lane]; vn[t * 128 + 64 + lane] = d1 * rstd * lng[64 + lane] + lnb[64 + lane]; }
    __syncthreads();
    const int t = tid >> 2, dq = tid & 3, send = (wave * 16 + 15);
    f4 acc[8];
#pragma unroll
    for (int j = 0; j < 8; ++j) acc[j] = (f4){0.f, 0.f, 0.f, 0.f};
    for (int s = 0; s <= send; ++s) { const float w = wt[s * 128 + t]; const LAS f4* vr = (const LAS f4*)(vn + s * 128 + dq * 32);
#pragma unroll
        for (int j = 0; j < 8; ++j) acc[j] += vr[j] * w; }
    const float bs = a->in[I_ABS][(L * 4 + g) * 128 + t];
    const float* ur = Z + (size_t)(m0 + t) * PIN + g * 128 + dq * 32;
    bf16* yo = (bf16*)(ws + WS_YMIX) + (size_t)(m0 + t) * DM + g * 128 + dq * 32;
#pragma unroll
    for (int j = 0; j < 4; ++j) { const f4 u0 = *(const f4*)(ur + 8 * j), u1 = *(const f4*)(ur + 8 * j + 4); const f4 x0 = acc[2 * j] + bs, x1 = acc[2 * j + 1] + bs; v4u o;
        o.x = pg8::cvt_pk_bf16(gelu_erf(u0.x) * x0.x, gelu_erf(u0.y) * x0.y); o.y = pg8::cvt_pk_bf16(gelu_erf(u0.z) * x0.z, gelu_erf(u0.w) * x0.w);
        o.z = pg8::cvt_pk_bf16(gelu_erf(u1.x) * x1.x, gelu_erf(u1.y) * x1.y); o.w = pg8::cvt_pk_bf16(gelu_erf(u1.z) * x1.z, gelu_erf(u1.w) * x1.w);
        *(v4u*)(yo + 8 * j) = o; }
}

__device__ __forceinline__ void hgrn_seq_unit(ArgsP a, int L, int unit, LAS unsigned char* lds, int tid, int lane, int wave) {
    unsigned char* ws = a->ws;
    const int b = unit / 6, h = unit - b * 6;
    const float* Z = (const float*)(ws + WS_Z);
    LAS bf16* qs = (LAS bf16*)(lds);
    LAS bf16* ks = (LAS bf16*)(lds + 4352);
    LAS bf16* vt = (LAS bf16*)(lds + 8704);
    LAS bf16* kht = (LAS bf16*)(lds + 12800);
    LAS float* ev = (LAS float*)(lds + 16896);
    LAS float* part = (LAS float*)(lds + 17408);
    const int ch = tid & 127, tq = tid >> 7;
    const float lb = lbound(a->in[I_CLB], L, h * 128 + ch), oml = 1.0f - lb;
    const int pch = (ch & ~31) | (((ch >> 2) & 3) << 3) | (((ch >> 4) & 1) << 2) | (ch & 3);
    const int x = lane & 15, quad = lane >> 4;
    pg8::f32x4 Sacc[8];
#pragma unroll
    for (int mt = 0; mt < 8; ++mt) Sacc[mt] = (pg8::f32x4){0.f, 0.f, 0.f, 0.f};
    const float* zb = Z + (size_t)(b * SEQ + 4 * tq) * PIN + OFF_C + h * 128 + ch;
    float qn[4], fn[4], vn_[4];
#pragma unroll
    for (int j = 0; j < 4; ++j) { const float* p = zb + (size_t)j * PIN; qn[j] = p[0]; fn[j] = p[WC]; vn_[j] = p[2 * WC]; }
    float* O = (float*)(ws + WS_O);
    __syncthreads();
    for (int st = 0; st < SEQ / 16; ++st) {
        float q[4], fz[4], iv[4];
#pragma unroll
        for (int j = 0; j < 4; ++j) { q[j] = qn[j]; fz[j] = fn[j]; iv[j] = vn_[j]; }
        if (st + 1 < SEQ / 16) {
#pragma unroll
            for (int j = 0; j < 4; ++j) { const float* p = zb + (size_t)((st + 1) * 16 + j) * PIN; qn[j] = p[0]; fn[j] = p[WC]; vn_[j] = p[2 * WC]; } }
        float bl[4], kv[4]; float run = 0.f;
#pragma unroll
        for (int j = 0; j < 4; ++j) { const float e = __expf(-fmaxf(fz[j], -80.f)), sg = __builtin_amdgcn_rcpf(1.0f + e);
            run += __logf(lb + oml * sg); bl[j] = run; kv[j] = oml * e * sg; }
        part[tq * 128 + ch] = run;
        __syncthreads();
        const float p0 = part[ch], p1 = part[128 + ch], p2 = part[256 + ch], p3 = part[384 + ch];
        const float tot = (p0 + p1) + (p2 + p3); const float pre = (tq > 0 ? p0 : 0.f) + (tq > 1 ? p1 : 0.f) + (tq > 2 ? p2 : 0.f);
        float kh[4];
#pragma unroll
        for (int j = 0; j < 4; ++j) { const float bj = pre + bl[j]; const int t = 4 * tq + j;
            qs[t * 136 + pch] = bf1(q[j] * __expf(bj)); ks[t * 136 + pch] = bf1(kv[j] * __expf(fminf(-bj, 60.f))); kh[j] = kv[j] * __expf(tot - bj); }
        { u2 w; w.x = cvt_pk_bf16_c(kh[0], kh[1]); w.y = cvt_pk_bf16_c(kh[2], kh[3]); *(LAS u2*)(kht + ch * 16 + 4 * tq) = w;
          w.x = cvt_pk_bf16_c(iv[0], iv[1]); w.y = cvt_pk_bf16_c(iv[2], iv[3]); *(LAS u2*)(vt + ch * 16 + 4 * tq) = w; }
        if (tq == 0) ev[ch] = __expf(tot);
        __syncthreads();
        bf16x8 qf[4], kf[4];
#pragma unroll
        for (int kt = 0; kt < 4; ++kt) { qf[kt] = *(const LAS bf16x8*)(qs + x * 136 + 32 * kt + 8 * quad); kf[kt] = *(const LAS bf16x8*)(ks + x * 136 + 32 * kt + 8 * quad); }
        pg8::f32x4 att = (pg8::f32x4){0.f, 0.f, 0.f, 0.f};
#pragma unroll
        for (int kt = 0; kt < 4; ++kt) att = __builtin_amdgcn_mfma_f32_16x16x32_bf16(kf[kt], qf[kt], att, 0, 0, 0);
#pragma unroll
        for (int i = 0; i < 4; ++i) if (4 * quad + i > x) att[i] = 0.f;
        v4u pbu; pbu.x = cvt_pk_bf16_c(att[0], att[1]); pbu.y = cvt_pk_bf16_c(att[2], att[3]); pbu.z = 0u; pbu.w = 0u;
        const bf16x8 pb = __builtin_bit_cast(bf16x8, pbu);
        const u2 vv = *(const LAS u2*)(vt + (16 * wave + x) * 16 + 4 * quad);
        v4u vfu; vfu.x = vv.x; vfu.y = vv.y; vfu.z = 0u; vfu.w = 0u; const bf16x8 vf = __builtin_bit_cast(bf16x8, vfu);
        pg8::f32x4 o = (pg8::f32x4){0.f, 0.f, 0.f, 0.f};
#pragma unroll
        for (int kt = 0; kt < 4; ++kt) { v4u su; su.x = cvt_pk_bf16_c(Sacc[2 * kt][0], Sacc[2 * kt][1]); su.y = cvt_pk_bf16_c(Sacc[2 * kt][2], Sacc[2 * kt][3]);
            su.z = cvt_pk_bf16_c(Sacc[2 * kt + 1][0], Sacc[2 * kt + 1][1]); su.w = cvt_pk_bf16_c(Sacc[2 * kt + 1][2], Sacc[2 * kt + 1][3]);
            o = __builtin_amdgcn_mfma_f32_16x16x32_bf16(__builtin_bit_cast(bf16x8, su), qf[kt], o, 0, 0, 0); }
        o = __builtin_amdgcn_mfma_f32_16x16x32_bf16(vf, pb, o, 0, 0, 0);
        *(pg8::f32x4*)(O + (size_t)(b * SEQ + st * 16 + x) * WC + h * 128 + 16 * wave + 4 * quad) = o;
#pragma unroll
        for (int mt = 0; mt < 8; ++mt) { const pg8::f32x4 e4 = *(const LAS pg8::f32x4*)(ev + 16 * mt + 4 * quad);
            const u2 kk2 = *(const LAS u2*)(kht + (16 * mt + x) * 16 + 4 * quad); v4u ku; ku.x = kk2.x; ku.y = kk2.y; ku.z = 0u; ku.w = 0u;
            Sacc[mt] = __builtin_amdgcn_mfma_f32_16x16x32_bf16(__builtin_bit_cast(bf16x8, ku), vf, Sacc[mt] * e4, 0, 0, 0); }
    }
    float* So = a->out + O_HP + (((size_t)L * NBAT + b) * 6 + h) * 16384;
#pragma unroll
    for (int mt = 0; mt < 8; ++mt)
#pragma unroll
        for (int i = 0; i < 4; ++i) So[(size_t)(16 * mt + 4 * quad + i) * 128 + 16 * wave + x] = Sacc[mt][i];
    __syncthreads();
}

__device__ __forceinline__ void phase_post(ArgsP a, int L, int lane, int wave, int blk, int G) {
    unsigned char* ws = a->ws; const int gw = blk * NWAVES + wave, NGW = G * NWAVES;
    const float* Y = (const float*)(ws + WS_Y); const float* O = (const float*)(ws + WS_O); const float* Gt = (const float*)(ws + WS_LORA) + 2 * WB; const float* Z = (const float*)(ws + WS_Z);
    const float* gng = a->in[I_BGNG] + L * WB; const float* gnb = a->in[I_BGNB] + L * WB; const float* rk = a->in[I_BRK] + L * WB; const float* cng = a->in[I_CNG] + L * WC;
    for (int m = gw; m < MV; m += NGW) {
        bf16* yo = (bf16*)(ws + WS_YMIX) + (size_t)m * DM;
        float ov[12], gz[12]; float ss = 0.f;
#pragma unroll
        for (int j = 0; j < 12; ++j) { const int c = 64 * j + lane; ov[j] = O[(size_t)m * WC + c]; gz[j] = Z[(size_t)m * PIN + OFF_C + 3 * WC + c]; ss += ov[j] * ov[j]; }
        if (m >= MP) {
#pragma unroll
            for (int j = 0; j < 12; ++j) { const int c = 64 * j + lane; const float* rec = (const float*)(ws + WS_RPS) + ((size_t)(m - MP) * 12 + j) * 384;
                const float y = Y[(size_t)m * WB + c], rr = rec[lane], kp = rec[128 + lane], vv = rec[192 + lane], gg = Gt[(size_t)m * NLORA + c];
                const float mean = wave_sum(y) * (1.f / 64.f); const float d = y - mean; const float rstd = 1.0f / sqrtf(wave_sum(d * d) * (1.f / 64.f) + GN_EPS);
                const float bonus = wave_sum(rr * kp * rk[c]);
                yo[WA + c] = bf1((d * rstd * gng[c] + gnb[c] + bonus * vv) * gg); } }
        const float rms = 1.0f / sqrtf(wave_sum(ss) * (1.f / WC) + RMS_EPS);
#pragma unroll
        for (int j = 0; j < 12; ++j) { const int c = 64 * j + lane; yo[WA + WB + c] = bf1(ov[j] * rms * cng[c] * (gz[j] * sigmoidf_(gz[j]))); }
    }
}

constexpr int REC_BYTES = 12288, RC_WT = 0, RC_RT = 2048, RC_AHT = 4096, RC_KHT = 6144, RC_VT = 8192, RC_BRA = 10240, RC_BRK = 10752, RC_M2 = 11264, RC_G15 = 11776, RC_BC = 12032;
constexpr int NCHUNK = NBAT * 12 * (SEQ / 16);
static_assert((size_t)NCHUNK * REC_BYTES <= (size_t)NBAT * 12 * SEQ * 384 * 4, "chunk records fit in the old record region");
__device__ __forceinline__ float readlane_f(float x, int l) { return __builtin_bit_cast(float, __builtin_amdgcn_readlane(__builtin_bit_cast(int, x), l)); }
__device__ __forceinline__ float wave_sum_fast(float x) { x = row16_sum(x); return (readlane_f(x, 0) + readlane_f(x, 16)) + (readlane_f(x, 32) + readlane_f(x, 48)); }
__device__ __forceinline__ int perm_ch(int ch) { return (ch & ~31) | (((ch >> 2) & 3) << 3) | (((ch >> 4) & 1) << 2) | (ch & 3); }

__device__ __forceinline__ void pre_chunk(ArgsP a, int L, int q, LAS unsigned char* wl, int lane) {
    unsigned char* ws = a->ws;
    const int bh = q >> 7, c = q & 127, b = bh / 12, h = bh - 12 * b, m0 = b * SEQ + c * 16, col = h * 64 + lane;
    const float* Z = (const float*)(ws + WS_Z) + (size_t)m0 * PIN + OFF_B + col; const float* LO = (const float*)(ws + WS_LORA) + (size_t)m0 * NLORA + col;
    unsigned char* rec = ws + WS_RPB + (size_t)q * REC_BYTES;
    LAS float* X0 = (LAS float*)wl;
    LAS float* X1 = (LAS float*)(wl + 4352);
    LAS float* Maa = (LAS float*)(wl + 8704);
    LAS float* Mak = (LAS float*)(wl + 9728);
    LAS bf16* Sm = (LAS bf16*)(wl + 10752);
    LAS bf16* Wim = (LAS bf16*)(wl + 12288);
    const float mur = a->in[I_BMU][L * PBW + col], muk = a->in[I_BMU][L * PBW + WB + col], muv = a->in[I_BMU][L * PBW + 2 * WB + col];
    const float w0c = a->in[I_BW0][L * WB + col], a0c = a->in[I_BA0][L * WB + col], kkc = a->in[I_BKK][L * WB + col], kac = a->in[I_BKA][L * WB + col], rkc = a->in[I_BRK][L * WB + col];
    float cr[16], ck[16], cv[16], lw[16], la[16];
#pragma unroll
    for (int t = 0; t < 16; ++t) { cr[t] = Z[(size_t)t * PIN]; ck[t] = Z[(size_t)t * PIN + WB]; cv[t] = Z[(size_t)t * PIN + 2 * WB]; lw[t] = LO[(size_t)t * NLORA]; la[t] = LO[(size_t)t * NLORA + WB]; }
    float pr = 0.f, pk = 0.f, pv = 0.f; if (c) { pr = Z[-(ptrdiff_t)PIN]; pk = Z[-(ptrdiff_t)PIN + WB]; pv = Z[-(ptrdiff_t)PIN + 2 * WB]; }
    float r_[16], k_[16], v_[16], kp_[16], al_[16], g_[16]; float run = 0.f, bcv = 0.f;
#pragma unroll
    for (int t = 0; t < 16; ++t) {
        const float r = cr[t] + mur * (pr - cr[t]), k = ck[t] + muk * (pk - ck[t]), v = cv[t] + muv * (pv - cv[t]); pr = cr[t]; pk = ck[t]; pv = cv[t];
        run += -0.6065306597126334f * __builtin_amdgcn_rcpf(1.0f + __expf(-(w0c + lw[t]))); g_[t] = run;
        const float av = __builtin_amdgcn_rcpf(1.0f + __expf(-(a0c + la[t])));
        const float kkr = k * kkc; const float ss = wave_sum_fast(kkr * kkr); const float kap = kkr / fmaxf(sqrtf(ss), 1e-12f);
        const float kpr = k * (1.0f + (av - 1.0f) * kac);
        const float bc = wave_sum_fast(r * kpr * rkc); if (lane == t) bcv = bc;
        r_[t] = r; k_[t] = kpr; v_[t] = v; kp_[t] = kap; al_[t] = kap * av; }
    const float gl = g_[15];
    { float ah[16], kh[16];
#pragma unroll
      for (int t = 0; t < 16; ++t) { const float ig = __expf(-g_[t]), eg = __expf(gl - g_[t]); X0[t * 68 + lane] = al_[t] * ig; X1[t * 68 + lane] = k_[t] * ig; ah[t] = al_[t] * eg; kh[t] = k_[t] * eg; }
      v4u o0, o1;
      o0.x = cvt_pk_bf16_c(ah[0], ah[1]); o0.y = cvt_pk_bf16_c(ah[2], ah[3]); o0.z = cvt_pk_bf16_c(ah[4], ah[5]); o0.w = cvt_pk_bf16_c(ah[6], ah[7]);
      o1.x = cvt_pk_bf16_c(ah[8], ah[9]); o1.y = cvt_pk_bf16_c(ah[10], ah[11]); o1.z = cvt_pk_bf16_c(ah[12], ah[13]); o1.w = cvt_pk_bf16_c(ah[14], ah[15]);
      *(v4u*)(rec + RC_AHT + lane * 32) = o0; *(v4u*)(rec + RC_AHT + lane * 32 + 16) = o1;
      o0.x = cvt_pk_bf16_c(kh[0], kh[1]); o0.y = cvt_pk_bf16_c(kh[2], kh[3]); o0.z = cvt_pk_bf16_c(kh[4], kh[5]); o0.w = cvt_pk_bf16_c(kh[6], kh[7]);
      o1.x = cvt_pk_bf16_c(kh[8], kh[9]); o1.y = cvt_pk_bf16_c(kh[10], kh[11]); o1.z = cvt_pk_bf16_c(kh[12], kh[13]); o1.w = cvt_pk_bf16_c(kh[14], kh[15]);
      *(v4u*)(rec + RC_KHT + lane * 32) = o0; *(v4u*)(rec + RC_KHT + lane * 32 + 16) = o1;
      o0.x = cvt_pk_bf16_c(v_[0], v_[1]); o0.y = cvt_pk_bf16_c(v_[2], v_[3]); o0.z = cvt_pk_bf16_c(v_[4], v_[5]); o0.w = cvt_pk_bf16_c(v_[6], v_[7]);
      o1.x = cvt_pk_bf16_c(v_[8], v_[9]); o1.y = cvt_pk_bf16_c(v_[10], v_[11]); o1.z = cvt_pk_bf16_c(v_[12], v_[13]); o1.w = cvt_pk_bf16_c(v_[14], v_[15]);
      *(v4u*)(rec + RC_VT + lane * 32) = o0; *(v4u*)(rec + RC_VT + lane * 32 + 16) = o1; }
    LDS_WAIT(); asm volatile("" ::: "memory");
    const int x = lane & 15, kq = lane >> 4;
    f4 ba[4], bk[4];
#pragma unroll
    for (int j = 0; j < 4; ++j) { ba[j] = *(const LAS f4*)(X0 + x * 68 + 16 * kq + 4 * j); bk[j] = *(const LAS f4*)(X1 + x * 68 + 16 * kq + 4 * j); }
    LDS_WAIT(); asm volatile("" ::: "memory");
    float kt[16];
#pragma unroll
    for (int t = 0; t < 16; ++t) { kt[t] = kp_[t] * (t ? __expf(g_[t - 1]) : 1.0f); X0[t * 68 + lane] = kt[t]; X1[t * 68 + lane] = r_[t] * __expf(g_[t]); }
    LDS_WAIT(); asm volatile("" ::: "memory");
    f4 ak[4], ar[4];
#pragma unroll
    for (int j = 0; j < 4; ++j) { ak[j] = *(const LAS f4*)(X0 + x * 68 + 16 * kq + 4 * j); ar[j] = *(const LAS f4*)(X1 + x * 68 + 16 * kq + 4 * j); }
    pg8::f32x4 Gaa = (pg8::f32x4){0.f, 0.f, 0.f, 0.f}, Gak = Gaa, Gra = Gaa, Grk = Gaa;
#pragma unroll
    for (int j = 0; j < 4; ++j)
#pragma unroll
        for (int e = 0; e < 4; ++e) { Gaa = __builtin_amdgcn_mfma_f32_16x16x4f32(ak[j][e], ba[j][e], Gaa, 0, 0, 0); Gak = __builtin_amdgcn_mfma_f32_16x16x4f32(ak[j][e], bk[j][e], Gak, 0, 0, 0);
            Gra = __builtin_amdgcn_mfma_f32_16x16x4f32(ar[j][e], ba[j][e], Gra, 0, 0, 0); Grk = __builtin_amdgcn_mfma_f32_16x16x4f32(ar[j][e], bk[j][e], Grk, 0, 0, 0); }
#pragma unroll
    for (int i = 0; i < 4; ++i) { const int t = 4 * kq + i; const bool sl = x < t, le = x <= t;
        Maa[t * 16 + x] = sl ? Gaa[i] : 0.f; Mak[t * 16 + x] = sl ? Gak[i] : 0.f;
        Sm[t * 16 + x] = bf1(le ? Gra[i] : 0.f); Sm[256 + t * 16 + x] = bf1(le ? Grk[i] : 0.f); }
    LDS_WAIT(); asm volatile("" ::: "memory");
    float xm[16];
#pragma unroll
    for (int t = 0; t < 16; ++t) xm[t] = Mak[t * 16 + x];
#pragma unroll
    for (int t = 1; t < 16; ++t) {
#pragma unroll
        for (int s4 = 0; s4 < (t + 3) / 4; ++s4) { const f4 ar4 = *(const LAS f4*)(Maa + t * 16 + 4 * s4);
#pragma unroll
            for (int e = 0; e < 4; ++e) if (4 * s4 + e < t) { kt[t] -= ar4[e] * kt[4 * s4 + e]; xm[t] -= ar4[e] * xm[4 * s4 + e]; } } }
#pragma unroll
    for (int t = 0; t < 16; ++t) { Wim[t * 64 + perm_ch(lane)] = bf1(-kt[t]); if (lane < 16) Sm[512 + t * 16 + lane] = bf1(-xm[t]); }
    LDS_WAIT(); asm volatile("" ::: "memory");
    *(v4u*)(rec + RC_WT + lane * 16) = *(const LAS v4u*)((LAS unsigned char*)Wim + lane * 16); *(v4u*)(rec + RC_WT + 1024 + lane * 16) = *(const LAS v4u*)((LAS unsigned char*)Wim + 1024 + lane * 16);
    *(v4u*)(rec + RC_BRA + lane * 16) = *(const LAS v4u*)((LAS unsigned char*)Sm + lane * 16); if (lane < 32) *(v4u*)(rec + RC_BRA + 1024 + lane * 16) = *(const LAS v4u*)((LAS unsigned char*)Sm + 1024 + lane * 16);
    LDS_WAIT(); asm volatile("" ::: "memory");
#pragma unroll
    for (int t = 0; t < 16; ++t) Wim[t * 64 + perm_ch(lane)] = bf1(r_[t] * __expf(g_[t]));
    LDS_WAIT(); asm volatile("" ::: "memory");
    *(v4u*)(rec + RC_RT + lane * 16) = *(const LAS v4u*)((LAS unsigned char*)Wim + lane * 16); *(v4u*)(rec + RC_RT + 1024 + lane * 16) = *(const LAS v4u*)((LAS unsigned char*)Wim + 1024 + lane * 16);
    *(float*)(rec + RC_G15 + lane * 4) = __expf(gl); if (lane < 16) *(float*)(rec + RC_BC + lane * 4) = bcv;
    LDS_WAIT(); asm volatile("" ::: "memory");
}
__device__ __forceinline__ void phase_pre(ArgsP a, int L, LAS unsigned char* lds, int lane, int wave, int blk, int G) {
    const int gw = blk * NWAVES + wave, NGW = G * NWAVES;
    for (int q = gw; q < NCHUNK; q += NGW) pre_chunk(a, L, q, lds + wave * 16384, lane);
}
__device__ __forceinline__ void rwkv_seq_unit(ArgsP a, int L, int unit, LAS unsigned char* lds, int lane, int wave) {
    unsigned char* ws = a->ws;
    const int b = unit / 12, h = unit - 12 * b;
    const unsigned char* recs = ws + WS_RPB + (size_t)unit * 128 * REC_BYTES;
    LAS float* ybuf = (LAS float*)(lds + 8 * REC_BYTES);
    const int x = lane & 15, quad = lane >> 4;
    constexpr int AHEAD = 6, NCH = SEQ / 16;
#define RW_DMA(cc) do { const unsigned char* g_ = recs + (size_t)(cc) * REC_BYTES + wave * 3072 + lane * 16; LAS unsigned char* l_ = lds + ((cc) & 7) * REC_BYTES + wave * 3072; \
        __builtin_amdgcn_global_load_lds((const unsigned*)(g_), (LAS unsigned*)(l_), 16, 0, 0); __builtin_amdgcn_global_load_lds((const unsigned*)(g_ + 1024), (LAS unsigned*)(l_ + 1024), 16, 0, 0); \
        __builtin_amdgcn_global_load_lds((const unsigned*)(g_ + 2048), (LAS unsigned*)(l_ + 2048), 16, 0, 0); } while (0)
    asm volatile("s_waitcnt vmcnt(0) lgkmcnt(0)" ::: "memory"); __builtin_amdgcn_s_barrier(); asm volatile("" ::: "memory");
    pg8::f32x4 Hacc[4];
#pragma unroll
    for (int nt = 0; nt < 4; ++nt) Hacc[nt] = (pg8::f32x4){0.f, 0.f, 0.f, 0.f};
    if (wave < 4) {
#pragma unroll
        for (int cc = 0; cc < AHEAD; ++cc) RW_DMA(cc);
        asm volatile("s_waitcnt vmcnt(15)" ::: "memory");
    }
    __builtin_amdgcn_s_barrier(); asm volatile("" ::: "memory");
    const float gng = a->in[I_BGNG][L * WB + h * 64 + lane], gnb = a->in[I_BGNB][L * WB + h * 64 + lane];
    const float* gate = (const float*)(ws + WS_LORA) + (size_t)(b * SEQ) * NLORA + 2 * WB + h * 64 + lane;
    bf16* ymix = (bf16*)(ws + WS_YMIX) + (size_t)(b * SEQ) * DM + WA + h * 64 + lane;
    for (int c = 0; c <= NCH; ++c) {
        if (wave < 4) {
            if (c < NCH) {
                if (c + AHEAD < NCH) RW_DMA(c + AHEAD); else { asm volatile("s_nop 0" ::: "memory"); }
                const LAS unsigned char* S = lds + (c & 7) * REC_BYTES;
                bf16x8 wf[2], rf[2], hb[2];
#pragma unroll
                for (int ks = 0; ks < 2; ++ks) { wf[ks] = *(const LAS bf16x8*)(S + RC_WT + x * 128 + 64 * ks + 16 * quad); rf[ks] = *(const LAS bf16x8*)(S + RC_RT + x * 128 + 64 * ks + 16 * quad);
                    v4u su; su.x = cvt_pk_bf16_c(Hacc[2 * ks][0], Hacc[2 * ks][1]); su.y = cvt_pk_bf16_c(Hacc[2 * ks][2], Hacc[2 * ks][3]);
                    su.z = cvt_pk_bf16_c(Hacc[2 * ks + 1][0], Hacc[2 * ks + 1][1]); su.w = cvt_pk_bf16_c(Hacc[2 * ks + 1][2], Hacc[2 * ks + 1][3]); hb[ks] = __builtin_bit_cast(bf16x8, su); }
                const u2 vv = *(const LAS u2*)(S + RC_VT + (16 * wave + x) * 32 + 8 * quad); v4u t4; t4.x = vv.x; t4.y = vv.y; t4.z = 0u; t4.w = 0u; const bf16x8 vf = __builtin_bit_cast(bf16x8, t4);
                const u2 m2v = *(const LAS u2*)(S + RC_M2 + x * 32 + 8 * quad); t4.x = m2v.x; t4.y = m2v.y; const bf16x8 m2f = __builtin_bit_cast(bf16x8, t4);
                const u2 brav = *(const LAS u2*)(S + RC_BRA + x * 32 + 8 * quad); t4.x = brav.x; t4.y = brav.y; const bf16x8 braf = __builtin_bit_cast(bf16x8, t4);
                const u2 brkv = *(const LAS u2*)(S + RC_BRK + x * 32 + 8 * quad); t4.x = brkv.x; t4.y = brkv.y; const bf16x8 brkf = __builtin_bit_cast(bf16x8, t4);
                pg8::f32x4 U = (pg8::f32x4){0.f, 0.f, 0.f, 0.f}, Y = U;
                U = __builtin_amdgcn_mfma_f32_16x16x32_bf16(wf[0], hb[0], U, 0, 0, 0); U = __builtin_amdgcn_mfma_f32_16x16x32_bf16(wf[1], hb[1], U, 0, 0, 0); U = __builtin_amdgcn_mfma_f32_16x16x32_bf16(m2f, vf, U, 0, 0, 0);
                Y = __builtin_amdgcn_mfma_f32_16x16x32_bf16(rf[0], hb[0], Y, 0, 0, 0); Y = __builtin_amdgcn_mfma_f32_16x16x32_bf16(rf[1], hb[1], Y, 0, 0, 0); Y = __builtin_amdgcn_mfma_f32_16x16x32_bf16(brkf, vf, Y, 0, 0, 0);
                t4.x = cvt_pk_bf16_c(U[0], U[1]); t4.y = cvt_pk_bf16_c(U[2], U[3]); const bf16x8 ub = __builtin_bit_cast(bf16x8, t4);
                Y = __builtin_amdgcn_mfma_f32_16x16x32_bf16(braf, ub, Y, 0, 0, 0);
#pragma unroll
                for (int nt = 0; nt < 4; ++nt) { const pg8::f32x4 g4 = *(const LAS pg8::f32x4*)(S + RC_G15 + (16 * nt + 4 * quad) * 4);
                    const u2 av = *(const LAS u2*)(S + RC_AHT + (16 * nt + x) * 32 + 8 * quad); t4.x = av.x; t4.y = av.y; const bf16x8 ahf = __builtin_bit_cast(bf16x8, t4);
                    const u2 kv = *(const LAS u2*)(S + RC_KHT + (16 * nt + x) * 32 + 8 * quad); t4.x = kv.x; t4.y = kv.y; const bf16x8 khf = __builtin_bit_cast(bf16x8, t4);
                    Hacc[nt] = __builtin_amdgcn_mfma_f32_16x16x32_bf16(ahf, ub, Hacc[nt] * g4, 0, 0, 0); Hacc[nt] = __builtin_amdgcn_mfma_f32_16x16x32_bf16(khf, vf, Hacc[nt], 0, 0, 0); }
                LAS float* yb = ybuf + (c & 1) * 1024;
#pragma unroll
                for (int i = 0; i < 4; ++i) yb[(4 * quad + i) * 64 + 16 * wave + x] = Y[i];
            }
            if (c + AHEAD < NCH) asm volatile("s_waitcnt vmcnt(15)" ::: "memory"); else asm volatile("s_waitcnt vmcnt(0)" ::: "memory");
        } else if (c > 0) {
            const int cp = c - 1; const LAS unsigned char* S = lds + (cp & 7) * REC_BYTES; const LAS float* yb = ybuf + (cp & 1) * 1024;
#pragma unroll
            for (int j = 0; j < 4; ++j) { const int tt = 4 * (wave - 4) + j; const size_t row = (size_t)(cp * 16 + tt);
                const float g = gate[row * NLORA]; const float y = yb[tt * 64 + lane];
                const float mean = wave_sum_fast(y) * (1.f / 64.f); const float d = y - mean; const float rstd = 1.0f / sqrtf(wave_sum_fast(d * d) * (1.f / 64.f) + GN_EPS);
                const float bcf = *(const LAS float*)(S + RC_BC + tt * 4); const unsigned short vb = *(const LAS unsigned short*)(S + RC_VT + lane * 32 + tt * 2);
                const float v = __builtin_bit_cast(float, (unsigned)vb << 16);
                ymix[row * DM] = bf1((d * rstd * gng + gnb + bcf * v) * g); }
        }
        asm volatile("s_waitcnt lgkmcnt(0)" ::: "memory"); __builtin_amdgcn_s_barrier(); asm volatile("" ::: "memory");
    }
    if (wave < 4) { float* So = a->out + O_RP + (((size_t)L * NBAT + b) * 12 + h) * 4096;
#pragma unroll
        for (int nt = 0; nt < 4; ++nt) *(pg8::f32x4*)(So + (size_t)(16 * wave + x) * 64 + 16 * nt + 4 * quad) = Hacc[nt]; }
#undef RW_DMA
    asm volatile("s_waitcnt vmcnt(0) lgkmcnt(0)" ::: "memory"); __builtin_amdgcn_s_barrier(); asm volatile("" ::: "memory");
}

enum { SE_STORE = 0, SE_RESID = 1, SE_SWIGLU = 2, SE_SIGMUL = 3 };
struct SEpi { int mode; float* out; const float* base; const float* add; int ld; float alpha; };
__device__ __forceinline__ void strip_task(const bf16* A, const bf16* Bt, int K, int r0, int r1, int c0, const SEpi& E, LAS unsigned char* lds, int lane, int wave) {
    const int x = lane & 15, quad = lane >> 4;
    const int nks = K >> 8;
    const bf16* Ap = A + (size_t)x * K + wave * (nks * 32) + 8 * quad;
    const bf16* B0 = Bt + (size_t)(r0 + x) * K + wave * (nks * 32) + 8 * quad;
    const bf16* B1 = Bt + (size_t)(r1 + x) * K + wave * (nks * 32) + 8 * quad;
    pg8::f32x4 acc[8][2];
#pragma unroll
    for (int mt = 0; mt < 8; ++mt) { acc[mt][0] = (pg8::f32x4){0.f, 0.f, 0.f, 0.f}; acc[mt][1] = (pg8::f32x4){0.f, 0.f, 0.f, 0.f}; }
    for (int s = 0; s < nks; ++s) {
        bf16x8 af[8]; const bf16x8 b0 = *(const bf16x8*)(B0 + 32 * s), b1 = *(const bf16x8*)(B1 + 32 * s);
#pragma unroll
        for (int mt = 0; mt < 8; ++mt) af[mt] = *(const bf16x8*)(Ap + (size_t)(16 * mt) * K + 32 * s);
#pragma unroll
        for (int mt = 0; mt < 8; ++mt) { acc[mt][0] = __builtin_amdgcn_mfma_f32_16x16x32_bf16(af[mt], b0, acc[mt][0], 0, 0, 0); acc[mt][1] = __builtin_amdgcn_mfma_f32_16x16x32_bf16(af[mt], b1, acc[mt][1], 0, 0, 0); }
    }
    __syncthreads();
    LAS pg8::f32x4* red = (LAS pg8::f32x4*)lds;
#pragma unroll
    for (int mt = 0; mt < 8; ++mt) { red[((wave * 8 + mt) * 2 + 0) * 64 + lane] = acc[mt][0]; red[((wave * 8 + mt) * 2 + 1) * 64 + lane] = acc[mt][1]; }
    __syncthreads();
    pg8::f32x4 s0 = (pg8::f32x4){0.f, 0.f, 0.f, 0.f}, s1 = s0;
#pragma unroll
    for (int w2 = 0; w2 < 8; ++w2) { s0 += red[((w2 * 8 + wave) * 2 + 0) * 64 + lane]; s1 += red[((w2 * 8 + wave) * 2 + 1) * 64 + lane]; }
#pragma unroll
    for (int i = 0; i < 4; ++i) { const size_t ro = (size_t)(16 * wave + 4 * quad + i) * E.ld;
        if (E.mode == SE_SWIGLU) { const float g = s0[i]; ((bf16*)E.out)[ro + c0 + x] = bf1(g * __builtin_amdgcn_rcpf(1.0f + __expf(-g)) * s1[i]); }
        else {
#pragma unroll
            for (int t = 0; t < 2; ++t) { const size_t o = ro + c0 + 16 * t + x; const float v = t ? s1[i] : s0[i]; float r;
                if (E.mode == SE_STORE) r = v;
                else if (E.mode == SE_RESID) { r = E.alpha * E.base[o] + v; if (E.add) r += E.add[o]; }
                else r = E.base[o] * __builtin_amdgcn_rcpf(1.0f + __expf(-v));
                E.out[o] = r; } }
    }
}
__device__ __forceinline__ void strip_gemm(const bf16* A, const bf16* Bt, int K, int N, const SEpi& E, LAS unsigned char* lds, int lane, int wave, int blk, int G) {
    const int per = (E.mode == SE_SWIGLU) ? 16 : 32, ntask = N / per;
    for (int t = G - 1 - blk; t < ntask; t += G) { const int c0 = t * per;
        if (E.mode == SE_SWIGLU) { const int rb = ((c0 >> 7) << 8) + (c0 & 127); strip_task(A, Bt, K, rb, rb + 128, c0, E, lds, lane, wave); }
        else strip_task(A, Bt, K, c0, c0 + 16, c0, E, lds, lane, wave); }
    __syncthreads();
}

#ifndef EN_PRO
#define EN_PRO 1
#endif
#ifndef EN_G1
#define EN_G1 1
#endif
#ifndef EN_PREP
#define EN_PREP 1
#endif
#ifndef EN_MIX
#define EN_MIX 1
#endif
#ifndef EN_POST
#define EN_POST 1
#endif
#ifndef EN_G3
#define EN_G3 1
#endif
#ifndef EN_LN
#define EN_LN 1
#endif
#ifndef EN_G4
#define EN_G4 1
#endif
#ifndef EN_G5
#define EN_G5 1
#endif
#ifndef REP_PHASE
#define REP_PHASE -1
#endif
#define NREP(k) ((REP_PHASE) == (k) ? 2 : 1)
#ifndef MK_SINGLE
#define MK_SINGLE 1
#endif
constexpr int PPL = 11, N_PHASES = 1 + PPL * DEPTH;
constexpr int SCAN_UNITS = NBAT * 12, HSEQ_UNITS = NBAT * 6, ROLE_BLOCKS = SCAN_UNITS + HSEQ_UNITS;
constexpr int N_SGU = NBAT * 16 * 4, N_RS = NS * 12 / 8, N_HS = NS * 6 / 4, N_MISC = N_SGU + N_RS + N_HS;

__global__ void __launch_bounds__(NTHR, 2) mk_fwd(Args a) {
    extern __shared__ __attribute__((aligned(16))) unsigned char lds_raw[];
    LAS unsigned char* lds = (LAS unsigned char*)lds_raw;
    const int tid = threadIdx.x, blk = blockIdx.x, G = gridDim.x; const int wave0 = __builtin_amdgcn_readfirstlane(tid >> 6);
    ArgsP ap0 = (ArgsP)__builtin_amdgcn_kernarg_segment_ptr();
    volatile LAS unsigned* MISC = (volatile LAS unsigned*)(lds + MISC_OFF);
    for (int u = tid; u < (LDS_BYTES - LDSCTL_OFF) / 4; u += NTHR) ((LAS unsigned*)(lds + LDSCTL_OFF))[u] = 0u;
    __syncthreads();
    const int lo = ap0->ph_lo, hi = ap0->ph_hi;
    XcdBarrier bar; bar.bar = (unsigned*)(ap0->ws + WS_CTL) + CW_BAR; bar.x = 0; bar.st = nullptr;
    if (hi - lo > 1) bar = xcd_barrier_post((unsigned*)(ap0->ws + WS_CTL) + CW_BAR, MISC + 8);
    bar.w0 = (wave0 == 0);
#define IN(k) (lo <= (k) && (k) < hi)
#define SEAM(k) do { if (IN(k) && IN((k) + 1)) { xcd_barrier(bar); } } while (0)
#define PHASE_BEGIN() ArgsP a = ap0; asm volatile("" : "+s"(a)); unsigned char* ws = a->ws; int tid_ = wave0 * 64 + mk_lane_id(); asm volatile("" : "+v"(tid_)); \
    const int lane_ = tid_ & 63; const int wave_ = __builtin_amdgcn_readfirstlane(tid_ >> 6); const int lane_s = lane_, wave_s = wave_; \
    bf16* HB = (bf16*)(ws + WS_HB); float* H = (float*)(ws + WS_H); float* T = (float*)(ws + WS_T); (void)HB; (void)H; (void)T; (void)lane_s; (void)wave_s

    #if EN_PRO
    if (IN(0)) for (int rep = 0; rep < NREP(0); ++rep) { PHASE_BEGIN(); phase_prologue(a, lds, lane_, wave_, blk, G); __syncthreads(); }
#endif
    SEAM(0);
    for (int L = 0; L < DEPTH; ++L) {
        const int pb = 1 + PPL * L;
#if EN_G1
        if (IN(pb)) for (int rep = 0; rep < NREP(1); ++rep) {
            { PHASE_BEGIN(); pg8::Gemm g{HB, (const bf16*)(ws + WS_WIN + L * SZ_WIN), MP, PIN, DM}; pg8::StaticOrder S; S.init(MP, PIN, G, blk);
              pg8::EpiF32 E{(float*)(ws + WS_Z), PIN}; pg8::gemm_phase<pg8::EpiF32, pg8::StaticOrder, true, true>(lds, g, S, E, wave0); }
              { PHASE_BEGIN(); const SEpi SE{SE_STORE, (float*)(ws + WS_Z) + (size_t)MP * PIN, nullptr, nullptr, PIN, 0.f}; strip_gemm(HB + (size_t)MP * DM, (const bf16*)(ws + WS_WIN + L * SZ_WIN), DM, PIN, SE, lds, lane_s, wave_s, blk, G); }
            { PHASE_BEGIN(); pg8::Gemm g{(const bf16*)(ws + WS_PBF + L * SZ_PBF), (const bf16*)(ws + WS_WPP + L * SZ_WPP), MP, DM, DPLE}; pg8::StaticOrder S; S.init(MP, DM, G, G - 1 - blk);
              pg8::EpiF32 E{(float*)(ws + WS_PPO), DM}; pg8::gemm_phase<pg8::EpiF32, pg8::StaticOrder, true, true>(lds, g, S, E, wave0); }
              { PHASE_BEGIN(); const SEpi SE{SE_STORE, (float*)(ws + WS_PPO) + (size_t)MP * DM, nullptr, nullptr, DM, 0.f}; strip_gemm((const bf16*)(ws + WS_PBF + L * SZ_PBF) + (size_t)MP * DPLE, (const bf16*)(ws + WS_WPP + L * SZ_WPP), DPLE, DM, SE, lds, lane_s, wave_s, blk, G); }
        }
#endif
        SEAM(pb);
#if EN_PREP
        if (IN(pb + 1)) for (int rep = 0; rep < NREP(2); ++rep) { PHASE_BEGIN(); phase_xc(a, L, lane_, wave_, blk, G); }
        SEAM(pb + 1);
        if (IN(pb + 2)) for (int rep = 0; rep < NREP(9); ++rep) {
            { PHASE_BEGIN(); pg8::Gemm g{(const bf16*)(ws + WS_XCAT), (const bf16*)(ws + WS_WL + L * SZ_WL), MP, NLORA, 256}; pg8::StaticOrder S; S.init(MP, NLORA, G, blk);
            pg8::EpiF32 E{(float*)(ws + WS_LORA), NLORA}; pg8::gemm_phase<pg8::EpiF32, pg8::StaticOrder, true, true>(lds, g, S, E, wave0); }
            { PHASE_BEGIN(); const SEpi SE{SE_STORE, (float*)(ws + WS_LORA) + (size_t)MP * NLORA, nullptr, nullptr, NLORA, 0.f}; strip_gemm((const bf16*)(ws + WS_XCAT) + (size_t)MP * 256, (const bf16*)(ws + WS_WL + L * SZ_WL), 256, NLORA, SE, lds, lane_s, wave_s, blk, G); }
        }
        SEAM(pb + 2);
        if (IN(pb + 3)) for (int rep = 0; rep < NREP(10); ++rep) { PHASE_BEGIN(); phase_pre(a, L, lds, lane_, wave_, blk, G); phase_fin(a, L, lane_, wave_, blk, G); }
#endif
        SEAM(pb + 3);
#if EN_MIX
        if (IN(pb + 4)) for (int rep = 0; rep < NREP(3); ++rep) { PHASE_BEGIN();
            const int tid = tid_, lane = lane_, wave = wave_;
            if (blk < SCAN_UNITS) { for (int r2 = 0; r2 < NREP(31); ++r2) rwkv_seq_unit(a, L, blk, lds, lane, wave); }
            else if (blk < ROLE_BLOCKS) { for (int r2 = 0; r2 < NREP(32); ++r2) hgrn_seq_unit(a, L, blk - SCAN_UNITS, lds, tid, lane, wave); }
            else for (int r2 = 0; r2 < NREP(33); ++r2) for (int it = blk - ROLE_BLOCKS; it < N_MISC; it += G - ROLE_BLOCKS) {
                if (it < N_SGU) sgu_item(a, L, it, lds, tid, lane, wave);
                else if (it < N_SGU + N_RS) rwkv_sample_item(a, L, it - N_SGU, lds, lane, wave);
                else hgrn_sample_item(a, L, it - N_SGU - N_RS, lds, lane, wave);
                __syncthreads();
            }
        }
#endif
        SEAM(pb + 4);
#if EN_POST
        if (IN(pb + 5)) for (int rep = 0; rep < NREP(4); ++rep) { PHASE_BEGIN(); phase_post(a, L, lane_, wave_, blk, G); }
#endif
        SEAM(pb + 5);
#if EN_G3
        if (IN(pb + 6)) for (int rep = 0; rep < NREP(5); ++rep) {
            { PHASE_BEGIN(); pg8::Gemm g{(const bf16*)(ws + WS_YMIX), (const bf16*)(ws + WS_WOUT + L * SZ_WOUT), MP, DM, DM}; pg8::StaticOrder S; S.init(MP, DM, G, blk);
            pg8::EpiResid E{T, H, nullptr, DM, DN_ALPHA}; pg8::gemm_phase<pg8::EpiResid, pg8::StaticOrder, true, true>(lds, g, S, E, wave0); }
            { PHASE_BEGIN(); const SEpi SE{SE_RESID, T + (size_t)MP * DM, H + (size_t)MP * DM, nullptr, DM, DN_ALPHA}; strip_gemm((const bf16*)(ws + WS_YMIX) + (size_t)MP * DM, (const bf16*)(ws + WS_WOUT + L * SZ_WOUT), DM, DM, SE, lds, lane_s, wave_s, blk, G); }
        }
#endif
        SEAM(pb + 6);
#if EN_LN
        if (IN(pb + 7)) for (int rep = 0; rep < NREP(6); ++rep) { PHASE_BEGIN(); phase_ln(a, a->in[I_LN1G] + L * DM, a->in[I_LN1B] + L * DM, false, lane_, wave_, blk, G); }
#endif
        SEAM(pb + 7);
#if EN_G4
        if (IN(pb + 8)) for (int rep = 0; rep < NREP(7); ++rep) {
            { PHASE_BEGIN(); pg8::Gemm g{HB, (const bf16*)(ws + WS_WGU + L * SZ_WGU), MP, 2 * DFF, DM}; pg8::StaticOrder S; S.init(MP, 2 * DFF, G, blk);
              pg8::EpiSwiglu E{(bf16*)(ws + WS_ACT), DFF}; pg8::gemm_phase<pg8::EpiSwiglu, pg8::StaticOrder, true, true>(lds, g, S, E, wave0); }
              { PHASE_BEGIN(); const SEpi SE{SE_SWIGLU, (float*)((bf16*)(ws + WS_ACT) + (size_t)MP * DFF), nullptr, nullptr, DFF, 0.f}; strip_gemm(HB + (size_t)MP * DM, (const bf16*)(ws + WS_WGU + L * SZ_WGU), DM, DFF, SE, lds, lane_s, wave_s, blk, G); }
            { PHASE_BEGIN(); pg8::Gemm g{HB, (const bf16*)(ws + WS_WPG + L * SZ_WPG), MP, DM, DM}; pg8::StaticOrder S; S.init(MP, DM, G, G - 1 - blk);
              pg8::EpiSigMul E{(float*)(ws + WS_PLE), (const float*)(ws + WS_PPO), DM}; pg8::gemm_phase<pg8::EpiSigMul, pg8::StaticOrder, true, true>(lds, g, S, E, wave0); }
              { PHASE_BEGIN(); const SEpi SE{SE_SIGMUL, (float*)(ws + WS_PLE) + (size_t)MP * DM, (const float*)(ws + WS_PPO) + (size_t)MP * DM, nullptr, DM, 0.f}; strip_gemm(HB + (size_t)MP * DM, (const bf16*)(ws + WS_WPG + L * SZ_WPG), DM, DM, SE, lds, lane_s, wave_s, blk, G); }
        }
#endif
        SEAM(pb + 8);
#if EN_G5
        if (IN(pb + 9)) for (int rep = 0; rep < NREP(8); ++rep) {
            { PHASE_BEGIN(); pg8::Gemm g{(const bf16*)(ws + WS_ACT), (const bf16*)(ws + WS_WD + L * SZ_WD), MP, DM, DFF}; pg8::StaticOrder S; S.init(MP, DM, G, blk);
            pg8::EpiResid E{T, H, (const float*)(ws + WS_PLE), DM, DN_ALPHA}; pg8::gemm_phase<pg8::EpiResid, pg8::StaticOrder, true, true>(lds, g, S, E, wave0); }
            { PHASE_BEGIN(); const SEpi SE{SE_RESID, T + (size_t)MP * DM, H + (size_t)MP * DM, (const float*)(ws + WS_PLE) + (size_t)MP * DM, DM, DN_ALPHA}; strip_gemm((const bf16*)(ws + WS_ACT) + (size_t)MP * DFF, (const bf16*)(ws + WS_WD + L * SZ_WD), DFF, DM, SE, lds, lane_s, wave_s, blk, G); }
        }
#endif
        SEAM(pb + 9);
#if EN_LN
        if (IN(pb + 10)) for (int rep = 0; rep < NREP(6); ++rep) { PHASE_BEGIN(); phase_ln(a, a->in[I_LN2G] + L * DM, a->in[I_LN2B] + L * DM, L == DEPTH - 1, lane_, wave_, blk, G); }
#endif
        SEAM(pb + 10);
    }
#undef IN
#undef SEAM
}

extern "C" void kernel_launch(void* const* d_in, const int* in_sizes, int n_in, void* d_out, int out_size, void* d_ws, size_t ws_size, hipStream_t stream) {
    static int grid = 0;
    if (grid == 0) {
        if (n_in != N_IN || (size_t)out_size != O_END || ws_size < WS_END) { fprintf(stderr, "kernel_launch: unexpected sizes n_in %d out %d ws %zu (need %zu)\n", n_in, out_size, ws_size, (size_t)WS_END); grid = -1; return; }
        int dev = 0, cus = 0, per_cu = 0;
        if (hipGetDevice(&dev) != hipSuccess || hipDeviceGetAttribute(&cus, hipDeviceAttributeMultiprocessorCount, dev) != hipSuccess) { grid = -1; return; }
        if (hipFuncSetAttribute((const void*)mk_fwd, hipFuncAttributeMaxDynamicSharedMemorySize, LDS_BYTES) != hipSuccess) { fprintf(stderr, "kernel_launch: hipFuncSetAttribute failed\n"); grid = -1; return; }
        if (hipOccupancyMaxActiveBlocksPerMultiprocessor(&per_cu, (const void*)mk_fwd, NTHR, LDS_BYTES) != hipSuccess || per_cu < 1) fprintf(stderr, "kernel_launch: occupancy query says %d\n", per_cu);
        (void)hipGetLastError();
        grid = cus;
        if (grid < ROLE_BLOCKS + 8) { fprintf(stderr, "kernel_launch: %d CUs is too few\n", grid); grid = -1; return; }
    }
    if (grid < 0) return;
    if (hipMemsetAsync((char*)d_ws + WS_CTL, 0, CTL_ZERO_BYTES, stream) != hipSuccess) return;
    Args a{};
    for (int i = 0; i < N_IN; ++i) a.in[i] = (const float*)d_in[i];
    a.out = (float*)d_out; a.ws = (unsigned char*)d_ws;
#if MK_SINGLE
    a.ph_lo = 0; a.ph_hi = N_PHASES;
    hipLaunchKernelGGL(mk_fwd, dim3(grid), dim3(NTHR), LDS_BYTES, stream, a);
#else
    for (int p = 0; p < N_PHASES; ++p) { a.ph_lo = p; a.ph_hi = p + 1; hipLaunchKernelGGL(mk_fwd, dim3(grid), dim3(NTHR), LDS_BYTES, stream, a); }
#endif
}
```

```cpp
#include <hip/hip_runtime.h>
#include <cstdio>
#include <cstdint>
typedef float mk_f32x2 __attribute__((ext_vector_type(2))); typedef __bf16 mk_bf16x2 __attribute__((ext_vector_type(2)));
__device__ __forceinline__ unsigned cvt_pk_bf16_c(float lo, float hi) { mk_f32x2 v = {lo, hi}; mk_bf16x2 b = __builtin_convertvector(v, mk_bf16x2); return __builtin_bit_cast(unsigned, b); }
__device__ __forceinline__ int mk_lane_id() { int l; asm volatile("v_mbcnt_lo_u32_b32 %0, -1, 0\n\tv_mbcnt_hi_u32_b32 %0, -1, %0" : "=v"(l)); return l; }
namespace pg8 {
#define PG8_LAS __attribute__((address_space(3)))
typedef unsigned short bf16_t;
typedef short bf16x8 __attribute__((ext_vector_type(8)));
typedef float f32x4 __attribute__((ext_vector_type(4)));
typedef unsigned u32x4 __attribute__((ext_vector_type(4)));
constexpr int BM = 256, BK = 64, HALF = 128, HTB = HALF * BK * 2  , STAGE_BYTES = 8 * HTB, NXCD = 8, WGM = 8;

__host__ __device__ __forceinline__ int lds_byte(int r, int c) { const int st = (r >> 4) * 2 + (c >> 5), rr = r & 15, cc = c & 31, ob = rr * 64 + cc * 2; return st * 1024 + (ob ^ (((ob >> 9) & 1) << 5)); }
__host__ __device__ __forceinline__ void stage_rc(int b, int& R, int& C) { const int st = b / 1024, sb = b % 1024, swz = sb ^ (((sb >> 9) & 1) << 5); R = (st >> 1) * 16 + swz / 64; C = (st & 1) * 32 + (swz % 64) / 2; }
__host__ __device__ __forceinline__ int perm32(int rho) { const int n = rho >> 4, i = rho & 15; return 8 * (i >> 2) + 4 * n + (i & 3); }

struct Unit { int pm, pn; };
struct Gemm { const bf16_t* A; const bf16_t* Bt; int M, N, K; };

struct StaticOrder {
    int nM, nN, nwg, G, c;
    __host__ __device__ void init(int M, int N, int G_, int c_) { nM = M / BM; nN = N / BM; nwg = nM * nN; G = G_; c = c_; }
    __host__ __device__ bool next(int i, Unit& u) const {
        const long L = (long)i * G + c; if (L >= nwg) return false;
        int wgid = (int)L; { const int q = nwg / NXCD, r = nwg % NXCD, xcd = wgid % NXCD, off = wgid / NXCD; wgid = (xcd < r ? xcd * (q + 1) : r * (q + 1) + (xcd - r) * q) + off; }
        const int nig = WGM * nN, gid = wgid / nig, fm = gid * WGM, gsz = (nM - fm) < WGM ? (nM - fm) : WGM;
        u.pm = fm + ((wgid % nig) % gsz); u.pn = (wgid % nig) / gsz; return true;
    }
    __device__ __forceinline__ void a_ready(const Unit&) const {}
    __device__ __forceinline__ void done(const Unit&) const {}
};

__device__ __forceinline__ unsigned cvt_pk_bf16(float lo, float hi) { unsigned r; asm volatile("v_cvt_pk_bf16_f32 %0, %1, %2" : "=v"(r) : "v"(lo), "v"(hi)); return r; }
typedef float f32x2 __attribute__((ext_vector_type(2)));
typedef unsigned u32x2 __attribute__((ext_vector_type(2)));
struct EpiF32 {
    static constexpr bool PERM = false, AFTER_DRAIN = false;
    float* C; int ldc;
    __device__ __forceinline__ void operator()(const f32x4 (&acc)[2][2][4][2], const Unit& u, int wr, int wc, int fr, int fq) const {
        const int row0 = u.pm * BM + wr * 64 + fr, col0 = u.pn * BM + wc * 32 + 4 * fq;
#pragma unroll
        for (int ai = 0; ai < 2; ++ai)
#pragma unroll
            for (int m = 0; m < 4; ++m) { float* rowp = C + (size_t)(row0 + ai * HALF + m * 16) * ldc + col0;
#pragma unroll
                for (int bj = 0; bj < 2; ++bj)
#pragma unroll
                    for (int n = 0; n < 2; ++n) *(f32x4*)(rowp + bj * HALF + n * 16) = acc[ai][bj][m][n]; }
    }
};
struct EpiResid {
    static constexpr bool PERM = false, AFTER_DRAIN = false;
    float* out; const float* base; const float* add; int ldc; float alpha;
    __device__ __forceinline__ void operator()(const f32x4 (&acc)[2][2][4][2], const Unit& u, int wr, int wc, int fr, int fq) const {
        const int row0 = u.pm * BM + wr * 64 + fr, col0 = u.pn * BM + wc * 32 + 4 * fq;
#pragma unroll
        for (int ai = 0; ai < 2; ++ai)
#pragma unroll
            for (int m = 0; m < 4; ++m) { const size_t off = (size_t)(row0 + ai * HALF + m * 16) * ldc + col0;
#pragma unroll
                for (int bj = 0; bj < 2; ++bj)
#pragma unroll
                    for (int n = 0; n < 2; ++n) { const size_t o2 = off + bj * HALF + n * 16; f32x4 v = *(const f32x4*)(base + o2) * alpha + acc[ai][bj][m][n];
                        if (add) v += *(const f32x4*)(add + o2); *(f32x4*)(out + o2) = v; } }
    }
};
struct EpiSigMul {
    static constexpr bool PERM = false, AFTER_DRAIN = false;
    float* out; const float* mul; int ldc;
    __device__ __forceinline__ void operator()(const f32x4 (&acc)[2][2][4][2], const Unit& u, int wr, int wc, int fr, int fq) const {
        const int row0 = u.pm * BM + wr * 64 + fr, col0 = u.pn * BM + wc * 32 + 4 * fq;
#pragma unroll
        for (int ai = 0; ai < 2; ++ai)
#pragma unroll
            for (int m = 0; m < 4; ++m) { const size_t off = (size_t)(row0 + ai * HALF + m * 16) * ldc + col0;
#pragma unroll
                for (int bj = 0; bj < 2; ++bj)
#pragma unroll
                    for (int n = 0; n < 2; ++n) { const size_t o2 = off + bj * HALF + n * 16; const f32x4 x = acc[ai][bj][m][n]; const f32x4 p = *(const f32x4*)(mul + o2); f32x4 v;
#pragma unroll
                        for (int e = 0; e < 4; ++e) v[e] = p[e] * __builtin_amdgcn_rcpf(1.0f + __expf(-x[e]));
                        *(f32x4*)(out + o2) = v; } }
    }
};
struct EpiSwiglu {
    static constexpr bool PERM = true, AFTER_DRAIN = false;
    bf16_t* O; int ldo;
    __device__ __forceinline__ void operator()(const f32x4 (&acc)[2][2][4][2], const Unit& u, int wr, int wc, int fr, int fq) const {
        const int row0 = u.pm * BM + wr * 64 + fr, col0 = u.pn * HALF + wc * 32 + 8 * fq;
#pragma unroll
        for (int ai = 0; ai < 2; ++ai)
#pragma unroll
            for (int m = 0; m < 4; ++m) { bf16_t* rowp = O + (size_t)(row0 + ai * HALF + m * 16) * ldo + col0; float r[8];
#pragma unroll
                for (int n = 0; n < 2; ++n)
#pragma unroll
                    for (int e = 0; e < 4; ++e) { const float g = acc[ai][0][m][n][e], up = acc[ai][1][m][n][e]; r[4 * n + e] = g * __builtin_amdgcn_rcpf(1.0f + __expf(-g)) * up; }
                u32x4 w; w.x = cvt_pk_bf16(r[0], r[1]); w.y = cvt_pk_bf16(r[2], r[3]); w.z = cvt_pk_bf16(r[4], r[5]); w.w = cvt_pk_bf16(r[6], r[7]);
                *(u32x4*)rowp = w; }
    }
};
template <class Epi, class Sched, bool ALIGN_EPI = false, bool SP2 = false>
__device__ __forceinline__ void gemm_phase(PG8_LAS unsigned char* lds, const Gemm g, const Sched& S, const Epi& E, int wid0) {
    int tid_l = wid0 * 64 + mk_lane_id(); asm volatile("" : "+v"(tid_l));
    const int tid = tid_l, wid = __builtin_amdgcn_readfirstlane(tid >> 6), lane = tid & 63, wr = wid >> 2, wc = wid & 3, fr = lane & 15, fq = lane >> 4;
    const int K = g.K, nt = K / BK;
    unsigned voffA[2], voffB[2];
#pragma unroll
    for (int i = 0; i < 2; ++i) { int R, C; stage_rc(tid * 16 + i * 8192, R, C); const int Rb = Epi::PERM ? ((R & ~31) + perm32(R & 31)) : R;
        voffA[i] = (unsigned)(R * K + C) * 2u; voffB[i] = (unsigned)(Rb * K + C) * 2u; }
    const size_t kstep = (size_t)(BK * 2);
    const size_t hstep = (size_t)HALF * K * 2;
    const size_t tstep = 2 * hstep;
    const unsigned ldsw = (unsigned)wid * 1024u;
    const int aoff = lds_byte(wr * 64 + fr, fq * 8), boff = lds_byte(wc * 32 + fr, fq * 8);
#define PG8_SA(b, h) (((b) * 2 + (h)) * HTB)
#define PG8_SB(b, h) ((4 + (b) * 2 + (h)) * HTB)
#define PG8_STAGE(bufoff, gbase, voff) do { _Pragma("unroll") for (int _i = 0; _i < 2; ++_i) \
        __builtin_amdgcn_global_load_lds((const unsigned*)((const char*)(gbase) + (voff)[_i]), (PG8_LAS unsigned*)(lds + (bufoff) + ldsw + _i * 8192), 16, 0, 0); } while (0)
#define PG8_LDA(dst, b, h) do { _Pragma("unroll") for (int m = 0; m < 4; ++m) _Pragma("unroll") for (int k = 0; k < 2; ++k) dst[m][k] = *(const PG8_LAS bf16x8*)(lds + PG8_SA(b, h) + aoff + m * 2048 + k * 1024); } while (0)
#define PG8_LDB(dst, b, h) do { _Pragma("unroll") for (int n = 0; n < 2; ++n) _Pragma("unroll") for (int k = 0; k < 2; ++k) dst[n][k] = *(const PG8_LAS bf16x8*)(lds + PG8_SB(b, h) + boff + n * 2048 + k * 1024); } while (0)
#define PG8_MMA(ai, bj, At, Bt) do { __builtin_amdgcn_s_setprio(1); _Pragma("unroll") for (int m = 0; m < 4; ++m) _Pragma("unroll") for (int n = 0; n < 2; ++n) _Pragma("unroll") for (int k = 0; k < 2; ++k) \
        acc[ai][bj][m][n] = __builtin_amdgcn_mfma_f32_16x16x32_bf16(Bt[n][k], At[m][k], acc[ai][bj][m][n], 0, 0, 0); __builtin_amdgcn_s_setprio(0); } while (0)
#define PG8_WAIT_V(n) asm volatile("s_waitcnt vmcnt(" #n ")" ::: "memory")
#define PG8_WAIT_L(n) asm volatile("s_waitcnt lgkmcnt(" #n ")" ::: "memory")
#define PG8_BAR __builtin_amdgcn_s_barrier()
#define PG8_SCHED __builtin_amdgcn_sched_barrier(0)
    Unit cur, nxt; int ui = 0;
    if (!S.next(0, cur)) return;
    f32x4 acc[2][2][4][2];
#pragma unroll
    for (int a = 0; a < 2; ++a)
#pragma unroll
        for (int b = 0; b < 2; ++b)
#pragma unroll
            for (int m = 0; m < 4; ++m)
#pragma unroll
                for (int n = 0; n < 2; ++n) acc[a][b][m][n] = (f32x4){0.f, 0.f, 0.f, 0.f};
    bf16x8 At[4][2], B0[2][2], B1[2][2];
    const char* cA = (const char*)g.A + (size_t)cur.pm * tstep; const char* cB = (const char*)g.Bt + (size_t)cur.pn * tstep;
    S.a_ready(cur);
    if constexpr (SP2) {
        PG8_STAGE(PG8_SB(0, 0), cB, voffB); PG8_STAGE(PG8_SB(0, 1), cB + hstep, voffB); PG8_STAGE(PG8_SA(0, 0), cA, voffA); PG8_STAGE(PG8_SA(0, 1), cA + hstep, voffA);
        if (wr == 1) PG8_BAR;
        PG8_WAIT_V(2); PG8_BAR;
        PG8_STAGE(PG8_SB(1, 0), cB + kstep, voffB); PG8_STAGE(PG8_SA(1, 0), cA + kstep, voffA); PG8_STAGE(PG8_SB(1, 1), cB + hstep + kstep, voffB);
        PG8_WAIT_V(6); PG8_BAR;
    } else {
        PG8_STAGE(PG8_SB(0, 0), cB, voffB); PG8_STAGE(PG8_SA(0, 0), cA, voffA); PG8_STAGE(PG8_SB(0, 1), cB + hstep, voffB); PG8_STAGE(PG8_SA(0, 1), cA + hstep, voffA);
        if (wr == 1) PG8_BAR;
        PG8_WAIT_V(4); PG8_BAR;
        PG8_STAGE(PG8_SB(1, 0), cB + kstep, voffB); PG8_STAGE(PG8_SA(1, 0), cA + kstep, voffA); PG8_STAGE(PG8_SB(1, 1), cB + hstep + kstep, voffB);
        PG8_WAIT_V(6); PG8_BAR;
    }
    for (;;) {
        const bool has_next = S.next(ui + 1, nxt);
        const char* nA = has_next ? (const char*)g.A + (size_t)nxt.pm * tstep : cA; const char* nB = has_next ? (const char*)g.Bt + (size_t)nxt.pn * tstep : cB;
        for (int t = 0; t < nt; t += 2) {
            const bool last = (t == nt - 2);
            const char* a1 = cA + (size_t)(t + 1) * kstep;
            const char* a2 = last ? nA : cA + (size_t)(t + 2) * kstep; const char* b2 = last ? nB : cB + (size_t)(t + 2) * kstep;
            const char* a3 = a2 + kstep; const char* b3 = b2 + kstep;
            if (last && has_next) S.a_ready(nxt);
            if constexpr (SP2) {
            PG8_LDB(B0, 0, 0); PG8_LDB(B1, 0, 1); PG8_SCHED; PG8_LDA(At, 0, 0); PG8_STAGE(PG8_SA(1, 1), a1 + hstep, voffA);
            PG8_WAIT_V(8); PG8_WAIT_L(0); PG8_BAR; PG8_MMA(0, 0, At, B0); PG8_MMA(0, 1, At, B1); PG8_BAR; PG8_SCHED;
            PG8_LDA(At, 0, 1); PG8_STAGE(PG8_SB(0, 0), b2, voffB); PG8_STAGE(PG8_SB(0, 1), b2 + hstep, voffB); PG8_STAGE(PG8_SA(0, 0), a2, voffA);
            PG8_WAIT_V(8); PG8_WAIT_L(0); PG8_BAR; PG8_MMA(1, 0, At, B0); PG8_MMA(1, 1, At, B1); PG8_BAR; PG8_SCHED;
            PG8_LDB(B0, 1, 0); PG8_LDB(B1, 1, 1); PG8_SCHED; PG8_LDA(At, 1, 0); PG8_STAGE(PG8_SA(0, 1), a2 + hstep, voffA);
            PG8_WAIT_V(8); PG8_WAIT_L(0); PG8_BAR; PG8_MMA(0, 0, At, B0); PG8_MMA(0, 1, At, B1); PG8_BAR; PG8_SCHED;
            PG8_LDA(At, 1, 1); PG8_STAGE(PG8_SB(1, 0), b3, voffB); PG8_STAGE(PG8_SB(1, 1), b3 + hstep, voffB); PG8_STAGE(PG8_SA(1, 0), a3, voffA);
            PG8_WAIT_V(8); PG8_WAIT_L(0); PG8_BAR; PG8_MMA(1, 0, At, B0); PG8_MMA(1, 1, At, B1); PG8_BAR; PG8_SCHED;
            } else {
            PG8_LDB(B0, 0, 0); PG8_SCHED; PG8_LDA(At, 0, 0); PG8_STAGE(PG8_SA(1, 1), a1 + hstep, voffA);
            PG8_WAIT_L(8); PG8_BAR; PG8_WAIT_L(0); PG8_MMA(0, 0, At, B0); PG8_BAR; PG8_SCHED;
            PG8_LDB(B1, 0, 1); PG8_STAGE(PG8_SB(0, 0), b2, voffB);
            PG8_BAR; PG8_WAIT_L(0); PG8_MMA(0, 1, At, B1); PG8_BAR;
            PG8_LDA(At, 0, 1); PG8_STAGE(PG8_SA(0, 0), a2, voffA);
            PG8_BAR; PG8_WAIT_L(0); PG8_MMA(1, 0, At, B0); PG8_BAR; PG8_SCHED;
            PG8_STAGE(PG8_SB(0, 1), b2 + hstep, voffB);
            PG8_WAIT_V(6); PG8_BAR; PG8_MMA(1, 1, At, B1); PG8_BAR;
            PG8_LDB(B0, 1, 0); PG8_SCHED; PG8_LDA(At, 1, 0); PG8_STAGE(PG8_SA(0, 1), a2 + hstep, voffA);
            PG8_WAIT_L(8); PG8_BAR; PG8_WAIT_L(0); PG8_MMA(0, 0, At, B0); PG8_BAR; PG8_SCHED;
            PG8_LDB(B1, 1, 1); PG8_STAGE(PG8_SB(1, 0), b3, voffB);
            PG8_BAR; PG8_WAIT_L(0); PG8_MMA(0, 1, At, B1); PG8_BAR;
            PG8_LDA(At, 1, 1); PG8_STAGE(PG8_SA(1, 0), a3, voffA);
            PG8_BAR; PG8_WAIT_L(0); PG8_MMA(1, 0, At, B0); PG8_BAR; PG8_SCHED;
            PG8_STAGE(PG8_SB(1, 1), b3 + hstep, voffB);
            PG8_WAIT_V(6); PG8_BAR; PG8_MMA(1, 1, At, B1); PG8_BAR;
            }
        }
        if constexpr (ALIGN_EPI) { if (wr == 0) PG8_BAR; }
        if constexpr (!Epi::AFTER_DRAIN) { E(acc, cur, wr, wc, fr, fq); S.done(cur); }
        if (!has_next) break;
#pragma unroll
        for (int a = 0; a < 2; ++a)
#pragma unroll
            for (int b = 0; b < 2; ++b)
#pragma unroll
                for (int m = 0; m < 4; ++m)
#pragma unroll
                    for (int n = 0; n < 2; ++n) acc[a][b][m][n] = (f32x4){0.f, 0.f, 0.f, 0.f};
        cur = nxt; cA = nA; cB = nB; ++ui;
        if constexpr (ALIGN_EPI) { if (wr == 1) PG8_BAR; }
    }
    PG8_WAIT_V(0);
    if constexpr (!ALIGN_EPI) { if (wr == 0) PG8_BAR; }
    PG8_BAR;
    if constexpr (Epi::AFTER_DRAIN) { E.fused(acc, cur, wr, wc, fr, fq, lds, wid, lane); S.done(cur); }
#undef PG8_SA
#undef PG8_SB
#undef PG8_STAGE
#undef PG8_LDA
#undef PG8_LDB
#undef PG8_MMA
#undef PG8_WAIT_V
#undef PG8_WAIT_L
#undef PG8_BAR
#undef PG8_SCHED
}
}
#define GAS __attribute__((address_space(1)))
#define LAS __attribute__((address_space(3)))
typedef unsigned short bf16;
typedef unsigned v4u __attribute__((ext_vector_type(4)));
typedef float f32x4 __attribute__((ext_vector_type(4)));
typedef short bf16x8 __attribute__((ext_vector_type(8)));
typedef GAS unsigned gu32;
typedef GAS unsigned long long gu64;
#define RLX_AGENT __ATOMIC_RELAXED, __HIP_MEMORY_SCOPE_AGENT
#define LDS_WAIT() asm volatile("s_waitcnt lgkmcnt(0)" ::: "memory")
#define VM_WAIT() asm volatile("s_waitcnt vmcnt(0)" ::: "memory")
__device__ __forceinline__ unsigned long long rt() { return __builtin_amdgcn_s_memrealtime(); }
__device__ __forceinline__ unsigned f2bf(float f) { unsigned u = __builtin_bit_cast(unsigned, f); return (u + 0x7fffu + ((u >> 16) & 1u)) >> 16; }
__device__ __forceinline__ unsigned pk2(float lo, float hi) { return f2bf(lo) | (f2bf(hi) << 16); }

#define XB_TMO      128
#define XB_XCNT(j)  (256  + 64 * (j))
#define XB_XSUB(j)  (1280 + 64 * (j))
#define XB_XGEN(j)  (2304 + 64 * (j))
#define XB_TOP      3328
#define XB_TOPGEN   3392
#define XCD_BAR_WORDS 3456
#define XB_SPIN_CAP (1u << 18)

__device__ __forceinline__ unsigned xb_ld(unsigned* p)              { return __hip_atomic_load(p, __ATOMIC_RELAXED, __HIP_MEMORY_SCOPE_AGENT); }
__device__ __forceinline__ unsigned xb_add(unsigned* p, unsigned v) { return __hip_atomic_fetch_add(p, v, __ATOMIC_RELAXED, __HIP_MEMORY_SCOPE_AGENT); }
__device__ __forceinline__ unsigned xb_xcc_id() { return (unsigned)__builtin_amdgcn_s_getreg((3 << 11) | 20) & 0xFu; }
#define XB_SPIN(cond, bar) do { unsigned _sp = 0; while (cond) { __builtin_amdgcn_s_sleep(1); \
    if ((++_sp & 255u) == 0u) { if (xb_ld(&(bar)[XB_TMO])) break; if (_sp > XB_SPIN_CAP) { atomicAdd(&(bar)[XB_TMO], 1u); break; } } } } while (0)

struct XcdBarrier {
    unsigned* bar; unsigned x;
    volatile LAS unsigned* st;
    bool w0;
};

__device__ __forceinline__ XcdBarrier xcd_barrier_post(unsigned* bar, volatile LAS unsigned* st) {
    XcdBarrier b; b.bar = bar; b.x = xb_xcc_id(); b.st = st;
    if (threadIdx.x == 0) (void)xb_add(&bar[XB_XCNT(b.x)], 1u);
    return b;
}
__device__ __forceinline__ void xcd_barrier_complete(unsigned* bar, unsigned x, unsigned& nloc, unsigned& nx) {
    const unsigned G = gridDim.x * gridDim.y * gridDim.z;
    unsigned sum, cnt, mine, sp = 0u;
    for (;;) {
        sum = 0u; cnt = 0u; mine = 0u;
#pragma unroll
        for (unsigned j = 0; j < 16; ++j) { const unsigned c = xb_ld(&bar[XB_XCNT(j)]); sum += c; cnt += (c > 0u) ? 1u : 0u; mine = (j == x) ? c : mine; }
        if (sum == G) break;
        __builtin_amdgcn_s_sleep(1);
        if ((++sp & 255u) == 0u) { if (xb_ld(&bar[XB_TMO])) break; if (sp > XB_SPIN_CAP) { atomicAdd(&bar[XB_TMO], 1u); break; } }
    }
    nloc = mine > 0u ? mine : 1u; nx = cnt > 0u ? cnt : 1u;
}

__device__ __forceinline__ void xcd_barrier(const XcdBarrier& b) {
    asm volatile("s_waitcnt vmcnt(0)" ::: "memory");
    __syncthreads();
    if (b.w0 && mk_lane_id() == 0) {
        unsigned* bar = b.bar;
        __builtin_amdgcn_s_waitcnt(0);
        unsigned nloc = b.st[0], nx = b.st[1];
        if (nloc == 0u) { xcd_barrier_complete(bar, b.x, nloc, nx); b.st[0] = nloc; b.st[1] = nx; }
        const unsigned old = xb_add(&bar[XB_XSUB(b.x)], 1u);
        const unsigned gen = old / nloc;
        if (old + 1u == (gen + 1u) * nloc) {
            __builtin_amdgcn_fence(__ATOMIC_RELEASE, "agent");
            asm volatile("s_waitcnt vmcnt(0)" ::: "memory");
            const unsigned og = xb_add(&bar[XB_TOP], 1u);
            const unsigned tg = og / nx;
            if (og + 1u == (tg + 1u) * nx) xb_add(&bar[XB_TOPGEN], 1u);
            else XB_SPIN(xb_ld(&bar[XB_TOPGEN]) == tg, bar);
            __builtin_amdgcn_fence(__ATOMIC_ACQUIRE, "agent");
            xb_add(&bar[XB_XGEN(b.x)], 1u);
            asm volatile("s_waitcnt vmcnt(0)" ::: "memory");
        } else {
            XB_SPIN(xb_ld(&bar[XB_XGEN(b.x)]) == gen, bar);
            __builtin_amdgcn_fence(__ATOMIC_ACQUIRE, "agent");
            asm volatile("s_waitcnt vmcnt(0)" ::: "memory");
        }
    }
    __syncthreads();
}

constexpr int DM = 2048, NBAT = 4, SEQ = 2048, DEPTH = 4, NS = 128;
constexpr int MP = NBAT * SEQ;
constexpr int MV = MP + NS;
constexpr int MPAD = 8448;
constexpr int WA = 512, WB = 768, WC = 768, PIN = 6656, DFF = 5632, DPLE = 256, PBW = 2560;
constexpr int OFF_B = 1024, OFF_C = 3584;
constexpr float LN_EPS = 1e-5f, GN_EPS = 64e-5f, RMS_EPS = 1e-6f;
constexpr float DN_ALPHA = 1.681792830507429f;
enum { I_XP = 0, I_XS, I_SRWKV, I_SSHIFT, I_SHGRN, I_PP, I_PS, I_LNING, I_LNINB, I_WIN, I_ALNG, I_ALNB, I_AWS, I_ABS, I_BMU, I_BW0, I_BWUP, I_BA0, I_BAUP, I_BGUP,
       I_BKK, I_BKA, I_BRK, I_BGNG, I_BGNB, I_CLB, I_CNG, I_WOUT, I_LN1G, I_LN1B, I_WG, I_WU, I_WD, I_WPG, I_WPP, I_LN2G, I_LN2B, N_IN };
constexpr size_t O_YP = 0, O_YS = O_YP + (size_t)MP * DM, O_RP = O_YS + (size_t)NS * DM, O_SP = O_RP + (size_t)DEPTH * NBAT * 12 * 4096,
                 O_HP = O_SP + (size_t)DEPTH * NBAT * PBW, O_RS = O_HP + (size_t)DEPTH * NBAT * 6 * 16384, O_SS = O_RS + (size_t)DEPTH * NS * 12 * 4096,
                 O_HS = O_SS + (size_t)DEPTH * NS * PBW, O_VS = O_HS + (size_t)DEPTH * NS * 6 * 16384, O_END = O_VS + (size_t)DEPTH * NS * WA;
static_assert(O_END == 96509952, "output size");
constexpr size_t al256(size_t x) { return (x + 255) & ~(size_t)255; }
constexpr size_t WS_CTL = 0, CTL_ZERO_BYTES = 1u << 20;
constexpr size_t SZ_WIN = (size_t)PIN * DM * 2, SZ_WOUT = (size_t)DM * DM * 2, SZ_WGU = (size_t)2 * DFF * DM * 2, SZ_WD = (size_t)DM * DFF * 2, SZ_WPG = SZ_WOUT, SZ_WPP = (size_t)DM * DPLE * 2;
constexpr size_t WS_WIN = CTL_ZERO_BYTES, WS_WOUT = WS_WIN + DEPTH * SZ_WIN, WS_WGU = WS_WOUT + DEPTH * SZ_WOUT, WS_WD = WS_WGU + DEPTH * SZ_WGU, WS_WPG = WS_WD + DEPTH * SZ_WD,
                 WS_WPP = WS_WPG + DEPTH * SZ_WPG, WS_PBF = WS_WPP + DEPTH * SZ_WPP;
constexpr size_t SZ_PBF = (size_t)MPAD * DPLE * 2;
constexpr size_t WS_H = WS_PBF + DEPTH * SZ_PBF, WS_HB = WS_H + (size_t)MPAD * DM * 4, WS_T = WS_HB + (size_t)MPAD * DM * 2, WS_YMIX = WS_T + (size_t)MPAD * DM * 4;
constexpr size_t WS_Z = WS_YMIX + (size_t)MPAD * DM * 2;
constexpr size_t WS_ACT = WS_Z, WS_PLE = WS_ACT + al256((size_t)MPAD * DFF * 2);
constexpr size_t WS_PPO = WS_Z + (size_t)MPAD * PIN * 4;
static_assert(WS_PLE + (size_t)MPAD * DM * 4 <= WS_PPO, "overlay fits");
constexpr size_t WS_RPB = WS_PPO + (size_t)MPAD * DM * 4;
constexpr size_t WS_RPS = WS_RPB + (size_t)NBAT * 12 * (SEQ / 16) * 16384;
constexpr int NLORA = 3 * WB;
constexpr size_t SZ_WL = (size_t)NLORA * 256 * 2;
constexpr size_t WS_WL = WS_RPS + (size_t)NS * 12 * 384 * 4;
constexpr size_t WS_XCAT = WS_WL + DEPTH * SZ_WL;
constexpr size_t WS_LORA = WS_XCAT + (size_t)MPAD * 256 * 2;
constexpr size_t WS_Y = WS_LORA + (size_t)MPAD * NLORA * 4;
constexpr size_t WS_O = WS_Y + (size_t)MPAD * WB * 4;
constexpr size_t WS_HREC = WS_O + (size_t)MPAD * WC * 4;
constexpr size_t WS_END = WS_HREC + (size_t)NBAT * 6 * (SEQ / 16) * 17408;
static_assert(WS_WIN % 256 == 0 && WS_H % 256 == 0 && WS_Z % 256 == 0 && WS_RPB % 256 == 0 && WS_WL % 256 == 0 && WS_XCAT % 256 == 0 && WS_LORA % 256 == 0 && WS_Y % 256 == 0, "alignment");
constexpr int CW_BAR = 4096;

constexpr int RING_BYTES = 131072, LDSCTL_OFF = RING_BYTES, MISC_OFF = LDSCTL_OFF + 320, LDS_BYTES = 147456;
constexpr int NWAVES = 8, NTHR = 512;

struct Args { const float* in[N_IN]; float* out; unsigned char* ws; int ph_lo, ph_hi; };
static_assert(sizeof(Args) == (N_IN + 2) * 8 + 8, "no padding in Args");
typedef const __attribute__((address_space(4))) Args* ArgsP;

typedef float f4 __attribute__((ext_vector_type(4)));
typedef float f2 __attribute__((ext_vector_type(2)));
typedef unsigned u2 __attribute__((ext_vector_type(2)));

__device__ __forceinline__ float wave_sum(float v) {
#pragma unroll
    for (int o = 1; o < 64; o <<= 1) v += __shfl_xor(v, o);
    return v;
}
template <int CTRL> __device__ __forceinline__ float dpp_f(float x) { return __builtin_bit_cast(float, __builtin_amdgcn_update_dpp(0, __builtin_bit_cast(int, x), CTRL, 0xF, 0xF, true)); }
__device__ __forceinline__ float row16_sum(float x) {
    x += dpp_f<0xB1>(x);
    x += dpp_f<0x4E>(x);
    x += dpp_f<0x141>(x);
    x += dpp_f<0x140>(x);
    return x;
}
__device__ __forceinline__ float sigmoidf_(float x) { return 1.0f / (1.0f + expf(-x)); }
__device__ __forceinline__ float gelu_erf(float x) { return 0.5f * x * (1.0f + erff(x * 0.70710678118654752f)); }
__device__ __forceinline__ unsigned short bf1(float x) { return (unsigned short)(cvt_pk_bf16_c(x, 0.f) & 0xffffu); }
__device__ __forceinline__ float lbound(const float* clb, int L, int c) {
    const float x0 = clb[c], x1 = clb[WC + c], x2 = clb[2 * WC + c], x3 = clb[3 * WC + c];
    const float mx = fmaxf(fmaxf(x0, x1), fmaxf(x2, x3));
    const float e0 = expf(x0 - mx), e1 = expf(x1 - mx), e2 = expf(x2 - mx), e3 = expf(x3 - mx);
    float s = 0.f; if (L >= 1) s += e1; if (L >= 2) s += e2; if (L >= 3) s += e3;
    return s / (e0 + e1 + e2 + e3);
}
__device__ __forceinline__ float log_sigmoid(float x) { return fminf(x, 0.f) - log1pf(expf(-fabsf(x))); }

__device__ __forceinline__ void tr_item(const float* W, int K, int N, bf16* WT, int mode, LAS float* scr, int item, int lane) {
    const int nblk = N >> 5, kb = item / nblk, nb = item - kb * nblk, k0 = kb << 6, n0 = nb << 5;
    int rb = n0; if (mode) rb = ((n0 >> 7) << 8) + (n0 & 127) + (mode == 2 ? 128 : 0);
#pragma unroll 8
    for (int i = 0; i < 32; ++i) { const int kk = 2 * i + (lane >> 5); scr[kk * 33 + (lane & 31)] = W[(size_t)(k0 + kk) * N + n0 + (lane & 31)]; }
    LDS_WAIT(); asm volatile("" ::: "memory");
    const int c = lane & 7;
#pragma unroll
    for (int j = 0; j < 4; ++j) { const int n = (lane >> 3) + 8 * j; const LAS float* s = scr + (8 * c) * 33 + n;
        v4u o; o.x = pg8::cvt_pk_bf16(s[0 * 33], s[1 * 33]); o.y = pg8::cvt_pk_bf16(s[2 * 33], s[3 * 33]); o.z = pg8::cvt_pk_bf16(s[4 * 33], s[5 * 33]); o.w = pg8::cvt_pk_bf16(s[6 * 33], s[7 * 33]);
        *(v4u*)(WT + (size_t)(rb + n) * K + k0 + 8 * c) = o; }
    LDS_WAIT(); asm volatile("" ::: "memory");
}
__device__ __forceinline__ void ln_row(const float* src, const float* g, const float* b, float* dstf, bf16* dstb, float* dst2, int lane) {
    f4 v[8]; float s = 0.f;
#pragma unroll
    for (int j = 0; j < 8; ++j) { v[j] = *(const f4*)(src + 4 * (lane + 64 * j)); s += (v[j].x + v[j].y) + (v[j].z + v[j].w); }
    const float mean = wave_sum(s) * (1.f / DM); float s2 = 0.f;
#pragma unroll
    for (int j = 0; j < 8; ++j) { v[j] = v[j] - mean; s2 += (v[j].x * v[j].x + v[j].y * v[j].y) + (v[j].z * v[j].z + v[j].w * v[j].w); }
    const float rstd = 1.0f / sqrtf(wave_sum(s2) * (1.f / DM) + LN_EPS);
#pragma unroll
    for (int j = 0; j < 8; ++j) { const int c = 4 * (lane + 64 * j); const f4 gg = *(const f4*)(g + c), bb = *(const f4*)(b + c); const f4 o = v[j] * rstd * gg + bb;
        *(f4*)(dstf + c) = o; if (dst2) *(f4*)(dst2 + c) = o;
        u2 w; w.x = pg8::cvt_pk_bf16(o.x, o.y); w.y = pg8::cvt_pk_bf16(o.z, o.w); *(u2*)(dstb + c) = w; }
}
__device__ __forceinline__ void phase_prologue(ArgsP a, LAS unsigned char* lds, int lane, int wave, int blk, int G) {
    LAS float* scr = (LAS float*)(lds + wave * 16384);
    const int gw = blk * NWAVES + wave, NGW = G * NWAVES;
    constexpr int I_IN = 32 * (PIN / 32), I_OUT = 32 * (DM / 32), I_G = 32 * (DFF / 32), I_D = (DFF / 64) * (DM / 32), I_PGc = I_OUT, I_PPc = (DPLE / 64) * (DM / 32);
    constexpr int PER_L = I_IN + I_OUT + 2 * I_G + I_D + I_PGc + I_PPc;
    unsigned char* ws = a->ws;
    for (int it = gw; it < DEPTH * PER_L; it += NGW) {
        const int L = it / PER_L; int r = it - L * PER_L;
        if (r < I_IN) { tr_item(a->in[I_WIN] + (size_t)L * DM * PIN, DM, PIN, (bf16*)(ws + WS_WIN + L * SZ_WIN), 0, scr, r, lane); continue; } r -= I_IN;
        if (r < I_OUT) { tr_item(a->in[I_WOUT] + (size_t)L * DM * DM, DM, DM, (bf16*)(ws + WS_WOUT + L * SZ_WOUT), 0, scr, r, lane); continue; } r -= I_OUT;
        if (r < I_G) { tr_item(a->in[I_WG] + (size_t)L * DM * DFF, DM, DFF, (bf16*)(ws + WS_WGU + L * SZ_WGU), 1, scr, r, lane); continue; } r -= I_G;
        if (r < I_G) { tr_item(a->in[I_WU] + (size_t)L * DM * DFF, DM, DFF, (bf16*)(ws + WS_WGU + L * SZ_WGU), 2, scr, r, lane); continue; } r -= I_G;
        if (r < I_D) { tr_item(a->in[I_WD] + (size_t)L * DFF * DM, DFF, DM, (bf16*)(ws + WS_WD + L * SZ_WD), 0, scr, r, lane); continue; } r -= I_D;
        if (r < I_PGc) { tr_item(a->in[I_WPG] + (size_t)L * DM * DM, DM, DM, (bf16*)(ws + WS_WPG + L * SZ_WPG), 0, scr, r, lane); continue; } r -= I_PGc;
        tr_item(a->in[I_WPP] + (size_t)L * DPLE * DM, DPLE, DM, (bf16*)(ws + WS_WPP + L * SZ_WPP), 0, scr, r, lane);
    }
    for (int it = gw; it < DEPTH * NLORA; it += NGW) { const int L = it / NLORA, n = it - L * NLORA; float v[4];
#pragma unroll
        for (int e = 0; e < 4; ++e) { const int k = 4 * lane + e; float x = 0.f;
            if (n < WB) { if (k < 64) x = a->in[I_BWUP][((size_t)L * 64 + k) * WB + n]; }
            else if (n < 2 * WB) { if (k >= 64 && k < 128) x = a->in[I_BAUP][((size_t)L * 64 + (k - 64)) * WB + (n - WB)]; }
            else { if (k >= 128) x = a->in[I_BGUP][((size_t)L * 128 + (k - 128)) * WB + (n - 2 * WB)]; }
            v[e] = x; }
        u2 w; w.x = pg8::cvt_pk_bf16(v[0], v[1]); w.y = pg8::cvt_pk_bf16(v[2], v[3]); *(u2*)((bf16*)(ws + WS_WL + L * SZ_WL) + (size_t)n * 256 + 4 * lane) = w; }
    for (int it = gw; it < DEPTH * MV; it += NGW) { const int L = it / MV, m = it - L * MV;
        const float* src = (m < MP) ? a->in[I_PP] + ((size_t)L * MP + m) * DPLE : a->in[I_PS] + ((size_t)L * NS + (m - MP)) * DPLE;
        const f4 v = *(const f4*)(src + 4 * lane); u2 w; w.x = pg8::cvt_pk_bf16(v.x, v.y); w.y = pg8::cvt_pk_bf16(v.z, v.w);
        *(u2*)((bf16*)(ws + WS_PBF + L * SZ_PBF) + (size_t)m * DPLE + 4 * lane) = w; }
    for (int m = gw; m < MV; m += NGW) { const float* src = (m < MP) ? a->in[I_XP] + (size_t)m * DM : a->in[I_XS] + (size_t)(m - MP) * DM;
        ln_row(src, a->in[I_LNING], a->in[I_LNINB], (float*)(ws + WS_H) + (size_t)m * DM, (bf16*)(ws + WS_HB) + (size_t)m * DM, nullptr, lane); }
}
__device__ __forceinline__ void phase_ln(ArgsP a, const float* g, const float* b, bool last, int lane, int wave, int blk, int G) {
    const int gw = blk * NWAVES + wave, NGW = G * NWAVES; unsigned char* ws = a->ws;
    for (int m = gw; m < MV; m += NGW)
        ln_row((const float*)(ws + WS_T) + (size_t)m * DM, g, b, (float*)(ws + WS_H) + (size_t)m * DM, (bf16*)(ws + WS_HB) + (size_t)m * DM,
               last ? a->out + (m < MP ? O_YP + (size_t)m * DM : O_YS + (size_t)(m - MP) * DM) : nullptr, lane);
}


__device__ __forceinline__ void phase_xc(ArgsP a, int L, int lane, int wave, int blk, int G) {
    unsigned char* ws = a->ws; const int gw = blk * NWAVES + wave, NGW = G * NWAVES;
    const float* Z = (const float*)(ws + WS_Z);
    const float* mu = a->in[I_BMU] + L * PBW; const float* sh0 = a->in[I_SSHIFT] + (size_t)L * NS * PBW;
    const f4 mu4 = *(const f4*)(mu + 2304 + 4 * lane);
    for (int m = gw; m < MV; m += NGW) {
        const bool samp = m >= MP; const float* zr = Z + (size_t)m * PIN + OFF_B;
        const f4 cur = *(const f4*)(zr + 2304 + 4 * lane); f4 prev;
        if (samp) prev = *(const f4*)(sh0 + (size_t)(m - MP) * PBW + 2304 + 4 * lane); else if (m & (SEQ - 1)) prev = *(const f4*)(zr - PIN + 2304 + 4 * lane); else prev = (f4){0.f, 0.f, 0.f, 0.f};
        f4 x = cur + mu4 * (prev - cur);
        if (lane < 16) { x.x = tanhf(x.x); x.y = tanhf(x.y); x.z = tanhf(x.z); x.w = tanhf(x.w); }
        else if (lane >= 32) { x.x = sigmoidf_(x.x); x.y = sigmoidf_(x.y); x.z = sigmoidf_(x.z); x.w = sigmoidf_(x.w); }
        u2 w; w.x = pg8::cvt_pk_bf16(x.x, x.y); w.y = pg8::cvt_pk_bf16(x.z, x.w); *(u2*)((bf16*)(ws + WS_XCAT) + (size_t)m * 256 + 4 * lane) = w;
        if (samp || (m & (SEQ - 1)) == SEQ - 1) { float* dst = samp ? a->out + O_SS + ((size_t)L * NS + (m - MP)) * PBW : a->out + O_SP + ((size_t)L * NBAT + (m >> 11)) * PBW;
#pragma unroll
            for (int j = 0; j < PBW / 256; ++j) *(f4*)(dst + 256 * j + 4 * lane) = *(const f4*)(zr + 256 * j + 4 * lane); }
        if (samp) { const int i = m - MP; const float* z0 = Z + (size_t)m * PIN; const float* lng = a->in[I_ALNG] + L * WA; const float* lnb = a->in[I_ALNB] + L * WA;
            for (int g = 0; g < 4; ++g) {
                const float u0 = gelu_erf(z0[g * 128 + lane]), u1 = gelu_erf(z0[g * 128 + 64 + lane]);
                const float v0 = gelu_erf(z0[WA + g * 128 + lane]), v1 = gelu_erf(z0[WA + g * 128 + 64 + lane]);
                const float mean = wave_sum(v0 + v1) * (1.f / 128.f); const float d0 = v0 - mean, d1 = v1 - mean;
                const float rstd = 1.0f / sqrtf(wave_sum(d0 * d0 + d1 * d1) * (1.f / 128.f) + LN_EPS);
                const float n0 = d0 * rstd * lng[g * 128 + lane] + lnb[g * 128 + lane], n1 = d1 * rstd * lng[g * 128 + 64 + lane] + lnb[g * 128 + 64 + lane];
                float* ov = a->out + O_VS + ((size_t)L * NS + i) * WA + g * 128; ov[lane] = n0; ov[64 + lane] = n1;
                const float w00 = a->in[I_AWS][(size_t)(L * 4 + g) * 16384], b0 = a->in[I_ABS][(L * 4 + g) * 128];
                bf16* yo = (bf16*)(ws + WS_YMIX) + (size_t)m * DM + g * 128; yo[lane] = bf1(u0 * (w00 * n0 + b0)); yo[64 + lane] = bf1(u1 * (w00 * n1 + b0)); } }
    }
}
__device__ __forceinline__ void phase_fin(ArgsP a, int L, int lane, int wave, int blk, int G) {
    unsigned char* ws = a->ws; const int gw = blk * NWAVES + wave, NGW = G * NWAVES;
    const float* Z = (const float*)(ws + WS_Z); const float* LO = (const float*)(ws + WS_LORA);
    const float* mu = a->in[I_BMU] + L * PBW; const float* w0 = a->in[I_BW0] + L * WB; const float* a0 = a->in[I_BA0] + L * WB;
    const float* k_k = a->in[I_BKK] + L * WB; const float* k_a = a->in[I_BKA] + L * WB; const float* sh0 = a->in[I_SSHIFT] + (size_t)L * NS * PBW;
    for (int m = MP + gw; m < MV; m += NGW) {
        const bool samp = m >= MP; const float* zr = Z + (size_t)m * PIN + OFF_B; const float* lo = LO + (size_t)m * NLORA;
        const float* pz = samp ? sh0 + (size_t)(m - MP) * PBW : zr - PIN; const bool first = !samp && (m & (SEQ - 1)) == 0;
#pragma unroll 4
        for (int j = 0; j < 12; ++j) { const int c = 64 * j + lane;
            const float cr = zr[c], ck = zr[WB + c], cv = zr[2 * WB + c];
            float pr = 0.f, pk = 0.f, pv = 0.f; if (!first) { pr = pz[c]; pk = pz[WB + c]; pv = pz[2 * WB + c]; }
            const float r = cr + mu[c] * (pr - cr), k = ck + mu[WB + c] * (pk - ck), v = cv + mu[2 * WB + c] * (pv - cv);
            const float dec = __expf(-0.6065306597126334f * sigmoidf_(w0[c] + lo[c]));
            const float av = sigmoidf_(a0[c] + lo[WB + c]);
            const float kkr = k * k_k[c]; const float ss = wave_sum(kkr * kkr); const float kk = kkr / fmaxf(sqrtf(ss), 1e-12f);
            const float kp = k * (1.0f + (av - 1.0f) * k_a[c]);
            float* rec = samp ? (float*)(ws + WS_RPS) + ((size_t)(m - MP) * 12 + j) * 384 : (float*)(ws + WS_RPB) + (((size_t)(m >> 11) * 12 + j) * SEQ + (m & (SEQ - 1))) * 384;
            rec[lane] = r; rec[64 + lane] = dec; rec[128 + lane] = kp; rec[192 + lane] = v; rec[256 + lane] = kk; rec[320 + lane] = kk * av; }
    }
}

__device__ __forceinline__ void rwkv_scan_unit(ArgsP a, int L, int unit, LAS unsigned char* lds, int tid, int lane, int wave) {
    unsigned char* ws = a->ws;
    const int bh = unit >> 1, half = unit & 1, b = bh / 12, h = bh - b * 12;
    const f4* rec4 = (const f4*)((const float*)(ws + WS_RPB) + (size_t)bh * SEQ * 384);
    LAS float* buf = (LAS float*)lds;
    LAS float* ybuf = (LAS float*)(lds + 49152);
    const int rowl = wave * 4 + (lane >> 4), kg = lane & 15, row = half * 32 + rowl;
    float S0 = 0.f, S1 = 0.f, S2 = 0.f, S3 = 0.f;
    f4 st0, st1, st2;
    __syncthreads();
    st0 = rec4[tid]; st1 = rec4[512 + tid]; st2 = rec4[1024 + tid];
    *(LAS f4*)(buf + 4 * tid) = st0; *(LAS f4*)(buf + 4 * (512 + tid)) = st1; *(LAS f4*)(buf + 4 * (1024 + tid)) = st2;
    __syncthreads();
    float* Y = (float*)(ws + WS_Y);
    for (int c = 0; c < SEQ / 16; ++c) {
        if (c + 1 < SEQ / 16) { const f4* nx = rec4 + (size_t)(c + 1) * 1536; st0 = nx[tid]; st1 = nx[512 + tid]; st2 = nx[1024 + tid]; }
        const LAS float* cur = buf + (c & 1) * 6144; LAS float* yb = ybuf + (c & 1) * 512;
        f4 r4 = *(const LAS f4*)(cur + 4 * kg), w4 = *(const LAS f4*)(cur + 64 + 4 * kg), k4 = *(const LAS f4*)(cur + 128 + 4 * kg),
           kk4 = *(const LAS f4*)(cur + 256 + 4 * kg), ka4 = *(const LAS f4*)(cur + 320 + 4 * kg); float v = cur[192 + row];
#pragma unroll
        for (int s = 0; s < 16; ++s) {
            const LAS float* R = cur + (s < 15 ? s + 1 : 15) * 384;
            const f4 nr4 = *(const LAS f4*)(R + 4 * kg), nw4 = *(const LAS f4*)(R + 64 + 4 * kg), nk4 = *(const LAS f4*)(R + 128 + 4 * kg),
                     nkk4 = *(const LAS f4*)(R + 256 + 4 * kg), nka4 = *(const LAS f4*)(R + 320 + 4 * kg);
            const float nv = R[192 + row];
            float sa = (S0 * kk4.x + S1 * kk4.y) + (S2 * kk4.z + S3 * kk4.w);
            sa = row16_sum(sa);
            S0 = S0 * w4.x + (v * k4.x - sa * ka4.x); S1 = S1 * w4.y + (v * k4.y - sa * ka4.y);
            S2 = S2 * w4.z + (v * k4.z - sa * ka4.z); S3 = S3 * w4.w + (v * k4.w - sa * ka4.w);
            float y = (S0 * r4.x + S1 * r4.y) + (S2 * r4.z + S3 * r4.w);
            y = row16_sum(y);
            if (kg == 0) yb[s * 32 + rowl] = y;
            r4 = nr4; w4 = nw4; k4 = nk4; kk4 = nkk4; ka4 = nka4; v = nv;
        }
        if (c + 1 < SEQ / 16) { LAS float* nb = buf + ((c + 1) & 1) * 6144;
            *(LAS f4*)(nb + 4 * tid) = st0; *(LAS f4*)(nb + 4 * (512 + tid)) = st1; *(LAS f4*)(nb + 4 * (1024 + tid)) = st2; }
        __syncthreads();
        { const int s = tid >> 5, rl = tid & 31; Y[((size_t)b * SEQ + c * 16 + s) * WB + h * 64 + half * 32 + rl] = yb[tid]; }
    }
    f4 so; so.x = S0; so.y = S1; so.z = S2; so.w = S3;
    *(f4*)(a->out + O_RP + ((((size_t)L * NBAT + b) * 12 + h) * 64 + row) * 64 + 4 * kg) = so;
    __syncthreads();
}
__device__ __forceinline__ void rwkv_sample_item(ArgsP a, int L, int item, LAS unsigned char* lds, int lane, int wave) {
    unsigned char* ws = a->ws;
    const int ih = item * 8 + wave, i = ih / 12, h = ih - i * 12;
    const float* rec = (const float*)(ws + WS_RPS) + (size_t)ih * 384;
    LAS float* sc = (LAS float*)(lds + wave * 2048);
    const float r = rec[lane], w = rec[64 + lane], k = rec[128 + lane], v = rec[192 + lane], kk = rec[256 + lane], ka = rec[320 + lane];
    sc[lane] = r; sc[64 + lane] = w; sc[128 + lane] = k; sc[192 + lane] = kk; sc[256 + lane] = ka;
    LDS_WAIT(); asm volatile("" ::: "memory");
    const f4* S0p = (const f4*)(a->in[I_SRWKV] + (((size_t)L * NS + i) * 12 + h) * 4096 + lane * 64);
    f4 S[16];
#pragma unroll
    for (int j = 0; j < 16; ++j) S[j] = S0p[j];
    float sa = 0.f;
#pragma unroll
    for (int j = 0; j < 16; ++j) { const f4 q = *(const LAS f4*)(sc + 192 + 4 * j); sa += (S[j].x * q.x + S[j].y * q.y) + (S[j].z * q.z + S[j].w * q.w); }
    float y = 0.f;
    f4* So = (f4*)(a->out + O_RS + (((size_t)L * NS + i) * 12 + h) * 4096 + lane * 64);
#pragma unroll
    for (int j = 0; j < 16; ++j) { const f4 w4 = *(const LAS f4*)(sc + 64 + 4 * j), k4 = *(const LAS f4*)(sc + 128 + 4 * j), a4 = *(const LAS f4*)(sc + 256 + 4 * j), r4 = *(const LAS f4*)(sc + 4 * j);
        f4 n = S[j] * w4 + (k4 * v - a4 * sa); So[j] = n; y += (n.x * r4.x + n.y * r4.y) + (n.z * r4.z + n.w * r4.w); }
    ((float*)(ws + WS_Y))[(size_t)(MP + i) * WB + h * 64 + lane] = y;
    LDS_WAIT(); asm volatile("" ::: "memory");
}
__device__ __forceinline__ void hgrn_sample_item(ArgsP a, int L, int item, LAS unsigned char* lds, int lane, int wave) {
    unsigned char* ws = a->ws;
    const int ih = item * 4 + (wave >> 1), i = ih / 6, h = ih - i * 6, vcol = (wave & 1) * 64 + lane, m = MP + i;
    const float* zc = (const float*)(ws + WS_Z) + (size_t)m * PIN + OFF_C + h * 128;
    LAS float* sc = (LAS float*)(lds + wave * 2048);
#pragma unroll
    for (int t = 0; t < 2; ++t) { const int k = lane + 64 * t; const float lb = lbound(a->in[I_CLB], L, h * 128 + k); const float fz = zc[WC + k];
        const float sg = sigmoidf_(fz); sc[k] = lb + (1.0f - lb) * sg; sc[128 + k] = (1.0f - lb) * (1.0f - sg) ; sc[256 + k] = zc[k]; }
    const float iv = zc[2 * WC + vcol];
    LDS_WAIT(); asm volatile("" ::: "memory");
    const float* S0 = a->in[I_SHGRN] + (((size_t)L * NS + i) * 6 + h) * 16384 + vcol;
    float* So = a->out + O_HS + (((size_t)L * NS + i) * 6 + h) * 16384 + vcol;
    float o = 0.f;
#pragma unroll 8
    for (int k = 0; k < 128; ++k) { const float n = sc[k] * S0[(size_t)k * 128] + sc[128 + k] * iv; So[(size_t)k * 128] = n; o += n * sc[256 + k]; }
    ((float*)(ws + WS_O))[(size_t)m * WC + h * 128 + vcol] = o;
    LDS_WAIT(); asm volatile("" ::: "memory");
}
__device__ __forceinline__ void sgu_item(ArgsP a, int L, int item, LAS unsigned char* lds, int tid, int lane, int wave) {
    unsigned char* ws = a->ws;
    const int g = item & 3, bc = item >> 2, m0 = bc * 128;
    const float* Z = (const float*)(ws + WS_Z);
    LAS float* vn = (LAS float*)lds;
    LAS float* wt = (LAS float*)(lds + 65536);
    const float* wsrc = a->in[I_AWS] + (size_t)(L * 4 + g) * 16384;
    __syncthreads();
    for (int e = tid; e < 16384; e += NTHR) { const int t = e >> 7, s = e & 127; wt[s * 128 + t] = (s <= t) ? wsrc[e] : 0.f; }
    const float* lng = a->in[I_ALNG] + L * WA + g * 128; const float* lnb = a->in[I_ALNB] + L * WA + g * 128;
    for (int rr = 0; rr < 16; ++rr) { const int t = wave * 16 + rr; const float* zr = Z + (size_t)(m0 + t) * PIN + WA + g * 128;
        const float v0 = gelu_erf(zr[lane]), v1 = gelu_erf(zr[64 + lane]);
        const float mean = wave_sum(v0 + v1) * (1.f / 128.f); const float d0 = v0 - mean, d1 = v1 - mean;
        const float rstd = 1.0f / sqrtf(wave_sum(d0 * d0 + d1 * d1) * (1.f / 128.f) + LN_EPS);
        vn[t * 128 + lane] = d0 * rstd * lng[lane] + lnb[lane]; vn[t * 128 + 64 + lane] = d1 * rstd * lng[64 + lane] + lnb[64 + lane]; }
    __syncthreads();
    const int t = tid >> 2, dq = tid & 3, send = (wave * 16 + 15);
    f4 acc[8];
#pragma unroll
    for (int j = 0; j < 8; ++j) acc[j] = (f4){0.f, 0.f, 0.f, 0.f};
    for (int s = 0; s <= send; ++s) { const float w = wt[s * 128 + t]; const LAS f4* vr = (const LAS f4*)(vn + s * 128 + dq * 32);
#pragma unroll
        for (int j = 0; j < 8; ++j) acc[j] += vr[j] * w; }
    const float bs = a->in[I_ABS][(L * 4 + g) * 128 + t];
    const float* ur = Z + (size_t)(m0 + t) * PIN + g * 128 + dq * 32;
    bf16* yo = (bf16*)(ws + WS_YMIX) + (size_t)(m0 + t) * DM + g * 128 + dq * 32;
#pragma unroll
    for (int j = 0; j < 4; ++j) { const f4 u0 = *(const f4*)(ur + 8 * j), u1 = *(const f4*)(ur + 8 * j + 4); const f4 x0 = acc[2 * j] + bs, x1 = acc[2 * j + 1] + bs; v4u o;
        o.x = pg8::cvt_pk_bf16(gelu_erf(u0.x) * x0.x, gelu_erf(u0.y) * x0.y); o.y = pg8::cvt_pk_bf16(gelu_erf(u0.z) * x0.z, gelu_erf(u0.w) * x0.w);
        o.z = pg8::cvt_pk_bf16(gelu_erf(u1.x) * x1.x, gelu_erf(u1.y) * x1.y); o.w = pg8::cvt_pk_bf16(gelu_erf(u1.z) * x1.z, gelu_erf(u1.w) * x1.w);
        *(v4u*)(yo + 8 * j) = o; }
}

__device__ __forceinline__ void hgrn_seq_unit(ArgsP a, int L, int unit, LAS unsigned char* lds, int tid, int lane, int wave) {
    unsigned char* ws = a->ws;
    const int b = unit / 6, h = unit - b * 6;
    const float* Z = (const float*)(ws + WS_Z);
    LAS bf16* qs = (LAS bf16*)(lds);
    LAS bf16* ks = (LAS bf16*)(lds + 4352);
    LAS bf16* vt = (LAS bf16*)(lds + 8704);
    LAS bf16* kht = (LAS bf16*)(lds + 12800);
    LAS float* ev = (LAS float*)(lds + 16896);
    LAS float* part = (LAS float*)(lds + 17408);
    const int ch = tid & 127, tq = tid >> 7;
    const float lb = lbound(a->in[I_CLB], L, h * 128 + ch), oml = 1.0f - lb;
    const int pch = (ch & ~31) | (((ch >> 2) & 3) << 3) | (((ch >> 4) & 1) << 2) | (ch & 3);
    const int x = lane & 15, quad = lane >> 4;
    pg8::f32x4 Sacc[8];
#pragma unroll
    for (int mt = 0; mt < 8; ++mt) Sacc[mt] = (pg8::f32x4){0.f, 0.f, 0.f, 0.f};
    const float* zb = Z + (size_t)(b * SEQ + 4 * tq) * PIN + OFF_C + h * 128 + ch;
    float qn[4], fn[4], vn_[4];
#pragma unroll
    for (int j = 0; j < 4; ++j) { const float* p = zb + (size_t)j * PIN; qn[j] = p[0]; fn[j] = p[WC]; vn_[j] = p[2 * WC]; }
    float* O = (float*)(ws + WS_O);
    __syncthreads();
    for (int st = 0; st < SEQ / 16; ++st) {
        float q[4], fz[4], iv[4];
#pragma unroll
        for (int j = 0; j < 4; ++j) { q[j] = qn[j]; fz[j] = fn[j]; iv[j] = vn_[j]; }
        if (st + 1 < SEQ / 16) {
#pragma unroll
            for (int j = 0; j < 4; ++j) { const float* p = zb + (size_t)((st + 1) * 16 + j) * PIN; qn[j] = p[0]; fn[j] = p[WC]; vn_[j] = p[2 * WC]; } }
        float bl[4], kv[4]; float run = 0.f;
#pragma unroll
        for (int j = 0; j < 4; ++j) { const float e = __expf(-fmaxf(fz[j], -80.f)), sg = __builtin_amdgcn_rcpf(1.0f + e);
            run += __logf(lb + oml * sg); bl[j] = run; kv[j] = oml * e * sg; }
        part[tq * 128 + ch] = run;
        asm volatile("s_waitcnt lgkmcnt(0)" ::: "memory"); __builtin_amdgcn_s_barrier(); asm volatile("" ::: "memory");
        const float p0 = part[ch], p1 = part[128 + ch], p2 = part[256 + ch], p3 = part[384 + ch];
        const float tot = (p0 + p1) + (p2 + p3); const float pre = (tq > 0 ? p0 : 0.f) + (tq > 1 ? p1 : 0.f) + (tq > 2 ? p2 : 0.f);
        float kh[4];
#pragma unroll
        for (int j = 0; j < 4; ++j) { const float bj = pre + bl[j]; const int t = 4 * tq + j;
            qs[t * 136 + pch] = bf1(q[j] * __expf(bj)); ks[t * 136 + pch] = bf1(kv[j] * __expf(fminf(-bj, 60.f))); kh[j] = kv[j] * __expf(tot - bj); }
        { u2 w; w.x = cvt_pk_bf16_c(kh[0], kh[1]); w.y = cvt_pk_bf16_c(kh[2], kh[3]); *(LAS u2*)(kht + ch * 16 + 4 * tq) = w;
          w.x = cvt_pk_bf16_c(iv[0], iv[1]); w.y = cvt_pk_bf16_c(iv[2], iv[3]); *(LAS u2*)(vt + ch * 16 + 4 * tq) = w; }
        if (tq == 0) ev[ch] = __expf(tot);
        asm volatile("s_waitcnt lgkmcnt(0)" ::: "memory"); __builtin_amdgcn_s_barrier(); asm volatile("" ::: "memory");
        bf16x8 qf[4], kf[4];
#pragma unroll
        for (int kt = 0; kt < 4; ++kt) { qf[kt] = *(const LAS bf16x8*)(qs + x * 136 + 32 * kt + 8 * quad); kf[kt] = *(const LAS bf16x8*)(ks + x * 136 + 32 * kt + 8 * quad); }
        pg8::f32x4 att = (pg8::f32x4){0.f, 0.f, 0.f, 0.f};
#pragma unroll
        for (int kt = 0; kt < 4; ++kt) att = __builtin_amdgcn_mfma_f32_16x16x32_bf16(kf[kt], qf[kt], att, 0, 0, 0);
#pragma unroll
        for (int i = 0; i < 4; ++i) if (4 * quad + i > x) att[i] = 0.f;
        v4u pbu; pbu.x = cvt_pk_bf16_c(att[0], att[1]); pbu.y = cvt_pk_bf16_c(att[2], att[3]); pbu.z = 0u; pbu.w = 0u;
        const bf16x8 pb = __builtin_bit_cast(bf16x8, pbu);
        const u2 vv = *(const LAS u2*)(vt + (16 * wave + x) * 16 + 4 * quad);
        v4u vfu; vfu.x = vv.x; vfu.y = vv.y; vfu.z = 0u; vfu.w = 0u; const bf16x8 vf = __builtin_bit_cast(bf16x8, vfu);
        pg8::f32x4 o = (pg8::f32x4){0.f, 0.f, 0.f, 0.f};
#pragma unroll
        for (int kt = 0; kt < 4; ++kt) { v4u su; su.x = cvt_pk_bf16_c(Sacc[2 * kt][0], Sacc[2 * kt][1]); su.y = cvt_pk_bf16_c(Sacc[2 * kt][2], Sacc[2 * kt][3]);
            su.z = cvt_pk_bf16_c(Sacc[2 * kt + 1][0], Sacc[2 * kt + 1][1]); su.w = cvt_pk_bf16_c(Sacc[2 * kt + 1][2], Sacc[2 * kt + 1][3]);
            o = __builtin_amdgcn_mfma_f32_16x16x32_bf16(__builtin_bit_cast(bf16x8, su), qf[kt], o, 0, 0, 0); }
        o = __builtin_amdgcn_mfma_f32_16x16x32_bf16(vf, pb, o, 0, 0, 0);
        *(pg8::f32x4*)(O + (size_t)(b * SEQ + st * 16 + x) * WC + h * 128 + 16 * wave + 4 * quad) = o;
#pragma unroll
        for (int mt = 0; mt < 8; ++mt) { const pg8::f32x4 e4 = *(const LAS pg8::f32x4*)(ev + 16 * mt + 4 * quad);
            const u2 kk2 = *(const LAS u2*)(kht + (16 * mt + x) * 16 + 4 * quad); v4u ku; ku.x = kk2.x; ku.y = kk2.y; ku.z = 0u; ku.w = 0u;
            Sacc[mt] = __builtin_amdgcn_mfma_f32_16x16x32_bf16(__builtin_bit_cast(bf16x8, ku), vf, Sacc[mt] * e4, 0, 0, 0); }
    }
    float* So = a->out + O_HP + (((size_t)L * NBAT + b) * 6 + h) * 16384;
#pragma unroll
    for (int mt = 0; mt < 8; ++mt)
#pragma unroll
        for (int i = 0; i < 4; ++i) So[(size_t)(16 * mt + 4 * quad + i) * 128 + 16 * wave + x] = Sacc[mt][i];
    __syncthreads();
}

__device__ __forceinline__ void phase_post(ArgsP a, int L, int lane, int wave, int blk, int G) {
    unsigned char* ws = a->ws; const int gw = blk * NWAVES + wave, NGW = G * NWAVES;
    const float* Y = (const float*)(ws + WS_Y); const float* O = (const float*)(ws + WS_O); const float* Gt = (const float*)(ws + WS_LORA) + 2 * WB; const float* Z = (const float*)(ws + WS_Z);
    const float* gng = a->in[I_BGNG] + L * WB; const float* gnb = a->in[I_BGNB] + L * WB; const float* rk = a->in[I_BRK] + L * WB; const float* cng = a->in[I_CNG] + L * WC;
    for (int m = gw; m < MV; m += NGW) {
        bf16* yo = (bf16*)(ws + WS_YMIX) + (size_t)m * DM;
        float ov[12], gz[12]; float ss = 0.f;
#pragma unroll
        for (int j = 0; j < 12; ++j) { const int c = 64 * j + lane; ov[j] = O[(size_t)m * WC + c]; gz[j] = Z[(size_t)m * PIN + OFF_C + 3 * WC + c]; ss += ov[j] * ov[j]; }
        if (m >= MP) {
#pragma unroll
            for (int j = 0; j < 12; ++j) { const int c = 64 * j + lane; const float* rec = (const float*)(ws + WS_RPS) + ((size_t)(m - MP) * 12 + j) * 384;
                const float y = Y[(size_t)m * WB + c], rr = rec[lane], kp = rec[128 + lane], vv = rec[192 + lane], gg = Gt[(size_t)m * NLORA + c];
                const float mean = wave_sum(y) * (1.f / 64.f); const float d = y - mean; const float rstd = 1.0f / sqrtf(wave_sum(d * d) * (1.f / 64.f) + GN_EPS);
                const float bonus = wave_sum(rr * kp * rk[c]);
                yo[WA + c] = bf1((d * rstd * gng[c] + gnb[c] + bonus * vv) * gg); } }
        const float rms = 1.0f / sqrtf(wave_sum(ss) * (1.f / WC) + RMS_EPS);
#pragma unroll
        for (int j = 0; j < 12; ++j) { const int c = 64 * j + lane; yo[WA + WB + c] = bf1(ov[j] * rms * cng[c] * (gz[j] * sigmoidf_(gz[j]))); }
    }
}

constexpr int REC_BYTES = 16384, RC_GT = 12288, RC_WT = 0, RC_RT = 2048, RC_AHT = 4096, RC_KHT = 6144, RC_VT = 8192, RC_BRA = 10240, RC_BRK = 10752, RC_M2 = 11264, RC_G15 = 11776, RC_BC = 12032;
constexpr int NCHUNK = NBAT * 12 * (SEQ / 16);
static_assert(WS_RPB + (size_t)NCHUNK * REC_BYTES == WS_RPS, "chunk record region");
__device__ __forceinline__ float readlane_f(float x, int l) { return __builtin_bit_cast(float, __builtin_amdgcn_readlane(__builtin_bit_cast(int, x), l)); }
__device__ __forceinline__ float wave_sum_fast(float x) { x = row16_sum(x); return (readlane_f(x, 0) + readlane_f(x, 16)) + (readlane_f(x, 32) + readlane_f(x, 48)); }
__device__ __forceinline__ int perm_ch(int ch) { return (ch & ~31) | (((ch >> 2) & 3) << 3) | (((ch >> 4) & 1) << 2) | (ch & 3); }

__device__ __forceinline__ void pre_chunk(ArgsP a, int L, int q, LAS unsigned char* wl, int lane) {
    unsigned char* ws = a->ws;
    const int bh = q >> 7, c = q & 127, b = bh / 12, h = bh - 12 * b, m0 = b * SEQ + c * 16, col = h * 64 + lane;
    const float* Z = (const float*)(ws + WS_Z) + (size_t)m0 * PIN + OFF_B + col; const float* LO = (const float*)(ws + WS_LORA) + (size_t)m0 * NLORA + col;
    unsigned char* rec = ws + WS_RPB + (size_t)q * REC_BYTES;
    LAS float* X0 = (LAS float*)wl;
    LAS float* X1 = (LAS float*)(wl + 4352);
    LAS float* Maa = (LAS float*)(wl + 8704);
    LAS float* Mak = (LAS float*)(wl + 9728);
    LAS bf16* Sm = (LAS bf16*)(wl + 10752);
    LAS bf16* Wim = (LAS bf16*)(wl + 12288);
    const float mur = a->in[I_BMU][L * PBW + col], muk = a->in[I_BMU][L * PBW + WB + col], muv = a->in[I_BMU][L * PBW + 2 * WB + col];
    const float w0c = a->in[I_BW0][L * WB + col], a0c = a->in[I_BA0][L * WB + col], kkc = a->in[I_BKK][L * WB + col], kac = a->in[I_BKA][L * WB + col], rkc = a->in[I_BRK][L * WB + col];
    float cr[16], ck[16], cv[16], lw[16], la[16];
#pragma unroll
    for (int t = 0; t < 16; ++t) { cr[t] = Z[(size_t)t * PIN]; ck[t] = Z[(size_t)t * PIN + WB]; cv[t] = Z[(size_t)t * PIN + 2 * WB]; lw[t] = LO[(size_t)t * NLORA]; la[t] = LO[(size_t)t * NLORA + WB];
        ((bf16*)(rec + RC_GT))[t * 64 + lane] = bf1(LO[(size_t)t * NLORA + 2 * WB]); }
    float pr = 0.f, pk = 0.f, pv = 0.f; if (c) { pr = Z[-(ptrdiff_t)PIN]; pk = Z[-(ptrdiff_t)PIN + WB]; pv = Z[-(ptrdiff_t)PIN + 2 * WB]; }
    float r_[16], k_[16], v_[16], kp_[16], al_[16], g_[16]; float run = 0.f, bcv = 0.f;
#pragma unroll
    for (int t = 0; t < 16; ++t) {
        const float r = cr[t] + mur * (pr - cr[t]), k = ck[t] + muk * (pk - ck[t]), v = cv[t] + muv * (pv - cv[t]); pr = cr[t]; pk = ck[t]; pv = cv[t];
        run += -0.6065306597126334f * __builtin_amdgcn_rcpf(1.0f + __expf(-(w0c + lw[t]))); g_[t] = run;
        const float av = __builtin_amdgcn_rcpf(1.0f + __expf(-(a0c + la[t])));
        const float kkr = k * kkc; const float ss = wave_sum_fast(kkr * kkr); const float kap = kkr / fmaxf(sqrtf(ss), 1e-12f);
        const float kpr = k * (1.0f + (av - 1.0f) * kac);
        const float bc = wave_sum_fast(r * kpr * rkc); if (lane == t) bcv = bc;
        r_[t] = r; k_[t] = kpr; v_[t] = v; kp_[t] = kap; al_[t] = kap * av; }
    const float gl = g_[15];
    { float ah[16], kh[16];
#pragma unroll
      for (int t = 0; t < 16; ++t) { const float ig = __expf(-g_[t]), eg = __expf(gl - g_[t]); X0[t * 68 + lane] = al_[t] * ig; X1[t * 68 + lane] = k_[t] * ig; ah[t] = al_[t] * eg; kh[t] = k_[t] * eg; }
      v4u o0, o1;
      o0.x = cvt_pk_bf16_c(ah[0], ah[1]); o0.y = cvt_pk_bf16_c(ah[2], ah[3]); o0.z = cvt_pk_bf16_c(ah[4], ah[5]); o0.w = cvt_pk_bf16_c(ah[6], ah[7]);
      o1.x = cvt_pk_bf16_c(ah[8], ah[9]); o1.y = cvt_pk_bf16_c(ah[10], ah[11]); o1.z = cvt_pk_bf16_c(ah[12], ah[13]); o1.w = cvt_pk_bf16_c(ah[14], ah[15]);
      *(v4u*)(rec + RC_AHT + lane * 32) = o0; *(v4u*)(rec + RC_AHT + lane * 32 + 16) = o1;
      o0.x = cvt_pk_bf16_c(kh[0], kh[1]); o0.y = cvt_pk_bf16_c(kh[2], kh[3]); o0.z = cvt_pk_bf16_c(kh[4], kh[5]); o0.w = cvt_pk_bf16_c(kh[6], kh[7]);
      o1.x = cvt_pk_bf16_c(kh[8], kh[9]); o1.y = cvt_pk_bf16_c(kh[10], kh[11]); o1.z = cvt_pk_bf16_c(kh[12], kh[13]); o1.w = cvt_pk_bf16_c(kh[14], kh[15]);
      *(v4u*)(rec + RC_KHT + lane * 32) = o0; *(v4u*)(rec + RC_KHT + lane * 32 + 16) = o1;
      o0.x = cvt_pk_bf16_c(v_[0], v_[1]); o0.y = cvt_pk_bf16_c(v_[2], v_[3]); o0.z = cvt_pk_bf16_c(v_[4], v_[5]); o0.w = cvt_pk_bf16_c(v_[6], v_[7]);
      o1.x = cvt_pk_bf16_c(v_[8], v_[9]); o1.y = cvt_pk_bf16_c(v_[10], v_[11]); o1.z = cvt_pk_bf16_c(v_[12], v_[13]); o1.w = cvt_pk_bf16_c(v_[14], v_[15]);
      *(v4u*)(rec + RC_VT + lane * 32) = o0; *(v4u*)(rec + RC_VT + lane * 32 + 16) = o1; }
    LDS_WAIT(); asm volatile("" ::: "memory");
    const int x = lane & 15, kq = lane >> 4;
    f4 ba[4], bk[4];
#pragma unroll
    for (int j = 0; j < 4; ++j) { ba[j] = *(const LAS f4*)(X0 + x * 68 + 16 * kq + 4 * j); bk[j] = *(const LAS f4*)(X1 + x * 68 + 16 * kq + 4 * j); }
    LDS_WAIT(); asm volatile("" ::: "memory");
    float kt[16];
#pragma unroll
    for (int t = 0; t < 16; ++t) { kt[t] = kp_[t] * (t ? __expf(g_[t - 1]) : 1.0f); X0[t * 68 + lane] = kt[t]; X1[t * 68 + lane] = r_[t] * __expf(g_[t]); }
    LDS_WAIT(); asm volatile("" ::: "memory");
    f4 ak[4], ar[4];
#pragma unroll
    for (int j = 0; j < 4; ++j) { ak[j] = *(const LAS f4*)(X0 + x * 68 + 16 * kq + 4 * j); ar[j] = *(const LAS f4*)(X1 + x * 68 + 16 * kq + 4 * j); }
    pg8::f32x4 Gaa = (pg8::f32x4){0.f, 0.f, 0.f, 0.f}, Gak = Gaa, Gra = Gaa, Grk = Gaa;
#pragma unroll
    for (int j = 0; j < 4; ++j)
#pragma unroll
        for (int e = 0; e < 4; ++e) { Gaa = __builtin_amdgcn_mfma_f32_16x16x4f32(ak[j][e], ba[j][e], Gaa, 0, 0, 0); Gak = __builtin_amdgcn_mfma_f32_16x16x4f32(ak[j][e], bk[j][e], Gak, 0, 0, 0);
            Gra = __builtin_amdgcn_mfma_f32_16x16x4f32(ar[j][e], ba[j][e], Gra, 0, 0, 0); Grk = __builtin_amdgcn_mfma_f32_16x16x4f32(ar[j][e], bk[j][e], Grk, 0, 0, 0); }
#pragma unroll
    for (int i = 0; i < 4; ++i) { const int t = 4 * kq + i; const bool sl = x < t, le = x <= t;
        Maa[t * 16 + x] = sl ? Gaa[i] : 0.f; Mak[t * 16 + x] = sl ? Gak[i] : 0.f;
        Sm[t * 16 + x] = bf1(le ? Gra[i] : 0.f); Sm[256 + t * 16 + x] = bf1(le ? Grk[i] : 0.f); }
    LDS_WAIT(); asm volatile("" ::: "memory");
    float xm[16];
#pragma unroll
    for (int t = 0; t < 16; ++t) xm[t] = Mak[t * 16 + x];
#pragma unroll
    for (int t = 1; t < 16; ++t) {
#pragma unroll
        for (int s4 = 0; s4 < (t + 3) / 4; ++s4) { const f4 ar4 = *(const LAS f4*)(Maa + t * 16 + 4 * s4);
#pragma unroll
            for (int e = 0; e < 4; ++e) if (4 * s4 + e < t) { kt[t] -= ar4[e] * kt[4 * s4 + e]; xm[t] -= ar4[e] * xm[4 * s4 + e]; } } }
#pragma unroll
    for (int t = 0; t < 16; ++t) { Wim[t * 64 + perm_ch(lane)] = bf1(-kt[t]); if (lane < 16) Sm[512 + t * 16 + lane] = bf1(-xm[t]); }
    LDS_WAIT(); asm volatile("" ::: "memory");
    *(v4u*)(rec + RC_WT + lane * 16) = *(const LAS v4u*)((LAS unsigned char*)Wim + lane * 16); *(v4u*)(rec + RC_WT + 1024 + lane * 16) = *(const LAS v4u*)((LAS unsigned char*)Wim + 1024 + lane * 16);
    *(v4u*)(rec + RC_BRA + lane * 16) = *(const LAS v4u*)((LAS unsigned char*)Sm + lane * 16); if (lane < 32) *(v4u*)(rec + RC_BRA + 1024 + lane * 16) = *(const LAS v4u*)((LAS unsigned char*)Sm + 1024 + lane * 16);
    LDS_WAIT(); asm volatile("" ::: "memory");
#pragma unroll
    for (int t = 0; t < 16; ++t) Wim[t * 64 + perm_ch(lane)] = bf1(r_[t] * __expf(g_[t]));
    LDS_WAIT(); asm volatile("" ::: "memory");
    *(v4u*)(rec + RC_RT + lane * 16) = *(const LAS v4u*)((LAS unsigned char*)Wim + lane * 16); *(v4u*)(rec + RC_RT + 1024 + lane * 16) = *(const LAS v4u*)((LAS unsigned char*)Wim + 1024 + lane * 16);
    *(float*)(rec + RC_G15 + lane * 4) = __expf(gl); if (lane < 16) *(float*)(rec + RC_BC + lane * 4) = bcv;
    LDS_WAIT(); asm volatile("" ::: "memory");
}

constexpr int HREC_BYTES = 17408, HR_QS = 0, HR_KS = 4352, HR_VT = 8704, HR_KHT = 12800, HR_EV = 16896, NHCHUNK = NBAT * 6 * (SEQ / 16);
__device__ __forceinline__ void hpre_chunk(ArgsP a, int L, int q2, LAS unsigned char* wl, int lane) {
    unsigned char* ws = a->ws;
    const int bh = q2 >> 7, c = q2 & 127, b = bh / 6, h = bh - 6 * b;
    const float* Z = (const float*)(ws + WS_Z) + (size_t)(b * SEQ + c * 16) * PIN + OFF_C + h * 128 + lane;
    unsigned char* rec = ws + WS_HREC + (size_t)q2 * HREC_BYTES;
    LAS bf16* qim = (LAS bf16*)wl; LAS bf16* kim = (LAS bf16*)(wl + 4352);
#pragma unroll
    for (int hh = 0; hh < 2; ++hh) { const int ch = lane + 64 * hh; const int pc = perm_ch(ch);
        const float lb = lbound(a->in[I_CLB], L, h * 128 + ch), oml = 1.0f - lb;
        float q[16], fz[16], iv[16];
#pragma unroll
        for (int t = 0; t < 16; ++t) { const float* p = Z + (size_t)t * PIN + 64 * hh; q[t] = p[0]; fz[t] = p[WC]; iv[t] = p[2 * WC]; }
        float bl[16], kv[16]; float run = 0.f;
#pragma unroll
        for (int t = 0; t < 16; ++t) { const float e = __expf(-fmaxf(fz[t], -80.f)), sg = __builtin_amdgcn_rcpf(1.0f + e); run += __logf(lb + oml * sg); bl[t] = run; kv[t] = oml * e * sg; }
        float kh[16];
#pragma unroll
        for (int t = 0; t < 16; ++t) { qim[t * 136 + pc] = bf1(q[t] * __expf(bl[t])); kim[t * 136 + pc] = bf1(kv[t] * __expf(fminf(-bl[t], 60.f))); kh[t] = kv[t] * __expf(run - bl[t]); }
        v4u o0, o1;
        o0.x = cvt_pk_bf16_c(kh[0], kh[1]); o0.y = cvt_pk_bf16_c(kh[2], kh[3]); o0.z = cvt_pk_bf16_c(kh[4], kh[5]); o0.w = cvt_pk_bf16_c(kh[6], kh[7]);
        o1.x = cvt_pk_bf16_c(kh[8], kh[9]); o1.y = cvt_pk_bf16_c(kh[10], kh[11]); o1.z = cvt_pk_bf16_c(kh[12], kh[13]); o1.w = cvt_pk_bf16_c(kh[14], kh[15]);
        *(v4u*)(rec + HR_KHT + ch * 32) = o0; *(v4u*)(rec + HR_KHT + ch * 32 + 16) = o1;
        o0.x = cvt_pk_bf16_c(iv[0], iv[1]); o0.y = cvt_pk_bf16_c(iv[2], iv[3]); o0.z = cvt_pk_bf16_c(iv[4], iv[5]); o0.w = cvt_pk_bf16_c(iv[6], iv[7]);
        o1.x = cvt_pk_bf16_c(iv[8], iv[9]); o1.y = cvt_pk_bf16_c(iv[10], iv[11]); o1.z = cvt_pk_bf16_c(iv[12], iv[13]); o1.w = cvt_pk_bf16_c(iv[14], iv[15]);
        *(v4u*)(rec + HR_VT + ch * 32) = o0; *(v4u*)(rec + HR_VT + ch * 32 + 16) = o1;
        *(float*)(rec + HR_EV + ch * 4) = __expf(run); }
    LDS_WAIT(); asm volatile("" ::: "memory");
#pragma unroll
    for (int j = 0; j < 9; ++j) { const int o = (j * 64 + lane) * 16; if (o < 8704) *(v4u*)(rec + o) = *(const LAS v4u*)(wl + o); }
    LDS_WAIT(); asm volatile("" ::: "memory");
}
__device__ __forceinline__ void hgrn_stream_unit(ArgsP a, int L, int unit, LAS unsigned char* lds, int lane, int wave) {
    unsigned char* ws = a->ws;
    const int b = unit / 6, h = unit - b * 6;
    const unsigned char* recs = ws + WS_HREC + (size_t)unit * 128 * HREC_BYTES;
    const int x = lane & 15, quad = lane >> 4;
    constexpr int AHEAD = 4, NCH = SEQ / 16;
#define HG_DMA(cc) do { const unsigned char* g_ = recs + (size_t)(cc) * HREC_BYTES + wave * 1024 + lane * 16; LAS unsigned char* l_ = lds + ((cc) % 6) * HREC_BYTES + wave * 1024; \
        __builtin_amdgcn_global_load_lds((const unsigned*)(g_), (LAS unsigned*)(l_), 16, 0, 0); __builtin_amdgcn_global_load_lds((const unsigned*)(g_ + 8192), (LAS unsigned*)(l_ + 8192), 16, 0, 0); \
        if (wave == 0) __builtin_amdgcn_global_load_lds((const unsigned*)(g_ + 16384), (LAS unsigned*)(l_ + 16384), 16, 0, 0); } while (0)
    asm volatile("s_waitcnt vmcnt(0) lgkmcnt(0)" ::: "memory"); __builtin_amdgcn_s_barrier(); asm volatile("" ::: "memory");
    pg8::f32x4 Sacc[8];
#pragma unroll
    for (int mt = 0; mt < 8; ++mt) Sacc[mt] = (pg8::f32x4){0.f, 0.f, 0.f, 0.f};
#pragma unroll
    for (int cc = 0; cc < AHEAD; ++cc) HG_DMA(cc);
    if (wave == 0) asm volatile("s_waitcnt vmcnt(9)" ::: "memory"); else asm volatile("s_waitcnt vmcnt(6)" ::: "memory");
    __builtin_amdgcn_s_barrier(); asm volatile("" ::: "memory");
    float* O = (float*)(ws + WS_O) + (size_t)(b * SEQ) * WC + h * 128 + 16 * wave + 4 * quad;
    for (int st = 0; st < NCH; ++st) {
        if (st + AHEAD < NCH) HG_DMA(st + AHEAD);
        const LAS unsigned char* S = lds + (st % 6) * HREC_BYTES;
        const LAS bf16* qs = (const LAS bf16*)(S + HR_QS); const LAS bf16* ks = (const LAS bf16*)(S + HR_KS); const LAS bf16* vt = (const LAS bf16*)(S + HR_VT);
        const LAS bf16* kht = (const LAS bf16*)(S + HR_KHT); const LAS float* ev = (const LAS float*)(S + HR_EV);
        bf16x8 qf[4], kf[4];
#pragma unroll
        for (int kt = 0; kt < 4; ++kt) { qf[kt] = *(const LAS bf16x8*)(qs + x * 136 + 32 * kt + 8 * quad); kf[kt] = *(const LAS bf16x8*)(ks + x * 136 + 32 * kt + 8 * quad); }
        pg8::f32x4 att = (pg8::f32x4){0.f, 0.f, 0.f, 0.f};
#pragma unroll
        for (int kt = 0; kt < 4; ++kt) att = __builtin_amdgcn_mfma_f32_16x16x32_bf16(kf[kt], qf[kt], att, 0, 0, 0);
#pragma unroll
        for (int i = 0; i < 4; ++i) if (4 * quad + i > x) att[i] = 0.f;
        v4u pbu; pbu.x = cvt_pk_bf16_c(att[0], att[1]); pbu.y = cvt_pk_bf16_c(att[2], att[3]); pbu.z = 0u; pbu.w = 0u;
        const bf16x8 pb = __builtin_bit_cast(bf16x8, pbu);
        const u2 vv = *(const LAS u2*)(vt + (16 * wave + x) * 16 + 4 * quad);
        v4u vfu; vfu.x = vv.x; vfu.y = vv.y; vfu.z = 0u; vfu.w = 0u; const bf16x8 vf = __builtin_bit_cast(bf16x8, vfu);
        pg8::f32x4 o = (pg8::f32x4){0.f, 0.f, 0.f, 0.f};
#pragma unroll
        for (int kt = 0; kt < 4; ++kt) { v4u su; su.x = cvt_pk_bf16_c(Sacc[2 * kt][0], Sacc[2 * kt][1]); su.y = cvt_pk_bf16_c(Sacc[2 * kt][2], Sacc[2 * kt][3]);
            su.z = cvt_pk_bf16_c(Sacc[2 * kt + 1][0], Sacc[2 * kt + 1][1]); su.w = cvt_pk_bf16_c(Sacc[2 * kt + 1][2], Sacc[2 * kt + 1][3]);
            o = __builtin_amdgcn_mfma_f32_16x16x32_bf16(__builtin_bit_cast(bf16x8, su), qf[kt], o, 0, 0, 0); }
        o = __builtin_amdgcn_mfma_f32_16x16x32_bf16(vf, pb, o, 0, 0, 0);
        *(pg8::f32x4*)(O + (size_t)(st * 16 + x) * WC) = o;
#pragma unroll
        for (int mt = 0; mt < 8; ++mt) { const pg8::f32x4 e4 = *(const LAS pg8::f32x4*)(ev + 16 * mt + 4 * quad);
            const u2 kk2 = *(const LAS u2*)(kht + (16 * mt + x) * 16 + 4 * quad); v4u ku; ku.x = kk2.x; ku.y = kk2.y; ku.z = 0u; ku.w = 0u;
            Sacc[mt] = __builtin_amdgcn_mfma_f32_16x16x32_bf16(__builtin_bit_cast(bf16x8, ku), vf, Sacc[mt] * e4, 0, 0, 0); }
        if (st + AHEAD < NCH) { if (wave == 0) asm volatile("s_waitcnt vmcnt(10)" ::: "memory"); else asm volatile("s_waitcnt vmcnt(7)" ::: "memory"); }
        else asm volatile("s_waitcnt vmcnt(0)" ::: "memory");
        asm volatile("s_waitcnt lgkmcnt(0)" ::: "memory"); __builtin_amdgcn_s_barrier(); asm volatile("" ::: "memory");
    }
#undef HG_DMA
    float* So = a->out + O_HP + (((size_t)L * NBAT + b) * 6 + h) * 16384;
#pragma unroll
    for (int mt = 0; mt < 8; ++mt)
#pragma unroll
        for (int i = 0; i < 4; ++i) So[(size_t)(16 * mt + 4 * quad + i) * 128 + 16 * wave + x] = Sacc[mt][i];
    asm volatile("s_waitcnt vmcnt(0) lgkmcnt(0)" ::: "memory"); __builtin_amdgcn_s_barrier(); asm volatile("" ::: "memory");
}

__device__ __forceinline__ void phase_pre(ArgsP a, int L, LAS unsigned char* lds, int lane, int wave, int blk, int G) {
    const int gw = blk * NWAVES + wave, NGW = G * NWAVES;
    for (int q = gw; q < NCHUNK; q += NGW) pre_chunk(a, L, q, lds + wave * 16384, lane);
    for (int q2 = gw; q2 < NHCHUNK; q2 += NGW) hpre_chunk(a, L, q2, lds + wave * 16384, lane);
}
__device__ __forceinline__ void rwkv_seq_unit(ArgsP a, int L, int unit, LAS unsigned char* lds, int lane, int wave) {
    unsigned char* ws = a->ws;
    const int b = unit / 12, h = unit - 12 * b;
    const unsigned char* recs = ws + WS_RPB + (size_t)unit * 128 * REC_BYTES;
    LAS float* ybuf = (LAS float*)(lds + 7 * REC_BYTES);
    const int x = lane & 15, quad = lane >> 4;
    constexpr int AHEAD = 5, NCH = SEQ / 16;
#define RW_DMA(cc) do { const unsigned char* g_ = recs + (size_t)(cc) * REC_BYTES + wave * 4096 + lane * 16; LAS unsigned char* l_ = lds + ((cc) % 7) * REC_BYTES + wave * 4096; \
        __builtin_amdgcn_global_load_lds((const unsigned*)(g_), (LAS unsigned*)(l_), 16, 0, 0); __builtin_amdgcn_global_load_lds((const unsigned*)(g_ + 1024), (LAS unsigned*)(l_ + 1024), 16, 0, 0); \
        __builtin_amdgcn_global_load_lds((const unsigned*)(g_ + 2048), (LAS unsigned*)(l_ + 2048), 16, 0, 0); __builtin_amdgcn_global_load_lds((const unsigned*)(g_ + 3072), (LAS unsigned*)(l_ + 3072), 16, 0, 0); } while (0)
    asm volatile("s_waitcnt vmcnt(0) lgkmcnt(0)" ::: "memory"); __builtin_amdgcn_s_barrier(); asm volatile("" ::: "memory");
    pg8::f32x4 Hacc[4];
#pragma unroll
    for (int nt = 0; nt < 4; ++nt) Hacc[nt] = (pg8::f32x4){0.f, 0.f, 0.f, 0.f};
    if (wave < 4) {
#pragma unroll
        for (int cc = 0; cc < AHEAD; ++cc) RW_DMA(cc);
        asm volatile("s_waitcnt vmcnt(16)" ::: "memory");
    }
    __builtin_amdgcn_s_barrier(); asm volatile("" ::: "memory");
    const float gng = a->in[I_BGNG][L * WB + h * 64 + lane], gnb = a->in[I_BGNB][L * WB + h * 64 + lane];
    bf16* ymix = (bf16*)(ws + WS_YMIX) + (size_t)(b * SEQ) * DM + WA + h * 64 + lane;
    for (int c = 0; c <= NCH; ++c) {
        if (wave < 4) {
            if (c < NCH) {
                if (c + AHEAD < NCH) RW_DMA(c + AHEAD); else { asm volatile("s_nop 0" ::: "memory"); }
                const LAS unsigned char* S = lds + (c % 7) * REC_BYTES;
                bf16x8 wf[2], rf[2], hb[2];
#pragma unroll
                for (int ks = 0; ks < 2; ++ks) { wf[ks] = *(const LAS bf16x8*)(S + RC_WT + x * 128 + 64 * ks + 16 * quad); rf[ks] = *(const LAS bf16x8*)(S + RC_RT + x * 128 + 64 * ks + 16 * quad);
                    v4u su; su.x = cvt_pk_bf16_c(Hacc[2 * ks][0], Hacc[2 * ks][1]); su.y = cvt_pk_bf16_c(Hacc[2 * ks][2], Hacc[2 * ks][3]);
                    su.z = cvt_pk_bf16_c(Hacc[2 * ks + 1][0], Hacc[2 * ks + 1][1]); su.w = cvt_pk_bf16_c(Hacc[2 * ks + 1][2], Hacc[2 * ks + 1][3]); hb[ks] = __builtin_bit_cast(bf16x8, su); }
                const u2 vv = *(const LAS u2*)(S + RC_VT + (16 * wave + x) * 32 + 8 * quad); v4u t4; t4.x = vv.x; t4.y = vv.y; t4.z = 0u; t4.w = 0u; const bf16x8 vf = __builtin_bit_cast(bf16x8, t4);
                const u2 m2v = *(const LAS u2*)(S + RC_M2 + x * 32 + 8 * quad); t4.x = m2v.x; t4.y = m2v.y; const bf16x8 m2f = __builtin_bit_cast(bf16x8, t4);
                const u2 brav = *(const LAS u2*)(S + RC_BRA + x * 32 + 8 * quad); t4.x = brav.x; t4.y = brav.y; const bf16x8 braf = __builtin_bit_cast(bf16x8, t4);
                const u2 brkv = *(const LAS u2*)(S + RC_BRK + x * 32 + 8 * quad); t4.x = brkv.x; t4.y = brkv.y; const bf16x8 brkf = __builtin_bit_cast(bf16x8, t4);
                pg8::f32x4 U = (pg8::f32x4){0.f, 0.f, 0.f, 0.f}, Y = U;
                U = __builtin_amdgcn_mfma_f32_16x16x32_bf16(wf[0], hb[0], U, 0, 0, 0); U = __builtin_amdgcn_mfma_f32_16x16x32_bf16(wf[1], hb[1], U, 0, 0, 0); U = __builtin_amdgcn_mfma_f32_16x16x32_bf16(m2f, vf, U, 0, 0, 0);
                Y = __builtin_amdgcn_mfma_f32_16x16x32_bf16(rf[0], hb[0], Y, 0, 0, 0); Y = __builtin_amdgcn_mfma_f32_16x16x32_bf16(rf[1], hb[1], Y, 0, 0, 0); Y = __builtin_amdgcn_mfma_f32_16x16x32_bf16(brkf, vf, Y, 0, 0, 0);
                t4.x = cvt_pk_bf16_c(U[0], U[1]); t4.y = cvt_pk_bf16_c(U[2], U[3]); const bf16x8 ub = __builtin_bit_cast(bf16x8, t4);
                Y = __builtin_amdgcn_mfma_f32_16x16x32_bf16(braf, ub, Y, 0, 0, 0);
#pragma unroll
                for (int nt = 0; nt < 4; ++nt) { const pg8::f32x4 g4 = *(const LAS pg8::f32x4*)(S + RC_G15 + (16 * nt + 4 * quad) * 4);
                    const u2 av = *(const LAS u2*)(S + RC_AHT + (16 * nt + x) * 32 + 8 * quad); t4.x = av.x; t4.y = av.y; const bf16x8 ahf = __builtin_bit_cast(bf16x8, t4);
                    const u2 kv = *(const LAS u2*)(S + RC_KHT + (16 * nt + x) * 32 + 8 * quad); t4.x = kv.x; t4.y = kv.y; const bf16x8 khf = __builtin_bit_cast(bf16x8, t4);
                    Hacc[nt] = __builtin_amdgcn_mfma_f32_16x16x32_bf16(ahf, ub, Hacc[nt] * g4, 0, 0, 0); Hacc[nt] = __builtin_amdgcn_mfma_f32_16x16x32_bf16(khf, vf, Hacc[nt], 0, 0, 0); }
                LAS float* yb = ybuf + (c & 1) * 1024;
#pragma unroll
                for (int i = 0; i < 4; ++i) yb[(4 * quad + i) * 64 + 16 * wave + x] = Y[i];
            }
            if (c + AHEAD < NCH) asm volatile("s_waitcnt vmcnt(16)" ::: "memory"); else asm volatile("s_waitcnt vmcnt(0)" ::: "memory");
        } else if (c > 0) {
            const int cp = c - 1; const LAS unsigned char* S = lds + (cp % 7) * REC_BYTES; const LAS float* yb = ybuf + (cp & 1) * 1024;
#pragma unroll
            for (int j = 0; j < 4; ++j) { const int tt = 4 * (wave - 4) + j; const size_t row = (size_t)(cp * 16 + tt);
                const float g = __builtin_bit_cast(float, (unsigned)(*(const LAS unsigned short*)(S + RC_GT + (tt * 64 + lane) * 2)) << 16); const float y = yb[tt * 64 + lane];
                const float mean = wave_sum_fast(y) * (1.f / 64.f); const float d = y - mean; const float rstd = 1.0f / sqrtf(wave_sum_fast(d * d) * (1.f / 64.f) + GN_EPS);
                const float bcf = *(const LAS float*)(S + RC_BC + tt * 4); const unsigned short vb = *(const LAS unsigned short*)(S + RC_VT + lane * 32 + tt * 2);
                const float v = __builtin_bit_cast(float, (unsigned)vb << 16);
                ymix[row * DM] = bf1((d * rstd * gng + gnb + bcf * v) * g); }
        }
        asm volatile("s_waitcnt lgkmcnt(0)" ::: "memory"); __builtin_amdgcn_s_barrier(); asm volatile("" ::: "memory");
    }
    if (wave < 4) { float* So = a->out + O_RP + (((size_t)L * NBAT + b) * 12 + h) * 4096;
#pragma unroll
        for (int nt = 0; nt < 4; ++nt) *(pg8::f32x4*)(So + (size_t)(16 * wave + x) * 64 + 16 * nt + 4 * quad) = Hacc[nt]; }
#undef RW_DMA
    asm volatile("s_waitcnt vmcnt(0) lgkmcnt(0)" ::: "memory"); __builtin_amdgcn_s_barrier(); asm volatile("" ::: "memory");
}

__device__ __forceinline__ float gelu_fast(float v) {
    const float t = __builtin_amdgcn_rcpf(__builtin_fabsf(v) * 0.2316418882f + 1.0f);
    float q = t * 0.5307027145f + (-0.7265760135f); q = q * t + 0.7107068705f; q = q * t + (-0.142248368f); q = q * t + 0.127414796f; q = q * t;
    const float e = __builtin_amdgcn_exp2f((v * v) * (-0.72134752044f)); const float m = v * (q * e);
    return v < 0.f ? m : v - m;
}
__device__ __forceinline__ void sgu_item2(ArgsP a, int L, int item, LAS unsigned char* lds, int tid, int lane, int wave) {
    unsigned char* ws = a->ws;
    const int g = item & 3, bc = item >> 2, m0 = bc * 128;
    const float* Z = (const float*)(ws + WS_Z);
    LAS bf16* Wb = (LAS bf16*)lds;
    LAS bf16* VT = (LAS bf16*)(lds + 34816);
    const float* wsrc = a->in[I_AWS] + (size_t)(L * 4 + g) * 16384;
    __syncthreads();
#pragma unroll
    for (int j = 0; j < 8; ++j) { const int e4 = j * NTHR + tid, t = e4 >> 5, s0 = (e4 & 31) * 4; const f4 w = *(const f4*)(wsrc + t * 128 + s0);
        u2 o; o.x = cvt_pk_bf16_c(s0 <= t ? w.x : 0.f, s0 + 1 <= t ? w.y : 0.f); o.y = cvt_pk_bf16_c(s0 + 2 <= t ? w.z : 0.f, s0 + 3 <= t ? w.w : 0.f); *(LAS u2*)(Wb + t * 136 + s0) = o; }
    const float lg0 = a->in[I_ALNG][L * WA + g * 128 + lane], lg1 = a->in[I_ALNG][L * WA + g * 128 + 64 + lane], lb0 = a->in[I_ALNB][L * WA + g * 128 + lane], lb1 = a->in[I_ALNB][L * WA + g * 128 + 64 + lane];
    float zv0[16], zv1[16];
#pragma unroll
    for (int rr = 0; rr < 16; ++rr) { const float* zr = Z + (size_t)(m0 + wave * 16 + rr) * PIN + WA + g * 128; zv0[rr] = zr[lane]; zv1[rr] = zr[64 + lane]; }
#pragma unroll
    for (int rr = 0; rr < 16; ++rr) { const int t = wave * 16 + rr; const float v0 = gelu_fast(zv0[rr]), v1 = gelu_fast(zv1[rr]);
        const float mean = wave_sum_fast(v0 + v1) * (1.f / 128.f); const float d0 = v0 - mean, d1 = v1 - mean;
        const float rstd = 1.0f / sqrtf(wave_sum_fast(d0 * d0 + d1 * d1) * (1.f / 128.f) + LN_EPS);
        VT[lane * 136 + t] = bf1(d0 * rstd * lg0 + lb0); VT[(64 + lane) * 136 + t] = bf1(d1 * rstd * lg1 + lb1); }
    __syncthreads();
    const int x = lane & 15, quad = lane >> 4, nks = (wave >> 1) + 1;
    pg8::f32x4 acc[8];
#pragma unroll
    for (int dt = 0; dt < 8; ++dt) acc[dt] = (pg8::f32x4){0.f, 0.f, 0.f, 0.f};
    for (int ks = 0; ks < nks; ++ks) { const bf16x8 wf = *(const LAS bf16x8*)(Wb + (16 * wave + x) * 136 + 32 * ks + 8 * quad);
#pragma unroll
        for (int dt = 0; dt < 8; ++dt) { const bf16x8 vf = *(const LAS bf16x8*)(VT + (16 * dt + x) * 136 + 32 * ks + 8 * quad); acc[dt] = __builtin_amdgcn_mfma_f32_16x16x32_bf16(vf, wf, acc[dt], 0, 0, 0); } }
    const int t = 16 * wave + x; const float bs = a->in[I_ABS][(L * 4 + g) * 128 + t];
    const float* ur = Z + (size_t)(m0 + t) * PIN + g * 128 + 4 * quad; bf16* yo = (bf16*)(ws + WS_YMIX) + (size_t)(m0 + t) * DM + g * 128 + 4 * quad;
#pragma unroll
    for (int dt = 0; dt < 8; ++dt) { const f4 u = *(const f4*)(ur + 16 * dt); u2 o;
        o.x = cvt_pk_bf16_c(gelu_fast(u.x) * (acc[dt][0] + bs), gelu_fast(u.y) * (acc[dt][1] + bs)); o.y = cvt_pk_bf16_c(gelu_fast(u.z) * (acc[dt][2] + bs), gelu_fast(u.w) * (acc[dt][3] + bs));
        *(u2*)(yo + 16 * dt) = o; }
}
__device__ __forceinline__ void hgrn_sample_item2(ArgsP a, int L, int item, LAS unsigned char* lds, int lane, int wave) {
    unsigned char* ws = a->ws;
    const int ih = item * 8 + wave, i = ih / 6, h = ih - i * 6, m = MP + i, vq = lane & 31, kh = lane >> 5;
    const float* zc = (const float*)(ws + WS_Z) + (size_t)m * PIN + OFF_C + h * 128;
    LAS f4* sc = (LAS f4*)(lds + wave * 2048);
#pragma unroll
    for (int t = 0; t < 2; ++t) { const int k = lane + 64 * t; const float lb = lbound(a->in[I_CLB], L, h * 128 + k); const float fz = zc[WC + k];
        const float e = __expf(-fmaxf(fz, -80.f)), sg = __builtin_amdgcn_rcpf(1.0f + e); f4 r; r.x = lb + (1.0f - lb) * sg; r.y = (1.0f - lb) * e * sg; r.z = zc[k]; r.w = 0.f; sc[k] = r; }
    const f4 iv = *(const f4*)(zc + 2 * WC + 4 * vq);
    LDS_WAIT(); asm volatile("" ::: "memory");
    const float* S0 = a->in[I_SHGRN] + (((size_t)L * NS + i) * 6 + h) * 16384 + 4 * vq;
    float* So = a->out + O_HS + (((size_t)L * NS + i) * 6 + h) * 16384 + 4 * vq;
    f4 o = (f4){0.f, 0.f, 0.f, 0.f};
#pragma unroll 1
    for (int qt = 0; qt < 4; ++qt) { f4 sv[16];
#pragma unroll
        for (int j = 0; j < 16; ++j) sv[j] = *(const f4*)(S0 + (size_t)(kh + 2 * (16 * qt + j)) * 128);
#pragma unroll
        for (int j = 0; j < 16; ++j) { const int k = kh + 2 * (16 * qt + j); const f4 c = sc[k]; const f4 n = sv[j] * c.x + iv * c.y; *(f4*)(So + (size_t)k * 128) = n; o += n * c.z; } }
    o.x += __shfl_xor(o.x, 32); o.y += __shfl_xor(o.y, 32); o.z += __shfl_xor(o.z, 32); o.w += __shfl_xor(o.w, 32);
    if (kh == 0) *(f4*)((float*)(ws + WS_O) + (size_t)m * WC + h * 128 + 4 * vq) = o;
    LDS_WAIT(); asm volatile("" ::: "memory");
}

enum { SE_STORE = 0, SE_RESID = 1, SE_SWIGLU = 2, SE_SIGMUL = 3 };
struct SEpi { int mode; float* out; const float* base; const float* add; int ld; float alpha; };
__device__ __forceinline__ void strip_task(const bf16* A, const bf16* Bt, int K, int r0, int r1, int c0, const SEpi& E, LAS unsigned char* lds, int lane, int wave) {
    const int x = lane & 15, quad = lane >> 4;
    const int nks = K >> 8;
    const bf16* Ap = A + (size_t)x * K + wave * (nks * 32) + 8 * quad;
    const bf16* B0 = Bt + (size_t)(r0 + x) * K + wave * (nks * 32) + 8 * quad;
    const bf16* B1 = Bt + (size_t)(r1 + x) * K + wave * (nks * 32) + 8 * quad;
    pg8::f32x4 acc[8][2];
#pragma unroll
    for (int mt = 0; mt < 8; ++mt) { acc[mt][0] = (pg8::f32x4){0.f, 0.f, 0.f, 0.f}; acc[mt][1] = (pg8::f32x4){0.f, 0.f, 0.f, 0.f}; }
    for (int s = 0; s < nks; ++s) {
        bf16x8 af[8]; const bf16x8 b0 = *(const bf16x8*)(B0 + 32 * s), b1 = *(const bf16x8*)(B1 + 32 * s);
#pragma unroll
        for (int mt = 0; mt < 8; ++mt) af[mt] = *(const bf16x8*)(Ap + (size_t)(16 * mt) * K + 32 * s);
#pragma unroll
        for (int mt = 0; mt < 8; ++mt) { acc[mt][0] = __builtin_amdgcn_mfma_f32_16x16x32_bf16(af[mt], b0, acc[mt][0], 0, 0, 0); acc[mt][1] = __builtin_amdgcn_mfma_f32_16x16x32_bf16(af[mt], b1, acc[mt][1], 0, 0, 0); }
    }
    __syncthreads();
    LAS pg8::f32x4* red = (LAS pg8::f32x4*)lds;
#pragma unroll
    for (int mt = 0; mt < 8; ++mt) { red[((wave * 8 + mt) * 2 + 0) * 64 + lane] = acc[mt][0]; red[((wave * 8 + mt) * 2 + 1) * 64 + lane] = acc[mt][1]; }
    __syncthreads();
    pg8::f32x4 s0 = (pg8::f32x4){0.f, 0.f, 0.f, 0.f}, s1 = s0;
#pragma unroll
    for (int w2 = 0; w2 < 8; ++w2) { s0 += red[((w2 * 8 + wave) * 2 + 0) * 64 + lane]; s1 += red[((w2 * 8 + wave) * 2 + 1) * 64 + lane]; }
#pragma unroll
    for (int i = 0; i < 4; ++i) { const size_t ro = (size_t)(16 * wave + 4 * quad + i) * E.ld;
        if (E.mode == SE_SWIGLU) { const float g = s0[i]; ((bf16*)E.out)[ro + c0 + x] = bf1(g * __builtin_amdgcn_rcpf(1.0f + __expf(-g)) * s1[i]); }
        else {
#pragma unroll
            for (int t = 0; t < 2; ++t) { const size_t o = ro + c0 + 16 * t + x; const float v = t ? s1[i] : s0[i]; float r;
                if (E.mode == SE_STORE) r = v;
                else if (E.mode == SE_RESID) { r = E.alpha * E.base[o] + v; if (E.add) r += E.add[o]; }
                else r = E.base[o] * __builtin_amdgcn_rcpf(1.0f + __expf(-v));
                E.out[o] = r; } }
    }
}
__device__ __forceinline__ void strip_gemm(const bf16* A, const bf16* Bt, int K, int N, const SEpi& E, LAS unsigned char* lds, int lane, int wave, int blk, int G) {
    const int per = (E.mode == SE_SWIGLU) ? 16 : 32, ntask = N / per;
    for (int t = G - 1 - blk; t < ntask; t += G) { const int c0 = t * per;
        if (E.mode == SE_SWIGLU) { const int rb = ((c0 >> 7) << 8) + (c0 & 127); strip_task(A, Bt, K, rb, rb + 128, c0, E, lds, lane, wave); }
        else strip_task(A, Bt, K, c0, c0 + 16, c0, E, lds, lane, wave); }
    __syncthreads();
}

#ifndef EN_PRO
#define EN_PRO 1
#endif
#ifndef EN_G1
#define EN_G1 1
#endif
#ifndef EN_PREP
#define EN_PREP 1
#endif
#ifndef EN_MIX
#define EN_MIX 1
#endif
#ifndef EN_POST
#define EN_POST 1
#endif
#ifndef EN_G3
#define EN_G3 1
#endif
#ifndef EN_LN
#define EN_LN 1
#endif
#ifndef EN_G4
#define EN_G4 1
#endif
#ifndef EN_G5
#define EN_G5 1
#endif
#ifndef REP_PHASE
#define REP_PHASE -1
#endif
#define NREP(k) ((REP_PHASE) == (k) ? 2 : 1)
#ifndef MK_SINGLE
#define MK_SINGLE 1
#endif
constexpr int PPL = 11, N_PHASES = 1 + PPL * DEPTH;
constexpr int SCAN_UNITS = NBAT * 12, HSEQ_UNITS = NBAT * 6, ROLE_BLOCKS = SCAN_UNITS + HSEQ_UNITS;
constexpr int N_SGU = NBAT * 16 * 4, N_RS = NS * 12 / 8, N_HS = NS * 6 / 8, N_MISC = N_SGU + N_RS + N_HS;

__global__ void __launch_bounds__(NTHR, 2) mk_fwd(Args a) {
    extern __shared__ __attribute__((aligned(16))) unsigned char lds_raw[];
    LAS unsigned char* lds = (LAS unsigned char*)lds_raw;
    const int tid = threadIdx.x, blk = blockIdx.x, G = gridDim.x; const int wave0 = __builtin_amdgcn_readfirstlane(tid >> 6);
    ArgsP ap0 = (ArgsP)__builtin_amdgcn_kernarg_segment_ptr();
    volatile LAS unsigned* MISC = (volatile LAS unsigned*)(lds + MISC_OFF);
    for (int u = tid; u < (LDS_BYTES - LDSCTL_OFF) / 4; u += NTHR) ((LAS unsigned*)(lds + LDSCTL_OFF))[u] = 0u;
    __syncthreads();
    const int lo = ap0->ph_lo, hi = ap0->ph_hi;
    XcdBarrier bar; bar.bar = (unsigned*)(ap0->ws + WS_CTL) + CW_BAR; bar.x = 0; bar.st = nullptr;
    if (hi - lo > 1) bar = xcd_barrier_post((unsigned*)(ap0->ws + WS_CTL) + CW_BAR, MISC + 8);
    bar.w0 = (wave0 == 0);
#define IN(k) (lo <= (k) && (k) < hi)
#define SEAM(k) do { if (IN(k) && IN((k) + 1)) { xcd_barrier(bar); } } while (0)
#define PHASE_BEGIN() ArgsP a = ap0; asm volatile("" : "+s"(a)); unsigned char* ws = a->ws; int tid_ = wave0 * 64 + mk_lane_id(); asm volatile("" : "+v"(tid_)); \
    const int lane_ = tid_ & 63; const int wave_ = __builtin_amdgcn_readfirstlane(tid_ >> 6); const int lane_s = lane_, wave_s = wave_; \
    bf16* HB = (bf16*)(ws + WS_HB); float* H = (float*)(ws + WS_H); float* T = (float*)(ws + WS_T); (void)HB; (void)H; (void)T; (void)lane_s; (void)wave_s

    #if EN_PRO
    if (IN(0)) for (int rep = 0; rep < NREP(0); ++rep) { PHASE_BEGIN(); phase_prologue(a, lds, lane_, wave_, blk, G); __syncthreads(); }
#endif
    SEAM(0);
    for (int L = 0; L < DEPTH; ++L) {
        const int pb = 1 + PPL * L;
#if EN_G1
        if (IN(pb)) for (int rep = 0; rep < NREP(1); ++rep) {
            { PHASE_BEGIN(); pg8::Gemm g{HB, (const bf16*)(ws + WS_WIN + L * SZ_WIN), MP, PIN, DM}; pg8::StaticOrder S; S.init(MP, PIN, G, blk);
              pg8::EpiF32 E{(float*)(ws + WS_Z), PIN}; pg8::gemm_phase<pg8::EpiF32, pg8::StaticOrder, true, true>(lds, g, S, E, wave0); }
              { PHASE_BEGIN(); const SEpi SE{SE_STORE, (float*)(ws + WS_Z) + (size_t)MP * PIN, nullptr, nullptr, PIN, 0.f}; strip_gemm(HB + (size_t)MP * DM, (const bf16*)(ws + WS_WIN + L * SZ_WIN), DM, PIN, SE, lds, lane_s, wave_s, blk, G); }
            { PHASE_BEGIN(); pg8::Gemm g{(const bf16*)(ws + WS_PBF + L * SZ_PBF), (const bf16*)(ws + WS_WPP + L * SZ_WPP), MP, DM, DPLE}; pg8::StaticOrder S; S.init(MP, DM, G, G - 1 - blk);
              pg8::EpiF32 E{(float*)(ws + WS_PPO), DM}; pg8::gemm_phase<pg8::EpiF32, pg8::StaticOrder, true, true>(lds, g, S, E, wave0); }
              { PHASE_BEGIN(); const SEpi SE{SE_STORE, (float*)(ws + WS_PPO) + (size_t)MP * DM, nullptr, nullptr, DM, 0.f}; strip_gemm((const bf16*)(ws + WS_PBF + L * SZ_PBF) + (size_t)MP * DPLE, (const bf16*)(ws + WS_WPP + L * SZ_WPP), DPLE, DM, SE, lds, lane_s, wave_s, blk, G); }
        }
#endif
        SEAM(pb);
#if EN_PREP
        if (IN(pb + 1)) for (int rep = 0; rep < NREP(2); ++rep) { PHASE_BEGIN(); phase_xc(a, L, lane_, wave_, blk, G); }
        SEAM(pb + 1);
        if (IN(pb + 2)) for (int rep = 0; rep < NREP(9); ++rep) {
            { PHASE_BEGIN(); pg8::Gemm g{(const bf16*)(ws + WS_XCAT), (const bf16*)(ws + WS_WL + L * SZ_WL), MP, NLORA, 256}; pg8::StaticOrder S; S.init(MP, NLORA, G, blk);
            pg8::EpiF32 E{(float*)(ws + WS_LORA), NLORA}; pg8::gemm_phase<pg8::EpiF32, pg8::StaticOrder, true, true>(lds, g, S, E, wave0); }
            { PHASE_BEGIN(); const SEpi SE{SE_STORE, (float*)(ws + WS_LORA) + (size_t)MP * NLORA, nullptr, nullptr, NLORA, 0.f}; strip_gemm((const bf16*)(ws + WS_XCAT) + (size_t)MP * 256, (const bf16*)(ws + WS_WL + L * SZ_WL), 256, NLORA, SE, lds, lane_s, wave_s, blk, G); }
        }
        SEAM(pb + 2);
        if (IN(pb + 3)) for (int rep = 0; rep < NREP(10); ++rep) { PHASE_BEGIN(); phase_pre(a, L, lds, lane_, wave_, blk, G); phase_fin(a, L, lane_, wave_, blk, G); }
#endif
        SEAM(pb + 3);
#if EN_MIX
        if (IN(pb + 4)) for (int rep = 0; rep < NREP(3); ++rep) { PHASE_BEGIN();
            const int tid = tid_, lane = lane_, wave = wave_;
            if (blk < SCAN_UNITS) { for (int r2 = 0; r2 < NREP(31); ++r2) rwkv_seq_unit(a, L, blk, lds, lane, wave); }
            else if (blk < ROLE_BLOCKS) { for (int r2 = 0; r2 < NREP(32); ++r2) hgrn_stream_unit(a, L, blk - SCAN_UNITS, lds, lane, wave); }
            else for (int r2 = 0; r2 < NREP(33); ++r2) for (int it = blk - ROLE_BLOCKS; it < N_MISC; it += G - ROLE_BLOCKS) {
                if (it < N_SGU) sgu_item2(a, L, it, lds, tid, lane, wave);
                else if (it < N_SGU + N_RS) rwkv_sample_item(a, L, it - N_SGU, lds, lane, wave);
                else hgrn_sample_item2(a, L, it - N_SGU - N_RS, lds, lane, wave);
                __syncthreads();
            }
        }
#endif
        SEAM(pb + 4);
#if EN_POST
        if (IN(pb + 5)) for (int rep = 0; rep < NREP(4); ++rep) { PHASE_BEGIN(); phase_post(a, L, lane_, wave_, blk, G); }
#endif
        SEAM(pb + 5);
#if EN_G3
        if (IN(pb + 6)) for (int rep = 0; rep < NREP(5); ++rep) {
            { PHASE_BEGIN(); pg8::Gemm g{(const bf16*)(ws + WS_YMIX), (const bf16*)(ws + WS_WOUT + L * SZ_WOUT), MP, DM, DM}; pg8::StaticOrder S; S.init(MP, DM, G, blk);
            pg8::EpiResid E{T, H, nullptr, DM, DN_ALPHA}; pg8::gemm_phase<pg8::EpiResid, pg8::StaticOrder, true, true>(lds, g, S, E, wave0); }
            { PHASE_BEGIN(); const SEpi SE{SE_RESID, T + (size_t)MP * DM, H + (size_t)MP * DM, nullptr, DM, DN_ALPHA}; strip_gemm((const bf16*)(ws + WS_YMIX) + (size_t)MP * DM, (const bf16*)(ws + WS_WOUT + L * SZ_WOUT), DM, DM, SE, lds, lane_s, wave_s, blk, G); }
        }
#endif
        SEAM(pb + 6);
#if EN_LN
        if (IN(pb + 7)) for (int rep = 0; rep < NREP(6); ++rep) { PHASE_BEGIN(); phase_ln(a, a->in[I_LN1G] + L * DM, a->in[I_LN1B] + L * DM, false, lane_, wave_, blk, G); }
#endif
        SEAM(pb + 7);
#if EN_G4
        if (IN(pb + 8)) for (int rep = 0; rep < NREP(7); ++rep) {
            { PHASE_BEGIN(); pg8::Gemm g{HB, (const bf16*)(ws + WS_WGU + L * SZ_WGU), MP, 2 * DFF, DM}; pg8::StaticOrder S; S.init(MP, 2 * DFF, G, blk);
              pg8::EpiSwiglu E{(bf16*)(ws + WS_ACT), DFF}; pg8::gemm_phase<pg8::EpiSwiglu, pg8::StaticOrder, true, true>(lds, g, S, E, wave0); }
              { PHASE_BEGIN(); const SEpi SE{SE_SWIGLU, (float*)((bf16*)(ws + WS_ACT) + (size_t)MP * DFF), nullptr, nullptr, DFF, 0.f}; strip_gemm(HB + (size_t)MP * DM, (const bf16*)(ws + WS_WGU + L * SZ_WGU), DM, DFF, SE, lds, lane_s, wave_s, blk, G); }
            { PHASE_BEGIN(); pg8::Gemm g{HB, (const bf16*)(ws + WS_WPG + L * SZ_WPG), MP, DM, DM}; pg8::StaticOrder S; S.init(MP, DM, G, G - 1 - blk);
              pg8::EpiSigMul E{(float*)(ws + WS_PLE), (const float*)(ws + WS_PPO), DM}; pg8::gemm_phase<pg8::EpiSigMul, pg8::StaticOrder, true, true>(lds, g, S, E, wave0); }
              { PHASE_BEGIN(); const SEpi SE{SE_SIGMUL, (float*)(ws + WS_PLE) + (size_t)MP * DM, (const float*)(ws + WS_PPO) + (size_t)MP * DM, nullptr, DM, 0.f}; strip_gemm(HB + (size_t)MP * DM, (const bf16*)(ws + WS_WPG + L * SZ_WPG), DM, DM, SE, lds, lane_s, wave_s, blk, G); }
        }
#endif
        SEAM(pb + 8);
#if EN_G5
        if (IN(pb + 9)) for (int rep = 0; rep < NREP(8); ++rep) {
            for (int r3 = 0; r3 < NREP(81); ++r3) { PHASE_BEGIN(); pg8::Gemm g{(const bf16*)(ws + WS_ACT), (const bf16*)(ws + WS_WD + L * SZ_WD), MP, DM, DFF}; pg8::StaticOrder S; S.init(MP, DM, G, blk);
            pg8::EpiResid E{T, H, (const float*)(ws + WS_PLE), DM, DN_ALPHA}; pg8::gemm_phase<pg8::EpiResid, pg8::StaticOrder, true, true>(lds, g, S, E, wave0); }
            for (int r3 = 0; r3 < NREP(82); ++r3) { PHASE_BEGIN(); const SEpi SE{SE_RESID, T + (size_t)MP * DM, H + (size_t)MP * DM, (const float*)(ws + WS_PLE) + (size_t)MP * DM, DM, DN_ALPHA}; strip_gemm((const bf16*)(ws + WS_ACT) + (size_t)MP * DFF, (const bf16*)(ws + WS_WD + L * SZ_WD), DFF, DM, SE, lds, lane_s, wave_s, blk, G); }
        }
#endif
        SEAM(pb + 9);
#if EN_LN
        if (IN(pb + 10)) for (int rep = 0; rep < NREP(6); ++rep) { PHASE_BEGIN(); phase_ln(a, a->in[I_LN2G] + L * DM, a->in[I_LN2B] + L * DM, L == DEPTH - 1, lane_, wave_, blk, G); }
#endif
        SEAM(pb + 10);
    }
#undef IN
#undef SEAM
}

extern "C" void kernel_launch(void* const* d_in, const int* in_sizes, int n_in, void* d_out, int out_size, void* d_ws, size_t ws_size, hipStream_t stream) {
    static int grid = 0;
    if (grid == 0) {
        if (n_in != N_IN || (size_t)out_size != O_END || ws_size < WS_END) { fprintf(stderr, "kernel_launch: unexpected sizes n_in %d out %d ws %zu (need %zu)\n", n_in, out_size, ws_size, (size_t)WS_END); grid = -1; return; }
        int dev = 0, cus = 0, per_cu = 0;
        if (hipGetDevice(&dev) != hipSuccess || hipDeviceGetAttribute(&cus, hipDeviceAttributeMultiprocessorCount, dev) != hipSuccess) { grid = -1; return; }
        if (hipFuncSetAttribute((const void*)mk_fwd, hipFuncAttributeMaxDynamicSharedMemorySize, LDS_BYTES) != hipSuccess) { fprintf(stderr, "kernel_launch: hipFuncSetAttribute failed\n"); grid = -1; return; }
        if (hipOccupancyMaxActiveBlocksPerMultiprocessor(&per_cu, (const void*)mk_fwd, NTHR, LDS_BYTES) != hipSuccess || per_cu < 1) fprintf(stderr, "kernel_launch: occupancy query says %d\n", per_cu);
        (void)hipGetLastError();
        grid = cus;
        if (grid < ROLE_BLOCKS + 8) { fprintf(stderr, "kernel_launch: %d CUs is too few\n", grid); grid = -1; return; }
    }
    if (grid < 0) return;
    if (hipMemsetAsync((char*)d_ws + WS_CTL, 0, CTL_ZERO_BYTES, stream) != hipSuccess) return;
    Args a{};
    for (int i = 0; i < N_IN; ++i) a.in[i] = (const float*)d_in[i];
    a.out = (float*)d_out; a.ws = (unsigned char*)d_ws;
#if MK_SINGLE
    a.ph_lo = 0; a.ph_hi = N_PHASES;
    hipLaunchKernelGGL(mk_fwd, dim3(grid), dim3(NTHR), LDS_BYTES, stream, a);
#else
    for (int p = 0; p < N_PHASES; ++p) { a.ph_lo = p; a.ph_hi = p + 1; hipLaunchKernelGGL(mk_fwd, dim3(grid), dim3(NTHR), LDS_BYTES, stream, a); }
#endif
}
```

```cpp
#include <hip/hip_runtime.h>
#include <cstdio>
#include <cstdint>
typedef float mk_f32x2 __attribute__((ext_vector_type(2))); typedef __bf16 mk_bf16x2 __attribute__((ext_vector_type(2)));
__device__ __forceinline__ unsigned cvt_pk_bf16_c(float lo, float hi) { mk_f32x2 v = {lo, hi}; mk_bf16x2 b = __builtin_convertvector(v, mk_bf16x2); return __builtin_bit_cast(unsigned, b); }
__device__ __forceinline__ int mk_lane_id() { int l; asm volatile("v_mbcnt_lo_u32_b32 %0, -1, 0\n\tv_mbcnt_hi_u32_b32 %0, -1, %0" : "=v"(l)); return l; }
namespace pg8 {
#define PG8_LAS __attribute__((address_space(3)))
typedef unsigned short bf16_t;
typedef short bf16x8 __attribute__((ext_vector_type(8)));
typedef float f32x4 __attribute__((ext_vector_type(4)));
typedef unsigned u32x4 __attribute__((ext_vector_type(4)));
constexpr int BM = 256, BK = 64, HALF = 128, HTB = HALF * BK * 2  , STAGE_BYTES = 8 * HTB, NXCD = 8, WGM = 8;

__host__ __device__ __forceinline__ int lds_byte(int r, int c) { const int st = (r >> 4) * 2 + (c >> 5), rr = r & 15, cc = c & 31, ob = rr * 64 + cc * 2; return st * 1024 + (ob ^ (((ob >> 9) & 1) << 5)); }
__host__ __device__ __forceinline__ void stage_rc(int b, int& R, int& C) { const int st = b / 1024, sb = b % 1024, swz = sb ^ (((sb >> 9) & 1) << 5); R = (st >> 1) * 16 + swz / 64; C = (st & 1) * 32 + (swz % 64) / 2; }
__host__ __device__ __forceinline__ int perm32(int rho) { const int n = rho >> 4, i = rho & 15; return 8 * (i >> 2) + 4 * n + (i & 3); }

struct Unit { int pm, pn; };
struct Gemm { const bf16_t* A; const bf16_t* Bt; int M, N, K; };

struct StaticOrder {
    int nM, nN, nwg, G, c;
    __host__ __device__ void init(int M, int N, int G_, int c_) { nM = M / BM; nN = N / BM; nwg = nM * nN; G = G_; c = c_; }
    __host__ __device__ bool next(int i, Unit& u) const {
        const long L = (long)i * G + c; if (L >= nwg) return false;
        int wgid = (int)L; { const int q = nwg / NXCD, r = nwg % NXCD, xcd = wgid % NXCD, off = wgid / NXCD; wgid = (xcd < r ? xcd * (q + 1) : r * (q + 1) + (xcd - r) * q) + off; }
        const int nig = WGM * nN, gid = wgid / nig, fm = gid * WGM, gsz = (nM - fm) < WGM ? (nM - fm) : WGM;
        u.pm = fm + ((wgid % nig) % gsz); u.pn = (wgid % nig) / gsz; return true;
    }
    __device__ __forceinline__ void a_ready(const Unit&) const {}
    __device__ __forceinline__ void done(const Unit&) const {}
};

__device__ __forceinline__ unsigned cvt_pk_bf16(float lo, float hi) { unsigned r; asm volatile("v_cvt_pk_bf16_f32 %0, %1, %2" : "=v"(r) : "v"(lo), "v"(hi)); return r; }
typedef float f32x2 __attribute__((ext_vector_type(2)));
typedef unsigned u32x2 __attribute__((ext_vector_type(2)));
struct EpiF32 {
    static constexpr bool PERM = false, AFTER_DRAIN = false;
    float* C; int ldc;
    __device__ __forceinline__ void operator()(const f32x4 (&acc)[2][2][4][2], const Unit& u, int wr, int wc, int fr, int fq) const {
        const int row0 = u.pm * BM + wr * 64 + fr, col0 = u.pn * BM + wc * 32 + 4 * fq;
#pragma unroll
        for (int ai = 0; ai < 2; ++ai)
#pragma unroll
            for (int m = 0; m < 4; ++m) { float* rowp = C + (size_t)(row0 + ai * HALF + m * 16) * ldc + col0;
#pragma unroll
                for (int bj = 0; bj < 2; ++bj)
#pragma unroll
                    for (int n = 0; n < 2; ++n) *(f32x4*)(rowp + bj * HALF + n * 16) = acc[ai][bj][m][n]; }
    }
};
struct EpiResid {
    static constexpr bool PERM = false, AFTER_DRAIN = false;
    float* out; const float* base; const float* add; int ldc; float alpha;
    __device__ __forceinline__ void operator()(const f32x4 (&acc)[2][2][4][2], const Unit& u, int wr, int wc, int fr, int fq) const {
        const int row0 = u.pm * BM + wr * 64 + fr, col0 = u.pn * BM + wc * 32 + 4 * fq;
#pragma unroll
        for (int ai = 0; ai < 2; ++ai)
#pragma unroll
            for (int m = 0; m < 4; ++m) { const size_t off = (size_t)(row0 + ai * HALF + m * 16) * ldc + col0;
#pragma unroll
                for (int bj = 0; bj < 2; ++bj)
#pragma unroll
                    for (int n = 0; n < 2; ++n) { const size_t o2 = off + bj * HALF + n * 16; f32x4 v = *(const f32x4*)(base + o2) * alpha + acc[ai][bj][m][n];
                        if (add) v += *(const f32x4*)(add + o2); *(f32x4*)(out + o2) = v; } }
    }
};
struct EpiSigMul {
    static constexpr bool PERM = false, AFTER_DRAIN = false;
    float* out; const float* mul; int ldc;
    __device__ __forceinline__ void operator()(const f32x4 (&acc)[2][2][4][2], const Unit& u, int wr, int wc, int fr, int fq) const {
        const int row0 = u.pm * BM + wr * 64 + fr, col0 = u.pn * BM + wc * 32 + 4 * fq;
#pragma unroll
        for (int ai = 0; ai < 2; ++ai)
#pragma unroll
            for (int m = 0; m < 4; ++m) { const size_t off = (size_t)(row0 + ai * HALF + m * 16) * ldc + col0;
#pragma unroll
                for (int bj = 0; bj < 2; ++bj)
#pragma unroll
                    for (int n = 0; n < 2; ++n) { const size_t o2 = off + bj * HALF + n * 16; const f32x4 x = acc[ai][bj][m][n]; const f32x4 p = *(const f32x4*)(mul + o2); f32x4 v;
#pragma unroll
                        for (int e = 0; e < 4; ++e) v[e] = p[e] * __builtin_amdgcn_rcpf(1.0f + __expf(-x[e]));
                        *(f32x4*)(out + o2) = v; } }
    }
};
struct EpiSwiglu {
    static constexpr bool PERM = true, AFTER_DRAIN = false;
    bf16_t* O; int ldo;
    __device__ __forceinline__ void operator()(const f32x4 (&acc)[2][2][4][2], const Unit& u, int wr, int wc, int fr, int fq) const {
        const int row0 = u.pm * BM + wr * 64 + fr, col0 = u.pn * HALF + wc * 32 + 8 * fq;
#pragma unroll
        for (int ai = 0; ai < 2; ++ai)
#pragma unroll
            for (int m = 0; m < 4; ++m) { bf16_t* rowp = O + (size_t)(row0 + ai * HALF + m * 16) * ldo + col0; float r[8];
#pragma unroll
                for (int n = 0; n < 2; ++n)
#pragma unroll
                    for (int e = 0; e < 4; ++e) { const float g = acc[ai][0][m][n][e], up = acc[ai][1][m][n][e]; r[4 * n + e] = g * __builtin_amdgcn_rcpf(1.0f + __expf(-g)) * up; }
                u32x4 w; w.x = cvt_pk_bf16(r[0], r[1]); w.y = cvt_pk_bf16(r[2], r[3]); w.z = cvt_pk_bf16(r[4], r[5]); w.w = cvt_pk_bf16(r[6], r[7]);
                *(u32x4*)rowp = w; }
    }
};
template <class Epi, class Sched, bool ALIGN_EPI = false, bool SP2 = false>
__device__ __forceinline__ void gemm_phase(PG8_LAS unsigned char* lds, const Gemm g, const Sched& S, const Epi& E, int wid0) {
    int tid_l = wid0 * 64 + mk_lane_id(); asm volatile("" : "+v"(tid_l));
    const int tid = tid_l, wid = __builtin_amdgcn_readfirstlane(tid >> 6), lane = tid & 63, wr = wid >> 2, wc = wid & 3, fr = lane & 15, fq = lane >> 4;
    const int K = g.K, nt = K / BK;
    unsigned voffA[2], voffB[2];
#pragma unroll
    for (int i = 0; i < 2; ++i) { int R, C; stage_rc(tid * 16 + i * 8192, R, C); const int Rb = Epi::PERM ? ((R & ~31) + perm32(R & 31)) : R;
        voffA[i] = (unsigned)(R * K + C) * 2u; voffB[i] = (unsigned)(Rb * K + C) * 2u; }
    const size_t kstep = (size_t)(BK * 2);
    const size_t hstep = (size_t)HALF * K * 2;
    const size_t tstep = 2 * hstep;
    const unsigned ldsw = (unsigned)wid * 1024u;
    const int aoff = lds_byte(wr * 64 + fr, fq * 8), boff = lds_byte(wc * 32 + fr, fq * 8);
#define PG8_SA(b, h) (((b) * 2 + (h)) * HTB)
#define PG8_SB(b, h) ((4 + (b) * 2 + (h)) * HTB)
#define PG8_STAGE(bufoff, gbase, voff) do { _Pragma("unroll") for (int _i = 0; _i < 2; ++_i) \
        __builtin_amdgcn_global_load_lds((const unsigned*)((const char*)(gbase) + (voff)[_i]), (PG8_LAS unsigned*)(lds + (bufoff) + ldsw + _i * 8192), 16, 0, 0); } while (0)
#define PG8_LDA(dst, b, h) do { _Pragma("unroll") for (int m = 0; m < 4; ++m) _Pragma("unroll") for (int k = 0; k < 2; ++k) dst[m][k] = *(const PG8_LAS bf16x8*)(lds + PG8_SA(b, h) + aoff + m * 2048 + k * 1024); } while (0)
#define PG8_LDB(dst, b, h) do { _Pragma("unroll") for (int n = 0; n < 2; ++n) _Pragma("unroll") for (int k = 0; k < 2; ++k) dst[n][k] = *(const PG8_LAS bf16x8*)(lds + PG8_SB(b, h) + boff + n * 2048 + k * 1024); } while (0)
#define PG8_MMA(ai, bj, At, Bt) do { __builtin_amdgcn_s_setprio(1); _Pragma("unroll") for (int m = 0; m < 4; ++m) _Pragma("unroll") for (int n = 0; n < 2; ++n) _Pragma("unroll") for (int k = 0; k < 2; ++k) \
        acc[ai][bj][m][n] = __builtin_amdgcn_mfma_f32_16x16x32_bf16(Bt[n][k], At[m][k], acc[ai][bj][m][n], 0, 0, 0); __builtin_amdgcn_s_setprio(0); } while (0)
#define PG8_WAIT_V(n) asm volatile("s_waitcnt vmcnt(" #n ")" ::: "memory")
#define PG8_WAIT_L(n) asm volatile("s_waitcnt lgkmcnt(" #n ")" ::: "memory")
#define PG8_BAR __builtin_amdgcn_s_barrier()
#define PG8_SCHED __builtin_amdgcn_sched_barrier(0)
    Unit cur, nxt; int ui = 0;
    if (!S.next(0, cur)) return;
    f32x4 acc[2][2][4][2];
#pragma unroll
    for (int a = 0; a < 2; ++a)
#pragma unroll
        for (int b = 0; b < 2; ++b)
#pragma unroll
            for (int m = 0; m < 4; ++m)
#pragma unroll
                for (int n = 0; n < 2; ++n) acc[a][b][m][n] = (f32x4){0.f, 0.f, 0.f, 0.f};
    bf16x8 At[4][2], B0[2][2], B1[2][2];
    const char* cA = (const char*)g.A + (size_t)cur.pm * tstep; const char* cB = (const char*)g.Bt + (size_t)cur.pn * tstep;
    S.a_ready(cur);
    if constexpr (SP2) {
        PG8_STAGE(PG8_SB(0, 0), cB, voffB); PG8_STAGE(PG8_SB(0, 1), cB + hstep, voffB); PG8_STAGE(PG8_SA(0, 0), cA, voffA); PG8_STAGE(PG8_SA(0, 1), cA + hstep, voffA);
        if (wr == 1) PG8_BAR;
        PG8_WAIT_V(2); PG8_BAR;
        PG8_STAGE(PG8_SB(1, 0), cB + kstep, voffB); PG8_STAGE(PG8_SA(1, 0), cA + kstep, voffA); PG8_STAGE(PG8_SB(1, 1), cB + hstep + kstep, voffB);
        PG8_WAIT_V(6); PG8_BAR;
    } else {
        PG8_STAGE(PG8_SB(0, 0), cB, voffB); PG8_STAGE(PG8_SA(0, 0), cA, voffA); PG8_STAGE(PG8_SB(0, 1), cB + hstep, voffB); PG8_STAGE(PG8_SA(0, 1), cA + hstep, voffA);
        if (wr == 1) PG8_BAR;
        PG8_WAIT_V(4); PG8_BAR;
        PG8_STAGE(PG8_SB(1, 0), cB + kstep, voffB); PG8_STAGE(PG8_SA(1, 0), cA + kstep, voffA); PG8_STAGE(PG8_SB(1, 1), cB + hstep + kstep, voffB);
        PG8_WAIT_V(6); PG8_BAR;
    }
    for (;;) {
        const bool has_next = S.next(ui + 1, nxt);
        const char* nA = has_next ? (const char*)g.A + (size_t)nxt.pm * tstep : cA; const char* nB = has_next ? (const char*)g.Bt + (size_t)nxt.pn * tstep : cB;
        for (int t = 0; t < nt; t += 2) {
            const bool last = (t == nt - 2);
            const char* a1 = cA + (size_t)(t + 1) * kstep;
            const char* a2 = last ? nA : cA + (size_t)(t + 2) * kstep; const char* b2 = last ? nB : cB + (size_t)(t + 2) * kstep;
            const char* a3 = a2 + kstep; const char* b3 = b2 + kstep;
            if (last && has_next) S.a_ready(nxt);
            if constexpr (SP2) {
            PG8_LDB(B0, 0, 0); PG8_LDB(B1, 0, 1); PG8_SCHED; PG8_LDA(At, 0, 0); PG8_STAGE(PG8_SA(1, 1), a1 + hstep, voffA);
            PG8_WAIT_V(8); PG8_WAIT_L(0); PG8_BAR; PG8_MMA(0, 0, At, B0); PG8_MMA(0, 1, At, B1); PG8_BAR; PG8_SCHED;
            PG8_LDA(At, 0, 1); PG8_STAGE(PG8_SB(0, 0), b2, voffB); PG8_STAGE(PG8_SB(0, 1), b2 + hstep, voffB); PG8_STAGE(PG8_SA(0, 0), a2, voffA);
            PG8_WAIT_V(8); PG8_WAIT_L(0); PG8_BAR; PG8_MMA(1, 0, At, B0); PG8_MMA(1, 1, At, B1); PG8_BAR; PG8_SCHED;
            PG8_LDB(B0, 1, 0); PG8_LDB(B1, 1, 1); PG8_SCHED; PG8_LDA(At, 1, 0); PG8_STAGE(PG8_SA(0, 1), a2 + hstep, voffA);
            PG8_WAIT_V(8); PG8_WAIT_L(0); PG8_BAR; PG8_MMA(0, 0, At, B0); PG8_MMA(0, 1, At, B1); PG8_BAR; PG8_SCHED;
            PG8_LDA(At, 1, 1); PG8_STAGE(PG8_SB(1, 0), b3, voffB); PG8_STAGE(PG8_SB(1, 1), b3 + hstep, voffB); PG8_STAGE(PG8_SA(1, 0), a3, voffA);
            PG8_WAIT_V(8); PG8_WAIT_L(0); PG8_BAR; PG8_MMA(1, 0, At, B0); PG8_MMA(1, 1, At, B1); PG8_BAR; PG8_SCHED;
            } else {
            PG8_LDB(B0, 0, 0); PG8_SCHED; PG8_LDA(At, 0, 0); PG8_STAGE(PG8_SA(1, 1), a1 + hstep, voffA);
            PG8_WAIT_L(8); PG8_BAR; PG8_WAIT_L(0); PG8_MMA(0, 0, At, B0); PG8_BAR; PG8_SCHED;
            PG8_LDB(B1, 0, 1); PG8_STAGE(PG8_SB(0, 0), b2, voffB);
            PG8_BAR; PG8_WAIT_L(0); PG8_MMA(0, 1, At, B1); PG8_BAR;
            PG8_LDA(At, 0, 1); PG8_STAGE(PG8_SA(0, 0), a2, voffA);
            PG8_BAR; PG8_WAIT_L(0); PG8_MMA(1, 0, At, B0); PG8_BAR; PG8_SCHED;
            PG8_STAGE(PG8_SB(0, 1), b2 + hstep, voffB);
            PG8_WAIT_V(6); PG8_BAR; PG8_MMA(1, 1, At, B1); PG8_BAR;
            PG8_LDB(B0, 1, 0); PG8_SCHED; PG8_LDA(At, 1, 0); PG8_STAGE(PG8_SA(0, 1), a2 + hstep, voffA);
            PG8_WAIT_L(8); PG8_BAR; PG8_WAIT_L(0); PG8_MMA(0, 0, At, B0); PG8_BAR; PG8_SCHED;
            PG8_LDB(B1, 1, 1); PG8_STAGE(PG8_SB(1, 0), b3, voffB);
            PG8_BAR; PG8_WAIT_L(0); PG8_MMA(0, 1, At, B1); PG8_BAR;
            PG8_LDA(At, 1, 1); PG8_STAGE(PG8_SA(1, 0), a3, voffA);
            PG8_BAR; PG8_WAIT_L(0); PG8_MMA(1, 0, At, B0); PG8_BAR; PG8_SCHED;
            PG8_STAGE(PG8_SB(1, 1), b3 + hstep, voffB);
            PG8_WAIT_V(6); PG8_BAR; PG8_MMA(1, 1, At, B1); PG8_BAR;
            }
        }
        if constexpr (ALIGN_EPI) { if (wr == 0) PG8_BAR; }
        if constexpr (!Epi::AFTER_DRAIN) { E(acc, cur, wr, wc, fr, fq); S.done(cur); }
        if (!has_next) break;
#pragma unroll
        for (int a = 0; a < 2; ++a)
#pragma unroll
            for (int b = 0; b < 2; ++b)
#pragma unroll
                for (int m = 0; m < 4; ++m)
#pragma unroll
                    for (int n = 0; n < 2; ++n) acc[a][b][m][n] = (f32x4){0.f, 0.f, 0.f, 0.f};
        cur = nxt; cA = nA; cB = nB; ++ui;
        if constexpr (ALIGN_EPI) { if (wr == 1) PG8_BAR; }
    }
    PG8_WAIT_V(0);
    if constexpr (!ALIGN_EPI) { if (wr == 0) PG8_BAR; }
    PG8_BAR;
    if constexpr (Epi::AFTER_DRAIN) { E.fused(acc, cur, wr, wc, fr, fq, lds, wid, lane); S.done(cur); }
#undef PG8_SA
#undef PG8_SB
#undef PG8_STAGE
#undef PG8_LDA
#undef PG8_LDB
#undef PG8_MMA
#undef PG8_WAIT_V
#undef PG8_WAIT_L
#undef PG8_BAR
#undef PG8_SCHED
}
}
#define GAS __attribute__((address_space(1)))
#define LAS __attribute__((address_space(3)))
typedef unsigned short bf16;
typedef unsigned v4u __attribute__((ext_vector_type(4)));
typedef float f32x4 __attribute__((ext_vector_type(4)));
typedef short bf16x8 __attribute__((ext_vector_type(8)));
typedef GAS unsigned gu32;
typedef GAS unsigned long long gu64;
#define RLX_AGENT __ATOMIC_RELAXED, __HIP_MEMORY_SCOPE_AGENT
#define LDS_WAIT() asm volatile("s_waitcnt lgkmcnt(0)" ::: "memory")
#define VM_WAIT() asm volatile("s_waitcnt vmcnt(0)" ::: "memory")
__device__ __forceinline__ unsigned long long rt() { return __builtin_amdgcn_s_memrealtime(); }
__device__ __forceinline__ unsigned f2bf(float f) { unsigned u = __builtin_bit_cast(unsigned, f); return (u + 0x7fffu + ((u >> 16) & 1u)) >> 16; }
__device__ __forceinline__ unsigned pk2(float lo, float hi) { return f2bf(lo) | (f2bf(hi) << 16); }

#define XB_TMO      128
#define XB_XCNT(j)  (256  + 64 * (j))
#define XB_XSUB(j)  (1280 + 64 * (j))
#define XB_XGEN(j)  (2304 + 64 * (j))
#define XB_TOP      3328
#define XB_TOPGEN   3392
#define XCD_BAR_WORDS 3456
#define XB_SPIN_CAP (1u << 18)

__device__ __forceinline__ unsigned xb_ld(unsigned* p)              { return __hip_atomic_load(p, __ATOMIC_RELAXED, __HIP_MEMORY_SCOPE_AGENT); }
__device__ __forceinline__ unsigned xb_add(unsigned* p, unsigned v) { return __hip_atomic_fetch_add(p, v, __ATOMIC_RELAXED, __HIP_MEMORY_SCOPE_AGENT); }
__device__ __forceinline__ unsigned xb_xcc_id() { return (unsigned)__builtin_amdgcn_s_getreg((3 << 11) | 20) & 0xFu; }
#define XB_SPIN(cond, bar) do { unsigned _sp = 0; while (cond) { __builtin_amdgcn_s_sleep(1); \
    if ((++_sp & 255u) == 0u) { if (xb_ld(&(bar)[XB_TMO])) break; if (_sp > XB_SPIN_CAP) { atomicAdd(&(bar)[XB_TMO], 1u); break; } } } } while (0)

struct XcdBarrier {
    unsigned* bar; unsigned x;
    volatile LAS unsigned* st;
    bool w0;
};

__device__ __forceinline__ XcdBarrier xcd_barrier_post(unsigned* bar, volatile LAS unsigned* st) {
    XcdBarrier b; b.bar = bar; b.x = xb_xcc_id(); b.st = st;
    if (threadIdx.x == 0) (void)xb_add(&bar[XB_XCNT(b.x)], 1u);
    return b;
}
__device__ __forceinline__ void xcd_barrier_complete(unsigned* bar, unsigned x, unsigned& nloc, unsigned& nx) {
    const unsigned G = gridDim.x * gridDim.y * gridDim.z;
    unsigned sum, cnt, mine, sp = 0u;
    for (;;) {
        sum = 0u; cnt = 0u; mine = 0u;
#pragma unroll
        for (unsigned j = 0; j < 16; ++j) { const unsigned c = xb_ld(&bar[XB_XCNT(j)]); sum += c; cnt += (c > 0u) ? 1u : 0u; mine = (j == x) ? c : mine; }
        if (sum == G) break;
        __builtin_amdgcn_s_sleep(1);
        if ((++sp & 255u) == 0u) { if (xb_ld(&bar[XB_TMO])) break; if (sp > XB_SPIN_CAP) { atomicAdd(&bar[XB_TMO], 1u); break; } }
    }
    nloc = mine > 0u ? mine : 1u; nx = cnt > 0u ? cnt : 1u;
}

__device__ __forceinline__ void xcd_barrier(const XcdBarrier& b) {
    asm volatile("s_waitcnt vmcnt(0)" ::: "memory");
    __syncthreads();
    if (b.w0 && mk_lane_id() == 0) {
        unsigned* bar = b.bar;
        __builtin_amdgcn_s_waitcnt(0);
        unsigned nloc = b.st[0], nx = b.st[1];
        if (nloc == 0u) { xcd_barrier_complete(bar, b.x, nloc, nx); b.st[0] = nloc; b.st[1] = nx; }
        const unsigned old = xb_add(&bar[XB_XSUB(b.x)], 1u);
        const unsigned gen = old / nloc;
        if (old + 1u == (gen + 1u) * nloc) {
            __builtin_amdgcn_fence(__ATOMIC_RELEASE, "agent");
            asm volatile("s_waitcnt vmcnt(0)" ::: "memory");
            const unsigned og = xb_add(&bar[XB_TOP], 1u);
            const unsigned tg = og / nx;
            if (og + 1u == (tg + 1u) * nx) xb_add(&bar[XB_TOPGEN], 1u);
            else XB_SPIN(xb_ld(&bar[XB_TOPGEN]) == tg, bar);
            __builtin_amdgcn_fence(__ATOMIC_ACQUIRE, "agent");
            xb_add(&bar[XB_XGEN(b.x)], 1u);
            asm volatile("s_waitcnt vmcnt(0)" ::: "memory");
        } else {
            XB_SPIN(xb_ld(&bar[XB_XGEN(b.x)]) == gen, bar);
            __builtin_amdgcn_fence(__ATOMIC_ACQUIRE, "agent");
            asm volatile("s_waitcnt vmcnt(0)" ::: "memory");
        }
    }
    __syncthreads();
}

constexpr int DM = 2048, NBAT = 4, SEQ = 2048, DEPTH = 4, NS = 128;
constexpr int MP = NBAT * SEQ;
constexpr int MV = MP + NS;
constexpr int MPAD = 8448;
constexpr int WA = 512, WB = 768, WC = 768, PIN = 6656, DFF = 5632, DPLE = 256, PBW = 2560;
constexpr int OFF_B = 1024, OFF_C = 3584;
constexpr float LN_EPS = 1e-5f, GN_EPS = 64e-5f, RMS_EPS = 1e-6f;
constexpr float DN_ALPHA = 1.681792830507429f;
enum { I_XP = 0, I_XS, I_SRWKV, I_SSHIFT, I_SHGRN, I_PP, I_PS, I_LNING, I_LNINB, I_WIN, I_ALNG, I_ALNB, I_AWS, I_ABS, I_BMU, I_BW0, I_BWUP, I_BA0, I_BAUP, I_BGUP,
       I_BKK, I_BKA, I_BRK, I_BGNG, I_BGNB, I_CLB, I_CNG, I_WOUT, I_LN1G, I_LN1B, I_WG, I_WU, I_WD, I_WPG, I_WPP, I_LN2G, I_LN2B, N_IN };
constexpr size_t O_YP = 0, O_YS = O_YP + (size_t)MP * DM, O_RP = O_YS + (size_t)NS * DM, O_SP = O_RP + (size_t)DEPTH * NBAT * 12 * 4096,
                 O_HP = O_SP + (size_t)DEPTH * NBAT * PBW, O_RS = O_HP + (size_t)DEPTH * NBAT * 6 * 16384, O_SS = O_RS + (size_t)DEPTH * NS * 12 * 4096,
                 O_HS = O_SS + (size_t)DEPTH * NS * PBW, O_VS = O_HS + (size_t)DEPTH * NS * 6 * 16384, O_END = O_VS + (size_t)DEPTH * NS * WA;
static_assert(O_END == 96509952, "output size");
constexpr size_t al256(size_t x) { return (x + 255) & ~(size_t)255; }
constexpr size_t WS_CTL = 0, CTL_ZERO_BYTES = 1u << 20;
constexpr size_t SZ_WIN = (size_t)PIN * DM * 2, SZ_WOUT = (size_t)DM * DM * 2, SZ_WGU = (size_t)2 * DFF * DM * 2, SZ_WD = (size_t)DM * DFF * 2, SZ_WPG = SZ_WOUT, SZ_WPP = (size_t)DM * DPLE * 2;
constexpr size_t WS_WIN = CTL_ZERO_BYTES, WS_WOUT = WS_WIN + DEPTH * SZ_WIN, WS_WGU = WS_WOUT + DEPTH * SZ_WOUT, WS_WD = WS_WGU + DEPTH * SZ_WGU, WS_WPG = WS_WD + DEPTH * SZ_WD,
                 WS_WPP = WS_WPG + DEPTH * SZ_WPG, WS_PBF = WS_WPP + DEPTH * SZ_WPP;
constexpr size_t SZ_PBF = (size_t)MPAD * DPLE * 2;
constexpr size_t WS_H = WS_PBF + DEPTH * SZ_PBF, WS_HB = WS_H + (size_t)MPAD * DM * 4, WS_T = WS_HB + (size_t)MPAD * DM * 2, WS_YMIX = WS_T + (size_t)MPAD * DM * 4;
constexpr size_t WS_Z = WS_YMIX + (size_t)MPAD * DM * 2;
constexpr size_t WS_ACT = WS_Z, WS_PLE = WS_ACT + al256((size_t)MPAD * DFF * 2);
constexpr size_t WS_PPO = WS_Z + (size_t)MPAD * PIN * 4;
static_assert(WS_PLE + (size_t)MPAD * DM * 4 <= WS_PPO, "overlay fits");
constexpr size_t WS_RPB = WS_PPO + (size_t)MPAD * DM * 4;
constexpr size_t WS_RPS = WS_RPB + (size_t)NBAT * 12 * (SEQ / 16) * 16384;
constexpr int NLORA = 3 * WB;
constexpr size_t SZ_WL = (size_t)NLORA * 256 * 2;
constexpr size_t WS_WL = WS_RPS + (size_t)NS * 12 * 384 * 4;
constexpr size_t WS_XCAT = WS_WL + DEPTH * SZ_WL;
constexpr size_t WS_LORA = WS_XCAT + (size_t)MPAD * 256 * 2;
constexpr size_t WS_Y = WS_LORA + (size_t)MPAD * NLORA * 4;
constexpr size_t WS_O = WS_Y + (size_t)MPAD * WB * 4;
constexpr size_t WS_HREC = WS_O + (size_t)MPAD * WC * 4;
constexpr size_t WS_END = WS_HREC + (size_t)NBAT * 6 * (SEQ / 16) * 17408;
static_assert(WS_WIN % 256 == 0 && WS_H % 256 == 0 && WS_Z % 256 == 0 && WS_RPB % 256 == 0 && WS_WL % 256 == 0 && WS_XCAT % 256 == 0 && WS_LORA % 256 == 0 && WS_Y % 256 == 0, "alignment");
constexpr int CW_BAR = 4096;

constexpr int RING_BYTES = 131072, LDSCTL_OFF = RING_BYTES, MISC_OFF = LDSCTL_OFF + 320, LDS_BYTES = 147456;
constexpr int NWAVES = 8, NTHR = 512;

struct Args { const float* in[N_IN]; float* out; unsigned char* ws; int ph_lo, ph_hi; };
static_assert(sizeof(Args) == (N_IN + 2) * 8 + 8, "no padding in Args");
typedef const __attribute__((address_space(4))) Args* ArgsP;

typedef float f4 __attribute__((ext_vector_type(4)));
typedef float f2 __attribute__((ext_vector_type(2)));
typedef unsigned u2 __attribute__((ext_vector_type(2)));

__device__ __forceinline__ float wave_sum(float v) {
#pragma unroll
    for (int o = 1; o < 64; o <<= 1) v += __shfl_xor(v, o);
    return v;
}
template <int CTRL> __device__ __forceinline__ float dpp_f(float x) { return __builtin_bit_cast(float, __builtin_amdgcn_update_dpp(0, __builtin_bit_cast(int, x), CTRL, 0xF, 0xF, true)); }
__device__ __forceinline__ float row16_sum(float x) {
    x += dpp_f<0xB1>(x);
    x += dpp_f<0x4E>(x);
    x += dpp_f<0x141>(x);
    x += dpp_f<0x140>(x);
    return x;
}
__device__ __forceinline__ float sigmoidf_(float x) { return 1.0f / (1.0f + expf(-x)); }
__device__ __forceinline__ float gelu_erf(float x) { return 0.5f * x * (1.0f + erff(x * 0.70710678118654752f)); }
__device__ __forceinline__ unsigned short bf1(float x) { return (unsigned short)(cvt_pk_bf16_c(x, 0.f) & 0xffffu); }
__device__ __forceinline__ float lbound(const float* clb, int L, int c) {
    const float x0 = clb[c], x1 = clb[WC + c], x2 = clb[2 * WC + c], x3 = clb[3 * WC + c];
    const float mx = fmaxf(fmaxf(x0, x1), fmaxf(x2, x3));
    const float e0 = expf(x0 - mx), e1 = expf(x1 - mx), e2 = expf(x2 - mx), e3 = expf(x3 - mx);
    float s = 0.f; if (L >= 1) s += e1; if (L >= 2) s += e2; if (L >= 3) s += e3;
    return s / (e0 + e1 + e2 + e3);
}
__device__ __forceinline__ float log_sigmoid(float x) { return fminf(x, 0.f) - log1pf(expf(-fabsf(x))); }

__device__ __forceinline__ void tr_item(const float* W, int K, int N, bf16* WT, int mode, LAS float* scr, int item, int lane) {
    const int nblk = N >> 5, kb = item / nblk, nb = item - kb * nblk, k0 = kb << 6, n0 = nb << 5;
    int rb = n0; if (mode) rb = ((n0 >> 7) << 8) + (n0 & 127) + (mode == 2 ? 128 : 0);
#pragma unroll 8
    for (int i = 0; i < 32; ++i) { const int kk = 2 * i + (lane >> 5); scr[kk * 33 + (lane & 31)] = W[(size_t)(k0 + kk) * N + n0 + (lane & 31)]; }
    LDS_WAIT(); asm volatile("" ::: "memory");
    const int c = lane & 7;
#pragma unroll
    for (int j = 0; j < 4; ++j) { const int n = (lane >> 3) + 8 * j; const LAS float* s = scr + (8 * c) * 33 + n;
        v4u o; o.x = pg8::cvt_pk_bf16(s[0 * 33], s[1 * 33]); o.y = pg8::cvt_pk_bf16(s[2 * 33], s[3 * 33]); o.z = pg8::cvt_pk_bf16(s[4 * 33], s[5 * 33]); o.w = pg8::cvt_pk_bf16(s[6 * 33], s[7 * 33]);
        *(v4u*)(WT + (size_t)(rb + n) * K + k0 + 8 * c) = o; }
    LDS_WAIT(); asm volatile("" ::: "memory");
}
__device__ __forceinline__ void ln_row(const float* src, const float* g, const float* b, float* dstf, bf16* dstb, float* dst2, int lane) {
    f4 v[8]; float s = 0.f;
#pragma unroll
    for (int j = 0; j < 8; ++j) { v[j] = *(const f4*)(src + 4 * (lane + 64 * j)); s += (v[j].x + v[j].y) + (v[j].z + v[j].w); }
    const float mean = wave_sum(s) * (1.f / DM); float s2 = 0.f;
#pragma unroll
    for (int j = 0; j < 8; ++j) { v[j] = v[j] - mean; s2 += (v[j].x * v[j].x + v[j].y * v[j].y) + (v[j].z * v[j].z + v[j].w * v[j].w); }
    const float rstd = 1.0f / sqrtf(wave_sum(s2) * (1.f / DM) + LN_EPS);
#pragma unroll
    for (int j = 0; j < 8; ++j) { const int c = 4 * (lane + 64 * j); const f4 gg = *(const f4*)(g + c), bb = *(const f4*)(b + c); const f4 o = v[j] * rstd * gg + bb;
        *(f4*)(dstf + c) = o; if (dst2) *(f4*)(dst2 + c) = o;
        u2 w; w.x = pg8::cvt_pk_bf16(o.x, o.y); w.y = pg8::cvt_pk_bf16(o.z, o.w); *(u2*)(dstb + c) = w; }
}
__device__ __forceinline__ void phase_prologue(ArgsP a, LAS unsigned char* lds, int lane, int wave, int blk, int G) {
    LAS float* scr = (LAS float*)(lds + wave * 16384);
    const int gw = blk * NWAVES + wave, NGW = G * NWAVES;
    constexpr int I_IN = 32 * (PIN / 32), I_OUT = 32 * (DM / 32), I_G = 32 * (DFF / 32), I_D = (DFF / 64) * (DM / 32), I_PGc = I_OUT, I_PPc = (DPLE / 64) * (DM / 32);
    constexpr int PER_L = I_IN + I_OUT + 2 * I_G + I_D + I_PGc + I_PPc;
    unsigned char* ws = a->ws;
    for (int it = gw; it < DEPTH * PER_L; it += NGW) {
        const int L = it / PER_L; int r = it - L * PER_L;
        if (r < I_IN) { tr_item(a->in[I_WIN] + (size_t)L * DM * PIN, DM, PIN, (bf16*)(ws + WS_WIN + L * SZ_WIN), 0, scr, r, lane); continue; } r -= I_IN;
        if (r < I_OUT) { tr_item(a->in[I_WOUT] + (size_t)L * DM * DM, DM, DM, (bf16*)(ws + WS_WOUT + L * SZ_WOUT), 0, scr, r, lane); continue; } r -= I_OUT;
        if (r < I_G) { tr_item(a->in[I_WG] + (size_t)L * DM * DFF, DM, DFF, (bf16*)(ws + WS_WGU + L * SZ_WGU), 1, scr, r, lane); continue; } r -= I_G;
        if (r < I_G) { tr_item(a->in[I_WU] + (size_t)L * DM * DFF, DM, DFF, (bf16*)(ws + WS_WGU + L * SZ_WGU), 2, scr, r, lane); continue; } r -= I_G;
        if (r < I_D) { tr_item(a->in[I_WD] + (size_t)L * DFF * DM, DFF, DM, (bf16*)(ws + WS_WD + L * SZ_WD), 0, scr, r, lane); continue; } r -= I_D;
        if (r < I_PGc) { tr_item(a->in[I_WPG] + (size_t)L * DM * DM, DM, DM, (bf16*)(ws + WS_WPG + L * SZ_WPG), 0, scr, r, lane); continue; } r -= I_PGc;
        tr_item(a->in[I_WPP] + (size_t)L * DPLE * DM, DPLE, DM, (bf16*)(ws + WS_WPP + L * SZ_WPP), 0, scr, r, lane);
    }
    for (int it = gw; it < DEPTH * NLORA; it += NGW) { const int L = it / NLORA, n = it - L * NLORA; float v[4];
#pragma unroll
        for (int e = 0; e < 4; ++e) { const int k = 4 * lane + e; float x = 0.f;
            if (n < WB) { if (k < 64) x = a->in[I_BWUP][((size_t)L * 64 + k) * WB + n]; }
            else if (n < 2 * WB) { if (k >= 64 && k < 128) x = a->in[I_BAUP][((size_t)L * 64 + (k - 64)) * WB + (n - WB)]; }
            else { if (k >= 128) x = a->in[I_BGUP][((size_t)L * 128 + (k - 128)) * WB + (n - 2 * WB)]; }
            v[e] = x; }
        u2 w; w.x = pg8::cvt_pk_bf16(v[0], v[1]); w.y = pg8::cvt_pk_bf16(v[2], v[3]); *(u2*)((bf16*)(ws + WS_WL + L * SZ_WL) + (size_t)n * 256 + 4 * lane) = w; }
    for (int it = gw; it < DEPTH * MV; it += NGW) { const int L = it / MV, m = it - L * MV;
        const float* src = (m < MP) ? a->in[I_PP] + ((size_t)L * MP + m) * DPLE : a->in[I_PS] + ((size_t)L * NS + (m - MP)) * DPLE;
        const f4 v = *(const f4*)(src + 4 * lane); u2 w; w.x = pg8::cvt_pk_bf16(v.x, v.y); w.y = pg8::cvt_pk_bf16(v.z, v.w);
        *(u2*)((bf16*)(ws + WS_PBF + L * SZ_PBF) + (size_t)m * DPLE + 4 * lane) = w; }
    for (int m = gw; m < MV; m += NGW) { const float* src = (m < MP) ? a->in[I_XP] + (size_t)m * DM : a->in[I_XS] + (size_t)(m - MP) * DM;
        ln_row(src, a->in[I_LNING], a->in[I_LNINB], (float*)(ws + WS_H) + (size_t)m * DM, (bf16*)(ws + WS_HB) + (size_t)m * DM, nullptr, lane); }
}
__device__ __forceinline__ void phase_ln(ArgsP a, const float* g, const float* b, bool last, int lane, int wave, int blk, int G) {
    const int gw = blk * NWAVES + wave, NGW = G * NWAVES; unsigned char* ws = a->ws;
    for (int m = gw; m < MV; m += NGW)
        ln_row((const float*)(ws + WS_T) + (size_t)m * DM, g, b, (float*)(ws + WS_H) + (size_t)m * DM, (bf16*)(ws + WS_HB) + (size_t)m * DM,
               last ? a->out + (m < MP ? O_YP + (size_t)m * DM : O_YS + (size_t)(m - MP) * DM) : nullptr, lane);
}


__device__ __forceinline__ void phase_xc(ArgsP a, int L, int lane, int wave, int blk, int G) {
    unsigned char* ws = a->ws; const int gw = blk * NWAVES + wave, NGW = G * NWAVES;
    const float* Z = (const float*)(ws + WS_Z);
    const float* mu = a->in[I_BMU] + L * PBW; const float* sh0 = a->in[I_SSHIFT] + (size_t)L * NS * PBW;
    const f4 mu4 = *(const f4*)(mu + 2304 + 4 * lane);
    for (int m = gw; m < MV; m += NGW) {
        const bool samp = m >= MP; const float* zr = Z + (size_t)m * PIN + OFF_B;
        const f4 cur = *(const f4*)(zr + 2304 + 4 * lane); f4 prev;
        if (samp) prev = *(const f4*)(sh0 + (size_t)(m - MP) * PBW + 2304 + 4 * lane); else if (m & (SEQ - 1)) prev = *(const f4*)(zr - PIN + 2304 + 4 * lane); else prev = (f4){0.f, 0.f, 0.f, 0.f};
        f4 x = cur + mu4 * (prev - cur);
        if (lane < 16) { x.x = tanhf(x.x); x.y = tanhf(x.y); x.z = tanhf(x.z); x.w = tanhf(x.w); }
        else if (lane >= 32) { x.x = sigmoidf_(x.x); x.y = sigmoidf_(x.y); x.z = sigmoidf_(x.z); x.w = sigmoidf_(x.w); }
        u2 w; w.x = pg8::cvt_pk_bf16(x.x, x.y); w.y = pg8::cvt_pk_bf16(x.z, x.w); *(u2*)((bf16*)(ws + WS_XCAT) + (size_t)m * 256 + 4 * lane) = w;
        if (samp || (m & (SEQ - 1)) == SEQ - 1) { float* dst = samp ? a->out + O_SS + ((size_t)L * NS + (m - MP)) * PBW : a->out + O_SP + ((size_t)L * NBAT + (m >> 11)) * PBW;
#pragma unroll
            for (int j = 0; j < PBW / 256; ++j) *(f4*)(dst + 256 * j + 4 * lane) = *(const f4*)(zr + 256 * j + 4 * lane); }
        if (samp) { const int i = m - MP; const float* z0 = Z + (size_t)m * PIN; const float* lng = a->in[I_ALNG] + L * WA; const float* lnb = a->in[I_ALNB] + L * WA;
            for (int g = 0; g < 4; ++g) {
                const float u0 = gelu_erf(z0[g * 128 + lane]), u1 = gelu_erf(z0[g * 128 + 64 + lane]);
                const float v0 = gelu_erf(z0[WA + g * 128 + lane]), v1 = gelu_erf(z0[WA + g * 128 + 64 + lane]);
                const float mean = wave_sum(v0 + v1) * (1.f / 128.f); const float d0 = v0 - mean, d1 = v1 - mean;
                const float rstd = 1.0f / sqrtf(wave_sum(d0 * d0 + d1 * d1) * (1.f / 128.f) + LN_EPS);
                const float n0 = d0 * rstd * lng[g * 128 + lane] + lnb[g * 128 + lane], n1 = d1 * rstd * lng[g * 128 + 64 + lane] + lnb[g * 128 + 64 + lane];
                float* ov = a->out + O_VS + ((size_t)L * NS + i) * WA + g * 128; ov[lane] = n0; ov[64 + lane] = n1;
                const float w00 = a->in[I_AWS][(size_t)(L * 4 + g) * 16384], b0 = a->in[I_ABS][(L * 4 + g) * 128];
                bf16* yo = (bf16*)(ws + WS_YMIX) + (size_t)m * DM + g * 128; yo[lane] = bf1(u0 * (w00 * n0 + b0)); yo[64 + lane] = bf1(u1 * (w00 * n1 + b0)); } }
    }
}
__device__ __forceinline__ void phase_fin(ArgsP a, int L, int lane, int wave, int blk, int G) {
    unsigned char* ws = a->ws; const int gw = blk * NWAVES + wave, NGW = G * NWAVES;
    const float* Z = (const float*)(ws + WS_Z); const float* LO = (const float*)(ws + WS_LORA);
    const float* mu = a->in[I_BMU] + L * PBW; const float* w0 = a->in[I_BW0] + L * WB; const float* a0 = a->in[I_BA0] + L * WB;
    const float* k_k = a->in[I_BKK] + L * WB; const float* k_a = a->in[I_BKA] + L * WB; const float* sh0 = a->in[I_SSHIFT] + (size_t)L * NS * PBW;
    for (int m = MP + gw; m < MV; m += NGW) {
        const bool samp = m >= MP; const float* zr = Z + (size_t)m * PIN + OFF_B; const float* lo = LO + (size_t)m * NLORA;
        const float* pz = samp ? sh0 + (size_t)(m - MP) * PBW : zr - PIN; const bool first = !samp && (m & (SEQ - 1)) == 0;
#pragma unroll 4
        for (int j = 0; j < 12; ++j) { const int c = 64 * j + lane;
            const float cr = zr[c], ck = zr[WB + c], cv = zr[2 * WB + c];
            float pr = 0.f, pk = 0.f, pv = 0.f; if (!first) { pr = pz[c]; pk = pz[WB + c]; pv = pz[2 * WB + c]; }
            const float r = cr + mu[c] * (pr - cr), k = ck + mu[WB + c] * (pk - ck), v = cv + mu[2 * WB + c] * (pv - cv);
            const float dec = __expf(-0.6065306597126334f * sigmoidf_(w0[c] + lo[c]));
            const float av = sigmoidf_(a0[c] + lo[WB + c]);
            const float kkr = k * k_k[c]; const float ss = wave_sum(kkr * kkr); const float kk = kkr / fmaxf(sqrtf(ss), 1e-12f);
            const float kp = k * (1.0f + (av - 1.0f) * k_a[c]);
            float* rec = samp ? (float*)(ws + WS_RPS) + ((size_t)(m - MP) * 12 + j) * 384 : (float*)(ws + WS_RPB) + (((size_t)(m >> 11) * 12 + j) * SEQ + (m & (SEQ - 1))) * 384;
            rec[lane] = r; rec[64 + lane] = dec; rec[128 + lane] = kp; rec[192 + lane] = v; rec[256 + lane] = kk; rec[320 + lane] = kk * av; }
    }
}

__device__ __forceinline__ void rwkv_scan_unit(ArgsP a, int L, int unit, LAS unsigned char* lds, int tid, int lane, int wave) {
    unsigned char* ws = a->ws;
    const int bh = unit >> 1, half = unit & 1, b = bh / 12, h = bh - b * 12;
    const f4* rec4 = (const f4*)((const float*)(ws + WS_RPB) + (size_t)bh * SEQ * 384);
    LAS float* buf = (LAS float*)lds;
    LAS float* ybuf = (LAS float*)(lds + 49152);
    const int rowl = wave * 4 + (lane >> 4), kg = lane & 15, row = half * 32 + rowl;
    float S0 = 0.f, S1 = 0.f, S2 = 0.f, S3 = 0.f;
    f4 st0, st1, st2;
    __syncthreads();
    st0 = rec4[tid]; st1 = rec4[512 + tid]; st2 = rec4[1024 + tid];
    *(LAS f4*)(buf + 4 * tid) = st0; *(LAS f4*)(buf + 4 * (512 + tid)) = st1; *(LAS f4*)(buf + 4 * (1024 + tid)) = st2;
    __syncthreads();
    float* Y = (float*)(ws + WS_Y);
    for (int c = 0; c < SEQ / 16; ++c) {
        if (c + 1 < SEQ / 16) { const f4* nx = rec4 + (size_t)(c + 1) * 1536; st0 = nx[tid]; st1 = nx[512 + tid]; st2 = nx[1024 + tid]; }
        const LAS float* cur = buf + (c & 1) * 6144; LAS float* yb = ybuf + (c & 1) * 512;
        f4 r4 = *(const LAS f4*)(cur + 4 * kg), w4 = *(const LAS f4*)(cur + 64 + 4 * kg), k4 = *(const LAS f4*)(cur + 128 + 4 * kg),
           kk4 = *(const LAS f4*)(cur + 256 + 4 * kg), ka4 = *(const LAS f4*)(cur + 320 + 4 * kg); float v = cur[192 + row];
#pragma unroll
        for (int s = 0; s < 16; ++s) {
            const LAS float* R = cur + (s < 15 ? s + 1 : 15) * 384;
            const f4 nr4 = *(const LAS f4*)(R + 4 * kg), nw4 = *(const LAS f4*)(R + 64 + 4 * kg), nk4 = *(const LAS f4*)(R + 128 + 4 * kg),
                     nkk4 = *(const LAS f4*)(R + 256 + 4 * kg), nka4 = *(const LAS f4*)(R + 320 + 4 * kg);
            const float nv = R[192 + row];
            float sa = (S0 * kk4.x + S1 * kk4.y) + (S2 * kk4.z + S3 * kk4.w);
            sa = row16_sum(sa);
            S0 = S0 * w4.x + (v * k4.x - sa * ka4.x); S1 = S1 * w4.y + (v * k4.y - sa * ka4.y);
            S2 = S2 * w4.z + (v * k4.z - sa * ka4.z); S3 = S3 * w4.w + (v * k4.w - sa * ka4.w);
            float y = (S0 * r4.x + S1 * r4.y) + (S2 * r4.z + S3 * r4.w);
            y = row16_sum(y);
            if (kg == 0) yb[s * 32 + rowl] = y;
            r4 = nr4; w4 = nw4; k4 = nk4; kk4 = nkk4; ka4 = nka4; v = nv;
        }
        if (c + 1 < SEQ / 16) { LAS float* nb = buf + ((c + 1) & 1) * 6144;
            *(LAS f4*)(nb + 4 * tid) = st0; *(LAS f4*)(nb + 4 * (512 + tid)) = st1; *(LAS f4*)(nb + 4 * (1024 + tid)) = st2; }
        __syncthreads();
        { const int s = tid >> 5, rl = tid & 31; Y[((size_t)b * SEQ + c * 16 + s) * WB + h * 64 + half * 32 + rl] = yb[tid]; }
    }
    f4 so; so.x = S0; so.y = S1; so.z = S2; so.w = S3;
    *(f4*)(a->out + O_RP + ((((size_t)L * NBAT + b) * 12 + h) * 64 + row) * 64 + 4 * kg) = so;
    __syncthreads();
}
__device__ __forceinline__ void rwkv_sample_item(ArgsP a, int L, int item, LAS unsigned char* lds, int lane, int wave) {
    unsigned char* ws = a->ws;
    const int ih = item * 8 + wave, i = ih / 12, h = ih - i * 12;
    const float* rec = (const float*)(ws + WS_RPS) + (size_t)ih * 384;
    LAS float* sc = (LAS float*)(lds + wave * 2048);
    const float r = rec[lane], w = rec[64 + lane], k = rec[128 + lane], v = rec[192 + lane], kk = rec[256 + lane], ka = rec[320 + lane];
    sc[lane] = r; sc[64 + lane] = w; sc[128 + lane] = k; sc[192 + lane] = kk; sc[256 + lane] = ka;
    LDS_WAIT(); asm volatile("" ::: "memory");
    const f4* S0p = (const f4*)(a->in[I_SRWKV] + (((size_t)L * NS + i) * 12 + h) * 4096 + lane * 64);
    f4 S[16];
#pragma unroll
    for (int j = 0; j < 16; ++j) S[j] = S0p[j];
    float sa = 0.f;
#pragma unroll
    for (int j = 0; j < 16; ++j) { const f4 q = *(const LAS f4*)(sc + 192 + 4 * j); sa += (S[j].x * q.x + S[j].y * q.y) + (S[j].z * q.z + S[j].w * q.w); }
    float y = 0.f;
    f4* So = (f4*)(a->out + O_RS + (((size_t)L * NS + i) * 12 + h) * 4096 + lane * 64);
#pragma unroll
    for (int j = 0; j < 16; ++j) { const f4 w4 = *(const LAS f4*)(sc + 64 + 4 * j), k4 = *(const LAS f4*)(sc + 128 + 4 * j), a4 = *(const LAS f4*)(sc + 256 + 4 * j), r4 = *(const LAS f4*)(sc + 4 * j);
        f4 n = S[j] * w4 + (k4 * v - a4 * sa); So[j] = n; y += (n.x * r4.x + n.y * r4.y) + (n.z * r4.z + n.w * r4.w); }
    ((float*)(ws + WS_Y))[(size_t)(MP + i) * WB + h * 64 + lane] = y;
    LDS_WAIT(); asm volatile("" ::: "memory");
}
__device__ __forceinline__ void hgrn_sample_item(ArgsP a, int L, int item, LAS unsigned char* lds, int lane, int wave) {
    unsigned char* ws = a->ws;
    const int ih = item * 4 + (wave >> 1), i = ih / 6, h = ih - i * 6, vcol = (wave & 1) * 64 + lane, m = MP + i;
    const float* zc = (const float*)(ws + WS_Z) + (size_t)m * PIN + OFF_C + h * 128;
    LAS float* sc = (LAS float*)(lds + wave * 2048);
#pragma unroll
    for (int t = 0; t < 2; ++t) { const int k = lane + 64 * t; const float lb = lbound(a->in[I_CLB], L, h * 128 + k); const float fz = zc[WC + k];
        const float sg = sigmoidf_(fz); sc[k] = lb + (1.0f - lb) * sg; sc[128 + k] = (1.0f - lb) * (1.0f - sg) ; sc[256 + k] = zc[k]; }
    const float iv = zc[2 * WC + vcol];
    LDS_WAIT(); asm volatile("" ::: "memory");
    const float* S0 = a->in[I_SHGRN] + (((size_t)L * NS + i) * 6 + h) * 16384 + vcol;
    float* So = a->out + O_HS + (((size_t)L * NS + i) * 6 + h) * 16384 + vcol;
    float o = 0.f;
#pragma unroll 8
    for (int k = 0; k < 128; ++k) { const float n = sc[k] * S0[(size_t)k * 128] + sc[128 + k] * iv; So[(size_t)k * 128] = n; o += n * sc[256 + k]; }
    ((float*)(ws + WS_O))[(size_t)m * WC + h * 128 + vcol] = o;
    LDS_WAIT(); asm volatile("" ::: "memory");
}
__device__ __forceinline__ void sgu_item(ArgsP a, int L, int item, LAS unsigned char* lds, int tid, int lane, int wave) {
    unsigned char* ws = a->ws;
    const int g = item & 3, bc = item >> 2, m0 = bc * 128;
    const float* Z = (const float*)(ws + WS_Z);
    LAS float* vn = (LAS float*)lds;
    LAS float* wt = (LAS float*)(lds + 65536);
    const float* wsrc = a->in[I_AWS] + (size_t)(L * 4 + g) * 16384;
    __syncthreads();
    for (int e = tid; e < 16384; e += NTHR) { const int t = e >> 7, s = e & 127; wt[s * 128 + t] = (s <= t) ? wsrc[e] : 0.f; }
    const float* lng = a->in[I_ALNG] + L * WA + g * 128; const float* lnb = a->in[I_ALNB] + L * WA + g * 128;
    for (int rr = 0; rr < 16; ++rr) { const int t = wave * 16 + rr; const float* zr = Z + (size_t)(m0 + t) * PIN + WA + g * 128;
        const float v0 = gelu_erf(zr[lane]), v1 = gelu_erf(zr[64 + lane]);
        const float mean = wave_sum(v0 + v1) * (1.f / 128.f); const float d0 = v0 - mean, d1 = v1 - mean;
        const float rstd = 1.0f / sqrtf(wave_sum(d0 * d0 + d1 * d1) * (1.f / 128.f) + LN_EPS);
        vn[t * 128 + lane] = d0 * rstd * lng[lane] + lnb[lane]; vn[t * 128 + 64 + lane] = d1 * rstd * lng[64 + lane] + lnb[64 + lane]; }
    __syncthreads();
    const int t = tid >> 2, dq = tid & 3, send = (wave * 16 + 15);
    f4 acc[8];
#pragma unroll
    for (int j = 0; j < 8; ++j) acc[j] = (f4){0.f, 0.f, 0.f, 0.f};
    for (int s = 0; s <= send; ++s) { const float w = wt[s * 128 + t]; const LAS f4* vr = (const LAS f4*)(vn + s * 128 + dq * 32);
#pragma unroll
        for (int j = 0; j < 8; ++j) acc[j] += vr[j] * w; }
    const float bs = a->in[I_ABS][(L * 4 + g) * 128 + t];
    const float* ur = Z + (size_t)(m0 + t) * PIN + g * 128 + dq * 32;
    bf16* yo = (bf16*)(ws + WS_YMIX) + (size_t)(m0 + t) * DM + g * 128 + dq * 32;
#pragma unroll
    for (int j = 0; j < 4; ++j) { const f4 u0 = *(const f4*)(ur + 8 * j), u1 = *(const f4*)(ur + 8 * j + 4); const f4 x0 = acc[2 * j] + bs, x1 = acc[2 * j + 1] + bs; v4u o;
        o.x = pg8::cvt_pk_bf16(gelu_erf(u0.x) * x0.x, gelu_erf(u0.y) * x0.y); o.y = pg8::cvt_pk_bf16(gelu_erf(u0.z) * x0.z, gelu_erf(u0.w) * x0.w);
        o.z = pg8::cvt_pk_bf16(gelu_erf(u1.x) * x1.x, gelu_erf(u1.y) * x1.y); o.w = pg8::cvt_pk_bf16(gelu_erf(u1.z) * x1.z, gelu_erf(u1.w) * x1.w);
        *(v4u*)(yo + 8 * j) = o; }
}

__device__ __forceinline__ void hgrn_seq_unit(ArgsP a, int L, int unit, LAS unsigned char* lds, int tid, int lane, int wave) {
    unsigned char* ws = a->ws;
    const int b = unit / 6, h = unit - b * 6;
    const float* Z = (const float*)(ws + WS_Z);
    LAS bf16* qs = (LAS bf16*)(lds);
    LAS bf16* ks = (LAS bf16*)(lds + 4352);
    LAS bf16* vt = (LAS bf16*)(lds + 8704);
    LAS bf16* kht = (LAS bf16*)(lds + 12800);
    LAS float* ev = (LAS float*)(lds + 16896);
    LAS float* part = (LAS float*)(lds + 17408);
    const int ch = tid & 127, tq = tid >> 7;
    const float lb = lbound(a->in[I_CLB], L, h * 128 + ch), oml = 1.0f - lb;
    const int pch = (ch & ~31) | (((ch >> 2) & 3) << 3) | (((ch >> 4) & 1) << 2) | (ch & 3);
    const int x = lane & 15, quad = lane >> 4;
    pg8::f32x4 Sacc[8];
#pragma unroll
    for (int mt = 0; mt < 8; ++mt) Sacc[mt] = (pg8::f32x4){0.f, 0.f, 0.f, 0.f};
    const float* zb = Z + (size_t)(b * SEQ + 4 * tq) * PIN + OFF_C + h * 128 + ch;
    float qn[4], fn[4], vn_[4];
#pragma unroll
    for (int j = 0; j < 4; ++j) { const float* p = zb + (size_t)j * PIN; qn[j] = p[0]; fn[j] = p[WC]; vn_[j] = p[2 * WC]; }
    float* O = (float*)(ws + WS_O);
    __syncthreads();
    for (int st = 0; st < SEQ / 16; ++st) {
        float q[4], fz[4], iv[4];
#pragma unroll
        for (int j = 0; j < 4; ++j) { q[j] = qn[j]; fz[j] = fn[j]; iv[j] = vn_[j]; }
        if (st + 1 < SEQ / 16) {
#pragma unroll
            for (int j = 0; j < 4; ++j) { const float* p = zb + (size_t)((st + 1) * 16 + j) * PIN; qn[j] = p[0]; fn[j] = p[WC]; vn_[j] = p[2 * WC]; } }
        float bl[4], kv[4]; float run = 0.f;
#pragma unroll
        for (int j = 0; j < 4; ++j) { const float e = __expf(-fmaxf(fz[j], -80.f)), sg = __builtin_amdgcn_rcpf(1.0f + e);
            run += __logf(lb + oml * sg); bl[j] = run; kv[j] = oml * e * sg; }
        part[tq * 128 + ch] = run;
        asm volatile("s_waitcnt lgkmcnt(0)" ::: "memory"); __builtin_amdgcn_s_barrier(); asm volatile("" ::: "memory");
        const float p0 = part[ch], p1 = part[128 + ch], p2 = part[256 + ch], p3 = part[384 + ch];
        const float tot = (p0 + p1) + (p2 + p3); const float pre = (tq > 0 ? p0 : 0.f) + (tq > 1 ? p1 : 0.f) + (tq > 2 ? p2 : 0.f);
        float kh[4];
#pragma unroll
        for (int j = 0; j < 4; ++j) { const float bj = pre + bl[j]; const int t = 4 * tq + j;
            qs[t * 136 + pch] = bf1(q[j] * __expf(bj)); ks[t * 136 + pch] = bf1(kv[j] * __expf(fminf(-bj, 60.f))); kh[j] = kv[j] * __expf(tot - bj); }
        { u2 w; w.x = cvt_pk_bf16_c(kh[0], kh[1]); w.y = cvt_pk_bf16_c(kh[2], kh[3]); *(LAS u2*)(kht + ch * 16 + 4 * tq) = w;
          w.x = cvt_pk_bf16_c(iv[0], iv[1]); w.y = cvt_pk_bf16_c(iv[2], iv[3]); *(LAS u2*)(vt + ch * 16 + 4 * tq) = w; }
        if (tq == 0) ev[ch] = __expf(tot);
        asm volatile("s_waitcnt lgkmcnt(0)" ::: "memory"); __builtin_amdgcn_s_barrier(); asm volatile("" ::: "memory");
        bf16x8 qf[4], kf[4];
#pragma unroll
        for (int kt = 0; kt < 4; ++kt) { qf[kt] = *(const LAS bf16x8*)(qs + x * 136 + 32 * kt + 8 * quad); kf[kt] = *(const LAS bf16x8*)(ks + x * 136 + 32 * kt + 8 * quad); }
        pg8::f32x4 att = (pg8::f32x4){0.f, 0.f, 0.f, 0.f};
#pragma unroll
        for (int kt = 0; kt < 4; ++kt) att = __builtin_amdgcn_mfma_f32_16x16x32_bf16(kf[kt], qf[kt], att, 0, 0, 0);
#pragma unroll
        for (int i = 0; i < 4; ++i) if (4 * quad + i > x) att[i] = 0.f;
        v4u pbu; pbu.x = cvt_pk_bf16_c(att[0], att[1]); pbu.y = cvt_pk_bf16_c(att[2], att[3]); pbu.z = 0u; pbu.w = 0u;
        const bf16x8 pb = __builtin_bit_cast(bf16x8, pbu);
        const u2 vv = *(const LAS u2*)(vt + (16 * wave + x) * 16 + 4 * quad);
        v4u vfu; vfu.x = vv.x; vfu.y = vv.y; vfu.z = 0u; vfu.w = 0u; const bf16x8 vf = __builtin_bit_cast(bf16x8, vfu);
        pg8::f32x4 o = (pg8::f32x4){0.f, 0.f, 0.f, 0.f};
#pragma unroll
        for (int kt = 0; kt < 4; ++kt) { v4u su; su.x = cvt_pk_bf16_c(Sacc[2 * kt][0], Sacc[2 * kt][1]); su.y = cvt_pk_bf16_c(Sacc[2 * kt][2], Sacc[2 * kt][3]);
            su.z = cvt_pk_bf16_c(Sacc[2 * kt + 1][0], Sacc[2 * kt + 1][1]); su.w = cvt_pk_bf16_c(Sacc[2 * kt + 1][2], Sacc[2 * kt + 1][3]);
            o = __builtin_amdgcn_mfma_f32_16x16x32_bf16(__builtin_bit_cast(bf16x8, su), qf[kt], o, 0, 0, 0); }
        o = __builtin_amdgcn_mfma_f32_16x16x32_bf16(vf, pb, o, 0, 0, 0);
        *(pg8::f32x4*)(O + (size_t)(b * SEQ + st * 16 + x) * WC + h * 128 + 16 * wave + 4 * quad) = o;
#pragma unroll
        for (int mt = 0; mt < 8; ++mt) { const pg8::f32x4 e4 = *(const LAS pg8::f32x4*)(ev + 16 * mt + 4 * quad);
            const u2 kk2 = *(const LAS u2*)(kht + (16 * mt + x) * 16 + 4 * quad); v4u ku; ku.x = kk2.x; ku.y = kk2.y; ku.z = 0u; ku.w = 0u;
            Sacc[mt] = __builtin_amdgcn_mfma_f32_16x16x32_bf16(__builtin_bit_cast(bf16x8, ku), vf, Sacc[mt] * e4, 0, 0, 0); }
    }
    float* So = a->out + O_HP + (((size_t)L * NBAT + b) * 6 + h) * 16384;
#pragma unroll
    for (int mt = 0; mt < 8; ++mt)
#pragma unroll
        for (int i = 0; i < 4; ++i) So[(size_t)(16 * mt + 4 * quad + i) * 128 + 16 * wave + x] = Sacc[mt][i];
    __syncthreads();
}

__device__ __forceinline__ void phase_post(ArgsP a, int L, int lane, int wave, int blk, int G) {
    unsigned char* ws = a->ws; const int gw = blk * NWAVES + wave, NGW = G * NWAVES;
    const float* Y = (const float*)(ws + WS_Y); const float* O = (const float*)(ws + WS_O); const float* Gt = (const float*)(ws + WS_LORA) + 2 * WB; const float* Z = (const float*)(ws + WS_Z);
    const float* gng = a->in[I_BGNG] + L * WB; const float* gnb = a->in[I_BGNB] + L * WB; const float* rk = a->in[I_BRK] + L * WB; const float* cng = a->in[I_CNG] + L * WC;
    for (int m = gw; m < MV; m += NGW) {
        bf16* yo = (bf16*)(ws + WS_YMIX) + (size_t)m * DM;
        float ov[12], gz[12]; float ss = 0.f;
#pragma unroll
        for (int j = 0; j < 12; ++j) { const int c = 64 * j + lane; ov[j] = O[(size_t)m * WC + c]; gz[j] = Z[(size_t)m * PIN + OFF_C + 3 * WC + c]; ss += ov[j] * ov[j]; }
        if (m >= MP) {
            { const float* hr = (const float*)(ws + WS_H) + (size_t)m * DM; float* tr = (float*)(ws + WS_T) + (size_t)m * DM;
#pragma unroll
              for (int j = 0; j < 8; ++j) *(f4*)(tr + 4 * (lane + 64 * j)) = *(const f4*)(hr + 4 * (lane + 64 * j)) * DN_ALPHA; }
#pragma unroll
            for (int j = 0; j < 12; ++j) { const int c = 64 * j + lane; const float* rec = (const float*)(ws + WS_RPS) + ((size_t)(m - MP) * 12 + j) * 384;
                const float y = Y[(size_t)m * WB + c], rr = rec[lane], kp = rec[128 + lane], vv = rec[192 + lane], gg = Gt[(size_t)m * NLORA + c];
                const float mean = wave_sum(y) * (1.f / 64.f); const float d = y - mean; const float rstd = 1.0f / sqrtf(wave_sum(d * d) * (1.f / 64.f) + GN_EPS);
                const float bonus = wave_sum(rr * kp * rk[c]);
                yo[WA + c] = bf1((d * rstd * gng[c] + gnb[c] + bonus * vv) * gg); } }
        const float rms = 1.0f / sqrtf(wave_sum(ss) * (1.f / WC) + RMS_EPS);
#pragma unroll
        for (int j = 0; j < 12; ++j) { const int c = 64 * j + lane; yo[WA + WB + c] = bf1(ov[j] * rms * cng[c] * (gz[j] * sigmoidf_(gz[j]))); }
    }
}

constexpr int REC_BYTES = 16384, RC_GT = 12288, RC_WT = 0, RC_RT = 2048, RC_AHT = 4096, RC_KHT = 6144, RC_VT = 8192, RC_BRA = 10240, RC_BRK = 10752, RC_M2 = 11264, RC_G15 = 11776, RC_BC = 12032;
constexpr int NCHUNK = NBAT * 12 * (SEQ / 16);
static_assert(WS_RPB + (size_t)NCHUNK * REC_BYTES == WS_RPS, "chunk record region");
__device__ __forceinline__ float readlane_f(float x, int l) { return __builtin_bit_cast(float, __builtin_amdgcn_readlane(__builtin_bit_cast(int, x), l)); }
__device__ __forceinline__ float wave_sum_fast(float x) { x = row16_sum(x); return (readlane_f(x, 0) + readlane_f(x, 16)) + (readlane_f(x, 32) + readlane_f(x, 48)); }
__device__ __forceinline__ int perm_ch(int ch) { return (ch & ~31) | (((ch >> 2) & 3) << 3) | (((ch >> 4) & 1) << 2) | (ch & 3); }

__device__ __forceinline__ void pre_chunk(ArgsP a, int L, int q, LAS unsigned char* wl, int lane) {
    unsigned char* ws = a->ws;
    const int bh = q >> 7, c = q & 127, b = bh / 12, h = bh - 12 * b, m0 = b * SEQ + c * 16, col = h * 64 + lane;
    const float* Z = (const float*)(ws + WS_Z) + (size_t)m0 * PIN + OFF_B + col; const float* LO = (const float*)(ws + WS_LORA) + (size_t)m0 * NLORA + col;
    unsigned char* rec = ws + WS_RPB + (size_t)q * REC_BYTES;
    LAS float* X0 = (LAS float*)wl;
    LAS float* X1 = (LAS float*)(wl + 4352);
    LAS float* Maa = (LAS float*)(wl + 8704);
    LAS float* Mak = (LAS float*)(wl + 9728);
    LAS bf16* Sm = (LAS bf16*)(wl + 10752);
    LAS bf16* Wim = (LAS bf16*)(wl + 12288);
    const float mur = a->in[I_BMU][L * PBW + col], muk = a->in[I_BMU][L * PBW + WB + col], muv = a->in[I_BMU][L * PBW + 2 * WB + col];
    const float w0c = a->in[I_BW0][L * WB + col], a0c = a->in[I_BA0][L * WB + col], kkc = a->in[I_BKK][L * WB + col], kac = a->in[I_BKA][L * WB + col], rkc = a->in[I_BRK][L * WB + col];
    float cr[16], ck[16], cv[16], lw[16], la[16];
#pragma unroll
    for (int t = 0; t < 16; ++t) { cr[t] = Z[(size_t)t * PIN]; ck[t] = Z[(size_t)t * PIN + WB]; cv[t] = Z[(size_t)t * PIN + 2 * WB]; lw[t] = LO[(size_t)t * NLORA]; la[t] = LO[(size_t)t * NLORA + WB];
        ((bf16*)(rec + RC_GT))[t * 64 + lane] = bf1(LO[(size_t)t * NLORA + 2 * WB]); }
    float pr = 0.f, pk = 0.f, pv = 0.f; if (c) { pr = Z[-(ptrdiff_t)PIN]; pk = Z[-(ptrdiff_t)PIN + WB]; pv = Z[-(ptrdiff_t)PIN + 2 * WB]; }
    float r_[16], k_[16], v_[16], kp_[16], al_[16], g_[16]; float run = 0.f, bcv = 0.f;
#pragma unroll
    for (int t = 0; t < 16; ++t) {
        const float r = cr[t] + mur * (pr - cr[t]), k = ck[t] + muk * (pk - ck[t]), v = cv[t] + muv * (pv - cv[t]); pr = cr[t]; pk = ck[t]; pv = cv[t];
        run += -0.6065306597126334f * __builtin_amdgcn_rcpf(1.0f + __expf(-(w0c + lw[t]))); g_[t] = run;
        const float av = __builtin_amdgcn_rcpf(1.0f + __expf(-(a0c + la[t])));
        const float kkr = k * kkc; const float ss = wave_sum_fast(kkr * kkr); const float kap = kkr / fmaxf(sqrtf(ss), 1e-12f);
        const float kpr = k * (1.0f + (av - 1.0f) * kac);
        const float bc = wave_sum_fast(r * kpr * rkc); if (lane == t) bcv = bc;
        r_[t] = r; k_[t] = kpr; v_[t] = v; kp_[t] = kap; al_[t] = kap * av; }
    const float gl = g_[15];
    { float ah[16], kh[16];
#pragma unroll
      for (int t = 0; t < 16; ++t) { const float ig = __expf(-g_[t]), eg = __expf(gl - g_[t]); X0[t * 68 + lane] = al_[t] * ig; X1[t * 68 + lane] = k_[t] * ig; ah[t] = al_[t] * eg; kh[t] = k_[t] * eg; }
      v4u o0, o1;
      o0.x = cvt_pk_bf16_c(ah[0], ah[1]); o0.y = cvt_pk_bf16_c(ah[2], ah[3]); o0.z = cvt_pk_bf16_c(ah[4], ah[5]); o0.w = cvt_pk_bf16_c(ah[6], ah[7]);
      o1.x = cvt_pk_bf16_c(ah[8], ah[9]); o1.y = cvt_pk_bf16_c(ah[10], ah[11]); o1.z = cvt_pk_bf16_c(ah[12], ah[13]); o1.w = cvt_pk_bf16_c(ah[14], ah[15]);
      *(v4u*)(rec + RC_AHT + lane * 32) = o0; *(v4u*)(rec + RC_AHT + lane * 32 + 16) = o1;
      o0.x = cvt_pk_bf16_c(kh[0], kh[1]); o0.y = cvt_pk_bf16_c(kh[2], kh[3]); o0.z = cvt_pk_bf16_c(kh[4], kh[5]); o0.w = cvt_pk_bf16_c(kh[6], kh[7]);
      o1.x = cvt_pk_bf16_c(kh[8], kh[9]); o1.y = cvt_pk_bf16_c(kh[10], kh[11]); o1.z = cvt_pk_bf16_c(kh[12], kh[13]); o1.w = cvt_pk_bf16_c(kh[14], kh[15]);
      *(v4u*)(rec + RC_KHT + lane * 32) = o0; *(v4u*)(rec + RC_KHT + lane * 32 + 16) = o1;
      o0.x = cvt_pk_bf16_c(v_[0], v_[1]); o0.y = cvt_pk_bf16_c(v_[2], v_[3]); o0.z = cvt_pk_bf16_c(v_[4], v_[5]); o0.w = cvt_pk_bf16_c(v_[6], v_[7]);
      o1.x = cvt_pk_bf16_c(v_[8], v_[9]); o1.y = cvt_pk_bf16_c(v_[10], v_[11]); o1.z = cvt_pk_bf16_c(v_[12], v_[13]); o1.w = cvt_pk_bf16_c(v_[14], v_[15]);
      *(v4u*)(rec + RC_VT + lane * 32) = o0; *(v4u*)(rec + RC_VT + lane * 32 + 16) = o1; }
    LDS_WAIT(); asm volatile("" ::: "memory");
    const int x = lane & 15, kq = lane >> 4;
    f4 ba[4], bk[4];
#pragma unroll
    for (int j = 0; j < 4; ++j) { ba[j] = *(const LAS f4*)(X0 + x * 68 + 16 * kq + 4 * j); bk[j] = *(const LAS f4*)(X1 + x * 68 + 16 * kq + 4 * j); }
    LDS_WAIT(); asm volatile("" ::: "memory");
    float kt[16];
#pragma unroll
    for (int t = 0; t < 16; ++t) { kt[t] = kp_[t] * (t ? __expf(g_[t - 1]) : 1.0f); X0[t * 68 + lane] = kt[t]; X1[t * 68 + lane] = r_[t] * __expf(g_[t]); }
    LDS_WAIT(); asm volatile("" ::: "memory");
    f4 ak[4], ar[4];
#pragma unroll
    for (int j = 0; j < 4; ++j) { ak[j] = *(const LAS f4*)(X0 + x * 68 + 16 * kq + 4 * j); ar[j] = *(const LAS f4*)(X1 + x * 68 + 16 * kq + 4 * j); }
    pg8::f32x4 Gaa = (pg8::f32x4){0.f, 0.f, 0.f, 0.f}, Gak = Gaa, Gra = Gaa, Grk = Gaa;
#pragma unroll
    for (int j = 0; j < 4; ++j)
#pragma unroll
        for (int e = 0; e < 4; ++e) { Gaa = __builtin_amdgcn_mfma_f32_16x16x4f32(ak[j][e], ba[j][e], Gaa, 0, 0, 0); Gak = __builtin_amdgcn_mfma_f32_16x16x4f32(ak[j][e], bk[j][e], Gak, 0, 0, 0);
            Gra = __builtin_amdgcn_mfma_f32_16x16x4f32(ar[j][e], ba[j][e], Gra, 0, 0, 0); Grk = __builtin_amdgcn_mfma_f32_16x16x4f32(ar[j][e], bk[j][e], Grk, 0, 0, 0); }
#pragma unroll
    for (int i = 0; i < 4; ++i) { const int t = 4 * kq + i; const bool sl = x < t, le = x <= t;
        Maa[t * 16 + x] = sl ? Gaa[i] : 0.f; Mak[t * 16 + x] = sl ? Gak[i] : 0.f;
        Sm[t * 16 + x] = bf1(le ? Gra[i] : 0.f); Sm[256 + t * 16 + x] = bf1(le ? Grk[i] : 0.f); }
    LDS_WAIT(); asm volatile("" ::: "memory");
    float xm[16];
#pragma unroll
    for (int t = 0; t < 16; ++t) xm[t] = Mak[t * 16 + x];
#pragma unroll
    for (int t = 1; t < 16; ++t) {
#pragma unroll
        for (int s4 = 0; s4 < (t + 3) / 4; ++s4) { const f4 ar4 = *(const LAS f4*)(Maa + t * 16 + 4 * s4);
#pragma unroll
            for (int e = 0; e < 4; ++e) if (4 * s4 + e < t) { kt[t] -= ar4[e] * kt[4 * s4 + e]; xm[t] -= ar4[e] * xm[4 * s4 + e]; } } }
#pragma unroll
    for (int t = 0; t < 16; ++t) { Wim[t * 64 + perm_ch(lane)] = bf1(-kt[t]); if (lane < 16) Sm[512 + t * 16 + lane] = bf1(-xm[t]); }
    LDS_WAIT(); asm volatile("" ::: "memory");
    *(v4u*)(rec + RC_WT + lane * 16) = *(const LAS v4u*)((LAS unsigned char*)Wim + lane * 16); *(v4u*)(rec + RC_WT + 1024 + lane * 16) = *(const LAS v4u*)((LAS unsigned char*)Wim + 1024 + lane * 16);
    *(v4u*)(rec + RC_BRA + lane * 16) = *(const LAS v4u*)((LAS unsigned char*)Sm + lane * 16); if (lane < 32) *(v4u*)(rec + RC_BRA + 1024 + lane * 16) = *(const LAS v4u*)((LAS unsigned char*)Sm + 1024 + lane * 16);
    LDS_WAIT(); asm volatile("" ::: "memory");
#pragma unroll
    for (int t = 0; t < 16; ++t) Wim[t * 64 + perm_ch(lane)] = bf1(r_[t] * __expf(g_[t]));
    LDS_WAIT(); asm volatile("" ::: "memory");
    *(v4u*)(rec + RC_RT + lane * 16) = *(const LAS v4u*)((LAS unsigned char*)Wim + lane * 16); *(v4u*)(rec + RC_RT + 1024 + lane * 16) = *(const LAS v4u*)((LAS unsigned char*)Wim + 1024 + lane * 16);
    *(float*)(rec + RC_G15 + lane * 4) = __expf(gl); if (lane < 16) *(float*)(rec + RC_BC + lane * 4) = bcv;
    LDS_WAIT(); asm volatile("" ::: "memory");
}

constexpr int HREC_BYTES = 17408, HR_QS = 0, HR_KS = 4352, HR_VT = 8704, HR_KHT = 12800, HR_EV = 16896, NHCHUNK = NBAT * 6 * (SEQ / 16);
__device__ __forceinline__ void hpre_chunk(ArgsP a, int L, int q2, LAS unsigned char* wl, int lane) {
    unsigned char* ws = a->ws;
    const int bh = q2 >> 7, c = q2 & 127, b = bh / 6, h = bh - 6 * b;
    const float* Z = (const float*)(ws + WS_Z) + (size_t)(b * SEQ + c * 16) * PIN + OFF_C + h * 128 + lane;
    unsigned char* rec = ws + WS_HREC + (size_t)q2 * HREC_BYTES;
    LAS bf16* qim = (LAS bf16*)wl; LAS bf16* kim = (LAS bf16*)(wl + 4352);
#pragma unroll
    for (int hh = 0; hh < 2; ++hh) { const int ch = lane + 64 * hh; const int pc = perm_ch(ch);
        const float lb = lbound(a->in[I_CLB], L, h * 128 + ch), oml = 1.0f - lb;
        float q[16], fz[16], iv[16];
#pragma unroll
        for (int t = 0; t < 16; ++t) { const float* p = Z + (size_t)t * PIN + 64 * hh; q[t] = p[0]; fz[t] = p[WC]; iv[t] = p[2 * WC]; }
        float bl[16], kv[16]; float run = 0.f;
#pragma unroll
        for (int t = 0; t < 16; ++t) { const float e = __expf(-fmaxf(fz[t], -80.f)), sg = __builtin_amdgcn_rcpf(1.0f + e); run += __logf(lb + oml * sg); bl[t] = run; kv[t] = oml * e * sg; }
        float kh[16];
#pragma unroll
        for (int t = 0; t < 16; ++t) { qim[t * 136 + pc] = bf1(q[t] * __expf(bl[t])); kim[t * 136 + pc] = bf1(kv[t] * __expf(fminf(-bl[t], 60.f))); kh[t] = kv[t] * __expf(run - bl[t]); }
        v4u o0, o1;
        o0.x = cvt_pk_bf16_c(kh[0], kh[1]); o0.y = cvt_pk_bf16_c(kh[2], kh[3]); o0.z = cvt_pk_bf16_c(kh[4], kh[5]); o0.w = cvt_pk_bf16_c(kh[6], kh[7]);
        o1.x = cvt_pk_bf16_c(kh[8], kh[9]); o1.y = cvt_pk_bf16_c(kh[10], kh[11]); o1.z = cvt_pk_bf16_c(kh[12], kh[13]); o1.w = cvt_pk_bf16_c(kh[14], kh[15]);
        *(v4u*)(rec + HR_KHT + ch * 32) = o0; *(v4u*)(rec + HR_KHT + ch * 32 + 16) = o1;
        o0.x = cvt_pk_bf16_c(iv[0], iv[1]); o0.y = cvt_pk_bf16_c(iv[2], iv[3]); o0.z = cvt_pk_bf16_c(iv[4], iv[5]); o0.w = cvt_pk_bf16_c(iv[6], iv[7]);
        o1.x = cvt_pk_bf16_c(iv[8], iv[9]); o1.y = cvt_pk_bf16_c(iv[10], iv[11]); o1.z = cvt_pk_bf16_c(iv[12], iv[13]); o1.w = cvt_pk_bf16_c(iv[14], iv[15]);
        *(v4u*)(rec + HR_VT + ch * 32) = o0; *(v4u*)(rec + HR_VT + ch * 32 + 16) = o1;
        *(float*)(rec + HR_EV + ch * 4) = __expf(run); }
    LDS_WAIT(); asm volatile("" ::: "memory");
#pragma unroll
    for (int j = 0; j < 9; ++j) { const int o = (j * 64 + lane) * 16; if (o < 8704) *(v4u*)(rec + o) = *(const LAS v4u*)(wl + o); }
    LDS_WAIT(); asm volatile("" ::: "memory");
}
__device__ __forceinline__ void hgrn_stream_unit(ArgsP a, int L, int unit, LAS unsigned char* lds, int lane, int wave) {
    unsigned char* ws = a->ws;
    const int b = unit / 6, h = unit - b * 6;
    const unsigned char* recs = ws + WS_HREC + (size_t)unit * 128 * HREC_BYTES;
    const int x = lane & 15, quad = lane >> 4;
    constexpr int AHEAD = 4, NCH = SEQ / 16;
#define HG_DMA(cc) do { const unsigned char* g_ = recs + (size_t)(cc) * HREC_BYTES + wave * 1024 + lane * 16; LAS unsigned char* l_ = lds + ((cc) % 6) * HREC_BYTES + wave * 1024; \
        __builtin_amdgcn_global_load_lds((const unsigned*)(g_), (LAS unsigned*)(l_), 16, 0, 0); __builtin_amdgcn_global_load_lds((const unsigned*)(g_ + 8192), (LAS unsigned*)(l_ + 8192), 16, 0, 0); \
        if (wave == 0) __builtin_amdgcn_global_load_lds((const unsigned*)(g_ + 16384), (LAS unsigned*)(l_ + 16384), 16, 0, 0); } while (0)
    asm volatile("s_waitcnt vmcnt(0) lgkmcnt(0)" ::: "memory"); __builtin_amdgcn_s_barrier(); asm volatile("" ::: "memory");
    pg8::f32x4 Sacc[8];
#pragma unroll
    for (int mt = 0; mt < 8; ++mt) Sacc[mt] = (pg8::f32x4){0.f, 0.f, 0.f, 0.f};
#pragma unroll
    for (int cc = 0; cc < AHEAD; ++cc) HG_DMA(cc);
    if (wave == 0) asm volatile("s_waitcnt vmcnt(9)" ::: "memory"); else asm volatile("s_waitcnt vmcnt(6)" ::: "memory");
    __builtin_amdgcn_s_barrier(); asm volatile("" ::: "memory");
    float* O = (float*)(ws + WS_O) + (size_t)(b * SEQ) * WC + h * 128 + 16 * wave + 4 * quad;
    for (int st = 0; st < NCH; ++st) {
        if (st + AHEAD < NCH) HG_DMA(st + AHEAD);
        const LAS unsigned char* S = lds + (st % 6) * HREC_BYTES;
        const LAS bf16* qs = (const LAS bf16*)(S + HR_QS); const LAS bf16* ks = (const LAS bf16*)(S + HR_KS); const LAS bf16* vt = (const LAS bf16*)(S + HR_VT);
        const LAS bf16* kht = (const LAS bf16*)(S + HR_KHT); const LAS float* ev = (const LAS float*)(S + HR_EV);
        bf16x8 qf[4], kf[4];
#pragma unroll
        for (int kt = 0; kt < 4; ++kt) { qf[kt] = *(const LAS bf16x8*)(qs + x * 136 + 32 * kt + 8 * quad); kf[kt] = *(const LAS bf16x8*)(ks + x * 136 + 32 * kt + 8 * quad); }
        pg8::f32x4 att = (pg8::f32x4){0.f, 0.f, 0.f, 0.f};
#pragma unroll
        for (int kt = 0; kt < 4; ++kt) att = __builtin_amdgcn_mfma_f32_16x16x32_bf16(kf[kt], qf[kt], att, 0, 0, 0);
#pragma unroll
        for (int i = 0; i < 4; ++i) if (4 * quad + i > x) att[i] = 0.f;
        v4u pbu; pbu.x = cvt_pk_bf16_c(att[0], att[1]); pbu.y = cvt_pk_bf16_c(att[2], att[3]); pbu.z = 0u; pbu.w = 0u;
        const bf16x8 pb = __builtin_bit_cast(bf16x8, pbu);
        const u2 vv = *(const LAS u2*)(vt + (16 * wave + x) * 16 + 4 * quad);
        v4u vfu; vfu.x = vv.x; vfu.y = vv.y; vfu.z = 0u; vfu.w = 0u; const bf16x8 vf = __builtin_bit_cast(bf16x8, vfu);
        pg8::f32x4 o = (pg8::f32x4){0.f, 0.f, 0.f, 0.f};
#pragma unroll
        for (int kt = 0; kt < 4; ++kt) { v4u su; su.x = cvt_pk_bf16_c(Sacc[2 * kt][0], Sacc[2 * kt][1]); su.y = cvt_pk_bf16_c(Sacc[2 * kt][2], Sacc[2 * kt][3]);
            su.z = cvt_pk_bf16_c(Sacc[2 * kt + 1][0], Sacc[2 * kt + 1][1]); su.w = cvt_pk_bf16_c(Sacc[2 * kt + 1][2], Sacc[2 * kt + 1][3]);
            o = __builtin_amdgcn_mfma_f32_16x16x32_bf16(__builtin_bit_cast(bf16x8, su), qf[kt], o, 0, 0, 0); }
        o = __builtin_amdgcn_mfma_f32_16x16x32_bf16(vf, pb, o, 0, 0, 0);
        *(pg8::f32x4*)(O + (size_t)(st * 16 + x) * WC) = o;
#pragma unroll
        for (int mt = 0; mt < 8; ++mt) { const pg8::f32x4 e4 = *(const LAS pg8::f32x4*)(ev + 16 * mt + 4 * quad);
            const u2 kk2 = *(const LAS u2*)(kht + (16 * mt + x) * 16 + 4 * quad); v4u ku; ku.x = kk2.x; ku.y = kk2.y; ku.z = 0u; ku.w = 0u;
            Sacc[mt] = __builtin_amdgcn_mfma_f32_16x16x32_bf16(__builtin_bit_cast(bf16x8, ku), vf, Sacc[mt] * e4, 0, 0, 0); }
        if (st + AHEAD < NCH) { if (wave == 0) asm volatile("s_waitcnt vmcnt(10)" ::: "memory"); else asm volatile("s_waitcnt vmcnt(7)" ::: "memory"); }
        else asm volatile("s_waitcnt vmcnt(0)" ::: "memory");
        asm volatile("s_waitcnt lgkmcnt(0)" ::: "memory"); __builtin_amdgcn_s_barrier(); asm volatile("" ::: "memory");
    }
#undef HG_DMA
    float* So = a->out + O_HP + (((size_t)L * NBAT + b) * 6 + h) * 16384;
#pragma unroll
    for (int mt = 0; mt < 8; ++mt)
#pragma unroll
        for (int i = 0; i < 4; ++i) So[(size_t)(16 * mt + 4 * quad + i) * 128 + 16 * wave + x] = Sacc[mt][i];
    asm volatile("s_waitcnt vmcnt(0) lgkmcnt(0)" ::: "memory"); __builtin_amdgcn_s_barrier(); asm volatile("" ::: "memory");
}

__device__ __forceinline__ void phase_pre(ArgsP a, int L, LAS unsigned char* lds, int lane, int wave, int blk, int G) {
    const int gw = blk * NWAVES + wave, NGW = G * NWAVES;
    for (int q = gw; q < NCHUNK; q += NGW) pre_chunk(a, L, q, lds + wave * 16384, lane);
    for (int q2 = gw; q2 < NHCHUNK; q2 += NGW) hpre_chunk(a, L, q2, lds + wave * 16384, lane);
}
__device__ __forceinline__ void rwkv_seq_unit(ArgsP a, int L, int unit, LAS unsigned char* lds, int lane, int wave) {
    unsigned char* ws = a->ws;
    const int b = unit / 12, h = unit - 12 * b;
    const unsigned char* recs = ws + WS_RPB + (size_t)unit * 128 * REC_BYTES;
    LAS float* ybuf = (LAS float*)(lds + 7 * REC_BYTES);
    const int x = lane & 15, quad = lane >> 4;
    constexpr int AHEAD = 5, NCH = SEQ / 16;
#define RW_DMA(cc) do { const unsigned char* g_ = recs + (size_t)(cc) * REC_BYTES + wave * 4096 + lane * 16; LAS unsigned char* l_ = lds + ((cc) % 7) * REC_BYTES + wave * 4096; \
        __builtin_amdgcn_global_load_lds((const unsigned*)(g_), (LAS unsigned*)(l_), 16, 0, 0); __builtin_amdgcn_global_load_lds((const unsigned*)(g_ + 1024), (LAS unsigned*)(l_ + 1024), 16, 0, 0); \
        __builtin_amdgcn_global_load_lds((const unsigned*)(g_ + 2048), (LAS unsigned*)(l_ + 2048), 16, 0, 0); __builtin_amdgcn_global_load_lds((const unsigned*)(g_ + 3072), (LAS unsigned*)(l_ + 3072), 16, 0, 0); } while (0)
    asm volatile("s_waitcnt vmcnt(0) lgkmcnt(0)" ::: "memory"); __builtin_amdgcn_s_barrier(); asm volatile("" ::: "memory");
    pg8::f32x4 Hacc[4];
#pragma unroll
    for (int nt = 0; nt < 4; ++nt) Hacc[nt] = (pg8::f32x4){0.f, 0.f, 0.f, 0.f};
    if (wave < 4) {
#pragma unroll
        for (int cc = 0; cc < AHEAD; ++cc) RW_DMA(cc);
        asm volatile("s_waitcnt vmcnt(16)" ::: "memory");
    }
    __builtin_amdgcn_s_barrier(); asm volatile("" ::: "memory");
    const float gng = a->in[I_BGNG][L * WB + h * 64 + lane], gnb = a->in[I_BGNB][L * WB + h * 64 + lane];
    bf16* ymix = (bf16*)(ws + WS_YMIX) + (size_t)(b * SEQ) * DM + WA + h * 64 + lane;
    for (int c = 0; c <= NCH; ++c) {
        if (wave < 4) {
            if (c < NCH) {
                if (c + AHEAD < NCH) RW_DMA(c + AHEAD); else { asm volatile("s_nop 0" ::: "memory"); }
                const LAS unsigned char* S = lds + (c % 7) * REC_BYTES;
                bf16x8 wf[2], rf[2], hb[2];
#pragma unroll
                for (int ks = 0; ks < 2; ++ks) { wf[ks] = *(const LAS bf16x8*)(S + RC_WT + x * 128 + 64 * ks + 16 * quad); rf[ks] = *(const LAS bf16x8*)(S + RC_RT + x * 128 + 64 * ks + 16 * quad);
                    v4u su; su.x = cvt_pk_bf16_c(Hacc[2 * ks][0], Hacc[2 * ks][1]); su.y = cvt_pk_bf16_c(Hacc[2 * ks][2], Hacc[2 * ks][3]);
                    su.z = cvt_pk_bf16_c(Hacc[2 * ks + 1][0], Hacc[2 * ks + 1][1]); su.w = cvt_pk_bf16_c(Hacc[2 * ks + 1][2], Hacc[2 * ks + 1][3]); hb[ks] = __builtin_bit_cast(bf16x8, su); }
                const u2 vv = *(const LAS u2*)(S + RC_VT + (16 * wave + x) * 32 + 8 * quad); v4u t4; t4.x = vv.x; t4.y = vv.y; t4.z = 0u; t4.w = 0u; const bf16x8 vf = __builtin_bit_cast(bf16x8, t4);
                const u2 m2v = *(const LAS u2*)(S + RC_M2 + x * 32 + 8 * quad); t4.x = m2v.x; t4.y = m2v.y; const bf16x8 m2f = __builtin_bit_cast(bf16x8, t4);
                const u2 brav = *(const LAS u2*)(S + RC_BRA + x * 32 + 8 * quad); t4.x = brav.x; t4.y = brav.y; const bf16x8 braf = __builtin_bit_cast(bf16x8, t4);
                const u2 brkv = *(const LAS u2*)(S + RC_BRK + x * 32 + 8 * quad); t4.x = brkv.x; t4.y = brkv.y; const bf16x8 brkf = __builtin_bit_cast(bf16x8, t4);
                pg8::f32x4 U = (pg8::f32x4){0.f, 0.f, 0.f, 0.f}, Y = U;
                U = __builtin_amdgcn_mfma_f32_16x16x32_bf16(wf[0], hb[0], U, 0, 0, 0); U = __builtin_amdgcn_mfma_f32_16x16x32_bf16(wf[1], hb[1], U, 0, 0, 0); U = __builtin_amdgcn_mfma_f32_16x16x32_bf16(m2f, vf, U, 0, 0, 0);
                Y = __builtin_amdgcn_mfma_f32_16x16x32_bf16(rf[0], hb[0], Y, 0, 0, 0); Y = __builtin_amdgcn_mfma_f32_16x16x32_bf16(rf[1], hb[1], Y, 0, 0, 0); Y = __builtin_amdgcn_mfma_f32_16x16x32_bf16(brkf, vf, Y, 0, 0, 0);
                t4.x = cvt_pk_bf16_c(U[0], U[1]); t4.y = cvt_pk_bf16_c(U[2], U[3]); const bf16x8 ub = __builtin_bit_cast(bf16x8, t4);
                Y = __builtin_amdgcn_mfma_f32_16x16x32_bf16(braf, ub, Y, 0, 0, 0);
#pragma unroll
                for (int nt = 0; nt < 4; ++nt) { const pg8::f32x4 g4 = *(const LAS pg8::f32x4*)(S + RC_G15 + (16 * nt + 4 * quad) * 4);
                    const u2 av = *(const LAS u2*)(S + RC_AHT + (16 * nt + x) * 32 + 8 * quad); t4.x = av.x; t4.y = av.y; const bf16x8 ahf = __builtin_bit_cast(bf16x8, t4);
                    const u2 kv = *(const LAS u2*)(S + RC_KHT + (16 * nt + x) * 32 + 8 * quad); t4.x = kv.x; t4.y = kv.y; const bf16x8 khf = __builtin_bit_cast(bf16x8, t4);
                    Hacc[nt] = __builtin_amdgcn_mfma_f32_16x16x32_bf16(ahf, ub, Hacc[nt] * g4, 0, 0, 0); Hacc[nt] = __builtin_amdgcn_mfma_f32_16x16x32_bf16(khf, vf, Hacc[nt], 0, 0, 0); }
                LAS float* yb = ybuf + (c & 1) * 1024;
#pragma unroll
                for (int i = 0; i < 4; ++i) yb[(4 * quad + i) * 64 + 16 * wave + x] = Y[i];
            }
            if (c + AHEAD < NCH) asm volatile("s_waitcnt vmcnt(16)" ::: "memory"); else asm volatile("s_waitcnt vmcnt(0)" ::: "memory");
        } else if (c > 0) {
            const int cp = c - 1; const LAS unsigned char* S = lds + (cp % 7) * REC_BYTES; const LAS float* yb = ybuf + (cp & 1) * 1024;
#pragma unroll
            for (int j = 0; j < 4; ++j) { const int tt = 4 * (wave - 4) + j; const size_t row = (size_t)(cp * 16 + tt);
                const float g = __builtin_bit_cast(float, (unsigned)(*(const LAS unsigned short*)(S + RC_GT + (tt * 64 + lane) * 2)) << 16); const float y = yb[tt * 64 + lane];
                const float mean = wave_sum_fast(y) * (1.f / 64.f); const float d = y - mean; const float rstd = 1.0f / sqrtf(wave_sum_fast(d * d) * (1.f / 64.f) + GN_EPS);
                const float bcf = *(const LAS float*)(S + RC_BC + tt * 4); const unsigned short vb = *(const LAS unsigned short*)(S + RC_VT + lane * 32 + tt * 2);
                const float v = __builtin_bit_cast(float, (unsigned)vb << 16);
                ymix[row * DM] = bf1((d * rstd * gng + gnb + bcf * v) * g); }
        }
        asm volatile("s_waitcnt lgkmcnt(0)" ::: "memory"); __builtin_amdgcn_s_barrier(); asm volatile("" ::: "memory");
    }
    if (wave < 4) { float* So = a->out + O_RP + (((size_t)L * NBAT + b) * 12 + h) * 4096;
#pragma unroll
        for (int nt = 0; nt < 4; ++nt) *(pg8::f32x4*)(So + (size_t)(16 * wave + x) * 64 + 16 * nt + 4 * quad) = Hacc[nt]; }
#undef RW_DMA
    asm volatile("s_waitcnt vmcnt(0) lgkmcnt(0)" ::: "memory"); __builtin_amdgcn_s_barrier(); asm volatile("" ::: "memory");
}

__device__ __forceinline__ float gelu_fast(float v) {
    const float t = __builtin_amdgcn_rcpf(__builtin_fabsf(v) * 0.2316418882f + 1.0f);
    float q = t * 0.5307027145f + (-0.7265760135f); q = q * t + 0.7107068705f; q = q * t + (-0.142248368f); q = q * t + 0.127414796f; q = q * t;
    const float e = __builtin_amdgcn_exp2f((v * v) * (-0.72134752044f)); const float m = v * (q * e);
    return v < 0.f ? m : v - m;
}
__device__ __forceinline__ void sgu_item2(ArgsP a, int L, int item, LAS unsigned char* lds, int tid, int lane, int wave) {
    unsigned char* ws = a->ws;
    const int g = item & 3, bc = item >> 2, m0 = bc * 128;
    const float* Z = (const float*)(ws + WS_Z);
    LAS bf16* Wb = (LAS bf16*)lds;
    LAS bf16* VT = (LAS bf16*)(lds + 34816);
    const float* wsrc = a->in[I_AWS] + (size_t)(L * 4 + g) * 16384;
    __syncthreads();
#pragma unroll
    for (int j = 0; j < 8; ++j) { const int e4 = j * NTHR + tid, t = e4 >> 5, s0 = (e4 & 31) * 4; const f4 w = *(const f4*)(wsrc + t * 128 + s0);
        u2 o; o.x = cvt_pk_bf16_c(s0 <= t ? w.x : 0.f, s0 + 1 <= t ? w.y : 0.f); o.y = cvt_pk_bf16_c(s0 + 2 <= t ? w.z : 0.f, s0 + 3 <= t ? w.w : 0.f); *(LAS u2*)(Wb + t * 136 + s0) = o; }
    const float lg0 = a->in[I_ALNG][L * WA + g * 128 + lane], lg1 = a->in[I_ALNG][L * WA + g * 128 + 64 + lane], lb0 = a->in[I_ALNB][L * WA + g * 128 + lane], lb1 = a->in[I_ALNB][L * WA + g * 128 + 64 + lane];
    float zv0[16], zv1[16];
#pragma unroll
    for (int rr = 0; rr < 16; ++rr) { const float* zr = Z + (size_t)(m0 + wave * 16 + rr) * PIN + WA + g * 128; zv0[rr] = zr[lane]; zv1[rr] = zr[64 + lane]; }
#pragma unroll
    for (int rr = 0; rr < 16; ++rr) { const int t = wave * 16 + rr; const float v0 = gelu_fast(zv0[rr]), v1 = gelu_fast(zv1[rr]);
        const float mean = wave_sum_fast(v0 + v1) * (1.f / 128.f); const float d0 = v0 - mean, d1 = v1 - mean;
        const float rstd = 1.0f / sqrtf(wave_sum_fast(d0 * d0 + d1 * d1) * (1.f / 128.f) + LN_EPS);
        VT[lane * 136 + t] = bf1(d0 * rstd * lg0 + lb0); VT[(64 + lane) * 136 + t] = bf1(d1 * rstd * lg1 + lb1); }
    __syncthreads();
    const int x = lane & 15, quad = lane >> 4, nks = (wave >> 1) + 1;
    pg8::f32x4 acc[8];
#pragma unroll
    for (int dt = 0; dt < 8; ++dt) acc[dt] = (pg8::f32x4){0.f, 0.f, 0.f, 0.f};
    for (int ks = 0; ks < nks; ++ks) { const bf16x8 wf = *(const LAS bf16x8*)(Wb + (16 * wave + x) * 136 + 32 * ks + 8 * quad);
#pragma unroll
        for (int dt = 0; dt < 8; ++dt) { const bf16x8 vf = *(const LAS bf16x8*)(VT + (16 * dt + x) * 136 + 32 * ks + 8 * quad); acc[dt] = __builtin_amdgcn_mfma_f32_16x16x32_bf16(vf, wf, acc[dt], 0, 0, 0); } }
    const int t = 16 * wave + x; const float bs = a->in[I_ABS][(L * 4 + g) * 128 + t];
    const float* ur = Z + (size_t)(m0 + t) * PIN + g * 128 + 4 * quad; bf16* yo = (bf16*)(ws + WS_YMIX) + (size_t)(m0 + t) * DM + g * 128 + 4 * quad;
#pragma unroll
    for (int dt = 0; dt < 8; ++dt) { const f4 u = *(const f4*)(ur + 16 * dt); u2 o;
        o.x = cvt_pk_bf16_c(gelu_fast(u.x) * (acc[dt][0] + bs), gelu_fast(u.y) * (acc[dt][1] + bs)); o.y = cvt_pk_bf16_c(gelu_fast(u.z) * (acc[dt][2] + bs), gelu_fast(u.w) * (acc[dt][3] + bs));
        *(u2*)(yo + 16 * dt) = o; }
}
__device__ __forceinline__ void hgrn_sample_item2(ArgsP a, int L, int item, LAS unsigned char* lds, int lane, int wave) {
    unsigned char* ws = a->ws;
    const int ih = item * 8 + wave, i = ih / 6, h = ih - i * 6, m = MP + i, vq = lane & 31, kh = lane >> 5;
    const float* zc = (const float*)(ws + WS_Z) + (size_t)m * PIN + OFF_C + h * 128;
    LAS f4* sc = (LAS f4*)(lds + wave * 2048);
#pragma unroll
    for (int t = 0; t < 2; ++t) { const int k = lane + 64 * t; const float lb = lbound(a->in[I_CLB], L, h * 128 + k); const float fz = zc[WC + k];
        const float e = __expf(-fmaxf(fz, -80.f)), sg = __builtin_amdgcn_rcpf(1.0f + e); f4 r; r.x = lb + (1.0f - lb) * sg; r.y = (1.0f - lb) * e * sg; r.z = zc[k]; r.w = 0.f; sc[k] = r; }
    const f4 iv = *(const f4*)(zc + 2 * WC + 4 * vq);
    LDS_WAIT(); asm volatile("" ::: "memory");
    const float* S0 = a->in[I_SHGRN] + (((size_t)L * NS + i) * 6 + h) * 16384 + 4 * vq;
    float* So = a->out + O_HS + (((size_t)L * NS + i) * 6 + h) * 16384 + 4 * vq;
    f4 o = (f4){0.f, 0.f, 0.f, 0.f};
#pragma unroll 1
    for (int qt = 0; qt < 4; ++qt) { f4 sv[16];
#pragma unroll
        for (int j = 0; j < 16; ++j) sv[j] = *(const f4*)(S0 + (size_t)(kh + 2 * (16 * qt + j)) * 128);
#pragma unroll
        for (int j = 0; j < 16; ++j) { const int k = kh + 2 * (16 * qt + j); const f4 c = sc[k]; const f4 n = sv[j] * c.x + iv * c.y; *(f4*)(So + (size_t)k * 128) = n; o += n * c.z; } }
    o.x += __shfl_xor(o.x, 32); o.y += __shfl_xor(o.y, 32); o.z += __shfl_xor(o.z, 32); o.w += __shfl_xor(o.w, 32);
    if (kh == 0) *(f4*)((float*)(ws + WS_O) + (size_t)m * WC + h * 128 + 4 * vq) = o;
    LDS_WAIT(); asm volatile("" ::: "memory");
}

enum { SE_STORE = 0, SE_RESID = 1, SE_SWIGLU = 2, SE_SIGMUL = 3, SE_ATOMIC = 4 };
struct SEpi { int mode; float* out; const float* base; const float* add; int ld; float alpha; float* tinit; };
template <bool PIPE> __device__ __forceinline__ void strip_task(const bf16* A, const bf16* Bt, int K, int r0, int r1, int c0, const SEpi& E, LAS unsigned char* lds, int lane, int wave, int kbeg, int nk) {
    const int x = lane & 15, quad = lane >> 4;
    const int q8 = nk >> 3, r8 = nk & 7, nks = q8 + (wave < r8 ? 1 : 0), ks0 = kbeg + wave * q8 + (wave < r8 ? wave : r8);
    const bf16* Ap = A + (size_t)x * K + ks0 * 32 + 8 * quad;
    const bf16* B0 = Bt + (size_t)(r0 + x) * K + ks0 * 32 + 8 * quad;
    const bf16* B1 = Bt + (size_t)(r1 + x) * K + ks0 * 32 + 8 * quad;
    pg8::f32x4 acc[8][2];
#pragma unroll
    for (int mt = 0; mt < 8; ++mt) { acc[mt][0] = (pg8::f32x4){0.f, 0.f, 0.f, 0.f}; acc[mt][1] = (pg8::f32x4){0.f, 0.f, 0.f, 0.f}; }
    int s = 0;
    if constexpr (PIPE) {
        for (; s + 2 <= nks; s += 2) {
            bf16x8 af[8], ag[8]; const bf16x8 b0 = *(const bf16x8*)(B0 + 32 * s), b1 = *(const bf16x8*)(B1 + 32 * s), c0v = *(const bf16x8*)(B0 + 32 * s + 32), c1v = *(const bf16x8*)(B1 + 32 * s + 32);
#pragma unroll
            for (int mt = 0; mt < 8; ++mt) { af[mt] = *(const bf16x8*)(Ap + (size_t)(16 * mt) * K + 32 * s); ag[mt] = *(const bf16x8*)(Ap + (size_t)(16 * mt) * K + 32 * s + 32); }
#pragma unroll
            for (int mt = 0; mt < 8; ++mt) { acc[mt][0] = __builtin_amdgcn_mfma_f32_16x16x32_bf16(af[mt], b0, acc[mt][0], 0, 0, 0); acc[mt][1] = __builtin_amdgcn_mfma_f32_16x16x32_bf16(af[mt], b1, acc[mt][1], 0, 0, 0); }
#pragma unroll
            for (int mt = 0; mt < 8; ++mt) { acc[mt][0] = __builtin_amdgcn_mfma_f32_16x16x32_bf16(ag[mt], c0v, acc[mt][0], 0, 0, 0); acc[mt][1] = __builtin_amdgcn_mfma_f32_16x16x32_bf16(ag[mt], c1v, acc[mt][1], 0, 0, 0); }
        }
    }
    for (; s < nks; ++s) {
        bf16x8 af[8]; const bf16x8 b0 = *(const bf16x8*)(B0 + 32 * s), b1 = *(const bf16x8*)(B1 + 32 * s);
#pragma unroll
        for (int mt = 0; mt < 8; ++mt) af[mt] = *(const bf16x8*)(Ap + (size_t)(16 * mt) * K + 32 * s);
#pragma unroll
        for (int mt = 0; mt < 8; ++mt) { acc[mt][0] = __builtin_amdgcn_mfma_f32_16x16x32_bf16(af[mt], b0, acc[mt][0], 0, 0, 0); acc[mt][1] = __builtin_amdgcn_mfma_f32_16x16x32_bf16(af[mt], b1, acc[mt][1], 0, 0, 0); }
    }
    __syncthreads();
    LAS pg8::f32x4* red = (LAS pg8::f32x4*)lds;
#pragma unroll
    for (int mt = 0; mt < 8; ++mt) { red[((wave * 8 + mt) * 2 + 0) * 64 + lane] = acc[mt][0]; red[((wave * 8 + mt) * 2 + 1) * 64 + lane] = acc[mt][1]; }
    __syncthreads();
    pg8::f32x4 s0 = (pg8::f32x4){0.f, 0.f, 0.f, 0.f}, s1 = s0;
#pragma unroll
    for (int w2 = 0; w2 < 8; ++w2) { s0 += red[((w2 * 8 + wave) * 2 + 0) * 64 + lane]; s1 += red[((w2 * 8 + wave) * 2 + 1) * 64 + lane]; }
#pragma unroll
    for (int i = 0; i < 4; ++i) { const size_t ro = (size_t)(16 * wave + 4 * quad + i) * E.ld;
        if (E.mode == SE_SWIGLU) { const float g = s0[i]; ((bf16*)E.out)[ro + c0 + x] = bf1(g * __builtin_amdgcn_rcpf(1.0f + __expf(-g)) * s1[i]); }
        else {
#pragma unroll
            for (int t = 0; t < 2; ++t) { const size_t o = ro + c0 + 16 * t + x; const float v = t ? s1[i] : s0[i]; float r;
                if (E.mode == SE_ATOMIC) { __hip_atomic_fetch_add(E.out + o, v, __ATOMIC_RELAXED, __HIP_MEMORY_SCOPE_AGENT); continue; }
                if (E.mode == SE_STORE) r = v;
                else if (E.mode == SE_RESID) { r = E.alpha * E.base[o] + v; if (E.add) r += E.add[o]; }
                else { r = E.base[o] * __builtin_amdgcn_rcpf(1.0f + __expf(-v)); if (E.tinit) E.tinit[o] = E.alpha * E.add[o] + r; }
                E.out[o] = r; } }
    }
}
template <bool PIPE = false> __device__ __forceinline__ void strip_gemm(const bf16* A, const bf16* Bt, int K, int N, const SEpi& E, LAS unsigned char* lds, int lane, int wave, int blk, int G, int ksplit = 1) {
    const int per = (E.mode == SE_SWIGLU) ? 16 : 32, ncg = N / per, ntask = ncg * ksplit, nkt = (K >> 5) / ksplit;
    for (int t = G - 1 - blk; t < ntask; t += G) { const int cg = t % ncg, kg = t / ncg, c0 = cg * per;
        if (E.mode == SE_SWIGLU) { const int rb = ((c0 >> 7) << 8) + (c0 & 127); strip_task<PIPE>(A, Bt, K, rb, rb + 128, c0, E, lds, lane, wave, 0, K >> 5); }
        else strip_task<PIPE>(A, Bt, K, c0, c0 + 16, c0, E, lds, lane, wave, kg * nkt, nkt); }
    __syncthreads();
}

#ifndef EN_PRO
#define EN_PRO 1
#endif
#ifndef EN_G1
#define EN_G1 1
#endif
#ifndef EN_PREP
#define EN_PREP 1
#endif
#ifndef EN_MIX
#define EN_MIX 1
#endif
#ifndef EN_POST
#define EN_POST 1
#endif
#ifndef EN_G3
#define EN_G3 1
#endif
#ifndef EN_LN
#define EN_LN 1
#endif
#ifndef EN_G4
#define EN_G4 1
#endif
#ifndef EN_G5
#define EN_G5 1
#endif
#ifndef REP_PHASE
#define REP_PHASE -1
#endif
#define NREP(k) ((REP_PHASE) == (k) ? 2 : 1)
#ifndef MK_SINGLE
#define MK_SINGLE 1
#endif
constexpr int PPL = 11, N_PHASES = 1 + PPL * DEPTH;
constexpr int SCAN_UNITS = NBAT * 12, HSEQ_UNITS = NBAT * 6, ROLE_BLOCKS = SCAN_UNITS + HSEQ_UNITS;
constexpr int N_SGU = NBAT * 16 * 4, N_RS = NS * 12 / 8, N_HS = NS * 6 / 8, N_MISC = N_SGU + N_RS + N_HS;

__global__ void __launch_bounds__(NTHR, 2) mk_fwd(Args a) {
    extern __shared__ __attribute__((aligned(16))) unsigned char lds_raw[];
    LAS unsigned char* lds = (LAS unsigned char*)lds_raw;
    const int tid = threadIdx.x, blk = blockIdx.x, G = gridDim.x; const int wave0 = __builtin_amdgcn_readfirstlane(tid >> 6);
    ArgsP ap0 = (ArgsP)__builtin_amdgcn_kernarg_segment_ptr();
    volatile LAS unsigned* MISC = (volatile LAS unsigned*)(lds + MISC_OFF);
    for (int u = tid; u < (LDS_BYTES - LDSCTL_OFF) / 4; u += NTHR) ((LAS unsigned*)(lds + LDSCTL_OFF))[u] = 0u;
    __syncthreads();
    const int lo = ap0->ph_lo, hi = ap0->ph_hi;
    XcdBarrier bar; bar.bar = (unsigned*)(ap0->ws + WS_CTL) + CW_BAR; bar.x = 0; bar.st = nullptr;
    if (hi - lo > 1) bar = xcd_barrier_post((unsigned*)(ap0->ws + WS_CTL) + CW_BAR, MISC + 8);
    bar.w0 = (wave0 == 0);
#define IN(k) (lo <= (k) && (k) < hi)
#define SEAM(k) do { if (IN(k) && IN((k) + 1)) { xcd_barrier(bar); } } while (0)
#define PHASE_BEGIN() ArgsP a = ap0; asm volatile("" : "+s"(a)); unsigned char* ws = a->ws; int tid_ = wave0 * 64 + mk_lane_id(); asm volatile("" : "+v"(tid_)); \
    const int lane_ = tid_ & 63; const int wave_ = __builtin_amdgcn_readfirstlane(tid_ >> 6); const int lane_s = lane_, wave_s = wave_; \
    bf16* HB = (bf16*)(ws + WS_HB); float* H = (float*)(ws + WS_H); float* T = (float*)(ws + WS_T); (void)HB; (void)H; (void)T; (void)lane_s; (void)wave_s

    #if EN_PRO
    if (IN(0)) for (int rep = 0; rep < NREP(0); ++rep) { PHASE_BEGIN(); phase_prologue(a, lds, lane_, wave_, blk, G); __syncthreads(); }
#endif
    SEAM(0);
    for (int L = 0; L < DEPTH; ++L) {
        const int pb = 1 + PPL * L;
#if EN_G1
        if (IN(pb)) for (int rep = 0; rep < NREP(1); ++rep) {
            { PHASE_BEGIN(); pg8::Gemm g{HB, (const bf16*)(ws + WS_WIN + L * SZ_WIN), MP, PIN, DM}; pg8::StaticOrder S; S.init(MP, PIN, G, blk);
              pg8::EpiF32 E{(float*)(ws + WS_Z), PIN}; pg8::gemm_phase<pg8::EpiF32, pg8::StaticOrder, true, true>(lds, g, S, E, wave0); }
              { PHASE_BEGIN(); const SEpi SE{SE_STORE, (float*)(ws + WS_Z) + (size_t)MP * PIN, nullptr, nullptr, PIN, 0.f, nullptr}; strip_gemm(HB + (size_t)MP * DM, (const bf16*)(ws + WS_WIN + L * SZ_WIN), DM, PIN, SE, lds, lane_s, wave_s, blk, G); }
            { PHASE_BEGIN(); pg8::Gemm g{(const bf16*)(ws + WS_PBF + L * SZ_PBF), (const bf16*)(ws + WS_WPP + L * SZ_WPP), MP, DM, DPLE}; pg8::StaticOrder S; S.init(MP, DM, G, G - 1 - blk);
              pg8::EpiF32 E{(float*)(ws + WS_PPO), DM}; pg8::gemm_phase<pg8::EpiF32, pg8::StaticOrder, true, true>(lds, g, S, E, wave0); }
              { PHASE_BEGIN(); const SEpi SE{SE_STORE, (float*)(ws + WS_PPO) + (size_t)MP * DM, nullptr, nullptr, DM, 0.f, nullptr}; strip_gemm((const bf16*)(ws + WS_PBF + L * SZ_PBF) + (size_t)MP * DPLE, (const bf16*)(ws + WS_WPP + L * SZ_WPP), DPLE, DM, SE, lds, lane_s, wave_s, blk, G); }
        }
#endif
        SEAM(pb);
#if EN_PREP
        if (IN(pb + 1)) for (int rep = 0; rep < NREP(2); ++rep) { PHASE_BEGIN(); phase_xc(a, L, lane_, wave_, blk, G); }
        SEAM(pb + 1);
        if (IN(pb + 2)) for (int rep = 0; rep < NREP(9); ++rep) {
            { PHASE_BEGIN(); pg8::Gemm g{(const bf16*)(ws + WS_XCAT), (const bf16*)(ws + WS_WL + L * SZ_WL), MP, NLORA, 256}; pg8::StaticOrder S; S.init(MP, NLORA, G, blk);
            pg8::EpiF32 E{(float*)(ws + WS_LORA), NLORA}; pg8::gemm_phase<pg8::EpiF32, pg8::StaticOrder, true, true>(lds, g, S, E, wave0); }
            { PHASE_BEGIN(); const SEpi SE{SE_STORE, (float*)(ws + WS_LORA) + (size_t)MP * NLORA, nullptr, nullptr, NLORA, 0.f, nullptr}; strip_gemm((const bf16*)(ws + WS_XCAT) + (size_t)MP * 256, (const bf16*)(ws + WS_WL + L * SZ_WL), 256, NLORA, SE, lds, lane_s, wave_s, blk, G); }
        }
        SEAM(pb + 2);
        if (IN(pb + 3)) for (int rep = 0; rep < NREP(10); ++rep) { PHASE_BEGIN(); phase_pre(a, L, lds, lane_, wave_, blk, G); phase_fin(a, L, lane_, wave_, blk, G); }
#endif
        SEAM(pb + 3);
#if EN_MIX
        if (IN(pb + 4)) for (int rep = 0; rep < NREP(3); ++rep) { PHASE_BEGIN();
            const int tid = tid_, lane = lane_, wave = wave_;
            if (blk < SCAN_UNITS) { for (int r2 = 0; r2 < NREP(31); ++r2) rwkv_seq_unit(a, L, blk, lds, lane, wave); }
            else if (blk < ROLE_BLOCKS) { for (int r2 = 0; r2 < NREP(32); ++r2) hgrn_stream_unit(a, L, blk - SCAN_UNITS, lds, lane, wave); }
            else for (int r2 = 0; r2 < NREP(33); ++r2) for (int it = blk - ROLE_BLOCKS; it < N_MISC; it += G - ROLE_BLOCKS) {
                if (it < N_SGU) sgu_item2(a, L, it, lds, tid, lane, wave);
                else if (it < N_SGU + N_RS) rwkv_sample_item(a, L, it - N_SGU, lds, lane, wave);
                else hgrn_sample_item2(a, L, it - N_SGU - N_RS, lds, lane, wave);
                __syncthreads();
            }
        }
#endif
        SEAM(pb + 4);
#if EN_POST
        if (IN(pb + 5)) for (int rep = 0; rep < NREP(4); ++rep) { PHASE_BEGIN(); phase_post(a, L, lane_, wave_, blk, G); }
#endif
        SEAM(pb + 5);
#if EN_G3
        if (IN(pb + 6)) for (int rep = 0; rep < NREP(5); ++rep) {
            { PHASE_BEGIN(); pg8::Gemm g{(const bf16*)(ws + WS_YMIX), (const bf16*)(ws + WS_WOUT + L * SZ_WOUT), MP, DM, DM}; pg8::StaticOrder S; S.init(MP, DM, G, blk);
            pg8::EpiResid E{T, H, nullptr, DM, DN_ALPHA}; pg8::gemm_phase<pg8::EpiResid, pg8::StaticOrder, true, true>(lds, g, S, E, wave0); }
            { PHASE_BEGIN(); const SEpi SE{SE_ATOMIC, T + (size_t)MP * DM, nullptr, nullptr, DM, 0.f, nullptr}; strip_gemm<false>((const bf16*)(ws + WS_YMIX) + (size_t)MP * DM, (const bf16*)(ws + WS_WOUT + L * SZ_WOUT), DM, DM, SE, lds, lane_s, wave_s, blk, G, 4); }
        }
#endif
        SEAM(pb + 6);
#if EN_LN
        if (IN(pb + 7)) for (int rep = 0; rep < NREP(6); ++rep) { PHASE_BEGIN(); phase_ln(a, a->in[I_LN1G] + L * DM, a->in[I_LN1B] + L * DM, false, lane_, wave_, blk, G); }
#endif
        SEAM(pb + 7);
#if EN_G4
        if (IN(pb + 8)) for (int rep = 0; rep < NREP(7); ++rep) {
            { PHASE_BEGIN(); pg8::Gemm g{HB, (const bf16*)(ws + WS_WGU + L * SZ_WGU), MP, 2 * DFF, DM}; pg8::StaticOrder S; S.init(MP, 2 * DFF, G, blk);
              pg8::EpiSwiglu E{(bf16*)(ws + WS_ACT), DFF}; pg8::gemm_phase<pg8::EpiSwiglu, pg8::StaticOrder, true, true>(lds, g, S, E, wave0); }
              { PHASE_BEGIN(); const SEpi SE{SE_SWIGLU, (float*)((bf16*)(ws + WS_ACT) + (size_t)MP * DFF), nullptr, nullptr, DFF, 0.f, nullptr}; strip_gemm(HB + (size_t)MP * DM, (const bf16*)(ws + WS_WGU + L * SZ_WGU), DM, DFF, SE, lds, lane_s, wave_s, blk, G); }
            { PHASE_BEGIN(); pg8::Gemm g{HB, (const bf16*)(ws + WS_WPG + L * SZ_WPG), MP, DM, DM}; pg8::StaticOrder S; S.init(MP, DM, G, G - 1 - blk);
              pg8::EpiSigMul E{(float*)(ws + WS_PLE), (const float*)(ws + WS_PPO), DM}; pg8::gemm_phase<pg8::EpiSigMul, pg8::StaticOrder, true, true>(lds, g, S, E, wave0); }
              { PHASE_BEGIN(); const SEpi SE{SE_SIGMUL, (float*)(ws + WS_PLE) + (size_t)MP * DM, (const float*)(ws + WS_PPO) + (size_t)MP * DM, H + (size_t)MP * DM, DM, DN_ALPHA, T + (size_t)MP * DM}; strip_gemm(HB + (size_t)MP * DM, (const bf16*)(ws + WS_WPG + L * SZ_WPG), DM, DM, SE, lds, lane_s, wave_s, blk, G); }
        }
#endif
        SEAM(pb + 8);
#if EN_G5
        if (IN(pb + 9)) for (int rep = 0; rep < NREP(8); ++rep) {
            for (int r3 = 0; r3 < NREP(81); ++r3) { PHASE_BEGIN(); pg8::Gemm g{(const bf16*)(ws + WS_ACT), (const bf16*)(ws + WS_WD + L * SZ_WD), MP, DM, DFF}; pg8::StaticOrder S; S.init(MP, DM, G, blk);
            pg8::EpiResid E{T, H, (const float*)(ws + WS_PLE), DM, DN_ALPHA}; pg8::gemm_phase<pg8::EpiResid, pg8::StaticOrder, true, true>(lds, g, S, E, wave0); }
            for (int r3 = 0; r3 < NREP(82); ++r3) { PHASE_BEGIN(); const SEpi SE{SE_ATOMIC, T + (size_t)MP * DM, nullptr, nullptr, DM, 0.f, nullptr}; strip_gemm<false>((const bf16*)(ws + WS_ACT) + (size_t)MP * DFF, (const bf16*)(ws + WS_WD + L * SZ_WD), DFF, DM, SE, lds, lane_s, wave_s, blk, G, 4); }
        }
#endif
        SEAM(pb + 9);
#if EN_LN
        if (IN(pb + 10)) for (int rep = 0; rep < NREP(6); ++rep) { PHASE_BEGIN(); phase_ln(a, a->in[I_LN2G] + L * DM, a->in[I_LN2B] + L * DM, L == DEPTH - 1, lane_, wave_, blk, G); }
#endif
        SEAM(pb + 10);
    }
#undef IN
#undef SEAM
}

extern "C" void kernel_launch(void* const* d_in, const int* in_sizes, int n_in, void* d_out, int out_size, void* d_ws, size_t ws_size, hipStream_t stream) {
    static int grid = 0;
    if (grid == 0) {
        if (n_in != N_IN || (size_t)out_size != O_END || ws_size < WS_END) { fprintf(stderr, "kernel_launch: unexpected sizes n_in %d out %d ws %zu (need %zu)\n", n_in, out_size, ws_size, (size_t)WS_END); grid = -1; return; }
        int dev = 0, cus = 0, per_cu = 0;
        if (hipGetDevice(&dev) != hipSuccess || hipDeviceGetAttribute(&cus, hipDeviceAttributeMultiprocessorCount, dev) != hipSuccess) { grid = -1; return; }
        if (hipFuncSetAttribute((const void*)mk_fwd, hipFuncAttributeMaxDynamicSharedMemorySize, LDS_BYTES) != hipSuccess) { fprintf(stderr, "kernel_launch: hipFuncSetAttribute failed\n"); grid = -1; return; }
        if (hipOccupancyMaxActiveBlocksPerMultiprocessor(&per_cu, (const void*)mk_fwd, NTHR, LDS_BYTES) != hipSuccess || per_cu < 1) fprintf(stderr, "kernel_launch: occupancy query says %d\n", per_cu);
        (void)hipGetLastError();
        grid = cus;
        if (grid < ROLE_BLOCKS + 8) { fprintf(stderr, "kernel_launch: %d CUs is too few\n", grid); grid = -1; return; }
    }
    if (grid < 0) return;
    if (hipMemsetAsync((char*)d_ws + WS_CTL, 0, CTL_ZERO_BYTES, stream) != hipSuccess) return;
    Args a{};
    for (int i = 0; i < N_IN; ++i) a.in[i] = (const float*)d_in[i];
    a.out = (float*)d_out; a.ws = (unsigned char*)d_ws;
#if MK_SINGLE
    a.ph_lo = 0; a.ph_hi = N_PHASES;
    hipLaunchKernelGGL(mk_fwd, dim3(grid), dim3(NTHR), LDS_BYTES, stream, a);
#else
    for (int p = 0; p < N_PHASES; ++p) { a.ph_lo = p; a.ph_hi = p + 1; hipLaunchKernelGGL(mk_fwd, dim3(grid), dim3(NTHR), LDS_BYTES, stream, a); }
#endif
}
```

```cpp
#include <hip/hip_runtime.h>
#include <cstdio>
#include <cstdint>
typedef float mk_f32x2 __attribute__((ext_vector_type(2))); typedef __bf16 mk_bf16x2 __attribute__((ext_vector_type(2)));
__device__ __forceinline__ unsigned cvt_pk_bf16_c(float lo, float hi) { mk_f32x2 v = {lo, hi}; mk_bf16x2 b = __builtin_convertvector(v, mk_bf16x2); return __builtin_bit_cast(unsigned, b); }
__device__ __forceinline__ int mk_lane_id() { int l; asm volatile("v_mbcnt_lo_u32_b32 %0, -1, 0\n\tv_mbcnt_hi_u32_b32 %0, -1, %0" : "=v"(l)); return l; }
namespace pg8 {
#define PG8_LAS __attribute__((address_space(3)))
typedef unsigned short bf16_t;
typedef short bf16x8 __attribute__((ext_vector_type(8)));
typedef float f32x4 __attribute__((ext_vector_type(4)));
typedef unsigned u32x4 __attribute__((ext_vector_type(4)));
constexpr int BM = 256, BK = 64, HALF = 128, HTB = HALF * BK * 2  , STAGE_BYTES = 8 * HTB, NXCD = 8, WGM = 8;

__host__ __device__ __forceinline__ int lds_byte(int r, int c) { const int st = (r >> 4) * 2 + (c >> 5), rr = r & 15, cc = c & 31, ob = rr * 64 + cc * 2; return st * 1024 + (ob ^ (((ob >> 9) & 1) << 5)); }
__host__ __device__ __forceinline__ void stage_rc(int b, int& R, int& C) { const int st = b / 1024, sb = b % 1024, swz = sb ^ (((sb >> 9) & 1) << 5); R = (st >> 1) * 16 + swz / 64; C = (st & 1) * 32 + (swz % 64) / 2; }
__host__ __device__ __forceinline__ int perm32(int rho) { const int n = rho >> 4, i = rho & 15; return 8 * (i >> 2) + 4 * n + (i & 3); }

struct Unit { int pm, pn; };
struct Gemm { const bf16_t* A; const bf16_t* Bt; int M, N, K; };

struct StaticOrder {
    int nM, nN, nwg, G, c;
    __host__ __device__ void init(int M, int N, int G_, int c_) { nM = M / BM; nN = N / BM; nwg = nM * nN; G = G_; c = c_; }
    __host__ __device__ bool next(int i, Unit& u) const {
        const long L = (long)i * G + c; if (L >= nwg) return false;
        int wgid = (int)L; { const int q = nwg / NXCD, r = nwg % NXCD, xcd = wgid % NXCD, off = wgid / NXCD; wgid = (xcd < r ? xcd * (q + 1) : r * (q + 1) + (xcd - r) * q) + off; }
        const int nig = WGM * nN, gid = wgid / nig, fm = gid * WGM, gsz = (nM - fm) < WGM ? (nM - fm) : WGM;
        u.pm = fm + ((wgid % nig) % gsz); u.pn = (wgid % nig) / gsz; return true;
    }
    __device__ __forceinline__ void a_ready(const Unit&) const {}
    __device__ __forceinline__ void done(const Unit&) const {}
};

__device__ __forceinline__ unsigned cvt_pk_bf16(float lo, float hi) { unsigned r; asm volatile("v_cvt_pk_bf16_f32 %0, %1, %2" : "=v"(r) : "v"(lo), "v"(hi)); return r; }
typedef float f32x2 __attribute__((ext_vector_type(2)));
typedef unsigned u32x2 __attribute__((ext_vector_type(2)));
struct EpiF32 {
    static constexpr bool PERM = false, AFTER_DRAIN = false;
    float* C; int ldc;
    __device__ __forceinline__ void operator()(const f32x4 (&acc)[2][2][4][2], const Unit& u, int wr, int wc, int fr, int fq) const {
        const int row0 = u.pm * BM + wr * 64 + fr, col0 = u.pn * BM + wc * 32 + 4 * fq;
#pragma unroll
        for (int ai = 0; ai < 2; ++ai)
#pragma unroll
            for (int m = 0; m < 4; ++m) { float* rowp = C + (size_t)(row0 + ai * HALF + m * 16) * ldc + col0;
#pragma unroll
                for (int bj = 0; bj < 2; ++bj)
#pragma unroll
                    for (int n = 0; n < 2; ++n) *(f32x4*)(rowp + bj * HALF + n * 16) = acc[ai][bj][m][n]; }
    }
};
struct EpiResid {
    static constexpr bool PERM = false, AFTER_DRAIN = false;
    float* out; const float* base; const float* add; int ldc; float alpha;
    __device__ __forceinline__ void operator()(const f32x4 (&acc)[2][2][4][2], const Unit& u, int wr, int wc, int fr, int fq) const {
        const int row0 = u.pm * BM + wr * 64 + fr, col0 = u.pn * BM + wc * 32 + 4 * fq;
#pragma unroll
        for (int ai = 0; ai < 2; ++ai)
#pragma unroll
            for (int m = 0; m < 4; ++m) { const size_t off = (size_t)(row0 + ai * HALF + m * 16) * ldc + col0;
#pragma unroll
                for (int bj = 0; bj < 2; ++bj)
#pragma unroll
                    for (int n = 0; n < 2; ++n) { const size_t o2 = off + bj * HALF + n * 16; f32x4 v = *(const f32x4*)(base + o2) * alpha + acc[ai][bj][m][n];
                        if (add) v += *(const f32x4*)(add + o2); *(f32x4*)(out + o2) = v; } }
    }
};
struct EpiSigMul {
    static constexpr bool PERM = false, AFTER_DRAIN = false;
    float* out; const float* mul; int ldc;
    __device__ __forceinline__ void operator()(const f32x4 (&acc)[2][2][4][2], const Unit& u, int wr, int wc, int fr, int fq) const {
        const int row0 = u.pm * BM + wr * 64 + fr, col0 = u.pn * BM + wc * 32 + 4 * fq;
#pragma unroll
        for (int ai = 0; ai < 2; ++ai)
#pragma unroll
            for (int m = 0; m < 4; ++m) { const size_t off = (size_t)(row0 + ai * HALF + m * 16) * ldc + col0;
#pragma unroll
                for (int bj = 0; bj < 2; ++bj)
#pragma unroll
                    for (int n = 0; n < 2; ++n) { const size_t o2 = off + bj * HALF + n * 16; const f32x4 x = acc[ai][bj][m][n]; const f32x4 p = *(const f32x4*)(mul + o2); f32x4 v;
#pragma unroll
                        for (int e = 0; e < 4; ++e) v[e] = p[e] * __builtin_amdgcn_rcpf(1.0f + __expf(-x[e]));
                        *(f32x4*)(out + o2) = v; } }
    }
};
struct EpiSwiglu {
    static constexpr bool PERM = true, AFTER_DRAIN = false;
    bf16_t* O; int ldo;
    __device__ __forceinline__ void operator()(const f32x4 (&acc)[2][2][4][2], const Unit& u, int wr, int wc, int fr, int fq) const {
        const int row0 = u.pm * BM + wr * 64 + fr, col0 = u.pn * HALF + wc * 32 + 8 * fq;
#pragma unroll
        for (int ai = 0; ai < 2; ++ai)
#pragma unroll
            for (int m = 0; m < 4; ++m) { bf16_t* rowp = O + (size_t)(row0 + ai * HALF + m * 16) * ldo + col0; float r[8];
#pragma unroll
                for (int n = 0; n < 2; ++n)
#pragma unroll
                    for (int e = 0; e < 4; ++e) { const float g = acc[ai][0][m][n][e], up = acc[ai][1][m][n][e]; r[4 * n + e] = g * __builtin_amdgcn_rcpf(1.0f + __expf(-g)) * up; }
                u32x4 w; w.x = cvt_pk_bf16(r[0], r[1]); w.y = cvt_pk_bf16(r[2], r[3]); w.z = cvt_pk_bf16(r[4], r[5]); w.w = cvt_pk_bf16(r[6], r[7]);
                *(u32x4*)rowp = w; }
    }
};
template <class Epi, class Sched, bool ALIGN_EPI = false, bool SP2 = false>
__device__ __forceinline__ void gemm_phase(PG8_LAS unsigned char* lds, const Gemm g, const Sched& S, const Epi& E, int wid0) {
    int tid_l = wid0 * 64 + mk_lane_id(); asm volatile("" : "+v"(tid_l));
    const int tid = tid_l, wid = __builtin_amdgcn_readfirstlane(tid >> 6), lane = tid & 63, wr = wid >> 2, wc = wid & 3, fr = lane & 15, fq = lane >> 4;
    const int K = g.K, nt = K / BK;
    unsigned voffA[2], voffB[2];
#pragma unroll
    for (int i = 0; i < 2; ++i) { int R, C; stage_rc(tid * 16 + i * 8192, R, C); const int Rb = Epi::PERM ? ((R & ~31) + perm32(R & 31)) : R;
        voffA[i] = (unsigned)(R * K + C) * 2u; voffB[i] = (unsigned)(Rb * K + C) * 2u; }
    const size_t kstep = (size_t)(BK * 2);
    const size_t hstep = (size_t)HALF * K * 2;
    const size_t tstep = 2 * hstep;
    const unsigned ldsw = (unsigned)wid * 1024u;
    const int aoff = lds_byte(wr * 64 + fr, fq * 8), boff = lds_byte(wc * 32 + fr, fq * 8);
#define PG8_SA(b, h) (((b) * 2 + (h)) * HTB)
#define PG8_SB(b, h) ((4 + (b) * 2 + (h)) * HTB)
#define PG8_STAGE(bufoff, gbase, voff) do { _Pragma("unroll") for (int _i = 0; _i < 2; ++_i) \
        __builtin_amdgcn_global_load_lds((const unsigned*)((const char*)(gbase) + (voff)[_i]), (PG8_LAS unsigned*)(lds + (bufoff) + ldsw + _i * 8192), 16, 0, 0); } while (0)
#define PG8_LDA(dst, b, h) do { _Pragma("unroll") for (int m = 0; m < 4; ++m) _Pragma("unroll") for (int k = 0; k < 2; ++k) dst[m][k] = *(const PG8_LAS bf16x8*)(lds + PG8_SA(b, h) + aoff + m * 2048 + k * 1024); } while (0)
#define PG8_LDB(dst, b, h) do { _Pragma("unroll") for (int n = 0; n < 2; ++n) _Pragma("unroll") for (int k = 0; k < 2; ++k) dst[n][k] = *(const PG8_LAS bf16x8*)(lds + PG8_SB(b, h) + boff + n * 2048 + k * 1024); } while (0)
#define PG8_MMA(ai, bj, At, Bt) do { __builtin_amdgcn_s_setprio(1); _Pragma("unroll") for (int m = 0; m < 4; ++m) _Pragma("unroll") for (int n = 0; n < 2; ++n) _Pragma("unroll") for (int k = 0; k < 2; ++k) \
        acc[ai][bj][m][n] = __builtin_amdgcn_mfma_f32_16x16x32_bf16(Bt[n][k], At[m][k], acc[ai][bj][m][n], 0, 0, 0); __builtin_amdgcn_s_setprio(0); } while (0)
#define PG8_WAIT_V(n) asm volatile("s_waitcnt vmcnt(" #n ")" ::: "memory")
#define PG8_WAIT_L(n) asm volatile("s_waitcnt lgkmcnt(" #n ")" ::: "memory")
#define PG8_BAR __builtin_amdgcn_s_barrier()
#define PG8_SCHED __builtin_amdgcn_sched_barrier(0)
    Unit cur, nxt; int ui = 0;
    if (!S.next(0, cur)) return;
    f32x4 acc[2][2][4][2];
#pragma unroll
    for (int a = 0; a < 2; ++a)
#pragma unroll
        for (int b = 0; b < 2; ++b)
#pragma unroll
            for (int m = 0; m < 4; ++m)
#pragma unroll
                for (int n = 0; n < 2; ++n) acc[a][b][m][n] = (f32x4){0.f, 0.f, 0.f, 0.f};
    bf16x8 At[4][2], B0[2][2], B1[2][2];
    const char* cA = (const char*)g.A + (size_t)cur.pm * tstep; const char* cB = (const char*)g.Bt + (size_t)cur.pn * tstep;
    S.a_ready(cur);
    if constexpr (SP2) {
        PG8_STAGE(PG8_SB(0, 0), cB, voffB); PG8_STAGE(PG8_SB(0, 1), cB + hstep, voffB); PG8_STAGE(PG8_SA(0, 0), cA, voffA); PG8_STAGE(PG8_SA(0, 1), cA + hstep, voffA);
        if (wr == 1) PG8_BAR;
        PG8_WAIT_V(2); PG8_BAR;
        PG8_STAGE(PG8_SB(1, 0), cB + kstep, voffB); PG8_STAGE(PG8_SA(1, 0), cA + kstep, voffA); PG8_STAGE(PG8_SB(1, 1), cB + hstep + kstep, voffB);
        PG8_WAIT_V(6); PG8_BAR;
    } else {
        PG8_STAGE(PG8_SB(0, 0), cB, voffB); PG8_STAGE(PG8_SA(0, 0), cA, voffA); PG8_STAGE(PG8_SB(0, 1), cB + hstep, voffB); PG8_STAGE(PG8_SA(0, 1), cA + hstep, voffA);
        if (wr == 1) PG8_BAR;
        PG8_WAIT_V(4); PG8_BAR;
        PG8_STAGE(PG8_SB(1, 0), cB + kstep, voffB); PG8_STAGE(PG8_SA(1, 0), cA + kstep, voffA); PG8_STAGE(PG8_SB(1, 1), cB + hstep + kstep, voffB);
        PG8_WAIT_V(6); PG8_BAR;
    }
    for (;;) {
        const bool has_next = S.next(ui + 1, nxt);
        const char* nA = has_next ? (const char*)g.A + (size_t)nxt.pm * tstep : cA; const char* nB = has_next ? (const char*)g.Bt + (size_t)nxt.pn * tstep : cB;
        for (int t = 0; t < nt; t += 2) {
            const bool last = (t == nt - 2);
            const char* a1 = cA + (size_t)(t + 1) * kstep;
            const char* a2 = last ? nA : cA + (size_t)(t + 2) * kstep; const char* b2 = last ? nB : cB + (size_t)(t + 2) * kstep;
            const char* a3 = a2 + kstep; const char* b3 = b2 + kstep;
            if (last && has_next) S.a_ready(nxt);
            if constexpr (SP2) {
            PG8_LDB(B0, 0, 0); PG8_LDB(B1, 0, 1); PG8_SCHED; PG8_LDA(At, 0, 0); PG8_STAGE(PG8_SA(1, 1), a1 + hstep, voffA);
            PG8_WAIT_V(8); PG8_WAIT_L(0); PG8_BAR; PG8_MMA(0, 0, At, B0); PG8_MMA(0, 1, At, B1); PG8_BAR; PG8_SCHED;
            PG8_LDA(At, 0, 1); PG8_STAGE(PG8_SB(0, 0), b2, voffB); PG8_STAGE(PG8_SB(0, 1), b2 + hstep, voffB); PG8_STAGE(PG8_SA(0, 0), a2, voffA);
            PG8_WAIT_V(8); PG8_WAIT_L(0); PG8_BAR; PG8_MMA(1, 0, At, B0); PG8_MMA(1, 1, At, B1); PG8_BAR; PG8_SCHED;
            PG8_LDB(B0, 1, 0); PG8_LDB(B1, 1, 1); PG8_SCHED; PG8_LDA(At, 1, 0); PG8_STAGE(PG8_SA(0, 1), a2 + hstep, voffA);
            PG8_WAIT_V(8); PG8_WAIT_L(0); PG8_BAR; PG8_MMA(0, 0, At, B0); PG8_MMA(0, 1, At, B1); PG8_BAR; PG8_SCHED;
            PG8_LDA(At, 1, 1); PG8_STAGE(PG8_SB(1, 0), b3, voffB); PG8_STAGE(PG8_SB(1, 1), b3 + hstep, voffB); PG8_STAGE(PG8_SA(1, 0), a3, voffA);
            PG8_WAIT_V(8); PG8_WAIT_L(0); PG8_BAR; PG8_MMA(1, 0, At, B0); PG8_MMA(1, 1, At, B1); PG8_BAR; PG8_SCHED;
            } else {
            PG8_LDB(B0, 0, 0); PG8_SCHED; PG8_LDA(At, 0, 0); PG8_STAGE(PG8_SA(1, 1), a1 + hstep, voffA);
            PG8_WAIT_L(8); PG8_BAR; PG8_WAIT_L(0); PG8_MMA(0, 0, At, B0); PG8_BAR; PG8_SCHED;
            PG8_LDB(B1, 0, 1); PG8_STAGE(PG8_SB(0, 0), b2, voffB);
            PG8_BAR; PG8_WAIT_L(0); PG8_MMA(0, 1, At, B1); PG8_BAR;
            PG8_LDA(At, 0, 1); PG8_STAGE(PG8_SA(0, 0), a2, voffA);
            PG8_BAR; PG8_WAIT_L(0); PG8_MMA(1, 0, At, B0); PG8_BAR; PG8_SCHED;
            PG8_STAGE(PG8_SB(0, 1), b2 + hstep, voffB);
            PG8_WAIT_V(6); PG8_BAR; PG8_MMA(1, 1, At, B1); PG8_BAR;
            PG8_LDB(B0, 1, 0); PG8_SCHED; PG8_LDA(At, 1, 0); PG8_STAGE(PG8_SA(0, 1), a2 + hstep, voffA);
            PG8_WAIT_L(8); PG8_BAR; PG8_WAIT_L(0); PG8_MMA(0, 0, At, B0); PG8_BAR; PG8_SCHED;
            PG8_LDB(B1, 1, 1); PG8_STAGE(PG8_SB(1, 0), b3, voffB);
            PG8_BAR; PG8_WAIT_L(0); PG8_MMA(0, 1, At, B1); PG8_BAR;
            PG8_LDA(At, 1, 1); PG8_STAGE(PG8_SA(1, 0), a3, voffA);
            PG8_BAR; PG8_WAIT_L(0); PG8_MMA(1, 0, At, B0); PG8_BAR; PG8_SCHED;
            PG8_STAGE(PG8_SB(1, 1), b3 + hstep, voffB);
            PG8_WAIT_V(6); PG8_BAR; PG8_MMA(1, 1, At, B1); PG8_BAR;
            }
        }
        if constexpr (ALIGN_EPI) { if (wr == 0) PG8_BAR; }
        if constexpr (!Epi::AFTER_DRAIN) { E(acc, cur, wr, wc, fr, fq); S.done(cur); }
        if (!has_next) break;
#pragma unroll
        for (int a = 0; a < 2; ++a)
#pragma unroll
            for (int b = 0; b < 2; ++b)
#pragma unroll
                for (int m = 0; m < 4; ++m)
#pragma unroll
                    for (int n = 0; n < 2; ++n) acc[a][b][m][n] = (f32x4){0.f, 0.f, 0.f, 0.f};
        cur = nxt; cA = nA; cB = nB; ++ui;
        if constexpr (ALIGN_EPI) { if (wr == 1) PG8_BAR; }
    }
    PG8_WAIT_V(0);
    if constexpr (!ALIGN_EPI) { if (wr == 0) PG8_BAR; }
    PG8_BAR;
    if constexpr (Epi::AFTER_DRAIN) { E.fused(acc, cur, wr, wc, fr, fq, lds, wid, lane); S.done(cur); }
#undef PG8_SA
#undef PG8_SB
#undef PG8_STAGE
#undef PG8_LDA
#undef PG8_LDB
#undef PG8_MMA
#undef PG8_WAIT_V
#undef PG8_WAIT_L
#undef PG8_BAR
#undef PG8_SCHED
}
}
#define GAS __attribute__((address_space(1)))
#define LAS __attribute__((address_space(3)))
typedef unsigned short bf16;
typedef unsigned v4u __attribute__((ext_vector_type(4)));
typedef float f32x4 __attribute__((ext_vector_type(4)));
typedef short bf16x8 __attribute__((ext_vector_type(8)));
typedef GAS unsigned gu32;
typedef GAS unsigned long long gu64;
#define RLX_AGENT __ATOMIC_RELAXED, __HIP_MEMORY_SCOPE_AGENT
#define LDS_WAIT() asm volatile("s_waitcnt lgkmcnt(0)" ::: "memory")
#define VM_WAIT() asm volatile("s_waitcnt vmcnt(0)" ::: "memory")
__device__ __forceinline__ unsigned long long rt() { return __builtin_amdgcn_s_memrealtime(); }
__device__ __forceinline__ unsigned f2bf(float f) { unsigned u = __builtin_bit_cast(unsigned, f); return (u + 0x7fffu + ((u >> 16) & 1u)) >> 16; }
__device__ __forceinline__ unsigned pk2(float lo, float hi) { return f2bf(lo) | (f2bf(hi) << 16); }

#define XB_TMO      128
#define XB_XCNT(j)  (256  + 64 * (j))
#define XB_XSUB(j)  (1280 + 64 * (j))
#define XB_XGEN(j)  (2304 + 64 * (j))
#define XB_TOP      3328
#define XB_TOPGEN   3392
#define XCD_BAR_WORDS 3456
#define XB_SPIN_CAP (1u << 18)

__device__ __forceinline__ unsigned xb_ld(unsigned* p)              { return __hip_atomic_load(p, __ATOMIC_RELAXED, __HIP_MEMORY_SCOPE_AGENT); }
__device__ __forceinline__ unsigned xb_add(unsigned* p, unsigned v) { return __hip_atomic_fetch_add(p, v, __ATOMIC_RELAXED, __HIP_MEMORY_SCOPE_AGENT); }
__device__ __forceinline__ unsigned xb_xcc_id() { return (unsigned)__builtin_amdgcn_s_getreg((3 << 11) | 20) & 0xFu; }
#define XB_SPIN(cond, bar) do { unsigned _sp = 0; while (cond) { __builtin_amdgcn_s_sleep(1); \
    if ((++_sp & 255u) == 0u) { if (xb_ld(&(bar)[XB_TMO])) break; if (_sp > XB_SPIN_CAP) { atomicAdd(&(bar)[XB_TMO], 1u); break; } } } } while (0)

struct XcdBarrier {
    unsigned* bar; unsigned x;
    volatile LAS unsigned* st;
    bool w0;
};

__device__ __forceinline__ XcdBarrier xcd_barrier_post(unsigned* bar, volatile LAS unsigned* st) {
    XcdBarrier b; b.bar = bar; b.x = xb_xcc_id(); b.st = st;
    if (threadIdx.x == 0) (void)xb_add(&bar[XB_XCNT(b.x)], 1u);
    return b;
}
__device__ __forceinline__ void xcd_barrier_complete(unsigned* bar, unsigned x, unsigned& nloc, unsigned& nx) {
    const unsigned G = gridDim.x * gridDim.y * gridDim.z;
    unsigned sum, cnt, mine, sp = 0u;
    for (;;) {
        sum = 0u; cnt = 0u; mine = 0u;
#pragma unroll
        for (unsigned j = 0; j < 16; ++j) { const unsigned c = xb_ld(&bar[XB_XCNT(j)]); sum += c; cnt += (c > 0u) ? 1u : 0u; mine = (j == x) ? c : mine; }
        if (sum == G) break;
        __builtin_amdgcn_s_sleep(1);
        if ((++sp & 255u) == 0u) { if (xb_ld(&bar[XB_TMO])) break; if (sp > XB_SPIN_CAP) { atomicAdd(&bar[XB_TMO], 1u); break; } }
    }
    nloc = mine > 0u ? mine : 1u; nx = cnt > 0u ? cnt : 1u;
}

__device__ __forceinline__ void xcd_barrier(const XcdBarrier& b) {
    asm volatile("s_waitcnt vmcnt(0)" ::: "memory");
    __syncthreads();
    if (b.w0 && mk_lane_id() == 0) {
        unsigned* bar = b.bar;
        __builtin_amdgcn_s_waitcnt(0);
        unsigned nloc = b.st[0], nx = b.st[1];
        if (nloc == 0u) { xcd_barrier_complete(bar, b.x, nloc, nx); b.st[0] = nloc; b.st[1] = nx; }
        const unsigned old = xb_add(&bar[XB_XSUB(b.x)], 1u);
        const unsigned gen = old / nloc;
        if (old + 1u == (gen + 1u) * nloc) {
            __builtin_amdgcn_fence(__ATOMIC_RELEASE, "agent");
            asm volatile("s_waitcnt vmcnt(0)" ::: "memory");
            const unsigned og = xb_add(&bar[XB_TOP], 1u);
            const unsigned tg = og / nx;
            if (og + 1u == (tg + 1u) * nx) xb_add(&bar[XB_TOPGEN], 1u);
            else XB_SPIN(xb_ld(&bar[XB_TOPGEN]) == tg, bar);
            __builtin_amdgcn_fence(__ATOMIC_ACQUIRE, "agent");
            xb_add(&bar[XB_XGEN(b.x)], 1u);
            asm volatile("s_waitcnt vmcnt(0)" ::: "memory");
        } else {
            XB_SPIN(xb_ld(&bar[XB_XGEN(b.x)]) == gen, bar);
            __builtin_amdgcn_fence(__ATOMIC_ACQUIRE, "agent");
            asm volatile("s_waitcnt vmcnt(0)" ::: "memory");
        }
    }
    __syncthreads();
}

constexpr int DM = 2048, NBAT = 4, SEQ = 2048, DEPTH = 4, NS = 128;
constexpr int MP = NBAT * SEQ;
constexpr int MV = MP + NS;
constexpr int MPAD = 8448;
constexpr int WA = 512, WB = 768, WC = 768, PIN = 6656, DFF = 5632, DPLE = 256, PBW = 2560;
constexpr int OFF_B = 1024, OFF_C = 3584;
constexpr float LN_EPS = 1e-5f, GN_EPS = 64e-5f, RMS_EPS = 1e-6f;
constexpr float DN_ALPHA = 1.681792830507429f;
enum { I_XP = 0, I_XS, I_SRWKV, I_SSHIFT, I_SHGRN, I_PP, I_PS, I_LNING, I_LNINB, I_WIN, I_ALNG, I_ALNB, I_AWS, I_ABS, I_BMU, I_BW0, I_BWUP, I_BA0, I_BAUP, I_BGUP,
       I_BKK, I_BKA, I_BRK, I_BGNG, I_BGNB, I_CLB, I_CNG, I_WOUT, I_LN1G, I_LN1B, I_WG, I_WU, I_WD, I_WPG, I_WPP, I_LN2G, I_LN2B, N_IN };
constexpr size_t O_YP = 0, O_YS = O_YP + (size_t)MP * DM, O_RP = O_YS + (size_t)NS * DM, O_SP = O_RP + (size_t)DEPTH * NBAT * 12 * 4096,
                 O_HP = O_SP + (size_t)DEPTH * NBAT * PBW, O_RS = O_HP + (size_t)DEPTH * NBAT * 6 * 16384, O_SS = O_RS + (size_t)DEPTH * NS * 12 * 4096,
                 O_HS = O_SS + (size_t)DEPTH * NS * PBW, O_VS = O_HS + (size_t)DEPTH * NS * 6 * 16384, O_END = O_VS + (size_t)DEPTH * NS * WA;
static_assert(O_END == 96509952, "output size");
constexpr size_t al256(size_t x) { return (x + 255) & ~(size_t)255; }
constexpr size_t WS_CTL = 0, CTL_ZERO_BYTES = 1u << 20;
constexpr size_t SZ_WIN = (size_t)PIN * DM * 2, SZ_WOUT = (size_t)DM * DM * 2, SZ_WGU = (size_t)2 * DFF * DM * 2, SZ_WD = (size_t)DM * DFF * 2, SZ_WPG = SZ_WOUT, SZ_WPP = (size_t)DM * DPLE * 2;
constexpr size_t WS_WIN = CTL_ZERO_BYTES, WS_WOUT = WS_WIN + DEPTH * SZ_WIN, WS_WGU = WS_WOUT + DEPTH * SZ_WOUT, WS_WD = WS_WGU + DEPTH * SZ_WGU, WS_WPG = WS_WD + DEPTH * SZ_WD,
                 WS_WPP = WS_WPG + DEPTH * SZ_WPG, WS_PBF = WS_WPP + DEPTH * SZ_WPP;
constexpr size_t SZ_PBF = (size_t)MPAD * DPLE * 2;
constexpr size_t WS_H = WS_PBF + DEPTH * SZ_PBF, WS_HB = WS_H + (size_t)MPAD * DM * 4, WS_T = WS_HB + (size_t)MPAD * DM * 2, WS_YMIX = WS_T + (size_t)MPAD * DM * 4;
constexpr size_t WS_Z = WS_YMIX + (size_t)MPAD * DM * 2;
constexpr size_t WS_ACT = WS_Z, WS_PLE = WS_ACT + al256((size_t)MPAD * DFF * 2);
constexpr size_t WS_PPO = WS_Z + (size_t)MPAD * PIN * 4;
static_assert(WS_PLE + (size_t)MPAD * DM * 4 <= WS_PPO, "overlay fits");
constexpr size_t WS_RPB = WS_PPO + (size_t)MPAD * DM * 4;
constexpr size_t WS_RPS = WS_RPB + (size_t)NBAT * 12 * (SEQ / 16) * 16384;
constexpr int NLORA = 3 * WB;
constexpr size_t SZ_WL = (size_t)NLORA * 256 * 2;
constexpr size_t WS_WL = WS_RPS + (size_t)NS * 12 * 384 * 4;
constexpr size_t WS_XCAT = WS_WL + DEPTH * SZ_WL;
constexpr size_t WS_LORA = WS_XCAT + (size_t)MPAD * 256 * 2;
constexpr size_t WS_Y = WS_LORA + (size_t)MPAD * NLORA * 4;
constexpr size_t WS_O = WS_Y + (size_t)MPAD * WB * 4;
constexpr size_t WS_HREC = WS_O + (size_t)MPAD * WC * 4;
constexpr size_t WS_END = WS_HREC + (size_t)NBAT * 6 * (SEQ / 16) * 17408;
static_assert(WS_WIN % 256 == 0 && WS_H % 256 == 0 && WS_Z % 256 == 0 && WS_RPB % 256 == 0 && WS_WL % 256 == 0 && WS_XCAT % 256 == 0 && WS_LORA % 256 == 0 && WS_Y % 256 == 0, "alignment");
constexpr int CW_BAR = 4096;

constexpr int RING_BYTES = 131072, LDSCTL_OFF = RING_BYTES, MISC_OFF = LDSCTL_OFF + 320, LDS_BYTES = 147456;
constexpr int NWAVES = 8, NTHR = 512;

struct Args { const float* in[N_IN]; float* out; unsigned char* ws; int ph_lo, ph_hi; };
static_assert(sizeof(Args) == (N_IN + 2) * 8 + 8, "no padding in Args");
typedef const __attribute__((address_space(4))) Args* ArgsP;

typedef float f4 __attribute__((ext_vector_type(4)));
typedef float f2 __attribute__((ext_vector_type(2)));
typedef unsigned u2 __attribute__((ext_vector_type(2)));

__device__ __forceinline__ float wave_sum(float v) {
#pragma unroll
    for (int o = 1; o < 64; o <<= 1) v += __shfl_xor(v, o);
    return v;
}
template <int CTRL> __device__ __forceinline__ float dpp_f(float x) { return __builtin_bit_cast(float, __builtin_amdgcn_update_dpp(0, __builtin_bit_cast(int, x), CTRL, 0xF, 0xF, true)); }
__device__ __forceinline__ float row16_sum(float x) {
    x += dpp_f<0xB1>(x);
    x += dpp_f<0x4E>(x);
    x += dpp_f<0x141>(x);
    x += dpp_f<0x140>(x);
    return x;
}
__device__ __forceinline__ float sigmoidf_(float x) { return 1.0f / (1.0f + expf(-x)); }
__device__ __forceinline__ float gelu_erf(float x) { return 0.5f * x * (1.0f + erff(x * 0.70710678118654752f)); }
__device__ __forceinline__ unsigned short bf1(float x) { return (unsigned short)(cvt_pk_bf16_c(x, 0.f) & 0xffffu); }
__device__ __forceinline__ float lbound(const float* clb, int L, int c) {
    const float x0 = clb[c], x1 = clb[WC + c], x2 = clb[2 * WC + c], x3 = clb[3 * WC + c];
    const float mx = fmaxf(fmaxf(x0, x1), fmaxf(x2, x3));
    const float e0 = expf(x0 - mx), e1 = expf(x1 - mx), e2 = expf(x2 - mx), e3 = expf(x3 - mx);
    float s = 0.f; if (L >= 1) s += e1; if (L >= 2) s += e2; if (L >= 3) s += e3;
    return s / (e0 + e1 + e2 + e3);
}
__device__ __forceinline__ float log_sigmoid(float x) { return fminf(x, 0.f) - log1pf(expf(-fabsf(x))); }

__device__ __forceinline__ void tr_item(const float* W, int K, int N, bf16* WT, int mode, LAS float* scr, int item, int lane) {
    const int nblk = N >> 5, kb = item / nblk, nb = item - kb * nblk, k0 = kb << 6, n0 = nb << 5;
    int rb = n0; if (mode) rb = ((n0 >> 7) << 8) + (n0 & 127) + (mode == 2 ? 128 : 0);
#pragma unroll 8
    for (int i = 0; i < 32; ++i) { const int kk = 2 * i + (lane >> 5); scr[kk * 33 + (lane & 31)] = W[(size_t)(k0 + kk) * N + n0 + (lane & 31)]; }
    LDS_WAIT(); asm volatile("" ::: "memory");
    const int c = lane & 7;
#pragma unroll
    for (int j = 0; j < 4; ++j) { const int n = (lane >> 3) + 8 * j; const LAS float* s = scr + (8 * c) * 33 + n;
        v4u o; o.x = pg8::cvt_pk_bf16(s[0 * 33], s[1 * 33]); o.y = pg8::cvt_pk_bf16(s[2 * 33], s[3 * 33]); o.z = pg8::cvt_pk_bf16(s[4 * 33], s[5 * 33]); o.w = pg8::cvt_pk_bf16(s[6 * 33], s[7 * 33]);
        *(v4u*)(WT + (size_t)(rb + n) * K + k0 + 8 * c) = o; }
    LDS_WAIT(); asm volatile("" ::: "memory");
}
__device__ __forceinline__ void ln_row(const float* src, const float* g, const float* b, float* dstf, bf16* dstb, float* dst2, int lane) {
    f4 v[8]; float s = 0.f;
#pragma unroll
    for (int j = 0; j < 8; ++j) { v[j] = *(const f4*)(src + 4 * (lane + 64 * j)); s += (v[j].x + v[j].y) + (v[j].z + v[j].w); }
    const float mean = wave_sum(s) * (1.f / DM); float s2 = 0.f;
#pragma unroll
    for (int j = 0; j < 8; ++j) { v[j] = v[j] - mean; s2 += (v[j].x * v[j].x + v[j].y * v[j].y) + (v[j].z * v[j].z + v[j].w * v[j].w); }
    const float rstd = 1.0f / sqrtf(wave_sum(s2) * (1.f / DM) + LN_EPS);
#pragma unroll
    for (int j = 0; j < 8; ++j) { const int c = 4 * (lane + 64 * j); const f4 gg = *(const f4*)(g + c), bb = *(const f4*)(b + c); const f4 o = v[j] * rstd * gg + bb;
        *(f4*)(dstf + c) = o; if (dst2) *(f4*)(dst2 + c) = o;
        u2 w; w.x = pg8::cvt_pk_bf16(o.x, o.y); w.y = pg8::cvt_pk_bf16(o.z, o.w); *(u2*)(dstb + c) = w; }
}
__device__ __forceinline__ void phase_prologue(ArgsP a, LAS unsigned char* lds, int lane, int wave, int blk, int G) {
    LAS float* scr = (LAS float*)(lds + wave * 16384);
    const int gw = blk * NWAVES + wave, NGW = G * NWAVES;
    constexpr int I_IN = 32 * (PIN / 32), I_OUT = 32 * (DM / 32), I_G = 32 * (DFF / 32), I_D = (DFF / 64) * (DM / 32), I_PGc = I_OUT, I_PPc = (DPLE / 64) * (DM / 32);
    constexpr int PER_L = I_IN + I_OUT + 2 * I_G + I_D + I_PGc + I_PPc;
    unsigned char* ws = a->ws;
    for (int it = gw; it < DEPTH * PER_L; it += NGW) {
        const int L = it / PER_L; int r = it - L * PER_L;
        if (r < I_IN) { tr_item(a->in[I_WIN] + (size_t)L * DM * PIN, DM, PIN, (bf16*)(ws + WS_WIN + L * SZ_WIN), 0, scr, r, lane); continue; } r -= I_IN;
        if (r < I_OUT) { tr_item(a->in[I_WOUT] + (size_t)L * DM * DM, DM, DM, (bf16*)(ws + WS_WOUT + L * SZ_WOUT), 0, scr, r, lane); continue; } r -= I_OUT;
        if (r < I_G) { tr_item(a->in[I_WG] + (size_t)L * DM * DFF, DM, DFF, (bf16*)(ws + WS_WGU + L * SZ_WGU), 1, scr, r, lane); continue; } r -= I_G;
        if (r < I_G) { tr_item(a->in[I_WU] + (size_t)L * DM * DFF, DM, DFF, (bf16*)(ws + WS_WGU + L * SZ_WGU), 2, scr, r, lane); continue; } r -= I_G;
        if (r < I_D) { tr_item(a->in[I_WD] + (size_t)L * DFF * DM, DFF, DM, (bf16*)(ws + WS_WD + L * SZ_WD), 0, scr, r, lane); continue; } r -= I_D;
        if (r < I_PGc) { tr_item(a->in[I_WPG] + (size_t)L * DM * DM, DM, DM, (bf16*)(ws + WS_WPG + L * SZ_WPG), 0, scr, r, lane); continue; } r -= I_PGc;
        tr_item(a->in[I_WPP] + (size_t)L * DPLE * DM, DPLE, DM, (bf16*)(ws + WS_WPP + L * SZ_WPP), 0, scr, r, lane);
    }
    for (int it = gw; it < DEPTH * NLORA; it += NGW) { const int L = it / NLORA, n = it - L * NLORA; float v[4];
#pragma unroll
        for (int e = 0; e < 4; ++e) { const int k = 4 * lane + e; float x = 0.f;
            if (n < WB) { if (k < 64) x = a->in[I_BWUP][((size_t)L * 64 + k) * WB + n]; }
            else if (n < 2 * WB) { if (k >= 64 && k < 128) x = a->in[I_BAUP][((size_t)L * 64 + (k - 64)) * WB + (n - WB)]; }
            else { if (k >= 128) x = a->in[I_BGUP][((size_t)L * 128 + (k - 128)) * WB + (n - 2 * WB)]; }
            v[e] = x; }
        u2 w; w.x = pg8::cvt_pk_bf16(v[0], v[1]); w.y = pg8::cvt_pk_bf16(v[2], v[3]); *(u2*)((bf16*)(ws + WS_WL + L * SZ_WL) + (size_t)n * 256 + 4 * lane) = w; }
    for (int it = gw; it < DEPTH * MV; it += NGW) { const int L = it / MV, m = it - L * MV;
        const float* src = (m < MP) ? a->in[I_PP] + ((size_t)L * MP + m) * DPLE : a->in[I_PS] + ((size_t)L * NS + (m - MP)) * DPLE;
        const f4 v = *(const f4*)(src + 4 * lane); u2 w; w.x = pg8::cvt_pk_bf16(v.x, v.y); w.y = pg8::cvt_pk_bf16(v.z, v.w);
        *(u2*)((bf16*)(ws + WS_PBF + L * SZ_PBF) + (size_t)m * DPLE + 4 * lane) = w; }
    for (int m = gw; m < MV; m += NGW) { const float* src = (m < MP) ? a->in[I_XP] + (size_t)m * DM : a->in[I_XS] + (size_t)(m - MP) * DM;
        ln_row(src, a->in[I_LNING], a->in[I_LNINB], (float*)(ws + WS_H) + (size_t)m * DM, (bf16*)(ws + WS_HB) + (size_t)m * DM, nullptr, lane); }
}
__device__ __forceinline__ void phase_ln(ArgsP a, const float* g, const float* b, bool last, int lane, int wave, int blk, int G) {
    const int gw = blk * NWAVES + wave, NGW = G * NWAVES; unsigned char* ws = a->ws;
    for (int m = gw; m < MV; m += NGW)
        ln_row((const float*)(ws + WS_T) + (size_t)m * DM, g, b, (float*)(ws + WS_H) + (size_t)m * DM, (bf16*)(ws + WS_HB) + (size_t)m * DM,
               last ? a->out + (m < MP ? O_YP + (size_t)m * DM : O_YS + (size_t)(m - MP) * DM) : nullptr, lane);
}


__device__ __forceinline__ void phase_xc(ArgsP a, int L, int lane, int wave, int blk, int G) {
    unsigned char* ws = a->ws; const int gw = blk * NWAVES + wave, NGW = G * NWAVES;
    const float* Z = (const float*)(ws + WS_Z);
    const float* mu = a->in[I_BMU] + L * PBW; const float* sh0 = a->in[I_SSHIFT] + (size_t)L * NS * PBW;
    const f4 mu4 = *(const f4*)(mu + 2304 + 4 * lane);
    for (int m = gw; m < MV; m += NGW) {
        const bool samp = m >= MP; const float* zr = Z + (size_t)m * PIN + OFF_B;
        const f4 cur = *(const f4*)(zr + 2304 + 4 * lane); f4 prev;
        if (samp) prev = *(const f4*)(sh0 + (size_t)(m - MP) * PBW + 2304 + 4 * lane); else if (m & (SEQ - 1)) prev = *(const f4*)(zr - PIN + 2304 + 4 * lane); else prev = (f4){0.f, 0.f, 0.f, 0.f};
        f4 x = cur + mu4 * (prev - cur);
        if (lane < 16) { x.x = tanhf(x.x); x.y = tanhf(x.y); x.z = tanhf(x.z); x.w = tanhf(x.w); }
        else if (lane >= 32) { x.x = sigmoidf_(x.x); x.y = sigmoidf_(x.y); x.z = sigmoidf_(x.z); x.w = sigmoidf_(x.w); }
        u2 w; w.x = pg8::cvt_pk_bf16(x.x, x.y); w.y = pg8::cvt_pk_bf16(x.z, x.w); *(u2*)((bf16*)(ws + WS_XCAT) + (size_t)m * 256 + 4 * lane) = w;
        if (samp || (m & (SEQ - 1)) == SEQ - 1) { float* dst = samp ? a->out + O_SS + ((size_t)L * NS + (m - MP)) * PBW : a->out + O_SP + ((size_t)L * NBAT + (m >> 11)) * PBW;
#pragma unroll
            for (int j = 0; j < PBW / 256; ++j) *(f4*)(dst + 256 * j + 4 * lane) = *(const f4*)(zr + 256 * j + 4 * lane); }
        if (samp) { const int i = m - MP; const float* z0 = Z + (size_t)m * PIN; const float* lng = a->in[I_ALNG] + L * WA; const float* lnb = a->in[I_ALNB] + L * WA;
            for (int g = 0; g < 4; ++g) {
                const float u0 = gelu_erf(z0[g * 128 + lane]), u1 = gelu_erf(z0[g * 128 + 64 + lane]);
                const float v0 = gelu_erf(z0[WA + g * 128 + lane]), v1 = gelu_erf(z0[WA + g * 128 + 64 + lane]);
                const float mean = wave_sum(v0 + v1) * (1.f / 128.f); const float d0 = v0 - mean, d1 = v1 - mean;
                const float rstd = 1.0f / sqrtf(wave_sum(d0 * d0 + d1 * d1) * (1.f / 128.f) + LN_EPS);
                const float n0 = d0 * rstd * lng[g * 128 + lane] + lnb[g * 128 + lane], n1 = d1 * rstd * lng[g * 128 + 64 + lane] + lnb[g * 128 + 64 + lane];
                float* ov = a->out + O_VS + ((size_t)L * NS + i) * WA + g * 128; ov[lane] = n0; ov[64 + lane] = n1;
                const float w00 = a->in[I_AWS][(size_t)(L * 4 + g) * 16384], b0 = a->in[I_ABS][(L * 4 + g) * 128];
                bf16* yo = (bf16*)(ws + WS_YMIX) + (size_t)m * DM + g * 128; yo[lane] = bf1(u0 * (w00 * n0 + b0)); yo[64 + lane] = bf1(u1 * (w00 * n1 + b0)); } }
    }
}
__device__ __forceinline__ void phase_fin(ArgsP a, int L, int lane, int wave, int blk, int G) {
    unsigned char* ws = a->ws; const int gw = blk * NWAVES + wave, NGW = G * NWAVES;
    const float* Z = (const float*)(ws + WS_Z); const float* LO = (const float*)(ws + WS_LORA);
    const float* mu = a->in[I_BMU] + L * PBW; const float* w0 = a->in[I_BW0] + L * WB; const float* a0 = a->in[I_BA0] + L * WB;
    const float* k_k = a->in[I_BKK] + L * WB; const float* k_a = a->in[I_BKA] + L * WB; const float* sh0 = a->in[I_SSHIFT] + (size_t)L * NS * PBW;
    for (int m = MP + gw; m < MV; m += NGW) {
        const bool samp = m >= MP; const float* zr = Z + (size_t)m * PIN + OFF_B; const float* lo = LO + (size_t)m * NLORA;
        const float* pz = samp ? sh0 + (size_t)(m - MP) * PBW : zr - PIN; const bool first = !samp && (m & (SEQ - 1)) == 0;
#pragma unroll 4
        for (int j = 0; j < 12; ++j) { const int c = 64 * j + lane;
            const float cr = zr[c], ck = zr[WB + c], cv = zr[2 * WB + c];
            float pr = 0.f, pk = 0.f, pv = 0.f; if (!first) { pr = pz[c]; pk = pz[WB + c]; pv = pz[2 * WB + c]; }
            const float r = cr + mu[c] * (pr - cr), k = ck + mu[WB + c] * (pk - ck), v = cv + mu[2 * WB + c] * (pv - cv);
            const float dec = __expf(-0.6065306597126334f * sigmoidf_(w0[c] + lo[c]));
            const float av = sigmoidf_(a0[c] + lo[WB + c]);
            const float kkr = k * k_k[c]; const float ss = wave_sum(kkr * kkr); const float kk = kkr / fmaxf(sqrtf(ss), 1e-12f);
            const float kp = k * (1.0f + (av - 1.0f) * k_a[c]);
            float* rec = samp ? (float*)(ws + WS_RPS) + ((size_t)(m - MP) * 12 + j) * 384 : (float*)(ws + WS_RPB) + (((size_t)(m >> 11) * 12 + j) * SEQ + (m & (SEQ - 1))) * 384;
            rec[lane] = r; rec[64 + lane] = dec; rec[128 + lane] = kp; rec[192 + lane] = v; rec[256 + lane] = kk; rec[320 + lane] = kk * av; }
    }
}

__device__ __forceinline__ void rwkv_scan_unit(ArgsP a, int L, int unit, LAS unsigned char* lds, int tid, int lane, int wave) {
    unsigned char* ws = a->ws;
    const int bh = unit >> 1, half = unit & 1, b = bh / 12, h = bh - b * 12;
    const f4* rec4 = (const f4*)((const float*)(ws + WS_RPB) + (size_t)bh * SEQ * 384);
    LAS float* buf = (LAS float*)lds;
    LAS float* ybuf = (LAS float*)(lds + 49152);
    const int rowl = wave * 4 + (lane >> 4), kg = lane & 15, row = half * 32 + rowl;
    float S0 = 0.f, S1 = 0.f, S2 = 0.f, S3 = 0.f;
    f4 st0, st1, st2;
    __syncthreads();
    st0 = rec4[tid]; st1 = rec4[512 + tid]; st2 = rec4[1024 + tid];
    *(LAS f4*)(buf + 4 * tid) = st0; *(LAS f4*)(buf + 4 * (512 + tid)) = st1; *(LAS f4*)(buf + 4 * (1024 + tid)) = st2;
    __syncthreads();
    float* Y = (float*)(ws + WS_Y);
    for (int c = 0; c < SEQ / 16; ++c) {
        if (c + 1 < SEQ / 16) { const f4* nx = rec4 + (size_t)(c + 1) * 1536; st0 = nx[tid]; st1 = nx[512 + tid]; st2 = nx[1024 + tid]; }
        const LAS float* cur = buf + (c & 1) * 6144; LAS float* yb = ybuf + (c & 1) * 512;
        f4 r4 = *(const LAS f4*)(cur + 4 * kg), w4 = *(const LAS f4*)(cur + 64 + 4 * kg), k4 = *(const LAS f4*)(cur + 128 + 4 * kg),
           kk4 = *(const LAS f4*)(cur + 256 + 4 * kg), ka4 = *(const LAS f4*)(cur + 320 + 4 * kg); float v = cur[192 + row];
#pragma unroll
        for (int s = 0; s < 16; ++s) {
            const LAS float* R = cur + (s < 15 ? s + 1 : 15) * 384;
            const f4 nr4 = *(const LAS f4*)(R + 4 * kg), nw4 = *(const LAS f4*)(R + 64 + 4 * kg), nk4 = *(const LAS f4*)(R + 128 + 4 * kg),
                     nkk4 = *(const LAS f4*)(R + 256 + 4 * kg), nka4 = *(const LAS f4*)(R + 320 + 4 * kg);
            const float nv = R[192 + row];
            float sa = (S0 * kk4.x + S1 * kk4.y) + (S2 * kk4.z + S3 * kk4.w);
            sa = row16_sum(sa);
            S0 = S0 * w4.x + (v * k4.x - sa * ka4.x); S1 = S1 * w4.y + (v * k4.y - sa * ka4.y);
            S2 = S2 * w4.z + (v * k4.z - sa * ka4.z); S3 = S3 * w4.w + (v * k4.w - sa * ka4.w);
            float y = (S0 * r4.x + S1 * r4.y) + (S2 * r4.z + S3 * r4.w);
            y = row16_sum(y);
            if (kg == 0) yb[s * 32 + rowl] = y;
            r4 = nr4; w4 = nw4; k4 = nk4; kk4 = nkk4; ka4 = nka4; v = nv;
        }
        if (c + 1 < SEQ / 16) { LAS float* nb = buf + ((c + 1) & 1) * 6144;
            *(LAS f4*)(nb + 4 * tid) = st0; *(LAS f4*)(nb + 4 * (512 + tid)) = st1; *(LAS f4*)(nb + 4 * (1024 + tid)) = st2; }
        __syncthreads();
        { const int s = tid >> 5, rl = tid & 31; Y[((size_t)b * SEQ + c * 16 + s) * WB + h * 64 + half * 32 + rl] = yb[tid]; }
    }
    f4 so; so.x = S0; so.y = S1; so.z = S2; so.w = S3;
    *(f4*)(a->out + O_RP + ((((size_t)L * NBAT + b) * 12 + h) * 64 + row) * 64 + 4 * kg) = so;
    __syncthreads();
}
__device__ __forceinline__ void rwkv_sample_item(ArgsP a, int L, int item, LAS unsigned char* lds, int lane, int wave) {
    unsigned char* ws = a->ws;
    const int ih = item * 8 + wave, i = ih / 12, h = ih - i * 12;
    const float* rec = (const float*)(ws + WS_RPS) + (size_t)ih * 384;
    LAS float* sc = (LAS float*)(lds + wave * 2048);
    const float r = rec[lane], w = rec[64 + lane], k = rec[128 + lane], v = rec[192 + lane], kk = rec[256 + lane], ka = rec[320 + lane];
    sc[lane] = r; sc[64 + lane] = w; sc[128 + lane] = k; sc[192 + lane] = kk; sc[256 + lane] = ka;
    LDS_WAIT(); asm volatile("" ::: "memory");
    const f4* S0p = (const f4*)(a->in[I_SRWKV] + (((size_t)L * NS + i) * 12 + h) * 4096 + lane * 64);
    f4 S[16];
#pragma unroll
    for (int j = 0; j < 16; ++j) S[j] = S0p[j];
    float sa = 0.f;
#pragma unroll
    for (int j = 0; j < 16; ++j) { const f4 q = *(const LAS f4*)(sc + 192 + 4 * j); sa += (S[j].x * q.x + S[j].y * q.y) + (S[j].z * q.z + S[j].w * q.w); }
    float y = 0.f;
    f4* So = (f4*)(a->out + O_RS + (((size_t)L * NS + i) * 12 + h) * 4096 + lane * 64);
#pragma unroll
    for (int j = 0; j < 16; ++j) { const f4 w4 = *(const LAS f4*)(sc + 64 + 4 * j), k4 = *(const LAS f4*)(sc + 128 + 4 * j), a4 = *(const LAS f4*)(sc + 256 + 4 * j), r4 = *(const LAS f4*)(sc + 4 * j);
        f4 n = S[j] * w4 + (k4 * v - a4 * sa); So[j] = n; y += (n.x * r4.x + n.y * r4.y) + (n.z * r4.z + n.w * r4.w); }
    ((float*)(ws + WS_Y))[(size_t)(MP + i) * WB + h * 64 + lane] = y;
    LDS_WAIT(); asm volatile("" ::: "memory");
}
__device__ __forceinline__ void hgrn_sample_item(ArgsP a, int L, int item, LAS unsigned char* lds, int lane, int wave) {
    unsigned char* ws = a->ws;
    const int ih = item * 4 + (wave >> 1), i = ih / 6, h = ih - i * 6, vcol = (wave & 1) * 64 + lane, m = MP + i;
    const float* zc = (const float*)(ws + WS_Z) + (size_t)m * PIN + OFF_C + h * 128;
    LAS float* sc = (LAS float*)(lds + wave * 2048);
#pragma unroll
    for (int t = 0; t < 2; ++t) { const int k = lane + 64 * t; const float lb = lbound(a->in[I_CLB], L, h * 128 + k); const float fz = zc[WC + k];
        const float sg = sigmoidf_(fz); sc[k] = lb + (1.0f - lb) * sg; sc[128 + k] = (1.0f - lb) * (1.0f - sg) ; sc[256 + k] = zc[k]; }
    const float iv = zc[2 * WC + vcol];
    LDS_WAIT(); asm volatile("" ::: "memory");
    const float* S0 = a->in[I_SHGRN] + (((size_t)L * NS + i) * 6 + h) * 16384 + vcol;
    float* So = a->out + O_HS + (((size_t)L * NS + i) * 6 + h) * 16384 + vcol;
    float o = 0.f;
#pragma unroll 8
    for (int k = 0; k < 128; ++k) { const float n = sc[k] * S0[(size_t)k * 128] + sc[128 + k] * iv; So[(size_t)k * 128] = n; o += n * sc[256 + k]; }
    ((float*)(ws + WS_O))[(size_t)m * WC + h * 128 + vcol] = o;
    LDS_WAIT(); asm volatile("" ::: "memory");
}
__device__ __forceinline__ void sgu_item(ArgsP a, int L, int item, LAS unsigned char* lds, int tid, int lane, int wave) {
    unsigned char* ws = a->ws;
    const int g = item & 3, bc = item >> 2, m0 = bc * 128;
    const float* Z = (const float*)(ws + WS_Z);
    LAS float* vn = (LAS float*)lds;
    LAS float* wt = (LAS float*)(lds + 65536);
    const float* wsrc = a->in[I_AWS] + (size_t)(L * 4 + g) * 16384;
    __syncthreads();
    for (int e = tid; e < 16384; e += NTHR) { const int t = e >> 7, s = e & 127; wt[s * 128 + t] = (s <= t) ? wsrc[e] : 0.f; }
    const float* lng = a->in[I_ALNG] + L * WA + g * 128; const float* lnb = a->in[I_ALNB] + L * WA + g * 128;
    for (int rr = 0; rr < 16; ++rr) { const int t = wave * 16 + rr; const float* zr = Z + (size_t)(m0 + t) * PIN + WA + g * 128;
        const float v0 = gelu_erf(zr[lane]), v1 = gelu_erf(zr[64 + lane]);
        const float mean = wave_sum(v0 + v1) * (1.f / 128.f); const float d0 = v0 - mean, d1 = v1 - mean;
        const float rstd = 1.0f / sqrtf(wave_sum(d0 * d0 + d1 * d1) * (1.f / 128.f) + LN_EPS);
        vn[t * 128 + lane] = d0 * rstd * lng[lane] + lnb[lane]; vn[t * 128 + 64 + lane] = d1 * rstd * lng[64 + lane] + lnb[64 + lane]; }
    __syncthreads();
    const int t = tid >> 2, dq = tid & 3, send = (wave * 16 + 15);
    f4 acc[8];
#pragma unroll
    for (int j = 0; j < 8; ++j) acc[j] = (f4){0.f, 0.f, 0.f, 0.f};
    for (int s = 0; s <= send; ++s) { const float w = wt[s * 128 + t]; const LAS f4* vr = (const LAS f4*)(vn + s * 128 + dq * 32);
#pragma unroll
        for (int j = 0; j < 8; ++j) acc[j] += vr[j] * w; }
    const float bs = a->in[I_ABS][(L * 4 + g) * 128 + t];
    const float* ur = Z + (size_t)(m0 + t) * PIN + g * 128 + dq * 32;
    bf16* yo = (bf16*)(ws + WS_YMIX) + (size_t)(m0 + t) * DM + g * 128 + dq * 32;
#pragma unroll
    for (int j = 0; j < 4; ++j) { const f4 u0 = *(const f4*)(ur + 8 * j), u1 = *(const f4*)(ur + 8 * j + 4); const f4 x0 = acc[2 * j] + bs, x1 = acc[2 * j + 1] + bs; v4u o;
        o.x = pg8::cvt_pk_bf16(gelu_erf(u0.x) * x0.x, gelu_erf(u0.y) * x0.y); o.y = pg8::cvt_pk_bf16(gelu_erf(u0.z) * x0.z, gelu_erf(u0.w) * x0.w);
        o.z = pg8::cvt_pk_bf16(gelu_erf(u1.x) * x1.x, gelu_erf(u1.y) * x1.y); o.w = pg8::cvt_pk_bf16(gelu_erf(u1.z) * x1.z, gelu_erf(u1.w) * x1.w);
        *(v4u*)(yo + 8 * j) = o; }
}

__device__ __forceinline__ void hgrn_seq_unit(ArgsP a, int L, int unit, LAS unsigned char* lds, int tid, int lane, int wave) {
    unsigned char* ws = a->ws;
    const int b = unit / 6, h = unit - b * 6;
    const float* Z = (const float*)(ws + WS_Z);
    LAS bf16* qs = (LAS bf16*)(lds);
    LAS bf16* ks = (LAS bf16*)(lds + 4352);
    LAS bf16* vt = (LAS bf16*)(lds + 8704);
    LAS bf16* kht = (LAS bf16*)(lds + 12800);
    LAS float* ev = (LAS float*)(lds + 16896);
    LAS float* part = (LAS float*)(lds + 17408);
    const int ch = tid & 127, tq = tid >> 7;
    const float lb = lbound(a->in[I_CLB], L, h * 128 + ch), oml = 1.0f - lb;
    const int pch = (ch & ~31) | (((ch >> 2) & 3) << 3) | (((ch >> 4) & 1) << 2) | (ch & 3);
    const int x = lane & 15, quad = lane >> 4;
    pg8::f32x4 Sacc[8];
#pragma unroll
    for (int mt = 0; mt < 8; ++mt) Sacc[mt] = (pg8::f32x4){0.f, 0.f, 0.f, 0.f};
    const float* zb = Z + (size_t)(b * SEQ + 4 * tq) * PIN + OFF_C + h * 128 + ch;
    float qn[4], fn[4], vn_[4];
#pragma unroll
    for (int j = 0; j < 4; ++j) { const float* p = zb + (size_t)j * PIN; qn[j] = p[0]; fn[j] = p[WC]; vn_[j] = p[2 * WC]; }
    float* O = (float*)(ws + WS_O);
    __syncthreads();
    for (int st = 0; st < SEQ / 16; ++st) {
        float q[4], fz[4], iv[4];
#pragma unroll
        for (int j = 0; j < 4; ++j) { q[j] = qn[j]; fz[j] = fn[j]; iv[j] = vn_[j]; }
        if (st + 1 < SEQ / 16) {
#pragma unroll
            for (int j = 0; j < 4; ++j) { const float* p = zb + (size_t)((st + 1) * 16 + j) * PIN; qn[j] = p[0]; fn[j] = p[WC]; vn_[j] = p[2 * WC]; } }
        float bl[4], kv[4]; float run = 0.f;
#pragma unroll
        for (int j = 0; j < 4; ++j) { const float e = __expf(-fmaxf(fz[j], -80.f)), sg = __builtin_amdgcn_rcpf(1.0f + e);
            run += __logf(lb + oml * sg); bl[j] = run; kv[j] = oml * e * sg; }
        part[tq * 128 + ch] = run;
        asm volatile("s_waitcnt lgkmcnt(0)" ::: "memory"); __builtin_amdgcn_s_barrier(); asm volatile("" ::: "memory");
        const float p0 = part[ch], p1 = part[128 + ch], p2 = part[256 + ch], p3 = part[384 + ch];
        const float tot = (p0 + p1) + (p2 + p3); const float pre = (tq > 0 ? p0 : 0.f) + (tq > 1 ? p1 : 0.f) + (tq > 2 ? p2 : 0.f);
        float kh[4];
#pragma unroll
        for (int j = 0; j < 4; ++j) { const float bj = pre + bl[j]; const int t = 4 * tq + j;
            qs[t * 136 + pch] = bf1(q[j] * __expf(bj)); ks[t * 136 + pch] = bf1(kv[j] * __expf(fminf(-bj, 60.f))); kh[j] = kv[j] * __expf(tot - bj); }
        { u2 w; w.x = cvt_pk_bf16_c(kh[0], kh[1]); w.y = cvt_pk_bf16_c(kh[2], kh[3]); *(LAS u2*)(kht + ch * 16 + 4 * tq) = w;
          w.x = cvt_pk_bf16_c(iv[0], iv[1]); w.y = cvt_pk_bf16_c(iv[2], iv[3]); *(LAS u2*)(vt + ch * 16 + 4 * tq) = w; }
        if (tq == 0) ev[ch] = __expf(tot);
        asm volatile("s_waitcnt lgkmcnt(0)" ::: "memory"); __builtin_amdgcn_s_barrier(); asm volatile("" ::: "memory");
        bf16x8 qf[4], kf[4];
#pragma unroll
        for (int kt = 0; kt < 4; ++kt) { qf[kt] = *(const LAS bf16x8*)(qs + x * 136 + 32 * kt + 8 * quad); kf[kt] = *(const LAS bf16x8*)(ks + x * 136 + 32 * kt + 8 * quad); }
        pg8::f32x4 att = (pg8::f32x4){0.f, 0.f, 0.f, 0.f};
#pragma unroll
        for (int kt = 0; kt < 4; ++kt) att = __builtin_amdgcn_mfma_f32_16x16x32_bf16(kf[kt], qf[kt], att, 0, 0, 0);
#pragma unroll
        for (int i = 0; i < 4; ++i) if (4 * quad + i > x) att[i] = 0.f;
        v4u pbu; pbu.x = cvt_pk_bf16_c(att[0], att[1]); pbu.y = cvt_pk_bf16_c(att[2], att[3]); pbu.z = 0u; pbu.w = 0u;
        const bf16x8 pb = __builtin_bit_cast(bf16x8, pbu);
        const u2 vv = *(const LAS u2*)(vt + (16 * wave + x) * 16 + 4 * quad);
        v4u vfu; vfu.x = vv.x; vfu.y = vv.y; vfu.z = 0u; vfu.w = 0u; const bf16x8 vf = __builtin_bit_cast(bf16x8, vfu);
        pg8::f32x4 o = (pg8::f32x4){0.f, 0.f, 0.f, 0.f};
#pragma unroll
        for (int kt = 0; kt < 4; ++kt) { v4u su; su.x = cvt_pk_bf16_c(Sacc[2 * kt][0], Sacc[2 * kt][1]); su.y = cvt_pk_bf16_c(Sacc[2 * kt][2], Sacc[2 * kt][3]);
            su.z = cvt_pk_bf16_c(Sacc[2 * kt + 1][0], Sacc[2 * kt + 1][1]); su.w = cvt_pk_bf16_c(Sacc[2 * kt + 1][2], Sacc[2 * kt + 1][3]);
            o = __builtin_amdgcn_mfma_f32_16x16x32_bf16(__builtin_bit_cast(bf16x8, su), qf[kt], o, 0, 0, 0); }
        o = __builtin_amdgcn_mfma_f32_16x16x32_bf16(vf, pb, o, 0, 0, 0);
        *(pg8::f32x4*)(O + (size_t)(b * SEQ + st * 16 + x) * WC + h * 128 + 16 * wave + 4 * quad) = o;
#pragma unroll
        for (int mt = 0; mt < 8; ++mt) { const pg8::f32x4 e4 = *(const LAS pg8::f32x4*)(ev + 16 * mt + 4 * quad);
            const u2 kk2 = *(const LAS u2*)(kht + (16 * mt + x) * 16 + 4 * quad); v4u ku; ku.x = kk2.x; ku.y = kk2.y; ku.z = 0u; ku.w = 0u;
            Sacc[mt] = __builtin_amdgcn_mfma_f32_16x16x32_bf16(__builtin_bit_cast(bf16x8, ku), vf, Sacc[mt] * e4, 0, 0, 0); }
    }
    float* So = a->out + O_HP + (((size_t)L * NBAT + b) * 6 + h) * 16384;
#pragma unroll
    for (int mt = 0; mt < 8; ++mt)
#pragma unroll
        for (int i = 0; i < 4; ++i) So[(size_t)(16 * mt + 4 * quad + i) * 128 + 16 * wave + x] = Sacc[mt][i];
    __syncthreads();
}

__device__ __forceinline__ void phase_post(ArgsP a, int L, int lane, int wave, int blk, int G) {
    unsigned char* ws = a->ws; const int gw = blk * NWAVES + wave, NGW = G * NWAVES;
    const float* Y = (const float*)(ws + WS_Y); const float* O = (const float*)(ws + WS_O); const float* Gt = (const float*)(ws + WS_LORA) + 2 * WB; const float* Z = (const float*)(ws + WS_Z);
    const float* gng = a->in[I_BGNG] + L * WB; const float* gnb = a->in[I_BGNB] + L * WB; const float* rk = a->in[I_BRK] + L * WB; const float* cng = a->in[I_CNG] + L * WC;
    for (int m = gw; m < MV; m += NGW) {
        bf16* yo = (bf16*)(ws + WS_YMIX) + (size_t)m * DM;
        float ov[12], gz[12]; float ss = 0.f;
#pragma unroll
        for (int j = 0; j < 12; ++j) { const int c = 64 * j + lane; ov[j] = O[(size_t)m * WC + c]; gz[j] = Z[(size_t)m * PIN + OFF_C + 3 * WC + c]; ss += ov[j] * ov[j]; }
        if (m >= MP) {
            { const float* hr = (const float*)(ws + WS_H) + (size_t)m * DM; float* tr = (float*)(ws + WS_T) + (size_t)m * DM;
#pragma unroll
              for (int j = 0; j < 8; ++j) *(f4*)(tr + 4 * (lane + 64 * j)) = *(const f4*)(hr + 4 * (lane + 64 * j)) * DN_ALPHA; }
#pragma unroll
            for (int j = 0; j < 12; ++j) { const int c = 64 * j + lane; const float* rec = (const float*)(ws + WS_RPS) + ((size_t)(m - MP) * 12 + j) * 384;
                const float y = Y[(size_t)m * WB + c], rr = rec[lane], kp = rec[128 + lane], vv = rec[192 + lane], gg = Gt[(size_t)m * NLORA + c];
                const float mean = wave_sum(y) * (1.f / 64.f); const float d = y - mean; const float rstd = 1.0f / sqrtf(wave_sum(d * d) * (1.f / 64.f) + GN_EPS);
                const float bonus = wave_sum(rr * kp * rk[c]);
                yo[WA + c] = bf1((d * rstd * gng[c] + gnb[c] + bonus * vv) * gg); } }
        const float rms = 1.0f / sqrtf(wave_sum(ss) * (1.f / WC) + RMS_EPS);
#pragma unroll
        for (int j = 0; j < 12; ++j) { const int c = 64 * j + lane; yo[WA + WB + c] = bf1(ov[j] * rms * cng[c] * (gz[j] * sigmoidf_(gz[j]))); }
    }
}

constexpr int REC_BYTES = 16384, RC_GT = 12288, RC_WT = 0, RC_RT = 2048, RC_AHT = 4096, RC_KHT = 6144, RC_VT = 8192, RC_BRA = 10240, RC_BRK = 10752, RC_M2 = 11264, RC_G15 = 11776, RC_BC = 12032;
constexpr int NCHUNK = NBAT * 12 * (SEQ / 16);
static_assert(WS_RPB + (size_t)NCHUNK * REC_BYTES == WS_RPS, "chunk record region");
__device__ __forceinline__ float readlane_f(float x, int l) { return __builtin_bit_cast(float, __builtin_amdgcn_readlane(__builtin_bit_cast(int, x), l)); }
__device__ __forceinline__ float wave_sum_fast(float x) { x = row16_sum(x); return (readlane_f(x, 0) + readlane_f(x, 16)) + (readlane_f(x, 32) + readlane_f(x, 48)); }
__device__ __forceinline__ int perm_ch(int ch) { return (ch & ~31) | (((ch >> 2) & 3) << 3) | (((ch >> 4) & 1) << 2) | (ch & 3); }

__device__ __forceinline__ void pre_chunk(ArgsP a, int L, int q, LAS unsigned char* wl, int lane) {
    unsigned char* ws = a->ws;
    const int bh = q >> 7, c = q & 127, b = bh / 12, h = bh - 12 * b, m0 = b * SEQ + c * 16, col = h * 64 + lane;
    const float* Z = (const float*)(ws + WS_Z) + (size_t)m0 * PIN + OFF_B + col; const float* LO = (const float*)(ws + WS_LORA) + (size_t)m0 * NLORA + col;
    unsigned char* rec = ws + WS_RPB + (size_t)q * REC_BYTES;
    LAS float* X0 = (LAS float*)wl;
    LAS float* X1 = (LAS float*)(wl + 4352);
    LAS float* Maa = (LAS float*)(wl + 8704);
    LAS float* Mak = (LAS float*)(wl + 9728);
    LAS bf16* Sm = (LAS bf16*)(wl + 10752);
    LAS bf16* Wim = (LAS bf16*)(wl + 12288);
    const float mur = a->in[I_BMU][L * PBW + col], muk = a->in[I_BMU][L * PBW + WB + col], muv = a->in[I_BMU][L * PBW + 2 * WB + col];
    const float w0c = a->in[I_BW0][L * WB + col], a0c = a->in[I_BA0][L * WB + col], kkc = a->in[I_BKK][L * WB + col], kac = a->in[I_BKA][L * WB + col], rkc = a->in[I_BRK][L * WB + col];
    float cr[16], ck[16], cv[16], lw[16], la[16];
#pragma unroll
    for (int t = 0; t < 16; ++t) { cr[t] = Z[(size_t)t * PIN]; ck[t] = Z[(size_t)t * PIN + WB]; cv[t] = Z[(size_t)t * PIN + 2 * WB]; lw[t] = LO[(size_t)t * NLORA]; la[t] = LO[(size_t)t * NLORA + WB];
        ((bf16*)(rec + RC_GT))[t * 64 + lane] = bf1(LO[(size_t)t * NLORA + 2 * WB]); }
    float pr = 0.f, pk = 0.f, pv = 0.f; if (c) { pr = Z[-(ptrdiff_t)PIN]; pk = Z[-(ptrdiff_t)PIN + WB]; pv = Z[-(ptrdiff_t)PIN + 2 * WB]; }
    float r_[16], k_[16], v_[16], kp_[16], al_[16], g_[16]; float run = 0.f, bcv = 0.f;
#pragma unroll
    for (int t = 0; t < 16; ++t) {
        const float r = cr[t] + mur * (pr - cr[t]), k = ck[t] + muk * (pk - ck[t]), v = cv[t] + muv * (pv - cv[t]); pr = cr[t]; pk = ck[t]; pv = cv[t];
        run += -0.6065306597126334f * __builtin_amdgcn_rcpf(1.0f + __expf(-(w0c + lw[t]))); g_[t] = run;
        const float av = __builtin_amdgcn_rcpf(1.0f + __expf(-(a0c + la[t])));
        const float kkr = k * kkc; const float ss = wave_sum_fast(kkr * kkr); const float kap = kkr / fmaxf(sqrtf(ss), 1e-12f);
        const float kpr = k * (1.0f + (av - 1.0f) * kac);
        const float bc = wave_sum_fast(r * kpr * rkc); if (lane == t) bcv = bc;
        r_[t] = r; k_[t] = kpr; v_[t] = v; kp_[t] = kap; al_[t] = kap * av; }
    const float gl = g_[15];
    { float ah[16], kh[16];
#pragma unroll
      for (int t = 0; t < 16; ++t) { const float ig = __expf(-g_[t]), eg = __expf(gl - g_[t]); X0[t * 68 + lane] = al_[t] * ig; X1[t * 68 + lane] = k_[t] * ig; ah[t] = al_[t] * eg; kh[t] = k_[t] * eg; }
      v4u o0, o1;
      o0.x = cvt_pk_bf16_c(ah[0], ah[1]); o0.y = cvt_pk_bf16_c(ah[2], ah[3]); o0.z = cvt_pk_bf16_c(ah[4], ah[5]); o0.w = cvt_pk_bf16_c(ah[6], ah[7]);
      o1.x = cvt_pk_bf16_c(ah[8], ah[9]); o1.y = cvt_pk_bf16_c(ah[10], ah[11]); o1.z = cvt_pk_bf16_c(ah[12], ah[13]); o1.w = cvt_pk_bf16_c(ah[14], ah[15]);
      *(v4u*)(rec + RC_AHT + lane * 32) = o0; *(v4u*)(rec + RC_AHT + lane * 32 + 16) = o1;
      o0.x = cvt_pk_bf16_c(kh[0], kh[1]); o0.y = cvt_pk_bf16_c(kh[2], kh[3]); o0.z = cvt_pk_bf16_c(kh[4], kh[5]); o0.w = cvt_pk_bf16_c(kh[6], kh[7]);
      o1.x = cvt_pk_bf16_c(kh[8], kh[9]); o1.y = cvt_pk_bf16_c(kh[10], kh[11]); o1.z = cvt_pk_bf16_c(kh[12], kh[13]); o1.w = cvt_pk_bf16_c(kh[14], kh[15]);
      *(v4u*)(rec + RC_KHT + lane * 32) = o0; *(v4u*)(rec + RC_KHT + lane * 32 + 16) = o1;
      o0.x = cvt_pk_bf16_c(v_[0], v_[1]); o0.y = cvt_pk_bf16_c(v_[2], v_[3]); o0.z = cvt_pk_bf16_c(v_[4], v_[5]); o0.w = cvt_pk_bf16_c(v_[6], v_[7]);
      o1.x = cvt_pk_bf16_c(v_[8], v_[9]); o1.y = cvt_pk_bf16_c(v_[10], v_[11]); o1.z = cvt_pk_bf16_c(v_[12], v_[13]); o1.w = cvt_pk_bf16_c(v_[14], v_[15]);
      *(v4u*)(rec + RC_VT + lane * 32) = o0; *(v4u*)(rec + RC_VT + lane * 32 + 16) = o1; }
    LDS_WAIT(); asm volatile("" ::: "memory");
    const int x = lane & 15, kq = lane >> 4;
    f4 ba[4], bk[4];
#pragma unroll
    for (int j = 0; j < 4; ++j) { ba[j] = *(const LAS f4*)(X0 + x * 68 + 16 * kq + 4 * j); bk[j] = *(const LAS f4*)(X1 + x * 68 + 16 * kq + 4 * j); }
    LDS_WAIT(); asm volatile("" ::: "memory");
    float kt[16];
#pragma unroll
    for (int t = 0; t < 16; ++t) { kt[t] = kp_[t] * (t ? __expf(g_[t - 1]) : 1.0f); X0[t * 68 + lane] = kt[t]; X1[t * 68 + lane] = r_[t] * __expf(g_[t]); }
    LDS_WAIT(); asm volatile("" ::: "memory");
    f4 ak[4], ar[4];
#pragma unroll
    for (int j = 0; j < 4; ++j) { ak[j] = *(const LAS f4*)(X0 + x * 68 + 16 * kq + 4 * j); ar[j] = *(const LAS f4*)(X1 + x * 68 + 16 * kq + 4 * j); }
    pg8::f32x4 Gaa = (pg8::f32x4){0.f, 0.f, 0.f, 0.f}, Gak = Gaa, Gra = Gaa, Grk = Gaa;
#pragma unroll
    for (int j = 0; j < 4; ++j)
#pragma unroll
        for (int e = 0; e < 4; ++e) { Gaa = __builtin_amdgcn_mfma_f32_16x16x4f32(ak[j][e], ba[j][e], Gaa, 0, 0, 0); Gak = __builtin_amdgcn_mfma_f32_16x16x4f32(ak[j][e], bk[j][e], Gak, 0, 0, 0);
            Gra = __builtin_amdgcn_mfma_f32_16x16x4f32(ar[j][e], ba[j][e], Gra, 0, 0, 0); Grk = __builtin_amdgcn_mfma_f32_16x16x4f32(ar[j][e], bk[j][e], Grk, 0, 0, 0); }
#pragma unroll
    for (int i = 0; i < 4; ++i) { const int t = 4 * kq + i; const bool sl = x < t, le = x <= t;
        Maa[t * 16 + x] = sl ? Gaa[i] : 0.f; Mak[t * 16 + x] = sl ? Gak[i] : 0.f;
        Sm[t * 16 + x] = bf1(le ? Gra[i] : 0.f); Sm[256 + t * 16 + x] = bf1(le ? Grk[i] : 0.f); }
    LDS_WAIT(); asm volatile("" ::: "memory");
    float xm[16];
#pragma unroll
    for (int t = 0; t < 16; ++t) xm[t] = Mak[t * 16 + x];
#pragma unroll
    for (int t = 1; t < 16; ++t) {
#pragma unroll
        for (int s4 = 0; s4 < (t + 3) / 4; ++s4) { const f4 ar4 = *(const LAS f4*)(Maa + t * 16 + 4 * s4);
#pragma unroll
            for (int e = 0; e < 4; ++e) if (4 * s4 + e < t) { kt[t] -= ar4[e] * kt[4 * s4 + e]; xm[t] -= ar4[e] * xm[4 * s4 + e]; } } }
#pragma unroll
    for (int t = 0; t < 16; ++t) { Wim[t * 64 + perm_ch(lane)] = bf1(-kt[t]); if (lane < 16) Sm[512 + t * 16 + lane] = bf1(-xm[t]); }
    LDS_WAIT(); asm volatile("" ::: "memory");
    *(v4u*)(rec + RC_WT + lane * 16) = *(const LAS v4u*)((LAS unsigned char*)Wim + lane * 16); *(v4u*)(rec + RC_WT + 1024 + lane * 16) = *(const LAS v4u*)((LAS unsigned char*)Wim + 1024 + lane * 16);
    *(v4u*)(rec + RC_BRA + lane * 16) = *(const LAS v4u*)((LAS unsigned char*)Sm + lane * 16); if (lane < 32) *(v4u*)(rec + RC_BRA + 1024 + lane * 16) = *(const LAS v4u*)((LAS unsigned char*)Sm + 1024 + lane * 16);
    LDS_WAIT(); asm volatile("" ::: "memory");
#pragma unroll
    for (int t = 0; t < 16; ++t) Wim[t * 64 + perm_ch(lane)] = bf1(r_[t] * __expf(g_[t]));
    LDS_WAIT(); asm volatile("" ::: "memory");
    *(v4u*)(rec + RC_RT + lane * 16) = *(const LAS v4u*)((LAS unsigned char*)Wim + lane * 16); *(v4u*)(rec + RC_RT + 1024 + lane * 16) = *(const LAS v4u*)((LAS unsigned char*)Wim + 1024 + lane * 16);
    *(float*)(rec + RC_G15 + lane * 4) = __expf(gl); if (lane < 16) *(float*)(rec + RC_BC + lane * 4) = bcv;
    LDS_WAIT(); asm volatile("" ::: "memory");
}

constexpr int HREC_BYTES = 17408, HR_QS = 0, HR_KS = 4352, HR_VT = 8704, HR_KHT = 12800, HR_EV = 16896, NHCHUNK = NBAT * 6 * (SEQ / 16);
__device__ __forceinline__ void hpre_chunk(ArgsP a, int L, int q2, LAS unsigned char* wl, int lane) {
    unsigned char* ws = a->ws;
    const int bh = q2 >> 7, c = q2 & 127, b = bh / 6, h = bh - 6 * b;
    const float* Z = (const float*)(ws + WS_Z) + (size_t)(b * SEQ + c * 16) * PIN + OFF_C + h * 128 + lane;
    unsigned char* rec = ws + WS_HREC + (size_t)q2 * HREC_BYTES;
    LAS bf16* qim = (LAS bf16*)wl; LAS bf16* kim = (LAS bf16*)(wl + 4352);
#pragma unroll
    for (int hh = 0; hh < 2; ++hh) { const int ch = lane + 64 * hh; const int pc = perm_ch(ch);
        const float lb = lbound(a->in[I_CLB], L, h * 128 + ch), oml = 1.0f - lb;
        float q[16], fz[16], iv[16];
#pragma unroll
        for (int t = 0; t < 16; ++t) { const float* p = Z + (size_t)t * PIN + 64 * hh; q[t] = p[0]; fz[t] = p[WC]; iv[t] = p[2 * WC]; }
        float bl[16], kv[16]; float run = 0.f;
#pragma unroll
        for (int t = 0; t < 16; ++t) { const float e = __expf(-fmaxf(fz[t], -80.f)), sg = __builtin_amdgcn_rcpf(1.0f + e); run += __logf(lb + oml * sg); bl[t] = run; kv[t] = oml * e * sg; }
        float kh[16];
#pragma unroll
        for (int t = 0; t < 16; ++t) { qim[t * 136 + pc] = bf1(q[t] * __expf(bl[t])); kim[t * 136 + pc] = bf1(kv[t] * __expf(fminf(-bl[t], 60.f))); kh[t] = kv[t] * __expf(run - bl[t]); }
        v4u o0, o1;
        o0.x = cvt_pk_bf16_c(kh[0], kh[1]); o0.y = cvt_pk_bf16_c(kh[2], kh[3]); o0.z = cvt_pk_bf16_c(kh[4], kh[5]); o0.w = cvt_pk_bf16_c(kh[6], kh[7]);
        o1.x = cvt_pk_bf16_c(kh[8], kh[9]); o1.y = cvt_pk_bf16_c(kh[10], kh[11]); o1.z = cvt_pk_bf16_c(kh[12], kh[13]); o1.w = cvt_pk_bf16_c(kh[14], kh[15]);
        *(v4u*)(rec + HR_KHT + ch * 32) = o0; *(v4u*)(rec + HR_KHT + ch * 32 + 16) = o1;
        o0.x = cvt_pk_bf16_c(iv[0], iv[1]); o0.y = cvt_pk_bf16_c(iv[2], iv[3]); o0.z = cvt_pk_bf16_c(iv[4], iv[5]); o0.w = cvt_pk_bf16_c(iv[6], iv[7]);
        o1.x = cvt_pk_bf16_c(iv[8], iv[9]); o1.y = cvt_pk_bf16_c(iv[10], iv[11]); o1.z = cvt_pk_bf16_c(iv[12], iv[13]); o1.w = cvt_pk_bf16_c(iv[14], iv[15]);
        *(v4u*)(rec + HR_VT + ch * 32) = o0; *(v4u*)(rec + HR_VT + ch * 32 + 16) = o1;
        *(float*)(rec + HR_EV + ch * 4) = __expf(run); }
    LDS_WAIT(); asm volatile("" ::: "memory");
#pragma unroll
    for (int j = 0; j < 9; ++j) { const int o = (j * 64 + lane) * 16; if (o < 8704) *(v4u*)(rec + o) = *(const LAS v4u*)(wl + o); }
    LDS_WAIT(); asm volatile("" ::: "memory");
}
__device__ __forceinline__ void hgrn_stream_unit(ArgsP a, int L, int unit, LAS unsigned char* lds, int lane, int wave) {
    unsigned char* ws = a->ws;
    const int bh = unit >> 1, half = unit & 1, b = bh / 6, h = bh - b * 6;
    const unsigned char* recs = ws + WS_HREC + (size_t)bh * 128 * HREC_BYTES;
    const int x = lane & 15, quad = lane >> 4, vbase = 64 * half + 16 * (wave & 3);
    constexpr int AHEAD = 4, NCH = SEQ / 16;
#define HG_DMA(cc) do { const unsigned char* g_ = recs + (size_t)(cc) * HREC_BYTES + (wave - 4) * 1024 + lane * 16; LAS unsigned char* l_ = lds + ((cc) % 6) * HREC_BYTES + (wave - 4) * 1024; \
        _Pragma("unroll") for (int j_ = 0; j_ < 4; ++j_) __builtin_amdgcn_global_load_lds((const unsigned*)(g_ + 4096 * j_), (LAS unsigned*)(l_ + 4096 * j_), 16, 0, 0); \
        if (wave == 4) __builtin_amdgcn_global_load_lds((const unsigned*)(g_ + 16384), (LAS unsigned*)(l_ + 16384), 16, 0, 0); } while (0)
    asm volatile("s_waitcnt vmcnt(0) lgkmcnt(0)" ::: "memory"); __builtin_amdgcn_s_barrier(); asm volatile("" ::: "memory");
    pg8::f32x4 Sacc[8];
#pragma unroll
    for (int mt = 0; mt < 8; ++mt) Sacc[mt] = (pg8::f32x4){0.f, 0.f, 0.f, 0.f};
    if (wave >= 4) {
#pragma unroll
        for (int cc = 0; cc < AHEAD; ++cc) HG_DMA(cc);
        if (wave == 4) asm volatile("s_waitcnt vmcnt(15)" ::: "memory"); else asm volatile("s_waitcnt vmcnt(12)" ::: "memory");
    }
    __builtin_amdgcn_s_barrier(); asm volatile("" ::: "memory");
    float* O = (float*)(ws + WS_O) + (size_t)(b * SEQ) * WC + h * 128 + vbase + 4 * quad;
    for (int st = 0; st < NCH; ++st) {
        if (wave >= 4) {
            if (st + AHEAD < NCH) { HG_DMA(st + AHEAD); if (wave == 4) asm volatile("s_waitcnt vmcnt(15)" ::: "memory"); else asm volatile("s_waitcnt vmcnt(12)" ::: "memory"); }
            else asm volatile("s_waitcnt vmcnt(0)" ::: "memory");
        } else {
        const LAS unsigned char* S = lds + (st % 6) * HREC_BYTES;
        const LAS bf16* qs = (const LAS bf16*)(S + HR_QS); const LAS bf16* ks = (const LAS bf16*)(S + HR_KS); const LAS bf16* vt = (const LAS bf16*)(S + HR_VT);
        const LAS bf16* kht = (const LAS bf16*)(S + HR_KHT); const LAS float* ev = (const LAS float*)(S + HR_EV);
        bf16x8 qf[4], kf[4];
#pragma unroll
        for (int kt = 0; kt < 4; ++kt) { qf[kt] = *(const LAS bf16x8*)(qs + x * 136 + 32 * kt + 8 * quad); kf[kt] = *(const LAS bf16x8*)(ks + x * 136 + 32 * kt + 8 * quad); }
        pg8::f32x4 att = (pg8::f32x4){0.f, 0.f, 0.f, 0.f};
#pragma unroll
        for (int kt = 0; kt < 4; ++kt) att = __builtin_amdgcn_mfma_f32_16x16x32_bf16(kf[kt], qf[kt], att, 0, 0, 0);
#pragma unroll
        for (int i = 0; i < 4; ++i) if (4 * quad + i > x) att[i] = 0.f;
        v4u pbu; pbu.x = cvt_pk_bf16_c(att[0], att[1]); pbu.y = cvt_pk_bf16_c(att[2], att[3]); pbu.z = 0u; pbu.w = 0u;
        const bf16x8 pb = __builtin_bit_cast(bf16x8, pbu);
        const u2 vv = *(const LAS u2*)(vt + (vbase + x) * 16 + 4 * quad);
        v4u vfu; vfu.x = vv.x; vfu.y = vv.y; vfu.z = 0u; vfu.w = 0u; const bf16x8 vf = __builtin_bit_cast(bf16x8, vfu);
        pg8::f32x4 o = (pg8::f32x4){0.f, 0.f, 0.f, 0.f};
#pragma unroll
        for (int kt = 0; kt < 4; ++kt) { v4u su; su.x = cvt_pk_bf16_c(Sacc[2 * kt][0], Sacc[2 * kt][1]); su.y = cvt_pk_bf16_c(Sacc[2 * kt][2], Sacc[2 * kt][3]);
            su.z = cvt_pk_bf16_c(Sacc[2 * kt + 1][0], Sacc[2 * kt + 1][1]); su.w = cvt_pk_bf16_c(Sacc[2 * kt + 1][2], Sacc[2 * kt + 1][3]);
            o = __builtin_amdgcn_mfma_f32_16x16x32_bf16(__builtin_bit_cast(bf16x8, su), qf[kt], o, 0, 0, 0); }
        o = __builtin_amdgcn_mfma_f32_16x16x32_bf16(vf, pb, o, 0, 0, 0);
        *(pg8::f32x4*)(O + (size_t)(st * 16 + x) * WC) = o;
#pragma unroll
        for (int mt = 0; mt < 8; ++mt) { const pg8::f32x4 e4 = *(const LAS pg8::f32x4*)(ev + 16 * mt + 4 * quad);
            const u2 kk2 = *(const LAS u2*)(kht + (16 * mt + x) * 16 + 4 * quad); v4u ku; ku.x = kk2.x; ku.y = kk2.y; ku.z = 0u; ku.w = 0u;
            Sacc[mt] = __builtin_amdgcn_mfma_f32_16x16x32_bf16(__builtin_bit_cast(bf16x8, ku), vf, Sacc[mt] * e4, 0, 0, 0); }
        }
        asm volatile("s_waitcnt lgkmcnt(0)" ::: "memory"); __builtin_amdgcn_s_barrier(); asm volatile("" ::: "memory");
    }
#undef HG_DMA
    if (wave < 4) { float* So = a->out + O_HP + (((size_t)L * NBAT + b) * 6 + h) * 16384;
#pragma unroll
        for (int mt = 0; mt < 8; ++mt)
#pragma unroll
            for (int i = 0; i < 4; ++i) So[(size_t)(16 * mt + 4 * quad + i) * 128 + vbase + x] = Sacc[mt][i]; }
    asm volatile("s_waitcnt vmcnt(0) lgkmcnt(0)" ::: "memory"); __builtin_amdgcn_s_barrier(); asm volatile("" ::: "memory");
}
__device__ __forceinline__ void phase_pre(ArgsP a, int L, LAS unsigned char* lds, int lane, int wave, int blk, int G) {
    const int gw = blk * NWAVES + wave, NGW = G * NWAVES;
    for (int q = gw; q < NCHUNK; q += NGW) pre_chunk(a, L, q, lds + wave * 16384, lane);
    for (int q2 = gw; q2 < NHCHUNK; q2 += NGW) hpre_chunk(a, L, q2, lds + wave * 16384, lane);
}
__device__ __forceinline__ void rwkv_seq_unit(ArgsP a, int L, int unit, LAS unsigned char* lds, int lane, int wave) {
    unsigned char* ws = a->ws;
    const int b = unit / 12, h = unit - 12 * b;
    const unsigned char* recs = ws + WS_RPB + (size_t)unit * 128 * REC_BYTES;
    LAS float* ybuf = (LAS float*)(lds + 7 * REC_BYTES);
    const int x = lane & 15, quad = lane >> 4;
    constexpr int AHEAD = 5, NCH = SEQ / 16;
#define RW_DMA(cc) do { const unsigned char* g_ = recs + (size_t)(cc) * REC_BYTES + (wave - 4) * 4096 + lane * 16; LAS unsigned char* l_ = lds + ((cc) % 7) * REC_BYTES + (wave - 4) * 4096; \
        __builtin_amdgcn_global_load_lds((const unsigned*)(g_), (LAS unsigned*)(l_), 16, 0, 0); __builtin_amdgcn_global_load_lds((const unsigned*)(g_ + 1024), (LAS unsigned*)(l_ + 1024), 16, 0, 0); \
        __builtin_amdgcn_global_load_lds((const unsigned*)(g_ + 2048), (LAS unsigned*)(l_ + 2048), 16, 0, 0); __builtin_amdgcn_global_load_lds((const unsigned*)(g_ + 3072), (LAS unsigned*)(l_ + 3072), 16, 0, 0); } while (0)
    asm volatile("s_waitcnt vmcnt(0) lgkmcnt(0)" ::: "memory"); __builtin_amdgcn_s_barrier(); asm volatile("" ::: "memory");
    pg8::f32x4 Hacc[4];
#pragma unroll
    for (int nt = 0; nt < 4; ++nt) Hacc[nt] = (pg8::f32x4){0.f, 0.f, 0.f, 0.f};
    f4 gng4 = (f4){0.f, 0.f, 0.f, 0.f}, gnb4 = gng4;
    if (wave >= 4) {
        gng4 = *(const f4*)(a->in[I_BGNG] + L * WB + h * 64 + 4 * x); gnb4 = *(const f4*)(a->in[I_BGNB] + L * WB + h * 64 + 4 * x);
        asm volatile("s_waitcnt vmcnt(0)" ::: "memory");
#pragma unroll
        for (int cc = 0; cc < AHEAD; ++cc) RW_DMA(cc);
        asm volatile("s_waitcnt vmcnt(16)" ::: "memory");
    }
    __builtin_amdgcn_s_barrier(); asm volatile("" ::: "memory");
    bf16* ymix = (bf16*)(ws + WS_YMIX) + (size_t)(b * SEQ) * DM + WA + h * 64 + 4 * x;
    for (int c = 0; c <= NCH; ++c) {
        if (wave < 4) {
            if (c < NCH) {
                const LAS unsigned char* S = lds + (c % 7) * REC_BYTES;
                bf16x8 wf[2], rf[2], hb[2];
#pragma unroll
                for (int ks = 0; ks < 2; ++ks) { wf[ks] = *(const LAS bf16x8*)(S + RC_WT + x * 128 + 64 * ks + 16 * quad); rf[ks] = *(const LAS bf16x8*)(S + RC_RT + x * 128 + 64 * ks + 16 * quad);
                    v4u su; su.x = cvt_pk_bf16_c(Hacc[2 * ks][0], Hacc[2 * ks][1]); su.y = cvt_pk_bf16_c(Hacc[2 * ks][2], Hacc[2 * ks][3]);
                    su.z = cvt_pk_bf16_c(Hacc[2 * ks + 1][0], Hacc[2 * ks + 1][1]); su.w = cvt_pk_bf16_c(Hacc[2 * ks + 1][2], Hacc[2 * ks + 1][3]); hb[ks] = __builtin_bit_cast(bf16x8, su); }
                const u2 vv = *(const LAS u2*)(S + RC_VT + (16 * wave + x) * 32 + 8 * quad); v4u t4; t4.x = vv.x; t4.y = vv.y; t4.z = 0u; t4.w = 0u; const bf16x8 vf = __builtin_bit_cast(bf16x8, t4);
                const u2 m2v = *(const LAS u2*)(S + RC_M2 + x * 32 + 8 * quad); t4.x = m2v.x; t4.y = m2v.y; const bf16x8 m2f = __builtin_bit_cast(bf16x8, t4);
                const u2 brav = *(const LAS u2*)(S + RC_BRA + x * 32 + 8 * quad); t4.x = brav.x; t4.y = brav.y; const bf16x8 braf = __builtin_bit_cast(bf16x8, t4);
                const u2 brkv = *(const LAS u2*)(S + RC_BRK + x * 32 + 8 * quad); t4.x = brkv.x; t4.y = brkv.y; const bf16x8 brkf = __builtin_bit_cast(bf16x8, t4);
                pg8::f32x4 U = (pg8::f32x4){0.f, 0.f, 0.f, 0.f}, Y = U;
                U = __builtin_amdgcn_mfma_f32_16x16x32_bf16(wf[0], hb[0], U, 0, 0, 0); U = __builtin_amdgcn_mfma_f32_16x16x32_bf16(wf[1], hb[1], U, 0, 0, 0); U = __builtin_amdgcn_mfma_f32_16x16x32_bf16(m2f, vf, U, 0, 0, 0);
                Y = __builtin_amdgcn_mfma_f32_16x16x32_bf16(rf[0], hb[0], Y, 0, 0, 0); Y = __builtin_amdgcn_mfma_f32_16x16x32_bf16(rf[1], hb[1], Y, 0, 0, 0); Y = __builtin_amdgcn_mfma_f32_16x16x32_bf16(brkf, vf, Y, 0, 0, 0);
                t4.x = cvt_pk_bf16_c(U[0], U[1]); t4.y = cvt_pk_bf16_c(U[2], U[3]); const bf16x8 ub = __builtin_bit_cast(bf16x8, t4);
                Y = __builtin_amdgcn_mfma_f32_16x16x32_bf16(braf, ub, Y, 0, 0, 0);
#pragma unroll
                for (int nt = 0; nt < 4; ++nt) { const pg8::f32x4 g4 = *(const LAS pg8::f32x4*)(S + RC_G15 + (16 * nt + 4 * quad) * 4);
                    const u2 av = *(const LAS u2*)(S + RC_AHT + (16 * nt + x) * 32 + 8 * quad); t4.x = av.x; t4.y = av.y; const bf16x8 ahf = __builtin_bit_cast(bf16x8, t4);
                    const u2 kv = *(const LAS u2*)(S + RC_KHT + (16 * nt + x) * 32 + 8 * quad); t4.x = kv.x; t4.y = kv.y; const bf16x8 khf = __builtin_bit_cast(bf16x8, t4);
                    Hacc[nt] = __builtin_amdgcn_mfma_f32_16x16x32_bf16(ahf, ub, Hacc[nt] * g4, 0, 0, 0); Hacc[nt] = __builtin_amdgcn_mfma_f32_16x16x32_bf16(khf, vf, Hacc[nt], 0, 0, 0); }
                LAS float* yb = ybuf + (c & 1) * 1024;
#pragma unroll
                for (int i = 0; i < 4; ++i) yb[(4 * quad + i) * 64 + 16 * wave + x] = Y[i];
            }
        } else {
            if (c + AHEAD < NCH) RW_DMA(c + AHEAD);
            if (c > 0) {
                const int cp = c - 1, tt = 4 * (wave - 4) + quad; const LAS unsigned char* S = lds + (cp % 7) * REC_BYTES; const LAS float* yb = ybuf + (cp & 1) * 1024;
                const f4 y4 = *(const LAS f4*)(yb + tt * 64 + 4 * x); const u2 gq = *(const LAS u2*)(S + RC_GT + (tt * 64 + 4 * x) * 2);
                const float bcf = *(const LAS float*)(S + RC_BC + tt * 4);
                f4 g4, v4; g4.x = __builtin_bit_cast(float, gq.x << 16); g4.y = __builtin_bit_cast(float, gq.x & 0xffff0000u); g4.z = __builtin_bit_cast(float, gq.y << 16); g4.w = __builtin_bit_cast(float, gq.y & 0xffff0000u);
#pragma unroll
                for (int i = 0; i < 4; ++i) v4[i] = __builtin_bit_cast(float, (unsigned)(*(const LAS unsigned short*)(S + RC_VT + (4 * x + i) * 32 + tt * 2)) << 16);
                const float mean = row16_sum((y4.x + y4.y) + (y4.z + y4.w)) * (1.f / 64.f); const f4 d = y4 - mean;
                const float rstd = 1.0f / sqrtf(row16_sum((d.x * d.x + d.y * d.y) + (d.z * d.z + d.w * d.w)) * (1.f / 64.f) + GN_EPS);
                const f4 o = (d * rstd * gng4 + gnb4 + v4 * bcf) * g4;
                u2 w; w.x = cvt_pk_bf16_c(o.x, o.y); w.y = cvt_pk_bf16_c(o.z, o.w); *(u2*)(ymix + (size_t)(cp * 16 + tt) * DM) = w;
            }
            if (c + AHEAD < NCH) asm volatile("s_waitcnt vmcnt(16)" ::: "memory"); else asm volatile("s_waitcnt vmcnt(0)" ::: "memory");
        }
        asm volatile("s_waitcnt lgkmcnt(0)" ::: "memory"); __builtin_amdgcn_s_barrier(); asm volatile("" ::: "memory");
    }
    if (wave < 4) { float* So = a->out + O_RP + (((size_t)L * NBAT + b) * 12 + h) * 4096;
#pragma unroll
        for (int nt = 0; nt < 4; ++nt) *(pg8::f32x4*)(So + (size_t)(16 * wave + x) * 64 + 16 * nt + 4 * quad) = Hacc[nt]; }
#undef RW_DMA
    asm volatile("s_waitcnt vmcnt(0) lgkmcnt(0)" ::: "memory"); __builtin_amdgcn_s_barrier(); asm volatile("" ::: "memory");
}

__device__ __forceinline__ float gelu_fast(float v) {
    const float t = __builtin_amdgcn_rcpf(__builtin_fabsf(v) * 0.2316418882f + 1.0f);
    float q = t * 0.5307027145f + (-0.7265760135f); q = q * t + 0.7107068705f; q = q * t + (-0.142248368f); q = q * t + 0.127414796f; q = q * t;
    const float e = __builtin_amdgcn_exp2f((v * v) * (-0.72134752044f)); const float m = v * (q * e);
    return v < 0.f ? m : v - m;
}
__device__ __forceinline__ void sgu_item2(ArgsP a, int L, int item, LAS unsigned char* lds, int tid, int lane, int wave) {
    unsigned char* ws = a->ws;
    const int g = item & 3, bc = item >> 2, m0 = bc * 128;
    const float* Z = (const float*)(ws + WS_Z);
    LAS bf16* Wb = (LAS bf16*)lds;
    LAS bf16* VT = (LAS bf16*)(lds + 34816);
    const float* wsrc = a->in[I_AWS] + (size_t)(L * 4 + g) * 16384;
    __syncthreads();
#pragma unroll
    for (int j = 0; j < 8; ++j) { const int e4 = j * NTHR + tid, t = e4 >> 5, s0 = (e4 & 31) * 4; const f4 w = *(const f4*)(wsrc + t * 128 + s0);
        u2 o; o.x = cvt_pk_bf16_c(s0 <= t ? w.x : 0.f, s0 + 1 <= t ? w.y : 0.f); o.y = cvt_pk_bf16_c(s0 + 2 <= t ? w.z : 0.f, s0 + 3 <= t ? w.w : 0.f); *(LAS u2*)(Wb + t * 136 + s0) = o; }
    const float lg0 = a->in[I_ALNG][L * WA + g * 128 + lane], lg1 = a->in[I_ALNG][L * WA + g * 128 + 64 + lane], lb0 = a->in[I_ALNB][L * WA + g * 128 + lane], lb1 = a->in[I_ALNB][L * WA + g * 128 + 64 + lane];
    float zv0[16], zv1[16];
#pragma unroll
    for (int rr = 0; rr < 16; ++rr) { const float* zr = Z + (size_t)(m0 + wave * 16 + rr) * PIN + WA + g * 128; zv0[rr] = zr[lane]; zv1[rr] = zr[64 + lane]; }
#pragma unroll
    for (int rr = 0; rr < 16; ++rr) { const int t = wave * 16 + rr; const float v0 = gelu_fast(zv0[rr]), v1 = gelu_fast(zv1[rr]);
        const float mean = wave_sum_fast(v0 + v1) * (1.f / 128.f); const float d0 = v0 - mean, d1 = v1 - mean;
        const float rstd = 1.0f / sqrtf(wave_sum_fast(d0 * d0 + d1 * d1) * (1.f / 128.f) + LN_EPS);
        VT[lane * 136 + t] = bf1(d0 * rstd * lg0 + lb0); VT[(64 + lane) * 136 + t] = bf1(d1 * rstd * lg1 + lb1); }
    __syncthreads();
    const int x = lane & 15, quad = lane >> 4, nks = (wave >> 1) + 1;
    pg8::f32x4 acc[8];
#pragma unroll
    for (int dt = 0; dt < 8; ++dt) acc[dt] = (pg8::f32x4){0.f, 0.f, 0.f, 0.f};
    for (int ks = 0; ks < nks; ++ks) { const bf16x8 wf = *(const LAS bf16x8*)(Wb + (16 * wave + x) * 136 + 32 * ks + 8 * quad);
#pragma unroll
        for (int dt = 0; dt < 8; ++dt) { const bf16x8 vf = *(const LAS bf16x8*)(VT + (16 * dt + x) * 136 + 32 * ks + 8 * quad); acc[dt] = __builtin_amdgcn_mfma_f32_16x16x32_bf16(vf, wf, acc[dt], 0, 0, 0); } }
    const int t = 16 * wave + x; const float bs = a->in[I_ABS][(L * 4 + g) * 128 + t];
    const float* ur = Z + (size_t)(m0 + t) * PIN + g * 128 + 4 * quad; bf16* yo = (bf16*)(ws + WS_YMIX) + (size_t)(m0 + t) * DM + g * 128 + 4 * quad;
#pragma unroll
    for (int dt = 0; dt < 8; ++dt) { const f4 u = *(const f4*)(ur + 16 * dt); u2 o;
        o.x = cvt_pk_bf16_c(gelu_fast(u.x) * (acc[dt][0] + bs), gelu_fast(u.y) * (acc[dt][1] + bs)); o.y = cvt_pk_bf16_c(gelu_fast(u.z) * (acc[dt][2] + bs), gelu_fast(u.w) * (acc[dt][3] + bs));
        *(u2*)(yo + 16 * dt) = o; }
}
__device__ __forceinline__ void hgrn_sample_item2(ArgsP a, int L, int item, LAS unsigned char* lds, int lane, int wave) {
    unsigned char* ws = a->ws;
    const int ih = item * 8 + wave, i = ih / 6, h = ih - i * 6, m = MP + i, vq = lane & 31, kh = lane >> 5;
    const float* zc = (const float*)(ws + WS_Z) + (size_t)m * PIN + OFF_C + h * 128;
    LAS f4* sc = (LAS f4*)(lds + wave * 2048);
#pragma unroll
    for (int t = 0; t < 2; ++t) { const int k = lane + 64 * t; const float lb = lbound(a->in[I_CLB], L, h * 128 + k); const float fz = zc[WC + k];
        const float e = __expf(-fmaxf(fz, -80.f)), sg = __builtin_amdgcn_rcpf(1.0f + e); f4 r; r.x = lb + (1.0f - lb) * sg; r.y = (1.0f - lb) * e * sg; r.z = zc[k]; r.w = 0.f; sc[k] = r; }
    const f4 iv = *(const f4*)(zc + 2 * WC + 4 * vq);
    LDS_WAIT(); asm volatile("" ::: "memory");
    const float* S0 = a->in[I_SHGRN] + (((size_t)L * NS + i) * 6 + h) * 16384 + 4 * vq;
    float* So = a->out + O_HS + (((size_t)L * NS + i) * 6 + h) * 16384 + 4 * vq;
    f4 o = (f4){0.f, 0.f, 0.f, 0.f};
#pragma unroll 1
    for (int qt = 0; qt < 4; ++qt) { f4 sv[16];
#pragma unroll
        for (int j = 0; j < 16; ++j) sv[j] = *(const f4*)(S0 + (size_t)(kh + 2 * (16 * qt + j)) * 128);
#pragma unroll
        for (int j = 0; j < 16; ++j) { const int k = kh + 2 * (16 * qt + j); const f4 c = sc[k]; const f4 n = sv[j] * c.x + iv * c.y; *(f4*)(So + (size_t)k * 128) = n; o += n * c.z; } }
    o.x += __shfl_xor(o.x, 32); o.y += __shfl_xor(o.y, 32); o.z += __shfl_xor(o.z, 32); o.w += __shfl_xor(o.w, 32);
    if (kh == 0) *(f4*)((float*)(ws + WS_O) + (size_t)m * WC + h * 128 + 4 * vq) = o;
    LDS_WAIT(); asm volatile("" ::: "memory");
}

enum { SE_STORE = 0, SE_RESID = 1, SE_SWIGLU = 2, SE_SIGMUL = 3, SE_ATOMIC = 4 };
struct SEpi { int mode; float* out; const float* base; const float* add; int ld; float alpha; float* tinit; };
template <bool PIPE> __device__ __forceinline__ void strip_task(const bf16* A, const bf16* Bt, int K, int r0, int r1, int c0, const SEpi& E, LAS unsigned char* lds, int lane, int wave, int kbeg, int nk) {
    const int x = lane & 15, quad = lane >> 4;
    const int q8 = nk >> 3, r8 = nk & 7, nks = q8 + (wave < r8 ? 1 : 0), ks0 = kbeg + wave * q8 + (wave < r8 ? wave : r8);
    const bf16* Ap = A + (size_t)x * K + ks0 * 32 + 8 * quad;
    const bf16* B0 = Bt + (size_t)(r0 + x) * K + ks0 * 32 + 8 * quad;
    const bf16* B1 = Bt + (size_t)(r1 + x) * K + ks0 * 32 + 8 * quad;
    pg8::f32x4 acc[8][2];
#pragma unroll
    for (int mt = 0; mt < 8; ++mt) { acc[mt][0] = (pg8::f32x4){0.f, 0.f, 0.f, 0.f}; acc[mt][1] = (pg8::f32x4){0.f, 0.f, 0.f, 0.f}; }
    int s = 0;
    if constexpr (PIPE) {
        for (; s + 2 <= nks; s += 2) {
            bf16x8 af[8], ag[8]; const bf16x8 b0 = *(const bf16x8*)(B0 + 32 * s), b1 = *(const bf16x8*)(B1 + 32 * s), c0v = *(const bf16x8*)(B0 + 32 * s + 32), c1v = *(const bf16x8*)(B1 + 32 * s + 32);
#pragma unroll
            for (int mt = 0; mt < 8; ++mt) { af[mt] = *(const bf16x8*)(Ap + (size_t)(16 * mt) * K + 32 * s); ag[mt] = *(const bf16x8*)(Ap + (size_t)(16 * mt) * K + 32 * s + 32); }
#pragma unroll
            for (int mt = 0; mt < 8; ++mt) { acc[mt][0] = __builtin_amdgcn_mfma_f32_16x16x32_bf16(af[mt], b0, acc[mt][0], 0, 0, 0); acc[mt][1] = __builtin_amdgcn_mfma_f32_16x16x32_bf16(af[mt], b1, acc[mt][1], 0, 0, 0); }
#pragma unroll
            for (int mt = 0; mt < 8; ++mt) { acc[mt][0] = __builtin_amdgcn_mfma_f32_16x16x32_bf16(ag[mt], c0v, acc[mt][0], 0, 0, 0); acc[mt][1] = __builtin_amdgcn_mfma_f32_16x16x32_bf16(ag[mt], c1v, acc[mt][1], 0, 0, 0); }
        }
    }
    for (; s < nks; ++s) {
        bf16x8 af[8]; const bf16x8 b0 = *(const bf16x8*)(B0 + 32 * s), b1 = *(const bf16x8*)(B1 + 32 * s);
#pragma unroll
        for (int mt = 0; mt < 8; ++mt) af[mt] = *(const bf16x8*)(Ap + (size_t)(16 * mt) * K + 32 * s);
#pragma unroll
        for (int mt = 0; mt < 8; ++mt) { acc[mt][0] = __builtin_amdgcn_mfma_f32_16x16x32_bf16(af[mt], b0, acc[mt][0], 0, 0, 0); acc[mt][1] = __builtin_amdgcn_mfma_f32_16x16x32_bf16(af[mt], b1, acc[mt][1], 0, 0, 0); }
    }
    __syncthreads();
    LAS pg8::f32x4* red = (LAS pg8::f32x4*)lds;
#pragma unroll
    for (int mt = 0; mt < 8; ++mt) { red[((wave * 8 + mt) * 2 + 0) * 64 + lane] = acc[mt][0]; red[((wave * 8 + mt) * 2 + 1) * 64 + lane] = acc[mt][1]; }
    __syncthreads();
    pg8::f32x4 s0 = (pg8::f32x4){0.f, 0.f, 0.f, 0.f}, s1 = s0;
#pragma unroll
    for (int w2 = 0; w2 < 8; ++w2) { s0 += red[((w2 * 8 + wave) * 2 + 0) * 64 + lane]; s1 += red[((w2 * 8 + wave) * 2 + 1) * 64 + lane]; }
#pragma unroll
    for (int i = 0; i < 4; ++i) { const size_t ro = (size_t)(16 * wave + 4 * quad + i) * E.ld;
        if (E.mode == SE_SWIGLU) { const float g = s0[i]; ((bf16*)E.out)[ro + c0 + x] = bf1(g * __builtin_amdgcn_rcpf(1.0f + __expf(-g)) * s1[i]); }
        else {
#pragma unroll
            for (int t = 0; t < 2; ++t) { const size_t o = ro + c0 + 16 * t + x; const float v = t ? s1[i] : s0[i]; float r;
                if (E.mode == SE_ATOMIC) { __hip_atomic_fetch_add(E.out + o, v, __ATOMIC_RELAXED, __HIP_MEMORY_SCOPE_AGENT); continue; }
                if (E.mode == SE_STORE) r = v;
                else if (E.mode == SE_RESID) { r = E.alpha * E.base[o] + v; if (E.add) r += E.add[o]; }
                else { r = E.base[o] * __builtin_amdgcn_rcpf(1.0f + __expf(-v)); if (E.tinit) E.tinit[o] = E.alpha * E.add[o] + r; }
                E.out[o] = r; } }
    }
}
template <bool PIPE = false> __device__ __forceinline__ void strip_gemm(const bf16* A, const bf16* Bt, int K, int N, const SEpi& E, LAS unsigned char* lds, int lane, int wave, int blk, int G, int ksplit = 1) {
    const int per = (E.mode == SE_SWIGLU) ? 16 : 32, ncg = N / per, ntask = ncg * ksplit, nkt = (K >> 5) / ksplit;
    for (int t = G - 1 - blk; t < ntask; t += G) { const int cg = t % ncg, kg = t / ncg, c0 = cg * per;
        if (E.mode == SE_SWIGLU) { const int rb = ((c0 >> 7) << 8) + (c0 & 127); strip_task<PIPE>(A, Bt, K, rb, rb + 128, c0, E, lds, lane, wave, 0, K >> 5); }
        else strip_task<PIPE>(A, Bt, K, c0, c0 + 16, c0, E, lds, lane, wave, kg * nkt, nkt); }
    __syncthreads();
}

#ifndef EN_PRO
#define EN_PRO 1
#endif
#ifndef EN_G1
#define EN_G1 1
#endif
#ifndef EN_PREP
#define EN_PREP 1
#endif
#ifndef EN_MIX
#define EN_MIX 1
#endif
#ifndef EN_POST
#define EN_POST 1
#endif
#ifndef EN_G3
#define EN_G3 1
#endif
#ifndef EN_LN
#define EN_LN 1
#endif
#ifndef EN_G4
#define EN_G4 1
#endif
#ifndef EN_G5
#define EN_G5 1
#endif
#ifndef REP_PHASE
#define REP_PHASE -1
#endif
#define NREP(k) ((REP_PHASE) == (k) ? 2 : 1)
#ifndef MK_SINGLE
#define MK_SINGLE 1
#endif
constexpr int PPL = 11, N_PHASES = 1 + PPL * DEPTH;
constexpr int SCAN_UNITS = NBAT * 12, HSEQ_UNITS = NBAT * 6 * 2, ROLE_BLOCKS = SCAN_UNITS + HSEQ_UNITS;
constexpr int N_SGU = NBAT * 16 * 4, N_RS = NS * 12 / 8, N_HS = NS * 6 / 8, N_MISC = N_SGU + N_RS + N_HS;

__global__ void __launch_bounds__(NTHR, 2) mk_fwd(Args a) {
    extern __shared__ __attribute__((aligned(16))) unsigned char lds_raw[];
    LAS unsigned char* lds = (LAS unsigned char*)lds_raw;
    const int tid = threadIdx.x, blk = blockIdx.x, G = gridDim.x; const int wave0 = __builtin_amdgcn_readfirstlane(tid >> 6);
    ArgsP ap0 = (ArgsP)__builtin_amdgcn_kernarg_segment_ptr();
    volatile LAS unsigned* MISC = (volatile LAS unsigned*)(lds + MISC_OFF);
    for (int u = tid; u < (LDS_BYTES - LDSCTL_OFF) / 4; u += NTHR) ((LAS unsigned*)(lds + LDSCTL_OFF))[u] = 0u;
    __syncthreads();
    const int lo = ap0->ph_lo, hi = ap0->ph_hi;
    XcdBarrier bar; bar.bar = (unsigned*)(ap0->ws + WS_CTL) + CW_BAR; bar.x = 0; bar.st = nullptr;
    if (hi - lo > 1) bar = xcd_barrier_post((unsigned*)(ap0->ws + WS_CTL) + CW_BAR, MISC + 8);
    bar.w0 = (wave0 == 0);
#define IN(k) (lo <= (k) && (k) < hi)
#define SEAM(k) do { if (IN(k) && IN((k) + 1)) { xcd_barrier(bar); } } while (0)
#define PHASE_BEGIN() ArgsP a = ap0; asm volatile("" : "+s"(a)); unsigned char* ws = a->ws; int tid_ = wave0 * 64 + mk_lane_id(); asm volatile("" : "+v"(tid_)); \
    const int lane_ = tid_ & 63; const int wave_ = __builtin_amdgcn_readfirstlane(tid_ >> 6); const int lane_s = lane_, wave_s = wave_; \
    bf16* HB = (bf16*)(ws + WS_HB); float* H = (float*)(ws + WS_H); float* T = (float*)(ws + WS_T); (void)HB; (void)H; (void)T; (void)lane_s; (void)wave_s

    #if EN_PRO
    if (IN(0)) for (int rep = 0; rep < NREP(0); ++rep) { PHASE_BEGIN(); phase_prologue(a, lds, lane_, wave_, blk, G); __syncthreads(); }
#endif
    SEAM(0);
    for (int L = 0; L < DEPTH; ++L) {
        const int pb = 1 + PPL * L;
#if EN_G1
        if (IN(pb)) for (int rep = 0; rep < NREP(1); ++rep) {
            { PHASE_BEGIN(); pg8::Gemm g{HB, (const bf16*)(ws + WS_WIN + L * SZ_WIN), MP, PIN, DM}; pg8::StaticOrder S; S.init(MP, PIN, G, blk);
              pg8::EpiF32 E{(float*)(ws + WS_Z), PIN}; pg8::gemm_phase<pg8::EpiF32, pg8::StaticOrder, true, true>(lds, g, S, E, wave0); }
              { PHASE_BEGIN(); const SEpi SE{SE_STORE, (float*)(ws + WS_Z) + (size_t)MP * PIN, nullptr, nullptr, PIN, 0.f, nullptr}; strip_gemm(HB + (size_t)MP * DM, (const bf16*)(ws + WS_WIN + L * SZ_WIN), DM, PIN, SE, lds, lane_s, wave_s, blk, G); }
            { PHASE_BEGIN(); pg8::Gemm g{(const bf16*)(ws + WS_PBF + L * SZ_PBF), (const bf16*)(ws + WS_WPP + L * SZ_WPP), MP, DM, DPLE}; pg8::StaticOrder S; S.init(MP, DM, G, G - 1 - blk);
              pg8::EpiF32 E{(float*)(ws + WS_PPO), DM}; pg8::gemm_phase<pg8::EpiF32, pg8::StaticOrder, true, true>(lds, g, S, E, wave0); }
              { PHASE_BEGIN(); const SEpi SE{SE_STORE, (float*)(ws + WS_PPO) + (size_t)MP * DM, nullptr, nullptr, DM, 0.f, nullptr}; strip_gemm((const bf16*)(ws + WS_PBF + L * SZ_PBF) + (size_t)MP * DPLE, (const bf16*)(ws + WS_WPP + L * SZ_WPP), DPLE, DM, SE, lds, lane_s, wave_s, blk, G); }
        }
#endif
        SEAM(pb);
#if EN_PREP
        if (IN(pb + 1)) for (int rep = 0; rep < NREP(2); ++rep) { PHASE_BEGIN(); phase_xc(a, L, lane_, wave_, blk, G); }
        SEAM(pb + 1);
        if (IN(pb + 2)) for (int rep = 0; rep < NREP(9); ++rep) {
            { PHASE_BEGIN(); pg8::Gemm g{(const bf16*)(ws + WS_XCAT), (const bf16*)(ws + WS_WL + L * SZ_WL), MP, NLORA, 256}; pg8::StaticOrder S; S.init(MP, NLORA, G, blk);
            pg8::EpiF32 E{(float*)(ws + WS_LORA), NLORA}; pg8::gemm_phase<pg8::EpiF32, pg8::StaticOrder, true, true>(lds, g, S, E, wave0); }
            { PHASE_BEGIN(); const SEpi SE{SE_STORE, (float*)(ws + WS_LORA) + (size_t)MP * NLORA, nullptr, nullptr, NLORA, 0.f, nullptr}; strip_gemm((const bf16*)(ws + WS_XCAT) + (size_t)MP * 256, (const bf16*)(ws + WS_WL + L * SZ_WL), 256, NLORA, SE, lds, lane_s, wave_s, blk, G); }
        }
        SEAM(pb + 2);
        if (IN(pb + 3)) for (int rep = 0; rep < NREP(10); ++rep) { PHASE_BEGIN(); phase_pre(a, L, lds, lane_, wave_, blk, G); phase_fin(a, L, lane_, wave_, blk, G); }
#endif
        SEAM(pb + 3);
#if EN_MIX
        if (IN(pb + 4)) for (int rep = 0; rep < NREP(3); ++rep) { PHASE_BEGIN();
            const int tid = tid_, lane = lane_, wave = wave_;
            if (blk < SCAN_UNITS) { for (int r2 = 0; r2 < NREP(31); ++r2) rwkv_seq_unit(a, L, blk, lds, lane, wave); }
            else if (blk < ROLE_BLOCKS) { for (int r2 = 0; r2 < NREP(32); ++r2) hgrn_stream_unit(a, L, blk - SCAN_UNITS, lds, lane, wave); }
            else for (int r2 = 0; r2 < NREP(33); ++r2) for (int it = blk - ROLE_BLOCKS; it < N_MISC; it += G - ROLE_BLOCKS) {
                if (it < N_SGU) sgu_item2(a, L, it, lds, tid, lane, wave);
                else if (it < N_SGU + N_RS) rwkv_sample_item(a, L, it - N_SGU, lds, lane, wave);
                else hgrn_sample_item2(a, L, it - N_SGU - N_RS, lds, lane, wave);
                __syncthreads();
            }
        }
#endif
        SEAM(pb + 4);
#if EN_POST
        if (IN(pb + 5)) for (int rep = 0; rep < NREP(4); ++rep) { PHASE_BEGIN(); phase_post(a, L, lane_, wave_, blk, G); }
#endif
        SEAM(pb + 5);
#if EN_G3
        if (IN(pb + 6)) for (int rep = 0; rep < NREP(5); ++rep) {
            { PHASE_BEGIN(); pg8::Gemm g{(const bf16*)(ws + WS_YMIX), (const bf16*)(ws + WS_WOUT + L * SZ_WOUT), MP, DM, DM}; pg8::StaticOrder S; S.init(MP, DM, G, blk);
            pg8::EpiResid E{T, H, nullptr, DM, DN_ALPHA}; pg8::gemm_phase<pg8::EpiResid, pg8::StaticOrder, true, true>(lds, g, S, E, wave0); }
            { PHASE_BEGIN(); const SEpi SE{SE_ATOMIC, T + (size_t)MP * DM, nullptr, nullptr, DM, 0.f, nullptr}; strip_gemm<false>((const bf16*)(ws + WS_YMIX) + (size_t)MP * DM, (const bf16*)(ws + WS_WOUT + L * SZ_WOUT), DM, DM, SE, lds, lane_s, wave_s, blk, G, 4); }
        }
#endif
        SEAM(pb + 6);
#if EN_LN
        if (IN(pb + 7)) for (int rep = 0; rep < NREP(6); ++rep) { PHASE_BEGIN(); phase_ln(a, a->in[I_LN1G] + L * DM, a->in[I_LN1B] + L * DM, false, lane_, wave_, blk, G); }
#endif
        SEAM(pb + 7);
#if EN_G4
        if (IN(pb + 8)) for (int rep = 0; rep < NREP(7); ++rep) {
            { PHASE_BEGIN(); pg8::Gemm g{HB, (const bf16*)(ws + WS_WGU + L * SZ_WGU), MP, 2 * DFF, DM}; pg8::StaticOrder S; S.init(MP, 2 * DFF, G, blk);
              pg8::EpiSwiglu E{(bf16*)(ws + WS_ACT), DFF}; pg8::gemm_phase<pg8::EpiSwiglu, pg8::StaticOrder, true, true>(lds, g, S, E, wave0); }
              { PHASE_BEGIN(); const SEpi SE{SE_SWIGLU, (float*)((bf16*)(ws + WS_ACT) + (size_t)MP * DFF), nullptr, nullptr, DFF, 0.f, nullptr}; strip_gemm(HB + (size_t)MP * DM, (const bf16*)(ws + WS_WGU + L * SZ_WGU), DM, DFF, SE, lds, lane_s, wave_s, blk, G); }
            { PHASE_BEGIN(); pg8::Gemm g{HB, (const bf16*)(ws + WS_WPG + L * SZ_WPG), MP, DM, DM}; pg8::StaticOrder S; S.init(MP, DM, G, G - 1 - blk);
              pg8::EpiSigMul E{(float*)(ws + WS_PLE), (const float*)(ws + WS_PPO), DM}; pg8::gemm_phase<pg8::EpiSigMul, pg8::StaticOrder, true, true>(lds, g, S, E, wave0); }
              { PHASE_BEGIN(); const SEpi SE{SE_SIGMUL, (float*)(ws + WS_PLE) + (size_t)MP * DM, (const float*)(ws + WS_PPO) + (size_t)MP * DM, H + (size_t)MP * DM, DM, DN_ALPHA, T + (size_t)MP * DM}; strip_gemm(HB + (size_t)MP * DM, (const bf16*)(ws + WS_WPG + L * SZ_WPG), DM, DM, SE, lds, lane_s, wave_s, blk, G); }
        }
#endif
        SEAM(pb + 8);
#if EN_G5
        if (IN(pb + 9)) for (int rep = 0; rep < NREP(8); ++rep) {
            for (int r3 = 0; r3 < NREP(81); ++r3) { PHASE_BEGIN(); pg8::Gemm g{(const bf16*)(ws + WS_ACT), (const bf16*)(ws + WS_WD + L * SZ_WD), MP, DM, DFF}; pg8::StaticOrder S; S.init(MP, DM, G, blk);
            pg8::EpiResid E{T, H, (const float*)(ws + WS_PLE), DM, DN_ALPHA}; pg8::gemm_phase<pg8::EpiResid, pg8::StaticOrder, true, true>(lds, g, S, E, wave0); }
            for (int r3 = 0; r3 < NREP(82); ++r3) { PHASE_BEGIN(); const SEpi SE{SE_ATOMIC, T + (size_t)MP * DM, nullptr, nullptr, DM, 0.f, nullptr}; strip_gemm<false>((const bf16*)(ws + WS_ACT) + (size_t)MP * DFF, (const bf16*)(ws + WS_WD + L * SZ_WD), DFF, DM, SE, lds, lane_s, wave_s, blk, G, 4); }
        }
#endif
        SEAM(pb + 9);
#if EN_LN
        if (IN(pb + 10)) for (int rep = 0; rep < NREP(6); ++rep) { PHASE_BEGIN(); phase_ln(a, a->in[I_LN2G] + L * DM, a->in[I_LN2B] + L * DM, L == DEPTH - 1, lane_, wave_, blk, G); }
#endif
        SEAM(pb + 10);
    }
#undef IN
#undef SEAM
}

extern "C" void kernel_launch(void* const* d_in, const int* in_sizes, int n_in, void* d_out, int out_size, void* d_ws, size_t ws_size, hipStream_t stream) {
    static int grid = 0;
    if (grid == 0) {
        if (n_in != N_IN || (size_t)out_size != O_END || ws_size < WS_END) { fprintf(stderr, "kernel_launch: unexpected sizes n_in %d out %d ws %zu (need %zu)\n", n_in, out_size, ws_size, (size_t)WS_END); grid = -1; return; }
        int dev = 0, cus = 0, per_cu = 0;
        if (hipGetDevice(&dev) != hipSuccess || hipDeviceGetAttribute(&cus, hipDeviceAttributeMultiprocessorCount, dev) != hipSuccess) { grid = -1; return; }
        if (hipFuncSetAttribute((const void*)mk_fwd, hipFuncAttributeMaxDynamicSharedMemorySize, LDS_BYTES) != hipSuccess) { fprintf(stderr, "kernel_launch: hipFuncSetAttribute failed\n"); grid = -1; return; }
        if (hipOccupancyMaxActiveBlocksPerMultiprocessor(&per_cu, (const void*)mk_fwd, NTHR, LDS_BYTES) != hipSuccess || per_cu < 1) fprintf(stderr, "kernel_launch: occupancy query says %d\n", per_cu);
        (void)hipGetLastError();
        grid = cus;
        if (grid < ROLE_BLOCKS + 8) { fprintf(stderr, "kernel_launch: %d CUs is too few\n", grid); grid = -1; return; }
    }
    if (grid < 0) return;
    if (hipMemsetAsync((char*)d_ws + WS_CTL, 0, CTL_ZERO_BYTES, stream) != hipSuccess) return;
    Args a{};
    for (int i = 0; i < N_IN; ++i) a.in[i] = (const float*)d_in[i];
    a.out = (float*)d_out; a.ws = (unsigned char*)d_ws;
#if MK_SINGLE
    a.ph_lo = 0; a.ph_hi = N_PHASES;
    hipLaunchKernelGGL(mk_fwd, dim3(grid), dim3(NTHR), LDS_BYTES, stream, a);
#else
    for (int p = 0; p < N_PHASES; ++p) { a.ph_lo = p; a.ph_hi = p + 1; hipLaunchKernelGGL(mk_fwd, dim3(grid), dim3(NTHR), LDS_BYTES, stream, a); }
#endif
}
```

```cpp
#include <hip/hip_runtime.h>
#include <cstdio>
#include <cstdint>
typedef float mk_f32x2 __attribute__((ext_vector_type(2))); typedef __bf16 mk_bf16x2 __attribute__((ext_vector_type(2)));
__device__ __forceinline__ unsigned cvt_pk_bf16_c(float lo, float hi) { mk_f32x2 v = {lo, hi}; mk_bf16x2 b = __builtin_convertvector(v, mk_bf16x2); return __builtin_bit_cast(unsigned, b); }
__device__ __forceinline__ int mk_lane_id() { int l; asm volatile("v_mbcnt_lo_u32_b32 %0, -1, 0\n\tv_mbcnt_hi_u32_b32 %0, -1, %0" : "=v"(l)); return l; }
namespace pg8 {
#define PG8_LAS __attribute__((address_space(3)))
typedef unsigned short bf16_t;
typedef short bf16x8 __attribute__((ext_vector_type(8)));
typedef float f32x4 __attribute__((ext_vector_type(4)));
typedef unsigned u32x4 __attribute__((ext_vector_type(4)));
constexpr int BM = 256, BK = 64, HALF = 128, HTB = HALF * BK * 2  , STAGE_BYTES = 8 * HTB, NXCD = 8, WGM = 8;

__host__ __device__ __forceinline__ int lds_byte(int r, int c) { const int st = (r >> 4) * 2 + (c >> 5), rr = r & 15, cc = c & 31, ob = rr * 64 + cc * 2; return st * 1024 + (ob ^ (((ob >> 9) & 1) << 5)); }
__host__ __device__ __forceinline__ void stage_rc(int b, int& R, int& C) { const int st = b / 1024, sb = b % 1024, swz = sb ^ (((sb >> 9) & 1) << 5); R = (st >> 1) * 16 + swz / 64; C = (st & 1) * 32 + (swz % 64) / 2; }
__host__ __device__ __forceinline__ int perm32(int rho) { const int n = rho >> 4, i = rho & 15; return 8 * (i >> 2) + 4 * n + (i & 3); }

struct Unit { int pm, pn; };
struct Gemm { const bf16_t* A; const bf16_t* Bt; int M, N, K; };

struct StaticOrder {
    int nM, nN, nwg, G, c;
    __host__ __device__ void init(int M, int N, int G_, int c_) { nM = M / BM; nN = N / BM; nwg = nM * nN; G = G_; c = c_; }
    __host__ __device__ bool next(int i, Unit& u) const {
        const long L = (long)i * G + c; if (L >= nwg) return false;
        int wgid = (int)L; { const int q = nwg / NXCD, r = nwg % NXCD, xcd = wgid % NXCD, off = wgid / NXCD; wgid = (xcd < r ? xcd * (q + 1) : r * (q + 1) + (xcd - r) * q) + off; }
        const int nig = WGM * nN, gid = wgid / nig, fm = gid * WGM, gsz = (nM - fm) < WGM ? (nM - fm) : WGM;
        u.pm = fm + ((wgid % nig) % gsz); u.pn = (wgid % nig) / gsz; return true;
    }
    __device__ __forceinline__ void a_ready(const Unit&) const {}
    __device__ __forceinline__ void done(const Unit&) const {}
};

__device__ __forceinline__ unsigned cvt_pk_bf16(float lo, float hi) { unsigned r; asm volatile("v_cvt_pk_bf16_f32 %0, %1, %2" : "=v"(r) : "v"(lo), "v"(hi)); return r; }
typedef float f32x2 __attribute__((ext_vector_type(2)));
typedef unsigned u32x2 __attribute__((ext_vector_type(2)));
struct EpiF32 {
    static constexpr bool PERM = false, AFTER_DRAIN = false;
    float* C; int ldc;
    __device__ __forceinline__ void operator()(const f32x4 (&acc)[2][2][4][2], const Unit& u, int wr, int wc, int fr, int fq) const {
        { const int l_ = mk_lane_id(); fr = l_ & 15; fq = l_ >> 4; }
        const int row0 = u.pm * BM + wr * 64 + fr, col0 = u.pn * BM + wc * 32 + 4 * fq;
#pragma unroll
        for (int ai = 0; ai < 2; ++ai)
#pragma unroll
            for (int m = 0; m < 4; ++m) { float* rowp = C + (size_t)(row0 + ai * HALF + m * 16) * ldc + col0;
#pragma unroll
                for (int bj = 0; bj < 2; ++bj)
#pragma unroll
                    for (int n = 0; n < 2; ++n) *(f32x4*)(rowp + bj * HALF + n * 16) = acc[ai][bj][m][n]; }
    }
};
struct EpiResid {
    static constexpr bool PERM = false, AFTER_DRAIN = false;
    float* out; const float* base; const float* add; int ldc; float alpha;
    __device__ __forceinline__ void operator()(const f32x4 (&acc)[2][2][4][2], const Unit& u, int wr, int wc, int fr, int fq) const {
        { const int l_ = mk_lane_id(); fr = l_ & 15; fq = l_ >> 4; }
        const int row0 = u.pm * BM + wr * 64 + fr, col0 = u.pn * BM + wc * 32 + 4 * fq;
#pragma unroll
        for (int ai = 0; ai < 2; ++ai)
#pragma unroll
            for (int m = 0; m < 4; ++m) { const size_t off = (size_t)(row0 + ai * HALF + m * 16) * ldc + col0;
#pragma unroll
                for (int bj = 0; bj < 2; ++bj)
#pragma unroll
                    for (int n = 0; n < 2; ++n) { const size_t o2 = off + bj * HALF + n * 16; f32x4 v = *(const f32x4*)(base + o2) * alpha + acc[ai][bj][m][n];
                        if (add) v += *(const f32x4*)(add + o2); *(f32x4*)(out + o2) = v; } }
    }
};
struct EpiSigMul {
    static constexpr bool PERM = false, AFTER_DRAIN = false;
    float* out; const float* mul; int ldc;
    __device__ __forceinline__ void operator()(const f32x4 (&acc)[2][2][4][2], const Unit& u, int wr, int wc, int fr, int fq) const {
        { const int l_ = mk_lane_id(); fr = l_ & 15; fq = l_ >> 4; }
        const int row0 = u.pm * BM + wr * 64 + fr, col0 = u.pn * BM + wc * 32 + 4 * fq;
#pragma unroll
        for (int ai = 0; ai < 2; ++ai)
#pragma unroll
            for (int m = 0; m < 4; ++m) { const size_t off = (size_t)(row0 + ai * HALF + m * 16) * ldc + col0;
#pragma unroll
                for (int bj = 0; bj < 2; ++bj)
#pragma unroll
                    for (int n = 0; n < 2; ++n) { const size_t o2 = off + bj * HALF + n * 16; const f32x4 x = acc[ai][bj][m][n]; const f32x4 p = *(const f32x4*)(mul + o2); f32x4 v;
#pragma unroll
                        for (int e = 0; e < 4; ++e) v[e] = p[e] * __builtin_amdgcn_rcpf(1.0f + __expf(-x[e]));
                        *(f32x4*)(out + o2) = v; } }
    }
};
struct EpiSwiglu {
    static constexpr bool PERM = true, AFTER_DRAIN = false;
    bf16_t* O; int ldo;
    __device__ __forceinline__ void operator()(const f32x4 (&acc)[2][2][4][2], const Unit& u, int wr, int wc, int fr, int fq) const {
        { const int l_ = mk_lane_id(); fr = l_ & 15; fq = l_ >> 4; }
        const int row0 = u.pm * BM + wr * 64 + fr, col0 = u.pn * HALF + wc * 32 + 8 * fq;
#pragma unroll
        for (int ai = 0; ai < 2; ++ai)
#pragma unroll
            for (int m = 0; m < 4; ++m) { bf16_t* rowp = O + (size_t)(row0 + ai * HALF + m * 16) * ldo + col0; float r[8];
#pragma unroll
                for (int n = 0; n < 2; ++n)
#pragma unroll
                    for (int e = 0; e < 4; ++e) { const float g = acc[ai][0][m][n][e], up = acc[ai][1][m][n][e]; r[4 * n + e] = g * __builtin_amdgcn_rcpf(1.0f + __expf(-g)) * up; }
                u32x4 w; w.x = cvt_pk_bf16(r[0], r[1]); w.y = cvt_pk_bf16(r[2], r[3]); w.z = cvt_pk_bf16(r[4], r[5]); w.w = cvt_pk_bf16(r[6], r[7]);
                *(u32x4*)rowp = w; }
    }
};
template <class Epi, class Sched, bool ALIGN_EPI = false, bool SP2 = false>
__device__ __forceinline__ void gemm_phase(PG8_LAS unsigned char* lds, const Gemm g, const Sched& S, const Epi& E, int wid0) {
    int tid_l = wid0 * 64 + mk_lane_id(); asm volatile("" : "+v"(tid_l));
    const int tid = tid_l, wid = __builtin_amdgcn_readfirstlane(tid >> 6), lane = tid & 63, wr = wid >> 2, wc = wid & 3, fr = lane & 15, fq = lane >> 4;
    const int K = g.K, nt = K / BK;
    unsigned voffA[2], voffB[2];
#pragma unroll
    for (int i = 0; i < 2; ++i) { int R, C; stage_rc(tid * 16 + i * 8192, R, C); const int Rb = Epi::PERM ? ((R & ~31) + perm32(R & 31)) : R;
        voffA[i] = (unsigned)(R * K + C) * 2u; voffB[i] = (unsigned)(Rb * K + C) * 2u; }
    const size_t kstep = (size_t)(BK * 2);
    const size_t hstep = (size_t)HALF * K * 2;
    const size_t tstep = 2 * hstep;
    const unsigned ldsw = (unsigned)wid * 1024u;
    const int aoff = lds_byte(wr * 64 + fr, fq * 8), boff = lds_byte(wc * 32 + fr, fq * 8);
#define PG8_SA(b, h) (((b) * 2 + (h)) * HTB)
#define PG8_SB(b, h) ((4 + (b) * 2 + (h)) * HTB)
#define PG8_STAGE(bufoff, gbase, voff) do { _Pragma("unroll") for (int _i = 0; _i < 2; ++_i) \
        __builtin_amdgcn_global_load_lds((const unsigned*)((const char*)(gbase) + (voff)[_i]), (PG8_LAS unsigned*)(lds + (bufoff) + ldsw + _i * 8192), 16, 0, 0); } while (0)
#define PG8_LDA(dst, b, h) do { _Pragma("unroll") for (int m = 0; m < 4; ++m) _Pragma("unroll") for (int k = 0; k < 2; ++k) dst[m][k] = *(const PG8_LAS bf16x8*)(lds + PG8_SA(b, h) + aoff + m * 2048 + k * 1024); } while (0)
#define PG8_LDB(dst, b, h) do { _Pragma("unroll") for (int n = 0; n < 2; ++n) _Pragma("unroll") for (int k = 0; k < 2; ++k) dst[n][k] = *(const PG8_LAS bf16x8*)(lds + PG8_SB(b, h) + boff + n * 2048 + k * 1024); } while (0)
#define PG8_MMA(ai, bj, At, Bt) do { __builtin_amdgcn_s_setprio(1); _Pragma("unroll") for (int m = 0; m < 4; ++m) _Pragma("unroll") for (int n = 0; n < 2; ++n) _Pragma("unroll") for (int k = 0; k < 2; ++k) \
        acc[ai][bj][m][n] = __builtin_amdgcn_mfma_f32_16x16x32_bf16(Bt[n][k], At[m][k], acc[ai][bj][m][n], 0, 0, 0); __builtin_amdgcn_s_setprio(0); } while (0)
#define PG8_WAIT_V(n) asm volatile("s_waitcnt vmcnt(" #n ")" ::: "memory")
#define PG8_WAIT_L(n) asm volatile("s_waitcnt lgkmcnt(" #n ")" ::: "memory")
#define PG8_BAR __builtin_amdgcn_s_barrier()
#define PG8_SCHED __builtin_amdgcn_sched_barrier(0)
    Unit cur, nxt; int ui = 0;
    if (!S.next(0, cur)) return;
    f32x4 acc[2][2][4][2];
#pragma unroll
    for (int a = 0; a < 2; ++a)
#pragma unroll
        for (int b = 0; b < 2; ++b)
#pragma unroll
            for (int m = 0; m < 4; ++m)
#pragma unroll
                for (int n = 0; n < 2; ++n) acc[a][b][m][n] = (f32x4){0.f, 0.f, 0.f, 0.f};
    bf16x8 At[4][2], B0[2][2], B1[2][2];
    const char* cA = (const char*)g.A + (size_t)cur.pm * tstep; const char* cB = (const char*)g.Bt + (size_t)cur.pn * tstep;
    S.a_ready(cur);
    if constexpr (SP2) {
        PG8_STAGE(PG8_SB(0, 0), cB, voffB); PG8_STAGE(PG8_SB(0, 1), cB + hstep, voffB); PG8_STAGE(PG8_SA(0, 0), cA, voffA); PG8_STAGE(PG8_SA(0, 1), cA + hstep, voffA);
        if (wr == 1) PG8_BAR;
        PG8_WAIT_V(2); PG8_BAR;
        PG8_STAGE(PG8_SB(1, 0), cB + kstep, voffB); PG8_STAGE(PG8_SA(1, 0), cA + kstep, voffA); PG8_STAGE(PG8_SB(1, 1), cB + hstep + kstep, voffB);
        PG8_WAIT_V(6); PG8_BAR;
    } else {
        PG8_STAGE(PG8_SB(0, 0), cB, voffB); PG8_STAGE(PG8_SA(0, 0), cA, voffA); PG8_STAGE(PG8_SB(0, 1), cB + hstep, voffB); PG8_STAGE(PG8_SA(0, 1), cA + hstep, voffA);
        if (wr == 1) PG8_BAR;
        PG8_WAIT_V(4); PG8_BAR;
        PG8_STAGE(PG8_SB(1, 0), cB + kstep, voffB); PG8_STAGE(PG8_SA(1, 0), cA + kstep, voffA); PG8_STAGE(PG8_SB(1, 1), cB + hstep + kstep, voffB);
        PG8_WAIT_V(6); PG8_BAR;
    }
    for (;;) {
        const bool has_next = S.next(ui + 1, nxt);
        const char* nA = has_next ? (const char*)g.A + (size_t)nxt.pm * tstep : cA; const char* nB = has_next ? (const char*)g.Bt + (size_t)nxt.pn * tstep : cB;
        for (int t = 0; t < nt; t += 2) {
            const bool last = (t == nt - 2);
            const char* a1 = cA + (size_t)(t + 1) * kstep;
            const char* a2 = last ? nA : cA + (size_t)(t + 2) * kstep; const char* b2 = last ? nB : cB + (size_t)(t + 2) * kstep;
            const char* a3 = a2 + kstep; const char* b3 = b2 + kstep;
            if (last && has_next) S.a_ready(nxt);
            if constexpr (SP2) {
            PG8_LDB(B0, 0, 0); PG8_LDB(B1, 0, 1); PG8_SCHED; PG8_LDA(At, 0, 0); PG8_STAGE(PG8_SA(1, 1), a1 + hstep, voffA);
            PG8_WAIT_V(8); PG8_WAIT_L(0); PG8_BAR; PG8_MMA(0, 0, At, B0); PG8_MMA(0, 1, At, B1); PG8_BAR; PG8_SCHED;
            PG8_LDA(At, 0, 1); PG8_STAGE(PG8_SB(0, 0), b2, voffB); PG8_STAGE(PG8_SB(0, 1), b2 + hstep, voffB); PG8_STAGE(PG8_SA(0, 0), a2, voffA);
            PG8_WAIT_V(8); PG8_WAIT_L(0); PG8_BAR; PG8_MMA(1, 0, At, B0); PG8_MMA(1, 1, At, B1); PG8_BAR; PG8_SCHED;
            PG8_LDB(B0, 1, 0); PG8_LDB(B1, 1, 1); PG8_SCHED; PG8_LDA(At, 1, 0); PG8_STAGE(PG8_SA(0, 1), a2 + hstep, voffA);
            PG8_WAIT_V(8); PG8_WAIT_L(0); PG8_BAR; PG8_MMA(0, 0, At, B0); PG8_MMA(0, 1, At, B1); PG8_BAR; PG8_SCHED;
            PG8_LDA(At, 1, 1); PG8_STAGE(PG8_SB(1, 0), b3, voffB); PG8_STAGE(PG8_SB(1, 1), b3 + hstep, voffB); PG8_STAGE(PG8_SA(1, 0), a3, voffA);
            PG8_WAIT_V(8); PG8_WAIT_L(0); PG8_BAR; PG8_MMA(1, 0, At, B0); PG8_MMA(1, 1, At, B1); PG8_BAR; PG8_SCHED;
            } else {
            PG8_LDB(B0, 0, 0); PG8_SCHED; PG8_LDA(At, 0, 0); PG8_STAGE(PG8_SA(1, 1), a1 + hstep, voffA);
            PG8_WAIT_L(8); PG8_BAR; PG8_WAIT_L(0); PG8_MMA(0, 0, At, B0); PG8_BAR; PG8_SCHED;
            PG8_LDB(B1, 0, 1); PG8_STAGE(PG8_SB(0, 0), b2, voffB);
            PG8_BAR; PG8_WAIT_L(0); PG8_MMA(0, 1, At, B1); PG8_BAR;
            PG8_LDA(At, 0, 1); PG8_STAGE(PG8_SA(0, 0), a2, voffA);
            PG8_BAR; PG8_WAIT_L(0); PG8_MMA(1, 0, At, B0); PG8_BAR; PG8_SCHED;
            PG8_STAGE(PG8_SB(0, 1), b2 + hstep, voffB);
            PG8_WAIT_V(6); PG8_BAR; PG8_MMA(1, 1, At, B1); PG8_BAR;
            PG8_LDB(B0, 1, 0); PG8_SCHED; PG8_LDA(At, 1, 0); PG8_STAGE(PG8_SA(0, 1), a2 + hstep, voffA);
            PG8_WAIT_L(8); PG8_BAR; PG8_WAIT_L(0); PG8_MMA(0, 0, At, B0); PG8_BAR; PG8_SCHED;
            PG8_LDB(B1, 1, 1); PG8_STAGE(PG8_SB(1, 0), b3, voffB);
            PG8_BAR; PG8_WAIT_L(0); PG8_MMA(0, 1, At, B1); PG8_BAR;
            PG8_LDA(At, 1, 1); PG8_STAGE(PG8_SA(1, 0), a3, voffA);
            PG8_BAR; PG8_WAIT_L(0); PG8_MMA(1, 0, At, B0); PG8_BAR; PG8_SCHED;
            PG8_STAGE(PG8_SB(1, 1), b3 + hstep, voffB);
            PG8_WAIT_V(6); PG8_BAR; PG8_MMA(1, 1, At, B1); PG8_BAR;
            }
        }
        if constexpr (ALIGN_EPI) { if (wr == 0) PG8_BAR; }
        if constexpr (!Epi::AFTER_DRAIN) { E(acc, cur, wr, wc, fr, fq); S.done(cur); }
        if (!has_next) break;
#pragma unroll
        for (int a = 0; a < 2; ++a)
#pragma unroll
            for (int b = 0; b < 2; ++b)
#pragma unroll
                for (int m = 0; m < 4; ++m)
#pragma unroll
                    for (int n = 0; n < 2; ++n) acc[a][b][m][n] = (f32x4){0.f, 0.f, 0.f, 0.f};
        cur = nxt; cA = nA; cB = nB; ++ui;
        if constexpr (ALIGN_EPI) { if (wr == 1) PG8_BAR; }
    }
    PG8_WAIT_V(0);
    if constexpr (!ALIGN_EPI) { if (wr == 0) PG8_BAR; }
    PG8_BAR;
    if constexpr (Epi::AFTER_DRAIN) { E.fused(acc, cur, wr, wc, fr, fq, lds, wid, lane); S.done(cur); }
#undef PG8_SA
#undef PG8_SB
#undef PG8_STAGE
#undef PG8_LDA
#undef PG8_LDB
#undef PG8_MMA
#undef PG8_WAIT_V
#undef PG8_WAIT_L
#undef PG8_BAR
#undef PG8_SCHED
}
}
#define GAS __attribute__((address_space(1)))
#define LAS __attribute__((address_space(3)))
typedef unsigned short bf16;
typedef unsigned v4u __attribute__((ext_vector_type(4)));
typedef float f32x4 __attribute__((ext_vector_type(4)));
typedef short bf16x8 __attribute__((ext_vector_type(8)));
typedef GAS unsigned gu32;
typedef GAS unsigned long long gu64;
#define RLX_AGENT __ATOMIC_RELAXED, __HIP_MEMORY_SCOPE_AGENT
#define LDS_WAIT() asm volatile("s_waitcnt lgkmcnt(0)" ::: "memory")
#define VM_WAIT() asm volatile("s_waitcnt vmcnt(0)" ::: "memory")
__device__ __forceinline__ unsigned long long rt() { return __builtin_amdgcn_s_memrealtime(); }
__device__ __forceinline__ unsigned f2bf(float f) { unsigned u = __builtin_bit_cast(unsigned, f); return (u + 0x7fffu + ((u >> 16) & 1u)) >> 16; }
__device__ __forceinline__ unsigned pk2(float lo, float hi) { return f2bf(lo) | (f2bf(hi) << 16); }

#define XB_TMO      128
#define XB_XCNT(j)  (256  + 64 * (j))
#define XB_XSUB(j)  (1280 + 64 * (j))
#define XB_XGEN(j)  (2304 + 64 * (j))
#define XB_TOP      3328
#define XB_TOPGEN   3392
#define XCD_BAR_WORDS 3456
#define XB_SPIN_CAP (1u << 18)

__device__ __forceinline__ unsigned xb_ld(unsigned* p)              { return __hip_atomic_load(p, __ATOMIC_RELAXED, __HIP_MEMORY_SCOPE_AGENT); }
__device__ __forceinline__ unsigned xb_add(unsigned* p, unsigned v) { return __hip_atomic_fetch_add(p, v, __ATOMIC_RELAXED, __HIP_MEMORY_SCOPE_AGENT); }
__device__ __forceinline__ unsigned xb_xcc_id() { return (unsigned)__builtin_amdgcn_s_getreg((3 << 11) | 20) & 0xFu; }
#define XB_SPIN(cond, bar) do { unsigned _sp = 0; while (cond) { __builtin_amdgcn_s_sleep(1); \
    if ((++_sp & 255u) == 0u) { if (xb_ld(&(bar)[XB_TMO])) break; if (_sp > XB_SPIN_CAP) { atomicAdd(&(bar)[XB_TMO], 1u); break; } } } } while (0)

struct XcdBarrier {
    unsigned* bar; unsigned x;
    volatile LAS unsigned* st;
    bool w0;
};

__device__ __forceinline__ XcdBarrier xcd_barrier_post(unsigned* bar, volatile LAS unsigned* st) {
    XcdBarrier b; b.bar = bar; b.x = xb_xcc_id(); b.st = st;
    if (threadIdx.x == 0) (void)xb_add(&bar[XB_XCNT(b.x)], 1u);
    return b;
}
__device__ __forceinline__ void xcd_barrier_complete(unsigned* bar, unsigned x, unsigned& nloc, unsigned& nx) {
    const unsigned G = gridDim.x * gridDim.y * gridDim.z;
    unsigned sum, cnt, mine, sp = 0u;
    for (;;) {
        sum = 0u; cnt = 0u; mine = 0u;
#pragma unroll 1
        for (unsigned j = 0; j < 16; ++j) { const unsigned c = xb_ld(&bar[XB_XCNT(j)]); sum += c; cnt += (c > 0u) ? 1u : 0u; mine = (j == x) ? c : mine; }
        if (sum == G) break;
        __builtin_amdgcn_s_sleep(1);
        if ((++sp & 255u) == 0u) { if (xb_ld(&bar[XB_TMO])) break; if (sp > XB_SPIN_CAP) { atomicAdd(&bar[XB_TMO], 1u); break; } }
    }
    nloc = mine > 0u ? mine : 1u; nx = cnt > 0u ? cnt : 1u;
}

__device__ __forceinline__ void xcd_barrier(const XcdBarrier& b) {
    asm volatile("s_waitcnt vmcnt(0)" ::: "memory");
    __syncthreads();
    if (b.w0 && mk_lane_id() == 0) {
        unsigned* bar = b.bar;
        __builtin_amdgcn_s_waitcnt(0);
        unsigned nloc = b.st[0], nx = b.st[1];
        if (nloc == 0u) { xcd_barrier_complete(bar, b.x, nloc, nx); b.st[0] = nloc; b.st[1] = nx; }
        const unsigned old = xb_add(&bar[XB_XSUB(b.x)], 1u);
        const unsigned gen = old / nloc;
        if (old + 1u == (gen + 1u) * nloc) {
            __builtin_amdgcn_fence(__ATOMIC_RELEASE, "agent");
            asm volatile("s_waitcnt vmcnt(0)" ::: "memory");
            const unsigned og = xb_add(&bar[XB_TOP], 1u);
            const unsigned tg = og / nx;
            if (og + 1u == (tg + 1u) * nx) xb_add(&bar[XB_TOPGEN], 1u);
            else XB_SPIN(xb_ld(&bar[XB_TOPGEN]) == tg, bar);
            __builtin_amdgcn_fence(__ATOMIC_ACQUIRE, "agent");
            xb_add(&bar[XB_XGEN(b.x)], 1u);
            asm volatile("s_waitcnt vmcnt(0)" ::: "memory");
        } else {
            XB_SPIN(xb_ld(&bar[XB_XGEN(b.x)]) == gen, bar);
            __builtin_amdgcn_fence(__ATOMIC_ACQUIRE, "agent");
            asm volatile("s_waitcnt vmcnt(0)" ::: "memory");
        }
    }
    __syncthreads();
}

constexpr int DM = 2048, NBAT = 4, SEQ = 2048, DEPTH = 4, NS = 128;
constexpr int MP = NBAT * SEQ;
constexpr int MV = MP + NS;
constexpr int MPAD = 8448;
constexpr int WA = 512, WB = 768, WC = 768, PIN = 6656, DFF = 5632, DPLE = 256, PBW = 2560;
constexpr int OFF_B = 1024, OFF_C = 3584;
constexpr float LN_EPS = 1e-5f, GN_EPS = 64e-5f, RMS_EPS = 1e-6f;
constexpr float DN_ALPHA = 1.681792830507429f;
enum { I_XP = 0, I_XS, I_SRWKV, I_SSHIFT, I_SHGRN, I_PP, I_PS, I_LNING, I_LNINB, I_WIN, I_ALNG, I_ALNB, I_AWS, I_ABS, I_BMU, I_BW0, I_BWUP, I_BA0, I_BAUP, I_BGUP,
       I_BKK, I_BKA, I_BRK, I_BGNG, I_BGNB, I_CLB, I_CNG, I_WOUT, I_LN1G, I_LN1B, I_WG, I_WU, I_WD, I_WPG, I_WPP, I_LN2G, I_LN2B, N_IN };
constexpr size_t O_YP = 0, O_YS = O_YP + (size_t)MP * DM, O_RP = O_YS + (size_t)NS * DM, O_SP = O_RP + (size_t)DEPTH * NBAT * 12 * 4096,
                 O_HP = O_SP + (size_t)DEPTH * NBAT * PBW, O_RS = O_HP + (size_t)DEPTH * NBAT * 6 * 16384, O_SS = O_RS + (size_t)DEPTH * NS * 12 * 4096,
                 O_HS = O_SS + (size_t)DEPTH * NS * PBW, O_VS = O_HS + (size_t)DEPTH * NS * 6 * 16384, O_END = O_VS + (size_t)DEPTH * NS * WA;
static_assert(O_END == 96509952, "output size");
constexpr size_t al256(size_t x) { return (x + 255) & ~(size_t)255; }
constexpr size_t WS_CTL = 0, CTL_ZERO_BYTES = 1u << 20;
constexpr size_t SZ_WIN = (size_t)PIN * DM * 2, SZ_WOUT = (size_t)DM * DM * 2, SZ_WGU = (size_t)2 * DFF * DM * 2, SZ_WD = (size_t)DM * DFF * 2, SZ_WPG = SZ_WOUT, SZ_WPP = (size_t)DM * DPLE * 2;
constexpr size_t WS_WIN = CTL_ZERO_BYTES, WS_WOUT = WS_WIN + DEPTH * SZ_WIN, WS_WGU = WS_WOUT + DEPTH * SZ_WOUT, WS_WD = WS_WGU + DEPTH * SZ_WGU, WS_WPG = WS_WD + DEPTH * SZ_WD,
                 WS_WPP = WS_WPG + DEPTH * SZ_WPG, WS_PBF = WS_WPP + DEPTH * SZ_WPP;
constexpr size_t SZ_PBF = (size_t)MPAD * DPLE * 2;
constexpr size_t WS_H = WS_PBF + DEPTH * SZ_PBF, WS_HB = WS_H + (size_t)MPAD * DM * 4, WS_T = WS_HB + (size_t)MPAD * DM * 2, WS_YMIX = WS_T + (size_t)MPAD * DM * 4;
constexpr size_t WS_Z = WS_YMIX + (size_t)MPAD * DM * 2;
constexpr size_t WS_ACT = WS_Z, WS_PLE = WS_ACT + al256((size_t)MPAD * DFF * 2);
constexpr size_t WS_PPO = WS_Z + (size_t)MPAD * PIN * 4;
static_assert(WS_PLE + (size_t)MPAD * DM * 4 <= WS_PPO, "overlay fits");
constexpr size_t WS_RPB = WS_PPO + (size_t)MPAD * DM * 4;
constexpr size_t WS_RPS = WS_RPB + (size_t)NBAT * 12 * (SEQ / 16) * 16384;
constexpr int NLORA = 3 * WB;
constexpr size_t SZ_WL = (size_t)NLORA * 256 * 2;
constexpr size_t WS_WL = WS_RPS + (size_t)NS * 12 * 384 * 4;
constexpr size_t WS_XCAT = WS_WL + DEPTH * SZ_WL;
constexpr size_t WS_LORA = WS_XCAT + (size_t)MPAD * 256 * 2;
constexpr size_t WS_Y = WS_LORA + (size_t)MPAD * NLORA * 4;
constexpr size_t WS_O = WS_Y + (size_t)MPAD * WB * 4;
constexpr size_t WS_HREC = WS_O + (size_t)MPAD * WC * 4;
constexpr size_t WS_END = WS_HREC + (size_t)NBAT * 6 * (SEQ / 16) * 17408;
static_assert(WS_WIN % 256 == 0 && WS_H % 256 == 0 && WS_Z % 256 == 0 && WS_RPB % 256 == 0 && WS_WL % 256 == 0 && WS_XCAT % 256 == 0 && WS_LORA % 256 == 0 && WS_Y % 256 == 0, "alignment");
constexpr int CW_BAR = 4096;

constexpr int RING_BYTES = 131072, LDSCTL_OFF = RING_BYTES, MISC_OFF = LDSCTL_OFF + 320, LDS_BYTES = 147456;
constexpr int NWAVES = 8, NTHR = 512;

struct Args { const float* in[N_IN]; float* out; unsigned char* ws; int ph_lo, ph_hi; };
static_assert(sizeof(Args) == (N_IN + 2) * 8 + 8, "no padding in Args");
typedef const __attribute__((address_space(4))) Args* ArgsP;

__device__ __forceinline__ size_t wso(size_t c) { asm volatile("" : "+s"(c)); return c; }
typedef float f4 __attribute__((ext_vector_type(4)));
typedef float f2 __attribute__((ext_vector_type(2)));
typedef unsigned u2 __attribute__((ext_vector_type(2)));

template <int CTRL> __device__ __forceinline__ float dpp_f(float x) { return __builtin_bit_cast(float, __builtin_amdgcn_update_dpp(0, __builtin_bit_cast(int, x), CTRL, 0xF, 0xF, true)); }
__device__ __forceinline__ float row16_sum(float x) {
    x += dpp_f<0xB1>(x);
    x += dpp_f<0x4E>(x);
    x += dpp_f<0x141>(x);
    x += dpp_f<0x140>(x);
    return x;
}
__device__ __forceinline__ float readlane_f(float x, int l) { return __builtin_bit_cast(float, __builtin_amdgcn_readlane(__builtin_bit_cast(int, x), l)); }
__device__ __forceinline__ float wave_sum_fast(float x) { x = row16_sum(x); return (readlane_f(x, 0) + readlane_f(x, 16)) + (readlane_f(x, 32) + readlane_f(x, 48)); }
__device__ __forceinline__ float wave_sum(float v) { return wave_sum_fast(v); }
__device__ __forceinline__ float sigmoidf_(float x) { return 1.0f / (1.0f + expf(-x)); }
__device__ __forceinline__ float gelu_erf(float x) { return 0.5f * x * (1.0f + erff(x * 0.70710678118654752f)); }
__device__ __forceinline__ unsigned short bf1(float x) { return (unsigned short)(cvt_pk_bf16_c(x, 0.f) & 0xffffu); }
__device__ __forceinline__ float lbound(const float* clb, int L, int c) {
    const float x0 = clb[c], x1 = clb[WC + c], x2 = clb[2 * WC + c], x3 = clb[3 * WC + c];
    const float mx = fmaxf(fmaxf(x0, x1), fmaxf(x2, x3));
    const float e0 = expf(x0 - mx), e1 = expf(x1 - mx), e2 = expf(x2 - mx), e3 = expf(x3 - mx);
    float s = 0.f; if (L >= 1) s += e1; if (L >= 2) s += e2; if (L >= 3) s += e3;
    return s / (e0 + e1 + e2 + e3);
}
__device__ __forceinline__ float log_sigmoid(float x) { return fminf(x, 0.f) - log1pf(expf(-fabsf(x))); }

__device__ __forceinline__ void tr_item(const float* W, int K, int N, bf16* WT, int mode, LAS float* scr, int item, int lane) {
    const int nblk = N >> 5, kb = item / nblk, nb = item - kb * nblk, k0 = kb << 6, n0 = nb << 5;
    int rb = n0; if (mode) rb = ((n0 >> 7) << 8) + (n0 & 127) + (mode == 2 ? 128 : 0);
#pragma unroll 8
    for (int i = 0; i < 32; ++i) { const int kk = 2 * i + (lane >> 5); scr[kk * 33 + (lane & 31)] = W[(size_t)(k0 + kk) * N + n0 + (lane & 31)]; }
    LDS_WAIT(); asm volatile("" ::: "memory");
    const int c = lane & 7;
#pragma unroll
    for (int j = 0; j < 4; ++j) { const int n = (lane >> 3) + 8 * j; const LAS float* s = scr + (8 * c) * 33 + n;
        v4u o; o.x = pg8::cvt_pk_bf16(s[0 * 33], s[1 * 33]); o.y = pg8::cvt_pk_bf16(s[2 * 33], s[3 * 33]); o.z = pg8::cvt_pk_bf16(s[4 * 33], s[5 * 33]); o.w = pg8::cvt_pk_bf16(s[6 * 33], s[7 * 33]);
        *(v4u*)(WT + (size_t)(rb + n) * K + k0 + 8 * c) = o; }
    LDS_WAIT(); asm volatile("" ::: "memory");
}
__device__ __forceinline__ void ln_row(const float* src, const float* g, const float* b, float* dstf, bf16* dstb, float* dst2, int lane) {
    f4 v[8]; float s = 0.f;
#pragma unroll
    for (int j = 0; j < 8; ++j) { v[j] = *(const f4*)(src + 4 * (lane + 64 * j)); s += (v[j].x + v[j].y) + (v[j].z + v[j].w); }
    const float mean = wave_sum(s) * (1.f / DM); float s2 = 0.f;
#pragma unroll
    for (int j = 0; j < 8; ++j) { v[j] = v[j] - mean; s2 += (v[j].x * v[j].x + v[j].y * v[j].y) + (v[j].z * v[j].z + v[j].w * v[j].w); }
    const float rstd = 1.0f / sqrtf(wave_sum(s2) * (1.f / DM) + LN_EPS);
#pragma unroll
    for (int j = 0; j < 8; ++j) { const int c = 4 * (lane + 64 * j); const f4 gg = *(const f4*)(g + c), bb = *(const f4*)(b + c); const f4 o = v[j] * rstd * gg + bb;
        *(f4*)(dstf + c) = o; if (dst2) *(f4*)(dst2 + c) = o;
        u2 w; w.x = pg8::cvt_pk_bf16(o.x, o.y); w.y = pg8::cvt_pk_bf16(o.z, o.w); *(u2*)(dstb + c) = w; }
}
__device__ __forceinline__ void phase_prologue(ArgsP a, LAS unsigned char* lds, int lane, int wave, int blk, int G) {
    LAS float* scr = (LAS float*)(lds + wave * 16384);
    const int gw = blk * NWAVES + wave, NGW = G * NWAVES;
    constexpr int I_IN = 32 * (PIN / 32), I_OUT = 32 * (DM / 32), I_G = 32 * (DFF / 32), I_D = (DFF / 64) * (DM / 32), I_PGc = I_OUT, I_PPc = (DPLE / 64) * (DM / 32);
    constexpr int PER_L = I_IN + I_OUT + 2 * I_G + I_D + I_PGc + I_PPc;
    unsigned char* ws = a->ws;
    for (int it = gw; it < DEPTH * PER_L; it += NGW) {
        const int L = it / PER_L; int r = it - L * PER_L;
        if (r < I_IN) { tr_item(a->in[I_WIN] + (size_t)L * DM * PIN, DM, PIN, (bf16*)(ws + wso(WS_WIN) + L * SZ_WIN), 0, scr, r, lane); continue; } r -= I_IN;
        if (r < I_OUT) { tr_item(a->in[I_WOUT] + (size_t)L * DM * DM, DM, DM, (bf16*)(ws + wso(WS_WOUT) + L * SZ_WOUT), 0, scr, r, lane); continue; } r -= I_OUT;
        if (r < I_G) { tr_item(a->in[I_WG] + (size_t)L * DM * DFF, DM, DFF, (bf16*)(ws + wso(WS_WGU) + L * SZ_WGU), 1, scr, r, lane); continue; } r -= I_G;
        if (r < I_G) { tr_item(a->in[I_WU] + (size_t)L * DM * DFF, DM, DFF, (bf16*)(ws + wso(WS_WGU) + L * SZ_WGU), 2, scr, r, lane); continue; } r -= I_G;
        if (r < I_D) { tr_item(a->in[I_WD] + (size_t)L * DFF * DM, DFF, DM, (bf16*)(ws + wso(WS_WD) + L * SZ_WD), 0, scr, r, lane); continue; } r -= I_D;
        if (r < I_PGc) { tr_item(a->in[I_WPG] + (size_t)L * DM * DM, DM, DM, (bf16*)(ws + wso(WS_WPG) + L * SZ_WPG), 0, scr, r, lane); continue; } r -= I_PGc;
        tr_item(a->in[I_WPP] + (size_t)L * DPLE * DM, DPLE, DM, (bf16*)(ws + wso(WS_WPP) + L * SZ_WPP), 0, scr, r, lane);
    }
    for (int it = gw; it < DEPTH * NLORA; it += NGW) { const int L = it / NLORA, n = it - L * NLORA; float v[4];
#pragma unroll
        for (int e = 0; e < 4; ++e) { const int k = 4 * lane + e; float x = 0.f;
            if (n < WB) { if (k < 64) x = a->in[I_BWUP][((size_t)L * 64 + k) * WB + n]; }
            else if (n < 2 * WB) { if (k >= 64 && k < 128) x = a->in[I_BAUP][((size_t)L * 64 + (k - 64)) * WB + (n - WB)]; }
            else { if (k >= 128) x = a->in[I_BGUP][((size_t)L * 128 + (k - 128)) * WB + (n - 2 * WB)]; }
            v[e] = x; }
        u2 w; w.x = pg8::cvt_pk_bf16(v[0], v[1]); w.y = pg8::cvt_pk_bf16(v[2], v[3]); *(u2*)((bf16*)(ws + wso(WS_WL) + L * SZ_WL) + (size_t)n * 256 + 4 * lane) = w; }
    for (int it = gw; it < DEPTH * MV; it += NGW) { const int L = it / MV, m = it - L * MV;
        const float* src = (m < MP) ? a->in[I_PP] + ((size_t)L * MP + m) * DPLE : a->in[I_PS] + ((size_t)L * NS + (m - MP)) * DPLE;
        const f4 v = *(const f4*)(src + 4 * lane); u2 w; w.x = pg8::cvt_pk_bf16(v.x, v.y); w.y = pg8::cvt_pk_bf16(v.z, v.w);
        *(u2*)((bf16*)(ws + wso(WS_PBF) + L * SZ_PBF) + (size_t)m * DPLE + 4 * lane) = w; }
    for (int m = gw; m < MV; m += NGW) { const float* src = (m < MP) ? a->in[I_XP] + (size_t)m * DM : a->in[I_XS] + (size_t)(m - MP) * DM;
        ln_row(src, a->in[I_LNING], a->in[I_LNINB], (float*)(ws + wso(WS_H)) + (size_t)m * DM, (bf16*)(ws + wso(WS_HB)) + (size_t)m * DM, nullptr, lane); }
}
__device__ __forceinline__ void phase_ln(ArgsP a, const float* g, const float* b, bool last, int lane, int wave, int blk, int G) {
    const int gw = blk * NWAVES + wave, NGW = G * NWAVES; unsigned char* ws = a->ws;
    for (int m = gw; m < MV; m += NGW)
        ln_row((const float*)(ws + wso(WS_T)) + (size_t)m * DM, g, b, (float*)(ws + wso(WS_H)) + (size_t)m * DM, (bf16*)(ws + wso(WS_HB)) + (size_t)m * DM,
               last ? a->out + (m < MP ? O_YP + (size_t)m * DM : O_YS + (size_t)(m - MP) * DM) : nullptr, lane);
}


__device__ __forceinline__ void phase_xc(ArgsP a, int L, int lane, int wave, int blk, int G) {
    unsigned char* ws = a->ws; const int gw = blk * NWAVES + wave, NGW = G * NWAVES;
    const float* Z = (const float*)(ws + wso(WS_Z));
    const float* mu = a->in[I_BMU] + L * PBW; const float* sh0 = a->in[I_SSHIFT] + (size_t)L * NS * PBW;
    const f4 mu4 = *(const f4*)(mu + 2304 + 4 * lane);
    for (int m = gw; m < MV; m += NGW) {
        const bool samp = m >= MP; const float* zr = Z + (size_t)m * PIN + OFF_B;
        const f4 cur = *(const f4*)(zr + 2304 + 4 * lane); f4 prev;
        if (samp) prev = *(const f4*)(sh0 + (size_t)(m - MP) * PBW + 2304 + 4 * lane); else if (m & (SEQ - 1)) prev = *(const f4*)(zr - PIN + 2304 + 4 * lane); else prev = (f4){0.f, 0.f, 0.f, 0.f};
        f4 x = cur + mu4 * (prev - cur);
        if (lane < 16) { x.x = tanhf(x.x); x.y = tanhf(x.y); x.z = tanhf(x.z); x.w = tanhf(x.w); }
        else if (lane >= 32) { x.x = sigmoidf_(x.x); x.y = sigmoidf_(x.y); x.z = sigmoidf_(x.z); x.w = sigmoidf_(x.w); }
        u2 w; w.x = pg8::cvt_pk_bf16(x.x, x.y); w.y = pg8::cvt_pk_bf16(x.z, x.w); *(u2*)((bf16*)(ws + wso(WS_XCAT)) + (size_t)m * 256 + 4 * lane) = w;
        if (samp || (m & (SEQ - 1)) == SEQ - 1) { float* dst = samp ? a->out + O_SS + ((size_t)L * NS + (m - MP)) * PBW : a->out + O_SP + ((size_t)L * NBAT + (m >> 11)) * PBW;
#pragma unroll
            for (int j = 0; j < PBW / 256; ++j) *(f4*)(dst + 256 * j + 4 * lane) = *(const f4*)(zr + 256 * j + 4 * lane); }
        if (samp) { const int i = m - MP; const float* z0 = Z + (size_t)m * PIN; const float* lng = a->in[I_ALNG] + L * WA; const float* lnb = a->in[I_ALNB] + L * WA;
            for (int g = 0; g < 4; ++g) {
                const float u0 = gelu_erf(z0[g * 128 + lane]), u1 = gelu_erf(z0[g * 128 + 64 + lane]);
                const float v0 = gelu_erf(z0[WA + g * 128 + lane]), v1 = gelu_erf(z0[WA + g * 128 + 64 + lane]);
                const float mean = wave_sum(v0 + v1) * (1.f / 128.f); const float d0 = v0 - mean, d1 = v1 - mean;
                const float rstd = 1.0f / sqrtf(wave_sum(d0 * d0 + d1 * d1) * (1.f / 128.f) + LN_EPS);
                const float n0 = d0 * rstd * lng[g * 128 + lane] + lnb[g * 128 + lane], n1 = d1 * rstd * lng[g * 128 + 64 + lane] + lnb[g * 128 + 64 + lane];
                float* ov = a->out + O_VS + ((size_t)L * NS + i) * WA + g * 128; ov[lane] = n0; ov[64 + lane] = n1;
                const float w00 = a->in[I_AWS][(size_t)(L * 4 + g) * 16384], b0 = a->in[I_ABS][(L * 4 + g) * 128];
                bf16* yo = (bf16*)(ws + wso(WS_YMIX)) + (size_t)m * DM + g * 128; yo[lane] = bf1(u0 * (w00 * n0 + b0)); yo[64 + lane] = bf1(u1 * (w00 * n1 + b0)); } }
    }
}
__device__ __forceinline__ void phase_fin(ArgsP a, int L, int lane, int wave, int blk, int G) {
    unsigned char* ws = a->ws; const int gw = blk * NWAVES + wave, NGW = G * NWAVES;
    const float* Z = (const float*)(ws + wso(WS_Z)); const float* LO = (const float*)(ws + wso(WS_LORA));
    const float* mu = a->in[I_BMU] + L * PBW; const float* w0 = a->in[I_BW0] + L * WB; const float* a0 = a->in[I_BA0] + L * WB;
    const float* k_k = a->in[I_BKK] + L * WB; const float* k_a = a->in[I_BKA] + L * WB; const float* sh0 = a->in[I_SSHIFT] + (size_t)L * NS * PBW;
    for (int m = MP + gw; m < MV; m += NGW) {
        const bool samp = m >= MP; const float* zr = Z + (size_t)m * PIN + OFF_B; const float* lo = LO + (size_t)m * NLORA;
        const float* pz = samp ? sh0 + (size_t)(m - MP) * PBW : zr - PIN; const bool first = !samp && (m & (SEQ - 1)) == 0;
#pragma unroll 4
        for (int j = 0; j < 12; ++j) { const int c = 64 * j + lane;
            const float cr = zr[c], ck = zr[WB + c], cv = zr[2 * WB + c];
            float pr = 0.f, pk = 0.f, pv = 0.f; if (!first) { pr = pz[c]; pk = pz[WB + c]; pv = pz[2 * WB + c]; }
            const float r = cr + mu[c] * (pr - cr), k = ck + mu[WB + c] * (pk - ck), v = cv + mu[2 * WB + c] * (pv - cv);
            const float dec = __expf(-0.6065306597126334f * sigmoidf_(w0[c] + lo[c]));
            const float av = sigmoidf_(a0[c] + lo[WB + c]);
            const float kkr = k * k_k[c]; const float ss = wave_sum(kkr * kkr); const float kk = kkr / fmaxf(sqrtf(ss), 1e-12f);
            const float kp = k * (1.0f + (av - 1.0f) * k_a[c]);
            float* rec = samp ? (float*)(ws + wso(WS_RPS)) + ((size_t)(m - MP) * 12 + j) * 384 : (float*)(ws + wso(WS_RPB)) + (((size_t)(m >> 11) * 12 + j) * SEQ + (m & (SEQ - 1))) * 384;
            rec[lane] = r; rec[64 + lane] = dec; rec[128 + lane] = kp; rec[192 + lane] = v; rec[256 + lane] = kk; rec[320 + lane] = kk * av; }
    }
}

__device__ __forceinline__ void rwkv_scan_unit(ArgsP a, int L, int unit, LAS unsigned char* lds, int tid, int lane, int wave) {
    unsigned char* ws = a->ws;
    const int bh = unit >> 1, half = unit & 1, b = bh / 12, h = bh - b * 12;
    const f4* rec4 = (const f4*)((const float*)(ws + wso(WS_RPB)) + (size_t)bh * SEQ * 384);
    LAS float* buf = (LAS float*)lds;
    LAS float* ybuf = (LAS float*)(lds + 49152);
    const int rowl = wave * 4 + (lane >> 4), kg = lane & 15, row = half * 32 + rowl;
    float S0 = 0.f, S1 = 0.f, S2 = 0.f, S3 = 0.f;
    f4 st0, st1, st2;
    __syncthreads();
    st0 = rec4[tid]; st1 = rec4[512 + tid]; st2 = rec4[1024 + tid];
    *(LAS f4*)(buf + 4 * tid) = st0; *(LAS f4*)(buf + 4 * (512 + tid)) = st1; *(LAS f4*)(buf + 4 * (1024 + tid)) = st2;
    __syncthreads();
    float* Y = (float*)(ws + wso(WS_Y));
    for (int c = 0; c < SEQ / 16; ++c) {
        if (c + 1 < SEQ / 16) { const f4* nx = rec4 + (size_t)(c + 1) * 1536; st0 = nx[tid]; st1 = nx[512 + tid]; st2 = nx[1024 + tid]; }
        const LAS float* cur = buf + (c & 1) * 6144; LAS float* yb = ybuf + (c & 1) * 512;
        f4 r4 = *(const LAS f4*)(cur + 4 * kg), w4 = *(const LAS f4*)(cur + 64 + 4 * kg), k4 = *(const LAS f4*)(cur + 128 + 4 * kg),
           kk4 = *(const LAS f4*)(cur + 256 + 4 * kg), ka4 = *(const LAS f4*)(cur + 320 + 4 * kg); float v = cur[192 + row];
#pragma unroll
        for (int s = 0; s < 16; ++s) {
            const LAS float* R = cur + (s < 15 ? s + 1 : 15) * 384;
            const f4 nr4 = *(const LAS f4*)(R + 4 * kg), nw4 = *(const LAS f4*)(R + 64 + 4 * kg), nk4 = *(const LAS f4*)(R + 128 + 4 * kg),
                     nkk4 = *(const LAS f4*)(R + 256 + 4 * kg), nka4 = *(const LAS f4*)(R + 320 + 4 * kg);
            const float nv = R[192 + row];
            float sa = (S0 * kk4.x + S1 * kk4.y) + (S2 * kk4.z + S3 * kk4.w);
            sa = row16_sum(sa);
            S0 = S0 * w4.x + (v * k4.x - sa * ka4.x); S1 = S1 * w4.y + (v * k4.y - sa * ka4.y);
            S2 = S2 * w4.z + (v * k4.z - sa * ka4.z); S3 = S3 * w4.w + (v * k4.w - sa * ka4.w);
            float y = (S0 * r4.x + S1 * r4.y) + (S2 * r4.z + S3 * r4.w);
            y = row16_sum(y);
            if (kg == 0) yb[s * 32 + rowl] = y;
            r4 = nr4; w4 = nw4; k4 = nk4; kk4 = nkk4; ka4 = nka4; v = nv;
        }
        if (c + 1 < SEQ / 16) { LAS float* nb = buf + ((c + 1) & 1) * 6144;
            *(LAS f4*)(nb + 4 * tid) = st0; *(LAS f4*)(nb + 4 * (512 + tid)) = st1; *(LAS f4*)(nb + 4 * (1024 + tid)) = st2; }
        __syncthreads();
        { const int s = tid >> 5, rl = tid & 31; Y[((size_t)b * SEQ + c * 16 + s) * WB + h * 64 + half * 32 + rl] = yb[tid]; }
    }
    f4 so; so.x = S0; so.y = S1; so.z = S2; so.w = S3;
    *(f4*)(a->out + O_RP + ((((size_t)L * NBAT + b) * 12 + h) * 64 + row) * 64 + 4 * kg) = so;
    __syncthreads();
}
__device__ __forceinline__ void rwkv_sample_item(ArgsP a, int L, int item, LAS unsigned char* lds, int lane, int wave) {
    unsigned char* ws = a->ws;
    const int ih = item * 8 + wave, i = ih / 12, h = ih - i * 12;
    const float* rec = (const float*)(ws + wso(WS_RPS)) + (size_t)ih * 384;
    LAS float* sc = (LAS float*)(lds + wave * 2048);
    const float r = rec[lane], w = rec[64 + lane], k = rec[128 + lane], v = rec[192 + lane], kk = rec[256 + lane], ka = rec[320 + lane];
    sc[lane] = r; sc[64 + lane] = w; sc[128 + lane] = k; sc[192 + lane] = kk; sc[256 + lane] = ka;
    LDS_WAIT(); asm volatile("" ::: "memory");
    const f4* S0p = (const f4*)(a->in[I_SRWKV] + (((size_t)L * NS + i) * 12 + h) * 4096 + lane * 64);
    f4 S[16];
#pragma unroll
    for (int j = 0; j < 16; ++j) S[j] = S0p[j];
    float sa = 0.f;
#pragma unroll
    for (int j = 0; j < 16; ++j) { const f4 q = *(const LAS f4*)(sc + 192 + 4 * j); sa += (S[j].x * q.x + S[j].y * q.y) + (S[j].z * q.z + S[j].w * q.w); }
    float y = 0.f;
    f4* So = (f4*)(a->out + O_RS + (((size_t)L * NS + i) * 12 + h) * 4096 + lane * 64);
#pragma unroll
    for (int j = 0; j < 16; ++j) { const f4 w4 = *(const LAS f4*)(sc + 64 + 4 * j), k4 = *(const LAS f4*)(sc + 128 + 4 * j), a4 = *(const LAS f4*)(sc + 256 + 4 * j), r4 = *(const LAS f4*)(sc + 4 * j);
        f4 n = S[j] * w4 + (k4 * v - a4 * sa); So[j] = n; y += (n.x * r4.x + n.y * r4.y) + (n.z * r4.z + n.w * r4.w); }
    ((float*)(ws + wso(WS_Y)))[(size_t)(MP + i) * WB + h * 64 + lane] = y;
    LDS_WAIT(); asm volatile("" ::: "memory");
}
__device__ __forceinline__ void hgrn_sample_item(ArgsP a, int L, int item, LAS unsigned char* lds, int lane, int wave) {
    unsigned char* ws = a->ws;
    const int ih = item * 4 + (wave >> 1), i = ih / 6, h = ih - i * 6, vcol = (wave & 1) * 64 + lane, m = MP + i;
    const float* zc = (const float*)(ws + wso(WS_Z)) + (size_t)m * PIN + OFF_C + h * 128;
    LAS float* sc = (LAS float*)(lds + wave * 2048);
#pragma unroll
    for (int t = 0; t < 2; ++t) { const int k = lane + 64 * t; const float lb = lbound(a->in[I_CLB], L, h * 128 + k); const float fz = zc[WC + k];
        const float sg = sigmoidf_(fz); sc[k] = lb + (1.0f - lb) * sg; sc[128 + k] = (1.0f - lb) * (1.0f - sg) ; sc[256 + k] = zc[k]; }
    const float iv = zc[2 * WC + vcol];
    LDS_WAIT(); asm volatile("" ::: "memory");
    const float* S0 = a->in[I_SHGRN] + (((size_t)L * NS + i) * 6 + h) * 16384 + vcol;
    float* So = a->out + O_HS + (((size_t)L * NS + i) * 6 + h) * 16384 + vcol;
    float o = 0.f;
#pragma unroll 8
    for (int k = 0; k < 128; ++k) { const float n = sc[k] * S0[(size_t)k * 128] + sc[128 + k] * iv; So[(size_t)k * 128] = n; o += n * sc[256 + k]; }
    ((float*)(ws + wso(WS_O)))[(size_t)m * WC + h * 128 + vcol] = o;
    LDS_WAIT(); asm volatile("" ::: "memory");
}
__device__ __forceinline__ void sgu_item(ArgsP a, int L, int item, LAS unsigned char* lds, int tid, int lane, int wave) {
    unsigned char* ws = a->ws;
    const int g = item & 3, bc = item >> 2, m0 = bc * 128;
    const float* Z = (const float*)(ws + wso(WS_Z));
    LAS float* vn = (LAS float*)lds;
    LAS float* wt = (LAS float*)(lds + 65536);
    const float* wsrc = a->in[I_AWS] + (size_t)(L * 4 + g) * 16384;
    __syncthreads();
    for (int e = tid; e < 16384; e += NTHR) { const int t = e >> 7, s = e & 127; wt[s * 128 + t] = (s <= t) ? wsrc[e] : 0.f; }
    const float* lng = a->in[I_ALNG] + L * WA + g * 128; const float* lnb = a->in[I_ALNB] + L * WA + g * 128;
    for (int rr = 0; rr < 16; ++rr) { const int t = wave * 16 + rr; const float* zr = Z + (size_t)(m0 + t) * PIN + WA + g * 128;
        const float v0 = gelu_erf(zr[lane]), v1 = gelu_erf(zr[64 + lane]);
        const float mean = wave_sum(v0 + v1) * (1.f / 128.f); const float d0 = v0 - mean, d1 = v1 - mean;
        const float rstd = 1.0f / sqrtf(wave_sum(d0 * d0 + d1 * d1) * (1.f / 128.f) + LN_EPS);
        vn[t * 128 + lane] = d0 * rstd * lng[lane] + lnb[lane]; vn[t * 128 + 64 + lane] = d1 * rstd * lng[64 + lane] + lnb[64 + lane]; }
    __syncthreads();
    const int t = tid >> 2, dq = tid & 3, send = (wave * 16 + 15);
    f4 acc[8];
#pragma unroll
    for (int j = 0; j < 8; ++j) acc[j] = (f4){0.f, 0.f, 0.f, 0.f};
    for (int s = 0; s <= send; ++s) { const float w = wt[s * 128 + t]; const LAS f4* vr = (const LAS f4*)(vn + s * 128 + dq * 32);
#pragma unroll
        for (int j = 0; j < 8; ++j) acc[j] += vr[j] * w; }
    const float bs = a->in[I_ABS][(L * 4 + g) * 128 + t];
    const float* ur = Z + (size_t)(m0 + t) * PIN + g * 128 + dq * 32;
    bf16* yo = (bf16*)(ws + wso(WS_YMIX)) + (size_t)(m0 + t) * DM + g * 128 + dq * 32;
#pragma unroll
    for (int j = 0; j < 4; ++j) { const f4 u0 = *(const f4*)(ur + 8 * j), u1 = *(const f4*)(ur + 8 * j + 4); const f4 x0 = acc[2 * j] + bs, x1 = acc[2 * j + 1] + bs; v4u o;
        o.x = pg8::cvt_pk_bf16(gelu_erf(u0.x) * x0.x, gelu_erf(u0.y) * x0.y); o.y = pg8::cvt_pk_bf16(gelu_erf(u0.z) * x0.z, gelu_erf(u0.w) * x0.w);
        o.z = pg8::cvt_pk_bf16(gelu_erf(u1.x) * x1.x, gelu_erf(u1.y) * x1.y); o.w = pg8::cvt_pk_bf16(gelu_erf(u1.z) * x1.z, gelu_erf(u1.w) * x1.w);
        *(v4u*)(yo + 8 * j) = o; }
}

__device__ __forceinline__ void hgrn_seq_unit(ArgsP a, int L, int unit, LAS unsigned char* lds, int tid, int lane, int wave) {
    unsigned char* ws = a->ws;
    const int b = unit / 6, h = unit - b * 6;
    const float* Z = (const float*)(ws + wso(WS_Z));
    LAS bf16* qs = (LAS bf16*)(lds);
    LAS bf16* ks = (LAS bf16*)(lds + 4352);
    LAS bf16* vt = (LAS bf16*)(lds + 8704);
    LAS bf16* kht = (LAS bf16*)(lds + 12800);
    LAS float* ev = (LAS float*)(lds + 16896);
    LAS float* part = (LAS float*)(lds + 17408);
    const int ch = tid & 127, tq = tid >> 7;
    const float lb = lbound(a->in[I_CLB], L, h * 128 + ch), oml = 1.0f - lb;
    const int pch = (ch & ~31) | (((ch >> 2) & 3) << 3) | (((ch >> 4) & 1) << 2) | (ch & 3);
    const int x = lane & 15, quad = lane >> 4;
    pg8::f32x4 Sacc[8];
#pragma unroll
    for (int mt = 0; mt < 8; ++mt) Sacc[mt] = (pg8::f32x4){0.f, 0.f, 0.f, 0.f};
    const float* zb = Z + (size_t)(b * SEQ + 4 * tq) * PIN + OFF_C + h * 128 + ch;
    float qn[4], fn[4], vn_[4];
#pragma unroll
    for (int j = 0; j < 4; ++j) { const float* p = zb + (size_t)j * PIN; qn[j] = p[0]; fn[j] = p[WC]; vn_[j] = p[2 * WC]; }
    float* O = (float*)(ws + wso(WS_O));
    __syncthreads();
    for (int st = 0; st < SEQ / 16; ++st) {
        float q[4], fz[4], iv[4];
#pragma unroll
        for (int j = 0; j < 4; ++j) { q[j] = qn[j]; fz[j] = fn[j]; iv[j] = vn_[j]; }
        if (st + 1 < SEQ / 16) {
#pragma unroll
            for (int j = 0; j < 4; ++j) { const float* p = zb + (size_t)((st + 1) * 16 + j) * PIN; qn[j] = p[0]; fn[j] = p[WC]; vn_[j] = p[2 * WC]; } }
        float bl[4], kv[4]; float run = 0.f;
#pragma unroll
        for (int j = 0; j < 4; ++j) { const float e = __expf(-fmaxf(fz[j], -80.f)), sg = __builtin_amdgcn_rcpf(1.0f + e);
            run += __logf(lb + oml * sg); bl[j] = run; kv[j] = oml * e * sg; }
        part[tq * 128 + ch] = run;
        asm volatile("s_waitcnt lgkmcnt(0)" ::: "memory"); __builtin_amdgcn_s_barrier(); asm volatile("" ::: "memory");
        const float p0 = part[ch], p1 = part[128 + ch], p2 = part[256 + ch], p3 = part[384 + ch];
        const float tot = (p0 + p1) + (p2 + p3); const float pre = (tq > 0 ? p0 : 0.f) + (tq > 1 ? p1 : 0.f) + (tq > 2 ? p2 : 0.f);
        float kh[4];
#pragma unroll
        for (int j = 0; j < 4; ++j) { const float bj = pre + bl[j]; const int t = 4 * tq + j;
            qs[t * 136 + pch] = bf1(q[j] * __expf(bj)); ks[t * 136 + pch] = bf1(kv[j] * __expf(fminf(-bj, 60.f))); kh[j] = kv[j] * __expf(tot - bj); }
        { u2 w; w.x = cvt_pk_bf16_c(kh[0], kh[1]); w.y = cvt_pk_bf16_c(kh[2], kh[3]); *(LAS u2*)(kht + ch * 16 + 4 * tq) = w;
          w.x = cvt_pk_bf16_c(iv[0], iv[1]); w.y = cvt_pk_bf16_c(iv[2], iv[3]); *(LAS u2*)(vt + ch * 16 + 4 * tq) = w; }
        if (tq == 0) ev[ch] = __expf(tot);
        asm volatile("s_waitcnt lgkmcnt(0)" ::: "memory"); __builtin_amdgcn_s_barrier(); asm volatile("" ::: "memory");
        bf16x8 qf[4], kf[4];
#pragma unroll
        for (int kt = 0; kt < 4; ++kt) { qf[kt] = *(const LAS bf16x8*)(qs + x * 136 + 32 * kt + 8 * quad); kf[kt] = *(const LAS bf16x8*)(ks + x * 136 + 32 * kt + 8 * quad); }
        pg8::f32x4 att = (pg8::f32x4){0.f, 0.f, 0.f, 0.f};
#pragma unroll
        for (int kt = 0; kt < 4; ++kt) att = __builtin_amdgcn_mfma_f32_16x16x32_bf16(kf[kt], qf[kt], att, 0, 0, 0);
#pragma unroll
        for (int i = 0; i < 4; ++i) if (4 * quad + i > x) att[i] = 0.f;
        v4u pbu; pbu.x = cvt_pk_bf16_c(att[0], att[1]); pbu.y = cvt_pk_bf16_c(att[2], att[3]); pbu.z = 0u; pbu.w = 0u;
        const bf16x8 pb = __builtin_bit_cast(bf16x8, pbu);
        const u2 vv = *(const LAS u2*)(vt + (16 * wave + x) * 16 + 4 * quad);
        v4u vfu; vfu.x = vv.x; vfu.y = vv.y; vfu.z = 0u; vfu.w = 0u; const bf16x8 vf = __builtin_bit_cast(bf16x8, vfu);
        pg8::f32x4 o = (pg8::f32x4){0.f, 0.f, 0.f, 0.f};
#pragma unroll
        for (int kt = 0; kt < 4; ++kt) { v4u su; su.x = cvt_pk_bf16_c(Sacc[2 * kt][0], Sacc[2 * kt][1]); su.y = cvt_pk_bf16_c(Sacc[2 * kt][2], Sacc[2 * kt][3]);
            su.z = cvt_pk_bf16_c(Sacc[2 * kt + 1][0], Sacc[2 * kt + 1][1]); su.w = cvt_pk_bf16_c(Sacc[2 * kt + 1][2], Sacc[2 * kt + 1][3]);
            o = __builtin_amdgcn_mfma_f32_16x16x32_bf16(__builtin_bit_cast(bf16x8, su), qf[kt], o, 0, 0, 0); }
        o = __builtin_amdgcn_mfma_f32_16x16x32_bf16(vf, pb, o, 0, 0, 0);
        *(pg8::f32x4*)(O + (size_t)(b * SEQ + st * 16 + x) * WC + h * 128 + 16 * wave + 4 * quad) = o;
#pragma unroll
        for (int mt = 0; mt < 8; ++mt) { const pg8::f32x4 e4 = *(const LAS pg8::f32x4*)(ev + 16 * mt + 4 * quad);
            const u2 kk2 = *(const LAS u2*)(kht + (16 * mt + x) * 16 + 4 * quad); v4u ku; ku.x = kk2.x; ku.y = kk2.y; ku.z = 0u; ku.w = 0u;
            Sacc[mt] = __builtin_amdgcn_mfma_f32_16x16x32_bf16(__builtin_bit_cast(bf16x8, ku), vf, Sacc[mt] * e4, 0, 0, 0); }
    }
    float* So = a->out + O_HP + (((size_t)L * NBAT + b) * 6 + h) * 16384;
#pragma unroll
    for (int mt = 0; mt < 8; ++mt)
#pragma unroll
        for (int i = 0; i < 4; ++i) So[(size_t)(16 * mt + 4 * quad + i) * 128 + 16 * wave + x] = Sacc[mt][i];
    __syncthreads();
}

__device__ __forceinline__ void phase_post(ArgsP a, int L, int lane, int wave, int blk, int G) {
    unsigned char* ws = a->ws; const int gw = blk * NWAVES + wave, NGW = G * NWAVES;
    const float* Y = (const float*)(ws + wso(WS_Y)); const float* O = (const float*)(ws + wso(WS_O)); const float* Gt = (const float*)(ws + wso(WS_LORA)) + 2 * WB; const float* Z = (const float*)(ws + wso(WS_Z));
    const float* gng = a->in[I_BGNG] + L * WB; const float* gnb = a->in[I_BGNB] + L * WB; const float* rk = a->in[I_BRK] + L * WB; const float* cng = a->in[I_CNG] + L * WC;
    for (int m = gw; m < MV; m += NGW) {
        bf16* yo = (bf16*)(ws + wso(WS_YMIX)) + (size_t)m * DM;
        float ov[12], gz[12]; float ss = 0.f;
#pragma unroll
        for (int j = 0; j < 12; ++j) { const int c = 64 * j + lane; ov[j] = O[(size_t)m * WC + c]; gz[j] = Z[(size_t)m * PIN + OFF_C + 3 * WC + c]; ss += ov[j] * ov[j]; }
        if (m >= MP) {
            { const float* hr = (const float*)(ws + wso(WS_H)) + (size_t)m * DM; float* tr = (float*)(ws + wso(WS_T)) + (size_t)m * DM;
#pragma unroll
              for (int j = 0; j < 8; ++j) *(f4*)(tr + 4 * (lane + 64 * j)) = *(const f4*)(hr + 4 * (lane + 64 * j)) * DN_ALPHA; }
#pragma unroll
            for (int j = 0; j < 12; ++j) { const int c = 64 * j + lane; const float* rec = (const float*)(ws + wso(WS_RPS)) + ((size_t)(m - MP) * 12 + j) * 384;
                const float y = Y[(size_t)m * WB + c], rr = rec[lane], kp = rec[128 + lane], vv = rec[192 + lane], gg = Gt[(size_t)m * NLORA + c];
                const float mean = wave_sum(y) * (1.f / 64.f); const float d = y - mean; const float rstd = 1.0f / sqrtf(wave_sum(d * d) * (1.f / 64.f) + GN_EPS);
                const float bonus = wave_sum(rr * kp * rk[c]);
                yo[WA + c] = bf1((d * rstd * gng[c] + gnb[c] + bonus * vv) * gg); } }
        const float rms = 1.0f / sqrtf(wave_sum(ss) * (1.f / WC) + RMS_EPS);
#pragma unroll
        for (int j = 0; j < 12; ++j) { const int c = 64 * j + lane; yo[WA + WB + c] = bf1(ov[j] * rms * cng[c] * (gz[j] * sigmoidf_(gz[j]))); }
    }
}

constexpr int REC_BYTES = 16384, RC_GT = 12288, RC_WT = 0, RC_RT = 2048, RC_AHT = 4096, RC_KHT = 6144, RC_VT = 8192, RC_BRA = 10240, RC_BRK = 10752, RC_M2 = 11264, RC_G15 = 11776, RC_BC = 12032;
constexpr int NCHUNK = NBAT * 12 * (SEQ / 16);
static_assert(WS_RPB + (size_t)NCHUNK * REC_BYTES == WS_RPS, "chunk record region");
__device__ __forceinline__ int perm_ch(int ch) { return (ch & ~31) | (((ch >> 2) & 3) << 3) | (((ch >> 4) & 1) << 2) | (ch & 3); }

__device__ __forceinline__ void pre_chunk(ArgsP a, int L, int q, LAS unsigned char* wl, int lane) {
    unsigned char* ws = a->ws;
    const int bh = q >> 7, c = q & 127, b = bh / 12, h = bh - 12 * b, m0 = b * SEQ + c * 16, col = h * 64 + lane;
    const float* Z = (const float*)(ws + wso(WS_Z)) + (size_t)m0 * PIN + OFF_B + col; const float* LO = (const float*)(ws + wso(WS_LORA)) + (size_t)m0 * NLORA + col;
    unsigned char* rec = ws + wso(WS_RPB) + (size_t)q * REC_BYTES;
    LAS float* X0 = (LAS float*)wl;
    LAS float* X1 = (LAS float*)(wl + 4352);
    LAS float* Maa = (LAS float*)(wl + 8704);
    LAS float* Mak = (LAS float*)(wl + 9728);
    LAS bf16* Sm = (LAS bf16*)(wl + 10752);
    LAS bf16* Wim = (LAS bf16*)(wl + 12288);
    const float mur = a->in[I_BMU][L * PBW + col], muk = a->in[I_BMU][L * PBW + WB + col], muv = a->in[I_BMU][L * PBW + 2 * WB + col];
    const float w0c = a->in[I_BW0][L * WB + col], a0c = a->in[I_BA0][L * WB + col], kkc = a->in[I_BKK][L * WB + col], kac = a->in[I_BKA][L * WB + col], rkc = a->in[I_BRK][L * WB + col];
    float cr[16], ck[16], cv[16], lw[16], la[16];
#pragma unroll
    for (int t = 0; t < 16; ++t) { cr[t] = Z[(size_t)t * PIN]; ck[t] = Z[(size_t)t * PIN + WB]; cv[t] = Z[(size_t)t * PIN + 2 * WB]; lw[t] = LO[(size_t)t * NLORA]; la[t] = LO[(size_t)t * NLORA + WB];
        ((bf16*)(rec + RC_GT))[t * 64 + lane] = bf1(LO[(size_t)t * NLORA + 2 * WB]); }
    float pr = 0.f, pk = 0.f, pv = 0.f; if (c) { pr = Z[-(ptrdiff_t)PIN]; pk = Z[-(ptrdiff_t)PIN + WB]; pv = Z[-(ptrdiff_t)PIN + 2 * WB]; }
    float r_[16], k_[16], v_[16], kp_[16], al_[16], g_[16]; float run = 0.f, bcv = 0.f;
#pragma unroll
    for (int t = 0; t < 16; ++t) {
        const float r = cr[t] + mur * (pr - cr[t]), k = ck[t] + muk * (pk - ck[t]), v = cv[t] + muv * (pv - cv[t]); pr = cr[t]; pk = ck[t]; pv = cv[t];
        run += -0.6065306597126334f * __builtin_amdgcn_rcpf(1.0f + __expf(-(w0c + lw[t]))); g_[t] = run;
        const float av = __builtin_amdgcn_rcpf(1.0f + __expf(-(a0c + la[t])));
        const float kkr = k * kkc; const float ss = wave_sum_fast(kkr * kkr); const float kap = kkr / fmaxf(sqrtf(ss), 1e-12f);
        const float kpr = k * (1.0f + (av - 1.0f) * kac);
        const float bc = wave_sum_fast(r * kpr * rkc); if (lane == t) bcv = bc;
        r_[t] = r; k_[t] = kpr; v_[t] = v; kp_[t] = kap; al_[t] = kap * av; }
    const float gl = g_[15];
    { float ah[16], kh[16];
#pragma unroll
      for (int t = 0; t < 16; ++t) { const float ig = __expf(-g_[t]), eg = __expf(gl - g_[t]); X0[t * 68 + lane] = al_[t] * ig; X1[t * 68 + lane] = k_[t] * ig; ah[t] = al_[t] * eg; kh[t] = k_[t] * eg; }
      v4u o0, o1;
      o0.x = cvt_pk_bf16_c(ah[0], ah[1]); o0.y = cvt_pk_bf16_c(ah[2], ah[3]); o0.z = cvt_pk_bf16_c(ah[4], ah[5]); o0.w = cvt_pk_bf16_c(ah[6], ah[7]);
      o1.x = cvt_pk_bf16_c(ah[8], ah[9]); o1.y = cvt_pk_bf16_c(ah[10], ah[11]); o1.z = cvt_pk_bf16_c(ah[12], ah[13]); o1.w = cvt_pk_bf16_c(ah[14], ah[15]);
      *(v4u*)(rec + RC_AHT + lane * 32) = o0; *(v4u*)(rec + RC_AHT + lane * 32 + 16) = o1;
      o0.x = cvt_pk_bf16_c(kh[0], kh[1]); o0.y = cvt_pk_bf16_c(kh[2], kh[3]); o0.z = cvt_pk_bf16_c(kh[4], kh[5]); o0.w = cvt_pk_bf16_c(kh[6], kh[7]);
      o1.x = cvt_pk_bf16_c(kh[8], kh[9]); o1.y = cvt_pk_bf16_c(kh[10], kh[11]); o1.z = cvt_pk_bf16_c(kh[12], kh[13]); o1.w = cvt_pk_bf16_c(kh[14], kh[15]);
      *(v4u*)(rec + RC_KHT + lane * 32) = o0; *(v4u*)(rec + RC_KHT + lane * 32 + 16) = o1;
      o0.x = cvt_pk_bf16_c(v_[0], v_[1]); o0.y = cvt_pk_bf16_c(v_[2], v_[3]); o0.z = cvt_pk_bf16_c(v_[4], v_[5]); o0.w = cvt_pk_bf16_c(v_[6], v_[7]);
      o1.x = cvt_pk_bf16_c(v_[8], v_[9]); o1.y = cvt_pk_bf16_c(v_[10], v_[11]); o1.z = cvt_pk_bf16_c(v_[12], v_[13]); o1.w = cvt_pk_bf16_c(v_[14], v_[15]);
      *(v4u*)(rec + RC_VT + lane * 32) = o0; *(v4u*)(rec + RC_VT + lane * 32 + 16) = o1; }
    LDS_WAIT(); asm volatile("" ::: "memory");
    const int x = lane & 15, kq = lane >> 4;
    f4 ba[4], bk[4];
#pragma unroll
    for (int j = 0; j < 4; ++j) { ba[j] = *(const LAS f4*)(X0 + x * 68 + 16 * kq + 4 * j); bk[j] = *(const LAS f4*)(X1 + x * 68 + 16 * kq + 4 * j); }
    LDS_WAIT(); asm volatile("" ::: "memory");
    float kt[16];
#pragma unroll
    for (int t = 0; t < 16; ++t) { kt[t] = kp_[t] * (t ? __expf(g_[t - 1]) : 1.0f); X0[t * 68 + lane] = kt[t]; X1[t * 68 + lane] = r_[t] * __expf(g_[t]); }
    LDS_WAIT(); asm volatile("" ::: "memory");
    f4 ak[4], ar[4];
#pragma unroll
    for (int j = 0; j < 4; ++j) { ak[j] = *(const LAS f4*)(X0 + x * 68 + 16 * kq + 4 * j); ar[j] = *(const LAS f4*)(X1 + x * 68 + 16 * kq + 4 * j); }
    pg8::f32x4 Gaa = (pg8::f32x4){0.f, 0.f, 0.f, 0.f}, Gak = Gaa, Gra = Gaa, Grk = Gaa;
#pragma unroll
    for (int j = 0; j < 4; ++j)
#pragma unroll
        for (int e = 0; e < 4; ++e) { Gaa = __builtin_amdgcn_mfma_f32_16x16x4f32(ak[j][e], ba[j][e], Gaa, 0, 0, 0); Gak = __builtin_amdgcn_mfma_f32_16x16x4f32(ak[j][e], bk[j][e], Gak, 0, 0, 0);
            Gra = __builtin_amdgcn_mfma_f32_16x16x4f32(ar[j][e], ba[j][e], Gra, 0, 0, 0); Grk = __builtin_amdgcn_mfma_f32_16x16x4f32(ar[j][e], bk[j][e], Grk, 0, 0, 0); }
#pragma unroll
    for (int i = 0; i < 4; ++i) { const int t = 4 * kq + i; const bool sl = x < t, le = x <= t;
        Maa[t * 16 + x] = sl ? Gaa[i] : 0.f; Mak[t * 16 + x] = sl ? Gak[i] : 0.f;
        Sm[t * 16 + x] = bf1(le ? Gra[i] : 0.f); Sm[256 + t * 16 + x] = bf1(le ? Grk[i] : 0.f); }
    LDS_WAIT(); asm volatile("" ::: "memory");
    float xm[16];
#pragma unroll
    for (int t = 0; t < 16; ++t) xm[t] = Mak[t * 16 + x];
#pragma unroll
    for (int t = 1; t < 16; ++t) {
#pragma unroll
        for (int s4 = 0; s4 < (t + 3) / 4; ++s4) { const f4 ar4 = *(const LAS f4*)(Maa + t * 16 + 4 * s4);
#pragma unroll
            for (int e = 0; e < 4; ++e) if (4 * s4 + e < t) { kt[t] -= ar4[e] * kt[4 * s4 + e]; xm[t] -= ar4[e] * xm[4 * s4 + e]; } } }
#pragma unroll
    for (int t = 0; t < 16; ++t) { Wim[t * 64 + perm_ch(lane)] = bf1(-kt[t]); if (lane < 16) Sm[512 + t * 16 + lane] = bf1(-xm[t]); }
    LDS_WAIT(); asm volatile("" ::: "memory");
    *(v4u*)(rec + RC_WT + lane * 16) = *(const LAS v4u*)((LAS unsigned char*)Wim + lane * 16); *(v4u*)(rec + RC_WT + 1024 + lane * 16) = *(const LAS v4u*)((LAS unsigned char*)Wim + 1024 + lane * 16);
    *(v4u*)(rec + RC_BRA + lane * 16) = *(const LAS v4u*)((LAS unsigned char*)Sm + lane * 16); if (lane < 32) *(v4u*)(rec + RC_BRA + 1024 + lane * 16) = *(const LAS v4u*)((LAS unsigned char*)Sm + 1024 + lane * 16);
    LDS_WAIT(); asm volatile("" ::: "memory");
#pragma unroll
    for (int t = 0; t < 16; ++t) Wim[t * 64 + perm_ch(lane)] = bf1(r_[t] * __expf(g_[t]));
    LDS_WAIT(); asm volatile("" ::: "memory");
    *(v4u*)(rec + RC_RT + lane * 16) = *(const LAS v4u*)((LAS unsigned char*)Wim + lane * 16); *(v4u*)(rec + RC_RT + 1024 + lane * 16) = *(const LAS v4u*)((LAS unsigned char*)Wim + 1024 + lane * 16);
    *(float*)(rec + RC_G15 + lane * 4) = __expf(gl); if (lane < 16) *(float*)(rec + RC_BC + lane * 4) = bcv;
    LDS_WAIT(); asm volatile("" ::: "memory");
}

constexpr int HREC_BYTES = 17408, HR_QS = 0, HR_KS = 4352, HR_VT = 8704, HR_KHT = 12800, HR_EV = 16896, NHCHUNK = NBAT * 6 * (SEQ / 16);
__device__ __forceinline__ void hpre_chunk(ArgsP a, int L, int q2, LAS unsigned char* wl, int lane) {
    unsigned char* ws = a->ws;
    const int bh = q2 >> 7, c = q2 & 127, b = bh / 6, h = bh - 6 * b;
    const float* Z = (const float*)(ws + wso(WS_Z)) + (size_t)(b * SEQ + c * 16) * PIN + OFF_C + h * 128 + lane;
    unsigned char* rec = ws + wso(WS_HREC) + (size_t)q2 * HREC_BYTES;
    LAS bf16* qim = (LAS bf16*)wl; LAS bf16* kim = (LAS bf16*)(wl + 4352);
#pragma unroll
    for (int hh = 0; hh < 2; ++hh) { const int ch = lane + 64 * hh; const int pc = perm_ch(ch);
        const float lb = lbound(a->in[I_CLB], L, h * 128 + ch), oml = 1.0f - lb;
        float q[16], fz[16], iv[16];
#pragma unroll
        for (int t = 0; t < 16; ++t) { const float* p = Z + (size_t)t * PIN + 64 * hh; q[t] = p[0]; fz[t] = p[WC]; iv[t] = p[2 * WC]; }
        float bl[16], kv[16]; float run = 0.f;
#pragma unroll
        for (int t = 0; t < 16; ++t) { const float e = __expf(-fmaxf(fz[t], -80.f)), sg = __builtin_amdgcn_rcpf(1.0f + e); run += __logf(lb + oml * sg); bl[t] = run; kv[t] = oml * e * sg; }
        float kh[16];
#pragma unroll
        for (int t = 0; t < 16; ++t) { qim[t * 136 + pc] = bf1(q[t] * __expf(bl[t])); kim[t * 136 + pc] = bf1(kv[t] * __expf(fminf(-bl[t], 60.f))); kh[t] = kv[t] * __expf(run - bl[t]); }
        v4u o0, o1;
        o0.x = cvt_pk_bf16_c(kh[0], kh[1]); o0.y = cvt_pk_bf16_c(kh[2], kh[3]); o0.z = cvt_pk_bf16_c(kh[4], kh[5]); o0.w = cvt_pk_bf16_c(kh[6], kh[7]);
        o1.x = cvt_pk_bf16_c(kh[8], kh[9]); o1.y = cvt_pk_bf16_c(kh[10], kh[11]); o1.z = cvt_pk_bf16_c(kh[12], kh[13]); o1.w = cvt_pk_bf16_c(kh[14], kh[15]);
        *(v4u*)(rec + HR_KHT + ch * 32) = o0; *(v4u*)(rec + HR_KHT + ch * 32 + 16) = o1;
        o0.x = cvt_pk_bf16_c(iv[0], iv[1]); o0.y = cvt_pk_bf16_c(iv[2], iv[3]); o0.z = cvt_pk_bf16_c(iv[4], iv[5]); o0.w = cvt_pk_bf16_c(iv[6], iv[7]);
        o1.x = cvt_pk_bf16_c(iv[8], iv[9]); o1.y = cvt_pk_bf16_c(iv[10], iv[11]); o1.z = cvt_pk_bf16_c(iv[12], iv[13]); o1.w = cvt_pk_bf16_c(iv[14], iv[15]);
        *(v4u*)(rec + HR_VT + ch * 32) = o0; *(v4u*)(rec + HR_VT + ch * 32 + 16) = o1;
        *(float*)(rec + HR_EV + ch * 4) = __expf(run); }
    LDS_WAIT(); asm volatile("" ::: "memory");
#pragma unroll
    for (int j = 0; j < 9; ++j) { const int o = (j * 64 + lane) * 16; if (o < 8704) *(v4u*)(rec + o) = *(const LAS v4u*)(wl + o); }
    LDS_WAIT(); asm volatile("" ::: "memory");
}
__device__ __forceinline__ void hgrn_stream_unit(ArgsP a, int L, int unit, LAS unsigned char* lds, int lane, int wave) {
    unsigned char* ws = a->ws;
    const int bh = unit >> 1, half = unit & 1, b = bh / 6, h = bh - b * 6;
    const unsigned char* recs = ws + wso(WS_HREC) + (size_t)bh * 128 * HREC_BYTES;
    const int x = lane & 15, quad = lane >> 4, vbase = 64 * half + 16 * (wave & 3);
    constexpr int AHEAD = 4, NCH = SEQ / 16;
#define HG_DMA(cc) do { const unsigned char* g_ = recs + (size_t)(cc) * HREC_BYTES + (wave - 4) * 1024 + lane * 16; LAS unsigned char* l_ = lds + ((cc) % 6) * HREC_BYTES + (wave - 4) * 1024; \
        _Pragma("unroll") for (int j_ = 0; j_ < 4; ++j_) __builtin_amdgcn_global_load_lds((const unsigned*)(g_ + 4096 * j_), (LAS unsigned*)(l_ + 4096 * j_), 16, 0, 0); \
        if (wave == 4) __builtin_amdgcn_global_load_lds((const unsigned*)(g_ + 16384), (LAS unsigned*)(l_ + 16384), 16, 0, 0); } while (0)
    asm volatile("s_waitcnt vmcnt(0) lgkmcnt(0)" ::: "memory"); __builtin_amdgcn_s_barrier(); asm volatile("" ::: "memory");
    pg8::f32x4 Sacc[8];
#pragma unroll
    for (int mt = 0; mt < 8; ++mt) Sacc[mt] = (pg8::f32x4){0.f, 0.f, 0.f, 0.f};
    if (wave >= 4) {
#pragma unroll
        for (int cc = 0; cc < AHEAD; ++cc) HG_DMA(cc);
        if (wave == 4) asm volatile("s_waitcnt vmcnt(15)" ::: "memory"); else asm volatile("s_waitcnt vmcnt(12)" ::: "memory");
    }
    __builtin_amdgcn_s_barrier(); asm volatile("" ::: "memory");
    float* O = (float*)(ws + wso(WS_O)) + (size_t)(b * SEQ) * WC + h * 128 + vbase + 4 * quad;
    for (int st = 0; st < NCH; ++st) {
        if (wave >= 4) {
            if (st + AHEAD < NCH) { HG_DMA(st + AHEAD); if (wave == 4) asm volatile("s_waitcnt vmcnt(15)" ::: "memory"); else asm volatile("s_waitcnt vmcnt(12)" ::: "memory"); }
            else asm volatile("s_waitcnt vmcnt(0)" ::: "memory");
        } else {
        const LAS unsigned char* S = lds + (st % 6) * HREC_BYTES;
        const LAS bf16* qs = (const LAS bf16*)(S + HR_QS); const LAS bf16* ks = (const LAS bf16*)(S + HR_KS); const LAS bf16* vt = (const LAS bf16*)(S + HR_VT);
        const LAS bf16* kht = (const LAS bf16*)(S + HR_KHT); const LAS float* ev = (const LAS float*)(S + HR_EV);
        bf16x8 qf[4], kf[4];
#pragma unroll
        for (int kt = 0; kt < 4; ++kt) { qf[kt] = *(const LAS bf16x8*)(qs + x * 136 + 32 * kt + 8 * quad); kf[kt] = *(const LAS bf16x8*)(ks + x * 136 + 32 * kt + 8 * quad); }
        pg8::f32x4 att = (pg8::f32x4){0.f, 0.f, 0.f, 0.f};
#pragma unroll
        for (int kt = 0; kt < 4; ++kt) att = __builtin_amdgcn_mfma_f32_16x16x32_bf16(kf[kt], qf[kt], att, 0, 0, 0);
#pragma unroll
        for (int i = 0; i < 4; ++i) if (4 * quad + i > x) att[i] = 0.f;
        v4u pbu; pbu.x = cvt_pk_bf16_c(att[0], att[1]); pbu.y = cvt_pk_bf16_c(att[2], att[3]); pbu.z = 0u; pbu.w = 0u;
        const bf16x8 pb = __builtin_bit_cast(bf16x8, pbu);
        const u2 vv = *(const LAS u2*)(vt + (vbase + x) * 16 + 4 * quad);
        v4u vfu; vfu.x = vv.x; vfu.y = vv.y; vfu.z = 0u; vfu.w = 0u; const bf16x8 vf = __builtin_bit_cast(bf16x8, vfu);
        pg8::f32x4 o = (pg8::f32x4){0.f, 0.f, 0.f, 0.f};
#pragma unroll
        for (int kt = 0; kt < 4; ++kt) { v4u su; su.x = cvt_pk_bf16_c(Sacc[2 * kt][0], Sacc[2 * kt][1]); su.y = cvt_pk_bf16_c(Sacc[2 * kt][2], Sacc[2 * kt][3]);
            su.z = cvt_pk_bf16_c(Sacc[2 * kt + 1][0], Sacc[2 * kt + 1][1]); su.w = cvt_pk_bf16_c(Sacc[2 * kt + 1][2], Sacc[2 * kt + 1][3]);
            o = __builtin_amdgcn_mfma_f32_16x16x32_bf16(__builtin_bit_cast(bf16x8, su), qf[kt], o, 0, 0, 0); }
        o = __builtin_amdgcn_mfma_f32_16x16x32_bf16(vf, pb, o, 0, 0, 0);
        *(pg8::f32x4*)(O + (size_t)(st * 16 + x) * WC) = o;
#pragma unroll
        for (int mt = 0; mt < 8; ++mt) { const pg8::f32x4 e4 = *(const LAS pg8::f32x4*)(ev + 16 * mt + 4 * quad);
            const u2 kk2 = *(const LAS u2*)(kht + (16 * mt + x) * 16 + 4 * quad); v4u ku; ku.x = kk2.x; ku.y = kk2.y; ku.z = 0u; ku.w = 0u;
            Sacc[mt] = __builtin_amdgcn_mfma_f32_16x16x32_bf16(__builtin_bit_cast(bf16x8, ku), vf, Sacc[mt] * e4, 0, 0, 0); }
        }
        asm volatile("s_waitcnt lgkmcnt(0)" ::: "memory"); __builtin_amdgcn_s_barrier(); asm volatile("" ::: "memory");
    }
#undef HG_DMA
    if (wave < 4) { float* So = a->out + O_HP + (((size_t)L * NBAT + b) * 6 + h) * 16384;
#pragma unroll
        for (int mt = 0; mt < 8; ++mt)
#pragma unroll
            for (int i = 0; i < 4; ++i) So[(size_t)(16 * mt + 4 * quad + i) * 128 + vbase + x] = Sacc[mt][i]; }
    asm volatile("s_waitcnt vmcnt(0) lgkmcnt(0)" ::: "memory"); __builtin_amdgcn_s_barrier(); asm volatile("" ::: "memory");
}
__device__ __forceinline__ void phase_pre(ArgsP a, int L, LAS unsigned char* lds, int lane, int wave, int blk, int G) {
    const int gw = blk * NWAVES + wave, NGW = G * NWAVES;
    for (int q = gw; q < NCHUNK; q += NGW) pre_chunk(a, L, q, lds + wave * 16384, lane);
    for (int q2 = gw; q2 < NHCHUNK; q2 += NGW) hpre_chunk(a, L, q2, lds + wave * 16384, lane);
}
__device__ __forceinline__ void rwkv_seq_unit(ArgsP a, int L, int unit, LAS unsigned char* lds, int lane, int wave) {
    unsigned char* ws = a->ws;
    const int b = unit / 12, h = unit - 12 * b;
    const unsigned char* recs = ws + wso(WS_RPB) + (size_t)unit * 128 * REC_BYTES;
    LAS float* ybuf = (LAS float*)(lds + 7 * REC_BYTES);
    const int x = lane & 15, quad = lane >> 4;
    constexpr int AHEAD = 5, NCH = SEQ / 16;
#define RW_DMA(cc) do { const unsigned char* g_ = recs + (size_t)(cc) * REC_BYTES + (wave - 4) * 4096 + lane * 16; LAS unsigned char* l_ = lds + ((cc) % 7) * REC_BYTES + (wave - 4) * 4096; \
        __builtin_amdgcn_global_load_lds((const unsigned*)(g_), (LAS unsigned*)(l_), 16, 0, 0); __builtin_amdgcn_global_load_lds((const unsigned*)(g_ + 1024), (LAS unsigned*)(l_ + 1024), 16, 0, 0); \
        __builtin_amdgcn_global_load_lds((const unsigned*)(g_ + 2048), (LAS unsigned*)(l_ + 2048), 16, 0, 0); __builtin_amdgcn_global_load_lds((const unsigned*)(g_ + 3072), (LAS unsigned*)(l_ + 3072), 16, 0, 0); } while (0)
    asm volatile("s_waitcnt vmcnt(0) lgkmcnt(0)" ::: "memory"); __builtin_amdgcn_s_barrier(); asm volatile("" ::: "memory");
    pg8::f32x4 Hacc[4];
#pragma unroll
    for (int nt = 0; nt < 4; ++nt) Hacc[nt] = (pg8::f32x4){0.f, 0.f, 0.f, 0.f};
    f4 gng4 = (f4){0.f, 0.f, 0.f, 0.f}, gnb4 = gng4;
    if (wave >= 4) {
        gng4 = *(const f4*)(a->in[I_BGNG] + L * WB + h * 64 + 4 * x); gnb4 = *(const f4*)(a->in[I_BGNB] + L * WB + h * 64 + 4 * x);
        asm volatile("s_waitcnt vmcnt(0)" ::: "memory");
#pragma unroll
        for (int cc = 0; cc < AHEAD; ++cc) RW_DMA(cc);
        asm volatile("s_waitcnt vmcnt(16)" ::: "memory");
    }
    __builtin_amdgcn_s_barrier(); asm volatile("" ::: "memory");
    bf16* ymix = (bf16*)(ws + wso(WS_YMIX)) + (size_t)(b * SEQ) * DM + WA + h * 64 + 4 * x;
    for (int c = 0; c <= NCH; ++c) {
        if (wave < 4) {
            if (c < NCH) {
                const LAS unsigned char* S = lds + (c % 7) * REC_BYTES;
                bf16x8 wf[2], rf[2], hb[2];
#pragma unroll
                for (int ks = 0; ks < 2; ++ks) { wf[ks] = *(const LAS bf16x8*)(S + RC_WT + x * 128 + 64 * ks + 16 * quad); rf[ks] = *(const LAS bf16x8*)(S + RC_RT + x * 128 + 64 * ks + 16 * quad);
                    v4u su; su.x = cvt_pk_bf16_c(Hacc[2 * ks][0], Hacc[2 * ks][1]); su.y = cvt_pk_bf16_c(Hacc[2 * ks][2], Hacc[2 * ks][3]);
                    su.z = cvt_pk_bf16_c(Hacc[2 * ks + 1][0], Hacc[2 * ks + 1][1]); su.w = cvt_pk_bf16_c(Hacc[2 * ks + 1][2], Hacc[2 * ks + 1][3]); hb[ks] = __builtin_bit_cast(bf16x8, su); }
                const u2 vv = *(const LAS u2*)(S + RC_VT + (16 * wave + x) * 32 + 8 * quad); v4u t4; t4.x = vv.x; t4.y = vv.y; t4.z = 0u; t4.w = 0u; const bf16x8 vf = __builtin_bit_cast(bf16x8, t4);
                const u2 m2v = *(const LAS u2*)(S + RC_M2 + x * 32 + 8 * quad); t4.x = m2v.x; t4.y = m2v.y; const bf16x8 m2f = __builtin_bit_cast(bf16x8, t4);
                const u2 brav = *(const LAS u2*)(S + RC_BRA + x * 32 + 8 * quad); t4.x = brav.x; t4.y = brav.y; const bf16x8 braf = __builtin_bit_cast(bf16x8, t4);
                const u2 brkv = *(const LAS u2*)(S + RC_BRK + x * 32 + 8 * quad); t4.x = brkv.x; t4.y = brkv.y; const bf16x8 brkf = __builtin_bit_cast(bf16x8, t4);
                pg8::f32x4 U = (pg8::f32x4){0.f, 0.f, 0.f, 0.f}, Y = U;
                U = __builtin_amdgcn_mfma_f32_16x16x32_bf16(wf[0], hb[0], U, 0, 0, 0); U = __builtin_amdgcn_mfma_f32_16x16x32_bf16(wf[1], hb[1], U, 0, 0, 0); U = __builtin_amdgcn_mfma_f32_16x16x32_bf16(m2f, vf, U, 0, 0, 0);
                Y = __builtin_amdgcn_mfma_f32_16x16x32_bf16(rf[0], hb[0], Y, 0, 0, 0); Y = __builtin_amdgcn_mfma_f32_16x16x32_bf16(rf[1], hb[1], Y, 0, 0, 0); Y = __builtin_amdgcn_mfma_f32_16x16x32_bf16(brkf, vf, Y, 0, 0, 0);
                t4.x = cvt_pk_bf16_c(U[0], U[1]); t4.y = cvt_pk_bf16_c(U[2], U[3]); const bf16x8 ub = __builtin_bit_cast(bf16x8, t4);
                Y = __builtin_amdgcn_mfma_f32_16x16x32_bf16(braf, ub, Y, 0, 0, 0);
#pragma unroll
                for (int nt = 0; nt < 4; ++nt) { const pg8::f32x4 g4 = *(const LAS pg8::f32x4*)(S + RC_G15 + (16 * nt + 4 * quad) * 4);
                    const u2 av = *(const LAS u2*)(S + RC_AHT + (16 * nt + x) * 32 + 8 * quad); t4.x = av.x; t4.y = av.y; const bf16x8 ahf = __builtin_bit_cast(bf16x8, t4);
                    const u2 kv = *(const LAS u2*)(S + RC_KHT + (16 * nt + x) * 32 + 8 * quad); t4.x = kv.x; t4.y = kv.y; const bf16x8 khf = __builtin_bit_cast(bf16x8, t4);
                    Hacc[nt] = __builtin_amdgcn_mfma_f32_16x16x32_bf16(ahf, ub, Hacc[nt] * g4, 0, 0, 0); Hacc[nt] = __builtin_amdgcn_mfma_f32_16x16x32_bf16(khf, vf, Hacc[nt], 0, 0, 0); }
                LAS float* yb = ybuf + (c & 1) * 1024;
#pragma unroll
                for (int i = 0; i < 4; ++i) yb[(4 * quad + i) * 64 + 16 * wave + x] = Y[i];
            }
        } else {
            if (c + AHEAD < NCH) RW_DMA(c + AHEAD);
            if (c > 0) {
                const int cp = c - 1, tt = 4 * (wave - 4) + quad; const LAS unsigned char* S = lds + (cp % 7) * REC_BYTES; const LAS float* yb = ybuf + (cp & 1) * 1024;
                const f4 y4 = *(const LAS f4*)(yb + tt * 64 + 4 * x); const u2 gq = *(const LAS u2*)(S + RC_GT + (tt * 64 + 4 * x) * 2);
                const float bcf = *(const LAS float*)(S + RC_BC + tt * 4);
                f4 g4, v4; g4.x = __builtin_bit_cast(float, gq.x << 16); g4.y = __builtin_bit_cast(float, gq.x & 0xffff0000u); g4.z = __builtin_bit_cast(float, gq.y << 16); g4.w = __builtin_bit_cast(float, gq.y & 0xffff0000u);
#pragma unroll
                for (int i = 0; i < 4; ++i) v4[i] = __builtin_bit_cast(float, (unsigned)(*(const LAS unsigned short*)(S + RC_VT + (4 * x + i) * 32 + tt * 2)) << 16);
                const float mean = row16_sum((y4.x + y4.y) + (y4.z + y4.w)) * (1.f / 64.f); const f4 d = y4 - mean;
                const float rstd = 1.0f / sqrtf(row16_sum((d.x * d.x + d.y * d.y) + (d.z * d.z + d.w * d.w)) * (1.f / 64.f) + GN_EPS);
                const f4 o = (d * rstd * gng4 + gnb4 + v4 * bcf) * g4;
                u2 w; w.x = cvt_pk_bf16_c(o.x, o.y); w.y = cvt_pk_bf16_c(o.z, o.w); *(u2*)(ymix + (size_t)(cp * 16 + tt) * DM) = w;
            }
            if (c + AHEAD < NCH) asm volatile("s_waitcnt vmcnt(16)" ::: "memory"); else asm volatile("s_waitcnt vmcnt(0)" ::: "memory");
        }
        asm volatile("s_waitcnt lgkmcnt(0)" ::: "memory"); __builtin_amdgcn_s_barrier(); asm volatile("" ::: "memory");
    }
    if (wave < 4) { float* So = a->out + O_RP + (((size_t)L * NBAT + b) * 12 + h) * 4096;
#pragma unroll
        for (int nt = 0; nt < 4; ++nt) *(pg8::f32x4*)(So + (size_t)(16 * wave + x) * 64 + 16 * nt + 4 * quad) = Hacc[nt]; }
#undef RW_DMA
    asm volatile("s_waitcnt vmcnt(0) lgkmcnt(0)" ::: "memory"); __builtin_amdgcn_s_barrier(); asm volatile("" ::: "memory");
}

__device__ __forceinline__ float gelu_fast(float v) {
    const float t = __builtin_amdgcn_rcpf(__builtin_fabsf(v) * 0.2316418882f + 1.0f);
    float q = t * 0.5307027145f + (-0.7265760135f); q = q * t + 0.7107068705f; q = q * t + (-0.142248368f); q = q * t + 0.127414796f; q = q * t;
    const float e = __builtin_amdgcn_exp2f((v * v) * (-0.72134752044f)); const float m = v * (q * e);
    return v < 0.f ? m : v - m;
}
__device__ __forceinline__ void sgu_item2(ArgsP a, int L, int item, LAS unsigned char* lds, int tid, int lane, int wave) {
    unsigned char* ws = a->ws;
    const int g = item & 3, bc = item >> 2, m0 = bc * 128;
    const float* Z = (const float*)(ws + wso(WS_Z));
    LAS bf16* Wb = (LAS bf16*)lds;
    LAS bf16* VT = (LAS bf16*)(lds + 34816);
    const float* wsrc = a->in[I_AWS] + (size_t)(L * 4 + g) * 16384;
    __syncthreads();
#pragma unroll
    for (int j = 0; j < 8; ++j) { const int e4 = j * NTHR + tid, t = e4 >> 5, s0 = (e4 & 31) * 4; const f4 w = *(const f4*)(wsrc + t * 128 + s0);
        u2 o; o.x = cvt_pk_bf16_c(s0 <= t ? w.x : 0.f, s0 + 1 <= t ? w.y : 0.f); o.y = cvt_pk_bf16_c(s0 + 2 <= t ? w.z : 0.f, s0 + 3 <= t ? w.w : 0.f); *(LAS u2*)(Wb + t * 136 + s0) = o; }
    const float lg0 = a->in[I_ALNG][L * WA + g * 128 + lane], lg1 = a->in[I_ALNG][L * WA + g * 128 + 64 + lane], lb0 = a->in[I_ALNB][L * WA + g * 128 + lane], lb1 = a->in[I_ALNB][L * WA + g * 128 + 64 + lane];
    float zv0[16], zv1[16];
#pragma unroll
    for (int rr = 0; rr < 16; ++rr) { const float* zr = Z + (size_t)(m0 + wave * 16 + rr) * PIN + WA + g * 128; zv0[rr] = zr[lane]; zv1[rr] = zr[64 + lane]; }
#pragma unroll
    for (int rr = 0; rr < 16; ++rr) { const int t = wave * 16 + rr; const float v0 = gelu_fast(zv0[rr]), v1 = gelu_fast(zv1[rr]);
        const float mean = wave_sum_fast(v0 + v1) * (1.f / 128.f); const float d0 = v0 - mean, d1 = v1 - mean;
        const float rstd = 1.0f / sqrtf(wave_sum_fast(d0 * d0 + d1 * d1) * (1.f / 128.f) + LN_EPS);
        VT[lane * 136 + t] = bf1(d0 * rstd * lg0 + lb0); VT[(64 + lane) * 136 + t] = bf1(d1 * rstd * lg1 + lb1); }
    __syncthreads();
    const int x = lane & 15, quad = lane >> 4, nks = (wave >> 1) + 1;
    pg8::f32x4 acc[8];
#pragma unroll
    for (int dt = 0; dt < 8; ++dt) acc[dt] = (pg8::f32x4){0.f, 0.f, 0.f, 0.f};
    for (int ks = 0; ks < nks; ++ks) { const bf16x8 wf = *(const LAS bf16x8*)(Wb + (16 * wave + x) * 136 + 32 * ks + 8 * quad);
#pragma unroll
        for (int dt = 0; dt < 8; ++dt) { const bf16x8 vf = *(const LAS bf16x8*)(VT + (16 * dt + x) * 136 + 32 * ks + 8 * quad); acc[dt] = __builtin_amdgcn_mfma_f32_16x16x32_bf16(vf, wf, acc[dt], 0, 0, 0); } }
    const int t = 16 * wave + x; const float bs = a->in[I_ABS][(L * 4 + g) * 128 + t];
    const float* ur = Z + (size_t)(m0 + t) * PIN + g * 128 + 4 * quad; bf16* yo = (bf16*)(ws + wso(WS_YMIX)) + (size_t)(m0 + t) * DM + g * 128 + 4 * quad;
#pragma unroll
    for (int dt = 0; dt < 8; ++dt) { const f4 u = *(const f4*)(ur + 16 * dt); u2 o;
        o.x = cvt_pk_bf16_c(gelu_fast(u.x) * (acc[dt][0] + bs), gelu_fast(u.y) * (acc[dt][1] + bs)); o.y = cvt_pk_bf16_c(gelu_fast(u.z) * (acc[dt][2] + bs), gelu_fast(u.w) * (acc[dt][3] + bs));
        *(u2*)(yo + 16 * dt) = o; }
}
__device__ __forceinline__ void hgrn_sample_item2(ArgsP a, int L, int item, LAS unsigned char* lds, int lane, int wave) {
    unsigned char* ws = a->ws;
    const int ih = item * 8 + wave, i = ih / 6, h = ih - i * 6, m = MP + i, vq = lane & 31, kh = lane >> 5;
    const float* zc = (const float*)(ws + wso(WS_Z)) + (size_t)m * PIN + OFF_C + h * 128;
    LAS f4* sc = (LAS f4*)(lds + wave * 2048);
#pragma unroll
    for (int t = 0; t < 2; ++t) { const int k = lane + 64 * t; const float lb = lbound(a->in[I_CLB], L, h * 128 + k); const float fz = zc[WC + k];
        const float e = __expf(-fmaxf(fz, -80.f)), sg = __builtin_amdgcn_rcpf(1.0f + e); f4 r; r.x = lb + (1.0f - lb) * sg; r.y = (1.0f - lb) * e * sg; r.z = zc[k]; r.w = 0.f; sc[k] = r; }
    const f4 iv = *(const f4*)(zc + 2 * WC + 4 * vq);
    LDS_WAIT(); asm volatile("" ::: "memory");
    const float* S0 = a->in[I_SHGRN] + (((size_t)L * NS + i) * 6 + h) * 16384 + 4 * vq;
    float* So = a->out + O_HS + (((size_t)L * NS + i) * 6 + h) * 16384 + 4 * vq;
    f4 o = (f4){0.f, 0.f, 0.f, 0.f};
#pragma unroll 1
    for (int qt = 0; qt < 4; ++qt) { f4 sv[16];
#pragma unroll
        for (int j = 0; j < 16; ++j) sv[j] = *(const f4*)(S0 + (size_t)(kh + 2 * (16 * qt + j)) * 128);
#pragma unroll
        for (int j = 0; j < 16; ++j) { const int k = kh + 2 * (16 * qt + j); const f4 c = sc[k]; const f4 n = sv[j] * c.x + iv * c.y; *(f4*)(So + (size_t)k * 128) = n; o += n * c.z; } }
    { LAS f4* ex = (LAS f4*)(lds + 16384 + wave * 1024); ex[lane] = o; LDS_WAIT(); asm volatile("" ::: "memory"); o += ex[lane ^ 32]; }
    if (kh == 0) *(f4*)((float*)(ws + wso(WS_O)) + (size_t)m * WC + h * 128 + 4 * vq) = o;
    LDS_WAIT(); asm volatile("" ::: "memory");
}

enum { SE_STORE = 0, SE_RESID = 1, SE_SWIGLU = 2, SE_SIGMUL = 3, SE_ATOMIC = 4 };
struct SEpi { int mode; float* out; const float* base; const float* add; int ld; float alpha; float* tinit; };
template <bool PIPE> __device__ __forceinline__ void strip_task(const bf16* A, const bf16* Bt, int K, int r0, int r1, int c0, const SEpi& E, LAS unsigned char* lds, int lane, int wave, int kbeg, int nk) {
    const int x = lane & 15, quad = lane >> 4;
    const int q8 = nk >> 3, r8 = nk & 7, nks = q8 + (wave < r8 ? 1 : 0), ks0 = kbeg + wave * q8 + (wave < r8 ? wave : r8);
    const bf16* Ap = A + (size_t)x * K + ks0 * 32 + 8 * quad;
    const bf16* B0 = Bt + (size_t)(r0 + x) * K + ks0 * 32 + 8 * quad;
    const bf16* B1 = Bt + (size_t)(r1 + x) * K + ks0 * 32 + 8 * quad;
    pg8::f32x4 acc[8][2];
#pragma unroll
    for (int mt = 0; mt < 8; ++mt) { acc[mt][0] = (pg8::f32x4){0.f, 0.f, 0.f, 0.f}; acc[mt][1] = (pg8::f32x4){0.f, 0.f, 0.f, 0.f}; }
    int s = 0;
    if constexpr (PIPE) {
        for (; s + 2 <= nks; s += 2) {
            bf16x8 af[8], ag[8]; const bf16x8 b0 = *(const bf16x8*)(B0 + 32 * s), b1 = *(const bf16x8*)(B1 + 32 * s), c0v = *(const bf16x8*)(B0 + 32 * s + 32), c1v = *(const bf16x8*)(B1 + 32 * s + 32);
#pragma unroll
            for (int mt = 0; mt < 8; ++mt) { af[mt] = *(const bf16x8*)(Ap + (size_t)(16 * mt) * K + 32 * s); ag[mt] = *(const bf16x8*)(Ap + (size_t)(16 * mt) * K + 32 * s + 32); }
#pragma unroll
            for (int mt = 0; mt < 8; ++mt) { acc[mt][0] = __builtin_amdgcn_mfma_f32_16x16x32_bf16(af[mt], b0, acc[mt][0], 0, 0, 0); acc[mt][1] = __builtin_amdgcn_mfma_f32_16x16x32_bf16(af[mt], b1, acc[mt][1], 0, 0, 0); }
#pragma unroll
            for (int mt = 0; mt < 8; ++mt) { acc[mt][0] = __builtin_amdgcn_mfma_f32_16x16x32_bf16(ag[mt], c0v, acc[mt][0], 0, 0, 0); acc[mt][1] = __builtin_amdgcn_mfma_f32_16x16x32_bf16(ag[mt], c1v, acc[mt][1], 0, 0, 0); }
        }
    }
    for (; s < nks; ++s) {
        bf16x8 af[8]; const bf16x8 b0 = *(const bf16x8*)(B0 + 32 * s), b1 = *(const bf16x8*)(B1 + 32 * s);
#pragma unroll
        for (int mt = 0; mt < 8; ++mt) af[mt] = *(const bf16x8*)(Ap + (size_t)(16 * mt) * K + 32 * s);
#pragma unroll
        for (int mt = 0; mt < 8; ++mt) { acc[mt][0] = __builtin_amdgcn_mfma_f32_16x16x32_bf16(af[mt], b0, acc[mt][0], 0, 0, 0); acc[mt][1] = __builtin_amdgcn_mfma_f32_16x16x32_bf16(af[mt], b1, acc[mt][1], 0, 0, 0); }
    }
    __syncthreads();
    LAS pg8::f32x4* red = (LAS pg8::f32x4*)lds;
#pragma unroll
    for (int mt = 0; mt < 8; ++mt) { red[((wave * 8 + mt) * 2 + 0) * 64 + lane] = acc[mt][0]; red[((wave * 8 + mt) * 2 + 1) * 64 + lane] = acc[mt][1]; }
    __syncthreads();
    pg8::f32x4 s0 = (pg8::f32x4){0.f, 0.f, 0.f, 0.f}, s1 = s0;
#pragma unroll
    for (int w2 = 0; w2 < 8; ++w2) { s0 += red[((w2 * 8 + wave) * 2 + 0) * 64 + lane]; s1 += red[((w2 * 8 + wave) * 2 + 1) * 64 + lane]; }
#pragma unroll
    for (int i = 0; i < 4; ++i) { const size_t ro = (size_t)(16 * wave + 4 * quad + i) * E.ld;
        if (E.mode == SE_SWIGLU) { const float g = s0[i]; ((bf16*)E.out)[ro + c0 + x] = bf1(g * __builtin_amdgcn_rcpf(1.0f + __expf(-g)) * s1[i]); }
        else {
#pragma unroll
            for (int t = 0; t < 2; ++t) { const size_t o = ro + c0 + 16 * t + x; const float v = t ? s1[i] : s0[i]; float r;
                if (E.mode == SE_ATOMIC) { __hip_atomic_fetch_add(E.out + o, v, __ATOMIC_RELAXED, __HIP_MEMORY_SCOPE_AGENT); continue; }
                if (E.mode == SE_STORE) r = v;
                else if (E.mode == SE_RESID) { r = E.alpha * E.base[o] + v; if (E.add) r += E.add[o]; }
                else { r = E.base[o] * __builtin_amdgcn_rcpf(1.0f + __expf(-v)); if (E.tinit) E.tinit[o] = E.alpha * E.add[o] + r; }
                E.out[o] = r; } }
    }
}
template <bool PIPE = false> __device__ __forceinline__ void strip_gemm(const bf16* A, const bf16* Bt, int K, int N, const SEpi& E, LAS unsigned char* lds, int lane, int wave, int blk, int G, int ksplit = 1) {
    const int per = (E.mode == SE_SWIGLU) ? 16 : 32, ncg = N / per, ntask = ncg * ksplit, nkt = (K >> 5) / ksplit;
    for (int t = G - 1 - blk; t < ntask; t += G) { const int cg = t % ncg, kg = t / ncg, c0 = cg * per;
        if (E.mode == SE_SWIGLU) { const int rb = ((c0 >> 7) << 8) + (c0 & 127); strip_task<PIPE>(A, Bt, K, rb, rb + 128, c0, E, lds, lane, wave, 0, K >> 5); }
        else strip_task<PIPE>(A, Bt, K, c0, c0 + 16, c0, E, lds, lane, wave, kg * nkt, nkt); }
    __syncthreads();
}

#ifndef EN_PRO
#define EN_PRO 1
#endif
#ifndef EN_G1
#define EN_G1 1
#endif
#ifndef EN_PREP
#define EN_PREP 1
#endif
#ifndef EN_MIX
#define EN_MIX 1
#endif
#ifndef EN_POST
#define EN_POST 1
#endif
#ifndef EN_G3
#define EN_G3 1
#endif
#ifndef EN_LN
#define EN_LN 1
#endif
#ifndef EN_G4
#define EN_G4 1
#endif
#ifndef EN_G5
#define EN_G5 1
#endif
#ifndef REP_PHASE
#define REP_PHASE -1
#endif
#define NREP(k) ((REP_PHASE) == (k) ? 2 : 1)
#ifndef MK_SINGLE
#define MK_SINGLE 1
#endif
constexpr int PPL = 11, N_PHASES = 1 + PPL * DEPTH;
constexpr int SCAN_UNITS = NBAT * 12, HSEQ_UNITS = NBAT * 6 * 2, ROLE_BLOCKS = SCAN_UNITS + HSEQ_UNITS;
constexpr int N_SGU = NBAT * 16 * 4, N_RS = NS * 12 / 8, N_HS = NS * 6 / 8, N_MISC = N_SGU + N_RS + N_HS;

__global__ void __launch_bounds__(NTHR, 2) mk_fwd(Args a) {
    extern __shared__ __attribute__((aligned(16))) unsigned char lds_raw[];
    LAS unsigned char* lds = (LAS unsigned char*)lds_raw;
    const int tid = threadIdx.x, blk = blockIdx.x, G = gridDim.x; const int wave0 = __builtin_amdgcn_readfirstlane(tid >> 6);
    ArgsP ap0 = (ArgsP)__builtin_amdgcn_kernarg_segment_ptr();
    volatile LAS unsigned* MISC = (volatile LAS unsigned*)(lds + MISC_OFF);
    for (int u = tid; u < (LDS_BYTES - LDSCTL_OFF) / 4; u += NTHR) ((LAS unsigned*)(lds + LDSCTL_OFF))[u] = 0u;
    __syncthreads();
    const int lo = ap0->ph_lo, hi = ap0->ph_hi;
    XcdBarrier bar; bar.bar = (unsigned*)(ap0->ws + WS_CTL) + CW_BAR; bar.x = 0; bar.st = nullptr;
    if (hi - lo > 1) bar = xcd_barrier_post((unsigned*)(ap0->ws + WS_CTL) + CW_BAR, MISC + 8);
    bar.w0 = (wave0 == 0);
#define IN(k) (lo <= (k) && (k) < hi)
#define SEAM(k) do { if (IN(k) && IN((k) + 1)) { xcd_barrier(bar); } } while (0)
#define PHASE_BEGIN() ArgsP a = ap0; asm volatile("" : "+s"(a)); unsigned char* ws = a->ws; int tid_ = wave0 * 64 + mk_lane_id(); asm volatile("" : "+v"(tid_)); \
    const int lane_ = tid_ & 63; const int wave_ = __builtin_amdgcn_readfirstlane(tid_ >> 6); const int lane_s = lane_, wave_s = wave_; \
    bf16* HB = (bf16*)(ws + wso(WS_HB)); float* H = (float*)(ws + wso(WS_H)); float* T = (float*)(ws + wso(WS_T)); (void)HB; (void)H; (void)T; (void)lane_s; (void)wave_s

    #if EN_PRO
    if (IN(0)) for (int rep = 0; rep < NREP(0); ++rep) { PHASE_BEGIN(); phase_prologue(a, lds, lane_, wave_, blk, G); __syncthreads(); }
#endif
    SEAM(0);
    for (int L = 0; L < DEPTH; ++L) {
        const int pb = 1 + PPL * L;
#if EN_G1
        if (IN(pb)) for (int rep = 0; rep < NREP(1); ++rep) {
            { PHASE_BEGIN(); pg8::Gemm g{HB, (const bf16*)(ws + wso(WS_WIN) + L * SZ_WIN), MP, PIN, DM}; pg8::StaticOrder S; S.init(MP, PIN, G, blk);
              pg8::EpiF32 E{(float*)(ws + wso(WS_Z)), PIN}; pg8::gemm_phase<pg8::EpiF32, pg8::StaticOrder, true, true>(lds, g, S, E, wave0); }
              { PHASE_BEGIN(); const SEpi SE{SE_STORE, (float*)(ws + wso(WS_Z)) + (size_t)MP * PIN, nullptr, nullptr, PIN, 0.f, nullptr}; strip_gemm(HB + (size_t)MP * DM, (const bf16*)(ws + wso(WS_WIN) + L * SZ_WIN), DM, PIN, SE, lds, lane_s, wave_s, blk, G); }
            { PHASE_BEGIN(); pg8::Gemm g{(const bf16*)(ws + wso(WS_PBF) + L * SZ_PBF), (const bf16*)(ws + wso(WS_WPP) + L * SZ_WPP), MP, DM, DPLE}; pg8::StaticOrder S; S.init(MP, DM, G, G - 1 - blk);
              pg8::EpiF32 E{(float*)(ws + wso(WS_PPO)), DM}; pg8::gemm_phase<pg8::EpiF32, pg8::StaticOrder, true, true>(lds, g, S, E, wave0); }
              { PHASE_BEGIN(); const SEpi SE{SE_STORE, (float*)(ws + wso(WS_PPO)) + (size_t)MP * DM, nullptr, nullptr, DM, 0.f, nullptr}; strip_gemm((const bf16*)(ws + wso(WS_PBF) + L * SZ_PBF) + (size_t)MP * DPLE, (const bf16*)(ws + wso(WS_WPP) + L * SZ_WPP), DPLE, DM, SE, lds, lane_s, wave_s, blk, G); }
        }
#endif
        SEAM(pb);
#if EN_PREP
        if (IN(pb + 1)) for (int rep = 0; rep < NREP(2); ++rep) { PHASE_BEGIN(); phase_xc(a, L, lane_, wave_, blk, G); }
        SEAM(pb + 1);
        if (IN(pb + 2)) for (int rep = 0; rep < NREP(9); ++rep) {
            { PHASE_BEGIN(); pg8::Gemm g{(const bf16*)(ws + wso(WS_XCAT)), (const bf16*)(ws + wso(WS_WL) + L * SZ_WL), MP, NLORA, 256}; pg8::StaticOrder S; S.init(MP, NLORA, G, blk);
            pg8::EpiF32 E{(float*)(ws + wso(WS_LORA)), NLORA}; pg8::gemm_phase<pg8::EpiF32, pg8::StaticOrder, true, true>(lds, g, S, E, wave0); }
            { PHASE_BEGIN(); const SEpi SE{SE_STORE, (float*)(ws + wso(WS_LORA)) + (size_t)MP * NLORA, nullptr, nullptr, NLORA, 0.f, nullptr}; strip_gemm((const bf16*)(ws + wso(WS_XCAT)) + (size_t)MP * 256, (const bf16*)(ws + wso(WS_WL) + L * SZ_WL), 256, NLORA, SE, lds, lane_s, wave_s, blk, G); }
        }
        SEAM(pb + 2);
        if (IN(pb + 3)) for (int rep = 0; rep < NREP(10); ++rep) { PHASE_BEGIN(); phase_pre(a, L, lds, lane_, wave_, blk, G); phase_fin(a, L, lane_, wave_, blk, G); }
#endif
        SEAM(pb + 3);
#if EN_MIX
        if (IN(pb + 4)) for (int rep = 0; rep < NREP(3); ++rep) { PHASE_BEGIN();
            const int tid = tid_, lane = lane_, wave = wave_;
            if (blk < SCAN_UNITS) { for (int r2 = 0; r2 < NREP(31); ++r2) rwkv_seq_unit(a, L, blk, lds, lane, wave); }
            else if (blk < ROLE_BLOCKS) { for (int r2 = 0; r2 < NREP(32); ++r2) hgrn_stream_unit(a, L, blk - SCAN_UNITS, lds, lane, wave); }
            else for (int r2 = 0; r2 < NREP(33); ++r2) for (int it = blk - ROLE_BLOCKS; it < N_MISC; it += G - ROLE_BLOCKS) {
                if (it < N_SGU) sgu_item2(a, L, it, lds, tid, lane, wave);
                else if (it < N_SGU + N_RS) rwkv_sample_item(a, L, it - N_SGU, lds, lane, wave);
                else hgrn_sample_item2(a, L, it - N_SGU - N_RS, lds, lane, wave);
                __syncthreads();
            }
        }
#endif
        SEAM(pb + 4);
#if EN_POST
        if (IN(pb + 5)) for (int rep = 0; rep < NREP(4); ++rep) { PHASE_BEGIN(); phase_post(a, L, lane_, wave_, blk, G); }
#endif
        SEAM(pb + 5);
#if EN_G3
        if (IN(pb + 6)) for (int rep = 0; rep < NREP(5); ++rep) {
            { PHASE_BEGIN(); pg8::Gemm g{(const bf16*)(ws + wso(WS_YMIX)), (const bf16*)(ws + wso(WS_WOUT) + L * SZ_WOUT), MP, DM, DM}; pg8::StaticOrder S; S.init(MP, DM, G, blk);
            pg8::EpiResid E{T, H, nullptr, DM, DN_ALPHA}; pg8::gemm_phase<pg8::EpiResid, pg8::StaticOrder, true, true>(lds, g, S, E, wave0); }
            { PHASE_BEGIN(); const SEpi SE{SE_ATOMIC, T + (size_t)MP * DM, nullptr, nullptr, DM, 0.f, nullptr}; strip_gemm<false>((const bf16*)(ws + wso(WS_YMIX)) + (size_t)MP * DM, (const bf16*)(ws + wso(WS_WOUT) + L * SZ_WOUT), DM, DM, SE, lds, lane_s, wave_s, blk, G, 4); }
        }
#endif
        SEAM(pb + 6);
#if EN_LN
        if (IN(pb + 7)) for (int rep = 0; rep < NREP(6); ++rep) { PHASE_BEGIN(); phase_ln(a, a->in[I_LN1G] + L * DM, a->in[I_LN1B] + L * DM, false, lane_, wave_, blk, G); }
#endif
        SEAM(pb + 7);
#if EN_G4
        if (IN(pb + 8)) for (int rep = 0; rep < NREP(7); ++rep) {
            { PHASE_BEGIN(); pg8::Gemm g{HB, (const bf16*)(ws + wso(WS_WGU) + L * SZ_WGU), MP, 2 * DFF, DM}; pg8::StaticOrder S; S.init(MP, 2 * DFF, G, blk);
              pg8::EpiSwiglu E{(bf16*)(ws + wso(WS_ACT)), DFF}; pg8::gemm_phase<pg8::EpiSwiglu, pg8::StaticOrder, true, true>(lds, g, S, E, wave0); }
              { PHASE_BEGIN(); const SEpi SE{SE_SWIGLU, (float*)((bf16*)(ws + wso(WS_ACT)) + (size_t)MP * DFF), nullptr, nullptr, DFF, 0.f, nullptr}; strip_gemm(HB + (size_t)MP * DM, (const bf16*)(ws + wso(WS_WGU) + L * SZ_WGU), DM, DFF, SE, lds, lane_s, wave_s, blk, G); }
            { PHASE_BEGIN(); pg8::Gemm g{HB, (const bf16*)(ws + wso(WS_WPG) + L * SZ_WPG), MP, DM, DM}; pg8::StaticOrder S; S.init(MP, DM, G, G - 1 - blk);
              pg8::EpiSigMul E{(float*)(ws + wso(WS_PLE)), (const float*)(ws + wso(WS_PPO)), DM}; pg8::gemm_phase<pg8::EpiSigMul, pg8::StaticOrder, true, true>(lds, g, S, E, wave0); }
              { PHASE_BEGIN(); const SEpi SE{SE_SIGMUL, (float*)(ws + wso(WS_PLE)) + (size_t)MP * DM, (const float*)(ws + wso(WS_PPO)) + (size_t)MP * DM, H + (size_t)MP * DM, DM, DN_ALPHA, T + (size_t)MP * DM}; strip_gemm(HB + (size_t)MP * DM, (const bf16*)(ws + wso(WS_WPG) + L * SZ_WPG), DM, DM, SE, lds, lane_s, wave_s, blk, G); }
        }
#endif
        SEAM(pb + 8);
#if EN_G5
        if (IN(pb + 9)) for (int rep = 0; rep < NREP(8); ++rep) {
            for (int r3 = 0; r3 < NREP(81); ++r3) { PHASE_BEGIN(); pg8::Gemm g{(const bf16*)(ws + wso(WS_ACT)), (const bf16*)(ws + wso(WS_WD) + L * SZ_WD), MP, DM, DFF}; pg8::StaticOrder S; S.init(MP, DM, G, blk);
            pg8::EpiResid E{T, H, (const float*)(ws + wso(WS_PLE)), DM, DN_ALPHA}; pg8::gemm_phase<pg8::EpiResid, pg8::StaticOrder, true, true>(lds, g, S, E, wave0); }
            for (int r3 = 0; r3 < NREP(82); ++r3) { PHASE_BEGIN(); const SEpi SE{SE_ATOMIC, T + (size_t)MP * DM, nullptr, nullptr, DM, 0.f, nullptr}; strip_gemm<false>((const bf16*)(ws + wso(WS_ACT)) + (size_t)MP * DFF, (const bf16*)(ws + wso(WS_WD) + L * SZ_WD), DFF, DM, SE, lds, lane_s, wave_s, blk, G, 4); }
        }
#endif
        SEAM(pb + 9);
#if EN_LN
        if (IN(pb + 10)) for (int rep = 0; rep < NREP(6); ++rep) { PHASE_BEGIN(); phase_ln(a, a->in[I_LN2G] + L * DM, a->in[I_LN2B] + L * DM, L == DEPTH - 1, lane_, wave_, blk, G); }
#endif
        SEAM(pb + 10);
    }
#undef IN
#undef SEAM
}

extern "C" void kernel_launch(void* const* d_in, const int* in_sizes, int n_in, void* d_out, int out_size, void* d_ws, size_t ws_size, hipStream_t stream) {
    static int grid = 0;
    if (grid == 0) {
        if (n_in != N_IN || (size_t)out_size != O_END || ws_size < WS_END) { fprintf(stderr, "kernel_launch: unexpected sizes n_in %d out %d ws %zu (need %zu)\n", n_in, out_size, ws_size, (size_t)WS_END); grid = -1; return; }
        int dev = 0, cus = 0, per_cu = 0;
        if (hipGetDevice(&dev) != hipSuccess || hipDeviceGetAttribute(&cus, hipDeviceAttributeMultiprocessorCount, dev) != hipSuccess) { grid = -1; return; }
        if (hipFuncSetAttribute((const void*)mk_fwd, hipFuncAttributeMaxDynamicSharedMemorySize, LDS_BYTES) != hipSuccess) { fprintf(stderr, "kernel_launch: hipFuncSetAttribute failed\n"); grid = -1; return; }
        if (hipOccupancyMaxActiveBlocksPerMultiprocessor(&per_cu, (const void*)mk_fwd, NTHR, LDS_BYTES) != hipSuccess || per_cu < 1) fprintf(stderr, "kernel_launch: occupancy query says %d\n", per_cu);
        (void)hipGetLastError();
        grid = cus;
        if (grid < ROLE_BLOCKS + 8) { fprintf(stderr, "kernel_launch: %d CUs is too few\n", grid); grid = -1; return; }
    }
    if (grid < 0) return;
    if (hipMemsetAsync((char*)d_ws + WS_CTL, 0, CTL_ZERO_BYTES, stream) != hipSuccess) return;
    Args a{};
    for (int i = 0; i < N_IN; ++i) a.in[i] = (const float*)d_in[i];
    a.out = (float*)d_out; a.ws = (unsigned char*)d_ws;
#if MK_SINGLE
    a.ph_lo = 0; a.ph_hi = N_PHASES;
    hipLaunchKernelGGL(mk_fwd, dim3(grid), dim3(NTHR), LDS_BYTES, stream, a);
#else
    for (int p = 0; p < N_PHASES; ++p) { a.ph_lo = p; a.ph_hi = p + 1; hipLaunchKernelGGL(mk_fwd, dim3(grid), dim3(NTHR), LDS_BYTES, stream, a); }
#endif
}
```

```cpp
#include <hip/hip_runtime.h>
#include <cstdio>
#include <cstdint>
typedef float mk_f32x2 __attribute__((ext_vector_type(2))); typedef __bf16 mk_bf16x2 __attribute__((ext_vector_type(2)));
__device__ __forceinline__ unsigned cvt_pk_bf16_c(float lo, float hi) { mk_f32x2 v = {lo, hi}; mk_bf16x2 b = __builtin_convertvector(v, mk_bf16x2); return __builtin_bit_cast(unsigned, b); }
__device__ __forceinline__ int mk_lane_id() { int l; asm volatile("v_mbcnt_lo_u32_b32 %0, -1, 0\n\tv_mbcnt_hi_u32_b32 %0, -1, %0" : "=v"(l)); return l; }
namespace pg8 {
#define PG8_LAS __attribute__((address_space(3)))
typedef unsigned short bf16_t;
typedef short bf16x8 __attribute__((ext_vector_type(8)));
typedef float f32x4 __attribute__((ext_vector_type(4)));
typedef unsigned u32x4 __attribute__((ext_vector_type(4)));
constexpr int BM = 256, BK = 64, HALF = 128, HTB = HALF * BK * 2  , STAGE_BYTES = 8 * HTB, NXCD = 8, WGM = 8;

__host__ __device__ __forceinline__ int lds_byte(int r, int c) { const int st = (r >> 4) * 2 + (c >> 5), rr = r & 15, cc = c & 31, ob = rr * 64 + cc * 2; return st * 1024 + (ob ^ (((ob >> 9) & 1) << 5)); }
__host__ __device__ __forceinline__ void stage_rc(int b, int& R, int& C) { const int st = b / 1024, sb = b % 1024, swz = sb ^ (((sb >> 9) & 1) << 5); R = (st >> 1) * 16 + swz / 64; C = (st & 1) * 32 + (swz % 64) / 2; }
__host__ __device__ __forceinline__ int perm32(int rho) { const int n = rho >> 4, i = rho & 15; return 8 * (i >> 2) + 4 * n + (i & 3); }

struct Unit { int pm, pn; };
struct Gemm { const bf16_t* A; const bf16_t* Bt; int M, N, K; };

struct StaticOrder {
    int nM, nN, nwg, G, c;
    __host__ __device__ void init(int M, int N, int G_, int c_) { nM = M / BM; nN = N / BM; nwg = nM * nN; G = G_; c = c_; }
    __host__ __device__ bool next(int i, Unit& u) const {
        const long L = (long)i * G + c; if (L >= nwg) return false;
        int wgid = (int)L; { const int q = nwg / NXCD, r = nwg % NXCD, xcd = wgid % NXCD, off = wgid / NXCD; wgid = (xcd < r ? xcd * (q + 1) : r * (q + 1) + (xcd - r) * q) + off; }
        const int nig = WGM * nN, gid = wgid / nig, fm = gid * WGM, gsz = (nM - fm) < WGM ? (nM - fm) : WGM;
        u.pm = fm + ((wgid % nig) % gsz); u.pn = (wgid % nig) / gsz; return true;
    }
    __device__ __forceinline__ void a_ready(const Unit&) const {}
    __device__ __forceinline__ void done(const Unit&) const {}
};

__device__ __forceinline__ unsigned cvt_pk_bf16(float lo, float hi) { unsigned r; asm volatile("v_cvt_pk_bf16_f32 %0, %1, %2" : "=v"(r) : "v"(lo), "v"(hi)); return r; }
typedef float f32x2 __attribute__((ext_vector_type(2)));
typedef unsigned u32x2 __attribute__((ext_vector_type(2)));
struct EpiSwiglu {
    static constexpr bool PERM = true, AFTER_DRAIN = false;
    bf16_t* O; int ldo;
    __device__ __forceinline__ void operator()(const f32x4 (&acc)[2][2][4][2], const Unit& u, int wr, int wc, int fr, int fq) const {
        { const int l_ = mk_lane_id(); fr = l_ & 15; fq = l_ >> 4; }
        const int row0 = u.pm * BM + wr * 64 + fr, col0 = u.pn * HALF + wc * 32 + 8 * fq;
#pragma unroll
        for (int ai = 0; ai < 2; ++ai)
#pragma unroll
            for (int m = 0; m < 4; ++m) { bf16_t* rowp = O + (size_t)(row0 + ai * HALF + m * 16) * ldo + col0; float r[8];
#pragma unroll
                for (int n = 0; n < 2; ++n)
#pragma unroll
                    for (int e = 0; e < 4; ++e) { const float g = acc[ai][0][m][n][e], up = acc[ai][1][m][n][e]; r[4 * n + e] = g * __builtin_amdgcn_rcpf(1.0f + __expf(-g)) * up; }
                u32x4 w; w.x = cvt_pk_bf16(r[0], r[1]); w.y = cvt_pk_bf16(r[2], r[3]); w.z = cvt_pk_bf16(r[4], r[5]); w.w = cvt_pk_bf16(r[6], r[7]);
                *(u32x4*)rowp = w; }
    }
};
struct EpiResidB {
    static constexpr bool PERM = false, AFTER_DRAIN = false;
    bf16_t* out; const bf16_t* base; const bf16_t* add; int ldc; float alpha;
    __device__ __forceinline__ void operator()(const f32x4 (&acc)[2][2][4][2], const Unit& u, int wr, int wc, int fr, int fq) const {
        { const int l_ = mk_lane_id(); fr = l_ & 15; fq = l_ >> 4; }
        const int row0 = u.pm * BM + wr * 64 + fr, col0 = u.pn * BM + wc * 32 + 4 * fq;
        const bool ha = add != nullptr;
        u32x2 hb[2][4], ab[2][4];
#define ERB_LOAD(g_, b_) { const size_t off = (size_t)(row0 + ((g_) >> 2) * HALF + ((g_) & 3) * 16) * ldc + col0; _Pragma("unroll") for (int p = 0; p < 4; ++p) { const size_t o2 = off + (p >> 1) * HALF + (p & 1) * 16; \
            hb[b_][p] = *(const u32x2*)(base + o2); if (ha) ab[b_][p] = *(const u32x2*)(add + o2); } }
        ERB_LOAD(0, 0)
#pragma unroll
        for (int g = 0; g < 8; ++g) {
            if (g + 1 < 8) ERB_LOAD(g + 1, (g + 1) & 1)
            __builtin_amdgcn_sched_barrier(0);
            const int ai = g >> 2, m = g & 3; const size_t off = (size_t)(row0 + ai * HALF + m * 16) * ldc + col0;
#pragma unroll
            for (int p = 0; p < 4; ++p) { const int bj = p >> 1, n = p & 1; const size_t o2 = off + bj * HALF + n * 16; const u32x2 h2 = hb[g & 1][p];
                f32x4 h; h[0] = __builtin_bit_cast(float, h2.x << 16); h[1] = __builtin_bit_cast(float, h2.x & 0xffff0000u); h[2] = __builtin_bit_cast(float, h2.y << 16); h[3] = __builtin_bit_cast(float, h2.y & 0xffff0000u);
                f32x4 v = h * alpha + acc[ai][bj][m][n]; if (ha) { const u32x2 a2 = ab[g & 1][p]; v[0] += __builtin_bit_cast(float, a2.x << 16); v[1] += __builtin_bit_cast(float, a2.x & 0xffff0000u); v[2] += __builtin_bit_cast(float, a2.y << 16); v[3] += __builtin_bit_cast(float, a2.y & 0xffff0000u); }
                u32x2 w; w.x = cvt_pk_bf16_c(v[0], v[1]); w.y = cvt_pk_bf16_c(v[2], v[3]); *(u32x2*)(out + o2) = w; }
            __builtin_amdgcn_sched_barrier(0);
        }
#undef ERB_LOAD
    }
};
struct EpiBf16Q {
    static constexpr bool PERM = false, AFTER_DRAIN = false;
    bf16_t* O; int ldo;
    __device__ __forceinline__ void operator()(const f32x4 (&acc)[2][2][4][2], const Unit& u, int wr, int wc, int fr, int fq) const {
        { const int l_ = mk_lane_id(); fr = l_ & 15; fq = l_ >> 4; }
        const int row0 = u.pm * BM + wr * 64 + fr, col0 = u.pn * BM + wc * 32 + 4 * fq;
#pragma unroll
        for (int ai = 0; ai < 2; ++ai)
#pragma unroll
            for (int m = 0; m < 4; ++m) { bf16_t* rowp = O + (size_t)(row0 + ai * HALF + m * 16) * ldo + col0;
#pragma unroll
                for (int bj = 0; bj < 2; ++bj)
#pragma unroll
                    for (int n = 0; n < 2; ++n) { const f32x4 v = acc[ai][bj][m][n]; u32x2 w; w.x = cvt_pk_bf16_c(v[0], v[1]); w.y = cvt_pk_bf16_c(v[2], v[3]); *(u32x2*)(rowp + bj * HALF + n * 16) = w; } }
    }
};
struct EpiSigMulB {
    static constexpr bool PERM = false, AFTER_DRAIN = false;
    bf16_t* out; const bf16_t* mul; int ldc;
    __device__ __forceinline__ void operator()(const f32x4 (&acc)[2][2][4][2], const Unit& u, int wr, int wc, int fr, int fq) const {
        { const int l_ = mk_lane_id(); fr = l_ & 15; fq = l_ >> 4; }
        const int row0 = u.pm * BM + wr * 64 + fr, col0 = u.pn * BM + wc * 32 + 4 * fq;
        u32x2 mb[2][4];
#define ESM_LOAD(g_, b_) { const size_t off = (size_t)(row0 + ((g_) >> 2) * HALF + ((g_) & 3) * 16) * ldc + col0; _Pragma("unroll") for (int p = 0; p < 4; ++p) mb[b_][p] = *(const u32x2*)(mul + off + (p >> 1) * HALF + (p & 1) * 16); }
        ESM_LOAD(0, 0)
#pragma unroll
        for (int g = 0; g < 8; ++g) {
            if (g + 1 < 8) ESM_LOAD(g + 1, (g + 1) & 1)
            __builtin_amdgcn_sched_barrier(0);
            const int ai = g >> 2, m = g & 3; const size_t off = (size_t)(row0 + ai * HALF + m * 16) * ldc + col0;
#pragma unroll
            for (int p = 0; p < 4; ++p) { const int bj = p >> 1, n = p & 1; const size_t o2 = off + bj * HALF + n * 16; const f32x4 x = acc[ai][bj][m][n]; const u32x2 pb = mb[g & 1][p];
                f32x4 pv; pv[0] = __builtin_bit_cast(float, pb.x << 16); pv[1] = __builtin_bit_cast(float, pb.x & 0xffff0000u); pv[2] = __builtin_bit_cast(float, pb.y << 16); pv[3] = __builtin_bit_cast(float, pb.y & 0xffff0000u);
                f32x4 v;
#pragma unroll
                for (int e2 = 0; e2 < 4; ++e2) v[e2] = pv[e2] * __builtin_amdgcn_rcpf(1.0f + __expf(-x[e2]));
                u32x2 w; w.x = cvt_pk_bf16_c(v[0], v[1]); w.y = cvt_pk_bf16_c(v[2], v[3]); *(u32x2*)(out + o2) = w; }
            __builtin_amdgcn_sched_barrier(0);
        }
#undef ESM_LOAD
    }
};
template <class Epi, class Sched, bool ALIGN_EPI = false, bool SP2 = false>
__device__ __forceinline__ void gemm_phase(PG8_LAS unsigned char* lds, const Gemm g, const Sched& S, const Epi& E, int wid0) {
    int tid_l = wid0 * 64 + mk_lane_id(); asm volatile("" : "+v"(tid_l));
    const int tid = tid_l, wid = __builtin_amdgcn_readfirstlane(tid >> 6), lane = tid & 63, wr = wid >> 2, wc = wid & 3, fr = lane & 15, fq = lane >> 4;
    const int K = g.K, nt = K / BK;
    unsigned voffA[2], voffB[2];
#pragma unroll
    for (int i = 0; i < 2; ++i) { int R, C; stage_rc(tid * 16 + i * 8192, R, C); const int Rb = Epi::PERM ? ((R & ~31) + perm32(R & 31)) : R;
        voffA[i] = (unsigned)(R * K + C) * 2u; voffB[i] = (unsigned)(Rb * K + C) * 2u; }
    const size_t kstep = (size_t)(BK * 2);
    const size_t hstep = (size_t)HALF * K * 2;
    const size_t tstep = 2 * hstep;
    const unsigned ldsw = (unsigned)wid * 1024u;
    const int aoff = lds_byte(wr * 64 + fr, fq * 8), boff = lds_byte(wc * 32 + fr, fq * 8);
#define PG8_SA(b, h) (((b) * 2 + (h)) * HTB)
#define PG8_SB(b, h) ((4 + (b) * 2 + (h)) * HTB)
#define PG8_STAGE(bufoff, gbase, voff) do { _Pragma("unroll") for (int _i = 0; _i < 2; ++_i) \
        __builtin_amdgcn_global_load_lds((const unsigned*)((const char*)(gbase) + (voff)[_i]), (PG8_LAS unsigned*)(lds + (bufoff) + ldsw + _i * 8192), 16, 0, 0); } while (0)
#define PG8_LDA(dst, b, h) do { _Pragma("unroll") for (int m = 0; m < 4; ++m) _Pragma("unroll") for (int k = 0; k < 2; ++k) dst[m][k] = *(const PG8_LAS bf16x8*)(lds + PG8_SA(b, h) + aoff + m * 2048 + k * 1024); } while (0)
#define PG8_LDB(dst, b, h) do { _Pragma("unroll") for (int n = 0; n < 2; ++n) _Pragma("unroll") for (int k = 0; k < 2; ++k) dst[n][k] = *(const PG8_LAS bf16x8*)(lds + PG8_SB(b, h) + boff + n * 2048 + k * 1024); } while (0)
#define PG8_MMA(ai, bj, At, Bt) do { __builtin_amdgcn_s_setprio(1); _Pragma("unroll") for (int m = 0; m < 4; ++m) _Pragma("unroll") for (int n = 0; n < 2; ++n) _Pragma("unroll") for (int k = 0; k < 2; ++k) \
        acc[ai][bj][m][n] = __builtin_amdgcn_mfma_f32_16x16x32_bf16(Bt[n][k], At[m][k], acc[ai][bj][m][n], 0, 0, 0); __builtin_amdgcn_s_setprio(0); } while (0)
#define PG8_WAIT_V(n) asm volatile("s_waitcnt vmcnt(" #n ")" ::: "memory")
#define PG8_WAIT_L(n) asm volatile("s_waitcnt lgkmcnt(" #n ")" ::: "memory")
#define PG8_BAR __builtin_amdgcn_s_barrier()
#define PG8_SCHED __builtin_amdgcn_sched_barrier(0)
    Unit cur, nxt; int ui = 0;
    if (!S.next(0, cur)) return;
    f32x4 acc[2][2][4][2];
#pragma unroll
    for (int a = 0; a < 2; ++a)
#pragma unroll
        for (int b = 0; b < 2; ++b)
#pragma unroll
            for (int m = 0; m < 4; ++m)
#pragma unroll
                for (int n = 0; n < 2; ++n) acc[a][b][m][n] = (f32x4){0.f, 0.f, 0.f, 0.f};
    bf16x8 At[4][2], B0[2][2], B1[2][2];
    const char* cA = (const char*)g.A + (size_t)cur.pm * tstep; const char* cB = (const char*)g.Bt + (size_t)cur.pn * tstep;
    S.a_ready(cur);
    if constexpr (SP2) {
        PG8_STAGE(PG8_SB(0, 0), cB, voffB); PG8_STAGE(PG8_SB(0, 1), cB + hstep, voffB); PG8_STAGE(PG8_SA(0, 0), cA, voffA); PG8_STAGE(PG8_SA(0, 1), cA + hstep, voffA);
        if (wr == 1) PG8_BAR;
        PG8_WAIT_V(2); PG8_BAR;
        PG8_STAGE(PG8_SB(1, 0), cB + kstep, voffB); PG8_STAGE(PG8_SA(1, 0), cA + kstep, voffA); PG8_STAGE(PG8_SB(1, 1), cB + hstep + kstep, voffB);
        PG8_WAIT_V(6); PG8_BAR;
    } else {
        PG8_STAGE(PG8_SB(0, 0), cB, voffB); PG8_STAGE(PG8_SA(0, 0), cA, voffA); PG8_STAGE(PG8_SB(0, 1), cB + hstep, voffB); PG8_STAGE(PG8_SA(0, 1), cA + hstep, voffA);
        if (wr == 1) PG8_BAR;
        PG8_WAIT_V(4); PG8_BAR;
        PG8_STAGE(PG8_SB(1, 0), cB + kstep, voffB); PG8_STAGE(PG8_SA(1, 0), cA + kstep, voffA); PG8_STAGE(PG8_SB(1, 1), cB + hstep + kstep, voffB);
        PG8_WAIT_V(6); PG8_BAR;
    }
    for (;;) {
        const bool has_next = S.next(ui + 1, nxt);
        const char* nA = has_next ? (const char*)g.A + (size_t)nxt.pm * tstep : cA; const char* nB = has_next ? (const char*)g.Bt + (size_t)nxt.pn * tstep : cB;
        for (int t = 0; t < nt; t += 2) {
            const bool last = (t == nt - 2);
            const char* a1 = cA + (size_t)(t + 1) * kstep;
            const char* a2 = last ? nA : cA + (size_t)(t + 2) * kstep; const char* b2 = last ? nB : cB + (size_t)(t + 2) * kstep;
            const char* a3 = a2 + kstep; const char* b3 = b2 + kstep;
            if (last && has_next) S.a_ready(nxt);
            if constexpr (SP2) {
            PG8_LDB(B0, 0, 0); PG8_LDB(B1, 0, 1); PG8_SCHED; PG8_LDA(At, 0, 0); PG8_STAGE(PG8_SA(1, 1), a1 + hstep, voffA);
            PG8_WAIT_V(8); PG8_WAIT_L(0); PG8_BAR; PG8_MMA(0, 0, At, B0); PG8_MMA(0, 1, At, B1); PG8_BAR; PG8_SCHED;
            PG8_LDA(At, 0, 1); PG8_STAGE(PG8_SB(0, 0), b2, voffB); PG8_STAGE(PG8_SB(0, 1), b2 + hstep, voffB); PG8_STAGE(PG8_SA(0, 0), a2, voffA);
            PG8_WAIT_V(8); PG8_WAIT_L(0); PG8_BAR; PG8_MMA(1, 0, At, B0); PG8_MMA(1, 1, At, B1); PG8_BAR; PG8_SCHED;
            PG8_LDB(B0, 1, 0); PG8_LDB(B1, 1, 1); PG8_SCHED; PG8_LDA(At, 1, 0); PG8_STAGE(PG8_SA(0, 1), a2 + hstep, voffA);
            PG8_WAIT_V(8); PG8_WAIT_L(0); PG8_BAR; PG8_MMA(0, 0, At, B0); PG8_MMA(0, 1, At, B1); PG8_BAR; PG8_SCHED;
            PG8_LDA(At, 1, 1); PG8_STAGE(PG8_SB(1, 0), b3, voffB); PG8_STAGE(PG8_SB(1, 1), b3 + hstep, voffB); PG8_STAGE(PG8_SA(1, 0), a3, voffA);
            PG8_WAIT_V(8); PG8_WAIT_L(0); PG8_BAR; PG8_MMA(1, 0, At, B0); PG8_MMA(1, 1, At, B1); PG8_BAR; PG8_SCHED;
            } else {
            PG8_LDB(B0, 0, 0); PG8_SCHED; PG8_LDA(At, 0, 0); PG8_STAGE(PG8_SA(1, 1), a1 + hstep, voffA);
            PG8_WAIT_L(8); PG8_BAR; PG8_WAIT_L(0); PG8_MMA(0, 0, At, B0); PG8_BAR; PG8_SCHED;
            PG8_LDB(B1, 0, 1); PG8_STAGE(PG8_SB(0, 0), b2, voffB);
            PG8_BAR; PG8_WAIT_L(0); PG8_MMA(0, 1, At, B1); PG8_BAR;
            PG8_LDA(At, 0, 1); PG8_STAGE(PG8_SA(0, 0), a2, voffA);
            PG8_BAR; PG8_WAIT_L(0); PG8_MMA(1, 0, At, B0); PG8_BAR; PG8_SCHED;
            PG8_STAGE(PG8_SB(0, 1), b2 + hstep, voffB);
            PG8_WAIT_V(6); PG8_BAR; PG8_MMA(1, 1, At, B1); PG8_BAR;
            PG8_LDB(B0, 1, 0); PG8_SCHED; PG8_LDA(At, 1, 0); PG8_STAGE(PG8_SA(0, 1), a2 + hstep, voffA);
            PG8_WAIT_L(8); PG8_BAR; PG8_WAIT_L(0); PG8_MMA(0, 0, At, B0); PG8_BAR; PG8_SCHED;
            PG8_LDB(B1, 1, 1); PG8_STAGE(PG8_SB(1, 0), b3, voffB);
            PG8_BAR; PG8_WAIT_L(0); PG8_MMA(0, 1, At, B1); PG8_BAR;
            PG8_LDA(At, 1, 1); PG8_STAGE(PG8_SA(1, 0), a3, voffA);
            PG8_BAR; PG8_WAIT_L(0); PG8_MMA(1, 0, At, B0); PG8_BAR; PG8_SCHED;
            PG8_STAGE(PG8_SB(1, 1), b3 + hstep, voffB);
            PG8_WAIT_V(6); PG8_BAR; PG8_MMA(1, 1, At, B1); PG8_BAR;
            }
        }
        if constexpr (ALIGN_EPI) { if (wr == 0) PG8_BAR; }
        if constexpr (!Epi::AFTER_DRAIN) { E(acc, cur, wr, wc, fr, fq); S.done(cur); }
        if (!has_next) break;
#pragma unroll
        for (int a = 0; a < 2; ++a)
#pragma unroll
            for (int b = 0; b < 2; ++b)
#pragma unroll
                for (int m = 0; m < 4; ++m)
#pragma unroll
                    for (int n = 0; n < 2; ++n) acc[a][b][m][n] = (f32x4){0.f, 0.f, 0.f, 0.f};
        cur = nxt; cA = nA; cB = nB; ++ui;
        if constexpr (ALIGN_EPI) { if (wr == 1) PG8_BAR; }
    }
    PG8_WAIT_V(0);
    if constexpr (!ALIGN_EPI) { if (wr == 0) PG8_BAR; }
    PG8_BAR;
    if constexpr (Epi::AFTER_DRAIN) { E.fused(acc, cur, wr, wc, fr, fq, lds, wid, lane); S.done(cur); }
#undef PG8_SA
#undef PG8_SB
#undef PG8_STAGE
#undef PG8_LDA
#undef PG8_LDB
#undef PG8_MMA
#undef PG8_WAIT_V
#undef PG8_WAIT_L
#undef PG8_BAR
#undef PG8_SCHED
}
}
#define GAS __attribute__((address_space(1)))
#define LAS __attribute__((address_space(3)))
typedef unsigned short bf16;
typedef unsigned v4u __attribute__((ext_vector_type(4)));
typedef float f32x4 __attribute__((ext_vector_type(4)));
typedef short bf16x8 __attribute__((ext_vector_type(8)));
typedef GAS unsigned gu32;
typedef GAS unsigned long long gu64;
#define RLX_AGENT __ATOMIC_RELAXED, __HIP_MEMORY_SCOPE_AGENT
#define LDS_WAIT() asm volatile("s_waitcnt lgkmcnt(0)" ::: "memory")
#define VM_WAIT() asm volatile("s_waitcnt vmcnt(0)" ::: "memory")
__device__ __forceinline__ unsigned long long rt() { return __builtin_amdgcn_s_memrealtime(); }
__device__ __forceinline__ unsigned f2bf(float f) { unsigned u = __builtin_bit_cast(unsigned, f); return (u + 0x7fffu + ((u >> 16) & 1u)) >> 16; }
__device__ __forceinline__ unsigned pk2(float lo, float hi) { return f2bf(lo) | (f2bf(hi) << 16); }

#define XB_TMO      128
#define XB_XCNT(j)  (256  + 64 * (j))
#define XB_XSUB(j)  (1280 + 64 * (j))
#define XB_XGEN(j)  (2304 + 64 * (j))
#define XB_TOP      3328
#define XB_TOPGEN   3392
#define XCD_BAR_WORDS 3456
#define XB_SPIN_CAP (1u << 18)

__device__ __forceinline__ unsigned xb_ld(unsigned* p)              { return __hip_atomic_load(p, __ATOMIC_RELAXED, __HIP_MEMORY_SCOPE_AGENT); }
__device__ __forceinline__ unsigned xb_add(unsigned* p, unsigned v) { return __hip_atomic_fetch_add(p, v, __ATOMIC_RELAXED, __HIP_MEMORY_SCOPE_AGENT); }
__device__ __forceinline__ unsigned xb_xcc_id() { return (unsigned)__builtin_amdgcn_s_getreg((3 << 11) | 20) & 0xFu; }
#define XB_SPIN(cond, bar) do { unsigned _sp = 0; while (cond) { __builtin_amdgcn_s_sleep(1); \
    if ((++_sp & 255u) == 0u) { if (xb_ld(&(bar)[XB_TMO])) break; if (_sp > XB_SPIN_CAP) { atomicAdd(&(bar)[XB_TMO], 1u); break; } } } } while (0)

struct XcdBarrier {
    unsigned* bar; unsigned x;
    volatile LAS unsigned* st;
    bool w0;
};

__device__ __forceinline__ XcdBarrier xcd_barrier_post(unsigned* bar, volatile LAS unsigned* st) {
    XcdBarrier b; b.bar = bar; b.x = xb_xcc_id(); b.st = st;
    if (threadIdx.x == 0) (void)xb_add(&bar[XB_XCNT(b.x)], 1u);
    return b;
}
__device__ __forceinline__ void xcd_barrier_complete(unsigned* bar, unsigned x, unsigned& nloc, unsigned& nx) {
    const unsigned G = gridDim.x * gridDim.y * gridDim.z;
    unsigned sum, cnt, mine, sp = 0u;
    for (;;) {
        sum = 0u; cnt = 0u; mine = 0u;
#pragma unroll 1
        for (unsigned j = 0; j < 16; ++j) { const unsigned c = xb_ld(&bar[XB_XCNT(j)]); sum += c; cnt += (c > 0u) ? 1u : 0u; mine = (j == x) ? c : mine; }
        if (sum == G) break;
        __builtin_amdgcn_s_sleep(1);
        if ((++sp & 255u) == 0u) { if (xb_ld(&bar[XB_TMO])) break; if (sp > XB_SPIN_CAP) { atomicAdd(&bar[XB_TMO], 1u); break; } }
    }
    nloc = mine > 0u ? mine : 1u; nx = cnt > 0u ? cnt : 1u;
}

__device__ __forceinline__ void xcd_barrier(const XcdBarrier& b) {
    asm volatile("s_waitcnt vmcnt(0)" ::: "memory");
    __syncthreads();
    if (b.w0 && mk_lane_id() == 0) {
        unsigned* bar = b.bar;
        __builtin_amdgcn_s_waitcnt(0);
        unsigned nloc = b.st[0], nx = b.st[1];
        if (nloc == 0u) { xcd_barrier_complete(bar, b.x, nloc, nx); b.st[0] = nloc; b.st[1] = nx; }
        const unsigned old = xb_add(&bar[XB_XSUB(b.x)], 1u);
        const unsigned gen = old / nloc;
        if (old + 1u == (gen + 1u) * nloc) {
            __builtin_amdgcn_fence(__ATOMIC_RELEASE, "agent");
            asm volatile("s_waitcnt vmcnt(0)" ::: "memory");
            const unsigned og = xb_add(&bar[XB_TOP], 1u);
            const unsigned tg = og / nx;
            if (og + 1u == (tg + 1u) * nx) xb_add(&bar[XB_TOPGEN], 1u);
            else XB_SPIN(xb_ld(&bar[XB_TOPGEN]) == tg, bar);
            __builtin_amdgcn_fence(__ATOMIC_ACQUIRE, "agent");
            xb_add(&bar[XB_XGEN(b.x)], 1u);
            asm volatile("s_waitcnt vmcnt(0)" ::: "memory");
        } else {
            XB_SPIN(xb_ld(&bar[XB_XGEN(b.x)]) == gen, bar);
            __builtin_amdgcn_fence(__ATOMIC_ACQUIRE, "agent");
            asm volatile("s_waitcnt vmcnt(0)" ::: "memory");
        }
    }
    __syncthreads();
}
#ifndef REP_PHASE
#define REP_PHASE -1
#endif
#define NREP(k) ((REP_PHASE) == (k) ? 2 : 1)

constexpr int DM = 2048, NBAT = 4, SEQ = 2048, DEPTH = 4, NS = 128;
constexpr int MP = NBAT * SEQ;
constexpr int MV = MP + NS;
constexpr int MPAD = 8448;
constexpr int WA = 512, WB = 768, WC = 768, PIN = 6656, DFF = 5632, DPLE = 256, PBW = 2560;
constexpr int OFF_B = 1024, OFF_C = 3584;
constexpr float LN_EPS = 1e-5f, GN_EPS = 64e-5f, RMS_EPS = 1e-6f;
constexpr float DN_ALPHA = 1.681792830507429f;
enum { I_XP = 0, I_XS, I_SRWKV, I_SSHIFT, I_SHGRN, I_PP, I_PS, I_LNING, I_LNINB, I_WIN, I_ALNG, I_ALNB, I_AWS, I_ABS, I_BMU, I_BW0, I_BWUP, I_BA0, I_BAUP, I_BGUP,
       I_BKK, I_BKA, I_BRK, I_BGNG, I_BGNB, I_CLB, I_CNG, I_WOUT, I_LN1G, I_LN1B, I_WG, I_WU, I_WD, I_WPG, I_WPP, I_LN2G, I_LN2B, N_IN };
constexpr size_t O_YP = 0, O_YS = O_YP + (size_t)MP * DM, O_RP = O_YS + (size_t)NS * DM, O_SP = O_RP + (size_t)DEPTH * NBAT * 12 * 4096,
                 O_HP = O_SP + (size_t)DEPTH * NBAT * PBW, O_RS = O_HP + (size_t)DEPTH * NBAT * 6 * 16384, O_SS = O_RS + (size_t)DEPTH * NS * 12 * 4096,
                 O_HS = O_SS + (size_t)DEPTH * NS * PBW, O_VS = O_HS + (size_t)DEPTH * NS * 6 * 16384, O_END = O_VS + (size_t)DEPTH * NS * WA;
static_assert(O_END == 96509952, "output size");
constexpr size_t al256(size_t x) { return (x + 255) & ~(size_t)255; }
constexpr size_t WS_CTL = 0, CTL_ZERO_BYTES = 1u << 20;
constexpr size_t SZ_WIN = (size_t)PIN * DM * 2, SZ_WOUT = (size_t)DM * DM * 2, SZ_WGU = (size_t)2 * DFF * DM * 2, SZ_WD = (size_t)DM * DFF * 2, SZ_WPG = SZ_WOUT, SZ_WPP = (size_t)DM * DPLE * 2;
constexpr size_t WS_WIN = CTL_ZERO_BYTES, WS_WOUT = WS_WIN + DEPTH * SZ_WIN, WS_WGU = WS_WOUT + DEPTH * SZ_WOUT, WS_WD = WS_WGU + DEPTH * SZ_WGU, WS_WPG = WS_WD + DEPTH * SZ_WD,
                 WS_WPP = WS_WPG + DEPTH * SZ_WPG, WS_PBF = WS_WPP + DEPTH * SZ_WPP;
constexpr size_t SZ_PBF = (size_t)MPAD * DPLE * 2;
constexpr size_t WS_H = WS_PBF + DEPTH * SZ_PBF, WS_HB = WS_H + (size_t)MPAD * DM * 4, WS_T = WS_HB + (size_t)MPAD * DM * 2, WS_YMIX = WS_T + (size_t)MPAD * DM * 4;
constexpr size_t WS_Z = WS_YMIX + (size_t)MPAD * DM * 2;
constexpr size_t WS_ACT = WS_Z, WS_PLE = WS_ACT + al256((size_t)MPAD * DFF * 2);
constexpr size_t WS_PPO = WS_Z + (size_t)MPAD * PIN * 4;
static_assert(WS_PLE + (size_t)MPAD * DM * 4 <= WS_PPO, "overlay fits");
constexpr size_t WS_RPB = WS_PPO + (size_t)MPAD * DM * 4;
constexpr size_t WS_RPS = WS_RPB + (size_t)NBAT * 12 * (SEQ / 16) * 16384;
constexpr int NLORA = 3 * WB;
constexpr size_t SZ_WL = (size_t)NLORA * 256 * 2;
constexpr size_t WS_WL = WS_RPS + (size_t)NS * 12 * 384 * 4;
constexpr size_t WS_XCAT = WS_WL + DEPTH * SZ_WL;
constexpr size_t WS_LORA = WS_XCAT + (size_t)MPAD * 256 * 2;
constexpr size_t WS_Y = WS_LORA + (size_t)MPAD * NLORA * 4;
constexpr size_t WS_O = WS_Y + (size_t)MPAD * WB * 4;
constexpr size_t WS_HREC = WS_O + (size_t)MPAD * WC * 4;
constexpr size_t WS_XB = WS_HREC + (size_t)NBAT * 6 * (SEQ / 16) * 17408;
constexpr size_t WS_END = WS_XB + 2 * (size_t)MP * 8 * 8;
constexpr int CW_SEAM = 16384;
static_assert(WS_WIN % 256 == 0 && WS_H % 256 == 0 && WS_Z % 256 == 0 && WS_RPB % 256 == 0 && WS_WL % 256 == 0 && WS_XCAT % 256 == 0 && WS_LORA % 256 == 0 && WS_Y % 256 == 0, "alignment");
constexpr int CW_BAR = 4096;

constexpr int RING_BYTES = 131072, LDSCTL_OFF = RING_BYTES, MISC_OFF = LDSCTL_OFF + 320, LDS_BYTES = 147456;
constexpr int NWAVES = 8, NTHR = 512;

struct Args { const float* in[N_IN]; float* out; unsigned char* ws; int ph_lo, ph_hi; };
static_assert(sizeof(Args) == (N_IN + 2) * 8 + 8, "no padding in Args");
typedef const __attribute__((address_space(4))) Args* ArgsP;

__device__ __forceinline__ size_t wso(size_t c) { asm volatile("" : "+s"(c)); return c; }
typedef float f4 __attribute__((ext_vector_type(4)));
typedef float f2 __attribute__((ext_vector_type(2)));
typedef unsigned u2 __attribute__((ext_vector_type(2)));

template <int CTRL> __device__ __forceinline__ float dpp_f(float x) { return __builtin_bit_cast(float, __builtin_amdgcn_update_dpp(0, __builtin_bit_cast(int, x), CTRL, 0xF, 0xF, true)); }
__device__ __forceinline__ float row16_sum(float x) {
    x += dpp_f<0xB1>(x);
    x += dpp_f<0x4E>(x);
    x += dpp_f<0x141>(x);
    x += dpp_f<0x140>(x);
    return x;
}
__device__ __forceinline__ float readlane_f(float x, int l) { return __builtin_bit_cast(float, __builtin_amdgcn_readlane(__builtin_bit_cast(int, x), l)); }
template <int CTRL, int RM> __device__ __forceinline__ float dpp_fm(float x) { return __builtin_bit_cast(float, __builtin_amdgcn_update_dpp(0, __builtin_bit_cast(int, x), CTRL, RM, 0xF, false)); }
__device__ __forceinline__ float wave_sum_fast(float x) { x = row16_sum(x); x += dpp_fm<0x142, 0xA>(x); x += dpp_fm<0x143, 0xC>(x); return readlane_f(x, 63); }
__device__ __forceinline__ float wave_sum(float v) { return wave_sum_fast(v); }
__device__ __forceinline__ float sigmoidf_(float x) { return 1.0f / (1.0f + expf(-x)); }
__device__ __forceinline__ float gelu_erf(float x) { return 0.5f * x * (1.0f + erff(x * 0.70710678118654752f)); }
__device__ __forceinline__ unsigned short bf1(float x) { return (unsigned short)(cvt_pk_bf16_c(x, 0.f) & 0xffffu); }
__device__ __forceinline__ float bfl(unsigned short u) { return __builtin_bit_cast(float, (unsigned)u << 16); }
__device__ __forceinline__ f4 bf4(u2 w) { f4 v; v.x = __builtin_bit_cast(float, w.x << 16); v.y = __builtin_bit_cast(float, w.x & 0xffff0000u); v.z = __builtin_bit_cast(float, w.y << 16); v.w = __builtin_bit_cast(float, w.y & 0xffff0000u); return v; }
__device__ __forceinline__ float lbound(const float* clb, int L, int c) {
    const float x0 = clb[c], x1 = clb[WC + c], x2 = clb[2 * WC + c], x3 = clb[3 * WC + c];
    const float mx = fmaxf(fmaxf(x0, x1), fmaxf(x2, x3));
    const float e0 = expf(x0 - mx), e1 = expf(x1 - mx), e2 = expf(x2 - mx), e3 = expf(x3 - mx);
    float s = 0.f; if (L >= 1) s += e1; if (L >= 2) s += e2; if (L >= 3) s += e3;
    return s / (e0 + e1 + e2 + e3);
}
__device__ __forceinline__ float lbound_v(float x0, float x1, float x2, float x3, int L) {
    const float mx = fmaxf(fmaxf(x0, x1), fmaxf(x2, x3));
    const float e0 = __expf(x0 - mx), e1 = __expf(x1 - mx), e2 = __expf(x2 - mx), e3 = __expf(x3 - mx);
    float s = 0.f; if (L >= 1) s += e1; if (L >= 2) s += e2; if (L >= 3) s += e3;
    return s * __builtin_amdgcn_rcpf(e0 + e1 + e2 + e3);
}

__device__ __forceinline__ void tr_item(const float* W, int K, int N, bf16* WT, int mode, LAS float* scr, int item, int lane) {
    const int nblk = N >> 5, kb = item / nblk, nb = item - kb * nblk, k0 = kb << 6, n0 = nb << 5;
    int rb = n0; if (mode) rb = ((n0 >> 7) << 8) + (n0 & 127) + (mode == 2 ? 128 : 0);
#pragma unroll 8
    for (int i = 0; i < 32; ++i) { const int kk = 2 * i + (lane >> 5); scr[kk * 33 + (lane & 31)] = W[(size_t)(k0 + kk) * N + n0 + (lane & 31)]; }
    LDS_WAIT(); asm volatile("" ::: "memory");
    const int c = lane & 7;
#pragma unroll
    for (int j = 0; j < 4; ++j) { const int n = (lane >> 3) + 8 * j; const LAS float* s = scr + (8 * c) * 33 + n;
        v4u o; o.x = pg8::cvt_pk_bf16(s[0 * 33], s[1 * 33]); o.y = pg8::cvt_pk_bf16(s[2 * 33], s[3 * 33]); o.z = pg8::cvt_pk_bf16(s[4 * 33], s[5 * 33]); o.w = pg8::cvt_pk_bf16(s[6 * 33], s[7 * 33]);
        *(v4u*)(WT + (size_t)(rb + n) * K + k0 + 8 * c) = o; }
    LDS_WAIT(); asm volatile("" ::: "memory");
}
__device__ __forceinline__ void ln_regs(f4 (&v)[8], const f4 (&gg)[8], const f4 (&bb)[8], float* dstf, bf16* dstb, float* dst2, int lane) {
    float s = 0.f;
#pragma unroll
    for (int j = 0; j < 8; ++j) s += (v[j].x + v[j].y) + (v[j].z + v[j].w);
    const float mean = wave_sum(s) * (1.f / DM); float s2 = 0.f;
#pragma unroll
    for (int j = 0; j < 8; ++j) { v[j] = v[j] - mean; s2 += (v[j].x * v[j].x + v[j].y * v[j].y) + (v[j].z * v[j].z + v[j].w * v[j].w); }
    const float rstd = 1.0f / sqrtf(wave_sum(s2) * (1.f / DM) + LN_EPS);
#pragma unroll
    for (int j = 0; j < 8; ++j) { const int c = 4 * (lane + 64 * j); const f4 o = v[j] * rstd * gg[j] + bb[j]; v[j] = o;
        u2 w; w.x = pg8::cvt_pk_bf16(o.x, o.y); w.y = pg8::cvt_pk_bf16(o.z, o.w); *(u2*)(dstb + c) = w; }
    if (dstf) {
#pragma unroll
        for (int j = 0; j < 8; ++j) *(f4*)(dstf + 4 * (lane + 64 * j)) = v[j]; }
    if (dst2) {
#pragma unroll
        for (int j = 0; j < 8; ++j) *(f4*)(dst2 + 4 * (lane + 64 * j)) = v[j]; }
}
__device__ __forceinline__ void phase_prologue(ArgsP a, LAS unsigned char* lds, int lane, int wave, int blk, int G) {
    LAS float* scr = (LAS float*)(lds + wave * 16384);
    const int gw = blk * NWAVES + wave, NGW = G * NWAVES;
    constexpr int I_IN = 32 * (PIN / 32), I_OUT = 32 * (DM / 32), I_G = 32 * (DFF / 32), I_D = (DFF / 64) * (DM / 32), I_PGc = I_OUT, I_PPc = (DPLE / 64) * (DM / 32);
    constexpr int PER_L = I_IN + I_OUT + 2 * I_G + I_D + I_PGc + I_PPc;
    unsigned char* ws = a->ws;
    for (int it = gw; it < DEPTH * PER_L; it += NGW) {
        const int L = it / PER_L; int r = it - L * PER_L;
        if (r < I_IN) { tr_item(a->in[I_WIN] + (size_t)L * DM * PIN, DM, PIN, (bf16*)(ws + wso(WS_WIN) + L * SZ_WIN), 0, scr, r, lane); continue; } r -= I_IN;
        if (r < I_OUT) { tr_item(a->in[I_WOUT] + (size_t)L * DM * DM, DM, DM, (bf16*)(ws + wso(WS_WOUT) + L * SZ_WOUT), 0, scr, r, lane); continue; } r -= I_OUT;
        if (r < I_G) { tr_item(a->in[I_WG] + (size_t)L * DM * DFF, DM, DFF, (bf16*)(ws + wso(WS_WGU) + L * SZ_WGU), 1, scr, r, lane); continue; } r -= I_G;
        if (r < I_G) { tr_item(a->in[I_WU] + (size_t)L * DM * DFF, DM, DFF, (bf16*)(ws + wso(WS_WGU) + L * SZ_WGU), 2, scr, r, lane); continue; } r -= I_G;
        if (r < I_D) { tr_item(a->in[I_WD] + (size_t)L * DFF * DM, DFF, DM, (bf16*)(ws + wso(WS_WD) + L * SZ_WD), 0, scr, r, lane); continue; } r -= I_D;
        if (r < I_PGc) { tr_item(a->in[I_WPG] + (size_t)L * DM * DM, DM, DM, (bf16*)(ws + wso(WS_WPG) + L * SZ_WPG), 0, scr, r, lane); continue; } r -= I_PGc;
        tr_item(a->in[I_WPP] + (size_t)L * DPLE * DM, DPLE, DM, (bf16*)(ws + wso(WS_WPP) + L * SZ_WPP), 0, scr, r, lane);
    }
    for (int it = gw; it < DEPTH * NLORA; it += NGW) { const int L = it / NLORA, n = it - L * NLORA; float v[4];
#pragma unroll
        for (int e = 0; e < 4; ++e) { const int k = 4 * lane + e; float x = 0.f;
            if (n < WB) { if (k < 64) x = a->in[I_BWUP][((size_t)L * 64 + k) * WB + n]; }
            else if (n < 2 * WB) { if (k >= 64 && k < 128) x = a->in[I_BAUP][((size_t)L * 64 + (k - 64)) * WB + (n - WB)]; }
            else { if (k >= 128) x = a->in[I_BGUP][((size_t)L * 128 + (k - 128)) * WB + (n - 2 * WB)]; }
            v[e] = x; }
        u2 w; w.x = pg8::cvt_pk_bf16(v[0], v[1]); w.y = pg8::cvt_pk_bf16(v[2], v[3]); *(u2*)((bf16*)(ws + wso(WS_WL) + L * SZ_WL) + (size_t)n * 256 + 4 * lane) = w; }
    for (int it = gw; it < DEPTH * MV; it += NGW) { const int L = it / MV, m = it - L * MV;
        const float* src = (m < MP) ? a->in[I_PP] + ((size_t)L * MP + m) * DPLE : a->in[I_PS] + ((size_t)L * NS + (m - MP)) * DPLE;
        const f4 v = *(const f4*)(src + 4 * lane); u2 w; w.x = pg8::cvt_pk_bf16(v.x, v.y); w.y = pg8::cvt_pk_bf16(v.z, v.w);
        *(u2*)((bf16*)(ws + wso(WS_PBF) + L * SZ_PBF) + (size_t)m * DPLE + 4 * lane) = w; }
    { f4 gg[8], bb[8];
#pragma unroll
      for (int j = 0; j < 8; ++j) { gg[j] = *(const f4*)(a->in[I_LNING] + 4 * (lane + 64 * j)); bb[j] = *(const f4*)(a->in[I_LNINB] + 4 * (lane + 64 * j)); }
      for (int mb = gw; mb < MV; mb += 2 * NGW) { const bool h1 = mb + NGW < MV; const int m1 = h1 ? mb + NGW : mb;
        const float* s0 = (mb < MP) ? a->in[I_XP] + (size_t)mb * DM : a->in[I_XS] + (size_t)(mb - MP) * DM; const float* s1 = (m1 < MP) ? a->in[I_XP] + (size_t)m1 * DM : a->in[I_XS] + (size_t)(m1 - MP) * DM;
        f4 v0[8], v1[8];
#pragma unroll
        for (int j = 0; j < 8; ++j) { v0[j] = *(const f4*)(s0 + 4 * (lane + 64 * j)); v1[j] = *(const f4*)(s1 + 4 * (lane + 64 * j)); }
        __builtin_amdgcn_sched_barrier(0);
        ln_regs(v0, gg, bb, (mb < MP) ? nullptr : (float*)(ws + wso(WS_H)) + (size_t)mb * DM, (bf16*)(ws + wso(WS_HB)) + (size_t)mb * DM, nullptr, lane);
        if (h1) ln_regs(v1, gg, bb, (m1 < MP) ? nullptr : (float*)(ws + wso(WS_H)) + (size_t)m1 * DM, (bf16*)(ws + wso(WS_HB)) + (size_t)m1 * DM, nullptr, lane); } }
}
__device__ __forceinline__ void phase_ln(ArgsP a, const float* g, const float* b, bool last, int lane, int wave, int blk, int G) {
    const int gw = blk * NWAVES + wave, NGW = G * NWAVES; unsigned char* ws = a->ws;
    f4 gg[8], bb[8];
#pragma unroll
    for (int j = 0; j < 8; ++j) { gg[j] = *(const f4*)(g + 4 * (lane + 64 * j)); bb[j] = *(const f4*)(b + 4 * (lane + 64 * j)); }
    const bf16* Tb = (const bf16*)(ws + wso(WS_T));
    for (int mb = gw; mb < MP; mb += 4 * NGW) {
        u2 raw[4][8];
#pragma unroll
        for (int k = 0; k < 4; ++k) { const int m = mb + k * NGW < MP ? mb + k * NGW : mb;
#pragma unroll
            for (int j = 0; j < 8; ++j) raw[k][j] = *(const u2*)(Tb + (size_t)m * DM + 4 * (lane + 64 * j)); }
        __builtin_amdgcn_sched_barrier(0);
#pragma unroll
        for (int k = 0; k < 4; ++k) { const int m = mb + k * NGW; if (m < MP) { f4 v[8];
#pragma unroll
            for (int j = 0; j < 8; ++j) { const u2 w = raw[k][j]; v[j].x = __builtin_bit_cast(float, w.x << 16); v[j].y = __builtin_bit_cast(float, w.x & 0xffff0000u);
                v[j].z = __builtin_bit_cast(float, w.y << 16); v[j].w = __builtin_bit_cast(float, w.y & 0xffff0000u); }
            ln_regs(v, gg, bb, nullptr, (bf16*)(ws + wso(WS_HB)) + (size_t)m * DM, last ? a->out + O_YP + (size_t)m * DM : nullptr, lane); } }
    }
    for (int m = MP + gw; m < MV; m += NGW) { f4 v[8]; const float* src = (const float*)(ws + wso(WS_T)) + (size_t)m * DM;
#pragma unroll
        for (int j = 0; j < 8; ++j) v[j] = *(const f4*)(src + 4 * (lane + 64 * j));
        ln_regs(v, gg, bb, (float*)(ws + wso(WS_H)) + (size_t)m * DM, (bf16*)(ws + wso(WS_HB)) + (size_t)m * DM, last ? a->out + O_YS + (size_t)(m - MP) * DM : nullptr, lane); }
}


__device__ __forceinline__ void phase_fin(ArgsP a, int L, LAS unsigned char* lds, int lane, int wave, int blk, int G) {
    unsigned char* ws = a->ws; const int gw = blk * NWAVES + wave, NGW = G * NWAVES;
    const float* Z = (const float*)(ws + wso(WS_Z));
    const float* mu = a->in[I_BMU] + L * PBW; const float* w0 = a->in[I_BW0] + L * WB; const float* a0 = a->in[I_BA0] + L * WB;
    const float* k_k = a->in[I_BKK] + L * WB; const float* k_a = a->in[I_BKA] + L * WB; const float* sh0 = a->in[I_SSHIFT] + (size_t)L * NS * PBW;
    const float* w_up = a->in[I_BWUP] + (size_t)L * 64 * WB; const float* a_up = a->in[I_BAUP] + (size_t)L * 64 * WB; const float* g_up = a->in[I_BGUP] + (size_t)L * 128 * WB;
    LAS float* xs = (LAS float*)(lds + wave * 16384);
    if (gw >= NGW / 2) for (int p = gw - NGW / 2; p < NS * 12 + NBAT; p += NGW / 2) {
        if (p >= NS * 12) { const int b = p - NS * 12; const bf16* zr = (const bf16*)(ws + wso(WS_Z)) + (size_t)(b * SEQ + SEQ - 1) * PIN + OFF_B; float* dst = a->out + O_SP + ((size_t)L * NBAT + b) * PBW;
#pragma unroll
            for (int j = 0; j < PBW / 256; ++j) *(f4*)(dst + 256 * j + 4 * lane) = bf4(*(const u2*)(zr + 256 * j + 4 * lane));
            continue; }
        const int i = p / 12, j = p - 12 * i, m = MP + i, c = 64 * j + lane;
        const float* zr = Z + (size_t)m * PIN + OFF_B; const float* pz = sh0 + (size_t)i * PBW;
        { const f4 cur = *(const f4*)(zr + 2304 + 4 * lane), prev = *(const f4*)(pz + 2304 + 4 * lane), mu4 = *(const f4*)(mu + 2304 + 4 * lane); f4 x = cur + mu4 * (prev - cur);
          { const float sc = lane < 16 ? 2.0f : 1.0f, of = lane < 16 ? -1.0f : 0.0f; const bool idn = lane >= 16 && lane < 32;
#pragma unroll
            for (int e = 0; e < 4; ++e) { const float sg = sc * __builtin_amdgcn_rcpf(1.0f + __expf(-sc * x[e])) + of; x[e] = idn ? x[e] : sg; } }
          *(LAS f4*)(xs + 4 * lane) = x; }
        LDS_WAIT(); asm volatile("" ::: "memory");
        float lw = 0.f, la = 0.f, lg = 0.f;
#pragma unroll 1
        for (int k0 = 0; k0 < 64; k0 += 32) { float wv[32], av[32];
#pragma unroll
            for (int u = 0; u < 32; ++u) { wv[u] = w_up[(size_t)(k0 + u) * WB + c]; av[u] = a_up[(size_t)(k0 + u) * WB + c]; }
            __builtin_amdgcn_sched_barrier(0);
#pragma unroll
            for (int u = 0; u < 32; ++u) { lw += xs[k0 + u] * wv[u]; la += xs[64 + k0 + u] * av[u]; }
            __builtin_amdgcn_sched_barrier(0); }
#pragma unroll 1
        for (int k0 = 0; k0 < 128; k0 += 64) { float gv[64];
#pragma unroll
            for (int u = 0; u < 64; ++u) gv[u] = g_up[(size_t)(k0 + u) * WB + c];
            __builtin_amdgcn_sched_barrier(0);
#pragma unroll
            for (int u = 0; u < 64; ++u) lg += xs[128 + k0 + u] * gv[u];
            __builtin_amdgcn_sched_barrier(0); }
        ((float*)(ws + wso(WS_LORA)))[(size_t)m * NLORA + 2 * WB + c] = lg;
        const float cr = zr[c], ck = zr[WB + c], cv = zr[2 * WB + c], pr = pz[c], pk = pz[WB + c], pv = pz[2 * WB + c];
        const float r = cr + mu[c] * (pr - cr), k = ck + mu[WB + c] * (pk - ck), v = cv + mu[2 * WB + c] * (pv - cv);
        const float dec = __expf(-0.6065306597126334f * __builtin_amdgcn_rcpf(1.0f + __expf(-(w0[c] + lw))));
        const float av = __builtin_amdgcn_rcpf(1.0f + __expf(-(a0[c] + la)));
        const float kkr = k * k_k[c]; const float ss = wave_sum(kkr * kkr); const float kk = kkr * __builtin_amdgcn_rsqf(fmaxf(ss, 1e-24f));
        const float kp = k * (1.0f + (av - 1.0f) * k_a[c]);
        float* rec = (float*)(ws + wso(WS_RPS)) + ((size_t)i * 12 + j) * 384;
        rec[lane] = r; rec[64 + lane] = dec; rec[128 + lane] = kp; rec[192 + lane] = v; rec[256 + lane] = kk; rec[320 + lane] = kk * av;
        LDS_WAIT(); asm volatile("" ::: "memory");
    }
    for (int i = gw - (NGW - NS); i >= 0 && i < NS; i += NGW) { const int m = MP + i; const float* zr = Z + (size_t)m * PIN + OFF_B;
            float* dst = a->out + O_SS + ((size_t)L * NS + i) * PBW;
#pragma unroll
            for (int q = 0; q < PBW / 256; ++q) *(f4*)(dst + 256 * q + 4 * lane) = *(const f4*)(zr + 256 * q + 4 * lane);
            const float* z0 = Z + (size_t)m * PIN; const float* lng = a->in[I_ALNG] + L * WA; const float* lnb = a->in[I_ALNB] + L * WA;
            for (int g = 0; g < 4; ++g) {
                const float u0 = gelu_erf(z0[g * 128 + lane]), u1 = gelu_erf(z0[g * 128 + 64 + lane]);
                const float v0 = gelu_erf(z0[WA + g * 128 + lane]), v1 = gelu_erf(z0[WA + g * 128 + 64 + lane]);
                const float mean = wave_sum(v0 + v1) * (1.f / 128.f); const float d0 = v0 - mean, d1 = v1 - mean;
                const float rstd = 1.0f / sqrtf(wave_sum(d0 * d0 + d1 * d1) * (1.f / 128.f) + LN_EPS);
                const float n0 = d0 * rstd * lng[g * 128 + lane] + lnb[g * 128 + lane], n1 = d1 * rstd * lng[g * 128 + 64 + lane] + lnb[g * 128 + 64 + lane];
                float* ov = a->out + O_VS + ((size_t)L * NS + i) * WA + g * 128; ov[lane] = n0; ov[64 + lane] = n1;
                const float w00 = a->in[I_AWS][(size_t)(L * 4 + g) * 16384], b0 = a->in[I_ABS][(L * 4 + g) * 128];
                bf16* yo = (bf16*)(ws + wso(WS_YMIX)) + (size_t)m * DM + g * 128; yo[lane] = bf1(u0 * (w00 * n0 + b0)); yo[64 + lane] = bf1(u1 * (w00 * n1 + b0)); }
    }
}

__device__ __forceinline__ void rwkv_sample_item(ArgsP a, int L, int item, LAS unsigned char* lds, int lane, int wave) {
    unsigned char* ws = a->ws;
    const int ih = item * 8 + wave, i = ih / 12, h = ih - i * 12;
    const float* rec = (const float*)(ws + wso(WS_RPS)) + (size_t)ih * 384;
    LAS float* sc = (LAS float*)(lds + wave * 2048);
    const float r = rec[lane], w = rec[64 + lane], k = rec[128 + lane], v = rec[192 + lane], kk = rec[256 + lane], ka = rec[320 + lane];
    sc[lane] = r; sc[64 + lane] = w; sc[128 + lane] = k; sc[192 + lane] = kk; sc[256 + lane] = ka;
    LDS_WAIT(); asm volatile("" ::: "memory");
    const f4* S0p = (const f4*)(a->in[I_SRWKV] + (((size_t)L * NS + i) * 12 + h) * 4096 + lane * 64);
    f4 S[16];
#pragma unroll
    for (int j = 0; j < 16; ++j) S[j] = S0p[j];
    float sa = 0.f;
#pragma unroll
    for (int j = 0; j < 16; ++j) { const f4 q = *(const LAS f4*)(sc + 192 + 4 * j); sa += (S[j].x * q.x + S[j].y * q.y) + (S[j].z * q.z + S[j].w * q.w); }
    float y = 0.f;
    f4* So = (f4*)(a->out + O_RS + (((size_t)L * NS + i) * 12 + h) * 4096 + lane * 64);
#pragma unroll
    for (int j = 0; j < 16; ++j) { const f4 w4 = *(const LAS f4*)(sc + 64 + 4 * j), k4 = *(const LAS f4*)(sc + 128 + 4 * j), a4 = *(const LAS f4*)(sc + 256 + 4 * j), r4 = *(const LAS f4*)(sc + 4 * j);
        f4 n = S[j] * w4 + (k4 * v - a4 * sa); So[j] = n; y += (n.x * r4.x + n.y * r4.y) + (n.z * r4.z + n.w * r4.w); }
    ((float*)(ws + wso(WS_Y)))[(size_t)(MP + i) * WB + h * 64 + lane] = y;
    LDS_WAIT(); asm volatile("" ::: "memory");
}

__device__ __forceinline__ void phase_post(ArgsP a, int L, int lane, int wave, int blk, int G) {
    unsigned char* ws = a->ws; const int gw = blk * NWAVES + wave, NGW = G * NWAVES;
    const float* Y = (const float*)(ws + wso(WS_Y)); const float* O = (const float*)(ws + wso(WS_O)); const float* Gt = (const float*)(ws + wso(WS_LORA)) + 2 * WB; const float* Z = (const float*)(ws + wso(WS_Z));
    const float* gng = a->in[I_BGNG] + L * WB; const float* gnb = a->in[I_BGNB] + L * WB; const float* rk = a->in[I_BRK] + L * WB; const float* cng = a->in[I_CNG] + L * WC;
    { f2 cg[6];
#pragma unroll
      for (int j = 0; j < 6; ++j) cg[j] = *(const f2*)(cng + 128 * j + 2 * lane);
      for (int mb = gw; mb < MP; mb += 4 * NGW) {
        f2 ov[4][6]; unsigned gz[4][6];
#pragma unroll
        for (int k = 0; k < 4; ++k) { const int m = mb + k * NGW < MP ? mb + k * NGW : mb;
#pragma unroll
            for (int j = 0; j < 6; ++j) { ov[k][j] = *(const f2*)(O + (size_t)m * WC + 128 * j + 2 * lane); gz[k][j] = *(const unsigned*)((const bf16*)Z + (size_t)m * PIN + OFF_C + 3 * WC + 128 * j + 2 * lane); } }
        __builtin_amdgcn_sched_barrier(0);
#pragma unroll
        for (int k = 0; k < 4; ++k) { const int m = mb + k * NGW; if (m < MP) {
            float ss = 0.f;
#pragma unroll
            for (int j = 0; j < 6; ++j) ss += ov[k][j].x * ov[k][j].x + ov[k][j].y * ov[k][j].y;
            const float rms = 1.0f / sqrtf(wave_sum(ss) * (1.f / WC) + RMS_EPS);
            unsigned* yo = (unsigned*)((bf16*)(ws + wso(WS_YMIX)) + (size_t)m * DM + WA + WB) + lane;
#pragma unroll
            for (int j = 0; j < 6; ++j) { f2 g2; g2.x = __builtin_bit_cast(float, gz[k][j] << 16); g2.y = __builtin_bit_cast(float, gz[k][j] & 0xffff0000u); const float y0 = ov[k][j].x * rms * cg[j].x * (g2.x * __builtin_amdgcn_rcpf(1.0f + __expf(-g2.x))), y1 = ov[k][j].y * rms * cg[j].y * (g2.y * __builtin_amdgcn_rcpf(1.0f + __expf(-g2.y)));
                yo[64 * j] = pg8::cvt_pk_bf16(y0, y1); } } }
      } }
    for (int p = gw; p < NS * 12; p += NGW) { const int i = p / 12, j = p - 12 * i, m = MP + i, c = 64 * j + lane;
        const float* rec = (const float*)(ws + wso(WS_RPS)) + (size_t)p * 384;
        const float y = Y[(size_t)m * WB + c], rr = rec[lane], kp = rec[128 + lane], vv = rec[192 + lane], gg = Gt[(size_t)m * NLORA + c], g1 = gng[c], b1 = gnb[c], rk1 = rk[c];
        const float mean = wave_sum(y) * (1.f / 64.f); const float d = y - mean; const float rstd = 1.0f / sqrtf(wave_sum(d * d) * (1.f / 64.f) + GN_EPS);
        const float bonus = wave_sum(rr * kp * rk1);
        ((bf16*)(ws + wso(WS_YMIX)) + (size_t)m * DM)[WA + c] = bf1((d * rstd * g1 + b1 + bonus * vv) * gg); }
    for (int r = NGW - 1 - gw; r < NS; r += NGW) { const int m = MP + r;
        bf16* yo = (bf16*)(ws + wso(WS_YMIX)) + (size_t)m * DM;
        float ov[12], gz[12], cg[12]; float ss = 0.f;
#pragma unroll
        for (int j = 0; j < 12; ++j) { const int c = 64 * j + lane; ov[j] = O[(size_t)m * WC + c]; gz[j] = Z[(size_t)m * PIN + OFF_C + 3 * WC + c]; cg[j] = cng[c]; }
        const float* hr = (const float*)(ws + wso(WS_H)) + (size_t)m * DM; float* tr = (float*)(ws + wso(WS_T)) + (size_t)m * DM;
        f4 hv[8];
#pragma unroll
        for (int j = 0; j < 8; ++j) hv[j] = *(const f4*)(hr + 4 * (lane + 64 * j));
        __builtin_amdgcn_sched_barrier(0);
#pragma unroll
        for (int j = 0; j < 8; ++j) *(f4*)(tr + 4 * (lane + 64 * j)) = hv[j] * DN_ALPHA;
#pragma unroll
        for (int j = 0; j < 12; ++j) ss += ov[j] * ov[j];
        const float rms = 1.0f / sqrtf(wave_sum(ss) * (1.f / WC) + RMS_EPS);
#pragma unroll
        for (int j = 0; j < 12; ++j) { const int c = 64 * j + lane; yo[WA + WB + c] = bf1(ov[j] * rms * cg[j] * (gz[j] * sigmoidf_(gz[j]))); }
    }
}

constexpr int REC_BYTES = 16384, RC_GT = 12288, RC_WT = 0, RC_RT = 2048, RC_AHT = 4096, RC_KHT = 6144, RC_VT = 8192, RC_BRA = 10240, RC_BRK = 10752, RC_M2 = 11264, RC_G15 = 11776, RC_BC = 12032;
constexpr int NCHUNK = NBAT * 12 * (SEQ / 16);
static_assert(WS_RPB + (size_t)NCHUNK * REC_BYTES == WS_RPS, "chunk record region");
__device__ __forceinline__ int perm_ch(int ch) { return (ch & ~31) | (((ch >> 2) & 3) << 3) | (((ch >> 4) & 1) << 2) | (ch & 3); }

__device__ __forceinline__ void pre_chunk(ArgsP a, int L, int q, LAS unsigned char* wl, int lane, bool first, bf16x8 (&xf)[8]) {
    asm volatile("" : "+v"(lane));
    unsigned char* ws = a->ws;
    const int bh = q >> 7, c = q & 127, b = bh / 12, h = bh - 12 * b, m0 = b * SEQ + c * 16, col = h * 64 + lane;
    const bf16* Z = (const bf16*)(ws + wso(WS_Z)) + (size_t)m0 * PIN + OFF_B + col;
    unsigned char* rec = ws + wso(WS_RPB) + (size_t)q * REC_BYTES;
    LAS float* X0 = (LAS float*)wl;
    LAS float* X1 = (LAS float*)(wl + 4352);
    LAS float* Maa = (LAS float*)(wl + 8704);
    LAS float* Mak = (LAS float*)(wl + 9728);
    LAS bf16* Sm = (LAS bf16*)(wl + 10752);
    LAS bf16* Wim = (LAS bf16*)(wl + 12288);
    const float mur = a->in[I_BMU][L * PBW + col], muk = a->in[I_BMU][L * PBW + WB + col], muv = a->in[I_BMU][L * PBW + 2 * WB + col];
    const float w0c = a->in[I_BW0][L * WB + col], a0c = a->in[I_BA0][L * WB + col], kkc = a->in[I_BKK][L * WB + col], kac = a->in[I_BKA][L * WB + col], rkc = a->in[I_BRK][L * WB + col];
    float cr[16], ck[16], cv[16], lw[16], la[16]; unsigned short zr_[16], zk_[16], zv_[16];
#pragma unroll
    for (int t = 0; t < 16; ++t) { zr_[t] = Z[(size_t)t * PIN]; zk_[t] = Z[(size_t)t * PIN + WB]; zv_[t] = Z[(size_t)t * PIN + 2 * WB]; }
    const ptrdiff_t pvo = c ? -(ptrdiff_t)PIN : 0;
    const unsigned short zpr = Z[pvo], zpk = Z[pvo + WB], zpv = Z[pvo + 2 * WB];
    const int lx = lane & 15, lq = lane >> 4;
    const bf16* bw0 = (const bf16*)(ws + wso(WS_WL) + L * SZ_WL) + (size_t)(h * 64 + lx) * 256 + 8 * lq;
    bf16x8 wb[2][8];
#define PRE_LDW(nt_, bf_) { const bf16* bw = bw0 + (size_t)(16 * (nt_)) * 256; wb[bf_][0] = *(const bf16x8*)(bw); wb[bf_][1] = *(const bf16x8*)(bw + 32); \
        wb[bf_][2] = *(const bf16x8*)(bw + (size_t)WB * 256 + 64); wb[bf_][3] = *(const bf16x8*)(bw + (size_t)WB * 256 + 96); \
        wb[bf_][4] = *(const bf16x8*)(bw + (size_t)2 * WB * 256 + 128); wb[bf_][5] = *(const bf16x8*)(bw + (size_t)2 * WB * 256 + 160); \
        wb[bf_][6] = *(const bf16x8*)(bw + (size_t)2 * WB * 256 + 192); wb[bf_][7] = *(const bf16x8*)(bw + (size_t)2 * WB * 256 + 224); }
    PRE_LDW(0, 0)
    if (first) {
        const bf16* zx = (const bf16*)(ws + wso(WS_Z)) + (size_t)m0 * PIN + OFF_B + 2304 + 4 * lane; const f4 mu4 = *(const f4*)(a->in[I_BMU] + L * PBW + 2304 + 4 * lane);
        u2 cur[16];
#pragma unroll
        for (int t = 0; t < 16; ++t) cur[t] = *(const u2*)(zx + (size_t)t * PIN);
        const u2 pvr = *(const u2*)(zx + pvo);
        __builtin_amdgcn_sched_barrier(0);
        f4 cu[16];
#pragma unroll
        for (int t = 0; t < 16; ++t) cu[t] = bf4(cur[t]);
        f4 pv4 = bf4(pvr);
        if (!c) pv4 = (f4){0.f, 0.f, 0.f, 0.f};
        LAS bf16* xa = (LAS bf16*)(wl + 4352);
        const float sc = lane < 16 ? 2.0f : 1.0f, of = lane < 16 ? -1.0f : 0.0f; const bool idn = lane >= 16 && lane < 32;
#pragma unroll
        for (int t = 0; t < 16; ++t) { f4 xv = cu[t] + mu4 * (pv4 - cu[t]); pv4 = cu[t];
#pragma unroll
            for (int e = 0; e < 4; ++e) { const float sg = sc * __builtin_amdgcn_rcpf(1.0f + __expf(-sc * xv[e])) + of; xv[e] = idn ? xv[e] : sg; }
            u2 w; w.x = cvt_pk_bf16_c(xv.x, xv.y); w.y = cvt_pk_bf16_c(xv.z, xv.w); *(LAS u2*)(xa + t * 264 + 4 * lane) = w; }
        LDS_WAIT(); asm volatile("" ::: "memory");
#pragma unroll
        for (int ks = 0; ks < 8; ++ks) xf[ks] = *(const LAS bf16x8*)(xa + lx * 264 + 32 * ks + 8 * lq);
        LDS_WAIT(); asm volatile("" ::: "memory");
    }
    __builtin_amdgcn_sched_barrier(0);
#pragma unroll
    for (int t = 0; t < 16; ++t) { cr[t] = bfl(zr_[t]); ck[t] = bfl(zk_[t]); cv[t] = bfl(zv_[t]); }
    float pr = bfl(zpr), pk = bfl(zpk), pv = bfl(zpv);
    if (!c) { pr = 0.f; pk = 0.f; pv = 0.f; }
    {
        const int x = lane & 15, quad = lane >> 4;
        pg8::f32x4 aw[4], aa[4], ag[4];
#pragma unroll
        for (int nt = 0; nt < 4; ++nt) { aw[nt] = (pg8::f32x4){0.f, 0.f, 0.f, 0.f}; aa[nt] = aw[nt]; ag[nt] = aw[nt];
            if (nt < 3) PRE_LDW(nt + 1, (nt + 1) & 1)
            __builtin_amdgcn_sched_barrier(0);
#pragma unroll
            for (int ks = 0; ks < 2; ++ks) { aw[nt] = __builtin_amdgcn_mfma_f32_16x16x32_bf16(xf[ks], wb[nt & 1][ks], aw[nt], 0, 0, 0);
                aa[nt] = __builtin_amdgcn_mfma_f32_16x16x32_bf16(xf[2 + ks], wb[nt & 1][2 + ks], aa[nt], 0, 0, 0); }
#pragma unroll
            for (int ks = 0; ks < 4; ++ks) ag[nt] = __builtin_amdgcn_mfma_f32_16x16x32_bf16(xf[4 + ks], wb[nt & 1][4 + ks], ag[nt], 0, 0, 0);
            __builtin_amdgcn_sched_barrier(0); }
#undef PRE_LDW
#pragma unroll
        for (int nt = 0; nt < 4; ++nt)
#pragma unroll
            for (int i = 0; i < 4; ++i) { const int t = 4 * quad + i, cc = 16 * nt + x; X0[t * 68 + cc] = aw[nt][i]; X1[t * 68 + cc] = aa[nt][i]; ((bf16*)(rec + RC_GT))[t * 64 + cc] = bf1(ag[nt][i]); }
        LDS_WAIT(); asm volatile("" ::: "memory");
#pragma unroll
        for (int t = 0; t < 16; ++t) { lw[t] = X0[t * 68 + lane]; la[t] = X1[t * 68 + lane]; }
        LDS_WAIT(); asm volatile("" ::: "memory");
    }
    float r_[16], k_[16], v_[16], kp_[16], al_[16], g_[16]; float run = 0.f, bcv = 0.f;
#pragma unroll
    for (int t = 0; t < 16; ++t) {
        const float r = cr[t] + mur * (pr - cr[t]), k = ck[t] + muk * (pk - ck[t]), v = cv[t] + muv * (pv - cv[t]); pr = cr[t]; pk = ck[t]; pv = cv[t];
        run += -0.6065306597126334f * __builtin_amdgcn_rcpf(1.0f + __expf(-(w0c + lw[t]))); g_[t] = run;
        const float av = __builtin_amdgcn_rcpf(1.0f + __expf(-(a0c + la[t])));
        const float kkr = k * kkc; const float ss = wave_sum_fast(kkr * kkr); const float kap = kkr * __builtin_amdgcn_rsqf(fmaxf(ss, 1e-24f));
        const float kpr = k * (1.0f + (av - 1.0f) * kac);
        const float bc = wave_sum_fast(r * kpr * rkc); if (lane == t) bcv = bc;
        r_[t] = r; k_[t] = kpr; v_[t] = v; kp_[t] = kap; al_[t] = kap * av; }
    float E_[16];
#pragma unroll
    for (int t = 0; t < 16; ++t) E_[t] = __expf(g_[t]);
    const float E15 = E_[15];
    { float ah[16], kh[16];
#pragma unroll
      for (int t = 0; t < 16; ++t) { const float ig = __builtin_amdgcn_rcpf(E_[t]), eg = E15 * ig; X0[t * 68 + lane] = al_[t] * ig; X1[t * 68 + lane] = k_[t] * ig; ah[t] = al_[t] * eg; kh[t] = k_[t] * eg; }
      v4u o0, o1;
      o0.x = cvt_pk_bf16_c(ah[0], ah[1]); o0.y = cvt_pk_bf16_c(ah[2], ah[3]); o0.z = cvt_pk_bf16_c(ah[4], ah[5]); o0.w = cvt_pk_bf16_c(ah[6], ah[7]);
      o1.x = cvt_pk_bf16_c(ah[8], ah[9]); o1.y = cvt_pk_bf16_c(ah[10], ah[11]); o1.z = cvt_pk_bf16_c(ah[12], ah[13]); o1.w = cvt_pk_bf16_c(ah[14], ah[15]);
      const int hs = (lane & 8) << 1;
      *(v4u*)(rec + RC_AHT + lane * 32 + hs) = o0; *(v4u*)(rec + RC_AHT + lane * 32 + (16 - hs)) = o1;
      o0.x = cvt_pk_bf16_c(kh[0], kh[1]); o0.y = cvt_pk_bf16_c(kh[2], kh[3]); o0.z = cvt_pk_bf16_c(kh[4], kh[5]); o0.w = cvt_pk_bf16_c(kh[6], kh[7]);
      o1.x = cvt_pk_bf16_c(kh[8], kh[9]); o1.y = cvt_pk_bf16_c(kh[10], kh[11]); o1.z = cvt_pk_bf16_c(kh[12], kh[13]); o1.w = cvt_pk_bf16_c(kh[14], kh[15]);
      *(v4u*)(rec + RC_KHT + lane * 32 + hs) = o0; *(v4u*)(rec + RC_KHT + lane * 32 + (16 - hs)) = o1;
      o0.x = cvt_pk_bf16_c(v_[0], v_[1]); o0.y = cvt_pk_bf16_c(v_[2], v_[3]); o0.z = cvt_pk_bf16_c(v_[4], v_[5]); o0.w = cvt_pk_bf16_c(v_[6], v_[7]);
      o1.x = cvt_pk_bf16_c(v_[8], v_[9]); o1.y = cvt_pk_bf16_c(v_[10], v_[11]); o1.z = cvt_pk_bf16_c(v_[12], v_[13]); o1.w = cvt_pk_bf16_c(v_[14], v_[15]);
      { const int vr = (lane >> 2) & 3; unsigned char* vrow = rec + RC_VT + lane * 32; u2 g2;
        g2.x = o0.x; g2.y = o0.y; *(u2*)(vrow + ((0 + vr) & 3) * 8) = g2; g2.x = o0.z; g2.y = o0.w; *(u2*)(vrow + ((1 + vr) & 3) * 8) = g2;
        g2.x = o1.x; g2.y = o1.y; *(u2*)(vrow + ((2 + vr) & 3) * 8) = g2; g2.x = o1.z; g2.y = o1.w; *(u2*)(vrow + ((3 + vr) & 3) * 8) = g2; } }
    LDS_WAIT(); asm volatile("" ::: "memory");
    const int x = lane & 15, kq = lane >> 4;
    f4 ba[4], bk[4];
#pragma unroll
    for (int j = 0; j < 4; ++j) { ba[j] = *(const LAS f4*)(X0 + x * 68 + 16 * kq + 4 * j); bk[j] = *(const LAS f4*)(X1 + x * 68 + 16 * kq + 4 * j); }
    LDS_WAIT(); asm volatile("" ::: "memory");
    float kt[16];
#pragma unroll
    for (int t = 0; t < 16; ++t) { kt[t] = kp_[t] * (t ? E_[t - 1] : 1.0f); X0[t * 68 + lane] = kt[t]; r_[t] *= E_[t]; X1[t * 68 + lane] = r_[t]; }
    LDS_WAIT(); asm volatile("" ::: "memory");
    f4 ak[4], ar[4];
#pragma unroll
    for (int j = 0; j < 4; ++j) { ak[j] = *(const LAS f4*)(X0 + x * 68 + 16 * kq + 4 * j); ar[j] = *(const LAS f4*)(X1 + x * 68 + 16 * kq + 4 * j); }
    pg8::f32x4 Gaa = (pg8::f32x4){0.f, 0.f, 0.f, 0.f}, Gak = Gaa, Gra = Gaa, Grk = Gaa;
#pragma unroll
    for (int j = 0; j < 4; ++j)
#pragma unroll
        for (int e = 0; e < 4; ++e) { Gaa = __builtin_amdgcn_mfma_f32_16x16x4f32(ak[j][e], ba[j][e], Gaa, 0, 0, 0); Gak = __builtin_amdgcn_mfma_f32_16x16x4f32(ak[j][e], bk[j][e], Gak, 0, 0, 0);
            Gra = __builtin_amdgcn_mfma_f32_16x16x4f32(ar[j][e], ba[j][e], Gra, 0, 0, 0); Grk = __builtin_amdgcn_mfma_f32_16x16x4f32(ar[j][e], bk[j][e], Grk, 0, 0, 0); }
#pragma unroll
    for (int i = 0; i < 4; ++i) { const int t = 4 * kq + i; const bool sl = x < t, le = x <= t;
        Maa[t * 16 + x] = sl ? Gaa[i] : 0.f; Mak[t * 16 + x] = sl ? Gak[i] : 0.f;
        Sm[t * 16 + x] = bf1(le ? Gra[i] : 0.f); Sm[256 + t * 16 + x] = bf1(le ? Grk[i] : 0.f); }
    LDS_WAIT(); asm volatile("" ::: "memory");
    float xm[16];
#pragma unroll
    for (int t = 0; t < 16; ++t) xm[t] = Mak[t * 16 + x];
#pragma unroll
    for (int t = 1; t < 16; ++t) {
#pragma unroll
        for (int s4 = 0; s4 < (t + 3) / 4; ++s4) { const f4 ar4 = *(const LAS f4*)(Maa + t * 16 + 4 * s4);
#pragma unroll
            for (int e = 0; e < 4; ++e) if (4 * s4 + e < t) { kt[t] -= ar4[e] * kt[4 * s4 + e]; xm[t] -= ar4[e] * xm[4 * s4 + e]; } } }
    const int wpc = perm_ch(lane);
#pragma unroll
    for (int t = 0; t < 16; ++t) { Wim[t * 64 + ((((wpc >> 3) ^ ((t >> 1) & 7)) << 3) | (wpc & 7))] = bf1(-kt[t]); if (lane < 16) Sm[512 + t * 16 + lane] = bf1(-xm[t]); }
    LDS_WAIT(); asm volatile("" ::: "memory");
    *(v4u*)(rec + RC_WT + lane * 16) = *(const LAS v4u*)((LAS unsigned char*)Wim + lane * 16); *(v4u*)(rec + RC_WT + 1024 + lane * 16) = *(const LAS v4u*)((LAS unsigned char*)Wim + 1024 + lane * 16);
    *(v4u*)(rec + RC_BRA + lane * 16) = *(const LAS v4u*)((LAS unsigned char*)Sm + lane * 16); if (lane < 32) *(v4u*)(rec + RC_BRA + 1024 + lane * 16) = *(const LAS v4u*)((LAS unsigned char*)Sm + 1024 + lane * 16);
    LDS_WAIT(); asm volatile("" ::: "memory");
#pragma unroll
    for (int t = 0; t < 16; ++t) Wim[t * 64 + ((((wpc >> 3) ^ ((t >> 1) & 7)) << 3) | (wpc & 7))] = bf1(r_[t]);
    LDS_WAIT(); asm volatile("" ::: "memory");
    *(v4u*)(rec + RC_RT + lane * 16) = *(const LAS v4u*)((LAS unsigned char*)Wim + lane * 16); *(v4u*)(rec + RC_RT + 1024 + lane * 16) = *(const LAS v4u*)((LAS unsigned char*)Wim + 1024 + lane * 16);
    *(float*)(rec + RC_G15 + lane * 4) = E15; if (lane < 16) *(float*)(rec + RC_BC + lane * 4) = bcv;
    LDS_WAIT(); asm volatile("" ::: "memory");
}

constexpr int HREC_BYTES = 17408, HR_QS = 0, HR_KS = 4352, HR_VT = 8704, HR_KHT = 12800, HR_EV = 16896, NHCHUNK = NBAT * 6 * (SEQ / 16);
__device__ __forceinline__ void hpre_chunk(ArgsP a, int L, int q2, LAS unsigned char* wl, int lane) {
    asm volatile("" : "+v"(lane));
    unsigned char* ws = a->ws;
    const int bh = q2 >> 7, c = q2 & 127, b = bh / 6, h = bh - 6 * b;
    const bf16* Z = (const bf16*)(ws + wso(WS_Z)) + (size_t)(b * SEQ + c * 16) * PIN + OFF_C + h * 128 + lane;
    unsigned char* rec = ws + wso(WS_HREC) + (size_t)q2 * HREC_BYTES;
    LAS bf16* qim = (LAS bf16*)wl; LAS bf16* kim = (LAS bf16*)(wl + 4352);
    float qq[2][16], fzz[2][16], ivv[2][16], lx[2][4]; unsigned short qr_[2][16], fr_[2][16], ir_[2][16];
#pragma unroll
    for (int hh = 0; hh < 2; ++hh) { const float* clb = a->in[I_CLB] + h * 128 + lane + 64 * hh; lx[hh][0] = clb[0]; lx[hh][1] = clb[WC]; lx[hh][2] = clb[2 * WC]; lx[hh][3] = clb[3 * WC];
#pragma unroll
        for (int t = 0; t < 16; ++t) { const bf16* p = Z + (size_t)t * PIN + 64 * hh; qr_[hh][t] = p[0]; fr_[hh][t] = p[WC]; ir_[hh][t] = p[2 * WC]; } }
    __builtin_amdgcn_sched_barrier(0);
#pragma unroll
    for (int hh = 0; hh < 2; ++hh)
#pragma unroll
        for (int t = 0; t < 16; ++t) { qq[hh][t] = bfl(qr_[hh][t]); fzz[hh][t] = bfl(fr_[hh][t]); ivv[hh][t] = bfl(ir_[hh][t]); }
#pragma unroll
    for (int hh = 0; hh < 2; ++hh) { const int ch = lane + 64 * hh; const int pc = perm_ch(ch);
        const float lb = lbound_v(lx[hh][0], lx[hh][1], lx[hh][2], lx[hh][3], L), oml = 1.0f - lb;
        const float (&q)[16] = qq[hh]; const float (&fz)[16] = fzz[hh]; const float (&iv)[16] = ivv[hh];
        float bl[16], kv[16]; float run = 0.f;
#pragma unroll
        for (int t = 0; t < 16; ++t) { const float e = __expf(-fmaxf(fz[t], -80.f)), sg = __builtin_amdgcn_rcpf(1.0f + e); run += __logf(lb + oml * sg); bl[t] = run; kv[t] = oml * e * sg; }
        float kh[16];
#pragma unroll
        for (int t = 0; t < 16; ++t) { qim[t * 136 + pc] = bf1(q[t] * __expf(bl[t])); kim[t * 136 + pc] = bf1(kv[t] * __expf(fminf(-bl[t], 60.f))); kh[t] = kv[t] * __expf(run - bl[t]); }
        v4u o0, o1;
        o0.x = cvt_pk_bf16_c(kh[0], kh[1]); o0.y = cvt_pk_bf16_c(kh[2], kh[3]); o0.z = cvt_pk_bf16_c(kh[4], kh[5]); o0.w = cvt_pk_bf16_c(kh[6], kh[7]);
        o1.x = cvt_pk_bf16_c(kh[8], kh[9]); o1.y = cvt_pk_bf16_c(kh[10], kh[11]); o1.z = cvt_pk_bf16_c(kh[12], kh[13]); o1.w = cvt_pk_bf16_c(kh[14], kh[15]);
        *(v4u*)(rec + HR_KHT + ch * 32) = o0; *(v4u*)(rec + HR_KHT + ch * 32 + 16) = o1;
        o0.x = cvt_pk_bf16_c(iv[0], iv[1]); o0.y = cvt_pk_bf16_c(iv[2], iv[3]); o0.z = cvt_pk_bf16_c(iv[4], iv[5]); o0.w = cvt_pk_bf16_c(iv[6], iv[7]);
        o1.x = cvt_pk_bf16_c(iv[8], iv[9]); o1.y = cvt_pk_bf16_c(iv[10], iv[11]); o1.z = cvt_pk_bf16_c(iv[12], iv[13]); o1.w = cvt_pk_bf16_c(iv[14], iv[15]);
        *(v4u*)(rec + HR_VT + ch * 32) = o0; *(v4u*)(rec + HR_VT + ch * 32 + 16) = o1;
        *(float*)(rec + HR_EV + ch * 4) = __expf(run); }
    LDS_WAIT(); asm volatile("" ::: "memory");
#pragma unroll
    for (int j = 0; j < 9; ++j) { const int o = (j * 64 + lane) * 16; if (o < 8704) *(v4u*)(rec + o) = *(const LAS v4u*)(wl + o); }
    LDS_WAIT(); asm volatile("" ::: "memory");
}
__device__ __forceinline__ void hgrn_stream_unit(ArgsP a, int L, int unit, LAS unsigned char* lds, int lane, int wave) {
    unsigned char* ws = a->ws;
    const int bh = unit >> 1, half = unit & 1, b = bh / 6, h = bh - b * 6;
    const unsigned char* recs = ws + wso(WS_HREC) + (size_t)bh * 128 * HREC_BYTES;
    const int x = lane & 15, quad = lane >> 4, vbase = 64 * half + 16 * (wave & 3);
    constexpr int AHEAD = 4, NCH = SEQ / 16;
#define HG_DMA(cc) do { const unsigned char* g_ = recs + (size_t)(cc) * HREC_BYTES + wave * 1024 + lane * 16; LAS unsigned char* l_ = lds + ((cc) % 6) * HREC_BYTES + wave * 1024; \
        __builtin_amdgcn_global_load_lds((const unsigned*)(g_), (LAS unsigned*)(l_), 16, 0, 0); __builtin_amdgcn_global_load_lds((const unsigned*)(g_ + 8192), (LAS unsigned*)(l_ + 8192), 16, 0, 0); \
        if (wave == 0) __builtin_amdgcn_global_load_lds((const unsigned*)(g_ + 16384), (LAS unsigned*)(l_ + 16384), 16, 0, 0); } while (0)
#define HG_WAIT(st_) do { if (wave >= 4) asm volatile("s_waitcnt vmcnt(6)" ::: "memory"); \
        else if ((st_) >= 3) { if (wave == 0) asm volatile("s_waitcnt vmcnt(13)" ::: "memory"); else asm volatile("s_waitcnt vmcnt(10)" ::: "memory"); }     \
        else { if (wave == 0) asm volatile("s_waitcnt vmcnt(10)" ::: "memory"); else asm volatile("s_waitcnt vmcnt(7)" ::: "memory"); } } while (0)
    asm volatile("s_waitcnt vmcnt(0) lgkmcnt(0)" ::: "memory"); __builtin_amdgcn_s_barrier(); asm volatile("" ::: "memory");
    if (wave < 4) __builtin_amdgcn_s_setprio(3);
    pg8::f32x4 Sacc[8];
#pragma unroll
    for (int mt = 0; mt < 8; ++mt) Sacc[mt] = (pg8::f32x4){0.f, 0.f, 0.f, 0.f};
#pragma unroll
    for (int cc = 0; cc < AHEAD; ++cc) HG_DMA(cc);
    if (wave == 0) asm volatile("s_waitcnt vmcnt(9)" ::: "memory"); else asm volatile("s_waitcnt vmcnt(6)" ::: "memory");
    __builtin_amdgcn_s_barrier(); asm volatile("" ::: "memory");
    float* O = (float*)(ws + wso(WS_O)) + (size_t)(b * SEQ) * WC + h * 128 + vbase + 4 * quad;
    for (int st = 0; st < NCH; ++st) {
        if (st + AHEAD < NCH) HG_DMA(st + AHEAD);
        if (wave < 4) {
        const LAS unsigned char* S = lds + (st % 6) * HREC_BYTES;
        const LAS bf16* qs = (const LAS bf16*)(S + HR_QS); const LAS bf16* ks = (const LAS bf16*)(S + HR_KS); const LAS bf16* vt = (const LAS bf16*)(S + HR_VT);
        const LAS bf16* kht = (const LAS bf16*)(S + HR_KHT); const LAS float* ev = (const LAS float*)(S + HR_EV);
        bf16x8 qf[4], kf[4];
#pragma unroll
        for (int kt = 0; kt < 4; ++kt) { qf[kt] = *(const LAS bf16x8*)(qs + x * 136 + 32 * kt + 8 * quad); kf[kt] = *(const LAS bf16x8*)(ks + x * 136 + 32 * kt + 8 * quad); }
        pg8::f32x4 att = (pg8::f32x4){0.f, 0.f, 0.f, 0.f};
#pragma unroll
        for (int kt = 0; kt < 4; ++kt) att = __builtin_amdgcn_mfma_f32_16x16x32_bf16(kf[kt], qf[kt], att, 0, 0, 0);
#pragma unroll
        for (int i = 0; i < 4; ++i) if (4 * quad + i > x) att[i] = 0.f;
        v4u pbu; pbu.x = cvt_pk_bf16_c(att[0], att[1]); pbu.y = cvt_pk_bf16_c(att[2], att[3]); pbu.z = 0u; pbu.w = 0u;
        const bf16x8 pb = __builtin_bit_cast(bf16x8, pbu);
        const u2 vv = *(const LAS u2*)(vt + (vbase + x) * 16 + 4 * quad);
        v4u vfu; vfu.x = vv.x; vfu.y = vv.y; vfu.z = 0u; vfu.w = 0u; const bf16x8 vf = __builtin_bit_cast(bf16x8, vfu);
        pg8::f32x4 o = (pg8::f32x4){0.f, 0.f, 0.f, 0.f};
#pragma unroll
        for (int kt = 0; kt < 4; ++kt) { v4u su; su.x = cvt_pk_bf16_c(Sacc[2 * kt][0], Sacc[2 * kt][1]); su.y = cvt_pk_bf16_c(Sacc[2 * kt][2], Sacc[2 * kt][3]);
            su.z = cvt_pk_bf16_c(Sacc[2 * kt + 1][0], Sacc[2 * kt + 1][1]); su.w = cvt_pk_bf16_c(Sacc[2 * kt + 1][2], Sacc[2 * kt + 1][3]);
            o = __builtin_amdgcn_mfma_f32_16x16x32_bf16(__builtin_bit_cast(bf16x8, su), qf[kt], o, 0, 0, 0); }
        o = __builtin_amdgcn_mfma_f32_16x16x32_bf16(vf, pb, o, 0, 0, 0);
        *(pg8::f32x4*)(O + (size_t)(st * 16 + x) * WC) = o;
#pragma unroll
        for (int mt = 0; mt < 8; ++mt) { const pg8::f32x4 e4 = *(const LAS pg8::f32x4*)(ev + 16 * mt + 4 * quad);
            const u2 kk2 = *(const LAS u2*)(kht + (16 * mt + x) * 16 + 4 * quad); v4u ku; ku.x = kk2.x; ku.y = kk2.y; ku.z = 0u; ku.w = 0u;
            Sacc[mt] = __builtin_amdgcn_mfma_f32_16x16x32_bf16(__builtin_bit_cast(bf16x8, ku), vf, Sacc[mt] * e4, 0, 0, 0); }
        }
        if (st + AHEAD < NCH) HG_WAIT(st); else asm volatile("s_waitcnt vmcnt(0)" ::: "memory");
        asm volatile("s_waitcnt lgkmcnt(0)" ::: "memory"); __builtin_amdgcn_s_barrier(); asm volatile("" ::: "memory");
    }
#undef HG_DMA
#undef HG_WAIT
    __builtin_amdgcn_s_setprio(0);
    if (wave < 4) { float* So = a->out + O_HP + (((size_t)L * NBAT + b) * 6 + h) * 16384;
#pragma unroll
        for (int mt = 0; mt < 8; ++mt)
#pragma unroll
            for (int i = 0; i < 4; ++i) So[(size_t)(16 * mt + 4 * quad + i) * 128 + vbase + x] = Sacc[mt][i]; }
    asm volatile("s_waitcnt vmcnt(0) lgkmcnt(0)" ::: "memory"); __builtin_amdgcn_s_barrier(); asm volatile("" ::: "memory");
}
__device__ __forceinline__ void phase_pre(ArgsP a, int L, LAS unsigned char* lds, int lane, int wave, int blk, int G) {
    const int gw = blk * NWAVES + wave, NGW = G * NWAVES;
    for (int r2 = 0; r2 < NREP(101); ++r2) for (int tr = gw; tr < NCHUNK / 3; tr += NGW) {
        const int b = tr >> 9, c = (tr >> 2) & 127, hg = tr & 3; bf16x8 xf[8];
#pragma unroll
        for (int ks = 0; ks < 8; ++ks) xf[ks] = (bf16x8){0, 0, 0, 0, 0, 0, 0, 0};
#pragma unroll 1
        for (int k = 0; k < 3; ++k) pre_chunk(a, L, ((b * 12 + 3 * hg + k) << 7) + c, lds + wave * 16384, lane, k == 0, xf); }
    for (int r2 = 0; r2 < NREP(102); ++r2) for (int q2 = gw; q2 < NHCHUNK; q2 += NGW) hpre_chunk(a, L, q2, lds + wave * 16384, lane);
}
__device__ __forceinline__ void rwkv_seq_unit(ArgsP a, int L, int unit, LAS unsigned char* lds, int lane, int wave) {
    unsigned char* ws = a->ws;
    const int b = unit / 12, h = unit - 12 * b;
    const unsigned char* recs = ws + wso(WS_RPB) + (size_t)unit * 128 * REC_BYTES;
    LAS float* ybuf = (LAS float*)(lds + 7 * REC_BYTES);
    const int x = lane & 15, quad = lane >> 4;
    constexpr int AHEAD = 5, NCH = SEQ / 16;
#define RW_DMA(cc) do { const unsigned char* g_ = recs + (size_t)(cc) * REC_BYTES + wave * 1024 + lane * 16; LAS unsigned char* l_ = lds + ((cc) % 7) * REC_BYTES + wave * 1024; \
        __builtin_amdgcn_global_load_lds((const unsigned*)(g_), (LAS unsigned*)(l_), 16, 0, 0); if (wave < 6) __builtin_amdgcn_global_load_lds((const unsigned*)(g_ + 8192), (LAS unsigned*)(l_ + 8192), 16, 0, 0); } while (0)
#define RW_WAIT(c_) do { if (wave < 4) asm volatile("s_waitcnt vmcnt(8)" ::: "memory"); \
        else if ((c_) >= 5) { if (wave < 6) asm volatile("s_waitcnt vmcnt(13)" ::: "memory"); else asm volatile("s_waitcnt vmcnt(9)" ::: "memory"); }          \
        else { if (wave < 6) asm volatile("s_waitcnt vmcnt(8)" ::: "memory"); else asm volatile("s_waitcnt vmcnt(4)" ::: "memory"); } } while (0)
    asm volatile("s_waitcnt vmcnt(0) lgkmcnt(0)" ::: "memory"); __builtin_amdgcn_s_barrier(); asm volatile("" ::: "memory");
    if (wave < 4) __builtin_amdgcn_s_setprio(3);
    pg8::f32x4 Hacc[4];
#pragma unroll
    for (int nt = 0; nt < 4; ++nt) Hacc[nt] = (pg8::f32x4){0.f, 0.f, 0.f, 0.f};
    f4 gng4 = (f4){0.f, 0.f, 0.f, 0.f}, gnb4 = gng4;
    if (wave >= 4) { gng4 = *(const f4*)(a->in[I_BGNG] + L * WB + h * 64 + 4 * x); gnb4 = *(const f4*)(a->in[I_BGNB] + L * WB + h * 64 + 4 * x); }
    asm volatile("s_waitcnt vmcnt(0)" ::: "memory");
#pragma unroll
    for (int cc = 0; cc < AHEAD; ++cc) RW_DMA(cc);
    RW_WAIT(0);
    __builtin_amdgcn_s_barrier(); asm volatile("" ::: "memory");
    bf16* ymix = (bf16*)(ws + wso(WS_YMIX)) + (size_t)(b * SEQ) * DM + WA + h * 64 + 4 * x;
    for (int c = 0; c <= NCH; ++c) {
        if (c + AHEAD < NCH) RW_DMA(c + AHEAD);
        if (wave < 4) {
            if (c < NCH) {
                const LAS unsigned char* S = lds + (c % 7) * REC_BYTES;
                bf16x8 wf[2], rf[2], hb[2];
#pragma unroll
                for (int ks = 0; ks < 2; ++ks) { const int so = x * 128 + 16 * ((4 * ks + quad) ^ ((x >> 1) & 7));        wf[ks] = *(const LAS bf16x8*)(S + RC_WT + so); rf[ks] = *(const LAS bf16x8*)(S + RC_RT + so);
                    v4u su; su.x = cvt_pk_bf16_c(Hacc[2 * ks][0], Hacc[2 * ks][1]); su.y = cvt_pk_bf16_c(Hacc[2 * ks][2], Hacc[2 * ks][3]);
                    su.z = cvt_pk_bf16_c(Hacc[2 * ks + 1][0], Hacc[2 * ks + 1][1]); su.w = cvt_pk_bf16_c(Hacc[2 * ks + 1][2], Hacc[2 * ks + 1][3]); hb[ks] = __builtin_bit_cast(bf16x8, su); }
                const u2 vv = *(const LAS u2*)(S + RC_VT + (16 * wave + x) * 32 + 8 * ((quad + (x >> 2)) & 3));     v4u t4; t4.x = vv.x; t4.y = vv.y; t4.z = 0u; t4.w = 0u; const bf16x8 vf = __builtin_bit_cast(bf16x8, t4);
                const u2 m2v = *(const LAS u2*)(S + RC_M2 + x * 32 + 8 * quad); t4.x = m2v.x; t4.y = m2v.y; const bf16x8 m2f = __builtin_bit_cast(bf16x8, t4);
                const u2 brav = *(const LAS u2*)(S + RC_BRA + x * 32 + 8 * quad); t4.x = brav.x; t4.y = brav.y; const bf16x8 braf = __builtin_bit_cast(bf16x8, t4);
                const u2 brkv = *(const LAS u2*)(S + RC_BRK + x * 32 + 8 * quad); t4.x = brkv.x; t4.y = brkv.y; const bf16x8 brkf = __builtin_bit_cast(bf16x8, t4);
                pg8::f32x4 U = (pg8::f32x4){0.f, 0.f, 0.f, 0.f}, Y = U;
                U = __builtin_amdgcn_mfma_f32_16x16x32_bf16(wf[0], hb[0], U, 0, 0, 0); U = __builtin_amdgcn_mfma_f32_16x16x32_bf16(wf[1], hb[1], U, 0, 0, 0); U = __builtin_amdgcn_mfma_f32_16x16x32_bf16(m2f, vf, U, 0, 0, 0);
                Y = __builtin_amdgcn_mfma_f32_16x16x32_bf16(rf[0], hb[0], Y, 0, 0, 0); Y = __builtin_amdgcn_mfma_f32_16x16x32_bf16(rf[1], hb[1], Y, 0, 0, 0); Y = __builtin_amdgcn_mfma_f32_16x16x32_bf16(brkf, vf, Y, 0, 0, 0);
                t4.x = cvt_pk_bf16_c(U[0], U[1]); t4.y = cvt_pk_bf16_c(U[2], U[3]); const bf16x8 ub = __builtin_bit_cast(bf16x8, t4);
                Y = __builtin_amdgcn_mfma_f32_16x16x32_bf16(braf, ub, Y, 0, 0, 0);
#pragma unroll
                for (int nt = 0; nt < 4; ++nt) { const pg8::f32x4 g4 = *(const LAS pg8::f32x4*)(S + RC_G15 + (16 * nt + 4 * quad) * 4);
                    const u2 av = *(const LAS u2*)(S + RC_AHT + (16 * nt + x) * 32 + 8 * ((quad + ((x >> 2) & 2)) & 3)); t4.x = av.x; t4.y = av.y; const bf16x8 ahf = __builtin_bit_cast(bf16x8, t4);
                    const u2 kv = *(const LAS u2*)(S + RC_KHT + (16 * nt + x) * 32 + 8 * ((quad + ((x >> 2) & 2)) & 3)); t4.x = kv.x; t4.y = kv.y; const bf16x8 khf = __builtin_bit_cast(bf16x8, t4);
                    Hacc[nt] = __builtin_amdgcn_mfma_f32_16x16x32_bf16(ahf, ub, Hacc[nt] * g4, 0, 0, 0); Hacc[nt] = __builtin_amdgcn_mfma_f32_16x16x32_bf16(khf, vf, Hacc[nt], 0, 0, 0); }
                LAS float* yb = ybuf + (c & 1) * 1024;
#pragma unroll
                for (int i = 0; i < 4; ++i) yb[(4 * quad + i) * 64 + 16 * wave + x] = Y[i];
            }
        } else {
            if (c > 0) {
                const int cp = c - 1, tt = 4 * (wave - 4) + quad; const LAS unsigned char* S = lds + (cp % 7) * REC_BYTES; const LAS float* yb = ybuf + (cp & 1) * 1024;
                const f4 y4 = *(const LAS f4*)(yb + tt * 64 + 4 * x); const u2 gq = *(const LAS u2*)(S + RC_GT + (tt * 64 + 4 * x) * 2);
                const float bcf = *(const LAS float*)(S + RC_BC + tt * 4);
                f4 g4, v4; g4.x = __builtin_bit_cast(float, gq.x << 16); g4.y = __builtin_bit_cast(float, gq.x & 0xffff0000u); g4.z = __builtin_bit_cast(float, gq.y << 16); g4.w = __builtin_bit_cast(float, gq.y & 0xffff0000u);
#pragma unroll
                for (int i = 0; i < 4; ++i) v4[i] = __builtin_bit_cast(float, (unsigned)(*(const LAS unsigned short*)(S + RC_VT + (4 * x + i) * 32 + ((tt + 4 * (x & 3)) & 15) * 2)) << 16);
                const float mean = row16_sum((y4.x + y4.y) + (y4.z + y4.w)) * (1.f / 64.f); const f4 d = y4 - mean;
                const float rstd = __builtin_amdgcn_rsqf(row16_sum((d.x * d.x + d.y * d.y) + (d.z * d.z + d.w * d.w)) * (1.f / 64.f) + GN_EPS);
                const f4 o = (d * rstd * gng4 + gnb4 + v4 * bcf) * g4;
                u2 w; w.x = cvt_pk_bf16_c(o.x, o.y); w.y = cvt_pk_bf16_c(o.z, o.w); *(u2*)(ymix + (size_t)(cp * 16 + tt) * DM) = w;
            }
        }
        if (c + AHEAD < NCH) RW_WAIT(c); else asm volatile("s_waitcnt vmcnt(0)" ::: "memory");
        asm volatile("s_waitcnt lgkmcnt(0)" ::: "memory"); __builtin_amdgcn_s_barrier(); asm volatile("" ::: "memory");
    }
    __builtin_amdgcn_s_setprio(0);
    if (wave < 4) { float* So = a->out + O_RP + (((size_t)L * NBAT + b) * 12 + h) * 4096;
#pragma unroll
        for (int nt = 0; nt < 4; ++nt) *(pg8::f32x4*)(So + (size_t)(16 * wave + x) * 64 + 16 * nt + 4 * quad) = Hacc[nt]; }
#undef RW_DMA
#undef RW_WAIT
    asm volatile("s_waitcnt vmcnt(0) lgkmcnt(0)" ::: "memory"); __builtin_amdgcn_s_barrier(); asm volatile("" ::: "memory");
}

__device__ __forceinline__ float gelu_fast(float v) {
    const float t = __builtin_amdgcn_rcpf(__builtin_fabsf(v) * 0.2316418882f + 1.0f);
    float q = t * 0.5307027145f + (-0.7265760135f); q = q * t + 0.7107068705f; q = q * t + (-0.142248368f); q = q * t + 0.127414796f; q = q * t;
    const float e = __builtin_amdgcn_exp2f((v * v) * (-0.72134752044f)); const float m = v * (q * e);
    return v < 0.f ? m : v - m;
}
__device__ __forceinline__ void sgu_item2(ArgsP a, int L, int item, LAS unsigned char* lds, int tid, int lane, int wave) {
    unsigned char* ws = a->ws;
    const int g = item & 3, bc = item >> 2, m0 = bc * 128;
    const bf16* Z = (const bf16*)(ws + wso(WS_Z));
    LAS bf16* Wb = (LAS bf16*)lds;
    LAS bf16* VT = (LAS bf16*)(lds + 34816);
    const float* wsrc = a->in[I_AWS] + (size_t)(L * 4 + g) * 16384;
    __syncthreads();
#pragma unroll
    for (int j = 0; j < 8; ++j) { const int e4 = j * NTHR + tid, t = e4 >> 5, s0 = (e4 & 31) * 4; const f4 w = *(const f4*)(wsrc + t * 128 + s0);
        u2 o; o.x = cvt_pk_bf16_c(s0 <= t ? w.x : 0.f, s0 + 1 <= t ? w.y : 0.f); o.y = cvt_pk_bf16_c(s0 + 2 <= t ? w.z : 0.f, s0 + 3 <= t ? w.w : 0.f); *(LAS u2*)(Wb + t * 136 + s0) = o; }
    const float lg0 = a->in[I_ALNG][L * WA + g * 128 + lane], lg1 = a->in[I_ALNG][L * WA + g * 128 + 64 + lane], lb0 = a->in[I_ALNB][L * WA + g * 128 + lane], lb1 = a->in[I_ALNB][L * WA + g * 128 + 64 + lane];
    float zv0[16], zv1[16];
#pragma unroll
    for (int rr = 0; rr < 16; ++rr) { const bf16* zr = Z + (size_t)(m0 + wave * 16 + rr) * PIN + WA + g * 128; zv0[rr] = bfl(zr[lane]); zv1[rr] = bfl(zr[64 + lane]); }
#pragma unroll
    for (int rr = 0; rr < 16; ++rr) { const int t = wave * 16 + rr; const float v0 = gelu_fast(zv0[rr]), v1 = gelu_fast(zv1[rr]);
        const float mean = wave_sum_fast(v0 + v1) * (1.f / 128.f); const float d0 = v0 - mean, d1 = v1 - mean;
        const float rstd = __builtin_amdgcn_rsqf(wave_sum_fast(d0 * d0 + d1 * d1) * (1.f / 128.f) + LN_EPS);
        VT[lane * 136 + t] = bf1(d0 * rstd * lg0 + lb0); VT[(64 + lane) * 136 + t] = bf1(d1 * rstd * lg1 + lb1); }
    __syncthreads();
    const int x = lane & 15, quad = lane >> 4, nks = (wave >> 1) + 1;
    pg8::f32x4 acc[8];
#pragma unroll
    for (int dt = 0; dt < 8; ++dt) acc[dt] = (pg8::f32x4){0.f, 0.f, 0.f, 0.f};
    for (int ks = 0; ks < nks; ++ks) { const bf16x8 wf = *(const LAS bf16x8*)(Wb + (16 * wave + x) * 136 + 32 * ks + 8 * quad);
#pragma unroll
        for (int dt = 0; dt < 8; ++dt) { const bf16x8 vf = *(const LAS bf16x8*)(VT + (16 * dt + x) * 136 + 32 * ks + 8 * quad); acc[dt] = __builtin_amdgcn_mfma_f32_16x16x32_bf16(vf, wf, acc[dt], 0, 0, 0); } }
    const int t = 16 * wave + x; const float bs = a->in[I_ABS][(L * 4 + g) * 128 + t];
    const bf16* ur = Z + (size_t)(m0 + t) * PIN + g * 128 + 4 * quad; bf16* yo = (bf16*)(ws + wso(WS_YMIX)) + (size_t)(m0 + t) * DM + g * 128 + 4 * quad;
#pragma unroll
    for (int dt = 0; dt < 8; ++dt) { const f4 u = bf4(*(const u2*)(ur + 16 * dt)); u2 o;
        o.x = cvt_pk_bf16_c(gelu_fast(u.x) * (acc[dt][0] + bs), gelu_fast(u.y) * (acc[dt][1] + bs)); o.y = cvt_pk_bf16_c(gelu_fast(u.z) * (acc[dt][2] + bs), gelu_fast(u.w) * (acc[dt][3] + bs));
        *(u2*)(yo + 16 * dt) = o; }
}
__device__ __forceinline__ void hgrn_sample_item2(ArgsP a, int L, int item, LAS unsigned char* lds, int lane, int wave) {
    unsigned char* ws = a->ws;
    const int ih = item * 8 + wave, i = ih / 6, h = ih - i * 6, m = MP + i, vq = lane & 31, kh = lane >> 5;
    const float* zc = (const float*)(ws + wso(WS_Z)) + (size_t)m * PIN + OFF_C + h * 128;
    LAS f4* sc = (LAS f4*)(lds + wave * 2048);
#pragma unroll
    for (int t = 0; t < 2; ++t) { const int k = lane + 64 * t; const float lb = lbound(a->in[I_CLB], L, h * 128 + k); const float fz = zc[WC + k];
        const float e = __expf(-fmaxf(fz, -80.f)), sg = __builtin_amdgcn_rcpf(1.0f + e); f4 r; r.x = lb + (1.0f - lb) * sg; r.y = (1.0f - lb) * e * sg; r.z = zc[k]; r.w = 0.f; sc[k] = r; }
    const f4 iv = *(const f4*)(zc + 2 * WC + 4 * vq);
    LDS_WAIT(); asm volatile("" ::: "memory");
    const float* S0 = a->in[I_SHGRN] + (((size_t)L * NS + i) * 6 + h) * 16384 + 4 * vq;
    float* So = a->out + O_HS + (((size_t)L * NS + i) * 6 + h) * 16384 + 4 * vq;
    f4 o = (f4){0.f, 0.f, 0.f, 0.f};
#pragma unroll 1
    for (int qt = 0; qt < 4; ++qt) { f4 sv[16];
#pragma unroll
        for (int j = 0; j < 16; ++j) sv[j] = *(const f4*)(S0 + (size_t)(kh + 2 * (16 * qt + j)) * 128);
#pragma unroll
        for (int j = 0; j < 16; ++j) { const int k = kh + 2 * (16 * qt + j); const f4 c = sc[k]; const f4 n = sv[j] * c.x + iv * c.y; *(f4*)(So + (size_t)k * 128) = n; o += n * c.z; } }
    { LAS f4* ex = (LAS f4*)(lds + 16384 + wave * 1024); ex[lane] = o; LDS_WAIT(); asm volatile("" ::: "memory"); o += ex[lane ^ 32]; }
    if (kh == 0) *(f4*)((float*)(ws + wso(WS_O)) + (size_t)m * WC + h * 128 + 4 * vq) = o;
    LDS_WAIT(); asm volatile("" ::: "memory");
}

enum { SE_STORE = 0, SE_RESID = 1, SE_SWIGLU = 2, SE_SIGMUL = 3, SE_ATOMIC = 4 };
struct SEpi { int mode; float* out; const float* base; const float* add; int ld; float alpha; float* tinit; };
template <int NT> __device__ __forceinline__ void strip_task(const bf16* A, const bf16* Bt, int K, int rb0, int rb1, int c0, const SEpi& E, LAS unsigned char* lds, int lane, int wave, int kbeg, int nk) {
    const int x = lane & 15, quad = lane >> 4;
    const int q8 = nk >> 3, r8 = nk & 7, nks = q8 + (wave < r8 ? 1 : 0), ks0 = kbeg + wave * q8 + (wave < r8 ? wave : r8);
    const bf16* Ap = A + (size_t)x * K + ks0 * 32 + 8 * quad;
    const bf16* Bp[NT];
#pragma unroll
    for (int i = 0; i < NT; ++i) { const int r = (i < NT / 2) ? rb0 + 16 * i : rb1 + 16 * (i - NT / 2); Bp[i] = Bt + (size_t)(r + x) * K + ks0 * 32 + 8 * quad; }
    pg8::f32x4 acc[8][NT];
#pragma unroll
    for (int mt = 0; mt < 8; ++mt)
#pragma unroll
        for (int i = 0; i < NT; ++i) acc[mt][i] = (pg8::f32x4){0.f, 0.f, 0.f, 0.f};
    for (int s = 0; s < nks; ++s) {
        bf16x8 af[8], bfr[NT];
#pragma unroll
        for (int i = 0; i < NT; ++i) bfr[i] = *(const bf16x8*)(Bp[i] + 32 * s);
#pragma unroll
        for (int mt = 0; mt < 8; ++mt) af[mt] = *(const bf16x8*)(Ap + (size_t)(16 * mt) * K + 32 * s);
#pragma unroll
        for (int mt = 0; mt < 8; ++mt)
#pragma unroll
            for (int i = 0; i < NT; ++i) acc[mt][i] = __builtin_amdgcn_mfma_f32_16x16x32_bf16(af[mt], bfr[i], acc[mt][i], 0, 0, 0);
    }
    LAS pg8::f32x4* red = (LAS pg8::f32x4*)lds;
    pg8::f32x4 sum[NT];
#pragma unroll
    for (int p = 0; p < NT / 2; ++p) {
        __syncthreads();
#pragma unroll
        for (int mt = 0; mt < 8; ++mt) { red[((wave * 8 + mt) * 2 + 0) * 64 + lane] = acc[mt][2 * p]; red[((wave * 8 + mt) * 2 + 1) * 64 + lane] = acc[mt][2 * p + 1]; }
        __syncthreads();
        pg8::f32x4 s0 = (pg8::f32x4){0.f, 0.f, 0.f, 0.f}, s1 = s0;
#pragma unroll
        for (int w2 = 0; w2 < 8; ++w2) { s0 += red[((w2 * 8 + wave) * 2 + 0) * 64 + lane]; s1 += red[((w2 * 8 + wave) * 2 + 1) * 64 + lane]; }
        sum[2 * p] = s0; sum[2 * p + 1] = s1;
    }
#pragma unroll
    for (int i = 0; i < 4; ++i) { const size_t ro = (size_t)(16 * wave + 4 * quad + i) * E.ld;
        if (E.mode == SE_SWIGLU) {
#pragma unroll
            for (int t = 0; t < NT / 2; ++t) { const float g = sum[t][i]; ((bf16*)E.out)[ro + c0 + 16 * t + x] = bf1(g * __builtin_amdgcn_rcpf(1.0f + __expf(-g)) * sum[NT / 2 + t][i]); } }
        else {
#pragma unroll
            for (int t = 0; t < NT; ++t) { const size_t o = ro + c0 + 16 * t + x; const float v = sum[t][i]; float r;
                if (E.mode == SE_ATOMIC) { __hip_atomic_fetch_add(E.out + o, v, __ATOMIC_RELAXED, __HIP_MEMORY_SCOPE_AGENT); continue; }
                if (E.mode == SE_STORE) r = v;
                else if (E.mode == SE_RESID) { r = E.alpha * E.base[o] + v; if (E.add) r += E.add[o]; }
                else { r = E.base[o] * __builtin_amdgcn_rcpf(1.0f + __expf(-v)); if (E.tinit) E.tinit[o] = E.alpha * E.add[o] + r; }
                E.out[o] = r; } }
    }
}
template <int NT = 2> __device__ __forceinline__ void strip_gemm(const bf16* A, const bf16* Bt, int K, int N, const SEpi& E, LAS unsigned char* lds, int lane, int wave, int blk, int G, int ksplit = 1, int nb = 0) {
    if (nb <= 0 || nb > G) nb = G;
    const int per = (E.mode == SE_SWIGLU) ? 8 * NT : 16 * NT, ncg = N / per, ntask = ncg * ksplit, nkt = (K >> 5) / ksplit;
    if (blk >= G - nb)
    for (int t = G - 1 - blk; t < ntask; t += nb) { const int cg = t % ncg, kg = t / ncg, c0 = cg * per;
        if (E.mode == SE_SWIGLU) { const int rb = ((c0 >> 7) << 8) + (c0 & 127); strip_task<NT>(A, Bt, K, rb, rb + 128, c0, E, lds, lane, wave, 0, K >> 5); }
        else strip_task<NT>(A, Bt, K, c0, c0 + 8 * NT, c0, E, lds, lane, wave, kg * nkt, nkt); }
    __syncthreads();
}

#ifndef EN_PRO
#define EN_PRO 1
#endif
#ifndef EN_G1
#define EN_G1 1
#endif
#ifndef EN_PREP
#define EN_PREP 1
#endif
#ifndef EN_MIX
#define EN_MIX 1
#endif
#ifndef EN_POST
#define EN_POST 1
#endif
#ifndef EN_G3
#define EN_G3 1
#endif
#ifndef EN_LN
#define EN_LN 1
#endif
#ifndef EN_G4
#define EN_G4 1
#endif
#ifndef EN_G5
#define EN_G5 1
#endif
#ifndef MK_SINGLE
#define MK_SINGLE 1
#endif
constexpr int PPL = 9, N_PHASES = 1 + PPL * DEPTH;
constexpr int SCAN_UNITS = NBAT * 12, HSEQ_UNITS = NBAT * 6 * 2, ROLE_BLOCKS = SCAN_UNITS + HSEQ_UNITS;
constexpr int G1Z = 208;
constexpr int N_SGU = NBAT * 16 * 4, N_RS = NS * 12 / 8, N_HS = NS * 6 / 8, N_MISC = N_SGU + N_RS + N_HS;

__global__ void __launch_bounds__(NTHR, 2) mk_fwd(Args a) {
    extern __shared__ __attribute__((aligned(16))) unsigned char lds_raw[];
    LAS unsigned char* lds = (LAS unsigned char*)lds_raw;
    const int tid = threadIdx.x, blk = blockIdx.x, G = gridDim.x; const int wave0 = __builtin_amdgcn_readfirstlane(tid >> 6);
    ArgsP ap0 = (ArgsP)__builtin_amdgcn_kernarg_segment_ptr();
    volatile LAS unsigned* MISC = (volatile LAS unsigned*)(lds + MISC_OFF);
    for (int u = tid; u < (LDS_BYTES - LDSCTL_OFF) / 4; u += NTHR) ((LAS unsigned*)(lds + LDSCTL_OFF))[u] = 0u;
    __syncthreads();
    const int lo = ap0->ph_lo, hi = ap0->ph_hi;
    XcdBarrier bar; bar.bar = (unsigned*)(ap0->ws + WS_CTL) + CW_BAR; bar.x = 0; bar.st = nullptr;
    if (hi - lo > 1) bar = xcd_barrier_post((unsigned*)(ap0->ws + WS_CTL) + CW_BAR, MISC + 8);
    bar.w0 = (wave0 == 0);
#define IN(k) (lo <= (k) && (k) < hi)
#define SEAM(k) do { if (IN(k) && IN((k) + 1)) { xcd_barrier(bar); } } while (0)
#define PHASE_BEGIN() ArgsP a = ap0; asm volatile("" : "+s"(a)); unsigned char* ws = a->ws; int tid_ = wave0 * 64 + mk_lane_id(); asm volatile("" : "+v"(tid_)); \
    const int lane_ = tid_ & 63; const int wave_ = __builtin_amdgcn_readfirstlane(tid_ >> 6); const int lane_s = lane_, wave_s = wave_; \
    bf16* HB = (bf16*)(ws + wso(WS_HB)); float* H = (float*)(ws + wso(WS_H)); float* T = (float*)(ws + wso(WS_T)); (void)HB; (void)H; (void)T; (void)lane_s; (void)wave_s

    #if EN_PRO
    if (IN(0)) for (int rep = 0; rep < NREP(0); ++rep) { PHASE_BEGIN(); phase_prologue(a, lds, lane_, wave_, blk, G); __syncthreads(); }
#endif
    SEAM(0);
    for (int L = 0; L < DEPTH; ++L) {
        const int pb = 1 + PPL * L;
#if EN_G1
        if (IN(pb)) for (int rep = 0; rep < NREP(1); ++rep) {
            { PHASE_BEGIN(); if (blk < G1Z) { pg8::Gemm g{HB, (const bf16*)(ws + wso(WS_WIN) + L * SZ_WIN), MP, PIN, DM}; pg8::StaticOrder S; S.init(MP, PIN, G1Z, blk);
              pg8::EpiBf16Q E{(bf16*)(ws + wso(WS_Z)), PIN}; pg8::gemm_phase<pg8::EpiBf16Q, pg8::StaticOrder, true, true>(lds, g, S, E, wave0); } }
              { PHASE_BEGIN(); const SEpi SE{SE_STORE, (float*)(ws + wso(WS_Z)) + (size_t)MP * PIN, nullptr, nullptr, PIN, 0.f, nullptr}; strip_gemm<4>(HB + (size_t)MP * DM, (const bf16*)(ws + wso(WS_WIN) + L * SZ_WIN), DM, PIN, SE, lds, lane_s, wave_s, blk, G, 1, G - G1Z); }
            { PHASE_BEGIN(); if (blk >= G1Z) { pg8::Gemm g{(const bf16*)(ws + wso(WS_PBF) + L * SZ_PBF), (const bf16*)(ws + wso(WS_WPP) + L * SZ_WPP), MP, DM, DPLE}; pg8::StaticOrder S; S.init(MP, DM, G - G1Z, blk - G1Z);
              pg8::EpiBf16Q E{(bf16*)(ws + wso(WS_PPO)), DM}; pg8::gemm_phase<pg8::EpiBf16Q, pg8::StaticOrder, true, true>(lds, g, S, E, wave0); } }
              { PHASE_BEGIN(); const SEpi SE{SE_STORE, (float*)(ws + wso(WS_PPO)) + (size_t)MP * DM, nullptr, nullptr, DM, 0.f, nullptr}; strip_gemm((const bf16*)(ws + wso(WS_PBF) + L * SZ_PBF) + (size_t)MP * DPLE, (const bf16*)(ws + wso(WS_WPP) + L * SZ_WPP), DPLE, DM, SE, lds, lane_s, wave_s, blk, G, 1, G - G1Z); }
        }
#endif
        SEAM(pb);
#if EN_PREP
        if (IN(pb + 1)) for (int rep = 0; rep < NREP(10); ++rep) { PHASE_BEGIN(); phase_pre(a, L, lds, lane_, wave_, blk, G); for (int r2 = 0; r2 < NREP(103); ++r2) phase_fin(a, L, lds, lane_, wave_, blk, G); }
#endif
        SEAM(pb + 1);
#if EN_MIX
        if (IN(pb + 2)) for (int rep = 0; rep < NREP(3); ++rep) { PHASE_BEGIN();
            const int tid = tid_, lane = lane_, wave = wave_;
            if (blk < SCAN_UNITS) { for (int r2 = 0; r2 < NREP(31); ++r2) rwkv_seq_unit(a, L, blk, lds, lane, wave); }
            else if (blk < ROLE_BLOCKS) { for (int r2 = 0; r2 < NREP(32); ++r2) hgrn_stream_unit(a, L, blk - SCAN_UNITS, lds, lane, wave); }
            else for (int r2 = 0; r2 < NREP(33); ++r2) for (int it = blk - ROLE_BLOCKS; it < N_MISC; it += G - ROLE_BLOCKS) {
                if (it < N_SGU) sgu_item2(a, L, it, lds, tid, lane, wave);
                else if (it < N_SGU + N_RS) rwkv_sample_item(a, L, it - N_SGU, lds, lane, wave);
                else hgrn_sample_item2(a, L, it - N_SGU - N_RS, lds, lane, wave);
                __syncthreads();
            }
        }
#endif
        SEAM(pb + 2);
#if EN_POST
        if (IN(pb + 3)) for (int rep = 0; rep < NREP(4); ++rep) { PHASE_BEGIN(); phase_post(a, L, lane_, wave_, blk, G); }
#endif
        SEAM(pb + 3);
#if EN_G3
        if (IN(pb + 4)) {
            for (int rep = 0; rep < NREP(5); ++rep) { PHASE_BEGIN(); pg8::Gemm g{(const bf16*)(ws + wso(WS_YMIX)), (const bf16*)(ws + wso(WS_WOUT) + L * SZ_WOUT), MP, DM, DM}; pg8::StaticOrder S; S.init(MP, DM, G, blk);
            pg8::EpiResidB E{(bf16*)T, HB, nullptr, DM, DN_ALPHA}; pg8::gemm_phase<pg8::EpiResidB, pg8::StaticOrder, true, true>(lds, g, S, E, wave0); }
            { PHASE_BEGIN(); const SEpi SE{SE_ATOMIC, T + (size_t)MP * DM, nullptr, nullptr, DM, 0.f, nullptr}; strip_gemm<4>((const bf16*)(ws + wso(WS_YMIX)) + (size_t)MP * DM, (const bf16*)(ws + wso(WS_WOUT) + L * SZ_WOUT), DM, DM, SE, lds, lane_s, wave_s, blk, G, 8); }
        }
#endif
        SEAM(pb + 4);
#if EN_LN
        if (IN(pb + 5)) for (int rep = 0; rep < NREP(6); ++rep) { PHASE_BEGIN(); phase_ln(a, a->in[I_LN1G] + L * DM, a->in[I_LN1B] + L * DM, false, lane_, wave_, blk, G); }
#endif
        SEAM(pb + 5);
#if EN_G4
        if (IN(pb + 6)) for (int rep = 0; rep < NREP(7); ++rep) {
            { PHASE_BEGIN(); pg8::Gemm g{HB, (const bf16*)(ws + wso(WS_WGU) + L * SZ_WGU), MP, 2 * DFF, DM}; pg8::StaticOrder S; S.init(MP, 2 * DFF, G, blk);
              pg8::EpiSwiglu E{(bf16*)(ws + wso(WS_ACT)), DFF}; pg8::gemm_phase<pg8::EpiSwiglu, pg8::StaticOrder, true, true>(lds, g, S, E, wave0); }
              { PHASE_BEGIN(); const SEpi SE{SE_SWIGLU, (float*)((bf16*)(ws + wso(WS_ACT)) + (size_t)MP * DFF), nullptr, nullptr, DFF, 0.f, nullptr}; strip_gemm<4>(HB + (size_t)MP * DM, (const bf16*)(ws + wso(WS_WGU) + L * SZ_WGU), DM, DFF, SE, lds, lane_s, wave_s, blk, G, 1, 128); }
            { PHASE_BEGIN(); pg8::Gemm g{HB, (const bf16*)(ws + wso(WS_WPG) + L * SZ_WPG), MP, DM, DM}; pg8::StaticOrder S; S.init(MP, DM, G, G - 1 - blk);
              pg8::EpiSigMulB E{(bf16*)(ws + wso(WS_PLE)), (const bf16*)(ws + wso(WS_PPO)), DM}; pg8::gemm_phase<pg8::EpiSigMulB, pg8::StaticOrder, true, true>(lds, g, S, E, wave0); }
              { PHASE_BEGIN(); const SEpi SE{SE_SIGMUL, (float*)(ws + wso(WS_PLE)) + (size_t)MP * DM, (const float*)(ws + wso(WS_PPO)) + (size_t)MP * DM, H + (size_t)MP * DM, DM, DN_ALPHA, T + (size_t)MP * DM}; strip_gemm<4>(HB + (size_t)MP * DM, (const bf16*)(ws + wso(WS_WPG) + L * SZ_WPG), DM, DM, SE, lds, lane_s, wave_s, blk, G, 1, 128); }
        }
#endif
        SEAM(pb + 6);
#if EN_G5
        if (IN(pb + 7)) {
            for (int rep = 0; rep < NREP(8); ++rep) { PHASE_BEGIN(); pg8::Gemm g{(const bf16*)(ws + wso(WS_ACT)), (const bf16*)(ws + wso(WS_WD) + L * SZ_WD), MP, DM, DFF}; pg8::StaticOrder S; S.init(MP, DM, G, blk);
            pg8::EpiResidB E{(bf16*)T, HB, (const bf16*)(ws + wso(WS_PLE)), DM, DN_ALPHA}; pg8::gemm_phase<pg8::EpiResidB, pg8::StaticOrder, true, true>(lds, g, S, E, wave0); }
            { PHASE_BEGIN(); const SEpi SE{SE_ATOMIC, T + (size_t)MP * DM, nullptr, nullptr, DM, 0.f, nullptr}; strip_gemm<4>((const bf16*)(ws + wso(WS_ACT)) + (size_t)MP * DFF, (const bf16*)(ws + wso(WS_WD) + L * SZ_WD), DFF, DM, SE, lds, lane_s, wave_s, blk, G, 8); }
        }
#endif
        SEAM(pb + 7);
#if EN_LN
        if (IN(pb + 8)) for (int rep = 0; rep < NREP(6); ++rep) { PHASE_BEGIN(); phase_ln(a, a->in[I_LN2G] + L * DM, a->in[I_LN2B] + L * DM, L == DEPTH - 1, lane_, wave_, blk, G); }
#endif
        SEAM(pb + 8);
    }
#undef IN
#undef SEAM
}

extern "C" void kernel_launch(void* const* d_in, const int* in_sizes, int n_in, void* d_out, int out_size, void* d_ws, size_t ws_size, hipStream_t stream) {
    static int grid = 0;
    if (grid == 0) {
        if (n_in != N_IN || (size_t)out_size != O_END || ws_size < WS_END) { fprintf(stderr, "kernel_launch: unexpected sizes n_in %d out %d ws %zu (need %zu)\n", n_in, out_size, ws_size, (size_t)WS_END); grid = -1; return; }
        int dev = 0, cus = 0, per_cu = 0;
        if (hipGetDevice(&dev) != hipSuccess || hipDeviceGetAttribute(&cus, hipDeviceAttributeMultiprocessorCount, dev) != hipSuccess) { grid = -1; return; }
        if (hipFuncSetAttribute((const void*)mk_fwd, hipFuncAttributeMaxDynamicSharedMemorySize, LDS_BYTES) != hipSuccess) { fprintf(stderr, "kernel_launch: hipFuncSetAttribute failed\n"); grid = -1; return; }
        if (hipOccupancyMaxActiveBlocksPerMultiprocessor(&per_cu, (const void*)mk_fwd, NTHR, LDS_BYTES) != hipSuccess || per_cu < 1) fprintf(stderr, "kernel_launch: occupancy query says %d\n", per_cu);
        (void)hipGetLastError();
        grid = cus;
        if (grid < G1Z + 8 || grid % 8) { fprintf(stderr, "kernel_launch: %d CUs is too few\n", grid); grid = -1; return; }
    }
    if (grid < 0) return;
    if (hipMemsetAsync((char*)d_ws + WS_CTL, 0, CTL_ZERO_BYTES, stream) != hipSuccess) return;
    Args a{};
    for (int i = 0; i < N_IN; ++i) a.in[i] = (const float*)d_in[i];
    a.out = (float*)d_out; a.ws = (unsigned char*)d_ws;
#if MK_SINGLE
    a.ph_lo = 0; a.ph_hi = N_PHASES;
    hipLaunchKernelGGL(mk_fwd, dim3(grid), dim3(NTHR), LDS_BYTES, stream, a);
#else
    for (int p = 0; p < N_PHASES; ++p) { a.ph_lo = p; a.ph_hi = p + 1; hipLaunchKernelGGL(mk_fwd, dim3(grid), dim3(NTHR), LDS_BYTES, stream, a); }
#endif
}
```

```cpp
#include <hip/hip_runtime.h>
#include <cstdio>
#include <cstdint>
typedef float mk_f32x2 __attribute__((ext_vector_type(2))); typedef __bf16 mk_bf16x2 __attribute__((ext_vector_type(2)));
__device__ __forceinline__ unsigned cvt_pk_bf16_c(float lo, float hi) { mk_f32x2 v = {lo, hi}; mk_bf16x2 b = __builtin_convertvector(v, mk_bf16x2); return __builtin_bit_cast(unsigned, b); }
__device__ __forceinline__ int mk_lane_id() { int l; asm volatile("v_mbcnt_lo_u32_b32 %0, -1, 0\n\tv_mbcnt_hi_u32_b32 %0, -1, %0" : "=v"(l)); return l; }
namespace pg8 {
#define PG8_LAS __attribute__((address_space(3)))
typedef unsigned short bf16_t;
typedef short bf16x8 __attribute__((ext_vector_type(8)));
typedef float f32x4 __attribute__((ext_vector_type(4)));
typedef unsigned u32x4 __attribute__((ext_vector_type(4)));
constexpr int BM = 256, BK = 64, HALF = 128, HTB = HALF * BK * 2  , STAGE_BYTES = 8 * HTB, NXCD = 8, WGM = 8;

__host__ __device__ __forceinline__ int lds_byte(int r, int c) { const int st = (r >> 4) * 2 + (c >> 5), rr = r & 15, cc = c & 31, ob = rr * 64 + cc * 2; return st * 1024 + (ob ^ (((ob >> 9) & 1) << 5)); }
__host__ __device__ __forceinline__ void stage_rc(int b, int& R, int& C) { const int st = b / 1024, sb = b % 1024, swz = sb ^ (((sb >> 9) & 1) << 5); R = (st >> 1) * 16 + swz / 64; C = (st & 1) * 32 + (swz % 64) / 2; }
__host__ __device__ __forceinline__ int perm32(int rho) { const int n = rho >> 4, i = rho & 15; return 8 * (i >> 2) + 4 * n + (i & 3); }

struct Unit { int pm, pn; };
struct Gemm { const bf16_t* A; const bf16_t* Bt; int M, N, K; };

struct StaticOrder {
    int nM, nN, nwg, G, c;
    __host__ __device__ void init(int M, int N, int G_, int c_) { nM = M / BM; nN = N / BM; nwg = nM * nN; G = G_; c = c_; }
    __host__ __device__ bool next(int i, Unit& u) const {
        const long L = (long)i * G + c; if (L >= nwg) return false;
        int wgid = (int)L; { const int q = nwg / NXCD, r = nwg % NXCD, xcd = wgid % NXCD, off = wgid / NXCD; wgid = (xcd < r ? xcd * (q + 1) : r * (q + 1) + (xcd - r) * q) + off; }
        const int nig = WGM * nN, gid = wgid / nig, fm = gid * WGM, gsz = (nM - fm) < WGM ? (nM - fm) : WGM;
        u.pm = fm + ((wgid % nig) % gsz); u.pn = (wgid % nig) / gsz; return true;
    }
    __device__ __forceinline__ void a_ready(const Unit&) const {}
    __device__ __forceinline__ void done(const Unit&) const {}
};

__device__ __forceinline__ unsigned cvt_pk_bf16(float lo, float hi) { unsigned r; asm volatile("v_cvt_pk_bf16_f32 %0, %1, %2" : "=v"(r) : "v"(lo), "v"(hi)); return r; }
typedef float f32x2 __attribute__((ext_vector_type(2)));
typedef unsigned u32x2 __attribute__((ext_vector_type(2)));
struct EpiSwiglu {
    static constexpr bool PERM = true, AFTER_DRAIN = false;
    bf16_t* O; int ldo;
    __device__ __forceinline__ void operator()(const f32x4 (&acc)[2][2][4][2], const Unit& u, int wr, int wc, int fr, int fq) const {
        { const int l_ = mk_lane_id(); fr = l_ & 15; fq = l_ >> 4; }
        const int row0 = u.pm * BM + wr * 64 + fr, col0 = u.pn * HALF + wc * 32 + 8 * fq;
#pragma unroll
        for (int ai = 0; ai < 2; ++ai)
#pragma unroll
            for (int m = 0; m < 4; ++m) { bf16_t* rowp = O + (size_t)(row0 + ai * HALF + m * 16) * ldo + col0; float r[8];
#pragma unroll
                for (int n = 0; n < 2; ++n)
#pragma unroll
                    for (int e = 0; e < 4; ++e) { const float g = acc[ai][0][m][n][e], up = acc[ai][1][m][n][e]; r[4 * n + e] = g * __builtin_amdgcn_rcpf(1.0f + __expf(-g)) * up; }
                u32x4 w; w.x = cvt_pk_bf16(r[0], r[1]); w.y = cvt_pk_bf16(r[2], r[3]); w.z = cvt_pk_bf16(r[4], r[5]); w.w = cvt_pk_bf16(r[6], r[7]);
                *(u32x4*)rowp = w; }
    }
};
struct EpiResidB {
    static constexpr bool PERM = false, AFTER_DRAIN = false;
    bf16_t* out; const bf16_t* base; const bf16_t* add; int ldc; float alpha;
    __device__ __forceinline__ void operator()(const f32x4 (&acc)[2][2][4][2], const Unit& u, int wr, int wc, int fr, int fq) const {
        { const int l_ = mk_lane_id(); fr = l_ & 15; fq = l_ >> 4; }
        const int row0 = u.pm * BM + wr * 64 + fr, col0 = u.pn * BM + wc * 32 + 4 * fq;
        const bool ha = add != nullptr;
        u32x2 hb[2][4], ab[2][4];
#define ERB_LOAD(g_, b_) { const size_t off = (size_t)(row0 + ((g_) >> 2) * HALF + ((g_) & 3) * 16) * ldc + col0; _Pragma("unroll") for (int p = 0; p < 4; ++p) { const size_t o2 = off + (p >> 1) * HALF + (p & 1) * 16; \
            hb[b_][p] = *(const u32x2*)(base + o2); if (ha) ab[b_][p] = *(const u32x2*)(add + o2); } }
        ERB_LOAD(0, 0)
#pragma unroll
        for (int g = 0; g < 8; ++g) {
            if (g + 1 < 8) ERB_LOAD(g + 1, (g + 1) & 1)
            __builtin_amdgcn_sched_barrier(0);
            const int ai = g >> 2, m = g & 3; const size_t off = (size_t)(row0 + ai * HALF + m * 16) * ldc + col0;
#pragma unroll
            for (int p = 0; p < 4; ++p) { const int bj = p >> 1, n = p & 1; const size_t o2 = off + bj * HALF + n * 16; const u32x2 h2 = hb[g & 1][p];
                f32x4 h; h[0] = __builtin_bit_cast(float, h2.x << 16); h[1] = __builtin_bit_cast(float, h2.x & 0xffff0000u); h[2] = __builtin_bit_cast(float, h2.y << 16); h[3] = __builtin_bit_cast(float, h2.y & 0xffff0000u);
                f32x4 v = h * alpha + acc[ai][bj][m][n]; if (ha) { const u32x2 a2 = ab[g & 1][p]; v[0] += __builtin_bit_cast(float, a2.x << 16); v[1] += __builtin_bit_cast(float, a2.x & 0xffff0000u); v[2] += __builtin_bit_cast(float, a2.y << 16); v[3] += __builtin_bit_cast(float, a2.y & 0xffff0000u); }
                u32x2 w; w.x = cvt_pk_bf16_c(v[0], v[1]); w.y = cvt_pk_bf16_c(v[2], v[3]); *(u32x2*)(out + o2) = w; }
            __builtin_amdgcn_sched_barrier(0);
        }
#undef ERB_LOAD
    }
};
struct EpiBf16Q {
    static constexpr bool PERM = false, AFTER_DRAIN = false;
    bf16_t* O; int ldo;
    __device__ __forceinline__ void operator()(const f32x4 (&acc)[2][2][4][2], const Unit& u, int wr, int wc, int fr, int fq) const {
        { const int l_ = mk_lane_id(); fr = l_ & 15; fq = l_ >> 4; }
        const int row0 = u.pm * BM + wr * 64 + fr, col0 = u.pn * BM + wc * 32 + 4 * fq;
#pragma unroll
        for (int ai = 0; ai < 2; ++ai)
#pragma unroll
            for (int m = 0; m < 4; ++m) { bf16_t* rowp = O + (size_t)(row0 + ai * HALF + m * 16) * ldo + col0;
#pragma unroll
                for (int bj = 0; bj < 2; ++bj)
#pragma unroll
                    for (int n = 0; n < 2; ++n) { const f32x4 v = acc[ai][bj][m][n]; u32x2 w; w.x = cvt_pk_bf16_c(v[0], v[1]); w.y = cvt_pk_bf16_c(v[2], v[3]); *(u32x2*)(rowp + bj * HALF + n * 16) = w; } }
    }
};
struct EpiSigMulB {
    static constexpr bool PERM = false, AFTER_DRAIN = false;
    bf16_t* out; const bf16_t* mul; int ldc;
    __device__ __forceinline__ void operator()(const f32x4 (&acc)[2][2][4][2], const Unit& u, int wr, int wc, int fr, int fq) const {
        { const int l_ = mk_lane_id(); fr = l_ & 15; fq = l_ >> 4; }
        const int row0 = u.pm * BM + wr * 64 + fr, col0 = u.pn * BM + wc * 32 + 4 * fq;
        u32x2 mb[2][4];
#define ESM_LOAD(g_, b_) { const size_t off = (size_t)(row0 + ((g_) >> 2) * HALF + ((g_) & 3) * 16) * ldc + col0; _Pragma("unroll") for (int p = 0; p < 4; ++p) mb[b_][p] = *(const u32x2*)(mul + off + (p >> 1) * HALF + (p & 1) * 16); }
        ESM_LOAD(0, 0)
#pragma unroll
        for (int g = 0; g < 8; ++g) {
            if (g + 1 < 8) ESM_LOAD(g + 1, (g + 1) & 1)
            __builtin_amdgcn_sched_barrier(0);
            const int ai = g >> 2, m = g & 3; const size_t off = (size_t)(row0 + ai * HALF + m * 16) * ldc + col0;
#pragma unroll
            for (int p = 0; p < 4; ++p) { const int bj = p >> 1, n = p & 1; const size_t o2 = off + bj * HALF + n * 16; const f32x4 x = acc[ai][bj][m][n]; const u32x2 pb = mb[g & 1][p];
                f32x4 pv; pv[0] = __builtin_bit_cast(float, pb.x << 16); pv[1] = __builtin_bit_cast(float, pb.x & 0xffff0000u); pv[2] = __builtin_bit_cast(float, pb.y << 16); pv[3] = __builtin_bit_cast(float, pb.y & 0xffff0000u);
                f32x4 v;
#pragma unroll
                for (int e2 = 0; e2 < 4; ++e2) v[e2] = pv[e2] * __builtin_amdgcn_rcpf(1.0f + __expf(-x[e2]));
                u32x2 w; w.x = cvt_pk_bf16_c(v[0], v[1]); w.y = cvt_pk_bf16_c(v[2], v[3]); *(u32x2*)(out + o2) = w; }
            __builtin_amdgcn_sched_barrier(0);
        }
#undef ESM_LOAD
    }
};
template <class Epi, class Sched, bool ALIGN_EPI = false, bool SP2 = false>
__device__ __forceinline__ void gemm_phase(PG8_LAS unsigned char* lds, const Gemm g, const Sched& S, const Epi& E, int wid0) {
    int tid_l = wid0 * 64 + mk_lane_id(); asm volatile("" : "+v"(tid_l));
    const int tid = tid_l, wid = __builtin_amdgcn_readfirstlane(tid >> 6), lane = tid & 63, wr = wid >> 2, wc = wid & 3, fr = lane & 15, fq = lane >> 4;
    const int K = g.K, nt = K / BK;
    unsigned voffA[2], voffB[2];
#pragma unroll
    for (int i = 0; i < 2; ++i) { int R, C; stage_rc(tid * 16 + i * 8192, R, C); const int Rb = Epi::PERM ? ((R & ~31) + perm32(R & 31)) : R;
        voffA[i] = (unsigned)(R * K + C) * 2u; voffB[i] = (unsigned)(Rb * K + C) * 2u; }
    const size_t kstep = (size_t)(BK * 2);
    const size_t hstep = (size_t)HALF * K * 2;
    const size_t tstep = 2 * hstep;
    const unsigned ldsw = (unsigned)wid * 1024u;
    const int aoff = lds_byte(wr * 64 + fr, fq * 8), boff = lds_byte(wc * 32 + fr, fq * 8);
#define PG8_SA(b, h) (((b) * 2 + (h)) * HTB)
#define PG8_SB(b, h) ((4 + (b) * 2 + (h)) * HTB)
#define PG8_STAGE(bufoff, gbase, voff) do { _Pragma("unroll") for (int _i = 0; _i < 2; ++_i) \
        __builtin_amdgcn_global_load_lds((const unsigned*)((const char*)(gbase) + (voff)[_i]), (PG8_LAS unsigned*)(lds + (bufoff) + ldsw + _i * 8192), 16, 0, 0); } while (0)
#define PG8_LDA(dst, b, h) do { _Pragma("unroll") for (int m = 0; m < 4; ++m) _Pragma("unroll") for (int k = 0; k < 2; ++k) dst[m][k] = *(const PG8_LAS bf16x8*)(lds + PG8_SA(b, h) + aoff + m * 2048 + k * 1024); } while (0)
#define PG8_LDB(dst, b, h) do { _Pragma("unroll") for (int n = 0; n < 2; ++n) _Pragma("unroll") for (int k = 0; k < 2; ++k) dst[n][k] = *(const PG8_LAS bf16x8*)(lds + PG8_SB(b, h) + boff + n * 2048 + k * 1024); } while (0)
#define PG8_MMA(ai, bj, At, Bt) do { __builtin_amdgcn_s_setprio(1); _Pragma("unroll") for (int m = 0; m < 4; ++m) _Pragma("unroll") for (int n = 0; n < 2; ++n) _Pragma("unroll") for (int k = 0; k < 2; ++k) \
        acc[ai][bj][m][n] = __builtin_amdgcn_mfma_f32_16x16x32_bf16(Bt[n][k], At[m][k], acc[ai][bj][m][n], 0, 0, 0); __builtin_amdgcn_s_setprio(0); } while (0)
#define PG8_WAIT_V(n) asm volatile("s_waitcnt vmcnt(" #n ")" ::: "memory")
#define PG8_WAIT_L(n) asm volatile("s_waitcnt lgkmcnt(" #n ")" ::: "memory")
#define PG8_BAR __builtin_amdgcn_s_barrier()
#define PG8_SCHED __builtin_amdgcn_sched_barrier(0)
    Unit cur, nxt; int ui = 0;
    if (!S.next(0, cur)) return;
    f32x4 acc[2][2][4][2];
#pragma unroll
    for (int a = 0; a < 2; ++a)
#pragma unroll
        for (int b = 0; b < 2; ++b)
#pragma unroll
            for (int m = 0; m < 4; ++m)
#pragma unroll
                for (int n = 0; n < 2; ++n) acc[a][b][m][n] = (f32x4){0.f, 0.f, 0.f, 0.f};
    bf16x8 At[4][2], B0[2][2], B1[2][2];
    const char* cA = (const char*)g.A + (size_t)cur.pm * tstep; const char* cB = (const char*)g.Bt + (size_t)cur.pn * tstep;
    S.a_ready(cur);
    if constexpr (SP2) {
        PG8_STAGE(PG8_SB(0, 0), cB, voffB); PG8_STAGE(PG8_SB(0, 1), cB + hstep, voffB); PG8_STAGE(PG8_SA(0, 0), cA, voffA); PG8_STAGE(PG8_SA(0, 1), cA + hstep, voffA);
        if (wr == 1) PG8_BAR;
        PG8_WAIT_V(2); PG8_BAR;
        PG8_STAGE(PG8_SB(1, 0), cB + kstep, voffB); PG8_STAGE(PG8_SA(1, 0), cA + kstep, voffA); PG8_STAGE(PG8_SB(1, 1), cB + hstep + kstep, voffB);
        PG8_WAIT_V(6); PG8_BAR;
    } else {
        PG8_STAGE(PG8_SB(0, 0), cB, voffB); PG8_STAGE(PG8_SA(0, 0), cA, voffA); PG8_STAGE(PG8_SB(0, 1), cB + hstep, voffB); PG8_STAGE(PG8_SA(0, 1), cA + hstep, voffA);
        if (wr == 1) PG8_BAR;
        PG8_WAIT_V(4); PG8_BAR;
        PG8_STAGE(PG8_SB(1, 0), cB + kstep, voffB); PG8_STAGE(PG8_SA(1, 0), cA + kstep, voffA); PG8_STAGE(PG8_SB(1, 1), cB + hstep + kstep, voffB);
        PG8_WAIT_V(6); PG8_BAR;
    }
    for (;;) {
        const bool has_next = S.next(ui + 1, nxt);
        const char* nA = has_next ? (const char*)g.A + (size_t)nxt.pm * tstep : cA; const char* nB = has_next ? (const char*)g.Bt + (size_t)nxt.pn * tstep : cB;
        for (int t = 0; t < nt; t += 2) {
            const bool last = (t == nt - 2);
            const char* a1 = cA + (size_t)(t + 1) * kstep;
            const char* a2 = last ? nA : cA + (size_t)(t + 2) * kstep; const char* b2 = last ? nB : cB + (size_t)(t + 2) * kstep;
            const char* a3 = a2 + kstep; const char* b3 = b2 + kstep;
            if (last && has_next) S.a_ready(nxt);
            if constexpr (SP2) {
            PG8_LDB(B0, 0, 0); PG8_LDB(B1, 0, 1); PG8_SCHED; PG8_LDA(At, 0, 0); PG8_STAGE(PG8_SA(1, 1), a1 + hstep, voffA);
            PG8_WAIT_V(8); PG8_WAIT_L(0); PG8_BAR; PG8_MMA(0, 0, At, B0); PG8_MMA(0, 1, At, B1); PG8_BAR; PG8_SCHED;
            PG8_LDA(At, 0, 1); PG8_STAGE(PG8_SB(0, 0), b2, voffB); PG8_STAGE(PG8_SB(0, 1), b2 + hstep, voffB); PG8_STAGE(PG8_SA(0, 0), a2, voffA);
            PG8_WAIT_V(8); PG8_WAIT_L(0); PG8_BAR; PG8_MMA(1, 0, At, B0); PG8_MMA(1, 1, At, B1); PG8_BAR; PG8_SCHED;
            PG8_LDB(B0, 1, 0); PG8_LDB(B1, 1, 1); PG8_SCHED; PG8_LDA(At, 1, 0); PG8_STAGE(PG8_SA(0, 1), a2 + hstep, voffA);
            PG8_WAIT_V(8); PG8_WAIT_L(0); PG8_BAR; PG8_MMA(0, 0, At, B0); PG8_MMA(0, 1, At, B1); PG8_BAR; PG8_SCHED;
            PG8_LDA(At, 1, 1); PG8_STAGE(PG8_SB(1, 0), b3, voffB); PG8_STAGE(PG8_SB(1, 1), b3 + hstep, voffB); PG8_STAGE(PG8_SA(1, 0), a3, voffA);
            PG8_WAIT_V(8); PG8_WAIT_L(0); PG8_BAR; PG8_MMA(1, 0, At, B0); PG8_MMA(1, 1, At, B1); PG8_BAR; PG8_SCHED;
            } else {
            PG8_LDB(B0, 0, 0); PG8_SCHED; PG8_LDA(At, 0, 0); PG8_STAGE(PG8_SA(1, 1), a1 + hstep, voffA);
            PG8_WAIT_L(8); PG8_BAR; PG8_WAIT_L(0); PG8_MMA(0, 0, At, B0); PG8_BAR; PG8_SCHED;
            PG8_LDB(B1, 0, 1); PG8_STAGE(PG8_SB(0, 0), b2, voffB);
            PG8_BAR; PG8_WAIT_L(0); PG8_MMA(0, 1, At, B1); PG8_BAR;
            PG8_LDA(At, 0, 1); PG8_STAGE(PG8_SA(0, 0), a2, voffA);
            PG8_BAR; PG8_WAIT_L(0); PG8_MMA(1, 0, At, B0); PG8_BAR; PG8_SCHED;
            PG8_STAGE(PG8_SB(0, 1), b2 + hstep, voffB);
            PG8_WAIT_V(6); PG8_BAR; PG8_MMA(1, 1, At, B1); PG8_BAR;
            PG8_LDB(B0, 1, 0); PG8_SCHED; PG8_LDA(At, 1, 0); PG8_STAGE(PG8_SA(0, 1), a2 + hstep, voffA);
            PG8_WAIT_L(8); PG8_BAR; PG8_WAIT_L(0); PG8_MMA(0, 0, At, B0); PG8_BAR; PG8_SCHED;
            PG8_LDB(B1, 1, 1); PG8_STAGE(PG8_SB(1, 0), b3, voffB);
            PG8_BAR; PG8_WAIT_L(0); PG8_MMA(0, 1, At, B1); PG8_BAR;
            PG8_LDA(At, 1, 1); PG8_STAGE(PG8_SA(1, 0), a3, voffA);
            PG8_BAR; PG8_WAIT_L(0); PG8_MMA(1, 0, At, B0); PG8_BAR; PG8_SCHED;
            PG8_STAGE(PG8_SB(1, 1), b3 + hstep, voffB);
            PG8_WAIT_V(6); PG8_BAR; PG8_MMA(1, 1, At, B1); PG8_BAR;
            }
        }
        if constexpr (ALIGN_EPI) { if (wr == 0) PG8_BAR; }
        if constexpr (!Epi::AFTER_DRAIN) { E(acc, cur, wr, wc, fr, fq); S.done(cur); }
        if (!has_next) break;
#pragma unroll
        for (int a = 0; a < 2; ++a)
#pragma unroll
            for (int b = 0; b < 2; ++b)
#pragma unroll
                for (int m = 0; m < 4; ++m)
#pragma unroll
                    for (int n = 0; n < 2; ++n) acc[a][b][m][n] = (f32x4){0.f, 0.f, 0.f, 0.f};
        cur = nxt; cA = nA; cB = nB; ++ui;
        if constexpr (ALIGN_EPI) { if (wr == 1) PG8_BAR; }
    }
    PG8_WAIT_V(0);
    if constexpr (!ALIGN_EPI) { if (wr == 0) PG8_BAR; }
    PG8_BAR;
    if constexpr (Epi::AFTER_DRAIN) { E.fused(acc, cur, wr, wc, fr, fq, lds, wid, lane); S.done(cur); }
#undef PG8_SA
#undef PG8_SB
#undef PG8_STAGE
#undef PG8_LDA
#undef PG8_LDB
#undef PG8_MMA
#undef PG8_WAIT_V
#undef PG8_WAIT_L
#undef PG8_BAR
#undef PG8_SCHED
}
}
#define GAS __attribute__((address_space(1)))
#define LAS __attribute__((address_space(3)))
typedef unsigned short bf16;
typedef unsigned v4u __attribute__((ext_vector_type(4)));
typedef float f32x4 __attribute__((ext_vector_type(4)));
typedef short bf16x8 __attribute__((ext_vector_type(8)));
typedef GAS unsigned gu32;
typedef GAS unsigned long long gu64;
#define RLX_AGENT __ATOMIC_RELAXED, __HIP_MEMORY_SCOPE_AGENT
#define LDS_WAIT() asm volatile("s_waitcnt lgkmcnt(0)" ::: "memory")
#define VM_WAIT() asm volatile("s_waitcnt vmcnt(0)" ::: "memory")
__device__ __forceinline__ unsigned long long rt() { return __builtin_amdgcn_s_memrealtime(); }
__device__ __forceinline__ unsigned f2bf(float f) { unsigned u = __builtin_bit_cast(unsigned, f); return (u + 0x7fffu + ((u >> 16) & 1u)) >> 16; }
__device__ __forceinline__ unsigned pk2(float lo, float hi) { return f2bf(lo) | (f2bf(hi) << 16); }

#define XB_TMO      128
#define XB_XCNT(j)  (256  + 64 * (j))
#define XB_XSUB(j)  (1280 + 64 * (j))
#define XB_XGEN(j)  (2304 + 64 * (j))
#define XB_TOP      3328
#define XB_TOPGEN   3392
#define XCD_BAR_WORDS 3456
#define XB_SPIN_CAP (1u << 18)

__device__ __forceinline__ unsigned xb_ld(unsigned* p)              { return __hip_atomic_load(p, __ATOMIC_RELAXED, __HIP_MEMORY_SCOPE_AGENT); }
__device__ __forceinline__ unsigned xb_add(unsigned* p, unsigned v) { return __hip_atomic_fetch_add(p, v, __ATOMIC_RELAXED, __HIP_MEMORY_SCOPE_AGENT); }
__device__ __forceinline__ unsigned xb_xcc_id() { return (unsigned)__builtin_amdgcn_s_getreg((3 << 11) | 20) & 0xFu; }
#define XB_SPIN(cond, bar) do { unsigned _sp = 0; while (cond) { __builtin_amdgcn_s_sleep(1); \
    if ((++_sp & 255u) == 0u) { if (xb_ld(&(bar)[XB_TMO])) break; if (_sp > XB_SPIN_CAP) { atomicAdd(&(bar)[XB_TMO], 1u); break; } } } } while (0)

struct XcdBarrier {
    unsigned* bar; unsigned x;
    volatile LAS unsigned* st;
    bool w0;
};

__device__ __forceinline__ XcdBarrier xcd_barrier_post(unsigned* bar, volatile LAS unsigned* st) {
    XcdBarrier b; b.bar = bar; b.x = xb_xcc_id(); b.st = st;
    if (threadIdx.x == 0) (void)xb_add(&bar[XB_XCNT(b.x)], 1u);
    return b;
}
__device__ __forceinline__ void xcd_barrier_complete(unsigned* bar, unsigned x, unsigned& nloc, unsigned& nx) {
    const unsigned G = gridDim.x * gridDim.y * gridDim.z;
    unsigned sum, cnt, mine, sp = 0u;
    for (;;) {
        sum = 0u; cnt = 0u; mine = 0u;
#pragma unroll 1
        for (unsigned j = 0; j < 16; ++j) { const unsigned c = xb_ld(&bar[XB_XCNT(j)]); sum += c; cnt += (c > 0u) ? 1u : 0u; mine = (j == x) ? c : mine; }
        if (sum == G) break;
        __builtin_amdgcn_s_sleep(1);
        if ((++sp & 255u) == 0u) { if (xb_ld(&bar[XB_TMO])) break; if (sp > XB_SPIN_CAP) { atomicAdd(&bar[XB_TMO], 1u); break; } }
    }
    nloc = mine > 0u ? mine : 1u; nx = cnt > 0u ? cnt : 1u;
}

__device__ __forceinline__ void xcd_barrier(const XcdBarrier& b) {
    asm volatile("s_waitcnt vmcnt(0)" ::: "memory");
    __syncthreads();
    if (b.w0 && mk_lane_id() == 0) {
        unsigned* bar = b.bar;
        __builtin_amdgcn_s_waitcnt(0);
        unsigned nloc = b.st[0], nx = b.st[1];
        if (nloc == 0u) { xcd_barrier_complete(bar, b.x, nloc, nx); b.st[0] = nloc; b.st[1] = nx; }
        const unsigned old = xb_add(&bar[XB_XSUB(b.x)], 1u);
        const unsigned gen = old / nloc;
        if (old + 1u == (gen + 1u) * nloc) {
            __builtin_amdgcn_fence(__ATOMIC_RELEASE, "agent");
            asm volatile("s_waitcnt vmcnt(0)" ::: "memory");
            const unsigned og = xb_add(&bar[XB_TOP], 1u);
            const unsigned tg = og / nx;
            if (og + 1u == (tg + 1u) * nx) xb_add(&bar[XB_TOPGEN], 1u);
            else XB_SPIN(xb_ld(&bar[XB_TOPGEN]) == tg, bar);
            __builtin_amdgcn_fence(__ATOMIC_ACQUIRE, "agent");
            xb_add(&bar[XB_XGEN(b.x)], 1u);
            asm volatile("s_waitcnt vmcnt(0)" ::: "memory");
        } else {
            XB_SPIN(xb_ld(&bar[XB_XGEN(b.x)]) == gen, bar);
            __builtin_amdgcn_fence(__ATOMIC_ACQUIRE, "agent");
            asm volatile("s_waitcnt vmcnt(0)" ::: "memory");
        }
    }
    __syncthreads();
}
#ifndef REP_PHASE
#define REP_PHASE -1
#endif
#define NREP(k) ((REP_PHASE) == (k) ? 2 : 1)

constexpr int DM = 2048, NBAT = 4, SEQ = 2048, DEPTH = 4, NS = 128;
constexpr int MP = NBAT * SEQ;
constexpr int MV = MP + NS;
constexpr int MPAD = 8448;
constexpr int WA = 512, WB = 768, WC = 768, PIN = 6656, DFF = 5632, DPLE = 256, PBW = 2560;
constexpr int OFF_B = 1024, OFF_C = 3584;
constexpr float LN_EPS = 1e-5f, GN_EPS = 64e-5f, RMS_EPS = 1e-6f;
constexpr float DN_ALPHA = 1.681792830507429f;
enum { I_XP = 0, I_XS, I_SRWKV, I_SSHIFT, I_SHGRN, I_PP, I_PS, I_LNING, I_LNINB, I_WIN, I_ALNG, I_ALNB, I_AWS, I_ABS, I_BMU, I_BW0, I_BWUP, I_BA0, I_BAUP, I_BGUP,
       I_BKK, I_BKA, I_BRK, I_BGNG, I_BGNB, I_CLB, I_CNG, I_WOUT, I_LN1G, I_LN1B, I_WG, I_WU, I_WD, I_WPG, I_WPP, I_LN2G, I_LN2B, N_IN };
constexpr size_t O_YP = 0, O_YS = O_YP + (size_t)MP * DM, O_RP = O_YS + (size_t)NS * DM, O_SP = O_RP + (size_t)DEPTH * NBAT * 12 * 4096,
                 O_HP = O_SP + (size_t)DEPTH * NBAT * PBW, O_RS = O_HP + (size_t)DEPTH * NBAT * 6 * 16384, O_SS = O_RS + (size_t)DEPTH * NS * 12 * 4096,
                 O_HS = O_SS + (size_t)DEPTH * NS * PBW, O_VS = O_HS + (size_t)DEPTH * NS * 6 * 16384, O_END = O_VS + (size_t)DEPTH * NS * WA;
static_assert(O_END == 96509952, "output size");
constexpr size_t al256(size_t x) { return (x + 255) & ~(size_t)255; }
constexpr size_t WS_CTL = 0, CTL_ZERO_BYTES = 1u << 20;
constexpr size_t SZ_WIN = (size_t)PIN * DM * 2, SZ_WOUT = (size_t)DM * DM * 2, SZ_WGU = (size_t)2 * DFF * DM * 2, SZ_WD = (size_t)DM * DFF * 2, SZ_WPG = SZ_WOUT, SZ_WPP = (size_t)DM * DPLE * 2;
constexpr size_t WS_WIN = CTL_ZERO_BYTES, WS_WOUT = WS_WIN + DEPTH * SZ_WIN, WS_WGU = WS_WOUT + DEPTH * SZ_WOUT, WS_WD = WS_WGU + DEPTH * SZ_WGU, WS_WPG = WS_WD + DEPTH * SZ_WD,
                 WS_WPP = WS_WPG + DEPTH * SZ_WPG, WS_PBF = WS_WPP + DEPTH * SZ_WPP;
constexpr size_t SZ_PBF = (size_t)MPAD * DPLE * 2;
constexpr size_t WS_H = WS_PBF + DEPTH * SZ_PBF, WS_HB = WS_H + (size_t)MPAD * DM * 4, WS_T = WS_HB + (size_t)MPAD * DM * 2, WS_YMIX = WS_T + (size_t)MPAD * DM * 4;
constexpr size_t WS_Z = WS_YMIX + (size_t)MPAD * DM * 2;
constexpr size_t WS_ACT = WS_Z, WS_PLE = WS_ACT + al256((size_t)MPAD * DFF * 2);
constexpr size_t WS_PPO = WS_Z + (size_t)MPAD * PIN * 4;
static_assert(WS_PLE + (size_t)MPAD * DM * 4 <= WS_PPO, "overlay fits");
constexpr size_t WS_RPB = WS_PPO + (size_t)MPAD * DM * 4;
constexpr size_t WS_RPS = WS_RPB + (size_t)NBAT * 12 * (SEQ / 16) * 16384;
constexpr int NLORA = 3 * WB;
constexpr size_t SZ_WL = (size_t)NLORA * 256 * 2;
constexpr size_t WS_WL = WS_RPS + (size_t)NS * 12 * 384 * 4;
constexpr size_t WS_XCAT = WS_WL + DEPTH * SZ_WL;
constexpr size_t WS_LORA = WS_XCAT + (size_t)MPAD * 256 * 2;
constexpr size_t WS_Y = WS_LORA + (size_t)MPAD * NLORA * 4;
constexpr size_t WS_O = WS_Y + (size_t)MPAD * WB * 4;
constexpr size_t WS_HREC = WS_O + (size_t)MPAD * WC * 4;
constexpr size_t WS_XB = WS_HREC + (size_t)NBAT * 6 * (SEQ / 16) * 17408;
constexpr size_t WS_END = WS_XB + 2 * (size_t)MP * 8 * 8;
constexpr int CW_SEAM = 16384;
static_assert(WS_WIN % 256 == 0 && WS_H % 256 == 0 && WS_Z % 256 == 0 && WS_RPB % 256 == 0 && WS_WL % 256 == 0 && WS_XCAT % 256 == 0 && WS_LORA % 256 == 0 && WS_Y % 256 == 0, "alignment");
constexpr int CW_BAR = 4096;

constexpr int RING_BYTES = 131072, LDSCTL_OFF = RING_BYTES, MISC_OFF = LDSCTL_OFF + 320, LDS_BYTES = 147456;
constexpr int NWAVES = 8, NTHR = 512;

struct Args { const float* in[N_IN]; float* out; unsigned char* ws; int ph_lo, ph_hi; };
static_assert(sizeof(Args) == (N_IN + 2) * 8 + 8, "no padding in Args");
typedef const __attribute__((address_space(4))) Args* ArgsP;

__device__ __forceinline__ size_t wso(size_t c) { asm volatile("" : "+s"(c)); return c; }
typedef float f4 __attribute__((ext_vector_type(4)));
typedef float f2 __attribute__((ext_vector_type(2)));
typedef unsigned u2 __attribute__((ext_vector_type(2)));

template <int CTRL> __device__ __forceinline__ float dpp_f(float x) { return __builtin_bit_cast(float, __builtin_amdgcn_update_dpp(0, __builtin_bit_cast(int, x), CTRL, 0xF, 0xF, true)); }
__device__ __forceinline__ float row16_sum(float x) {
    x += dpp_f<0xB1>(x);
    x += dpp_f<0x4E>(x);
    x += dpp_f<0x141>(x);
    x += dpp_f<0x140>(x);
    return x;
}
__device__ __forceinline__ float readlane_f(float x, int l) { return __builtin_bit_cast(float, __builtin_amdgcn_readlane(__builtin_bit_cast(int, x), l)); }
template <int CTRL, int RM> __device__ __forceinline__ float dpp_fm(float x) { return __builtin_bit_cast(float, __builtin_amdgcn_update_dpp(0, __builtin_bit_cast(int, x), CTRL, RM, 0xF, false)); }
__device__ __forceinline__ float wave_sum_fast(float x) { x = row16_sum(x); x += dpp_fm<0x142, 0xA>(x); x += dpp_fm<0x143, 0xC>(x); return readlane_f(x, 63); }
__device__ __forceinline__ float wave_sum(float v) { return wave_sum_fast(v); }
__device__ __forceinline__ float sigmoidf_(float x) { return 1.0f / (1.0f + expf(-x)); }
__device__ __forceinline__ float gelu_erf(float x) { return 0.5f * x * (1.0f + erff(x * 0.70710678118654752f)); }
__device__ __forceinline__ unsigned short bf1(float x) { return (unsigned short)(cvt_pk_bf16_c(x, 0.f) & 0xffffu); }
__device__ __forceinline__ float bfl(unsigned short u) { return __builtin_bit_cast(float, (unsigned)u << 16); }
__device__ __forceinline__ f4 bf4(u2 w) { f4 v; v.x = __builtin_bit_cast(float, w.x << 16); v.y = __builtin_bit_cast(float, w.x & 0xffff0000u); v.z = __builtin_bit_cast(float, w.y << 16); v.w = __builtin_bit_cast(float, w.y & 0xffff0000u); return v; }
__device__ __forceinline__ float lbound(const float* clb, int L, int c) {
    const float x0 = clb[c], x1 = clb[WC + c], x2 = clb[2 * WC + c], x3 = clb[3 * WC + c];
    const float mx = fmaxf(fmaxf(x0, x1), fmaxf(x2, x3));
    const float e0 = expf(x0 - mx), e1 = expf(x1 - mx), e2 = expf(x2 - mx), e3 = expf(x3 - mx);
    float s = 0.f; if (L >= 1) s += e1; if (L >= 2) s += e2; if (L >= 3) s += e3;
    return s / (e0 + e1 + e2 + e3);
}
__device__ __forceinline__ float lbound_v(float x0, float x1, float x2, float x3, int L) {
    const float mx = fmaxf(fmaxf(x0, x1), fmaxf(x2, x3));
    const float e0 = __expf(x0 - mx), e1 = __expf(x1 - mx), e2 = __expf(x2 - mx), e3 = __expf(x3 - mx);
    float s = 0.f; if (L >= 1) s += e1; if (L >= 2) s += e2; if (L >= 3) s += e3;
    return s * __builtin_amdgcn_rcpf(e0 + e1 + e2 + e3);
}

__device__ __forceinline__ void tr_item(const float* W, int K, int N, bf16* WT, int mode, LAS float* scr, int item, int lane) {
    const int nblk = N >> 5, kb = item / nblk, nb = item - kb * nblk, k0 = kb << 6, n0 = nb << 5;
    int rb = n0; if (mode) rb = ((n0 >> 7) << 8) + (n0 & 127) + (mode == 2 ? 128 : 0);
#pragma unroll 8
    for (int i = 0; i < 32; ++i) { const int kk = 2 * i + (lane >> 5); scr[kk * 33 + (lane & 31)] = W[(size_t)(k0 + kk) * N + n0 + (lane & 31)]; }
    LDS_WAIT(); asm volatile("" ::: "memory");
    const int c = lane & 7;
#pragma unroll
    for (int j = 0; j < 4; ++j) { const int n = (lane >> 3) + 8 * j; const LAS float* s = scr + (8 * c) * 33 + n;
        v4u o; o.x = pg8::cvt_pk_bf16(s[0 * 33], s[1 * 33]); o.y = pg8::cvt_pk_bf16(s[2 * 33], s[3 * 33]); o.z = pg8::cvt_pk_bf16(s[4 * 33], s[5 * 33]); o.w = pg8::cvt_pk_bf16(s[6 * 33], s[7 * 33]);
        *(v4u*)(WT + (size_t)(rb + n) * K + k0 + 8 * c) = o; }
    LDS_WAIT(); asm volatile("" ::: "memory");
}
__device__ __forceinline__ void ln_regs(f4 (&v)[8], const f4 (&gg)[8], const f4 (&bb)[8], float* dstf, bf16* dstb, float* dst2, int lane) {
    float s = 0.f;
#pragma unroll
    for (int j = 0; j < 8; ++j) s += (v[j].x + v[j].y) + (v[j].z + v[j].w);
    const float mean = wave_sum(s) * (1.f / DM); float s2 = 0.f;
#pragma unroll
    for (int j = 0; j < 8; ++j) { v[j] = v[j] - mean; s2 += (v[j].x * v[j].x + v[j].y * v[j].y) + (v[j].z * v[j].z + v[j].w * v[j].w); }
    const float rstd = __builtin_amdgcn_rsqf(wave_sum(s2) * (1.f / DM) + LN_EPS);
#pragma unroll
    for (int j = 0; j < 8; ++j) { const int c = 4 * (lane + 64 * j); const f4 o = v[j] * rstd * gg[j] + bb[j]; v[j] = o;
        u2 w; w.x = pg8::cvt_pk_bf16(o.x, o.y); w.y = pg8::cvt_pk_bf16(o.z, o.w); *(u2*)(dstb + c) = w; }
    if (dstf) {
#pragma unroll
        for (int j = 0; j < 8; ++j) *(f4*)(dstf + 4 * (lane + 64 * j)) = v[j]; }
    if (dst2) {
#pragma unroll
        for (int j = 0; j < 8; ++j) *(f4*)(dst2 + 4 * (lane + 64 * j)) = v[j]; }
}
__device__ __forceinline__ void phase_prologue(ArgsP a, LAS unsigned char* lds, int lane, int wave, int blk, int G) {
    LAS float* scr = (LAS float*)(lds + wave * 16384);
    const int gw = blk * NWAVES + wave, NGW = G * NWAVES;
    constexpr int I_IN = 32 * (PIN / 32), I_OUT = 32 * (DM / 32), I_G = 32 * (DFF / 32), I_D = (DFF / 64) * (DM / 32), I_PGc = I_OUT, I_PPc = (DPLE / 64) * (DM / 32);
    constexpr int PER_L = I_IN + I_OUT + 2 * I_G + I_D + I_PGc + I_PPc;
    unsigned char* ws = a->ws;
    for (int it = gw; it < DEPTH * PER_L; it += NGW) {
        const int L = it / PER_L; int r = it - L * PER_L;
        if (r < I_IN) { tr_item(a->in[I_WIN] + (size_t)L * DM * PIN, DM, PIN, (bf16*)(ws + wso(WS_WIN) + L * SZ_WIN), 0, scr, r, lane); continue; } r -= I_IN;
        if (r < I_OUT) { tr_item(a->in[I_WOUT] + (size_t)L * DM * DM, DM, DM, (bf16*)(ws + wso(WS_WOUT) + L * SZ_WOUT), 0, scr, r, lane); continue; } r -= I_OUT;
        if (r < I_G) { tr_item(a->in[I_WG] + (size_t)L * DM * DFF, DM, DFF, (bf16*)(ws + wso(WS_WGU) + L * SZ_WGU), 1, scr, r, lane); continue; } r -= I_G;
        if (r < I_G) { tr_item(a->in[I_WU] + (size_t)L * DM * DFF, DM, DFF, (bf16*)(ws + wso(WS_WGU) + L * SZ_WGU), 2, scr, r, lane); continue; } r -= I_G;
        if (r < I_D) { tr_item(a->in[I_WD] + (size_t)L * DFF * DM, DFF, DM, (bf16*)(ws + wso(WS_WD) + L * SZ_WD), 0, scr, r, lane); continue; } r -= I_D;
        if (r < I_PGc) { tr_item(a->in[I_WPG] + (size_t)L * DM * DM, DM, DM, (bf16*)(ws + wso(WS_WPG) + L * SZ_WPG), 0, scr, r, lane); continue; } r -= I_PGc;
        tr_item(a->in[I_WPP] + (size_t)L * DPLE * DM, DPLE, DM, (bf16*)(ws + wso(WS_WPP) + L * SZ_WPP), 0, scr, r, lane);
    }
    for (int it = gw; it < DEPTH * NLORA; it += NGW) { const int L = it / NLORA, n = it - L * NLORA; float v[4];
#pragma unroll
        for (int e = 0; e < 4; ++e) { const int k = 4 * lane + e; float x = 0.f;
            if (n < WB) { if (k < 64) x = a->in[I_BWUP][((size_t)L * 64 + k) * WB + n]; }
            else if (n < 2 * WB) { if (k >= 64 && k < 128) x = a->in[I_BAUP][((size_t)L * 64 + (k - 64)) * WB + (n - WB)]; }
            else { if (k >= 128) x = a->in[I_BGUP][((size_t)L * 128 + (k - 128)) * WB + (n - 2 * WB)]; }
            v[e] = x; }
        u2 w; w.x = pg8::cvt_pk_bf16(v[0], v[1]); w.y = pg8::cvt_pk_bf16(v[2], v[3]); *(u2*)((bf16*)(ws + wso(WS_WL) + L * SZ_WL) + (size_t)n * 256 + 4 * lane) = w; }
    for (int it = gw; it < DEPTH * MV; it += NGW) { const int L = it / MV, m = it - L * MV;
        const float* src = (m < MP) ? a->in[I_PP] + ((size_t)L * MP + m) * DPLE : a->in[I_PS] + ((size_t)L * NS + (m - MP)) * DPLE;
        const f4 v = *(const f4*)(src + 4 * lane); u2 w; w.x = pg8::cvt_pk_bf16(v.x, v.y); w.y = pg8::cvt_pk_bf16(v.z, v.w);
        *(u2*)((bf16*)(ws + wso(WS_PBF) + L * SZ_PBF) + (size_t)m * DPLE + 4 * lane) = w; }
    { f4 gg[8], bb[8];
#pragma unroll
      for (int j = 0; j < 8; ++j) { gg[j] = *(const f4*)(a->in[I_LNING] + 4 * (lane + 64 * j)); bb[j] = *(const f4*)(a->in[I_LNINB] + 4 * (lane + 64 * j)); }
      for (int mb = gw; mb < MV; mb += 2 * NGW) { const bool h1 = mb + NGW < MV; const int m1 = h1 ? mb + NGW : mb;
        const float* s0 = (mb < MP) ? a->in[I_XP] + (size_t)mb * DM : a->in[I_XS] + (size_t)(mb - MP) * DM; const float* s1 = (m1 < MP) ? a->in[I_XP] + (size_t)m1 * DM : a->in[I_XS] + (size_t)(m1 - MP) * DM;
        f4 v0[8], v1[8];
#pragma unroll
        for (int j = 0; j < 8; ++j) { v0[j] = *(const f4*)(s0 + 4 * (lane + 64 * j)); v1[j] = *(const f4*)(s1 + 4 * (lane + 64 * j)); }
        __builtin_amdgcn_sched_barrier(0);
        ln_regs(v0, gg, bb, (mb < MP) ? nullptr : (float*)(ws + wso(WS_H)) + (size_t)mb * DM, (bf16*)(ws + wso(WS_HB)) + (size_t)mb * DM, nullptr, lane);
        if (h1) ln_regs(v1, gg, bb, (m1 < MP) ? nullptr : (float*)(ws + wso(WS_H)) + (size_t)m1 * DM, (bf16*)(ws + wso(WS_HB)) + (size_t)m1 * DM, nullptr, lane); } }
}
__device__ __forceinline__ void phase_ln(ArgsP a, const float* g, const float* b, bool last, int lane, int wave, int blk, int G) {
    const int gw = blk * NWAVES + wave, NGW = G * NWAVES; unsigned char* ws = a->ws;
    f4 gg[8], bb[8];
#pragma unroll
    for (int j = 0; j < 8; ++j) { gg[j] = *(const f4*)(g + 4 * (lane + 64 * j)); bb[j] = *(const f4*)(b + 4 * (lane + 64 * j)); }
    const bf16* Tb = (const bf16*)(ws + wso(WS_T));
    for (int mb = gw; mb < MP; mb += 4 * NGW) {
        u2 raw[4][8];
#pragma unroll
        for (int k = 0; k < 4; ++k) { const int m = mb + k * NGW < MP ? mb + k * NGW : mb;
#pragma unroll
            for (int j = 0; j < 8; ++j) raw[k][j] = *(const u2*)(Tb + (size_t)m * DM + 4 * (lane + 64 * j)); }
        __builtin_amdgcn_sched_barrier(0);
#pragma unroll
        for (int k = 0; k < 4; ++k) { const int m = mb + k * NGW; if (m < MP) { f4 v[8];
#pragma unroll
            for (int j = 0; j < 8; ++j) { const u2 w = raw[k][j]; v[j].x = __builtin_bit_cast(float, w.x << 16); v[j].y = __builtin_bit_cast(float, w.x & 0xffff0000u);
                v[j].z = __builtin_bit_cast(float, w.y << 16); v[j].w = __builtin_bit_cast(float, w.y & 0xffff0000u); }
            ln_regs(v, gg, bb, nullptr, (bf16*)(ws + wso(WS_HB)) + (size_t)m * DM, last ? a->out + O_YP + (size_t)m * DM : nullptr, lane); } }
    }
    for (int m = MP + gw; m < MV; m += NGW) { f4 v[8]; const float* src = (const float*)(ws + wso(WS_T)) + (size_t)m * DM;
#pragma unroll
        for (int j = 0; j < 8; ++j) v[j] = *(const f4*)(src + 4 * (lane + 64 * j));
        ln_regs(v, gg, bb, (float*)(ws + wso(WS_H)) + (size_t)m * DM, (bf16*)(ws + wso(WS_HB)) + (size_t)m * DM, last ? a->out + O_YS + (size_t)(m - MP) * DM : nullptr, lane); }
}


__device__ __forceinline__ void phase_fin(ArgsP a, int L, LAS unsigned char* lds, int lane, int wave, int blk, int G) {
    unsigned char* ws = a->ws; const int gw = blk * NWAVES + wave, NGW = G * NWAVES;
    const float* Z = (const float*)(ws + wso(WS_Z));
    const float* mu = a->in[I_BMU] + L * PBW; const float* w0 = a->in[I_BW0] + L * WB; const float* a0 = a->in[I_BA0] + L * WB;
    const float* k_k = a->in[I_BKK] + L * WB; const float* k_a = a->in[I_BKA] + L * WB; const float* sh0 = a->in[I_SSHIFT] + (size_t)L * NS * PBW;
    const float* w_up = a->in[I_BWUP] + (size_t)L * 64 * WB; const float* a_up = a->in[I_BAUP] + (size_t)L * 64 * WB; const float* g_up = a->in[I_BGUP] + (size_t)L * 128 * WB;
    LAS float* xs = (LAS float*)(lds + wave * 16384);
    if (gw >= NGW / 2) for (int p = gw - NGW / 2; p < NS * 12 + NBAT; p += NGW / 2) {
        if (p >= NS * 12) { const int b = p - NS * 12; const bf16* zr = (const bf16*)(ws + wso(WS_Z)) + (size_t)(b * SEQ + SEQ - 1) * PIN + OFF_B; float* dst = a->out + O_SP + ((size_t)L * NBAT + b) * PBW;
#pragma unroll
            for (int j = 0; j < PBW / 256; ++j) *(f4*)(dst + 256 * j + 4 * lane) = bf4(*(const u2*)(zr + 256 * j + 4 * lane));
            continue; }
        const int i = p / 12, j = p - 12 * i, m = MP + i, c = 64 * j + lane;
        const float* zr = Z + (size_t)m * PIN + OFF_B; const float* pz = sh0 + (size_t)i * PBW;
        { const f4 cur = *(const f4*)(zr + 2304 + 4 * lane), prev = *(const f4*)(pz + 2304 + 4 * lane), mu4 = *(const f4*)(mu + 2304 + 4 * lane); f4 x = cur + mu4 * (prev - cur);
          { const float sc = lane < 16 ? 2.0f : 1.0f, of = lane < 16 ? -1.0f : 0.0f; const bool idn = lane >= 16 && lane < 32;
#pragma unroll
            for (int e = 0; e < 4; ++e) { const float sg = sc * __builtin_amdgcn_rcpf(1.0f + __expf(-sc * x[e])) + of; x[e] = idn ? x[e] : sg; } }
          *(LAS f4*)(xs + 4 * lane) = x; }
        LDS_WAIT(); asm volatile("" ::: "memory");
        float lw = 0.f, la = 0.f, lg = 0.f;
#pragma unroll 1
        for (int k0 = 0; k0 < 64; k0 += 32) { float wv[32], av[32];
#pragma unroll
            for (int u = 0; u < 32; ++u) { wv[u] = w_up[(size_t)(k0 + u) * WB + c]; av[u] = a_up[(size_t)(k0 + u) * WB + c]; }
            __builtin_amdgcn_sched_barrier(0);
#pragma unroll
            for (int u = 0; u < 32; ++u) { lw += xs[k0 + u] * wv[u]; la += xs[64 + k0 + u] * av[u]; }
            __builtin_amdgcn_sched_barrier(0); }
#pragma unroll 1
        for (int k0 = 0; k0 < 128; k0 += 64) { float gv[64];
#pragma unroll
            for (int u = 0; u < 64; ++u) gv[u] = g_up[(size_t)(k0 + u) * WB + c];
            __builtin_amdgcn_sched_barrier(0);
#pragma unroll
            for (int u = 0; u < 64; ++u) lg += xs[128 + k0 + u] * gv[u];
            __builtin_amdgcn_sched_barrier(0); }
        ((float*)(ws + wso(WS_LORA)))[(size_t)m * NLORA + 2 * WB + c] = lg;
        const float cr = zr[c], ck = zr[WB + c], cv = zr[2 * WB + c], pr = pz[c], pk = pz[WB + c], pv = pz[2 * WB + c];
        const float r = cr + mu[c] * (pr - cr), k = ck + mu[WB + c] * (pk - ck), v = cv + mu[2 * WB + c] * (pv - cv);
        const float dec = __expf(-0.6065306597126334f * __builtin_amdgcn_rcpf(1.0f + __expf(-(w0[c] + lw))));
        const float av = __builtin_amdgcn_rcpf(1.0f + __expf(-(a0[c] + la)));
        const float kkr = k * k_k[c]; const float ss = wave_sum(kkr * kkr); const float kk = kkr * __builtin_amdgcn_rsqf(fmaxf(ss, 1e-24f));
        const float kp = k * (1.0f + (av - 1.0f) * k_a[c]);
        float* rec = (float*)(ws + wso(WS_RPS)) + ((size_t)i * 12 + j) * 384;
        rec[lane] = r; rec[64 + lane] = dec; rec[128 + lane] = kp; rec[192 + lane] = v; rec[256 + lane] = kk; rec[320 + lane] = kk * av;
        LDS_WAIT(); asm volatile("" ::: "memory");
    }
    for (int i = gw - (NGW - NS); i >= 0 && i < NS; i += NGW) { const int m = MP + i; const float* zr = Z + (size_t)m * PIN + OFF_B;
            float* dst = a->out + O_SS + ((size_t)L * NS + i) * PBW;
#pragma unroll
            for (int q = 0; q < PBW / 256; ++q) *(f4*)(dst + 256 * q + 4 * lane) = *(const f4*)(zr + 256 * q + 4 * lane);
            const float* z0 = Z + (size_t)m * PIN; const float* lng = a->in[I_ALNG] + L * WA; const float* lnb = a->in[I_ALNB] + L * WA;
            for (int g = 0; g < 4; ++g) {
                const float u0 = gelu_erf(z0[g * 128 + lane]), u1 = gelu_erf(z0[g * 128 + 64 + lane]);
                const float v0 = gelu_erf(z0[WA + g * 128 + lane]), v1 = gelu_erf(z0[WA + g * 128 + 64 + lane]);
                const float mean = wave_sum(v0 + v1) * (1.f / 128.f); const float d0 = v0 - mean, d1 = v1 - mean;
                const float rstd = 1.0f / sqrtf(wave_sum(d0 * d0 + d1 * d1) * (1.f / 128.f) + LN_EPS);
                const float n0 = d0 * rstd * lng[g * 128 + lane] + lnb[g * 128 + lane], n1 = d1 * rstd * lng[g * 128 + 64 + lane] + lnb[g * 128 + 64 + lane];
                float* ov = a->out + O_VS + ((size_t)L * NS + i) * WA + g * 128; ov[lane] = n0; ov[64 + lane] = n1;
                const float w00 = a->in[I_AWS][(size_t)(L * 4 + g) * 16384], b0 = a->in[I_ABS][(L * 4 + g) * 128];
                bf16* yo = (bf16*)(ws + wso(WS_YMIX)) + (size_t)m * DM + g * 128; yo[lane] = bf1(u0 * (w00 * n0 + b0)); yo[64 + lane] = bf1(u1 * (w00 * n1 + b0)); }
    }
}

__device__ __forceinline__ void rwkv_sample_item(ArgsP a, int L, int item, LAS unsigned char* lds, int lane, int wave) {
    unsigned char* ws = a->ws;
    const int ih = item * 8 + wave, i = ih / 12, h = ih - i * 12;
    const float* rec = (const float*)(ws + wso(WS_RPS)) + (size_t)ih * 384;
    LAS float* sc = (LAS float*)(lds + wave * 2048);
    const float r = rec[lane], w = rec[64 + lane], k = rec[128 + lane], v = rec[192 + lane], kk = rec[256 + lane], ka = rec[320 + lane];
    sc[lane] = r; sc[64 + lane] = w; sc[128 + lane] = k; sc[192 + lane] = kk; sc[256 + lane] = ka;
    LDS_WAIT(); asm volatile("" ::: "memory");
    const f4* S0p = (const f4*)(a->in[I_SRWKV] + (((size_t)L * NS + i) * 12 + h) * 4096 + lane * 64);
    f4 S[16];
#pragma unroll
    for (int j = 0; j < 16; ++j) S[j] = S0p[j];
    float sa = 0.f;
#pragma unroll
    for (int j = 0; j < 16; ++j) { const f4 q = *(const LAS f4*)(sc + 192 + 4 * j); sa += (S[j].x * q.x + S[j].y * q.y) + (S[j].z * q.z + S[j].w * q.w); }
    float y = 0.f;
    f4* So = (f4*)(a->out + O_RS + (((size_t)L * NS + i) * 12 + h) * 4096 + lane * 64);
#pragma unroll
    for (int j = 0; j < 16; ++j) { const f4 w4 = *(const LAS f4*)(sc + 64 + 4 * j), k4 = *(const LAS f4*)(sc + 128 + 4 * j), a4 = *(const LAS f4*)(sc + 256 + 4 * j), r4 = *(const LAS f4*)(sc + 4 * j);
        f4 n = S[j] * w4 + (k4 * v - a4 * sa); So[j] = n; y += (n.x * r4.x + n.y * r4.y) + (n.z * r4.z + n.w * r4.w); }
    ((float*)(ws + wso(WS_Y)))[(size_t)(MP + i) * WB + h * 64 + lane] = y;
    LDS_WAIT(); asm volatile("" ::: "memory");
}

__device__ __forceinline__ void phase_post(ArgsP a, int L, int lane, int wave, int blk, int G) {
    unsigned char* ws = a->ws; const int gw = blk * NWAVES + wave, NGW = G * NWAVES;
    const float* Y = (const float*)(ws + wso(WS_Y)); const float* O = (const float*)(ws + wso(WS_O)); const float* Gt = (const float*)(ws + wso(WS_LORA)) + 2 * WB; const float* Z = (const float*)(ws + wso(WS_Z));
    const float* gng = a->in[I_BGNG] + L * WB; const float* gnb = a->in[I_BGNB] + L * WB; const float* rk = a->in[I_BRK] + L * WB; const float* cng = a->in[I_CNG] + L * WC;
    { f2 cg[6];
#pragma unroll
      for (int j = 0; j < 6; ++j) cg[j] = *(const f2*)(cng + 128 * j + 2 * lane);
      for (int mb = gw; mb < MP; mb += 4 * NGW) {
        f2 ov[4][6]; unsigned gz[4][6];
#pragma unroll
        for (int k = 0; k < 4; ++k) { const int m = mb + k * NGW < MP ? mb + k * NGW : mb;
#pragma unroll
            for (int j = 0; j < 6; ++j) { ov[k][j] = *(const f2*)(O + (size_t)m * WC + 128 * j + 2 * lane); gz[k][j] = *(const unsigned*)((const bf16*)Z + (size_t)m * PIN + OFF_C + 3 * WC + 128 * j + 2 * lane); } }
        __builtin_amdgcn_sched_barrier(0);
#pragma unroll
        for (int k = 0; k < 4; ++k) { const int m = mb + k * NGW; if (m < MP) {
            float ss = 0.f;
#pragma unroll
            for (int j = 0; j < 6; ++j) ss += ov[k][j].x * ov[k][j].x + ov[k][j].y * ov[k][j].y;
            const float rms = __builtin_amdgcn_rsqf(wave_sum(ss) * (1.f / WC) + RMS_EPS);
            unsigned* yo = (unsigned*)((bf16*)(ws + wso(WS_YMIX)) + (size_t)m * DM + WA + WB) + lane;
#pragma unroll
            for (int j = 0; j < 6; ++j) { f2 g2; g2.x = __builtin_bit_cast(float, gz[k][j] << 16); g2.y = __builtin_bit_cast(float, gz[k][j] & 0xffff0000u); const float y0 = ov[k][j].x * rms * cg[j].x * (g2.x * __builtin_amdgcn_rcpf(1.0f + __expf(-g2.x))), y1 = ov[k][j].y * rms * cg[j].y * (g2.y * __builtin_amdgcn_rcpf(1.0f + __expf(-g2.y)));
                yo[64 * j] = pg8::cvt_pk_bf16(y0, y1); } } }
      } }
    for (int p = gw; p < NS * 12; p += NGW) { const int i = p / 12, j = p - 12 * i, m = MP + i, c = 64 * j + lane;
        const float* rec = (const float*)(ws + wso(WS_RPS)) + (size_t)p * 384;
        const float y = Y[(size_t)m * WB + c], rr = rec[lane], kp = rec[128 + lane], vv = rec[192 + lane], gg = Gt[(size_t)m * NLORA + c], g1 = gng[c], b1 = gnb[c], rk1 = rk[c];
        const float mean = wave_sum(y) * (1.f / 64.f); const float d = y - mean; const float rstd = 1.0f / sqrtf(wave_sum(d * d) * (1.f / 64.f) + GN_EPS);
        const float bonus = wave_sum(rr * kp * rk1);
        ((bf16*)(ws + wso(WS_YMIX)) + (size_t)m * DM)[WA + c] = bf1((d * rstd * g1 + b1 + bonus * vv) * gg); }
    for (int r = NGW - 1 - gw; r < NS; r += NGW) { const int m = MP + r;
        bf16* yo = (bf16*)(ws + wso(WS_YMIX)) + (size_t)m * DM;
        float ov[12], gz[12], cg[12]; float ss = 0.f;
#pragma unroll
        for (int j = 0; j < 12; ++j) { const int c = 64 * j + lane; ov[j] = O[(size_t)m * WC + c]; gz[j] = Z[(size_t)m * PIN + OFF_C + 3 * WC + c]; cg[j] = cng[c]; }
        const float* hr = (const float*)(ws + wso(WS_H)) + (size_t)m * DM; float* tr = (float*)(ws + wso(WS_T)) + (size_t)m * DM;
        f4 hv[8];
#pragma unroll
        for (int j = 0; j < 8; ++j) hv[j] = *(const f4*)(hr + 4 * (lane + 64 * j));
        __builtin_amdgcn_sched_barrier(0);
#pragma unroll
        for (int j = 0; j < 8; ++j) *(f4*)(tr + 4 * (lane + 64 * j)) = hv[j] * DN_ALPHA;
#pragma unroll
        for (int j = 0; j < 12; ++j) ss += ov[j] * ov[j];
        const float rms = 1.0f / sqrtf(wave_sum(ss) * (1.f / WC) + RMS_EPS);
#pragma unroll
        for (int j = 0; j < 12; ++j) { const int c = 64 * j + lane; yo[WA + WB + c] = bf1(ov[j] * rms * cg[j] * (gz[j] * sigmoidf_(gz[j]))); }
    }
}

constexpr int REC_BYTES = 16384, RC_GT = 12288, RC_WT = 0, RC_RT = 2048, RC_AHT = 4096, RC_KHT = 6144, RC_VT = 8192, RC_BRA = 10240, RC_BRK = 10752, RC_M2 = 11264, RC_G15 = 11776, RC_BC = 12032;
constexpr int NCHUNK = NBAT * 12 * (SEQ / 16);
static_assert(WS_RPB + (size_t)NCHUNK * REC_BYTES == WS_RPS, "chunk record region");
__device__ __forceinline__ int perm_ch(int ch) { return (ch & ~31) | (((ch >> 2) & 3) << 3) | (((ch >> 4) & 1) << 2) | (ch & 3); }

__device__ __forceinline__ void pre_chunk(ArgsP a, int L, int q, LAS unsigned char* wl, int lane, bool first, bf16x8 (&xf)[8]) {
    asm volatile("" : "+v"(lane));
    unsigned char* ws = a->ws;
    const int bh = q >> 7, c = q & 127, b = bh / 12, h = bh - 12 * b, m0 = b * SEQ + c * 16, col = h * 64 + lane;
    const bf16* Z = (const bf16*)(ws + wso(WS_Z)) + (size_t)m0 * PIN + OFF_B + col;
    unsigned char* rec = ws + wso(WS_RPB) + (size_t)q * REC_BYTES;
    LAS float* X0 = (LAS float*)wl;
    LAS float* X1 = (LAS float*)(wl + 4352);
    LAS float* Maa = (LAS float*)(wl + 8704);
    LAS float* Mak = (LAS float*)(wl + 9728);
    LAS bf16* Sm = (LAS bf16*)(wl + 10752);
    LAS bf16* Wim = (LAS bf16*)(wl + 12288);
    const float mur = a->in[I_BMU][L * PBW + col], muk = a->in[I_BMU][L * PBW + WB + col], muv = a->in[I_BMU][L * PBW + 2 * WB + col];
    const float w0c = a->in[I_BW0][L * WB + col], a0c = a->in[I_BA0][L * WB + col], kkc = a->in[I_BKK][L * WB + col], kac = a->in[I_BKA][L * WB + col], rkc = a->in[I_BRK][L * WB + col];
    float cr[16], ck[16], cv[16], lw[16], la[16]; unsigned short zr_[16], zk_[16], zv_[16];
#pragma unroll
    for (int t = 0; t < 16; ++t) { zr_[t] = Z[(size_t)t * PIN]; zk_[t] = Z[(size_t)t * PIN + WB]; zv_[t] = Z[(size_t)t * PIN + 2 * WB]; }
    const ptrdiff_t pvo = c ? -(ptrdiff_t)PIN : 0;
    const unsigned short zpr = Z[pvo], zpk = Z[pvo + WB], zpv = Z[pvo + 2 * WB];
    const int lx = lane & 15, lq = lane >> 4;
    const bf16* bw0 = (const bf16*)(ws + wso(WS_WL) + L * SZ_WL) + (size_t)(h * 64 + lx) * 256 + 8 * lq;
    bf16x8 wb[2][8];
#define PRE_LDW(nt_, bf_) { const bf16* bw = bw0 + (size_t)(16 * (nt_)) * 256; wb[bf_][0] = *(const bf16x8*)(bw); wb[bf_][1] = *(const bf16x8*)(bw + 32); \
        wb[bf_][2] = *(const bf16x8*)(bw + (size_t)WB * 256 + 64); wb[bf_][3] = *(const bf16x8*)(bw + (size_t)WB * 256 + 96); \
        wb[bf_][4] = *(const bf16x8*)(bw + (size_t)2 * WB * 256 + 128); wb[bf_][5] = *(const bf16x8*)(bw + (size_t)2 * WB * 256 + 160); \
        wb[bf_][6] = *(const bf16x8*)(bw + (size_t)2 * WB * 256 + 192); wb[bf_][7] = *(const bf16x8*)(bw + (size_t)2 * WB * 256 + 224); }
    PRE_LDW(0, 0)
    if (first) {
        const bf16* zx = (const bf16*)(ws + wso(WS_Z)) + (size_t)m0 * PIN + OFF_B + 2304 + 4 * lane; const f4 mu4 = *(const f4*)(a->in[I_BMU] + L * PBW + 2304 + 4 * lane);
        u2 cur[16];
#pragma unroll
        for (int t = 0; t < 16; ++t) cur[t] = *(const u2*)(zx + (size_t)t * PIN);
        const u2 pvr = *(const u2*)(zx + pvo);
        __builtin_amdgcn_sched_barrier(0);
        f4 cu[16];
#pragma unroll
        for (int t = 0; t < 16; ++t) cu[t] = bf4(cur[t]);
        f4 pv4 = bf4(pvr);
        if (!c) pv4 = (f4){0.f, 0.f, 0.f, 0.f};
        LAS bf16* xa = (LAS bf16*)(wl + 4352);
        const float sc = lane < 16 ? 2.0f : 1.0f, of = lane < 16 ? -1.0f : 0.0f; const bool idn = lane >= 16 && lane < 32;
#pragma unroll
        for (int t = 0; t < 16; ++t) { f4 xv = cu[t] + mu4 * (pv4 - cu[t]); pv4 = cu[t];
#pragma unroll
            for (int e = 0; e < 4; ++e) { const float sg = sc * __builtin_amdgcn_rcpf(1.0f + __expf(-sc * xv[e])) + of; xv[e] = idn ? xv[e] : sg; }
            u2 w; w.x = cvt_pk_bf16_c(xv.x, xv.y); w.y = cvt_pk_bf16_c(xv.z, xv.w); *(LAS u2*)(xa + t * 264 + 4 * lane) = w; }
        LDS_WAIT(); asm volatile("" ::: "memory");
#pragma unroll
        for (int ks = 0; ks < 8; ++ks) xf[ks] = *(const LAS bf16x8*)(xa + lx * 264 + 32 * ks + 8 * lq);
        LDS_WAIT(); asm volatile("" ::: "memory");
    }
    __builtin_amdgcn_sched_barrier(0);
#pragma unroll
    for (int t = 0; t < 16; ++t) { cr[t] = bfl(zr_[t]); ck[t] = bfl(zk_[t]); cv[t] = bfl(zv_[t]); }
    float pr = bfl(zpr), pk = bfl(zpk), pv = bfl(zpv);
    if (!c) { pr = 0.f; pk = 0.f; pv = 0.f; }
    {
        const int x = lane & 15, quad = lane >> 4;
        pg8::f32x4 aw[4], aa[4], ag[4];
#pragma unroll
        for (int nt = 0; nt < 4; ++nt) { aw[nt] = (pg8::f32x4){0.f, 0.f, 0.f, 0.f}; aa[nt] = aw[nt]; ag[nt] = aw[nt];
            if (nt < 3) PRE_LDW(nt + 1, (nt + 1) & 1)
            __builtin_amdgcn_sched_barrier(0);
#pragma unroll
            for (int ks = 0; ks < 2; ++ks) { aw[nt] = __builtin_amdgcn_mfma_f32_16x16x32_bf16(xf[ks], wb[nt & 1][ks], aw[nt], 0, 0, 0);
                aa[nt] = __builtin_amdgcn_mfma_f32_16x16x32_bf16(xf[2 + ks], wb[nt & 1][2 + ks], aa[nt], 0, 0, 0); }
#pragma unroll
            for (int ks = 0; ks < 4; ++ks) ag[nt] = __builtin_amdgcn_mfma_f32_16x16x32_bf16(xf[4 + ks], wb[nt & 1][4 + ks], ag[nt], 0, 0, 0);
            __builtin_amdgcn_sched_barrier(0); }
#undef PRE_LDW
#pragma unroll
        for (int nt = 0; nt < 4; ++nt)
#pragma unroll
            for (int i = 0; i < 4; ++i) { const int t = 4 * quad + i, cc = 16 * nt + x; X0[t * 68 + cc] = aw[nt][i]; X1[t * 68 + cc] = aa[nt][i]; ((bf16*)(rec + RC_GT))[t * 64 + cc] = bf1(ag[nt][i]); }
        LDS_WAIT(); asm volatile("" ::: "memory");
#pragma unroll
        for (int t = 0; t < 16; ++t) { lw[t] = X0[t * 68 + lane]; la[t] = X1[t * 68 + lane]; }
        LDS_WAIT(); asm volatile("" ::: "memory");
    }
    float r_[16], k_[16], v_[16], kp_[16], al_[16], g_[16]; float run = 0.f, bcv = 0.f;
#pragma unroll
    for (int t = 0; t < 16; ++t) {
        const float r = cr[t] + mur * (pr - cr[t]), k = ck[t] + muk * (pk - ck[t]), v = cv[t] + muv * (pv - cv[t]); pr = cr[t]; pk = ck[t]; pv = cv[t];
        run += -0.6065306597126334f * __builtin_amdgcn_rcpf(1.0f + __expf(-(w0c + lw[t]))); g_[t] = run;
        const float av = __builtin_amdgcn_rcpf(1.0f + __expf(-(a0c + la[t])));
        const float kkr = k * kkc; const float ss = wave_sum_fast(kkr * kkr); const float kap = kkr * __builtin_amdgcn_rsqf(fmaxf(ss, 1e-24f));
        const float kpr = k * (1.0f + (av - 1.0f) * kac);
        const float bc = wave_sum_fast(r * kpr * rkc); if (lane == t) bcv = bc;
        r_[t] = r; k_[t] = kpr; v_[t] = v; kp_[t] = kap; al_[t] = kap * av; }
    float E_[16];
#pragma unroll
    for (int t = 0; t < 16; ++t) E_[t] = __expf(g_[t]);
    const float E15 = E_[15];
    { float ah[16], kh[16];
#pragma unroll
      for (int t = 0; t < 16; ++t) { const float ig = __builtin_amdgcn_rcpf(E_[t]), eg = E15 * ig; X0[t * 68 + lane] = al_[t] * ig; X1[t * 68 + lane] = k_[t] * ig; ah[t] = al_[t] * eg; kh[t] = k_[t] * eg; }
      v4u o0, o1;
      o0.x = cvt_pk_bf16_c(ah[0], ah[1]); o0.y = cvt_pk_bf16_c(ah[2], ah[3]); o0.z = cvt_pk_bf16_c(ah[4], ah[5]); o0.w = cvt_pk_bf16_c(ah[6], ah[7]);
      o1.x = cvt_pk_bf16_c(ah[8], ah[9]); o1.y = cvt_pk_bf16_c(ah[10], ah[11]); o1.z = cvt_pk_bf16_c(ah[12], ah[13]); o1.w = cvt_pk_bf16_c(ah[14], ah[15]);
      *(v4u*)(rec + RC_AHT + lane * 32) = o0; *(v4u*)(rec + RC_AHT + lane * 32 + 16) = o1;
      o0.x = cvt_pk_bf16_c(kh[0], kh[1]); o0.y = cvt_pk_bf16_c(kh[2], kh[3]); o0.z = cvt_pk_bf16_c(kh[4], kh[5]); o0.w = cvt_pk_bf16_c(kh[6], kh[7]);
      o1.x = cvt_pk_bf16_c(kh[8], kh[9]); o1.y = cvt_pk_bf16_c(kh[10], kh[11]); o1.z = cvt_pk_bf16_c(kh[12], kh[13]); o1.w = cvt_pk_bf16_c(kh[14], kh[15]);
      *(v4u*)(rec + RC_KHT + lane * 32) = o0; *(v4u*)(rec + RC_KHT + lane * 32 + 16) = o1;
      o0.x = cvt_pk_bf16_c(v_[0], v_[1]); o0.y = cvt_pk_bf16_c(v_[2], v_[3]); o0.z = cvt_pk_bf16_c(v_[4], v_[5]); o0.w = cvt_pk_bf16_c(v_[6], v_[7]);
      o1.x = cvt_pk_bf16_c(v_[8], v_[9]); o1.y = cvt_pk_bf16_c(v_[10], v_[11]); o1.z = cvt_pk_bf16_c(v_[12], v_[13]); o1.w = cvt_pk_bf16_c(v_[14], v_[15]);
      { const int vr = (lane >> 2) & 3; unsigned char* vrow = rec + RC_VT + lane * 32; u2 g2;
        g2.x = o0.x; g2.y = o0.y; *(u2*)(vrow + ((0 + vr) & 3) * 8) = g2; g2.x = o0.z; g2.y = o0.w; *(u2*)(vrow + ((1 + vr) & 3) * 8) = g2;
        g2.x = o1.x; g2.y = o1.y; *(u2*)(vrow + ((2 + vr) & 3) * 8) = g2; g2.x = o1.z; g2.y = o1.w; *(u2*)(vrow + ((3 + vr) & 3) * 8) = g2; } }
    LDS_WAIT(); asm volatile("" ::: "memory");
    const int x = lane & 15, kq = lane >> 4;
    f4 ba[4], bk[4];
#pragma unroll
    for (int j = 0; j < 4; ++j) { ba[j] = *(const LAS f4*)(X0 + x * 68 + 16 * kq + 4 * j); bk[j] = *(const LAS f4*)(X1 + x * 68 + 16 * kq + 4 * j); }
    LDS_WAIT(); asm volatile("" ::: "memory");
    float kt[16];
#pragma unroll
    for (int t = 0; t < 16; ++t) { kt[t] = kp_[t] * (t ? E_[t - 1] : 1.0f); X0[t * 68 + lane] = kt[t]; r_[t] *= E_[t]; X1[t * 68 + lane] = r_[t]; }
    LDS_WAIT(); asm volatile("" ::: "memory");
    f4 ak[4], ar[4];
#pragma unroll
    for (int j = 0; j < 4; ++j) { ak[j] = *(const LAS f4*)(X0 + x * 68 + 16 * kq + 4 * j); ar[j] = *(const LAS f4*)(X1 + x * 68 + 16 * kq + 4 * j); }
    pg8::f32x4 Gaa = (pg8::f32x4){0.f, 0.f, 0.f, 0.f}, Gak = Gaa, Gra = Gaa, Grk = Gaa;
#pragma unroll
    for (int j = 0; j < 4; ++j)
#pragma unroll
        for (int e = 0; e < 4; ++e) { Gaa = __builtin_amdgcn_mfma_f32_16x16x4f32(ak[j][e], ba[j][e], Gaa, 0, 0, 0); Gak = __builtin_amdgcn_mfma_f32_16x16x4f32(ak[j][e], bk[j][e], Gak, 0, 0, 0);
            Gra = __builtin_amdgcn_mfma_f32_16x16x4f32(ar[j][e], ba[j][e], Gra, 0, 0, 0); Grk = __builtin_amdgcn_mfma_f32_16x16x4f32(ar[j][e], bk[j][e], Grk, 0, 0, 0); }
#pragma unroll
    for (int i = 0; i < 4; ++i) { const int t = 4 * kq + i; const bool sl = x < t, le = x <= t;
        Maa[t * 16 + x] = sl ? Gaa[i] : 0.f; Mak[t * 16 + x] = sl ? Gak[i] : 0.f;
        Sm[t * 16 + x] = bf1(le ? Gra[i] : 0.f); Sm[256 + t * 16 + x] = bf1(le ? Grk[i] : 0.f); }
    LDS_WAIT(); asm volatile("" ::: "memory");
    float xm[16];
#pragma unroll
    for (int t = 0; t < 16; ++t) xm[t] = Mak[t * 16 + x];
#pragma unroll
    for (int t = 1; t < 16; ++t) {
#pragma unroll
        for (int s4 = 0; s4 < (t + 3) / 4; ++s4) { const f4 ar4 = *(const LAS f4*)(Maa + t * 16 + 4 * s4);
#pragma unroll
            for (int e = 0; e < 4; ++e) if (4 * s4 + e < t) { kt[t] -= ar4[e] * kt[4 * s4 + e]; xm[t] -= ar4[e] * xm[4 * s4 + e]; } } }
    const int wpc = perm_ch(lane);
#pragma unroll
    for (int t = 0; t < 16; ++t) { Wim[t * 64 + ((((wpc >> 3) ^ ((t >> 1) & 7)) << 3) | (wpc & 7))] = bf1(-kt[t]); if (lane < 16) Sm[512 + t * 16 + lane] = bf1(-xm[t]); }
    LDS_WAIT(); asm volatile("" ::: "memory");
    *(v4u*)(rec + RC_WT + lane * 16) = *(const LAS v4u*)((LAS unsigned char*)Wim + lane * 16); *(v4u*)(rec + RC_WT + 1024 + lane * 16) = *(const LAS v4u*)((LAS unsigned char*)Wim + 1024 + lane * 16);
    *(v4u*)(rec + RC_BRA + lane * 16) = *(const LAS v4u*)((LAS unsigned char*)Sm + lane * 16); if (lane < 32) *(v4u*)(rec + RC_BRA + 1024 + lane * 16) = *(const LAS v4u*)((LAS unsigned char*)Sm + 1024 + lane * 16);
    LDS_WAIT(); asm volatile("" ::: "memory");
#pragma unroll
    for (int t = 0; t < 16; ++t) Wim[t * 64 + ((((wpc >> 3) ^ ((t >> 1) & 7)) << 3) | (wpc & 7))] = bf1(r_[t]);
    LDS_WAIT(); asm volatile("" ::: "memory");
    *(v4u*)(rec + RC_RT + lane * 16) = *(const LAS v4u*)((LAS unsigned char*)Wim + lane * 16); *(v4u*)(rec + RC_RT + 1024 + lane * 16) = *(const LAS v4u*)((LAS unsigned char*)Wim + 1024 + lane * 16);
    *(float*)(rec + RC_G15 + lane * 4) = E15; if (lane < 16) *(float*)(rec + RC_BC + lane * 4) = bcv;
    LDS_WAIT(); asm volatile("" ::: "memory");
}

constexpr int HREC_BYTES = 17408, HR_QS = 0, HR_KS = 4352, HR_VT = 8704, HR_KHT = 12800, HR_EV = 16896, NHCHUNK = NBAT * 6 * (SEQ / 16);
__device__ __forceinline__ void hpre_chunk(ArgsP a, int L, int q2, LAS unsigned char* wl, int lane) {
    asm volatile("" : "+v"(lane));
    unsigned char* ws = a->ws;
    const int bh = q2 >> 7, c = q2 & 127, b = bh / 6, h = bh - 6 * b;
    const bf16* Z = (const bf16*)(ws + wso(WS_Z)) + (size_t)(b * SEQ + c * 16) * PIN + OFF_C + h * 128 + lane;
    unsigned char* rec = ws + wso(WS_HREC) + (size_t)q2 * HREC_BYTES;
    LAS bf16* qim = (LAS bf16*)wl; LAS bf16* kim = (LAS bf16*)(wl + 4352);
    float qq[2][16], fzz[2][16], ivv[2][16], lx[2][4]; unsigned short qr_[2][16], fr_[2][16], ir_[2][16];
#pragma unroll
    for (int hh = 0; hh < 2; ++hh) { const float* clb = a->in[I_CLB] + h * 128 + lane + 64 * hh; lx[hh][0] = clb[0]; lx[hh][1] = clb[WC]; lx[hh][2] = clb[2 * WC]; lx[hh][3] = clb[3 * WC];
#pragma unroll
        for (int t = 0; t < 16; ++t) { const bf16* p = Z + (size_t)t * PIN + 64 * hh; qr_[hh][t] = p[0]; fr_[hh][t] = p[WC]; ir_[hh][t] = p[2 * WC]; } }
    __builtin_amdgcn_sched_barrier(0);
#pragma unroll
    for (int hh = 0; hh < 2; ++hh)
#pragma unroll
        for (int t = 0; t < 16; ++t) { qq[hh][t] = bfl(qr_[hh][t]); fzz[hh][t] = bfl(fr_[hh][t]); ivv[hh][t] = bfl(ir_[hh][t]); }
#pragma unroll
    for (int hh = 0; hh < 2; ++hh) { const int ch = lane + 64 * hh; const int pc = perm_ch(ch);
        const float lb = lbound_v(lx[hh][0], lx[hh][1], lx[hh][2], lx[hh][3], L), oml = 1.0f - lb;
        const float (&q)[16] = qq[hh]; const float (&fz)[16] = fzz[hh]; const float (&iv)[16] = ivv[hh];
        float bl[16], kv[16]; float run = 0.f;
#pragma unroll
        for (int t = 0; t < 16; ++t) { const float e = __expf(-fmaxf(fz[t], -80.f)), sg = __builtin_amdgcn_rcpf(1.0f + e); run += __logf(lb + oml * sg); bl[t] = run; kv[t] = oml * e * sg; }
        float kh[16];
#pragma unroll
        for (int t = 0; t < 16; ++t) { qim[t * 136 + pc] = bf1(q[t] * __expf(bl[t])); kim[t * 136 + pc] = bf1(kv[t] * __expf(fminf(-bl[t], 60.f))); kh[t] = kv[t] * __expf(run - bl[t]); }
        v4u o0, o1;
        o0.x = cvt_pk_bf16_c(kh[0], kh[1]); o0.y = cvt_pk_bf16_c(kh[2], kh[3]); o0.z = cvt_pk_bf16_c(kh[4], kh[5]); o0.w = cvt_pk_bf16_c(kh[6], kh[7]);
        o1.x = cvt_pk_bf16_c(kh[8], kh[9]); o1.y = cvt_pk_bf16_c(kh[10], kh[11]); o1.z = cvt_pk_bf16_c(kh[12], kh[13]); o1.w = cvt_pk_bf16_c(kh[14], kh[15]);
        *(v4u*)(rec + HR_KHT + ch * 32) = o0; *(v4u*)(rec + HR_KHT + ch * 32 + 16) = o1;
        o0.x = cvt_pk_bf16_c(iv[0], iv[1]); o0.y = cvt_pk_bf16_c(iv[2], iv[3]); o0.z = cvt_pk_bf16_c(iv[4], iv[5]); o0.w = cvt_pk_bf16_c(iv[6], iv[7]);
        o1.x = cvt_pk_bf16_c(iv[8], iv[9]); o1.y = cvt_pk_bf16_c(iv[10], iv[11]); o1.z = cvt_pk_bf16_c(iv[12], iv[13]); o1.w = cvt_pk_bf16_c(iv[14], iv[15]);
        *(v4u*)(rec + HR_VT + ch * 32) = o0; *(v4u*)(rec + HR_VT + ch * 32 + 16) = o1;
        *(float*)(rec + HR_EV + ch * 4) = __expf(run); }
    LDS_WAIT(); asm volatile("" ::: "memory");
#pragma unroll
    for (int j = 0; j < 9; ++j) { const int o = (j * 64 + lane) * 16; if (o < 8704) *(v4u*)(rec + o) = *(const LAS v4u*)(wl + o); }
    LDS_WAIT(); asm volatile("" ::: "memory");
}
__device__ __forceinline__ void hgrn_stream_unit(ArgsP a, int L, int unit, LAS unsigned char* lds, int lane, int wave) {
    unsigned char* ws = a->ws;
    const int bh = unit >> 1, half = unit & 1, b = bh / 6, h = bh - b * 6;
    const unsigned char* recs = ws + wso(WS_HREC) + (size_t)bh * 128 * HREC_BYTES;
    const int x = lane & 15, quad = lane >> 4, vbase = 64 * half + 16 * (wave & 3);
    constexpr int AHEAD = 4, NCH = SEQ / 16;
#define HG_DMA(cc) do { const unsigned char* g_ = recs + (size_t)(cc) * HREC_BYTES + wave * 1024 + lane * 16; LAS unsigned char* l_ = lds + ((cc) % 6) * HREC_BYTES + wave * 1024; \
        __builtin_amdgcn_global_load_lds((const unsigned*)(g_), (LAS unsigned*)(l_), 16, 0, 0); __builtin_amdgcn_global_load_lds((const unsigned*)(g_ + 8192), (LAS unsigned*)(l_ + 8192), 16, 0, 0); \
        if (wave == 0) __builtin_amdgcn_global_load_lds((const unsigned*)(g_ + 16384), (LAS unsigned*)(l_ + 16384), 16, 0, 0); } while (0)
#define HG_WAIT(st_) do { if (wave >= 4) asm volatile("s_waitcnt vmcnt(6)" ::: "memory"); \
        else if ((st_) >= 3) { if (wave == 0) asm volatile("s_waitcnt vmcnt(13)" ::: "memory"); else asm volatile("s_waitcnt vmcnt(10)" ::: "memory"); }     \
        else { if (wave == 0) asm volatile("s_waitcnt vmcnt(10)" ::: "memory"); else asm volatile("s_waitcnt vmcnt(7)" ::: "memory"); } } while (0)
    asm volatile("s_waitcnt vmcnt(0) lgkmcnt(0)" ::: "memory"); __builtin_amdgcn_s_barrier(); asm volatile("" ::: "memory");
    if (wave < 4) __builtin_amdgcn_s_setprio(3);
    pg8::f32x4 Sacc[8];
#pragma unroll
    for (int mt = 0; mt < 8; ++mt) Sacc[mt] = (pg8::f32x4){0.f, 0.f, 0.f, 0.f};
#pragma unroll
    for (int cc = 0; cc < AHEAD; ++cc) HG_DMA(cc);
    if (wave == 0) asm volatile("s_waitcnt vmcnt(9)" ::: "memory"); else asm volatile("s_waitcnt vmcnt(6)" ::: "memory");
    __builtin_amdgcn_s_barrier(); asm volatile("" ::: "memory");
    float* O = (float*)(ws + wso(WS_O)) + (size_t)(b * SEQ) * WC + h * 128 + vbase + 4 * quad;
    for (int st = 0; st < NCH; ++st) {
        if (st + AHEAD < NCH) HG_DMA(st + AHEAD);
        if (wave < 4) {
        const LAS unsigned char* S = lds + (st % 6) * HREC_BYTES;
        const LAS bf16* qs = (const LAS bf16*)(S + HR_QS); const LAS bf16* ks = (const LAS bf16*)(S + HR_KS); const LAS bf16* vt = (const LAS bf16*)(S + HR_VT);
        const LAS bf16* kht = (const LAS bf16*)(S + HR_KHT); const LAS float* ev = (const LAS float*)(S + HR_EV);
        bf16x8 qf[4], kf[4];
#pragma unroll
        for (int kt = 0; kt < 4; ++kt) { qf[kt] = *(const LAS bf16x8*)(qs + x * 136 + 32 * kt + 8 * quad); kf[kt] = *(const LAS bf16x8*)(ks + x * 136 + 32 * kt + 8 * quad); }
        pg8::f32x4 att = (pg8::f32x4){0.f, 0.f, 0.f, 0.f};
#pragma unroll
        for (int kt = 0; kt < 4; ++kt) att = __builtin_amdgcn_mfma_f32_16x16x32_bf16(kf[kt], qf[kt], att, 0, 0, 0);
#pragma unroll
        for (int i = 0; i < 4; ++i) if (4 * quad + i > x) att[i] = 0.f;
        v4u pbu; pbu.x = cvt_pk_bf16_c(att[0], att[1]); pbu.y = cvt_pk_bf16_c(att[2], att[3]); pbu.z = 0u; pbu.w = 0u;
        const bf16x8 pb = __builtin_bit_cast(bf16x8, pbu);
        const u2 vv = *(const LAS u2*)(vt + (vbase + x) * 16 + 4 * quad);
        v4u vfu; vfu.x = vv.x; vfu.y = vv.y; vfu.z = 0u; vfu.w = 0u; const bf16x8 vf = __builtin_bit_cast(bf16x8, vfu);
        pg8::f32x4 o = (pg8::f32x4){0.f, 0.f, 0.f, 0.f};
#pragma unroll
        for (int kt = 0; kt < 4; ++kt) { v4u su; su.x = cvt_pk_bf16_c(Sacc[2 * kt][0], Sacc[2 * kt][1]); su.y = cvt_pk_bf16_c(Sacc[2 * kt][2], Sacc[2 * kt][3]);
            su.z = cvt_pk_bf16_c(Sacc[2 * kt + 1][0], Sacc[2 * kt + 1][1]); su.w = cvt_pk_bf16_c(Sacc[2 * kt + 1][2], Sacc[2 * kt + 1][3]);
            o = __builtin_amdgcn_mfma_f32_16x16x32_bf16(__builtin_bit_cast(bf16x8, su), qf[kt], o, 0, 0, 0); }
        o = __builtin_amdgcn_mfma_f32_16x16x32_bf16(vf, pb, o, 0, 0, 0);
        *(pg8::f32x4*)(O + (size_t)(st * 16 + x) * WC) = o;
#pragma unroll
        for (int mt = 0; mt < 8; ++mt) { const pg8::f32x4 e4 = *(const LAS pg8::f32x4*)(ev + 16 * mt + 4 * quad);
            const u2 kk2 = *(const LAS u2*)(kht + (16 * mt + x) * 16 + 4 * quad); v4u ku; ku.x = kk2.x; ku.y = kk2.y; ku.z = 0u; ku.w = 0u;
            Sacc[mt] = __builtin_amdgcn_mfma_f32_16x16x32_bf16(__builtin_bit_cast(bf16x8, ku), vf, Sacc[mt] * e4, 0, 0, 0); }
        }
        if (st + AHEAD < NCH) HG_WAIT(st); else asm volatile("s_waitcnt vmcnt(0)" ::: "memory");
        asm volatile("s_waitcnt lgkmcnt(0)" ::: "memory"); __builtin_amdgcn_s_barrier(); asm volatile("" ::: "memory");
    }
#undef HG_DMA
#undef HG_WAIT
    __builtin_amdgcn_s_setprio(0);
    if (wave < 4) { float* So = a->out + O_HP + (((size_t)L * NBAT + b) * 6 + h) * 16384;
#pragma unroll
        for (int mt = 0; mt < 8; ++mt)
#pragma unroll
            for (int i = 0; i < 4; ++i) So[(size_t)(16 * mt + 4 * quad + i) * 128 + vbase + x] = Sacc[mt][i]; }
    asm volatile("s_waitcnt vmcnt(0) lgkmcnt(0)" ::: "memory"); __builtin_amdgcn_s_barrier(); asm volatile("" ::: "memory");
}
__device__ __forceinline__ void phase_pre(ArgsP a, int L, LAS unsigned char* lds, int lane, int wave, int blk, int G) {
    const int gw = blk * NWAVES + wave, NGW = G * NWAVES;
    for (int r2 = 0; r2 < NREP(101); ++r2) for (int tr = gw; tr < NCHUNK / 3; tr += NGW) {
        const int b = tr >> 9, c = (tr >> 2) & 127, hg = tr & 3; bf16x8 xf[8];
#pragma unroll
        for (int ks = 0; ks < 8; ++ks) xf[ks] = (bf16x8){0, 0, 0, 0, 0, 0, 0, 0};
#pragma unroll 1
        for (int k = 0; k < 3; ++k) pre_chunk(a, L, ((b * 12 + 3 * hg + k) << 7) + c, lds + wave * 16384, lane, k == 0, xf); }
    for (int r2 = 0; r2 < NREP(102); ++r2) for (int q2 = gw; q2 < NHCHUNK; q2 += NGW) hpre_chunk(a, L, q2, lds + wave * 16384, lane);
}
__device__ __forceinline__ void rwkv_seq_unit(ArgsP a, int L, int unit, LAS unsigned char* lds, int lane, int wave) {
    unsigned char* ws = a->ws;
    const int b = unit / 12, h = unit - 12 * b;
    const unsigned char* recs = ws + wso(WS_RPB) + (size_t)unit * 128 * REC_BYTES;
    LAS float* ybuf = (LAS float*)(lds + 7 * REC_BYTES);
    const int x = lane & 15, quad = lane >> 4;
    constexpr int AHEAD = 5, NCH = SEQ / 16;
#define RW_DMA(cc) do { const unsigned char* g_ = recs + (size_t)(cc) * REC_BYTES + wave * 1024 + lane * 16; LAS unsigned char* l_ = lds + ((cc) % 7) * REC_BYTES + wave * 1024; \
        __builtin_amdgcn_global_load_lds((const unsigned*)(g_), (LAS unsigned*)(l_), 16, 0, 0); if (wave < 6) __builtin_amdgcn_global_load_lds((const unsigned*)(g_ + 8192), (LAS unsigned*)(l_ + 8192), 16, 0, 0); } while (0)
#define RW_WAIT(c_) do { if (wave < 4) asm volatile("s_waitcnt vmcnt(8)" ::: "memory"); \
        else if ((c_) >= 5) { if (wave < 6) asm volatile("s_waitcnt vmcnt(13)" ::: "memory"); else asm volatile("s_waitcnt vmcnt(9)" ::: "memory"); }          \
        else { if (wave < 6) asm volatile("s_waitcnt vmcnt(8)" ::: "memory"); else asm volatile("s_waitcnt vmcnt(4)" ::: "memory"); } } while (0)
    asm volatile("s_waitcnt vmcnt(0) lgkmcnt(0)" ::: "memory"); __builtin_amdgcn_s_barrier(); asm volatile("" ::: "memory");
    if (wave < 4) __builtin_amdgcn_s_setprio(3);
    pg8::f32x4 Hacc[4];
#pragma unroll
    for (int nt = 0; nt < 4; ++nt) Hacc[nt] = (pg8::f32x4){0.f, 0.f, 0.f, 0.f};
    f4 gng4 = (f4){0.f, 0.f, 0.f, 0.f}, gnb4 = gng4;
    if (wave >= 4) { gng4 = *(const f4*)(a->in[I_BGNG] + L * WB + h * 64 + 4 * x); gnb4 = *(const f4*)(a->in[I_BGNB] + L * WB + h * 64 + 4 * x); }
    asm volatile("s_waitcnt vmcnt(0)" ::: "memory");
#pragma unroll
    for (int cc = 0; cc < AHEAD; ++cc) RW_DMA(cc);
    RW_WAIT(0);
    __builtin_amdgcn_s_barrier(); asm volatile("" ::: "memory");
    bf16* ymix = (bf16*)(ws + wso(WS_YMIX)) + (size_t)(b * SEQ) * DM + WA + h * 64 + 4 * x;
    for (int c = 0; c <= NCH; ++c) {
        if (c + AHEAD < NCH) RW_DMA(c + AHEAD);
        if (wave < 4) {
            if (c < NCH) {
                const LAS unsigned char* S = lds + (c % 7) * REC_BYTES;
                bf16x8 wf[2], rf[2], hb[2];
#pragma unroll
                for (int ks = 0; ks < 2; ++ks) { const int so = x * 128 + 16 * ((4 * ks + quad) ^ ((x >> 1) & 7));        wf[ks] = *(const LAS bf16x8*)(S + RC_WT + so); rf[ks] = *(const LAS bf16x8*)(S + RC_RT + so);
                    v4u su; su.x = cvt_pk_bf16_c(Hacc[2 * ks][0], Hacc[2 * ks][1]); su.y = cvt_pk_bf16_c(Hacc[2 * ks][2], Hacc[2 * ks][3]);
                    su.z = cvt_pk_bf16_c(Hacc[2 * ks + 1][0], Hacc[2 * ks + 1][1]); su.w = cvt_pk_bf16_c(Hacc[2 * ks + 1][2], Hacc[2 * ks + 1][3]); hb[ks] = __builtin_bit_cast(bf16x8, su); }
                const u2 vv = *(const LAS u2*)(S + RC_VT + (16 * wave + x) * 32 + 8 * ((quad + (x >> 2)) & 3));     v4u t4; t4.x = vv.x; t4.y = vv.y; t4.z = 0u; t4.w = 0u; const bf16x8 vf = __builtin_bit_cast(bf16x8, t4);
                const u2 m2v = *(const LAS u2*)(S + RC_M2 + x * 32 + 8 * quad); t4.x = m2v.x; t4.y = m2v.y; const bf16x8 m2f = __builtin_bit_cast(bf16x8, t4);
                const u2 brav = *(const LAS u2*)(S + RC_BRA + x * 32 + 8 * quad); t4.x = brav.x; t4.y = brav.y; const bf16x8 braf = __builtin_bit_cast(bf16x8, t4);
                const u2 brkv = *(const LAS u2*)(S + RC_BRK + x * 32 + 8 * quad); t4.x = brkv.x; t4.y = brkv.y; const bf16x8 brkf = __builtin_bit_cast(bf16x8, t4);
                pg8::f32x4 U = (pg8::f32x4){0.f, 0.f, 0.f, 0.f}, Y = U;
                U = __builtin_amdgcn_mfma_f32_16x16x32_bf16(wf[0], hb[0], U, 0, 0, 0); U = __builtin_amdgcn_mfma_f32_16x16x32_bf16(wf[1], hb[1], U, 0, 0, 0); U = __builtin_amdgcn_mfma_f32_16x16x32_bf16(m2f, vf, U, 0, 0, 0);
                Y = __builtin_amdgcn_mfma_f32_16x16x32_bf16(rf[0], hb[0], Y, 0, 0, 0); Y = __builtin_amdgcn_mfma_f32_16x16x32_bf16(rf[1], hb[1], Y, 0, 0, 0); Y = __builtin_amdgcn_mfma_f32_16x16x32_bf16(brkf, vf, Y, 0, 0, 0);
                t4.x = cvt_pk_bf16_c(U[0], U[1]); t4.y = cvt_pk_bf16_c(U[2], U[3]); const bf16x8 ub = __builtin_bit_cast(bf16x8, t4);
                Y = __builtin_amdgcn_mfma_f32_16x16x32_bf16(braf, ub, Y, 0, 0, 0);
#pragma unroll
                for (int nt = 0; nt < 4; ++nt) { const pg8::f32x4 g4 = *(const LAS pg8::f32x4*)(S + RC_G15 + (16 * nt + 4 * quad) * 4);
                    const u2 av = *(const LAS u2*)(S + RC_AHT + (16 * nt + x) * 32 + 8 * quad); t4.x = av.x; t4.y = av.y; const bf16x8 ahf = __builtin_bit_cast(bf16x8, t4);
                    const u2 kv = *(const LAS u2*)(S + RC_KHT + (16 * nt + x) * 32 + 8 * quad); t4.x = kv.x; t4.y = kv.y; const bf16x8 khf = __builtin_bit_cast(bf16x8, t4);
                    Hacc[nt] = __builtin_amdgcn_mfma_f32_16x16x32_bf16(ahf, ub, Hacc[nt] * g4, 0, 0, 0); Hacc[nt] = __builtin_amdgcn_mfma_f32_16x16x32_bf16(khf, vf, Hacc[nt], 0, 0, 0); }
                LAS float* yb = ybuf + (c & 1) * 1024;
#pragma unroll
                for (int i = 0; i < 4; ++i) yb[(4 * quad + i) * 64 + 16 * wave + x] = Y[i];
            }
        } else {
            if (c > 0) {
                const int cp = c - 1, tt = 4 * (wave - 4) + quad; const LAS unsigned char* S = lds + (cp % 7) * REC_BYTES; const LAS float* yb = ybuf + (cp & 1) * 1024;
                const f4 y4 = *(const LAS f4*)(yb + tt * 64 + 4 * x); const u2 gq = *(const LAS u2*)(S + RC_GT + (tt * 64 + 4 * x) * 2);
                const float bcf = *(const LAS float*)(S + RC_BC + tt * 4);
                f4 g4, v4; g4.x = __builtin_bit_cast(float, gq.x << 16); g4.y = __builtin_bit_cast(float, gq.x & 0xffff0000u); g4.z = __builtin_bit_cast(float, gq.y << 16); g4.w = __builtin_bit_cast(float, gq.y & 0xffff0000u);
#pragma unroll
                for (int i = 0; i < 4; ++i) v4[i] = __builtin_bit_cast(float, (unsigned)(*(const LAS unsigned short*)(S + RC_VT + (4 * x + i) * 32 + ((tt + 4 * (x & 3)) & 15) * 2)) << 16);
                const float mean = row16_sum((y4.x + y4.y) + (y4.z + y4.w)) * (1.f / 64.f); const f4 d = y4 - mean;
                const float rstd = __builtin_amdgcn_rsqf(row16_sum((d.x * d.x + d.y * d.y) + (d.z * d.z + d.w * d.w)) * (1.f / 64.f) + GN_EPS);
                const f4 o = (d * rstd * gng4 + gnb4 + v4 * bcf) * g4;
                u2 w; w.x = cvt_pk_bf16_c(o.x, o.y); w.y = cvt_pk_bf16_c(o.z, o.w); *(u2*)(ymix + (size_t)(cp * 16 + tt) * DM) = w;
            }
        }
        if (c + AHEAD < NCH) RW_WAIT(c); else asm volatile("s_waitcnt vmcnt(0)" ::: "memory");
        asm volatile("s_waitcnt lgkmcnt(0)" ::: "memory"); __builtin_amdgcn_s_barrier(); asm volatile("" ::: "memory");
    }
    __builtin_amdgcn_s_setprio(0);
    if (wave < 4) { float* So = a->out + O_RP + (((size_t)L * NBAT + b) * 12 + h) * 4096;
#pragma unroll
        for (int nt = 0; nt < 4; ++nt) *(pg8::f32x4*)(So + (size_t)(16 * wave + x) * 64 + 16 * nt + 4 * quad) = Hacc[nt]; }
#undef RW_DMA
#undef RW_WAIT
    asm volatile("s_waitcnt vmcnt(0) lgkmcnt(0)" ::: "memory"); __builtin_amdgcn_s_barrier(); asm volatile("" ::: "memory");
}

__device__ __forceinline__ float gelu_fast(float v) {
    const float t = __builtin_amdgcn_rcpf(__builtin_fabsf(v) * 0.2316418882f + 1.0f);
    float q = t * 0.5307027145f + (-0.7265760135f); q = q * t + 0.7107068705f; q = q * t + (-0.142248368f); q = q * t + 0.127414796f; q = q * t;
    const float e = __builtin_amdgcn_exp2f((v * v) * (-0.72134752044f)); const float m = v * (q * e);
    return v < 0.f ? m : v - m;
}
__device__ __forceinline__ void sgu_item2(ArgsP a, int L, int item, LAS unsigned char* lds, int tid, int lane, int wave) {
    unsigned char* ws = a->ws;
    const int g = item & 3, bc = item >> 2, m0 = bc * 128;
    const bf16* Z = (const bf16*)(ws + wso(WS_Z));
    LAS bf16* Wb = (LAS bf16*)lds;
    LAS bf16* VT = (LAS bf16*)(lds + 34816);
    const float* wsrc = a->in[I_AWS] + (size_t)(L * 4 + g) * 16384;
    __syncthreads();
#pragma unroll
    for (int j = 0; j < 8; ++j) { const int e4 = j * NTHR + tid, t = e4 >> 5, s0 = (e4 & 31) * 4; const f4 w = *(const f4*)(wsrc + t * 128 + s0);
        u2 o; o.x = cvt_pk_bf16_c(s0 <= t ? w.x : 0.f, s0 + 1 <= t ? w.y : 0.f); o.y = cvt_pk_bf16_c(s0 + 2 <= t ? w.z : 0.f, s0 + 3 <= t ? w.w : 0.f); *(LAS u2*)(Wb + t * 136 + s0) = o; }
    const float lg0 = a->in[I_ALNG][L * WA + g * 128 + lane], lg1 = a->in[I_ALNG][L * WA + g * 128 + 64 + lane], lb0 = a->in[I_ALNB][L * WA + g * 128 + lane], lb1 = a->in[I_ALNB][L * WA + g * 128 + 64 + lane];
    float zv0[16], zv1[16];
#pragma unroll
    for (int rr = 0; rr < 16; ++rr) { const bf16* zr = Z + (size_t)(m0 + wave * 16 + rr) * PIN + WA + g * 128; zv0[rr] = bfl(zr[lane]); zv1[rr] = bfl(zr[64 + lane]); }
#pragma unroll
    for (int rr = 0; rr < 16; ++rr) { const int t = wave * 16 + rr; const float v0 = gelu_fast(zv0[rr]), v1 = gelu_fast(zv1[rr]);
        const float mean = wave_sum_fast(v0 + v1) * (1.f / 128.f); const float d0 = v0 - mean, d1 = v1 - mean;
        const float rstd = __builtin_amdgcn_rsqf(wave_sum_fast(d0 * d0 + d1 * d1) * (1.f / 128.f) + LN_EPS);
        VT[lane * 136 + t] = bf1(d0 * rstd * lg0 + lb0); VT[(64 + lane) * 136 + t] = bf1(d1 * rstd * lg1 + lb1); }
    __syncthreads();
    const int x = lane & 15, quad = lane >> 4, nks = (wave >> 1) + 1;
    pg8::f32x4 acc[8];
#pragma unroll
    for (int dt = 0; dt < 8; ++dt) acc[dt] = (pg8::f32x4){0.f, 0.f, 0.f, 0.f};
    for (int ks = 0; ks < nks; ++ks) { const bf16x8 wf = *(const LAS bf16x8*)(Wb + (16 * wave + x) * 136 + 32 * ks + 8 * quad);
#pragma unroll
        for (int dt = 0; dt < 8; ++dt) { const bf16x8 vf = *(const LAS bf16x8*)(VT + (16 * dt + x) * 136 + 32 * ks + 8 * quad); acc[dt] = __builtin_amdgcn_mfma_f32_16x16x32_bf16(vf, wf, acc[dt], 0, 0, 0); } }
    const int t = 16 * wave + x; const float bs = a->in[I_ABS][(L * 4 + g) * 128 + t];
    const bf16* ur = Z + (size_t)(m0 + t) * PIN + g * 128 + 4 * quad; bf16* yo = (bf16*)(ws + wso(WS_YMIX)) + (size_t)(m0 + t) * DM + g * 128 + 4 * quad;
#pragma unroll
    for (int dt = 0; dt < 8; ++dt) { const f4 u = bf4(*(const u2*)(ur + 16 * dt)); u2 o;
        o.x = cvt_pk_bf16_c(gelu_fast(u.x) * (acc[dt][0] + bs), gelu_fast(u.y) * (acc[dt][1] + bs)); o.y = cvt_pk_bf16_c(gelu_fast(u.z) * (acc[dt][2] + bs), gelu_fast(u.w) * (acc[dt][3] + bs));
        *(u2*)(yo + 16 * dt) = o; }
}
__device__ __forceinline__ void hgrn_sample_item2(ArgsP a, int L, int item, LAS unsigned char* lds, int lane, int wave) {
    unsigned char* ws = a->ws;
    const int ih = item * 8 + wave, i = ih / 6, h = ih - i * 6, m = MP + i, vq = lane & 31, kh = lane >> 5;
    const float* zc = (const float*)(ws + wso(WS_Z)) + (size_t)m * PIN + OFF_C + h * 128;
    LAS f4* sc = (LAS f4*)(lds + wave * 2048);
#pragma unroll
    for (int t = 0; t < 2; ++t) { const int k = lane + 64 * t; const float lb = lbound(a->in[I_CLB], L, h * 128 + k); const float fz = zc[WC + k];
        const float e = __expf(-fmaxf(fz, -80.f)), sg = __builtin_amdgcn_rcpf(1.0f + e); f4 r; r.x = lb + (1.0f - lb) * sg; r.y = (1.0f - lb) * e * sg; r.z = zc[k]; r.w = 0.f; sc[k] = r; }
    const f4 iv = *(const f4*)(zc + 2 * WC + 4 * vq);
    LDS_WAIT(); asm volatile("" ::: "memory");
    const float* S0 = a->in[I_SHGRN] + (((size_t)L * NS + i) * 6 + h) * 16384 + 4 * vq;
    float* So = a->out + O_HS + (((size_t)L * NS + i) * 6 + h) * 16384 + 4 * vq;
    f4 o = (f4){0.f, 0.f, 0.f, 0.f};
#pragma unroll 1
    for (int qt = 0; qt < 4; ++qt) { f4 sv[16];
#pragma unroll
        for (int j = 0; j < 16; ++j) sv[j] = *(const f4*)(S0 + (size_t)(kh + 2 * (16 * qt + j)) * 128);
#pragma unroll
        for (int j = 0; j < 16; ++j) { const int k = kh + 2 * (16 * qt + j); const f4 c = sc[k]; const f4 n = sv[j] * c.x + iv * c.y; *(f4*)(So + (size_t)k * 128) = n; o += n * c.z; } }
    { LAS f4* ex = (LAS f4*)(lds + 16384 + wave * 1024); ex[lane] = o; LDS_WAIT(); asm volatile("" ::: "memory"); o += ex[lane ^ 32]; }
    if (kh == 0) *(f4*)((float*)(ws + wso(WS_O)) + (size_t)m * WC + h * 128 + 4 * vq) = o;
    LDS_WAIT(); asm volatile("" ::: "memory");
}

enum { SE_STORE = 0, SE_RESID = 1, SE_SWIGLU = 2, SE_SIGMUL = 3, SE_ATOMIC = 4 };
struct SEpi { int mode; float* out; const float* base; const float* add; int ld; float alpha; float* tinit; };
template <int NT> __device__ __forceinline__ void strip_task(const bf16* A, const bf16* Bt, int K, int rb0, int rb1, int c0, const SEpi& E, LAS unsigned char* lds, int lane, int wave, int kbeg, int nk) {
    const int x = lane & 15, quad = lane >> 4;
    const int q8 = nk >> 3, r8 = nk & 7, nks = q8 + (wave < r8 ? 1 : 0), ks0 = kbeg + wave * q8 + (wave < r8 ? wave : r8);
    const bf16* Ap = A + (size_t)x * K + ks0 * 32 + 8 * quad;
    const bf16* Bp[NT];
#pragma unroll
    for (int i = 0; i < NT; ++i) { const int r = (i < NT / 2) ? rb0 + 16 * i : rb1 + 16 * (i - NT / 2); Bp[i] = Bt + (size_t)(r + x) * K + ks0 * 32 + 8 * quad; }
    pg8::f32x4 acc[8][NT];
#pragma unroll
    for (int mt = 0; mt < 8; ++mt)
#pragma unroll
        for (int i = 0; i < NT; ++i) acc[mt][i] = (pg8::f32x4){0.f, 0.f, 0.f, 0.f};
    for (int s = 0; s < nks; ++s) {
        bf16x8 af[8], bfr[NT];
#pragma unroll
        for (int i = 0; i < NT; ++i) bfr[i] = *(const bf16x8*)(Bp[i] + 32 * s);
#pragma unroll
        for (int mt = 0; mt < 8; ++mt) af[mt] = *(const bf16x8*)(Ap + (size_t)(16 * mt) * K + 32 * s);
#pragma unroll
        for (int mt = 0; mt < 8; ++mt)
#pragma unroll
            for (int i = 0; i < NT; ++i) acc[mt][i] = __builtin_amdgcn_mfma_f32_16x16x32_bf16(af[mt], bfr[i], acc[mt][i], 0, 0, 0);
    }
    LAS pg8::f32x4* red = (LAS pg8::f32x4*)lds;
    pg8::f32x4 sum[NT];
#pragma unroll
    for (int p = 0; p < NT / 2; ++p) {
        __syncthreads();
#pragma unroll
        for (int mt = 0; mt < 8; ++mt) { red[((wave * 8 + mt) * 2 + 0) * 64 + lane] = acc[mt][2 * p]; red[((wave * 8 + mt) * 2 + 1) * 64 + lane] = acc[mt][2 * p + 1]; }
        __syncthreads();
        pg8::f32x4 s0 = (pg8::f32x4){0.f, 0.f, 0.f, 0.f}, s1 = s0;
#pragma unroll
        for (int w2 = 0; w2 < 8; ++w2) { s0 += red[((w2 * 8 + wave) * 2 + 0) * 64 + lane]; s1 += red[((w2 * 8 + wave) * 2 + 1) * 64 + lane]; }
        sum[2 * p] = s0; sum[2 * p + 1] = s1;
    }
#pragma unroll
    for (int i = 0; i < 4; ++i) { const size_t ro = (size_t)(16 * wave + 4 * quad + i) * E.ld;
        if (E.mode == SE_SWIGLU) {
#pragma unroll
            for (int t = 0; t < NT / 2; ++t) { const float g = sum[t][i]; ((bf16*)E.out)[ro + c0 + 16 * t + x] = bf1(g * __builtin_amdgcn_rcpf(1.0f + __expf(-g)) * sum[NT / 2 + t][i]); } }
        else {
#pragma unroll
            for (int t = 0; t < NT; ++t) { const size_t o = ro + c0 + 16 * t + x; const float v = sum[t][i]; float r;
                if (E.mode == SE_ATOMIC) { __hip_atomic_fetch_add(E.out + o, v, __ATOMIC_RELAXED, __HIP_MEMORY_SCOPE_AGENT); continue; }
                if (E.mode == SE_STORE) r = v;
                else if (E.mode == SE_RESID) { r = E.alpha * E.base[o] + v; if (E.add) r += E.add[o]; }
                else { r = E.base[o] * __builtin_amdgcn_rcpf(1.0f + __expf(-v)); if (E.tinit) E.tinit[o] = E.alpha * E.add[o] + r; }
                E.out[o] = r; } }
    }
}
template <int NT = 2> __device__ __forceinline__ void strip_gemm(const bf16* A, const bf16* Bt, int K, int N, const SEpi& E, LAS unsigned char* lds, int lane, int wave, int blk, int G, int ksplit = 1, int nb = 0) {
    if (nb <= 0 || nb > G) nb = G;
    const int per = (E.mode == SE_SWIGLU) ? 8 * NT : 16 * NT, ncg = N / per, ntask = ncg * ksplit, nkt = (K >> 5) / ksplit;
    if (blk >= G - nb)
    for (int t = G - 1 - blk; t < ntask; t += nb) { const int cg = t % ncg, kg = t / ncg, c0 = cg * per;
        if (E.mode == SE_SWIGLU) { const int rb = ((c0 >> 7) << 8) + (c0 & 127); strip_task<NT>(A, Bt, K, rb, rb + 128, c0, E, lds, lane, wave, 0, K >> 5); }
        else strip_task<NT>(A, Bt, K, c0, c0 + 8 * NT, c0, E, lds, lane, wave, kg * nkt, nkt); }
    __syncthreads();
}

#ifndef EN_PRO
#define EN_PRO 1
#endif
#ifndef EN_G1
#define EN_G1 1
#endif
#ifndef EN_PREP
#define EN_PREP 1
#endif
#ifndef EN_MIX
#define EN_MIX 1
#endif
#ifndef EN_POST
#define EN_POST 1
#endif
#ifndef EN_G3
#define EN_G3 1
#endif
#ifndef EN_LN
#define EN_LN 1
#endif
#ifndef EN_G4
#define EN_G4 1
#endif
#ifndef EN_G5
#define EN_G5 1
#endif
#ifndef MK_SINGLE
#define MK_SINGLE 1
#endif
constexpr int PPL = 9, N_PHASES = 1 + PPL * DEPTH;
constexpr int SCAN_UNITS = NBAT * 12, HSEQ_UNITS = NBAT * 6 * 2, ROLE_BLOCKS = SCAN_UNITS + HSEQ_UNITS;
constexpr int G1Z = 208;
constexpr int N_SGU = NBAT * 16 * 4, N_RS = NS * 12 / 8, N_HS = NS * 6 / 8, N_MISC = N_SGU + N_RS + N_HS;

__global__ void __launch_bounds__(NTHR, 2) mk_fwd(Args a) {
    extern __shared__ __attribute__((aligned(16))) unsigned char lds_raw[];
    LAS unsigned char* lds = (LAS unsigned char*)lds_raw;
    const int tid = threadIdx.x, blk = blockIdx.x, G = gridDim.x; const int wave0 = __builtin_amdgcn_readfirstlane(tid >> 6);
    ArgsP ap0 = (ArgsP)__builtin_amdgcn_kernarg_segment_ptr();
    volatile LAS unsigned* MISC = (volatile LAS unsigned*)(lds + MISC_OFF);
    for (int u = tid; u < (LDS_BYTES - LDSCTL_OFF) / 4; u += NTHR) ((LAS unsigned*)(lds + LDSCTL_OFF))[u] = 0u;
    __syncthreads();
    const int lo = ap0->ph_lo, hi = ap0->ph_hi;
    XcdBarrier bar; bar.bar = (unsigned*)(ap0->ws + WS_CTL) + CW_BAR; bar.x = 0; bar.st = nullptr;
    if (hi - lo > 1) bar = xcd_barrier_post((unsigned*)(ap0->ws + WS_CTL) + CW_BAR, MISC + 8);
    bar.w0 = (wave0 == 0);
#define IN(k) (lo <= (k) && (k) < hi)
#define SEAM(k) do { if (IN(k) && IN((k) + 1)) { xcd_barrier(bar); } } while (0)
#define PHASE_BEGIN() ArgsP a = ap0; asm volatile("" : "+s"(a)); unsigned char* ws = a->ws; int tid_ = wave0 * 64 + mk_lane_id(); asm volatile("" : "+v"(tid_)); \
    const int lane_ = tid_ & 63; const int wave_ = __builtin_amdgcn_readfirstlane(tid_ >> 6); const int lane_s = lane_, wave_s = wave_; \
    bf16* HB = (bf16*)(ws + wso(WS_HB)); float* H = (float*)(ws + wso(WS_H)); float* T = (float*)(ws + wso(WS_T)); (void)HB; (void)H; (void)T; (void)lane_s; (void)wave_s

    #if EN_PRO
    if (IN(0)) for (int rep = 0; rep < NREP(0); ++rep) { PHASE_BEGIN(); phase_prologue(a, lds, lane_, wave_, blk, G); __syncthreads(); }
#endif
    SEAM(0);
    for (int L = 0; L < DEPTH; ++L) {
        const int pb = 1 + PPL * L;
#if EN_G1
        if (IN(pb)) for (int rep = 0; rep < NREP(1); ++rep) {
            { PHASE_BEGIN(); if (blk < G1Z) { pg8::Gemm g{HB, (const bf16*)(ws + wso(WS_WIN) + L * SZ_WIN), MP, PIN, DM}; pg8::StaticOrder S; S.init(MP, PIN, G1Z, blk);
              pg8::EpiBf16Q E{(bf16*)(ws + wso(WS_Z)), PIN}; pg8::gemm_phase<pg8::EpiBf16Q, pg8::StaticOrder, true, true>(lds, g, S, E, wave0); } }
              { PHASE_BEGIN(); const SEpi SE{SE_STORE, (float*)(ws + wso(WS_Z)) + (size_t)MP * PIN, nullptr, nullptr, PIN, 0.f, nullptr}; strip_gemm<4>(HB + (size_t)MP * DM, (const bf16*)(ws + wso(WS_WIN) + L * SZ_WIN), DM, PIN, SE, lds, lane_s, wave_s, blk, G, 1, G - G1Z); }
            { PHASE_BEGIN(); if (blk >= G1Z) { pg8::Gemm g{(const bf16*)(ws + wso(WS_PBF) + L * SZ_PBF), (const bf16*)(ws + wso(WS_WPP) + L * SZ_WPP), MP, DM, DPLE}; pg8::StaticOrder S; S.init(MP, DM, G - G1Z, blk - G1Z);
              pg8::EpiBf16Q E{(bf16*)(ws + wso(WS_PPO)), DM}; pg8::gemm_phase<pg8::EpiBf16Q, pg8::StaticOrder, true, true>(lds, g, S, E, wave0); } }
              { PHASE_BEGIN(); const SEpi SE{SE_STORE, (float*)(ws + wso(WS_PPO)) + (size_t)MP * DM, nullptr, nullptr, DM, 0.f, nullptr}; strip_gemm((const bf16*)(ws + wso(WS_PBF) + L * SZ_PBF) + (size_t)MP * DPLE, (const bf16*)(ws + wso(WS_WPP) + L * SZ_WPP), DPLE, DM, SE, lds, lane_s, wave_s, blk, G, 1, G - G1Z); }
        }
#endif
        SEAM(pb);
#if EN_PREP
        if (IN(pb + 1)) for (int rep = 0; rep < NREP(10); ++rep) { PHASE_BEGIN(); phase_pre(a, L, lds, lane_, wave_, blk, G); for (int r2 = 0; r2 < NREP(103); ++r2) phase_fin(a, L, lds, lane_, wave_, blk, G); }
#endif
        SEAM(pb + 1);
#if EN_MIX
        if (IN(pb + 2)) for (int rep = 0; rep < NREP(3); ++rep) { PHASE_BEGIN();
            const int tid = tid_, lane = lane_, wave = wave_;
            if (blk < SCAN_UNITS) { for (int r2 = 0; r2 < NREP(31); ++r2) rwkv_seq_unit(a, L, blk, lds, lane, wave); }
            else if (blk < ROLE_BLOCKS) { for (int r2 = 0; r2 < NREP(32); ++r2) hgrn_stream_unit(a, L, blk - SCAN_UNITS, lds, lane, wave); }
            else for (int r2 = 0; r2 < NREP(33); ++r2) for (int it = blk - ROLE_BLOCKS; it < N_MISC; it += G - ROLE_BLOCKS) {
                if (it < N_SGU) sgu_item2(a, L, it, lds, tid, lane, wave);
                else if (it < N_SGU + N_RS) rwkv_sample_item(a, L, it - N_SGU, lds, lane, wave);
                else hgrn_sample_item2(a, L, it - N_SGU - N_RS, lds, lane, wave);
                __syncthreads();
            }
        }
#endif
        SEAM(pb + 2);
#if EN_POST
        if (IN(pb + 3)) for (int rep = 0; rep < NREP(4); ++rep) { PHASE_BEGIN(); phase_post(a, L, lane_, wave_, blk, G); }
#endif
        SEAM(pb + 3);
#if EN_G3
        if (IN(pb + 4)) {
            for (int rep = 0; rep < NREP(5); ++rep) { PHASE_BEGIN(); pg8::Gemm g{(const bf16*)(ws + wso(WS_YMIX)), (const bf16*)(ws + wso(WS_WOUT) + L * SZ_WOUT), MP, DM, DM}; pg8::StaticOrder S; S.init(MP, DM, G, blk);
            pg8::EpiResidB E{(bf16*)T, HB, nullptr, DM, DN_ALPHA}; pg8::gemm_phase<pg8::EpiResidB, pg8::StaticOrder, true, true>(lds, g, S, E, wave0); }
            { PHASE_BEGIN(); const SEpi SE{SE_ATOMIC, T + (size_t)MP * DM, nullptr, nullptr, DM, 0.f, nullptr}; strip_gemm<4>((const bf16*)(ws + wso(WS_YMIX)) + (size_t)MP * DM, (const bf16*)(ws + wso(WS_WOUT) + L * SZ_WOUT), DM, DM, SE, lds, lane_s, wave_s, blk, G, 8); }
        }
#endif
        SEAM(pb + 4);
#if EN_LN
        if (IN(pb + 5)) for (int rep = 0; rep < NREP(6); ++rep) { PHASE_BEGIN(); phase_ln(a, a->in[I_LN1G] + L * DM, a->in[I_LN1B] + L * DM, false, lane_, wave_, blk, G); }
#endif
        SEAM(pb + 5);
#if EN_G4
        if (IN(pb + 6)) for (int rep = 0; rep < NREP(7); ++rep) {
            { PHASE_BEGIN(); pg8::Gemm g{HB, (const bf16*)(ws + wso(WS_WGU) + L * SZ_WGU), MP, 2 * DFF, DM}; pg8::StaticOrder S; S.init(MP, 2 * DFF, G, blk);
              pg8::EpiSwiglu E{(bf16*)(ws + wso(WS_ACT)), DFF}; pg8::gemm_phase<pg8::EpiSwiglu, pg8::StaticOrder, true, true>(lds, g, S, E, wave0); }
              { PHASE_BEGIN(); const SEpi SE{SE_SWIGLU, (float*)((bf16*)(ws + wso(WS_ACT)) + (size_t)MP * DFF), nullptr, nullptr, DFF, 0.f, nullptr}; strip_gemm<4>(HB + (size_t)MP * DM, (const bf16*)(ws + wso(WS_WGU) + L * SZ_WGU), DM, DFF, SE, lds, lane_s, wave_s, blk, G, 1, 128); }
            { PHASE_BEGIN(); pg8::Gemm g{HB, (const bf16*)(ws + wso(WS_WPG) + L * SZ_WPG), MP, DM, DM}; pg8::StaticOrder S; S.init(MP, DM, G, G - 1 - blk);
              pg8::EpiSigMulB E{(bf16*)(ws + wso(WS_PLE)), (const bf16*)(ws + wso(WS_PPO)), DM}; pg8::gemm_phase<pg8::EpiSigMulB, pg8::StaticOrder, true, true>(lds, g, S, E, wave0); }
              { PHASE_BEGIN(); const SEpi SE{SE_SIGMUL, (float*)(ws + wso(WS_PLE)) + (size_t)MP * DM, (const float*)(ws + wso(WS_PPO)) + (size_t)MP * DM, H + (size_t)MP * DM, DM, DN_ALPHA, T + (size_t)MP * DM}; strip_gemm<4>(HB + (size_t)MP * DM, (const bf16*)(ws + wso(WS_WPG) + L * SZ_WPG), DM, DM, SE, lds, lane_s, wave_s, blk, G, 1, 128); }
        }
#endif
        SEAM(pb + 6);
#if EN_G5
        if (IN(pb + 7)) {
            for (int rep = 0; rep < NREP(8); ++rep) { PHASE_BEGIN(); pg8::Gemm g{(const bf16*)(ws + wso(WS_ACT)), (const bf16*)(ws + wso(WS_WD) + L * SZ_WD), MP, DM, DFF}; pg8::StaticOrder S; S.init(MP, DM, G, blk);
            pg8::EpiResidB E{(bf16*)T, HB, (const bf16*)(ws + wso(WS_PLE)), DM, DN_ALPHA}; pg8::gemm_phase<pg8::EpiResidB, pg8::StaticOrder, true, true>(lds, g, S, E, wave0); }
            { PHASE_BEGIN(); const SEpi SE{SE_ATOMIC, T + (size_t)MP * DM, nullptr, nullptr, DM, 0.f, nullptr}; strip_gemm<4>((const bf16*)(ws + wso(WS_ACT)) + (size_t)MP * DFF, (const bf16*)(ws + wso(WS_WD) + L * SZ_WD), DFF, DM, SE, lds, lane_s, wave_s, blk, G, 8); }
        }
#endif
        SEAM(pb + 7);
#if EN_LN
        if (IN(pb + 8)) for (int rep = 0; rep < NREP(6); ++rep) { PHASE_BEGIN(); phase_ln(a, a->in[I_LN2G] + L * DM, a->in[I_LN2B] + L * DM, L == DEPTH - 1, lane_, wave_, blk, G); }
#endif
        SEAM(pb + 8);
    }
#undef IN
#undef SEAM
}

extern "C" void kernel_launch(void* const* d_in, const int* in_sizes, int n_in, void* d_out, int out_size, void* d_ws, size_t ws_size, hipStream_t stream) {
    static int grid = 0;
    if (grid == 0) {
        if (n_in != N_IN || (size_t)out_size != O_END || ws_size < WS_END) { fprintf(stderr, "kernel_launch: unexpected sizes n_in %d out %d ws %zu (need %zu)\n", n_in, out_size, ws_size, (size_t)WS_END); grid = -1; return; }
        int dev = 0, cus = 0, per_cu = 0;
        if (hipGetDevice(&dev) != hipSuccess || hipDeviceGetAttribute(&cus, hipDeviceAttributeMultiprocessorCount, dev) != hipSuccess) { grid = -1; return; }
        if (hipFuncSetAttribute((const void*)mk_fwd, hipFuncAttributeMaxDynamicSharedMemorySize, LDS_BYTES) != hipSuccess) { fprintf(stderr, "kernel_launch: hipFuncSetAttribute failed\n"); grid = -1; return; }
        if (hipOccupancyMaxActiveBlocksPerMultiprocessor(&per_cu, (const void*)mk_fwd, NTHR, LDS_BYTES) != hipSuccess || per_cu < 1) fprintf(stderr, "kernel_launch: occupancy query says %d\n", per_cu);
        (void)hipGetLastError();
        grid = cus;
        if (grid < G1Z + 8 || grid % 8) { fprintf(stderr, "kernel_launch: %d CUs is too few\n", grid); grid = -1; return; }
    }
    if (grid < 0) return;
    if (hipMemsetAsync((char*)d_ws + WS_CTL, 0, CTL_ZERO_BYTES, stream) != hipSuccess) return;
    Args a{};
    for (int i = 0; i < N_IN; ++i) a.in[i] = (const float*)d_in[i];
    a.out = (float*)d_out; a.ws = (unsigned char*)d_ws;
#if MK_SINGLE
    a.ph_lo = 0; a.ph_hi = N_PHASES;
    hipLaunchKernelGGL(mk_fwd, dim3(grid), dim3(NTHR), LDS_BYTES, stream, a);
#else
    for (int p = 0; p < N_PHASES; ++p) { a.ph_lo = p; a.ph_hi = p + 1; hipLaunchKernelGGL(mk_fwd, dim3(grid), dim3(NTHR), LDS_BYTES, stream, a); }
#endif
}
```
